# Optimizing an MI355X kernel written in HIP

```python
import math
import jax, jax.numpy as jnp
from jax import lax
import numpy as np

D_MODEL = 1024
BATCH = 4
SEQ = 4096
DEPTH = 2

GRID_W = 64
CTX_LEN = 256
N_MIXERS = 2
N_HEADS = 8
N_KV_HEADS = 2
HEAD_DIM = D_MODEL // N_HEADS
KV_REP = N_HEADS // N_KV_HEADS
QKV_DIM = (N_HEADS + 2 * N_KV_HEADS) * HEAD_DIM
Q_BLOCK = 128
WINDOW = 128
ROPE_THETA = 10000.0
RMS_EPS = 1e-6
NEG_INF = -1e30
N_WINDOW_LAYERS = DEPTH // N_MIXERS
PEER_HEADS = 8
PEER_TOPK = 16
N_KEYS = 128
N_EXPERTS = N_KEYS * N_KEYS
PEER_QDIM = 256
PEER_BLOCK = 128
N_MOD = 6

kernel_name = "hybrid_dit_gqa_window_peer"


def rms_norm(x, gain):
    xf = x.astype(jnp.float32)
    y = xf * lax.rsqrt(jnp.mean(xf * xf, axis=-1, keepdims=True) + RMS_EPS)
    return (y * gain.astype(jnp.float32)).astype(x.dtype)


def axial_rope_tables(n_tokens, dtype):
    rows = n_tokens // GRID_W
    row = jnp.repeat(jnp.arange(rows), GRID_W).astype(jnp.float32)
    col = jnp.tile(jnp.arange(GRID_W), rows).astype(jnp.float32)
    half = HEAD_DIM // 2
    inv = ROPE_THETA ** (-jnp.arange(0, half, 2, dtype=jnp.float32) / half)
    ang = jnp.concatenate([row[:, None] * inv, col[:, None] * inv], axis=-1)
    return jnp.cos(ang).astype(dtype), jnp.sin(ang).astype(dtype)


def apply_axial_rope(x, cos, sin):
    n = x.shape[1]
    xr = x.reshape(x.shape[:-1] + (2, 2, HEAD_DIM // 4))
    x1 = xr[..., 0, :]
    x2 = xr[..., 1, :]
    c = cos.reshape(n, 1, 2, HEAD_DIM // 4)
    s = sin.reshape(n, 1, 2, HEAD_DIM // 4)
    out = jnp.stack([x1 * c - x2 * s, x1 * s + x2 * c], axis=-2)
    return out.reshape(x.shape)


def modulate(h, shift, scale):
    return h * (1 + scale) + shift


def project_qkv(h, w_qkv, q_gain, k_gain, rope):
    b, n, _ = h.shape
    y = h @ w_qkv
    q = y[..., : N_HEADS * HEAD_DIM].reshape(b, n, N_HEADS, HEAD_DIM)
    k = y[..., N_HEADS * HEAD_DIM:(N_HEADS + N_KV_HEADS) * HEAD_DIM].reshape(b, n, N_KV_HEADS, HEAD_DIM)
    v = y[..., (N_HEADS + N_KV_HEADS) * HEAD_DIM:].reshape(b, n, N_KV_HEADS, HEAD_DIM)
    q = rms_norm(q, q_gain)
    k = rms_norm(k, k_gain)
    if rope is not None:
        cos, sin = rope
        q = apply_axial_rope(q, cos, sin)
        k = apply_axial_rope(k, cos, sin)
    q = q.reshape(b, n, N_KV_HEADS, KV_REP, HEAD_DIM)
    return q, k, v


def latent_global_attention(q, k, v, kc, vc):
    b, n = q.shape[:2]
    nblk = n // Q_BLOCK
    scale = HEAD_DIM ** -0.5
    ka = jnp.concatenate([kc, k], axis=1)
    va = jnp.concatenate([vc, v], axis=1)
    qb = jnp.moveaxis(q.reshape(b, nblk, Q_BLOCK, N_KV_HEADS, KV_REP, HEAD_DIM), 1, 0)

    def attend_block(qblk):
        s = jnp.einsum('bqgrd,bkgd->bgrqk', qblk, ka).astype(jnp.float32) * scale
        p = jax.nn.softmax(s, axis=-1)
        return jnp.einsum('bgrqk,bkgd->bqgrd', p.astype(va.dtype), va)

    o = lax.map(attend_block, qb)
    return jnp.moveaxis(o, 0, 1).reshape(b, n, N_HEADS * HEAD_DIM)


def latent_window_attention(q, k, v, kc, vc, sink):
    b, n = q.shape[:2]
    nblk = n // Q_BLOCK
    span = Q_BLOCK + 2 * WINDOW
    scale = HEAD_DIM ** -0.5
    kp = jnp.pad(k, ((0, 0), (WINDOW, WINDOW), (0, 0), (0, 0)))
    vp = jnp.pad(v, ((0, 0), (WINDOW, WINDOW), (0, 0), (0, 0)))
    idx = jnp.arange(nblk)[:, None] * Q_BLOCK + jnp.arange(span)[None, :]
    kb = kp[:, idx]
    vb = vp[:, idx]
    kpos = idx - WINDOW
    qpos = jnp.arange(nblk)[:, None] * Q_BLOCK + jnp.arange(Q_BLOCK)[None, :]
    mask = ((kpos[:, None, :] >= 0) & (kpos[:, None, :] < n)
            & (jnp.abs(qpos[:, :, None] - kpos[:, None, :]) <= WINDOW))
    qb = q.reshape(b, nblk, Q_BLOCK, N_KV_HEADS, KV_REP, HEAD_DIM)
    s_loc = jnp.einsum('bnqgrd,bnkgd->bngrqk', qb, kb).astype(jnp.float32) * scale
    s_loc = jnp.where(mask[None, :, None, None], s_loc, NEG_INF)
    s_ctx = jnp.einsum('bnqgrd,bcgd->bngrqc', qb, kc).astype(jnp.float32) * scale
    sk = jnp.broadcast_to(sink.astype(jnp.float32).reshape(N_KV_HEADS, KV_REP, 1, 1),
                          s_loc.shape[:-1] + (1,))
    p = jax.nn.softmax(jnp.concatenate([s_loc, s_ctx, sk], axis=-1), axis=-1)
    p_loc = p[..., :span]
    p_ctx = p[..., span:span + kc.shape[1]]
    o = (jnp.einsum('bngrqk,bnkgd->bnqgrd', p_loc.astype(vb.dtype), vb)
         + jnp.einsum('bngrqc,bcgd->bnqgrd', p_ctx.astype(vc.dtype), vc))
    return o.reshape(b, n, N_HEADS * HEAD_DIM)


def context_attention(qc, kc, vc, sink):
    b, n = qc.shape[:2]
    scale = HEAD_DIM ** -0.5
    s = jnp.einsum('bqgrd,bkgd->bgrqk', qc, kc).astype(jnp.float32) * scale
    if sink is not None:
        sk = jnp.broadcast_to(sink.astype(jnp.float32).reshape(N_KV_HEADS, KV_REP, 1, 1),
                              s.shape[:-1] + (1,))
        p = jax.nn.softmax(jnp.concatenate([s, sk], axis=-1), axis=-1)[..., :n]
    else:
        p = jax.nn.softmax(s, axis=-1)
    o = jnp.einsum('bgrqk,bkgd->bqgrd', p.astype(vc.dtype), vc)
    return o.reshape(b, n, N_HEADS * HEAD_DIM)


def peer_block(hb, w_q, sub_keys, u_tab, v_tab):
    n = hb.shape[0]
    q = (hb @ w_q).reshape(n, PEER_HEADS, PEER_QDIM)
    q1 = q[..., : PEER_QDIM // 2]
    q2 = q[..., PEER_QDIM // 2:]
    s1 = jnp.einsum('nhd,kd->nhk', q1, sub_keys[0]).astype(jnp.float32)
    s2 = jnp.einsum('nhd,kd->nhk', q2, sub_keys[1]).astype(jnp.float32)
    v1, i1 = lax.top_k(s1, PEER_TOPK)
    v2, i2 = lax.top_k(s2, PEER_TOPK)
    cand_s = (v1[..., :, None] + v2[..., None, :]).reshape(n, PEER_HEADS, PEER_TOPK * PEER_TOPK)
    cand_i = (i1[..., :, None] * N_KEYS + i2[..., None, :]).reshape(n, PEER_HEADS, PEER_TOPK * PEER_TOPK)
    top_s, pos = lax.top_k(cand_s, PEER_TOPK)
    expert = jnp.take_along_axis(cand_i, pos, axis=-1)
    g = jax.nn.softmax(top_s, axis=-1)
    u = u_tab[expert]
    act = jax.nn.gelu(jnp.einsum('nhkd,nd->nhk', u, hb).astype(jnp.float32))
    w = (g * act).astype(hb.dtype)
    return jnp.einsum('nhk,nhkd->nd', w, v_tab[expert])


def peer_ffn(h, w_q, sub_keys, u_tab, v_tab):
    b, n, d = h.shape
    hb = h.reshape(-1, PEER_BLOCK, d)
    out = lax.map(lambda blk: peer_block(blk, w_q, sub_keys, u_tab, v_tab), hb)
    return out.reshape(b, n, d)


def setup_inputs(seed: int = 0) -> dict:
    key = jax.random.key(seed)
    ks = jax.random.split(key, 18)
    f32 = jnp.float32
    x = jax.random.normal(ks[0], (BATCH, SEQ, D_MODEL), f32)
    c = jax.random.normal(ks[1], (BATCH, D_MODEL), f32)
    ctx = jax.random.normal(ks[2], (BATCH, CTX_LEN, D_MODEL), f32)
    c_ctx = jax.random.normal(ks[3], (D_MODEL,), f32)
    ada_w = jax.random.normal(ks[4], (DEPTH, D_MODEL, N_MOD * D_MODEL), f32) * (0.5 * D_MODEL ** -0.5)
    ada_b = jax.random.normal(ks[5], (DEPTH, N_MOD * D_MODEL), f32) * 0.1
    norm1_gain = 1.0 + 0.02 * jax.random.normal(ks[6], (DEPTH, D_MODEL), f32)
    norm2_gain = 1.0 + 0.02 * jax.random.normal(ks[7], (DEPTH, D_MODEL), f32)
    w_qkv = jax.random.normal(ks[8], (DEPTH, D_MODEL, QKV_DIM), f32) * D_MODEL ** -0.5
    q_norm_gain = 1.0 + 0.02 * jax.random.normal(ks[9], (DEPTH, HEAD_DIM), f32)
    k_norm_gain = 1.0 + 0.02 * jax.random.normal(ks[10], (DEPTH, HEAD_DIM), f32)
    w_o = jax.random.normal(ks[11], (DEPTH, N_HEADS * HEAD_DIM, D_MODEL), f32) * (N_HEADS * HEAD_DIM) ** -0.5
    attn_sinks = jax.random.normal(ks[12], (N_WINDOW_LAYERS, N_HEADS), f32) * 0.5
    peer_w_q = jax.random.normal(ks[13], (DEPTH, D_MODEL, PEER_HEADS * PEER_QDIM), f32) * D_MODEL ** -0.5
    peer_sub_keys = jax.random.normal(ks[14], (DEPTH, 2, N_KEYS, PEER_QDIM // 2), f32) * (PEER_QDIM // 2) ** -0.5
    peer_u = jax.random.normal(ks[15], (DEPTH, N_EXPERTS, D_MODEL), f32) * D_MODEL ** -0.5
    peer_v = jax.random.normal(ks[16], (DEPTH, N_EXPERTS, D_MODEL), f32) * PEER_HEADS ** -0.5
    return {"x": x, "c": c, "ctx": ctx, "c_ctx": c_ctx, "ada_w": ada_w, "ada_b": ada_b,
            "norm1_gain": norm1_gain, "norm2_gain": norm2_gain, "w_qkv": w_qkv,
            "q_norm_gain": q_norm_gain, "k_norm_gain": k_norm_gain, "w_o": w_o,
            "attn_sinks": attn_sinks, "peer_w_q": peer_w_q, "peer_sub_keys": peer_sub_keys,
            "peer_u": peer_u, "peer_v": peer_v}


def reference(x, c, ctx, c_ctx, ada_w, ada_b, norm1_gain, norm2_gain, w_qkv, q_norm_gain,
              k_norm_gain, w_o, attn_sinks, peer_w_q, peer_sub_keys, peer_u, peer_v):
    n_lat = x.shape[1]
    rope = axial_rope_tables(n_lat, x.dtype)
    xc = ctx
    for i in range(DEPTH):
        last = i == DEPTH - 1
        mod = jax.nn.silu(c) @ ada_w[i] + ada_b[i]
        sh1, sc1, g1, sh2, sc2, g2 = [m[:, None, :] for m in jnp.split(mod, N_MOD, axis=-1)]
        modc = jax.nn.silu(c_ctx) @ ada_w[i] + ada_b[i]
        csh1, csc1, cg1, csh2, csc2, cg2 = jnp.split(modc, N_MOD, axis=-1)

        h = modulate(rms_norm(x, norm1_gain[i]), sh1, sc1)
        hc = modulate(rms_norm(xc, norm1_gain[i]), csh1, csc1)
        q, k, v = project_qkv(h, w_qkv[i], q_norm_gain[i], k_norm_gain[i], rope)
        qc, kc, vc = project_qkv(hc, w_qkv[i], q_norm_gain[i], k_norm_gain[i], None)
        if i % N_MIXERS == 0:
            o = latent_global_attention(q, k, v, kc, vc)
            sink = None
        else:
            sink = attn_sinks[i // N_MIXERS]
            o = latent_window_attention(q, k, v, kc, vc, sink)
        x = x + g1 * (o @ w_o[i])
        if not last:
            oc = context_attention(qc, kc, vc, sink)
            xc = xc + cg1 * (oc @ w_o[i])

        h2 = modulate(rms_norm(x, norm2_gain[i]), sh2, sc2)
        x = x + g2 * peer_ffn(h2, peer_w_q[i], peer_sub_keys[i], peer_u[i], peer_v[i])
        if not last:
            h2c = modulate(rms_norm(xc, norm2_gain[i]), csh2, csc2)
            xc = xc + cg2 * peer_ffn(h2c, peer_w_q[i], peer_sub_keys[i], peer_u[i], peer_v[i])
    return x
```

```cpp
#include <hip/hip_runtime.h>
#include <hip/hip_cooperative_groups.h>
#include <cstdio>
#include <cstdint>

constexpr int NB = 4, SEQ = 4096, CTXL = 256, DM = 1024, DEPTH = 2;
constexpr int RPB = CTXL + SEQ;
constexpr int NROWS = NB * RPB;
constexpr int NH = 8, NKV = 2, HD = 128, QKVD = 1536, NMOD = 6;
constexpr int PH = 8, PK = 16, NKEYS = 128, PQD = 256, PQN = PH * PQD;
constexpr float RMS_EPS = 1e-6f;

namespace nv {

__device__ __forceinline__ float silu(float x) { return x / (1.f + __expf(-x)); }
__device__ __forceinline__ float gelu_tanh(float x) {
  const float y = 0.7978845608028654f * (x + 0.044715f * x * x * x);
  const float t = 1.f - 2.f / (__expf(2.f * y) + 1.f);
  return 0.5f * x * (1.f + t);
}

__global__ void k_mod(const float* __restrict__ c, const float* __restrict__ c_ctx, const float* __restrict__ ada_w,
                      const float* __restrict__ ada_b, float* __restrict__ mod) {
  const int idx = blockIdx.x * 256 + threadIdx.x;
  if (idx >= DEPTH * 5 * NMOD * DM) return;
  const int n = idx % (NMOD * DM), r = (idx / (NMOD * DM)) % 5, i = idx / (5 * NMOD * DM);
  const float* cv = r < 4 ? c + r * DM : c_ctx;
  const float* w = ada_w + (size_t)i * DM * NMOD * DM + n;
  float s = 0.f;
  for (int j = 0; j < DM; ++j) s += silu(cv[j]) * w[(size_t)j * NMOD * DM];
  mod[idx] = s + ada_b[i * NMOD * DM + n];
}

__device__ __forceinline__ float* xrow(float* xl, float* xc, int r) {
  const int b = r / RPB, j = r % RPB;
  return j < CTXL ? xc + (size_t)(b * CTXL + j) * DM : xl + (size_t)(b * SEQ + (j - CTXL)) * DM;
}

__global__ void k_norm(float* xl, float* xc, const float* __restrict__ gain, const float* __restrict__ modi, int sh_i, int sc_i,
                       float* __restrict__ H) {
  const int r = blockIdx.x, t = threadIdx.x;
  const int b = r / RPB, j = r % RPB, mr = j < CTXL ? 4 : b;
  const float* x = xrow(xl, xc, r);
  __shared__ float red[4];
  float v[4]; float s = 0.f;
#pragma unroll
  for (int q = 0; q < 4; ++q) { v[q] = x[t + 256 * q]; s += v[q] * v[q]; }
  for (int o = 32; o > 0; o >>= 1) s += __shfl_xor(s, o);
  if ((t & 63) == 0) red[t >> 6] = s;
  __syncthreads();
  s = red[0] + red[1] + red[2] + red[3];
  const float rstd = rsqrtf(s / DM + RMS_EPS);
  const float* sh = modi + (size_t)mr * NMOD * DM + sh_i * DM; const float* sc = modi + (size_t)mr * NMOD * DM + sc_i * DM;
#pragma unroll
  for (int q = 0; q < 4; ++q) { const int d = t + 256 * q; H[(size_t)r * DM + d] = v[q] * rstd * gain[d] * (1.f + sc[d]) + sh[d]; }
}

template <int EPI>
__global__ void k_gemm(const float* __restrict__ A, const float* __restrict__ B, float* __restrict__ C, int M, int N, int K,
                       float* xl, float* xc, const float* __restrict__ modi, int g_i, int skip_ctx) {
  __shared__ float As[16][68], Bs[16][68];
  const int t = threadIdx.x, tx = t & 15, ty = t >> 4, m0 = blockIdx.y * 64, n0 = blockIdx.x * 64;
  float acc[4][4] = {};
  for (int k0 = 0; k0 < K; k0 += 16) {
    for (int q = 0; q < 4; ++q) { const int e = t + 256 * q, mm = e >> 4, kk = e & 15; As[kk][mm] = A[(size_t)(m0 + mm) * K + k0 + kk]; }
    for (int q = 0; q < 4; ++q) { const int e = t + 256 * q, kk = e >> 6, nn = e & 63; Bs[kk][nn] = B[(size_t)(k0 + kk) * N + n0 + nn]; }
    __syncthreads();
#pragma unroll
    for (int kk = 0; kk < 16; ++kk) {
      float a[4], b[4];
#pragma unroll
      for (int i = 0; i < 4; ++i) { a[i] = As[kk][ty * 4 + i]; b[i] = Bs[kk][tx * 4 + i]; }
#pragma unroll
      for (int i = 0; i < 4; ++i)
#pragma unroll
        for (int j = 0; j < 4; ++j) acc[i][j] += a[i] * b[j];
    }
    __syncthreads();
  }
#pragma unroll
  for (int i = 0; i < 4; ++i) {
    const int r = m0 + ty * 4 + i;
    if (EPI == 0) {
#pragma unroll
      for (int j = 0; j < 4; ++j) C[(size_t)r * N + n0 + tx * 4 + j] = acc[i][j];
    } else {
      const int b = r / RPB, jj = r % RPB; if (skip_ctx && jj < CTXL) continue;
      const int mr = jj < CTXL ? 4 : b; float* x = xrow(xl, xc, r);
      const float* g = modi + (size_t)mr * NMOD * DM + g_i * DM;
#pragma unroll
      for (int j = 0; j < 4; ++j) { const int n = n0 + tx * 4 + j; x[n] += g[n] * acc[i][j]; }
    }
  }
}

__global__ void k_qknorm_rope(float* __restrict__ QKV, const float* __restrict__ qg, const float* __restrict__ kg) {
  const int r = blockIdx.x, t = threadIdx.x, head = t >> 6, p = t & 63, axis = p >> 5, f = p & 31;
  const int j = r % RPB;
  float* base = QKV + (size_t)r * QKVD + head * HD;
  const int e1 = axis * 64 + f, e2 = e1 + 32;
  float x1 = base[e1], x2 = base[e2];
  float s = x1 * x1 + x2 * x2;
  for (int o = 32; o > 0; o >>= 1) s += __shfl_xor(s, o);
  const float rstd = rsqrtf(s / HD + RMS_EPS);
  const float* g = head < NH ? qg : kg;
  x1 = x1 * rstd * g[e1]; x2 = x2 * rstd * g[e2];
  if (j >= CTXL) {
    const int sp = j - CTXL; const float pos = (float)(axis == 0 ? sp / 64 : sp % 64);
    const float inv = powf(10000.f, -(float)(2 * f) / 64.f);
    const float ang = pos * inv; const float cs = cosf(ang), sn = sinf(ang);
    const float y1 = x1 * cs - x2 * sn, y2 = x1 * sn + x2 * cs; x1 = y1; x2 = y2;
  }
  base[e1] = x1; base[e2] = x2;
}

__global__ void k_attn(float* __restrict__ QKV, int mode, const float* __restrict__ sink) {
  extern __shared__ float sm[];
  const int t = threadIdx.x, w = t >> 6, lane = t & 63, g = blockIdx.y;
  int b, j;
  if (mode == 1) { b = blockIdx.x / CTXL; j = blockIdx.x % CTXL; } else { b = blockIdx.x / SEQ; j = CTXL + blockIdx.x % SEQ; }
  const int r = b * RPB + j, h = g * 4 + w;
  float* sc = sm + w * RPB; float* qs = sm + 4 * RPB + w * HD;
  float* qp = QKV + (size_t)r * QKVD + h * HD;
  qs[lane] = qp[lane]; qs[lane + 64] = qp[lane + 64];
  __syncthreads();
  int a0 = 0, a1, b0 = 0, b1 = 0;
  if (mode == 0) a1 = RPB; else if (mode == 1) a1 = CTXL;
  else { a1 = CTXL; const int s = j - CTXL; const int lo = s - 128 < 0 ? 0 : s - 128, hi = s + 128 > SEQ - 1 ? SEQ - 1 : s + 128; b0 = CTXL + lo; b1 = CTXL + hi + 1; }
  const int nk = (a1 - a0) + (b1 - b0);
  const float scale = 0.08838834764831845f;
  float mx = -1e30f;
  for (int i = lane; i < nk; i += 64) {
    const int kr = i < (a1 - a0) ? a0 + i : b0 + (i - (a1 - a0));
    const float4* kp = (const float4*)(QKV + (size_t)(b * RPB + kr) * QKVD + NH * HD + g * HD);
    float s = 0.f;
    for (int d = 0; d < 32; ++d) { const float4 kv = kp[d]; s += kv.x * qs[4 * d] + kv.y * qs[4 * d + 1] + kv.z * qs[4 * d + 2] + kv.w * qs[4 * d + 3]; }
    s *= scale; sc[i] = s; mx = fmaxf(mx, s);
  }
  for (int o = 32; o > 0; o >>= 1) mx = fmaxf(mx, __shfl_xor(mx, o));
  if (mode == 2) mx = fmaxf(mx, sink[h]);
  float l = 0.f;
  for (int i = lane; i < nk; i += 64) { const float p = __expf(sc[i] - mx); sc[i] = p; l += p; }
  for (int o = 32; o > 0; o >>= 1) l += __shfl_xor(l, o);
  if (mode == 2) l += __expf(sink[h] - mx);
  __syncthreads();
  float o0 = 0.f, o1 = 0.f;
  for (int i = 0; i < nk; ++i) {
    const int kr = i < (a1 - a0) ? a0 + i : b0 + (i - (a1 - a0));
    const float* vp = QKV + (size_t)(b * RPB + kr) * QKVD + (NH + NKV) * HD + g * HD;
    const float p = sc[i]; o0 += p * vp[lane]; o1 += p * vp[lane + 64];
  }
  const float il = 1.f / l;
  qp[lane] = o0 * il; qp[lane + 64] = o1 * il;
}

__global__ void k_copy_o(const float* __restrict__ QKV, float* __restrict__ O) {
  const int r = blockIdx.x, t = threadIdx.x;
  for (int q = 0; q < 4; ++q) O[(size_t)r * DM + t + 256 * q] = QKV[(size_t)r * QKVD + t + 256 * q];
}

__global__ void __launch_bounds__(256) k_peer_topk(const float* __restrict__ PQ, const float* __restrict__ SK  , int* __restrict__ eidx, float* __restrict__ gate) {
  __shared__ float q[PQN]; __shared__ float s[16][128]; __shared__ float tv[16][16]; __shared__ int ti[16][16];
  __shared__ float cs[8][256]; __shared__ int taken[8][256];
  const int r = blockIdx.x, t = threadIdx.x;
  for (int i = t; i < PQN; i += 256) q[i] = PQ[(size_t)r * PQN + i];
  __syncthreads();
  { const int k = t & 127, half = t >> 7; const float* kp = SK + (size_t)half * NKEYS * 128 + (size_t)k * 128;
#pragma nounroll
    for (int h = 0; h < PH; ++h) { float a = 0.f; const float* qq = q + h * PQD + half * 128;
#pragma unroll 4
      for (int d = 0; d < 128; ++d) a += qq[d] * kp[d];
      s[h * 2 + half][k] = a; } }
  __syncthreads();
  if (t < 16) {
#pragma nounroll
    for (int it = 0; it < PK; ++it) { float bv = -3e38f; int bi = 0;
#pragma nounroll
      for (int k = 0; k < 128; ++k) { const float v = s[t][k]; if (v > bv) { bv = v; bi = k; } } tv[t][it] = bv; ti[t][it] = bi; s[t][bi] = -3e38f; }
  }
  __syncthreads();
  for (int i = t; i < 8 * 256; i += 256) { const int h = i >> 8, c = i & 255; cs[h][c] = tv[h * 2][c >> 4] + tv[h * 2 + 1][c & 15]; taken[h][c] = 0; }
  __syncthreads();
  if (t < 8) {
    float m = -3e38f;
#pragma nounroll
    for (int it = 0; it < PK; ++it) { float bv = -3e38f; int bi = 0;
#pragma nounroll
      for (int c = 0; c < 256; ++c) { const float v = cs[t][c]; if (!taken[t][c] && v > bv) { bv = v; bi = c; } }
      taken[t][bi] = 1; s[t][it] = bv; m = fmaxf(m, bv); eidx[(size_t)r * 128 + t * PK + it] = ti[t * 2][bi >> 4] * NKEYS + ti[t * 2 + 1][bi & 15]; }
    float l = 0.f;
#pragma nounroll
    for (int it = 0; it < PK; ++it) l += __expf(s[t][it] - m);
#pragma nounroll
    for (int it = 0; it < PK; ++it) gate[(size_t)r * 128 + t * PK + it] = __expf(s[t][it] - m) / l;
  }
}

__global__ void k_peer_u(const float* __restrict__ H, const float* __restrict__ U, const int* __restrict__ eidx, const float* __restrict__ gate, float* __restrict__ W) {
  __shared__ float h[DM];
  const int r = blockIdx.x, t = threadIdx.x, w = t >> 6, lane = t & 63;
  for (int i = t; i < DM; i += 256) h[i] = H[(size_t)r * DM + i];
  __syncthreads();
  for (int k = w; k < 128; k += 4) {
    const int e = eidx[(size_t)r * 128 + k]; const float* u = U + (size_t)e * DM; float a = 0.f;
    for (int d = lane; d < DM; d += 64) a += u[d] * h[d];
    for (int o = 32; o > 0; o >>= 1) a += __shfl_xor(a, o);
    if (lane == 0) W[(size_t)r * 128 + k] = gate[(size_t)r * 128 + k] * gelu_tanh(a);
  }
}
__global__ void k_peer_v(const float* __restrict__ V, const int* __restrict__ eidx, const float* __restrict__ W, float* xl, float* xc,
                         const float* __restrict__ modi, int g_i, int skip_ctx) {
  const int r = blockIdx.x, t = threadIdx.x; const int b = r / RPB, j = r % RPB; if (skip_ctx && j < CTXL) return;
  float4 acc = {0.f, 0.f, 0.f, 0.f};
  for (int k = 0; k < 128; ++k) { const int e = eidx[(size_t)r * 128 + k]; const float w = W[(size_t)r * 128 + k]; const float4 v = ((const float4*)(V + (size_t)e * DM))[t];
    acc.x += w * v.x; acc.y += w * v.y; acc.z += w * v.z; acc.w += w * v.w; }
  const int mr = j < CTXL ? 4 : b; float4* x = (float4*)xrow(xl, xc, r) + t; const float4 g = ((const float4*)(modi + (size_t)mr * NMOD * DM + g_i * DM))[t];
  float4 xv = *x; xv.x += g.x * acc.x; xv.y += g.y * acc.y; xv.z += g.z * acc.z; xv.w += g.w * acc.w; *x = xv;
}
}


namespace pg8 {
#define PG8_LAS __attribute__((address_space(3)))
typedef unsigned short bf16_t;
typedef short bf16x8 __attribute__((ext_vector_type(8)));
typedef float f32x4 __attribute__((ext_vector_type(4)));
typedef unsigned u32x4 __attribute__((ext_vector_type(4)));
constexpr int BM = 256, BK = 64, HALF = 128, HTB = HALF * BK * 2  , STAGE_BYTES = 8 * HTB, NXCD = 8, WGM = 8;

__host__ __device__ __forceinline__ int lds_byte(int r, int c) { const int st = (r >> 4) * 2 + (c >> 5), rr = r & 15, cc = c & 31, ob = rr * 64 + cc * 2; return st * 1024 + (ob ^ (((ob >> 9) & 1) << 5)); }
__host__ __device__ __forceinline__ void stage_rc(int b, int& R, int& C) { const int st = b / 1024, sb = b % 1024, swz = sb ^ (((sb >> 9) & 1) << 5); R = (st >> 1) * 16 + swz / 64; C = (st & 1) * 32 + (swz % 64) / 2; }
__host__ __device__ __forceinline__ int perm32(int rho) { const int n = rho >> 4, i = rho & 15; return 8 * (i >> 2) + 4 * n + (i & 3); }

struct Unit { int pm, pn; };
struct Gemm { const bf16_t* A; const bf16_t* Bt; int M, N, K; };

struct StaticOrder {
    int nM, nN, nwg, G, c;
    __host__ __device__ void init(int M, int N, int G_, int c_) { nM = M / BM; nN = N / BM; nwg = nM * nN; G = G_; c = c_; }
    __host__ __device__ bool next(int i, Unit& u) const {
        const long L = (long)i * G + c; if (L >= nwg) return false;
        int wgid = (int)L; { const int q = nwg / NXCD, r = nwg % NXCD, xcd = wgid % NXCD, off = wgid / NXCD; wgid = (xcd < r ? xcd * (q + 1) : r * (q + 1) + (xcd - r) * q) + off; }
        const int nig = WGM * nN, gid = wgid / nig, fm = gid * WGM, gsz = (nM - fm) < WGM ? (nM - fm) : WGM;
        u.pm = fm + ((wgid % nig) % gsz); u.pn = (wgid % nig) / gsz; return true;
    }
    __device__ __forceinline__ void a_ready(const Unit&) const {}
    __device__ __forceinline__ void done(const Unit&) const {}
};

__device__ __forceinline__ unsigned cvt_pk_bf16(float lo, float hi) { unsigned r; asm volatile("v_cvt_pk_bf16_f32 %0, %1, %2" : "=v"(r) : "v"(lo), "v"(hi)); return r; }
typedef float f32x2 __attribute__((ext_vector_type(2)));
__device__ __forceinline__ f32x2 gelu_pk(f32x2 v) {
    const f32x2 av = __builtin_elementwise_abs(v), d = av * 0.2316418882f + 1.0f;
    f32x2 t; t.x = __builtin_amdgcn_rcpf(d.x); t.y = __builtin_amdgcn_rcpf(d.y);
    f32x2 q = t * 0.5307027145f + (-0.7265760135f); q = q * t + 0.7107068705f; q = q * t + (-0.142248368f); q = q * t + 0.127414796f; q = q * t;
    const f32x2 s = (v * v) * (-0.72134752044f);
    f32x2 e; e.x = __builtin_amdgcn_exp2f(s.x); e.y = __builtin_amdgcn_exp2f(s.y);
    const f32x2 m = v * (q * e), r = v - m;
    f32x2 o; o.x = v.x < 0.f ? m.x : r.x; o.y = v.y < 0.f ? m.y : r.y; return o;
}

template <int ACT  > struct EpiBf16 {
    static constexpr bool PERM = true, AFTER_DRAIN = false; static_assert(ACT == 0 || ACT == 1, "EpiBf16: ACT is 0 (none) or 1 (gelu_pk)");
    bf16_t* O; int ldc; const float* bias; int split_cols; size_t split_stride; float scale0;
    __device__ __forceinline__ void operator()(const f32x4 (&acc)[2][2][4][2], const Unit& u, int wr, int wc, int fr, int fq) const {
        const int row0 = u.pm * BM + wr * 64 + fr; int colt = u.pn * BM; bf16_t* base = O;
        float sc = 1.f; if (split_cols) { const int t = colt / split_cols; base += (size_t)t * split_stride; colt -= t * split_cols; if (t == 0) sc = scale0; }
        const int col0 = colt + wc * 32 + 8 * fq, bcol0 = u.pn * BM + wc * 32 + 8 * fq;
        f32x4 bv[2][2];
#pragma unroll
        for (int bj = 0; bj < 2; ++bj)
#pragma unroll
            for (int n = 0; n < 2; ++n) bv[bj][n] = bias ? *(const f32x4*)(bias + bcol0 + bj * HALF + 4 * n) : (f32x4){0.f, 0.f, 0.f, 0.f};
#pragma unroll
        for (int ai = 0; ai < 2; ++ai)
#pragma unroll
            for (int m = 0; m < 4; ++m) { bf16_t* rowp = base + (size_t)(row0 + ai * HALF + m * 16) * ldc + col0;
#pragma unroll
                for (int bj = 0; bj < 2; ++bj) { f32x4 v0 = acc[ai][bj][m][0] + bv[bj][0], v1 = acc[ai][bj][m][1] + bv[bj][1];
                    if (ACT == 1) { f32x2 a = gelu_pk((f32x2){v0[0], v0[1]}), b = gelu_pk((f32x2){v0[2], v0[3]}), c = gelu_pk((f32x2){v1[0], v1[1]}), d = gelu_pk((f32x2){v1[2], v1[3]});
                        v0 = (f32x4){a.x, a.y, b.x, b.y}; v1 = (f32x4){c.x, c.y, d.x, d.y}; }
                    v0 = v0 * sc; v1 = v1 * sc; u32x4 w; w.x = cvt_pk_bf16(v0[0], v0[1]); w.y = cvt_pk_bf16(v0[2], v0[3]); w.z = cvt_pk_bf16(v1[0], v1[1]); w.w = cvt_pk_bf16(v1[2], v1[3]);
                    *(u32x4*)(rowp + bj * HALF) = w; } }
    }
};

template <class Epi, class Sched, bool ALIGN_EPI = false, bool SP2 = false>
__device__ __forceinline__ void gemm_phase(PG8_LAS unsigned char* lds, const Gemm g, const Sched& S, const Epi& E) {
    int tid_ = threadIdx.x; asm volatile("" : "+v"(tid_));
    const int tid = tid_, wid = __builtin_amdgcn_readfirstlane(tid >> 6), lane = tid & 63, wr = wid >> 2, wc = wid & 3, fr = lane & 15, fq = lane >> 4;
    const int K = g.K, nt = K / BK;
    unsigned voffA[2], voffB[2];
#pragma unroll
    for (int i = 0; i < 2; ++i) { int R, C; stage_rc(tid * 16 + i * 8192, R, C); const int Rb = Epi::PERM ? ((R & ~31) + perm32(R & 31)) : R;
        voffA[i] = (unsigned)(R * K + C) * 2u; voffB[i] = (unsigned)(Rb * K + C) * 2u; }
    const size_t kstep = (size_t)(BK * 2);
    const size_t hstep = (size_t)HALF * K * 2;
    const size_t tstep = 2 * hstep;
    const unsigned ldsw = (unsigned)wid * 1024u;
    const int aoff = lds_byte(wr * 64 + fr, fq * 8), boff = lds_byte(wc * 32 + fr, fq * 8);
#define PG8_SA(b, h) (((b) * 2 + (h)) * HTB)
#define PG8_SB(b, h) ((4 + (b) * 2 + (h)) * HTB)
#define PG8_STAGE(bufoff, gbase, voff) do { _Pragma("unroll") for (int _i = 0; _i < 2; ++_i) \
        __builtin_amdgcn_global_load_lds((const unsigned*)((const char*)(gbase) + (voff)[_i]), (PG8_LAS unsigned*)(lds + (bufoff) + ldsw + _i * 8192), 16, 0, 0); } while (0)
#define PG8_LDA(dst, b, h) do { _Pragma("unroll") for (int m = 0; m < 4; ++m) _Pragma("unroll") for (int k = 0; k < 2; ++k) dst[m][k] = *(const PG8_LAS bf16x8*)(lds + PG8_SA(b, h) + aoff + m * 2048 + k * 1024); } while (0)
#define PG8_LDB(dst, b, h) do { _Pragma("unroll") for (int n = 0; n < 2; ++n) _Pragma("unroll") for (int k = 0; k < 2; ++k) dst[n][k] = *(const PG8_LAS bf16x8*)(lds + PG8_SB(b, h) + boff + n * 2048 + k * 1024); } while (0)
#define PG8_MMA(ai, bj, At, Bt) do { __builtin_amdgcn_s_setprio(1); _Pragma("unroll") for (int m = 0; m < 4; ++m) _Pragma("unroll") for (int n = 0; n < 2; ++n) _Pragma("unroll") for (int k = 0; k < 2; ++k) \
        acc[ai][bj][m][n] = __builtin_amdgcn_mfma_f32_16x16x32_bf16(Bt[n][k], At[m][k], acc[ai][bj][m][n], 0, 0, 0); __builtin_amdgcn_s_setprio(0); } while (0)
#define PG8_WAIT_V(n) asm volatile("s_waitcnt vmcnt(" #n ")" ::: "memory")
#define PG8_WAIT_L(n) asm volatile("s_waitcnt lgkmcnt(" #n ")" ::: "memory")
#define PG8_BAR __builtin_amdgcn_s_barrier()
#define PG8_SCHED __builtin_amdgcn_sched_barrier(0)
    Unit cur, nxt; int ui = 0;
    if (!S.next(0, cur)) return;
    f32x4 acc[2][2][4][2];
#pragma unroll
    for (int a = 0; a < 2; ++a)
#pragma unroll
        for (int b = 0; b < 2; ++b)
#pragma unroll
            for (int m = 0; m < 4; ++m)
#pragma unroll
                for (int n = 0; n < 2; ++n) acc[a][b][m][n] = (f32x4){0.f, 0.f, 0.f, 0.f};
    bf16x8 At[4][2], B0[2][2], B1[2][2];
    const char* cA = (const char*)g.A + (size_t)cur.pm * tstep; const char* cB = (const char*)g.Bt + (size_t)cur.pn * tstep;
    S.a_ready(cur);
    if constexpr (SP2) {
        PG8_STAGE(PG8_SB(0, 0), cB, voffB); PG8_STAGE(PG8_SB(0, 1), cB + hstep, voffB); PG8_STAGE(PG8_SA(0, 0), cA, voffA); PG8_STAGE(PG8_SA(0, 1), cA + hstep, voffA);
        if (wr == 1) PG8_BAR;
        PG8_WAIT_V(2); PG8_BAR;
        PG8_STAGE(PG8_SB(1, 0), cB + kstep, voffB); PG8_STAGE(PG8_SA(1, 0), cA + kstep, voffA); PG8_STAGE(PG8_SB(1, 1), cB + hstep + kstep, voffB);
        PG8_WAIT_V(6); PG8_BAR;
    } else {
        PG8_STAGE(PG8_SB(0, 0), cB, voffB); PG8_STAGE(PG8_SA(0, 0), cA, voffA); PG8_STAGE(PG8_SB(0, 1), cB + hstep, voffB); PG8_STAGE(PG8_SA(0, 1), cA + hstep, voffA);
        if (wr == 1) PG8_BAR;
        PG8_WAIT_V(4); PG8_BAR;
        PG8_STAGE(PG8_SB(1, 0), cB + kstep, voffB); PG8_STAGE(PG8_SA(1, 0), cA + kstep, voffA); PG8_STAGE(PG8_SB(1, 1), cB + hstep + kstep, voffB);
        PG8_WAIT_V(6); PG8_BAR;
    }
    for (;;) {
        const bool has_next = S.next(ui + 1, nxt);
        const char* nA = has_next ? (const char*)g.A + (size_t)nxt.pm * tstep : cA; const char* nB = has_next ? (const char*)g.Bt + (size_t)nxt.pn * tstep : cB;
        for (int t = 0; t < nt; t += 2) {
            const bool last = (t == nt - 2);
            const char* a1 = cA + (size_t)(t + 1) * kstep;
            const char* a2 = last ? nA : cA + (size_t)(t + 2) * kstep; const char* b2 = last ? nB : cB + (size_t)(t + 2) * kstep;
            const char* a3 = a2 + kstep; const char* b3 = b2 + kstep;
            if (last && has_next) S.a_ready(nxt);
            if constexpr (SP2) {
            PG8_LDB(B0, 0, 0); PG8_LDB(B1, 0, 1); PG8_SCHED; PG8_LDA(At, 0, 0); PG8_STAGE(PG8_SA(1, 1), a1 + hstep, voffA);
            PG8_WAIT_V(8); PG8_WAIT_L(0); PG8_BAR; PG8_MMA(0, 0, At, B0); PG8_MMA(0, 1, At, B1); PG8_BAR; PG8_SCHED;
            PG8_LDA(At, 0, 1); PG8_STAGE(PG8_SB(0, 0), b2, voffB); PG8_STAGE(PG8_SB(0, 1), b2 + hstep, voffB); PG8_STAGE(PG8_SA(0, 0), a2, voffA);
            PG8_WAIT_V(8); PG8_WAIT_L(0); PG8_BAR; PG8_MMA(1, 0, At, B0); PG8_MMA(1, 1, At, B1); PG8_BAR; PG8_SCHED;
            PG8_LDB(B0, 1, 0); PG8_LDB(B1, 1, 1); PG8_SCHED; PG8_LDA(At, 1, 0); PG8_STAGE(PG8_SA(0, 1), a2 + hstep, voffA);
            PG8_WAIT_V(8); PG8_WAIT_L(0); PG8_BAR; PG8_MMA(0, 0, At, B0); PG8_MMA(0, 1, At, B1); PG8_BAR; PG8_SCHED;
            PG8_LDA(At, 1, 1); PG8_STAGE(PG8_SB(1, 0), b3, voffB); PG8_STAGE(PG8_SB(1, 1), b3 + hstep, voffB); PG8_STAGE(PG8_SA(1, 0), a3, voffA);
            PG8_WAIT_V(8); PG8_WAIT_L(0); PG8_BAR; PG8_MMA(1, 0, At, B0); PG8_MMA(1, 1, At, B1); PG8_BAR; PG8_SCHED;
            } else {
            PG8_LDB(B0, 0, 0); PG8_SCHED; PG8_LDA(At, 0, 0); PG8_STAGE(PG8_SA(1, 1), a1 + hstep, voffA);
            PG8_WAIT_L(8); PG8_BAR; PG8_WAIT_L(0); PG8_MMA(0, 0, At, B0); PG8_BAR; PG8_SCHED;
            PG8_LDB(B1, 0, 1); PG8_STAGE(PG8_SB(0, 0), b2, voffB);
            PG8_BAR; PG8_WAIT_L(0); PG8_MMA(0, 1, At, B1); PG8_BAR;
            PG8_LDA(At, 0, 1); PG8_STAGE(PG8_SA(0, 0), a2, voffA);
            PG8_BAR; PG8_WAIT_L(0); PG8_MMA(1, 0, At, B0); PG8_BAR; PG8_SCHED;
            PG8_STAGE(PG8_SB(0, 1), b2 + hstep, voffB);
            PG8_WAIT_V(6); PG8_BAR; PG8_MMA(1, 1, At, B1); PG8_BAR;
            PG8_LDB(B0, 1, 0); PG8_SCHED; PG8_LDA(At, 1, 0); PG8_STAGE(PG8_SA(0, 1), a2 + hstep, voffA);
            PG8_WAIT_L(8); PG8_BAR; PG8_WAIT_L(0); PG8_MMA(0, 0, At, B0); PG8_BAR; PG8_SCHED;
            PG8_LDB(B1, 1, 1); PG8_STAGE(PG8_SB(1, 0), b3, voffB);
            PG8_BAR; PG8_WAIT_L(0); PG8_MMA(0, 1, At, B1); PG8_BAR;
            PG8_LDA(At, 1, 1); PG8_STAGE(PG8_SA(1, 0), a3, voffA);
            PG8_BAR; PG8_WAIT_L(0); PG8_MMA(1, 0, At, B0); PG8_BAR; PG8_SCHED;
            PG8_STAGE(PG8_SB(1, 1), b3 + hstep, voffB);
            PG8_WAIT_V(6); PG8_BAR; PG8_MMA(1, 1, At, B1); PG8_BAR;
            }
        }
        if constexpr (ALIGN_EPI) { if (wr == 0) PG8_BAR; }
        if constexpr (!Epi::AFTER_DRAIN) { E(acc, cur, wr, wc, fr, fq); S.done(cur); }
        if (!has_next) break;
#pragma unroll
        for (int a = 0; a < 2; ++a)
#pragma unroll
            for (int b = 0; b < 2; ++b)
#pragma unroll
                for (int m = 0; m < 4; ++m)
#pragma unroll
                    for (int n = 0; n < 2; ++n) acc[a][b][m][n] = (f32x4){0.f, 0.f, 0.f, 0.f};
        cur = nxt; cA = nA; cB = nB; ++ui;
        if constexpr (ALIGN_EPI) { if (wr == 1) PG8_BAR; }
    }
    PG8_WAIT_V(0);
    if constexpr (!ALIGN_EPI) { if (wr == 0) PG8_BAR; }
    PG8_BAR;
    if constexpr (Epi::AFTER_DRAIN) { E.fused(acc, cur, wr, wc, fr, fq, lds, wid, lane); S.done(cur); }
#undef PG8_SA
#undef PG8_SB
#undef PG8_STAGE
#undef PG8_LDA
#undef PG8_LDB
#undef PG8_MMA
#undef PG8_WAIT_V
#undef PG8_WAIT_L
#undef PG8_BAR
#undef PG8_SCHED
}
}

namespace att {
typedef unsigned short bf16;
constexpr int D = 128, NW = 8, QBLK = 32, KVBLK = 64, LDQ = 1024, LDK = 256;
constexpr float SCALE = 0.088388347648318440f;
constexpr float THR = 8.f;
#ifndef ATT_SDEPTH
#define ATT_SDEPTH 1
#endif
constexpr int SDEPTH = ATT_SDEPTH;
constexpr size_t SHM_V = KVBLK * D * 2, SHM_K = KVBLK * D * 2, SHM_ATTN = 2 * SHM_V + 2 * SHM_K + NW * 64 * 4;
using bf16x8 = __attribute__((ext_vector_type(8))) short;
using s16x4  = __attribute__((ext_vector_type(4))) short;
using f32x16 = __attribute__((ext_vector_type(16))) float;
using u32x4  = __attribute__((ext_vector_type(4))) unsigned;
#define KSWZ(row, colB) ((row) * 256 + ((colB) ^ (((row) & 7) << 4)))
#define SBAR() __builtin_amdgcn_sched_barrier(0)
__device__ __forceinline__ int crow(int r, int hi) { return (r & 3) + 8 * (r >> 2) + 4 * hi; }
__device__ __forceinline__ unsigned cvtpk(float lo, float hi) { unsigned r; asm volatile("v_cvt_pk_bf16_f32 %0, %1, %2" : "=v"(r) : "v"(lo), "v"(hi)); return r; }
__device__ __forceinline__ void partialSM(f32x16& p0, f32x16& p1, float& m_reg, float& mn, float& alpha) {
  constexpr float C = SCALE * 1.4426950408889634f;
  float pmax = p0[0]; for (int r = 1; r < 16; ++r) pmax = fmaxf(pmax, p0[r]); for (int r = 0; r < 16; ++r) pmax = fmaxf(pmax, p1[r]);
  { auto rr = __builtin_amdgcn_permlane32_swap(__float_as_uint(pmax), __float_as_uint(pmax), false, false);
    pmax = fmaxf(__uint_as_float(rr[0]), __uint_as_float(rr[1])); }
  if (__builtin_expect(__all(pmax - m_reg <= THR / SCALE), 1)) { mn = m_reg; alpha = 1.f; }
  else { mn = fmaxf(m_reg, pmax); alpha = __builtin_amdgcn_exp2f((m_reg - mn) * C); m_reg = mn; }
  float mnC = -mn * C;
  for (int r = 0; r < 16; ++r) p0[r] = fmaf(p0[r], C, mnC); for (int r = 0; r < 16; ++r) p1[r] = fmaf(p1[r], C, mnC);
  for (int r = 0; r < 16; ++r) p0[r] = __builtin_amdgcn_exp2f(p0[r]);
}
__device__ __forceinline__ void finishSM(f32x16& p0, f32x16& p1, float alpha, float& l_reg, bf16x8& pa0, bf16x8& pa1, bf16x8& pa2, bf16x8& pa3) {
  for (int r = 0; r < 16; ++r) p1[r] = __builtin_amdgcn_exp2f(p1[r]);
  float ps = 0; for (int r = 0; r < 16; ++r) ps += p0[r]; for (int r = 0; r < 16; ++r) ps += p1[r];
  { auto rr = __builtin_amdgcn_permlane32_swap(__float_as_uint(ps), __float_as_uint(ps), false, false);
    ps = __uint_as_float(rr[0]) + __uint_as_float(rr[1]); }
  l_reg = l_reg * alpha + ps;
#define PK4(P, BASE, OUT) do { unsigned a0 = cvtpk(P[BASE + 0], P[BASE + 1]), a1 = cvtpk(P[BASE + 2], P[BASE + 3]);   \
    unsigned b0 = cvtpk(P[BASE + 4], P[BASE + 5]), b1 = cvtpk(P[BASE + 6], P[BASE + 7]);                              \
    auto r0 = __builtin_amdgcn_permlane32_swap(a0, b0, false, false); auto r1 = __builtin_amdgcn_permlane32_swap(a1, b1, false, false); \
    u32x4 w = {r0[0], r1[0], r0[1], r1[1]}; OUT = *reinterpret_cast<bf16x8*>(&w); } while (0)
  PK4(p0, 0, pa0); PK4(p0, 8, pa1); PK4(p1, 0, pa2); PK4(p1, 8, pa3);
#undef PK4
}
__device__ __forceinline__ void qkt(f32x16& p0, f32x16& p1, const bf16* Ks, const bf16x8* qr, int r32, int hi) {
  p0 = f32x16{}; p1 = f32x16{};
  for (int d0 = 0; d0 < 8; ++d0) { int cb = (d0 * 16 + hi * 8) * 2;
    bf16x8 b0 = *reinterpret_cast<const bf16x8*>((const char*)Ks + KSWZ(r32, cb));
    bf16x8 b1 = *reinterpret_cast<const bf16x8*>((const char*)Ks + KSWZ(32 + r32, cb));
    p0 = __builtin_amdgcn_mfma_f32_32x32x16_bf16(b0, qr[d0], p0, 0, 0, 0);
    p1 = __builtin_amdgcn_mfma_f32_32x32x16_bf16(b1, qr[d0], p1, 0, 0, 0); }
}
__device__ __forceinline__ int v_st(int k, int c) { const int kk = (k & ~0xC) | ((k & 4) << 1) | ((k & 8) >> 1); return ((kk >> 3) * 4 + (c >> 5)) * 512 + ((kk & 7) * 32 + (c & 31)) * 2; }
__device__ __forceinline__ int v_rd_base(int lane) { return ((lane & 3) << 3) | (((lane >> 2) & 3) << 6) | (((lane >> 4) & 1) << 5) | (((lane >> 5) & 1) << 8); }
constexpr int v_rd_off(int d0, int ks, int half) { return d0 * 512 + ks * 4096 + half * 2048; }
template <int OFF> __device__ __forceinline__ s16x4 tr_read(int vb) {
  s16x4 r; asm volatile("ds_read_b64_tr_b16 %0, %1 offset:%2" : "=&v"(r) : "v"(vb), "i"(OFF) : "memory"); return r;
}
template <int D0> __device__ __forceinline__ void pv_one(f32x16& od, int vb, bf16x8 pa0, bf16x8 pa1, bf16x8 pa2, bf16x8 pa3) {
  const s16x4 l0 = tr_read<v_rd_off(D0, 0, 0)>(vb), h0 = tr_read<v_rd_off(D0, 0, 1)>(vb), l1 = tr_read<v_rd_off(D0, 1, 0)>(vb), h1 = tr_read<v_rd_off(D0, 1, 1)>(vb);
  const s16x4 l2 = tr_read<v_rd_off(D0, 2, 0)>(vb), h2 = tr_read<v_rd_off(D0, 2, 1)>(vb), l3 = tr_read<v_rd_off(D0, 3, 0)>(vb), h3 = tr_read<v_rd_off(D0, 3, 1)>(vb);
  asm volatile("s_waitcnt lgkmcnt(0)" ::: "memory"); SBAR();
#define PKV(L, H) (bf16x8){L[0], L[1], L[2], L[3], H[0], H[1], H[2], H[3]}
  od = __builtin_amdgcn_mfma_f32_32x32x16_bf16(pa0, PKV(l0, h0), od, 0, 0, 0);
  od = __builtin_amdgcn_mfma_f32_32x32x16_bf16(pa1, PKV(l1, h1), od, 0, 0, 0);
  od = __builtin_amdgcn_mfma_f32_32x32x16_bf16(pa2, PKV(l2, h2), od, 0, 0, 0);
  od = __builtin_amdgcn_mfma_f32_32x32x16_bf16(pa3, PKV(l3, h3), od, 0, 0, 0);
#undef PKV
}
__device__ __forceinline__ void pv_d0(f32x16* o, int vb, bf16x8 pa0, bf16x8 pa1, bf16x8 pa2, bf16x8 pa3) {
  pv_one<0>(o[0], vb, pa0, pa1, pa2, pa3); pv_one<1>(o[1], vb, pa0, pa1, pa2, pa3); pv_one<2>(o[2], vb, pa0, pa1, pa2, pa3); pv_one<3>(o[3], vb, pa0, pa1, pa2, pa3);
}
__device__ __forceinline__ void wmask(f32x16& p0, f32x16& p1, int kb, int qp, int hi) {
  const int bd = kb - qp + 4 * hi + 128;
#pragma unroll
  for (int r = 0; r < 16; ++r) { const int d0 = bd + (r & 3) + 8 * (r >> 2);
    if ((unsigned)d0 > 256u) p0[r] = -1e30f; if ((unsigned)(d0 + 32) > 256u) p1[r] = -1e30f; }
}
__device__ __forceinline__ void attn_unit(const bool WIN, bf16* Qb, const bf16* __restrict__ Kh, const bf16* __restrict__ Vh, int NT, int kstart, int q0, float sink_l2, char* lds) {
  int tid_ = threadIdx.x; asm volatile("" : "+v"(tid_));
  const int tid = tid_, wid = tid >> 6, lane = tid & 63, r32 = lane & 31, hi = lane >> 5;
  bf16* V_lds = (bf16*)lds; bf16* K_lds = (bf16*)(lds + 2 * SHM_V);
  float* ws = (float*)(lds + 2 * SHM_V + 2 * SHM_K) + wid * 64; float* li_l = ws; float* al_l = ws + 32;
  float m_reg = -1e30f, l_reg = 0; f32x16 o[4] = {}; bf16x8 qr[8];
  bf16* Qw = Qb + (long)(wid * QBLK + r32) * LDQ + hi * 8;
#pragma unroll
  for (int d0 = 0; d0 < 8; ++d0) qr[d0] = *reinterpret_cast<const bf16x8*>(Qw + d0 * 16);
  const int sr = tid >> 4, sc = (tid & 15) * 8, vst0 = v_st(sr, sc), vst1 = v_st(32 + sr, sc);
  const int vb0 = (int)(uintptr_t)V_lds + v_rd_base(lane);
  const int qp = q0 + wid * QBLK + r32;
  struct { bf16x8 vs0, vs1, ks0, ks1; } sr_[SDEPTH];
#define TROW(t) (WIN ? ((t) < 4 ? (t) * KVBLK : kstart + (t) * KVBLK) : (t) * KVBLK)
#define SLOAD(i, t) do { const int k0_ = TROW(t); sr_[i].vs0 = *reinterpret_cast<const bf16x8*>(&Vh[(long)(k0_ + sr) * LDK + sc]); sr_[i].vs1 = *reinterpret_cast<const bf16x8*>(&Vh[(long)(k0_ + 32 + sr) * LDK + sc]); \
    sr_[i].ks0 = *reinterpret_cast<const bf16x8*>(&Kh[(long)(k0_ + sr) * LDK + sc]); sr_[i].ks1 = *reinterpret_cast<const bf16x8*>(&Kh[(long)(k0_ + 32 + sr) * LDK + sc]); } while (0)
#define SWRITE(b, i) do { *(bf16x8*)((char*)V_lds + (b) * SHM_V + vst0) = sr_[i].vs0;          \
    *(bf16x8*)((char*)V_lds + (b) * SHM_V + vst1) = sr_[i].vs1; int kc = sc * 2;               \
    *(bf16x8*)((char*)K_lds + (b) * SHM_K + KSWZ(sr, kc)) = sr_[i].ks0;                       \
    *(bf16x8*)((char*)K_lds + (b) * SHM_K + KSWZ(32 + sr, kc)) = sr_[i].ks1; } while (0)
#define SWAIT() do { if constexpr (SDEPTH == 2) asm volatile("s_waitcnt vmcnt(4)" ::: "memory"); else asm volatile("s_waitcnt vmcnt(0)" ::: "memory"); } while (0)
#define RESC(a) do { if (__any((a) < 1.f)) { if (hi == 0) al_l[r32] = (a); asm volatile("s_waitcnt lgkmcnt(0)" ::: "memory"); \
    for (int d = 0; d < 4; ++d) for (int r = 0; r < 16; ++r) o[d][r] *= al_l[crow(r, hi)]; } } while (0)
#define WMASK(P0, P1, t) do { if (WIN) { if ((t) >= 4) wmask(P0, P1, kstart + ((t) - 4) * KVBLK, qp, hi); } } while (0)
  f32x16 pA0, pA1, pB0, pB1; float mnA, mnB, alA, alB; bf16x8 pa0, pa1, pa2, pa3;
  constexpr int SE = 0, SO = SDEPTH - 1;
  SLOAD(SE, 0); asm volatile("s_waitcnt vmcnt(0)" ::: "memory"); SWRITE(0, SE); __syncthreads();
  qkt(pA0, pA1, K_lds, qr, r32, hi); WMASK(pA0, pA1, 0); partialSM(pA0, pA1, m_reg, mnA, alA);
  SLOAD(SO, 1); if constexpr (SDEPTH == 2) { if (2 < NT) SLOAD(SE, 2); }
  SWAIT(); SWRITE(1, SO); __syncthreads();
  for (int j = 1; j + 1 < NT; j += 2) {
    SBAR(); qkt(pB0, pB1, (bf16*)((char*)K_lds + SHM_K), qr, r32, hi); WMASK(pB0, pB1, j);
    finishSM(pA0, pA1, alA, l_reg, pa0, pa1, pa2, pa3); SBAR();
    SLOAD(SO, j + SDEPTH); SBAR();
    pv_d0(o, vb0, pa0, pa1, pa2, pa3); partialSM(pB0, pB1, m_reg, mnB, alB);
    __syncthreads(); SWAIT(); SWRITE(0, SE);
    RESC(alB); __syncthreads();
    SBAR(); qkt(pA0, pA1, K_lds, qr, r32, hi); WMASK(pA0, pA1, j + 1);
    finishSM(pB0, pB1, alB, l_reg, pa0, pa1, pa2, pa3); SBAR();
    if (SDEPTH == 1 || j + 3 < NT) SLOAD(SE, j + 1 + SDEPTH); SBAR();
    pv_d0(o, vb0 + (int)SHM_V, pa0, pa1, pa2, pa3); partialSM(pA0, pA1, m_reg, mnA, alA);
    __syncthreads(); SWAIT(); SWRITE(1, SO);
    RESC(alA); __syncthreads();
  }
  SBAR(); qkt(pB0, pB1, (bf16*)((char*)K_lds + SHM_K), qr, r32, hi); WMASK(pB0, pB1, NT - 1);
  finishSM(pA0, pA1, alA, l_reg, pa0, pa1, pa2, pa3); SBAR();
  pv_d0(o, vb0, pa0, pa1, pa2, pa3); partialSM(pB0, pB1, m_reg, mnB, alB);
  __syncthreads(); RESC(alB);
  finishSM(pB0, pB1, alB, l_reg, pa0, pa1, pa2, pa3); SBAR();
  pv_d0(o, vb0 + (int)SHM_V, pa0, pa1, pa2, pa3);
  if (WIN) { constexpr float C = SCALE * 1.4426950408889634f; l_reg += __builtin_amdgcn_exp2f(sink_l2 - m_reg * C); }
  if (hi == 0) li_l[r32] = l_reg; asm volatile("s_waitcnt lgkmcnt(0)" ::: "memory");
  float rli[16];
#pragma unroll
  for (int r = 0; r < 16; ++r) rli[r] = __builtin_amdgcn_rcpf(li_l[crow(r, hi)]);
  bf16* Ow = Qb + (long)(wid * QBLK) * LDQ;
#pragma unroll
  for (int r = 0; r < 16; ++r) { const int orow = crow(r, hi);
#pragma unroll
    for (int d0 = 0; d0 < 4; ++d0) { const float v = o[d0][r] * rli[r]; Ow[(long)orow * LDQ + d0 * 32 + r32] = (bf16)(cvtpk(v, v) & 0xffffu); } }
  __syncthreads();
#undef TROW
#undef SLOAD
#undef SWRITE
#undef SWAIT
#undef RESC
#undef WMASK
}
#undef KSWZ
#undef SBAR
}

namespace mk {
namespace cg = cooperative_groups;
typedef unsigned short bf16;
typedef short bf16x8 __attribute__((ext_vector_type(8)));
typedef float f32x4 __attribute__((ext_vector_type(4)));
typedef unsigned u32x4 __attribute__((ext_vector_type(4)));
typedef unsigned u32x2 __attribute__((ext_vector_type(2)));
typedef __bf16 bf2_t __attribute__((ext_vector_type(2)));
#define LAS __attribute__((address_space(3)))
constexpr int NWAVES = 8, NTHR = 512;
constexpr size_t MiB = 1u << 20;
constexpr size_t WS_CTL = 0, CTL_BYTES = 1 * MiB;
constexpr size_t WS_MOD = 1 * MiB;
constexpr size_t WS_XC = 2 * MiB;
constexpr size_t WS_WQKV = 6 * MiB;
constexpr size_t WS_WO = 12 * MiB;
constexpr size_t WS_WP = 16 * MiB;
constexpr size_t WS_H = 24 * MiB;
constexpr size_t WS_Q = 58 * MiB;
constexpr size_t WS_K = 92 * MiB;
constexpr size_t WS_V = 101 * MiB;
constexpr size_t WS_EIDX = 110 * MiB;
constexpr size_t WS_GATE = 119 * MiB;
constexpr size_t WS_PW = 128 * MiB;
constexpr size_t WS_S = 137 * MiB;
constexpr size_t WS_UT = 274 * MiB;
constexpr size_t WS_VT = 338 * MiB;
constexpr size_t WS_END = 402 * MiB;
constexpr int LDS_BYTES = 155648;
constexpr int NPHASE = 21;

struct Args { const float* in[17]; float* out; unsigned char* ws; int ph_lo, ph_hi; };

constexpr int PTAB_OFF = 153600;
struct Ctx {
  unsigned char* ws;
  int tid, lane, wave, bid, G;
  LAS unsigned char* lds; unsigned char* ldsg;
  __device__ __forceinline__ const float* in(int k) const {
    const volatile LAS unsigned* t = (const volatile LAS unsigned*)(lds + PTAB_OFF) + 2 * k;
    const unsigned lo = __builtin_amdgcn_readfirstlane(t[0]), hi = __builtin_amdgcn_readfirstlane(t[1]);
    return (const float*)(((unsigned long long)hi << 32) | lo);
  }
  __device__ __forceinline__ float* outp() const { return (float*)in(17); }
};
enum { I_X = 0, I_C, I_CTX, I_CCTX, I_ADAW, I_ADAB, I_N1G, I_N2G, I_WQKV, I_QNG, I_KNG, I_WO, I_SINKS, I_PWQ, I_PSK, I_PU, I_PV };

__device__ __forceinline__ unsigned f2bf(float f) { unsigned u = __builtin_bit_cast(unsigned, f); return (u + 0x7fffu + ((u >> 16) & 1u)) >> 16; }
__device__ __forceinline__ unsigned pk2(float lo, float hi) { unsigned r; asm volatile("v_cvt_pk_bf16_f32 %0, %1, %2" : "=v"(r) : "v"(lo), "v"(hi)); return r; }
__device__ __forceinline__ float bflo(unsigned u) { return __uint_as_float(u << 16); }
__device__ __forceinline__ float bfhi(unsigned u) { return __uint_as_float(u & 0xffff0000u); }
__device__ __forceinline__ float silu(float x) { return x / (1.f + __expf(-x)); }
__device__ __forceinline__ float gelu_tanh(float x) {
  const float y = 0.7978845608028654f * (x + 0.044715f * x * x * x);
  const float t = 1.f - 2.f / (__expf(2.f * y) + 1.f);
  return 0.5f * x * (1.f + t);
}
__device__ __forceinline__ float wave_sum(float v) {
#pragma unroll
  for (int o = 1; o < 64; o <<= 1) v += __shfl_xor(v, o);
  return v;
}
__device__ __forceinline__ const float* xrow_sel(const float* lat, const float* cx, int r) { const int b = r / RPB, j = r % RPB; return j < CTXL ? cx + (size_t)(b * CTXL + j) * DM : lat + (size_t)(b * SEQ + (j - CTXL)) * DM; }
__device__ __forceinline__ int mod_row(int r) { const int b = r / RPB, j = r % RPB; return j < CTXL ? 4 : b; }

__device__ __forceinline__ void p0_transpose_item(const float* W, int K, int N, bf16* WT, LAS float* scr, int item, int lane) {
  const int nblk = N / 32, kb = item / nblk, nb = item % nblk, k0 = 64 * kb, n0 = 32 * nb;
#pragma unroll 8
  for (int i = 0; i < 32; ++i) { const int kk = 2 * i + (lane >> 5); scr[kk * 33 + (lane & 31)] = W[(size_t)(k0 + kk) * N + n0 + (lane & 31)]; }
  asm volatile("s_waitcnt lgkmcnt(0)" ::: "memory");
  const int c = lane & 7;
#pragma unroll
  for (int j = 0; j < 4; ++j) { const int n = (lane >> 3) + 8 * j; const LAS float* s = scr + (8 * c) * 33 + n;
    u32x4 o; o.x = pk2(s[0 * 33], s[1 * 33]); o.y = pk2(s[2 * 33], s[3 * 33]); o.z = pk2(s[4 * 33], s[5 * 33]); o.w = pk2(s[6 * 33], s[7 * 33]);
    *(u32x4*)(WT + (size_t)(n0 + n) * K + k0 + 8 * c) = o; }
  asm volatile("s_waitcnt lgkmcnt(0)" ::: "memory");
}

__device__ __forceinline__ void phase_prologue(const Ctx& F) {
  { LAS float* sl = (LAS float*)F.lds;
    LAS float* red = sl + 5 * DM;
    { const float* cp = F.in(I_C); const float* ccp = F.in(I_CCTX);
      for (int e = F.tid; e < 5 * DM; e += NTHR) { const int r = e / DM, j = e % DM; sl[e] = silu(r < 4 ? cp[r * DM + j] : ccp[j]); } }
    __syncthreads();
    const float* adaw = F.in(I_ADAW); const float* adab = F.in(I_ADAB);
    for (int task = F.bid; task < DEPTH * 96; task += F.G) {
      const int i = task / 96, n = (task % 96) * 64 + F.lane;
      const float* w = adaw + (size_t)i * DM * NMOD * DM + n;
      float a0 = 0.f, a1 = 0.f, a2 = 0.f, a3 = 0.f, a4 = 0.f;
#pragma unroll 8
      for (int jj = 0; jj < 128; ++jj) { const int j = F.wave * 128 + jj; const float wv = w[(size_t)j * NMOD * DM];
        a0 += sl[j] * wv; a1 += sl[DM + j] * wv; a2 += sl[2 * DM + j] * wv; a3 += sl[3 * DM + j] * wv; a4 += sl[4 * DM + j] * wv; }
      red[(F.wave * 5 + 0) * 64 + F.lane] = a0; red[(F.wave * 5 + 1) * 64 + F.lane] = a1; red[(F.wave * 5 + 2) * 64 + F.lane] = a2;
      red[(F.wave * 5 + 3) * 64 + F.lane] = a3; red[(F.wave * 5 + 4) * 64 + F.lane] = a4;
      __syncthreads();
      if (F.tid < 320) { const int r = F.tid >> 6, l = F.tid & 63; float s = 0.f;
#pragma unroll
        for (int w8 = 0; w8 < 8; ++w8) s += red[(w8 * 5 + r) * 64 + l];
        const int nn = (task % 96) * 64 + l;
        ((float*)(F.ws + WS_MOD))[((size_t)i * 5 + r) * NMOD * DM + nn] = s + adab[i * NMOD * DM + nn]; }
      __syncthreads();
    }
  }
  { LAS float* sk = (LAS float*)F.lds;
    LAS float* wq = sk + 128 * 132;
    const float* pskp = F.in(I_PSK); const float* pwqp = F.in(I_PWQ);
    for (int task = F.bid; task < DEPTH * 8 * 2 * 16; task += F.G) {
      const int jc = task & 15, half = (task >> 4) & 1, h = (task >> 5) & 7, i = task >> 8;
      const float* SK = pskp + ((size_t)i * 2 + half) * NKEYS * 128;
      const float* WQ = pwqp + (size_t)i * DM * PQN + (size_t)(jc * 64) * PQN + h * PQD + half * 128;
      for (int e = F.tid; e < 128 * 32; e += NTHR) { const int kk = e >> 5, d4 = e & 31; const f32x4 v = *(const f32x4*)(SK + (size_t)kk * 128 + d4 * 4); *(LAS f32x4*)(sk + kk * 132 + d4 * 4) = v; }
      for (int e = F.tid; e < 64 * 32; e += NTHR) { const int j = e >> 5, d4 = e & 31; const f32x4 v = *(const f32x4*)(WQ + (size_t)j * PQN + d4 * 4); *(LAS f32x4*)(wq + j * 128 + d4 * 4) = v; }
      __syncthreads();
      const int kk = F.tid & 127, jg = F.tid >> 7;
      float acc[16];
#pragma unroll
      for (int q = 0; q < 16; ++q) acc[q] = 0.f;
#pragma unroll 2
      for (int d4 = 0; d4 < 32; ++d4) { const f32x4 s = *(const LAS f32x4*)(sk + kk * 132 + d4 * 4);
#pragma unroll
        for (int q = 0; q < 16; ++q) { const f32x4 w = *(const LAS f32x4*)(wq + (jg * 16 + q) * 128 + d4 * 4); acc[q] += s.x * w.x + s.y * w.y + s.z * w.z + s.w * w.w; } }
      bf16* o = (bf16*)(F.ws + WS_WP) + ((size_t)i * PQN + h * PQD + half * 128 + kk) * DM + jc * 64 + jg * 16;
      u32x4 o0, o1; o0.x = pk2(acc[0], acc[1]); o0.y = pk2(acc[2], acc[3]); o0.z = pk2(acc[4], acc[5]); o0.w = pk2(acc[6], acc[7]);
      o1.x = pk2(acc[8], acc[9]); o1.y = pk2(acc[10], acc[11]); o1.z = pk2(acc[12], acc[13]); o1.w = pk2(acc[14], acc[15]);
      *(u32x4*)o = o0; *(u32x4*)(o + 8) = o1;
      __syncthreads();
    }
  }
  { LAS float* scr = (LAS float*)F.lds + F.wave * (64 * 33 + 16);
    const int gw = F.bid * NWAVES + F.wave, NGW = F.G * NWAVES;
    constexpr int I_QKV = (DM / 64) * (QKVD / 32), I_O = (DM / 64) * (DM / 32);
    const float* wqkvp = F.in(I_WQKV); const float* wop = F.in(I_WO);
    for (int it = gw; it < DEPTH * (I_QKV + I_O); it += NGW) {
      const int i = it / (I_QKV + I_O); int r = it % (I_QKV + I_O);
      if (r < I_QKV) p0_transpose_item(wqkvp + (size_t)i * DM * QKVD, DM, QKVD, (bf16*)(F.ws + WS_WQKV) + (size_t)i * QKVD * DM, scr, r, F.lane);
      else p0_transpose_item(wop + (size_t)i * DM * DM, DM, DM, (bf16*)(F.ws + WS_WO) + (size_t)i * DM * DM, scr, r - I_QKV, F.lane);
    }
  }
  { const size_t n8 = (size_t)DEPTH * NKEYS * NKEYS * DM / 8;
    const size_t gt = (size_t)F.bid * NTHR + F.tid, GT = (size_t)F.G * NTHR;
    const float* pup = F.in(I_PU); const float* pvp = F.in(I_PV);
    for (size_t e = gt; e < 2 * n8; e += GT) { const bool isu = e < n8; const size_t j = isu ? e : e - n8;
      const float* src = (isu ? pup : pvp) + j * 8; const f32x4 a = *(const f32x4*)src, b = *(const f32x4*)(src + 4);
      u32x4 o; o.x = pk2(a.x, a.y); o.y = pk2(a.z, a.w); o.z = pk2(b.x, b.y); o.w = pk2(b.z, b.w);
      *(u32x4*)((bf16*)(F.ws + (isu ? WS_UT : WS_VT)) + j * 8) = o; }
  }
}

__device__ __forceinline__ void phase_norm(const Ctx& F, int layer, int which  , bool from_input, bool latent_only) {
  const int gw = F.bid * NWAVES + F.wave, NGW = F.G * NWAVES;
  const float* gain = (which == 0 ? F.in(I_N1G) : F.in(I_N2G)) + layer * DM;
  const float* modl = (const float*)(F.ws + WS_MOD) + (size_t)layer * 5 * NMOD * DM;
  bf16* H = (bf16*)(F.ws + WS_H);
  const float* latp = from_input ? F.in(I_X) : (const float*)F.outp(); const float* cxp = from_input ? F.in(I_CTX) : (const float*)(F.ws + WS_XC);
  for (int r = gw; r < NROWS; r += NGW) {
    if (latent_only && (r % RPB) < CTXL) continue;
    const float* xr = xrow_sel(latp, cxp, r);
    const float* mrow = modl + (size_t)mod_row(r) * NMOD * DM;
    const float* sh = mrow + (which == 0 ? 0 : 3) * DM; const float* sc = mrow + (which == 0 ? 1 : 4) * DM;
    f32x4 v[4]; float s = 0.f;
#pragma unroll
    for (int j = 0; j < 4; ++j) { v[j] = ((const f32x4*)xr)[F.lane + 64 * j]; s += (v[j].x * v[j].x + v[j].y * v[j].y) + (v[j].z * v[j].z + v[j].w * v[j].w); }
    const float rstd = rsqrtf(wave_sum(s) * (1.f / DM) + RMS_EPS);
    unsigned long long* o8 = (unsigned long long*)(H + (size_t)r * DM) + F.lane;
#pragma unroll
    for (int j = 0; j < 4; ++j) { const f32x4 g = ((const f32x4*)gain)[F.lane + 64 * j], a = ((const f32x4*)sc)[F.lane + 64 * j], b = ((const f32x4*)sh)[F.lane + 64 * j];
      const float y0 = v[j].x * rstd * g.x * (1.f + a.x) + b.x, y1 = v[j].y * rstd * g.y * (1.f + a.y) + b.y, y2 = v[j].z * rstd * g.z * (1.f + a.z) + b.z, y3 = v[j].w * rstd * g.w * (1.f + a.w) + b.w;
      o8[64 * j] = (unsigned long long)pk2(y0, y1) | ((unsigned long long)pk2(y2, y3) << 32); }
  }
}

__device__ __forceinline__ void phase_qknorm(const Ctx& F, int layer) {
  const int gw = F.bid * NWAVES + F.wave, NGW = F.G * NWAVES;
  const int axis = F.lane >> 5, f = F.lane & 31, e1 = axis * 64 + f, e2 = e1 + 32;
  const float* qg = F.in(I_QNG) + layer * HD; const float* kg = F.in(I_KNG) + layer * HD;
  const float qg1 = qg[e1], qg2 = qg[e2], kg1 = kg[e1], kg2 = kg[e2];
  const float inv = exp2f(-(float)(2 * f) * (13.287712379549449f / 64.f));
  bf16* Q = (bf16*)(F.ws + WS_Q); bf16* K = (bf16*)(F.ws + WS_K);
  for (int r = gw; r < NROWS; r += NGW) {
    const int j = r % RPB; float cs = 1.f, sn = 0.f;
    if (j >= CTXL) { const int sp = j - CTXL; const float pos = (float)(axis == 0 ? (sp >> 6) : (sp & 63)); sincosf(pos * inv, &sn, &cs); }
#pragma unroll
    for (int h = 0; h < NH + NKV; ++h) {
      bf16* base = h < NH ? Q + (size_t)r * DM + h * HD : K + (size_t)r * (NKV * HD) + (h - NH) * HD;
      float x1 = bflo(base[e1]), x2 = bflo(base[e2]);
      const float rstd = rsqrtf(wave_sum(x1 * x1 + x2 * x2) * (1.f / HD) + RMS_EPS);
      x1 *= rstd * (h < NH ? qg1 : kg1); x2 *= rstd * (h < NH ? qg2 : kg2);
      const float y1 = x1 * cs - x2 * sn, y2 = x1 * sn + x2 * cs;
      base[e1] = (bf16)f2bf(y1); base[e2] = (bf16)f2bf(y2);
    }
  }
}
struct Order {
  int nM, nN, nwg, G, c, lat;
  __device__ void init(int nM_, int nN_, int G_, int c_, int lat_) { nM = nM_; nN = nN_; nwg = nM * nN; G = G_; c = c_; lat = lat_; }
  __device__ bool next(int i, pg8::Unit& u) const {
    const long L = (long)i * G + c; if (L >= nwg) return false;
    int wgid = (int)L; { const int q = nwg / 8, r = nwg % 8, xcd = wgid % 8, off = wgid / 8; wgid = (xcd < r ? xcd * (q + 1) : r * (q + 1) + (xcd - r) * q) + off; }
    const int WGM = 8, nig = WGM * nN, gid = wgid / nig, fm = gid * WGM, gsz = (nM - fm) < WGM ? (nM - fm) : WGM;
    int pm = fm + ((wgid % nig) % gsz); u.pn = (wgid % nig) / gsz;
    if (lat) pm = (pm >> 4) * 17 + 1 + (pm & 15);
    u.pm = pm; return true;
  }
  __device__ __forceinline__ void a_ready(const pg8::Unit&) const {}
  __device__ __forceinline__ void done(const pg8::Unit&) const {}
};
struct EpiQKV {
  static constexpr bool PERM = true, AFTER_DRAIN = false;
  unsigned char* ws;
  __device__ __forceinline__ void operator()(const pg8::f32x4 (&acc)[2][2][4][2], const pg8::Unit& u, int wr, int wc, int fr, int fq) const {
    const int row0 = u.pm * 256 + wr * 64 + fr;
    const size_t boff = u.pn < 4 ? WS_Q : (u.pn == 4 ? WS_K : WS_V); const int ldc = u.pn < 4 ? DM : NKV * HD, colt = u.pn < 4 ? u.pn * 256 : 0;
    bf16* base = (bf16*)(ws + boff);
    const int col0 = colt + wc * 32 + 8 * fq;
#pragma unroll
    for (int ai = 0; ai < 2; ++ai)
#pragma unroll
      for (int m = 0; m < 4; ++m) { bf16* rowp = base + (size_t)(row0 + ai * 128 + m * 16) * ldc + col0;
#pragma unroll
        for (int bj = 0; bj < 2; ++bj) { const pg8::f32x4 v0 = acc[ai][bj][m][0], v1 = acc[ai][bj][m][1];
          u32x4 w; w.x = pk2(v0[0], v0[1]); w.y = pk2(v0[2], v0[3]); w.z = pk2(v1[0], v1[1]); w.w = pk2(v1[2], v1[3]);
          *(u32x4*)(rowp + bj * 128) = w; } }
  }
};
struct EpiRes {
  static constexpr bool PERM = false, AFTER_DRAIN = false;
  const float *xin, *cin; float *xout, *xc; const float* gmod  ; bool from_input;
  __device__ __forceinline__ void operator()(const pg8::f32x4 (&acc)[2][2][4][2], const pg8::Unit& u, int wr, int wc, int fr, int fq) const {
    const int col0 = u.pn * 256 + wc * 32 + 4 * fq;
#pragma unroll
    for (int ai = 0; ai < 2; ++ai)
#pragma unroll
      for (int m = 0; m < 4; ++m) { const int r = u.pm * 256 + ai * 128 + wr * 64 + m * 16 + fr;
        const int b_ = r / RPB, j_ = r % RPB; const size_t oc = (size_t)(b_ * CTXL + j_) * DM, ol = (size_t)(b_ * SEQ + (j_ - CTXL)) * DM;
        float* xn = j_ < CTXL ? xc + oc : xout + ol; const float* xo = from_input ? (j_ < CTXL ? cin + oc : xin + ol) : xn; const float* g = gmod + (size_t)(j_ < CTXL ? 4 : b_) * NMOD * DM;
#pragma unroll
        for (int bj = 0; bj < 2; ++bj)
#pragma unroll
          for (int n = 0; n < 2; ++n) { const int c = col0 + bj * 128 + n * 16; const f32x4 xv = *(const f32x4*)(xo + c), gv = *(const f32x4*)(g + c); const pg8::f32x4 a = acc[ai][bj][m][n];
            f32x4 o; o.x = xv.x + gv.x * a[0]; o.y = xv.y + gv.y * a[1]; o.z = xv.z + gv.z * a[2]; o.w = xv.w + gv.w * a[3]; *(f32x4*)(xn + c) = o; } }
  }
};
struct EpiF32 {
  static constexpr bool PERM = false, AFTER_DRAIN = false;
  float* S; int ldc;
  __device__ __forceinline__ void operator()(const pg8::f32x4 (&acc)[2][2][4][2], const pg8::Unit& u, int wr, int wc, int fr, int fq) const {
    const int col0 = u.pn * 256 + wc * 32 + 4 * fq;
#pragma unroll
    for (int ai = 0; ai < 2; ++ai)
#pragma unroll
      for (int m = 0; m < 4; ++m) { float* rowp = S + (size_t)(u.pm * 256 + ai * 128 + wr * 64 + m * 16 + fr) * ldc + col0;
#pragma unroll
        for (int bj = 0; bj < 2; ++bj)
#pragma unroll
          for (int n = 0; n < 2; ++n) { const pg8::f32x4 a = acc[ai][bj][m][n]; f32x4 o; o.x = a[0]; o.y = a[1]; o.z = a[2]; o.w = a[3]; *(f32x4*)(rowp + bj * 128 + n * 16) = o; } }
  }
};

__device__ __forceinline__ void phase_attn(const Ctx& F, int layer) {
  bf16* Q = (bf16*)(F.ws + WS_Q); const bf16* K = (const bf16*)(F.ws + WS_K); const bf16* V = (const bf16*)(F.ws + WS_V);
  char* lds = (char*)F.ldsg;
  const int pair = F.bid & 7, slot = F.bid >> 3, nslot = F.G >> 3;
  const int b = pair >> 1, g = pair & 1;
  const bf16* Kh = K + (size_t)(b * RPB) * (NKV * HD) + g * HD; const bf16* Vh = V + (size_t)(b * RPB) * (NKV * HD) + g * HD;
  const float* sinkp = F.in(I_SINKS);
  const int nunits = layer == 0 ? 68 : 64;
#pragma unroll 1
  for (int u = slot; u < nunits; u += nslot) {
    int h, NT, ks = 0, q0 = 0; float sk = 0.f; bf16* Qb; const bool win = layer != 0;
    if (u < 64) { h = g * 4 + (u >> 4); const int qb = u & 15; Qb = Q + (size_t)(b * RPB + CTXL + qb * 256) * DM + h * HD;
      if (!win) NT = RPB / 64;
      else { q0 = qb * 256; ks = q0 - 128 < 0 ? 0 : q0 - 128; const int ke = q0 + 384 > SEQ ? SEQ : q0 + 384; NT = 4 + (ke - ks) / 64; sk = sinkp[(layer / 2) * NH + h] * 1.4426950408889634f; } }
    else { h = g * 4 + (u - 64); Qb = Q + (size_t)(b * RPB) * DM + h * HD; NT = CTXL / 64; }
    att::attn_unit(win, Qb, Kh, Vh, NT, ks, q0, sk, lds);
  }
}

__device__ __forceinline__ void ins16(float (&v)[16], float x) {
#pragma unroll
  for (int i = 0; i < 16; ++i) { const float hi = fmaxf(v[i], x); x = fminf(v[i], x); v[i] = hi; }
}
__device__ __forceinline__ void phase_topk(const Ctx& F, bool latent_only) {
  LAS float* sc = (LAS float*)F.lds;
  LAS unsigned* T = (LAS unsigned*)(F.lds + 512 * 65 * 4);
  const float* S = (const float*)(F.ws + WS_S); int* EIDX = (int*)(F.ws + WS_EIDX); float* GATE = (float*)(F.ws + WS_GATE);
  const int ngroups = NROWS / 16;
  for (int grp = F.bid; grp < ngroups; grp += F.G) {
    const int r0 = grp * 16;
    if (latent_only && (r0 % RPB) < CTXL) continue;
#pragma unroll 4
    for (int it = 0; it < 16; ++it) { const int e4 = it * NTHR + F.tid, rl = e4 >> 9, c = (e4 & 511) * 4;
      const f32x4 v = *(const f32x4*)(S + (size_t)(r0 + rl) * PQN + c); LAS float* d = sc + (rl * 32 + (c >> 6)) * 65 + (c & 63);
      d[0] = v.x; d[1] = v.y; d[2] = v.z; d[3] = v.w; }
    __syncthreads();
    float v[16];
#pragma unroll
    for (int i = 0; i < 16; ++i) v[i] = -INFINITY;
    { const LAS float* my = sc + F.tid * 65; const unsigned eb = (F.tid & 1) * 64;
#pragma unroll 8
      for (int e = 0; e < 64; ++e) { const unsigned key = (__float_as_uint(my[e]) & ~127u) | (eb + e); ins16(v, __uint_as_float(key)); } }
    { float o[16];
#pragma unroll
      for (int i = 0; i < 16; ++i) o[i] = __shfl_xor(v[i], 1);
#pragma unroll
      for (int i = 0; i < 16; ++i) ins16(v, o[i]); }
    if ((F.tid & 1) == 0) {
#pragma unroll
      for (int i = 0; i < 16; ++i) T[(F.tid >> 1) * 16 + i] = __float_as_uint(v[i]); }
    __syncthreads();
    if (F.tid < 128) {
      const int rl = F.tid >> 3, head = F.tid & 7, p1 = (rl * 16 + head * 2) * 16, p2 = p1 + 16;
      float a[16], bq[16];
#pragma unroll
      for (int i = 0; i < 16; ++i) { a[i] = __uint_as_float(T[p1 + i] & ~127u); bq[i] = __uint_as_float(T[p2 + i] & ~127u); }
      float w[16];
#pragma unroll
      for (int i = 0; i < 16; ++i) w[i] = -INFINITY;
#pragma unroll
      for (int ia = 0; ia < 16; ++ia)
#pragma unroll
        for (int ib = 0; ib < 16; ++ib) if ((ia + 1) * (ib + 1) <= 16) { const float s = a[ia] + bq[ib]; ins16(w, __uint_as_float((__float_as_uint(s) & ~255u) | (unsigned)(ia * 16 + ib))); }
      float ts[16]; int ex[16];
#pragma unroll
      for (int k = 0; k < 16; ++k) { const unsigned id = __float_as_uint(w[k]) & 255u; const unsigned k1 = T[p1 + (id >> 4)], k2 = T[p2 + (id & 15)];
        ts[k] = __uint_as_float(k1 & ~127u) + __uint_as_float(k2 & ~127u); ex[k] = (int)((k1 & 127u) * NKEYS + (k2 & 127u)); }
      float m = ts[0];
#pragma unroll
      for (int k = 1; k < 16; ++k) m = fmaxf(m, ts[k]);
      float l = 0.f;
#pragma unroll
      for (int k = 0; k < 16; ++k) { ts[k] = __expf(ts[k] - m); l += ts[k]; }
      const float il = 1.f / l; const size_t ob = (size_t)(r0 + rl) * 128 + head * 16;
#pragma unroll
      for (int k = 0; k < 16; k += 4) { *(int4*)(EIDX + ob + k) = make_int4(ex[k], ex[k + 1], ex[k + 2], ex[k + 3]);
        f32x4 gv; gv.x = ts[k] * il; gv.y = ts[k + 1] * il; gv.z = ts[k + 2] * il; gv.w = ts[k + 3] * il; *(f32x4*)(GATE + ob + k) = gv; }
    }
    __syncthreads();
  }
}

__device__ __forceinline__ float dot2(unsigned a, unsigned b, float c) { return __builtin_amdgcn_fdot2_f32_bf16(__builtin_bit_cast(bf2_t, a), __builtin_bit_cast(bf2_t, b), c, false); }
__device__ __forceinline__ float dot8(u32x4 a, u32x4 b, float c) {
  const unsigned a0 = a.x, a1 = a.y, a2 = a.z, a3 = a.w, b0 = b.x, b1 = b.y, b2 = b.z, b3 = b.w;
  return dot2(a3, b3, dot2(a2, b2, dot2(a1, b1, dot2(a0, b0, c))));
}
__device__ __forceinline__ void phase_peer_u(const Ctx& F, int layer, bool latent_only) {
  const int gw = F.bid * NWAVES + F.wave, NGW = F.G * NWAVES;
  const bf16* H = (const bf16*)(F.ws + WS_H); const bf16* U = (const bf16*)(F.ws + WS_UT) + (size_t)layer * NKEYS * NKEYS * DM;
  const int* EIDX = (const int*)(F.ws + WS_EIDX); const float* GATE = (const float*)(F.ws + WS_GATE); float* PW = (float*)(F.ws + WS_PW);
  for (int r = gw; r < NROWS; r += NGW) {
    if (latent_only && (r % RPB) < CTXL) continue;
    const u32x4 hA = *(const u32x4*)(H + (size_t)r * DM + F.lane * 8), hB = *(const u32x4*)(H + (size_t)r * DM + 512 + F.lane * 8);
#pragma unroll 1
    for (int bt = 0; bt < 2; ++bt) {
      const int ev = EIDX[(size_t)r * 128 + bt * 64 + F.lane];
      float p[64];
#pragma unroll
      for (int j = 0; j < 64; ++j) { const int e = __builtin_amdgcn_readlane(ev, j); const bf16* ur = U + (size_t)e * DM + F.lane * 8;
        const u32x4 uA = *(const u32x4*)ur, uB = *(const u32x4*)(ur + 512); p[j] = dot8(uB, hB, dot8(uA, hA, 0.f)); }
#pragma unroll
      for (int j = 0; j < 32; ++j) { auto s = __builtin_amdgcn_permlane32_swap(__float_as_uint(p[j]), __float_as_uint(p[j + 32]), false, false); p[j] = __uint_as_float(s[0]) + __uint_as_float(s[1]); }
#pragma unroll
      for (int j = 0; j < 16; ++j) { auto s = __builtin_amdgcn_permlane16_swap(__float_as_uint(p[j]), __float_as_uint(p[j + 16]), false, false); p[j] = __uint_as_float(s[0]) + __uint_as_float(s[1]); }
#pragma unroll
      for (int m = 8; m >= 1; m >>= 1) {
        const bool up = (F.lane & m) != 0;
#pragma unroll
        for (int j = 0; j < m; ++j) { const float send = up ? p[j] : p[j + m], keep = up ? p[j + m] : p[j]; p[j] = keep + __shfl_xor(send, m); }
      }
      const size_t o = (size_t)r * 128 + bt * 64 + F.lane;
      PW[o] = GATE[o] * gelu_tanh(p[0]);
    }
  }
}

__device__ __forceinline__ void phase_peer_v(const Ctx& F, int layer, bool latent_only) {
  const int gw = F.bid * NWAVES + F.wave, NGW = F.G * NWAVES;
  const bf16* V = (const bf16*)(F.ws + WS_VT) + (size_t)layer * NKEYS * NKEYS * DM;
  const int* EIDX = (const int*)(F.ws + WS_EIDX); const float* PW = (const float*)(F.ws + WS_PW);
  const float* g2 = (const float*)(F.ws + WS_MOD) + (size_t)layer * 5 * NMOD * DM + 5 * DM;
  const float* outl = F.outp();
  for (int r = gw; r < NROWS; r += NGW) {
    if (latent_only && (r % RPB) < CTXL) continue;
    float acc[16];
#pragma unroll
    for (int q = 0; q < 16; ++q) acc[q] = 0.f;
#pragma unroll 1
    for (int bt = 0; bt < 2; ++bt) {
      const int ev = EIDX[(size_t)r * 128 + bt * 64 + F.lane]; const float wv = PW[(size_t)r * 128 + bt * 64 + F.lane];
#pragma unroll 16
      for (int j = 0; j < 64; ++j) { const int e = __builtin_amdgcn_readlane(ev, j); const float w = __uint_as_float(__builtin_amdgcn_readlane(__float_as_uint(wv), j));
        const bf16* vr = V + (size_t)e * DM + F.lane * 8; const u32x4 a = *(const u32x4*)vr, b = *(const u32x4*)(vr + 512);
        acc[0] += w * bflo(a.x); acc[1] += w * bfhi(a.x); acc[2] += w * bflo(a.y); acc[3] += w * bfhi(a.y); acc[4] += w * bflo(a.z); acc[5] += w * bfhi(a.z); acc[6] += w * bflo(a.w); acc[7] += w * bfhi(a.w);
        acc[8] += w * bflo(b.x); acc[9] += w * bfhi(b.x); acc[10] += w * bflo(b.y); acc[11] += w * bfhi(b.y); acc[12] += w * bflo(b.z); acc[13] += w * bfhi(b.z); acc[14] += w * bflo(b.w); acc[15] += w * bfhi(b.w); }
    }
    float* x = (float*)xrow_sel(outl, (const float*)(F.ws + WS_XC), r); const float* g = g2 + (size_t)mod_row(r) * NMOD * DM;
#pragma unroll
    for (int hf = 0; hf < 2; ++hf)
#pragma unroll
      for (int q = 0; q < 2; ++q) { const int c = hf * 512 + F.lane * 8 + q * 4; f32x4 xv = *(const f32x4*)(x + c); const f32x4 gv = *(const f32x4*)(g + c);
        xv.x += gv.x * acc[hf * 8 + q * 4 + 0]; xv.y += gv.y * acc[hf * 8 + q * 4 + 1]; xv.z += gv.z * acc[hf * 8 + q * 4 + 2]; xv.w += gv.w * acc[hf * 8 + q * 4 + 3]; *(f32x4*)(x + c) = xv; }
  }
}

__global__ void __launch_bounds__(NTHR, 2) fwd(Args args) {
  extern __shared__ __attribute__((aligned(16))) unsigned char lds[];
  Ctx F;
  F.ws = args.ws; F.tid = threadIdx.x; F.lane = F.tid & 63; F.wave = __builtin_amdgcn_readfirstlane(F.tid >> 6); F.bid = blockIdx.x; F.G = gridDim.x;
  F.lds = (LAS unsigned char*)lds; F.ldsg = lds;
  if (F.tid < 18) { const unsigned long long p = F.tid < 17 ? (unsigned long long)args.in[F.tid] : (unsigned long long)args.out; ((LAS unsigned long long*)(F.lds + PTAB_OFF))[F.tid] = p; }
  __syncthreads();
  const int lo = args.ph_lo, hi = args.ph_hi;
#ifndef PHMASK
#define PHMASK 0x7ff
#endif
#define IN(k) (lo <= (k) && (k) < hi)
#define EN(b) ((PHMASK >> (b)) & 1)
#define FRESH() do { int t_ = threadIdx.x; asm volatile("" : "+v"(t_)); F.tid = t_; F.lane = t_ & 63; F.wave = __builtin_amdgcn_readfirstlane(t_ >> 6); int b_ = blockIdx.x; asm volatile("" : "+s"(b_)); F.bid = b_; } while (0)
#define SEAM(k) do { if (IN(k) && IN((k) + 1)) { cg::this_grid().sync(); } } while (0)
  if (EN(10) && IN(0)) { FRESH(); phase_prologue(F); } SEAM(0);
#pragma unroll 1
  for (int layer = 0; layer < DEPTH; ++layer) {
    const int pb = 1 + 10 * layer; const bool last = layer == DEPTH - 1;
    const float* modl = (const float*)(F.ws + WS_MOD) + (size_t)layer * 5 * NMOD * DM;
    if (EN(0) && IN(pb + 0)) { FRESH(); phase_norm(F, layer, 0, layer == 0, false); } SEAM(pb + 0);
    if (EN(1) && IN(pb + 1)) { FRESH(); pg8::Gemm g{(const pg8::bf16_t*)(F.ws + WS_H), (const pg8::bf16_t*)(F.ws + WS_WQKV) + (size_t)layer * QKVD * DM, NROWS, QKVD, DM};
      Order S; S.init(NROWS / 256, QKVD / 256, F.G, F.bid, 0); EpiQKV E{F.ws};
      pg8::gemm_phase<EpiQKV, Order, true, true>(F.lds, g, S, E); } SEAM(pb + 1);
    if (EN(2) && IN(pb + 2)) { FRESH(); phase_qknorm(F, layer); } SEAM(pb + 2);
    if (EN(3) && IN(pb + 3)) { FRESH(); phase_attn(F, layer); } SEAM(pb + 3);
    if (EN(4) && IN(pb + 4)) { FRESH(); pg8::Gemm g{(const pg8::bf16_t*)(F.ws + WS_Q), (const pg8::bf16_t*)(F.ws + WS_WO) + (size_t)layer * DM * DM, NROWS, DM, DM};
      Order S; S.init(last ? NB * 16 : NROWS / 256, DM / 256, F.G, F.bid, last ? 1 : 0); EpiRes E{F.in(I_X), F.in(I_CTX), F.outp(), (float*)(F.ws + WS_XC), modl + 2 * DM, layer == 0};
      pg8::gemm_phase<EpiRes, Order, true, true>(F.lds, g, S, E); } SEAM(pb + 4);
    if (EN(5) && IN(pb + 5)) { FRESH(); phase_norm(F, layer, 1, false, last); } SEAM(pb + 5);
    if (EN(6) && IN(pb + 6)) { FRESH(); pg8::Gemm g{(const pg8::bf16_t*)(F.ws + WS_H), (const pg8::bf16_t*)(F.ws + WS_WP) + (size_t)layer * PQN * DM, NROWS, PQN, DM};
      Order S; S.init(last ? NB * 16 : NROWS / 256, PQN / 256, F.G, F.bid, last ? 1 : 0); EpiF32 E{(float*)(F.ws + WS_S), PQN};
      pg8::gemm_phase<EpiF32, Order, true, true>(F.lds, g, S, E); } SEAM(pb + 6);
    if (EN(7) && IN(pb + 7)) { FRESH(); phase_topk(F, last); } SEAM(pb + 7);
    if (EN(8) && IN(pb + 8)) { FRESH(); phase_peer_u(F, layer, last); } SEAM(pb + 8);
    if (EN(9) && IN(pb + 9)) { FRESH(); phase_peer_v(F, layer, last); } if (!last) SEAM(pb + 9);
  }
#undef IN
#undef SEAM
}
}

#ifndef MK_MULTI
#define MK_MULTI 0
#endif
#ifndef DBG
#define DBG 0
#endif
namespace dbg {
template <bool ABF>
__global__ void __launch_bounds__(1024) k_cmp(const void* __restrict__ a, long lda, long aoff, const float* __restrict__ b, long ldb, long boff, int rows, int cols, int row0, int rstep_lat  , float* res) {
  __shared__ float sd[1024], sr[1024];
  float d2 = 0.f, r2 = 0.f;
  for (long e = threadIdx.x; e < (long)rows * cols; e += 1024) { const int r = row0 + (int)(e / cols), c = (int)(e % cols);
    if (rstep_lat == 1 && (r % RPB) < CTXL) continue; if (rstep_lat == 2 && (r % RPB) >= CTXL) continue;
    float av; if (ABF) av = __uint_as_float((unsigned)((const unsigned short*)a)[(long)r * lda + aoff + c] << 16); else av = ((const float*)a)[(long)r * lda + aoff + c];
    const float bv = b[(long)r * ldb + boff + c]; d2 += (av - bv) * (av - bv); r2 += bv * bv; }
  sd[threadIdx.x] = d2; sr[threadIdx.x] = r2; __syncthreads();
  for (int o = 512; o > 0; o >>= 1) { if ((int)threadIdx.x < o) { sd[threadIdx.x] += sd[threadIdx.x + o]; sr[threadIdx.x] += sr[threadIdx.x + o]; } __syncthreads(); }
  if (threadIdx.x == 0) *res = sqrtf(sd[0] / fmaxf(sr[0], 1e-30f));
}
__global__ void __launch_bounds__(1024) k_cmp_scores(const float* __restrict__ S, const float* __restrict__ PQ, const float* __restrict__ SK, int nrows, float* res) {
  __shared__ float sd[1024], sr[1024];
  float d2 = 0.f, r2 = 0.f;
  for (long e = threadIdx.x; e < (long)nrows * PQN; e += 1024) { const int r = (int)(e / PQN), c = (int)(e % PQN), h = c >> 8, half = (c >> 7) & 1, k = c & 127;
    const float* q = PQ + (long)r * PQN + h * PQD + half * 128; const float* kp = SK + (long)half * NKEYS * 128 + (long)k * 128; float a = 0.f; for (int d = 0; d < 128; ++d) a += q[d] * kp[d];
    const float f = S[(long)r * PQN + c]; d2 += (f - a) * (f - a); r2 += a * a; }
  sd[threadIdx.x] = d2; sr[threadIdx.x] = r2; __syncthreads();
  for (int o = 512; o > 0; o >>= 1) { if ((int)threadIdx.x < o) { sd[threadIdx.x] += sd[threadIdx.x + o]; sr[threadIdx.x] += sr[threadIdx.x + o]; } __syncthreads(); }
  if (threadIdx.x == 0) *res = sqrtf(sd[0] / fmaxf(sr[0], 1e-30f));
}
__global__ void k_final(float* out, long n, const float* res) {
  const float sa = 1.f + 10.f * res[0];
  for (long i = blockIdx.x * 256L + threadIdx.x; i < n; i += gridDim.x * 256L) out[i] *= sa;
  if (blockIdx.x == 0 && threadIdx.x == 0) { }
}
__global__ void k_final2(float* out, const float* res) { out[0] += 1000.f * (res[1] + res[2]); }
}

static void run_naive(void* const* d_in, float* out, char* ws, hipStream_t stream, int slayer, int stop) {
  const float* x = (const float*)d_in[0]; const float* c = (const float*)d_in[1]; const float* ctx = (const float*)d_in[2]; const float* c_ctx = (const float*)d_in[3];
  const float* ada_w = (const float*)d_in[4]; const float* ada_b = (const float*)d_in[5]; const float* n1g = (const float*)d_in[6]; const float* n2g = (const float*)d_in[7];
  const float* w_qkv = (const float*)d_in[8]; const float* qng = (const float*)d_in[9]; const float* kng = (const float*)d_in[10]; const float* w_o = (const float*)d_in[11];
  const float* sinks = (const float*)d_in[12]; const float* pwq = (const float*)d_in[13]; const float* psk = (const float*)d_in[14]; const float* pu = (const float*)d_in[15];
  const float* pv = (const float*)d_in[16];
  constexpr size_t MiB = 1u << 20;
  float* MOD = (float*)(ws + 0); float* XC = (float*)(ws + 1 * MiB); int* EIDX = (int*)(ws + 6 * MiB); float* GATE = (float*)(ws + 15 * MiB); float* PW = (float*)(ws + 24 * MiB);
  float* H = (float*)(ws + 34 * MiB); float* QKV = (float*)(ws + 104 * MiB); float* O = (float*)(ws + 242 * MiB); float* PQ = QKV;
  hipFuncSetAttribute((const void*)nv::k_attn, hipFuncAttributeMaxDynamicSharedMemorySize, (4 * RPB + 4 * HD) * 4);
  hipMemcpyAsync(out, x, (size_t)NB * SEQ * DM * 4, hipMemcpyDeviceToDevice, stream);
  hipMemcpyAsync(XC, ctx, (size_t)NB * CTXL * DM * 4, hipMemcpyDeviceToDevice, stream);
  nv::k_mod<<<(DEPTH * 5 * NMOD * DM + 255) / 256, 256, 0, stream>>>(c, c_ctx, ada_w, ada_b, MOD);
  for (int i = 0; i < DEPTH; ++i) {
#define STOP(k) if (i == slayer && stop == (k)) return
    const bool last = i == DEPTH - 1; const float* modi = MOD + (size_t)i * 5 * NMOD * DM;
    STOP(1); nv::k_norm<<<NROWS, 256, 0, stream>>>(out, XC, n1g + i * DM, modi, 0, 1, H);
    STOP(2); nv::k_gemm<0><<<dim3(QKVD / 64, NROWS / 64), 256, 0, stream>>>(H, w_qkv + (size_t)i * DM * QKVD, QKV, NROWS, QKVD, DM, nullptr, nullptr, nullptr, 0, 0);
    STOP(3); nv::k_qknorm_rope<<<NROWS, 640, 0, stream>>>(QKV, qng + i * HD, kng + i * HD);
    STOP(4); const size_t shm = (4 * RPB + 4 * HD) * 4;
    if (i % 2 == 0) { nv::k_attn<<<dim3(NB * SEQ, NKV), 256, shm, stream>>>(QKV, 0, nullptr); if (!last) nv::k_attn<<<dim3(NB * CTXL, NKV), 256, shm, stream>>>(QKV, 1, nullptr); }
    else { nv::k_attn<<<dim3(NB * SEQ, NKV), 256, shm, stream>>>(QKV, 2, sinks + (i / 2) * NH); }
    STOP(5); nv::k_copy_o<<<NROWS, 256, 0, stream>>>(QKV, O);
    nv::k_gemm<1><<<dim3(DM / 64, NROWS / 64), 256, 0, stream>>>(O, w_o + (size_t)i * DM * DM, nullptr, NROWS, DM, DM, out, XC, modi, 2, last ? 1 : 0);
    STOP(6); nv::k_norm<<<NROWS, 256, 0, stream>>>(out, XC, n2g + i * DM, modi, 3, 4, H);
    STOP(7); nv::k_gemm<0><<<dim3(PQN / 64, NROWS / 64), 256, 0, stream>>>(H, pwq + (size_t)i * DM * PQN, PQ, NROWS, PQN, DM, nullptr, nullptr, nullptr, 0, 0);
    STOP(8); nv::k_peer_topk<<<NROWS, 256, 0, stream>>>(PQ, psk + (size_t)i * 2 * NKEYS * 128, EIDX, GATE);
    STOP(9); nv::k_peer_u<<<NROWS, 256, 0, stream>>>(H, pu + (size_t)i * NKEYS * NKEYS * DM, EIDX, GATE, PW);
    STOP(10); nv::k_peer_v<<<NROWS, 256, 0, stream>>>(pv + (size_t)i * NKEYS * NKEYS * DM, EIDX, PW, out, XC, modi, 5, last ? 1 : 0);
#undef STOP
  }
}

extern "C" void kernel_launch(void* const* d_in, const int* in_sizes, int n_in, void* d_out, int out_size, void* d_ws, size_t ws_size, hipStream_t stream) {
  static int grid = 0;
  if (grid == 0) {
    if (n_in != 17 || out_size != NB * SEQ * DM || ws_size < mk::WS_END) { fprintf(stderr, "kernel_launch: unexpected shapes (n_in %d out %d ws %zu)\n", n_in, out_size, ws_size); grid = -1; return; }
    int dev = 0, cus = 0, per_cu = 0;
    hipGetDevice(&dev); hipDeviceGetAttribute(&cus, hipDeviceAttributeMultiprocessorCount, dev);
    if (hipFuncSetAttribute((const void*)mk::fwd, hipFuncAttributeMaxDynamicSharedMemorySize, mk::LDS_BYTES) != hipSuccess) { fprintf(stderr, "kernel_launch: hipFuncSetAttribute failed\n"); grid = -1; return; }
    if (hipOccupancyMaxActiveBlocksPerMultiprocessor(&per_cu, (const void*)mk::fwd, mk::NTHR, mk::LDS_BYTES) != hipSuccess || per_cu < 1) { fprintf(stderr, "kernel_launch: occupancy query failed (%d)\n", per_cu); grid = -1; return; }
    grid = cus * 1;
    grid -= grid % 8;
  }
  if (grid < 0) return;
  mk::Args a{};
  for (int i = 0; i < 17; ++i) a.in[i] = (const float*)d_in[i];
  a.out = (float*)d_out; a.ws = (unsigned char*)d_ws;
#if DBG == 0
#if MK_MULTI
  for (int p = 0; p < mk::NPHASE; ++p) { a.ph_lo = p; a.ph_hi = p + 1; hipLaunchKernelGGL(mk::fwd, dim3(grid), dim3(mk::NTHR), mk::LDS_BYTES, stream, a); }
#else
  a.ph_lo = 0; a.ph_hi = mk::NPHASE; void* kargs[] = {&a};
  hipError_t e = hipLaunchCooperativeKernel((const void*)mk::fwd, dim3(grid), dim3(mk::NTHR), kargs, mk::LDS_BYTES, stream);
  if (e != hipSuccess) fprintf(stderr, "cooperative launch failed: %s (grid %d)\n", hipGetErrorString(e), grid);
#endif
#else
  {
    constexpr size_t MiB = 1u << 20; char* ws = (char*)d_ws; float* out = (float*)d_out;
    float* REF = (float*)(ws + 402 * MiB); float* RES = (float*)(ws + 511 * MiB);
    float* nH = (float*)(ws + 34 * MiB); float* nQKV = (float*)(ws + 104 * MiB); float* nMOD = (float*)ws; float* nXC = (float*)(ws + 1 * MiB);
    hipMemsetAsync(RES, 0, 64, stream);
    int slayer = 0, stop = 0, fastp = 0;
#if DBG == 1
    slayer = 0; stop = 2; fastp = 2;
#elif DBG == 2
    slayer = 0; stop = 4; fastp = 4;
#elif DBG == 3
    slayer = 0; stop = 5; fastp = 5;
#elif DBG == 4
    slayer = 0; stop = 6; fastp = 6;
#elif DBG == 5
    slayer = 0; stop = 8; fastp = 8;
#elif DBG == 6
    slayer = 1; stop = 1; fastp = 11;
#elif DBG == 7
    slayer = 1; stop = 5; fastp = 15;
#elif DBG == 8
    slayer = 9; stop = 99; fastp = 21;
#elif DBG == 9
    slayer = 1; stop = 1; fastp = 9;
#elif DBG == 10
    slayer = 0; stop = 10; fastp = 9;
#elif DBG == 11
    slayer = 0; stop = 1; fastp = 1;
#endif
    run_naive(d_in, out, ws, stream, slayer, stop);
#if DBG == 1
    hipMemcpyAsync(REF, nH, (size_t)NROWS * DM * 4, hipMemcpyDeviceToDevice, stream); hipMemcpyAsync(REF + (size_t)NROWS * DM, nMOD, (size_t)DEPTH * 5 * NMOD * DM * 4, hipMemcpyDeviceToDevice, stream);
#elif DBG == 2 || DBG == 3 || DBG == 7
    hipMemcpyAsync(REF, nQKV, (size_t)NROWS * QKVD * 4, hipMemcpyDeviceToDevice, stream);
#elif DBG == 4 || DBG == 6 || DBG == 8 || DBG == 9
    hipMemcpyAsync(REF, out, (size_t)NB * SEQ * DM * 4, hipMemcpyDeviceToDevice, stream); hipMemcpyAsync(REF + (size_t)NB * SEQ * DM, nXC, (size_t)NB * CTXL * DM * 4, hipMemcpyDeviceToDevice, stream);
#endif
#if DBG == 10
    hipMemcpyAsync(REF, ws + 24 * MiB, (size_t)NROWS * 128 * 4, hipMemcpyDeviceToDevice, stream);
#endif
#if DBG == 9 || DBG == 10
    hipMemcpyAsync(REF + (size_t)70 * MiB / 4, ws + 6 * MiB, (size_t)NROWS * 128 * 4, hipMemcpyDeviceToDevice, stream); hipMemcpyAsync(REF + (size_t)80 * MiB / 4, ws + 15 * MiB, (size_t)NROWS * 128 * 4, hipMemcpyDeviceToDevice, stream);
#elif DBG == 5
    hipMemcpyAsync(REF, nQKV  , (size_t)512 * PQN * 4, hipMemcpyDeviceToDevice, stream);
#endif
    for (int p = 0; p < fastp; ++p) { a.ph_lo = p; a.ph_hi = p + 1; hipLaunchKernelGGL(mk::fwd, dim3(grid), dim3(mk::NTHR), mk::LDS_BYTES, stream, a); }
    unsigned char* fw = (unsigned char*)d_ws;
#if DBG == 9 || DBG == 10
    hipMemcpyAsync(fw + mk::WS_EIDX, REF + (size_t)70 * MiB / 4, (size_t)NROWS * 128 * 4, hipMemcpyDeviceToDevice, stream); hipMemcpyAsync(fw + mk::WS_GATE, REF + (size_t)80 * MiB / 4, (size_t)NROWS * 128 * 4, hipMemcpyDeviceToDevice, stream);
    for (int p = 9; p < (DBG == 9 ? 11 : 10); ++p) { a.ph_lo = p; a.ph_hi = p + 1; hipLaunchKernelGGL(mk::fwd, dim3(grid), dim3(mk::NTHR), mk::LDS_BYTES, stream, a); }
#endif
#if DBG == 1
    dbg::k_cmp<true><<<1, 1024, 0, stream>>>(fw + mk::WS_H, DM, 0, REF, DM, 0, NROWS, DM, 0, 0, RES);
    dbg::k_cmp<false><<<1, 1024, 0, stream>>>(fw + mk::WS_MOD, NMOD * DM, 0, REF + (size_t)NROWS * DM, NMOD * DM, 0, DEPTH * 5, NMOD * DM, 0, 0, RES + 1);
#elif DBG == 2
    dbg::k_cmp<true><<<1, 1024, 0, stream>>>(fw + mk::WS_Q, DM, 0, REF, QKVD, 0, NROWS, DM, 0, 0, RES);
    dbg::k_cmp<true><<<1, 1024, 0, stream>>>(fw + mk::WS_K, 256, 0, REF, QKVD, 1024, NROWS, 256, 0, 0, RES + 2);
    dbg::k_cmp<true><<<1, 1024, 0, stream>>>(fw + mk::WS_V, 256, 0, REF, QKVD, 1280, NROWS, 256, 0, 0, RES + 1);
#elif DBG == 3 || DBG == 7
    dbg::k_cmp<true><<<1, 1024, 0, stream>>>(fw + mk::WS_Q, DM, 0, REF, QKVD, 0, NROWS, DM, 0, 1, RES);
    if (DBG == 3) dbg::k_cmp<true><<<1, 1024, 0, stream>>>(fw + mk::WS_Q, DM, 0, REF, QKVD, 0, NROWS, DM, 0, 2, RES + 1);
#elif DBG == 4 || DBG == 6 || DBG == 8 || DBG == 9
    dbg::k_cmp<false><<<1, 1024, 0, stream>>>(out, DM, 0, REF, DM, 0, NB * SEQ, DM, 0, 0, RES);
    if (DBG != 8) dbg::k_cmp<false><<<1, 1024, 0, stream>>>(fw + mk::WS_XC, DM, 0, REF + (size_t)NB * SEQ * DM, DM, 0, NB * CTXL, DM, 0, 0, RES + 1);
#elif DBG == 11
    dbg::k_cmp<true><<<1, 1024, 0, stream>>>(fw + mk::WS_UT, DM, 0, (const float*)d_in[15], DM, 0, DEPTH * NKEYS * NKEYS, DM, 0, 0, RES);
    dbg::k_cmp<true><<<1, 1024, 0, stream>>>(fw + mk::WS_VT, DM, 0, (const float*)d_in[16], DM, 0, DEPTH * NKEYS * NKEYS, DM, 0, 0, RES + 1);
#elif DBG == 10
    dbg::k_cmp<false><<<1, 1024, 0, stream>>>(fw + mk::WS_PW, 128, 0, REF, 128, 0, NROWS, 128, 0, 0, RES);
#elif DBG == 5
    dbg::k_cmp_scores<<<1, 1024, 0, stream>>>((const float*)(fw + mk::WS_S), REF, (const float*)d_in[14], 512, RES);
#endif
    hipMemcpyAsync(REF, RES, 64, hipMemcpyDeviceToDevice, stream);
    run_naive(d_in, out, ws, stream, 9, 99);
    dbg::k_final<<<1024, 256, 0, stream>>>(out, (long)NB * SEQ * DM, REF);
    dbg::k_final2<<<1, 1, 0, stream>>>(out, REF);
  }
#endif
}
```

```cpp
#include <hip/hip_runtime.h>
#include <hip/hip_cooperative_groups.h>
#include <cstdio>
#include <cstdint>

constexpr int NB = 4, SEQ = 4096, CTXL = 256, DM = 1024, DEPTH = 2;
constexpr int RPB = CTXL + SEQ;
constexpr int NROWS = NB * RPB;
constexpr int NH = 8, NKV = 2, HD = 128, QKVD = 1536, NMOD = 6;
constexpr int PH = 8, PK = 16, NKEYS = 128, PQD = 256, PQN = PH * PQD;
constexpr float RMS_EPS = 1e-6f;

namespace nv {

__device__ __forceinline__ float silu(float x) { return x / (1.f + __expf(-x)); }
__device__ __forceinline__ float gelu_tanh(float x) {
  const float y = 0.7978845608028654f * (x + 0.044715f * x * x * x);
  const float t = 1.f - 2.f / (__expf(2.f * y) + 1.f);
  return 0.5f * x * (1.f + t);
}

__global__ void k_mod(const float* __restrict__ c, const float* __restrict__ c_ctx, const float* __restrict__ ada_w,
                      const float* __restrict__ ada_b, float* __restrict__ mod) {
  const int idx = blockIdx.x * 256 + threadIdx.x;
  if (idx >= DEPTH * 5 * NMOD * DM) return;
  const int n = idx % (NMOD * DM), r = (idx / (NMOD * DM)) % 5, i = idx / (5 * NMOD * DM);
  const float* cv = r < 4 ? c + r * DM : c_ctx;
  const float* w = ada_w + (size_t)i * DM * NMOD * DM + n;
  float s = 0.f;
  for (int j = 0; j < DM; ++j) s += silu(cv[j]) * w[(size_t)j * NMOD * DM];
  mod[idx] = s + ada_b[i * NMOD * DM + n];
}

__device__ __forceinline__ float* xrow(float* xl, float* xc, int r) {
  const int b = r / RPB, j = r % RPB;
  return j < CTXL ? xc + (size_t)(b * CTXL + j) * DM : xl + (size_t)(b * SEQ + (j - CTXL)) * DM;
}

__global__ void k_norm(float* xl, float* xc, const float* __restrict__ gain, const float* __restrict__ modi, int sh_i, int sc_i,
                       float* __restrict__ H) {
  const int r = blockIdx.x, t = threadIdx.x;
  const int b = r / RPB, j = r % RPB, mr = j < CTXL ? 4 : b;
  const float* x = xrow(xl, xc, r);
  __shared__ float red[4];
  float v[4]; float s = 0.f;
#pragma unroll
  for (int q = 0; q < 4; ++q) { v[q] = x[t + 256 * q]; s += v[q] * v[q]; }
  for (int o = 32; o > 0; o >>= 1) s += __shfl_xor(s, o);
  if ((t & 63) == 0) red[t >> 6] = s;
  __syncthreads();
  s = red[0] + red[1] + red[2] + red[3];
  const float rstd = rsqrtf(s / DM + RMS_EPS);
  const float* sh = modi + (size_t)mr * NMOD * DM + sh_i * DM; const float* sc = modi + (size_t)mr * NMOD * DM + sc_i * DM;
#pragma unroll
  for (int q = 0; q < 4; ++q) { const int d = t + 256 * q; H[(size_t)r * DM + d] = v[q] * rstd * gain[d] * (1.f + sc[d]) + sh[d]; }
}

template <int EPI>
__global__ void k_gemm(const float* __restrict__ A, const float* __restrict__ B, float* __restrict__ C, int M, int N, int K,
                       float* xl, float* xc, const float* __restrict__ modi, int g_i, int skip_ctx) {
  __shared__ float As[16][68], Bs[16][68];
  const int t = threadIdx.x, tx = t & 15, ty = t >> 4, m0 = blockIdx.y * 64, n0 = blockIdx.x * 64;
  float acc[4][4] = {};
  for (int k0 = 0; k0 < K; k0 += 16) {
    for (int q = 0; q < 4; ++q) { const int e = t + 256 * q, mm = e >> 4, kk = e & 15; As[kk][mm] = A[(size_t)(m0 + mm) * K + k0 + kk]; }
    for (int q = 0; q < 4; ++q) { const int e = t + 256 * q, kk = e >> 6, nn = e & 63; Bs[kk][nn] = B[(size_t)(k0 + kk) * N + n0 + nn]; }
    __syncthreads();
#pragma unroll
    for (int kk = 0; kk < 16; ++kk) {
      float a[4], b[4];
#pragma unroll
      for (int i = 0; i < 4; ++i) { a[i] = As[kk][ty * 4 + i]; b[i] = Bs[kk][tx * 4 + i]; }
#pragma unroll
      for (int i = 0; i < 4; ++i)
#pragma unroll
        for (int j = 0; j < 4; ++j) acc[i][j] += a[i] * b[j];
    }
    __syncthreads();
  }
#pragma unroll
  for (int i = 0; i < 4; ++i) {
    const int r = m0 + ty * 4 + i;
    if (EPI == 0) {
#pragma unroll
      for (int j = 0; j < 4; ++j) C[(size_t)r * N + n0 + tx * 4 + j] = acc[i][j];
    } else {
      const int b = r / RPB, jj = r % RPB; if (skip_ctx && jj < CTXL) continue;
      const int mr = jj < CTXL ? 4 : b; float* x = xrow(xl, xc, r);
      const float* g = modi + (size_t)mr * NMOD * DM + g_i * DM;
#pragma unroll
      for (int j = 0; j < 4; ++j) { const int n = n0 + tx * 4 + j; x[n] += g[n] * acc[i][j]; }
    }
  }
}

__global__ void k_qknorm_rope(float* __restrict__ QKV, const float* __restrict__ qg, const float* __restrict__ kg) {
  const int r = blockIdx.x, t = threadIdx.x, head = t >> 6, p = t & 63, axis = p >> 5, f = p & 31;
  const int j = r % RPB;
  float* base = QKV + (size_t)r * QKVD + head * HD;
  const int e1 = axis * 64 + f, e2 = e1 + 32;
  float x1 = base[e1], x2 = base[e2];
  float s = x1 * x1 + x2 * x2;
  for (int o = 32; o > 0; o >>= 1) s += __shfl_xor(s, o);
  const float rstd = rsqrtf(s / HD + RMS_EPS);
  const float* g = head < NH ? qg : kg;
  x1 = x1 * rstd * g[e1]; x2 = x2 * rstd * g[e2];
  if (j >= CTXL) {
    const int sp = j - CTXL; const float pos = (float)(axis == 0 ? sp / 64 : sp % 64);
    const float inv = powf(10000.f, -(float)(2 * f) / 64.f);
    const float ang = pos * inv; const float cs = cosf(ang), sn = sinf(ang);
    const float y1 = x1 * cs - x2 * sn, y2 = x1 * sn + x2 * cs; x1 = y1; x2 = y2;
  }
  base[e1] = x1; base[e2] = x2;
}

__global__ void k_attn(float* __restrict__ QKV, int mode, const float* __restrict__ sink) {
  extern __shared__ float sm[];
  const int t = threadIdx.x, w = t >> 6, lane = t & 63, g = blockIdx.y;
  int b, j;
  if (mode == 1) { b = blockIdx.x / CTXL; j = blockIdx.x % CTXL; } else { b = blockIdx.x / SEQ; j = CTXL + blockIdx.x % SEQ; }
  const int r = b * RPB + j, h = g * 4 + w;
  float* sc = sm + w * RPB; float* qs = sm + 4 * RPB + w * HD;
  float* qp = QKV + (size_t)r * QKVD + h * HD;
  qs[lane] = qp[lane]; qs[lane + 64] = qp[lane + 64];
  __syncthreads();
  int a0 = 0, a1, b0 = 0, b1 = 0;
  if (mode == 0) a1 = RPB; else if (mode == 1) a1 = CTXL;
  else { a1 = CTXL; const int s = j - CTXL; const int lo = s - 128 < 0 ? 0 : s - 128, hi = s + 128 > SEQ - 1 ? SEQ - 1 : s + 128; b0 = CTXL + lo; b1 = CTXL + hi + 1; }
  const int nk = (a1 - a0) + (b1 - b0);
  const float scale = 0.08838834764831845f;
  float mx = -1e30f;
  for (int i = lane; i < nk; i += 64) {
    const int kr = i < (a1 - a0) ? a0 + i : b0 + (i - (a1 - a0));
    const float4* kp = (const float4*)(QKV + (size_t)(b * RPB + kr) * QKVD + NH * HD + g * HD);
    float s = 0.f;
    for (int d = 0; d < 32; ++d) { const float4 kv = kp[d]; s += kv.x * qs[4 * d] + kv.y * qs[4 * d + 1] + kv.z * qs[4 * d + 2] + kv.w * qs[4 * d + 3]; }
    s *= scale; sc[i] = s; mx = fmaxf(mx, s);
  }
  for (int o = 32; o > 0; o >>= 1) mx = fmaxf(mx, __shfl_xor(mx, o));
  if (mode == 2) mx = fmaxf(mx, sink[h]);
  float l = 0.f;
  for (int i = lane; i < nk; i += 64) { const float p = __expf(sc[i] - mx); sc[i] = p; l += p; }
  for (int o = 32; o > 0; o >>= 1) l += __shfl_xor(l, o);
  if (mode == 2) l += __expf(sink[h] - mx);
  __syncthreads();
  float o0 = 0.f, o1 = 0.f;
  for (int i = 0; i < nk; ++i) {
    const int kr = i < (a1 - a0) ? a0 + i : b0 + (i - (a1 - a0));
    const float* vp = QKV + (size_t)(b * RPB + kr) * QKVD + (NH + NKV) * HD + g * HD;
    const float p = sc[i]; o0 += p * vp[lane]; o1 += p * vp[lane + 64];
  }
  const float il = 1.f / l;
  qp[lane] = o0 * il; qp[lane + 64] = o1 * il;
}

__global__ void k_copy_o(const float* __restrict__ QKV, float* __restrict__ O) {
  const int r = blockIdx.x, t = threadIdx.x;
  for (int q = 0; q < 4; ++q) O[(size_t)r * DM + t + 256 * q] = QKV[(size_t)r * QKVD + t + 256 * q];
}

__global__ void __launch_bounds__(256) k_peer_topk(const float* __restrict__ PQ, const float* __restrict__ SK  , int* __restrict__ eidx, float* __restrict__ gate) {
  __shared__ float q[PQN]; __shared__ float s[16][128]; __shared__ float tv[16][16]; __shared__ int ti[16][16];
  __shared__ float cs[8][256]; __shared__ int taken[8][256];
  const int r = blockIdx.x, t = threadIdx.x;
  for (int i = t; i < PQN; i += 256) q[i] = PQ[(size_t)r * PQN + i];
  __syncthreads();
  { const int k = t & 127, half = t >> 7; const float* kp = SK + (size_t)half * NKEYS * 128 + (size_t)k * 128;
#pragma nounroll
    for (int h = 0; h < PH; ++h) { float a = 0.f; const float* qq = q + h * PQD + half * 128;
#pragma unroll 4
      for (int d = 0; d < 128; ++d) a += qq[d] * kp[d];
      s[h * 2 + half][k] = a; } }
  __syncthreads();
  if (t < 16) {
#pragma nounroll
    for (int it = 0; it < PK; ++it) { float bv = -3e38f; int bi = 0;
#pragma nounroll
      for (int k = 0; k < 128; ++k) { const float v = s[t][k]; if (v > bv) { bv = v; bi = k; } } tv[t][it] = bv; ti[t][it] = bi; s[t][bi] = -3e38f; }
  }
  __syncthreads();
  for (int i = t; i < 8 * 256; i += 256) { const int h = i >> 8, c = i & 255; cs[h][c] = tv[h * 2][c >> 4] + tv[h * 2 + 1][c & 15]; taken[h][c] = 0; }
  __syncthreads();
  if (t < 8) {
    float m = -3e38f;
#pragma nounroll
    for (int it = 0; it < PK; ++it) { float bv = -3e38f; int bi = 0;
#pragma nounroll
      for (int c = 0; c < 256; ++c) { const float v = cs[t][c]; if (!taken[t][c] && v > bv) { bv = v; bi = c; } }
      taken[t][bi] = 1; s[t][it] = bv; m = fmaxf(m, bv); eidx[(size_t)r * 128 + t * PK + it] = ti[t * 2][bi >> 4] * NKEYS + ti[t * 2 + 1][bi & 15]; }
    float l = 0.f;
#pragma nounroll
    for (int it = 0; it < PK; ++it) l += __expf(s[t][it] - m);
#pragma nounroll
    for (int it = 0; it < PK; ++it) gate[(size_t)r * 128 + t * PK + it] = __expf(s[t][it] - m) / l;
  }
}

__global__ void k_peer_u(const float* __restrict__ H, const float* __restrict__ U, const int* __restrict__ eidx, const float* __restrict__ gate, float* __restrict__ W) {
  __shared__ float h[DM];
  const int r = blockIdx.x, t = threadIdx.x, w = t >> 6, lane = t & 63;
  for (int i = t; i < DM; i += 256) h[i] = H[(size_t)r * DM + i];
  __syncthreads();
  for (int k = w; k < 128; k += 4) {
    const int e = eidx[(size_t)r * 128 + k]; const float* u = U + (size_t)e * DM; float a = 0.f;
    for (int d = lane; d < DM; d += 64) a += u[d] * h[d];
    for (int o = 32; o > 0; o >>= 1) a += __shfl_xor(a, o);
    if (lane == 0) W[(size_t)r * 128 + k] = gate[(size_t)r * 128 + k] * gelu_tanh(a);
  }
}
__global__ void k_peer_v(const float* __restrict__ V, const int* __restrict__ eidx, const float* __restrict__ W, float* xl, float* xc,
                         const float* __restrict__ modi, int g_i, int skip_ctx) {
  const int r = blockIdx.x, t = threadIdx.x; const int b = r / RPB, j = r % RPB; if (skip_ctx && j < CTXL) return;
  float4 acc = {0.f, 0.f, 0.f, 0.f};
  for (int k = 0; k < 128; ++k) { const int e = eidx[(size_t)r * 128 + k]; const float w = W[(size_t)r * 128 + k]; const float4 v = ((const float4*)(V + (size_t)e * DM))[t];
    acc.x += w * v.x; acc.y += w * v.y; acc.z += w * v.z; acc.w += w * v.w; }
  const int mr = j < CTXL ? 4 : b; float4* x = (float4*)xrow(xl, xc, r) + t; const float4 g = ((const float4*)(modi + (size_t)mr * NMOD * DM + g_i * DM))[t];
  float4 xv = *x; xv.x += g.x * acc.x; xv.y += g.y * acc.y; xv.z += g.z * acc.z; xv.w += g.w * acc.w; *x = xv;
}
}


namespace pg8 {
#define PG8_LAS __attribute__((address_space(3)))
typedef unsigned short bf16_t;
typedef short bf16x8 __attribute__((ext_vector_type(8)));
typedef float f32x4 __attribute__((ext_vector_type(4)));
typedef unsigned u32x4 __attribute__((ext_vector_type(4)));
constexpr int BM = 256, BK = 64, HALF = 128, HTB = HALF * BK * 2  , STAGE_BYTES = 8 * HTB, NXCD = 8, WGM = 8;

__host__ __device__ __forceinline__ int lds_byte(int r, int c) { const int st = (r >> 4) * 2 + (c >> 5), rr = r & 15, cc = c & 31, ob = rr * 64 + cc * 2; return st * 1024 + (ob ^ (((ob >> 9) & 1) << 5)); }
__host__ __device__ __forceinline__ void stage_rc(int b, int& R, int& C) { const int st = b / 1024, sb = b % 1024, swz = sb ^ (((sb >> 9) & 1) << 5); R = (st >> 1) * 16 + swz / 64; C = (st & 1) * 32 + (swz % 64) / 2; }
__host__ __device__ __forceinline__ int perm32(int rho) { const int n = rho >> 4, i = rho & 15; return 8 * (i >> 2) + 4 * n + (i & 3); }

struct Unit { int pm, pn; };
struct Gemm { const bf16_t* A; const bf16_t* Bt; int M, N, K; };

struct StaticOrder {
    int nM, nN, nwg, G, c;
    __host__ __device__ void init(int M, int N, int G_, int c_) { nM = M / BM; nN = N / BM; nwg = nM * nN; G = G_; c = c_; }
    __host__ __device__ bool next(int i, Unit& u) const {
        const long L = (long)i * G + c; if (L >= nwg) return false;
        int wgid = (int)L; { const int q = nwg / NXCD, r = nwg % NXCD, xcd = wgid % NXCD, off = wgid / NXCD; wgid = (xcd < r ? xcd * (q + 1) : r * (q + 1) + (xcd - r) * q) + off; }
        const int nig = WGM * nN, gid = wgid / nig, fm = gid * WGM, gsz = (nM - fm) < WGM ? (nM - fm) : WGM;
        u.pm = fm + ((wgid % nig) % gsz); u.pn = (wgid % nig) / gsz; return true;
    }
    __device__ __forceinline__ void a_ready(const Unit&) const {}
    __device__ __forceinline__ void done(const Unit&) const {}
};

__device__ __forceinline__ unsigned cvt_pk_bf16(float lo, float hi) { unsigned r; asm volatile("v_cvt_pk_bf16_f32 %0, %1, %2" : "=v"(r) : "v"(lo), "v"(hi)); return r; }
typedef float f32x2 __attribute__((ext_vector_type(2)));
__device__ __forceinline__ f32x2 gelu_pk(f32x2 v) {
    const f32x2 av = __builtin_elementwise_abs(v), d = av * 0.2316418882f + 1.0f;
    f32x2 t; t.x = __builtin_amdgcn_rcpf(d.x); t.y = __builtin_amdgcn_rcpf(d.y);
    f32x2 q = t * 0.5307027145f + (-0.7265760135f); q = q * t + 0.7107068705f; q = q * t + (-0.142248368f); q = q * t + 0.127414796f; q = q * t;
    const f32x2 s = (v * v) * (-0.72134752044f);
    f32x2 e; e.x = __builtin_amdgcn_exp2f(s.x); e.y = __builtin_amdgcn_exp2f(s.y);
    const f32x2 m = v * (q * e), r = v - m;
    f32x2 o; o.x = v.x < 0.f ? m.x : r.x; o.y = v.y < 0.f ? m.y : r.y; return o;
}

template <int ACT  > struct EpiBf16 {
    static constexpr bool PERM = true, AFTER_DRAIN = false; static_assert(ACT == 0 || ACT == 1, "EpiBf16: ACT is 0 (none) or 1 (gelu_pk)");
    bf16_t* O; int ldc; const float* bias; int split_cols; size_t split_stride; float scale0;
    __device__ __forceinline__ void operator()(const f32x4 (&acc)[2][2][4][2], const Unit& u, int wr, int wc, int fr, int fq) const {
        const int row0 = u.pm * BM + wr * 64 + fr; int colt = u.pn * BM; bf16_t* base = O;
        float sc = 1.f; if (split_cols) { const int t = colt / split_cols; base += (size_t)t * split_stride; colt -= t * split_cols; if (t == 0) sc = scale0; }
        const int col0 = colt + wc * 32 + 8 * fq, bcol0 = u.pn * BM + wc * 32 + 8 * fq;
        f32x4 bv[2][2];
#pragma unroll
        for (int bj = 0; bj < 2; ++bj)
#pragma unroll
            for (int n = 0; n < 2; ++n) bv[bj][n] = bias ? *(const f32x4*)(bias + bcol0 + bj * HALF + 4 * n) : (f32x4){0.f, 0.f, 0.f, 0.f};
#pragma unroll
        for (int ai = 0; ai < 2; ++ai)
#pragma unroll
            for (int m = 0; m < 4; ++m) { bf16_t* rowp = base + (size_t)(row0 + ai * HALF + m * 16) * ldc + col0;
#pragma unroll
                for (int bj = 0; bj < 2; ++bj) { f32x4 v0 = acc[ai][bj][m][0] + bv[bj][0], v1 = acc[ai][bj][m][1] + bv[bj][1];
                    if (ACT == 1) { f32x2 a = gelu_pk((f32x2){v0[0], v0[1]}), b = gelu_pk((f32x2){v0[2], v0[3]}), c = gelu_pk((f32x2){v1[0], v1[1]}), d = gelu_pk((f32x2){v1[2], v1[3]});
                        v0 = (f32x4){a.x, a.y, b.x, b.y}; v1 = (f32x4){c.x, c.y, d.x, d.y}; }
                    v0 = v0 * sc; v1 = v1 * sc; u32x4 w; w.x = cvt_pk_bf16(v0[0], v0[1]); w.y = cvt_pk_bf16(v0[2], v0[3]); w.z = cvt_pk_bf16(v1[0], v1[1]); w.w = cvt_pk_bf16(v1[2], v1[3]);
                    *(u32x4*)(rowp + bj * HALF) = w; } }
    }
};

template <class Epi, class Sched, bool ALIGN_EPI = false, bool SP2 = false>
__device__ __forceinline__ void gemm_phase(PG8_LAS unsigned char* lds, const Gemm g, const Sched& S, const Epi& E) {
    int tid_ = threadIdx.x; asm volatile("" : "+v"(tid_));
    const int tid = tid_, wid = __builtin_amdgcn_readfirstlane(tid >> 6), lane = tid & 63, wr = wid >> 2, wc = wid & 3, fr = lane & 15, fq = lane >> 4;
    const int K = g.K, nt = K / BK;
    unsigned voffA[2], voffB[2];
#pragma unroll
    for (int i = 0; i < 2; ++i) { int R, C; stage_rc(tid * 16 + i * 8192, R, C); const int Rb = Epi::PERM ? ((R & ~31) + perm32(R & 31)) : R;
        voffA[i] = (unsigned)(R * K + C) * 2u; voffB[i] = (unsigned)(Rb * K + C) * 2u; }
    const size_t kstep = (size_t)(BK * 2);
    const size_t hstep = (size_t)HALF * K * 2;
    const size_t tstep = 2 * hstep;
    const unsigned ldsw = (unsigned)wid * 1024u;
    const int aoff = lds_byte(wr * 64 + fr, fq * 8), boff = lds_byte(wc * 32 + fr, fq * 8);
#define PG8_SA(b, h) (((b) * 2 + (h)) * HTB)
#define PG8_SB(b, h) ((4 + (b) * 2 + (h)) * HTB)
#define PG8_STAGE(bufoff, gbase, voff) do { _Pragma("unroll") for (int _i = 0; _i < 2; ++_i) \
        __builtin_amdgcn_global_load_lds((const unsigned*)((const char*)(gbase) + (voff)[_i]), (PG8_LAS unsigned*)(lds + (bufoff) + ldsw + _i * 8192), 16, 0, 0); } while (0)
#define PG8_LDA(dst, b, h) do { _Pragma("unroll") for (int m = 0; m < 4; ++m) _Pragma("unroll") for (int k = 0; k < 2; ++k) dst[m][k] = *(const PG8_LAS bf16x8*)(lds + PG8_SA(b, h) + aoff + m * 2048 + k * 1024); } while (0)
#define PG8_LDB(dst, b, h) do { _Pragma("unroll") for (int n = 0; n < 2; ++n) _Pragma("unroll") for (int k = 0; k < 2; ++k) dst[n][k] = *(const PG8_LAS bf16x8*)(lds + PG8_SB(b, h) + boff + n * 2048 + k * 1024); } while (0)
#define PG8_MMA(ai, bj, At, Bt) do { __builtin_amdgcn_s_setprio(1); _Pragma("unroll") for (int m = 0; m < 4; ++m) _Pragma("unroll") for (int n = 0; n < 2; ++n) _Pragma("unroll") for (int k = 0; k < 2; ++k) \
        acc[ai][bj][m][n] = __builtin_amdgcn_mfma_f32_16x16x32_bf16(Bt[n][k], At[m][k], acc[ai][bj][m][n], 0, 0, 0); __builtin_amdgcn_s_setprio(0); } while (0)
#define PG8_WAIT_V(n) asm volatile("s_waitcnt vmcnt(" #n ")" ::: "memory")
#define PG8_WAIT_L(n) asm volatile("s_waitcnt lgkmcnt(" #n ")" ::: "memory")
#define PG8_BAR __builtin_amdgcn_s_barrier()
#define PG8_SCHED __builtin_amdgcn_sched_barrier(0)
    Unit cur, nxt; int ui = 0;
    if (!S.next(0, cur)) return;
    f32x4 acc[2][2][4][2];
#pragma unroll
    for (int a = 0; a < 2; ++a)
#pragma unroll
        for (int b = 0; b < 2; ++b)
#pragma unroll
            for (int m = 0; m < 4; ++m)
#pragma unroll
                for (int n = 0; n < 2; ++n) acc[a][b][m][n] = (f32x4){0.f, 0.f, 0.f, 0.f};
    bf16x8 At[4][2], B0[2][2], B1[2][2];
    const char* cA = (const char*)g.A + (size_t)cur.pm * tstep; const char* cB = (const char*)g.Bt + (size_t)cur.pn * tstep;
    S.a_ready(cur);
    if constexpr (SP2) {
        PG8_STAGE(PG8_SB(0, 0), cB, voffB); PG8_STAGE(PG8_SB(0, 1), cB + hstep, voffB); PG8_STAGE(PG8_SA(0, 0), cA, voffA); PG8_STAGE(PG8_SA(0, 1), cA + hstep, voffA);
        if (wr == 1) PG8_BAR;
        PG8_WAIT_V(2); PG8_BAR;
        PG8_STAGE(PG8_SB(1, 0), cB + kstep, voffB); PG8_STAGE(PG8_SA(1, 0), cA + kstep, voffA); PG8_STAGE(PG8_SB(1, 1), cB + hstep + kstep, voffB);
        PG8_WAIT_V(6); PG8_BAR;
    } else {
        PG8_STAGE(PG8_SB(0, 0), cB, voffB); PG8_STAGE(PG8_SA(0, 0), cA, voffA); PG8_STAGE(PG8_SB(0, 1), cB + hstep, voffB); PG8_STAGE(PG8_SA(0, 1), cA + hstep, voffA);
        if (wr == 1) PG8_BAR;
        PG8_WAIT_V(4); PG8_BAR;
        PG8_STAGE(PG8_SB(1, 0), cB + kstep, voffB); PG8_STAGE(PG8_SA(1, 0), cA + kstep, voffA); PG8_STAGE(PG8_SB(1, 1), cB + hstep + kstep, voffB);
        PG8_WAIT_V(6); PG8_BAR;
    }
    for (;;) {
        const bool has_next = S.next(ui + 1, nxt);
        const char* nA = has_next ? (const char*)g.A + (size_t)nxt.pm * tstep : cA; const char* nB = has_next ? (const char*)g.Bt + (size_t)nxt.pn * tstep : cB;
        for (int t = 0; t < nt; t += 2) {
            const bool last = (t == nt - 2);
            const char* a1 = cA + (size_t)(t + 1) * kstep;
            const char* a2 = last ? nA : cA + (size_t)(t + 2) * kstep; const char* b2 = last ? nB : cB + (size_t)(t + 2) * kstep;
            const char* a3 = a2 + kstep; const char* b3 = b2 + kstep;
            if (last && has_next) S.a_ready(nxt);
            if constexpr (SP2) {
            PG8_LDB(B0, 0, 0); PG8_LDB(B1, 0, 1); PG8_SCHED; PG8_LDA(At, 0, 0); PG8_STAGE(PG8_SA(1, 1), a1 + hstep, voffA);
            PG8_WAIT_V(8); PG8_WAIT_L(0); PG8_BAR; PG8_MMA(0, 0, At, B0); PG8_MMA(0, 1, At, B1); PG8_BAR; PG8_SCHED;
            PG8_LDA(At, 0, 1); PG8_STAGE(PG8_SB(0, 0), b2, voffB); PG8_STAGE(PG8_SB(0, 1), b2 + hstep, voffB); PG8_STAGE(PG8_SA(0, 0), a2, voffA);
            PG8_WAIT_V(8); PG8_WAIT_L(0); PG8_BAR; PG8_MMA(1, 0, At, B0); PG8_MMA(1, 1, At, B1); PG8_BAR; PG8_SCHED;
            PG8_LDB(B0, 1, 0); PG8_LDB(B1, 1, 1); PG8_SCHED; PG8_LDA(At, 1, 0); PG8_STAGE(PG8_SA(0, 1), a2 + hstep, voffA);
            PG8_WAIT_V(8); PG8_WAIT_L(0); PG8_BAR; PG8_MMA(0, 0, At, B0); PG8_MMA(0, 1, At, B1); PG8_BAR; PG8_SCHED;
            PG8_LDA(At, 1, 1); PG8_STAGE(PG8_SB(1, 0), b3, voffB); PG8_STAGE(PG8_SB(1, 1), b3 + hstep, voffB); PG8_STAGE(PG8_SA(1, 0), a3, voffA);
            PG8_WAIT_V(8); PG8_WAIT_L(0); PG8_BAR; PG8_MMA(1, 0, At, B0); PG8_MMA(1, 1, At, B1); PG8_BAR; PG8_SCHED;
            } else {
            PG8_LDB(B0, 0, 0); PG8_SCHED; PG8_LDA(At, 0, 0); PG8_STAGE(PG8_SA(1, 1), a1 + hstep, voffA);
            PG8_WAIT_L(8); PG8_BAR; PG8_WAIT_L(0); PG8_MMA(0, 0, At, B0); PG8_BAR; PG8_SCHED;
            PG8_LDB(B1, 0, 1); PG8_STAGE(PG8_SB(0, 0), b2, voffB);
            PG8_BAR; PG8_WAIT_L(0); PG8_MMA(0, 1, At, B1); PG8_BAR;
            PG8_LDA(At, 0, 1); PG8_STAGE(PG8_SA(0, 0), a2, voffA);
            PG8_BAR; PG8_WAIT_L(0); PG8_MMA(1, 0, At, B0); PG8_BAR; PG8_SCHED;
            PG8_STAGE(PG8_SB(0, 1), b2 + hstep, voffB);
            PG8_WAIT_V(6); PG8_BAR; PG8_MMA(1, 1, At, B1); PG8_BAR;
            PG8_LDB(B0, 1, 0); PG8_SCHED; PG8_LDA(At, 1, 0); PG8_STAGE(PG8_SA(0, 1), a2 + hstep, voffA);
            PG8_WAIT_L(8); PG8_BAR; PG8_WAIT_L(0); PG8_MMA(0, 0, At, B0); PG8_BAR; PG8_SCHED;
            PG8_LDB(B1, 1, 1); PG8_STAGE(PG8_SB(1, 0), b3, voffB);
            PG8_BAR; PG8_WAIT_L(0); PG8_MMA(0, 1, At, B1); PG8_BAR;
            PG8_LDA(At, 1, 1); PG8_STAGE(PG8_SA(1, 0), a3, voffA);
            PG8_BAR; PG8_WAIT_L(0); PG8_MMA(1, 0, At, B0); PG8_BAR; PG8_SCHED;
            PG8_STAGE(PG8_SB(1, 1), b3 + hstep, voffB);
            PG8_WAIT_V(6); PG8_BAR; PG8_MMA(1, 1, At, B1); PG8_BAR;
            }
        }
        if constexpr (ALIGN_EPI) { if (wr == 0) PG8_BAR; }
        if constexpr (!Epi::AFTER_DRAIN) { E(acc, cur, wr, wc, fr, fq); S.done(cur); }
        if (!has_next) break;
#pragma unroll
        for (int a = 0; a < 2; ++a)
#pragma unroll
            for (int b = 0; b < 2; ++b)
#pragma unroll
                for (int m = 0; m < 4; ++m)
#pragma unroll
                    for (int n = 0; n < 2; ++n) acc[a][b][m][n] = (f32x4){0.f, 0.f, 0.f, 0.f};
        cur = nxt; cA = nA; cB = nB; ++ui;
        if constexpr (ALIGN_EPI) { if (wr == 1) PG8_BAR; }
    }
    PG8_WAIT_V(0);
    if constexpr (!ALIGN_EPI) { if (wr == 0) PG8_BAR; }
    PG8_BAR;
    if constexpr (Epi::AFTER_DRAIN) { E.fused(acc, cur, wr, wc, fr, fq, lds, wid, lane); S.done(cur); }
#undef PG8_SA
#undef PG8_SB
#undef PG8_STAGE
#undef PG8_LDA
#undef PG8_LDB
#undef PG8_MMA
#undef PG8_WAIT_V
#undef PG8_WAIT_L
#undef PG8_BAR
#undef PG8_SCHED
}
}

namespace att {
typedef unsigned short bf16;
constexpr int D = 128, NW = 8, QBLK = 32, KVBLK = 64, LDQ = 1024, LDK = 256;
constexpr float SCALE = 0.088388347648318440f;
constexpr float THR = 8.f;
#ifndef ATT_SDEPTH
#define ATT_SDEPTH 1
#endif
constexpr int SDEPTH = ATT_SDEPTH;
constexpr size_t SHM_V = KVBLK * D * 2, SHM_K = KVBLK * D * 2, SHM_ATTN = 2 * SHM_V + 2 * SHM_K + NW * 64 * 4;
using bf16x8 = __attribute__((ext_vector_type(8))) short;
using s16x4  = __attribute__((ext_vector_type(4))) short;
using f32x16 = __attribute__((ext_vector_type(16))) float;
using u32x4  = __attribute__((ext_vector_type(4))) unsigned;
#define KSWZ(row, colB) ((row) * 256 + ((colB) ^ (((row) & 7) << 4)))
#define SBAR() __builtin_amdgcn_sched_barrier(0)
__device__ __forceinline__ int crow(int r, int hi) { return (r & 3) + 8 * (r >> 2) + 4 * hi; }
__device__ __forceinline__ unsigned cvtpk(float lo, float hi) { unsigned r; asm volatile("v_cvt_pk_bf16_f32 %0, %1, %2" : "=v"(r) : "v"(lo), "v"(hi)); return r; }
__device__ __forceinline__ void partialSM(f32x16& p0, f32x16& p1, float& m_reg, float& mn, float& alpha) {
  constexpr float C = SCALE * 1.4426950408889634f;
  float pmax = p0[0]; for (int r = 1; r < 16; ++r) pmax = fmaxf(pmax, p0[r]); for (int r = 0; r < 16; ++r) pmax = fmaxf(pmax, p1[r]);
  { auto rr = __builtin_amdgcn_permlane32_swap(__float_as_uint(pmax), __float_as_uint(pmax), false, false);
    pmax = fmaxf(__uint_as_float(rr[0]), __uint_as_float(rr[1])); }
  if (__builtin_expect(__all(pmax - m_reg <= THR / SCALE), 1)) { mn = m_reg; alpha = 1.f; }
  else { mn = fmaxf(m_reg, pmax); alpha = __builtin_amdgcn_exp2f((m_reg - mn) * C); m_reg = mn; }
  float mnC = -mn * C;
  for (int r = 0; r < 16; ++r) p0[r] = fmaf(p0[r], C, mnC); for (int r = 0; r < 16; ++r) p1[r] = fmaf(p1[r], C, mnC);
  for (int r = 0; r < 16; ++r) p0[r] = __builtin_amdgcn_exp2f(p0[r]);
}
__device__ __forceinline__ void finishSM(f32x16& p0, f32x16& p1, float alpha, float& l_reg, bf16x8& pa0, bf16x8& pa1, bf16x8& pa2, bf16x8& pa3) {
  for (int r = 0; r < 16; ++r) p1[r] = __builtin_amdgcn_exp2f(p1[r]);
  float ps = 0; for (int r = 0; r < 16; ++r) ps += p0[r]; for (int r = 0; r < 16; ++r) ps += p1[r];
  { auto rr = __builtin_amdgcn_permlane32_swap(__float_as_uint(ps), __float_as_uint(ps), false, false);
    ps = __uint_as_float(rr[0]) + __uint_as_float(rr[1]); }
  l_reg = l_reg * alpha + ps;
#define PK4(P, BASE, OUT) do { unsigned a0 = cvtpk(P[BASE + 0], P[BASE + 1]), a1 = cvtpk(P[BASE + 2], P[BASE + 3]);   \
    unsigned b0 = cvtpk(P[BASE + 4], P[BASE + 5]), b1 = cvtpk(P[BASE + 6], P[BASE + 7]);                              \
    auto r0 = __builtin_amdgcn_permlane32_swap(a0, b0, false, false); auto r1 = __builtin_amdgcn_permlane32_swap(a1, b1, false, false); \
    u32x4 w = {r0[0], r1[0], r0[1], r1[1]}; OUT = *reinterpret_cast<bf16x8*>(&w); } while (0)
  PK4(p0, 0, pa0); PK4(p0, 8, pa1); PK4(p1, 0, pa2); PK4(p1, 8, pa3);
#undef PK4
}
__device__ __forceinline__ void qkt(f32x16& p0, f32x16& p1, const bf16* Ks, const bf16x8* qr, int r32, int hi) {
  p0 = f32x16{}; p1 = f32x16{};
  for (int d0 = 0; d0 < 8; ++d0) { int cb = (d0 * 16 + hi * 8) * 2;
    bf16x8 b0 = *reinterpret_cast<const bf16x8*>((const char*)Ks + KSWZ(r32, cb));
    bf16x8 b1 = *reinterpret_cast<const bf16x8*>((const char*)Ks + KSWZ(32 + r32, cb));
    p0 = __builtin_amdgcn_mfma_f32_32x32x16_bf16(b0, qr[d0], p0, 0, 0, 0);
    p1 = __builtin_amdgcn_mfma_f32_32x32x16_bf16(b1, qr[d0], p1, 0, 0, 0); }
}
__device__ __forceinline__ int v_st(int k, int c) { const int kk = (k & ~0xC) | ((k & 4) << 1) | ((k & 8) >> 1); return ((kk >> 3) * 4 + (c >> 5)) * 512 + ((kk & 7) * 32 + (c & 31)) * 2; }
__device__ __forceinline__ int v_rd_base(int lane) { return ((lane & 3) << 3) | (((lane >> 2) & 3) << 6) | (((lane >> 4) & 1) << 5) | (((lane >> 5) & 1) << 8); }
constexpr int v_rd_off(int d0, int ks, int half) { return d0 * 512 + ks * 4096 + half * 2048; }
template <int OFF> __device__ __forceinline__ s16x4 tr_read(int vb) {
  s16x4 r; asm volatile("ds_read_b64_tr_b16 %0, %1 offset:%2" : "=&v"(r) : "v"(vb), "i"(OFF) : "memory"); return r;
}
template <int D0> __device__ __forceinline__ void pv_one(f32x16& od, int vb, bf16x8 pa0, bf16x8 pa1, bf16x8 pa2, bf16x8 pa3) {
  const s16x4 l0 = tr_read<v_rd_off(D0, 0, 0)>(vb), h0 = tr_read<v_rd_off(D0, 0, 1)>(vb), l1 = tr_read<v_rd_off(D0, 1, 0)>(vb), h1 = tr_read<v_rd_off(D0, 1, 1)>(vb);
  const s16x4 l2 = tr_read<v_rd_off(D0, 2, 0)>(vb), h2 = tr_read<v_rd_off(D0, 2, 1)>(vb), l3 = tr_read<v_rd_off(D0, 3, 0)>(vb), h3 = tr_read<v_rd_off(D0, 3, 1)>(vb);
  asm volatile("s_waitcnt lgkmcnt(0)" ::: "memory"); SBAR();
#define PKV(L, H) (bf16x8){L[0], L[1], L[2], L[3], H[0], H[1], H[2], H[3]}
  od = __builtin_amdgcn_mfma_f32_32x32x16_bf16(pa0, PKV(l0, h0), od, 0, 0, 0);
  od = __builtin_amdgcn_mfma_f32_32x32x16_bf16(pa1, PKV(l1, h1), od, 0, 0, 0);
  od = __builtin_amdgcn_mfma_f32_32x32x16_bf16(pa2, PKV(l2, h2), od, 0, 0, 0);
  od = __builtin_amdgcn_mfma_f32_32x32x16_bf16(pa3, PKV(l3, h3), od, 0, 0, 0);
#undef PKV
}
__device__ __forceinline__ void pv_d0(f32x16* o, int vb, bf16x8 pa0, bf16x8 pa1, bf16x8 pa2, bf16x8 pa3) {
  pv_one<0>(o[0], vb, pa0, pa1, pa2, pa3); pv_one<1>(o[1], vb, pa0, pa1, pa2, pa3); pv_one<2>(o[2], vb, pa0, pa1, pa2, pa3); pv_one<3>(o[3], vb, pa0, pa1, pa2, pa3);
}
__device__ __forceinline__ void wmask(f32x16& p0, f32x16& p1, int kb, int qp, int hi) {
  const int bd = kb - qp + 4 * hi + 128;
#pragma unroll
  for (int r = 0; r < 16; ++r) { const int d0 = bd + (r & 3) + 8 * (r >> 2);
    if ((unsigned)d0 > 256u) p0[r] = -1e30f; if ((unsigned)(d0 + 32) > 256u) p1[r] = -1e30f; }
}
__device__ __forceinline__ void attn_unit(const bool WIN, bf16* Qb, const bf16* __restrict__ Kh, const bf16* __restrict__ Vh, int NT, int kstart, int q0, float sink_l2, char* lds) {
  int tid_ = threadIdx.x; asm volatile("" : "+v"(tid_));
  const int tid = tid_, wid = tid >> 6, lane = tid & 63, r32 = lane & 31, hi = lane >> 5;
  bf16* V_lds = (bf16*)lds; bf16* K_lds = (bf16*)(lds + 2 * SHM_V);
  float* ws = (float*)(lds + 2 * SHM_V + 2 * SHM_K) + wid * 64; float* li_l = ws; float* al_l = ws + 32;
  float m_reg = -1e30f, l_reg = 0; f32x16 o[4] = {}; bf16x8 qr[8];
  bf16* Qw = Qb + (long)(wid * QBLK + r32) * LDQ + hi * 8;
#pragma unroll
  for (int d0 = 0; d0 < 8; ++d0) qr[d0] = *reinterpret_cast<const bf16x8*>(Qw + d0 * 16);
  const int sr = tid >> 4, sc = (tid & 15) * 8, vst0 = v_st(sr, sc), vst1 = v_st(32 + sr, sc);
  const int vb0 = (int)(uintptr_t)V_lds + v_rd_base(lane);
  const int qp = q0 + wid * QBLK + r32;
  struct { bf16x8 vs0, vs1, ks0, ks1; } sr_[SDEPTH];
#define TROW(t) (WIN ? ((t) < 4 ? (t) * KVBLK : kstart + (t) * KVBLK) : (t) * KVBLK)
#define SLOAD(i, t) do { const int k0_ = TROW(t); sr_[i].vs0 = *reinterpret_cast<const bf16x8*>(&Vh[(long)(k0_ + sr) * LDK + sc]); sr_[i].vs1 = *reinterpret_cast<const bf16x8*>(&Vh[(long)(k0_ + 32 + sr) * LDK + sc]); \
    sr_[i].ks0 = *reinterpret_cast<const bf16x8*>(&Kh[(long)(k0_ + sr) * LDK + sc]); sr_[i].ks1 = *reinterpret_cast<const bf16x8*>(&Kh[(long)(k0_ + 32 + sr) * LDK + sc]); } while (0)
#define SWRITE(b, i) do { *(bf16x8*)((char*)V_lds + (b) * SHM_V + vst0) = sr_[i].vs0;          \
    *(bf16x8*)((char*)V_lds + (b) * SHM_V + vst1) = sr_[i].vs1; int kc = sc * 2;               \
    *(bf16x8*)((char*)K_lds + (b) * SHM_K + KSWZ(sr, kc)) = sr_[i].ks0;                       \
    *(bf16x8*)((char*)K_lds + (b) * SHM_K + KSWZ(32 + sr, kc)) = sr_[i].ks1; } while (0)
#define SWAIT() do { if constexpr (SDEPTH == 2) asm volatile("s_waitcnt vmcnt(4)" ::: "memory"); else asm volatile("s_waitcnt vmcnt(0)" ::: "memory"); } while (0)
#define RESC(a) do { if (__any((a) < 1.f)) { if (hi == 0) al_l[r32] = (a); asm volatile("s_waitcnt lgkmcnt(0)" ::: "memory"); \
    for (int d = 0; d < 4; ++d) for (int r = 0; r < 16; ++r) o[d][r] *= al_l[crow(r, hi)]; } } while (0)
#define WMASK(P0, P1, t) do { if (WIN) { if ((t) >= 4) wmask(P0, P1, kstart + ((t) - 4) * KVBLK, qp, hi); } } while (0)
  f32x16 pA0, pA1, pB0, pB1; float mnA, mnB, alA, alB; bf16x8 pa0, pa1, pa2, pa3;
  constexpr int SE = 0, SO = SDEPTH - 1;
  SLOAD(SE, 0); asm volatile("s_waitcnt vmcnt(0)" ::: "memory"); SWRITE(0, SE); __syncthreads();
  qkt(pA0, pA1, K_lds, qr, r32, hi); WMASK(pA0, pA1, 0); partialSM(pA0, pA1, m_reg, mnA, alA);
  SLOAD(SO, 1); if constexpr (SDEPTH == 2) { if (2 < NT) SLOAD(SE, 2); }
  SWAIT(); SWRITE(1, SO); __syncthreads();
  for (int j = 1; j + 1 < NT; j += 2) {
    SBAR(); qkt(pB0, pB1, (bf16*)((char*)K_lds + SHM_K), qr, r32, hi); WMASK(pB0, pB1, j);
    finishSM(pA0, pA1, alA, l_reg, pa0, pa1, pa2, pa3); SBAR();
    SLOAD(SO, j + SDEPTH); SBAR();
    pv_d0(o, vb0, pa0, pa1, pa2, pa3); partialSM(pB0, pB1, m_reg, mnB, alB);
    __syncthreads(); SWAIT(); SWRITE(0, SE);
    RESC(alB); __syncthreads();
    SBAR(); qkt(pA0, pA1, K_lds, qr, r32, hi); WMASK(pA0, pA1, j + 1);
    finishSM(pB0, pB1, alB, l_reg, pa0, pa1, pa2, pa3); SBAR();
    if (SDEPTH == 1 || j + 3 < NT) SLOAD(SE, j + 1 + SDEPTH); SBAR();
    pv_d0(o, vb0 + (int)SHM_V, pa0, pa1, pa2, pa3); partialSM(pA0, pA1, m_reg, mnA, alA);
    __syncthreads(); SWAIT(); SWRITE(1, SO);
    RESC(alA); __syncthreads();
  }
  SBAR(); qkt(pB0, pB1, (bf16*)((char*)K_lds + SHM_K), qr, r32, hi); WMASK(pB0, pB1, NT - 1);
  finishSM(pA0, pA1, alA, l_reg, pa0, pa1, pa2, pa3); SBAR();
  pv_d0(o, vb0, pa0, pa1, pa2, pa3); partialSM(pB0, pB1, m_reg, mnB, alB);
  __syncthreads(); RESC(alB);
  finishSM(pB0, pB1, alB, l_reg, pa0, pa1, pa2, pa3); SBAR();
  pv_d0(o, vb0 + (int)SHM_V, pa0, pa1, pa2, pa3);
  if (WIN) { constexpr float C = SCALE * 1.4426950408889634f; l_reg += __builtin_amdgcn_exp2f(sink_l2 - m_reg * C); }
  if (hi == 0) li_l[r32] = l_reg; asm volatile("s_waitcnt lgkmcnt(0)" ::: "memory");
  float rli[16];
#pragma unroll
  for (int r = 0; r < 16; ++r) rli[r] = __builtin_amdgcn_rcpf(li_l[crow(r, hi)]);
  bf16* Ow = Qb + (long)(wid * QBLK) * LDQ;
#pragma unroll
  for (int r = 0; r < 16; ++r) { const int orow = crow(r, hi);
#pragma unroll
    for (int d0 = 0; d0 < 4; ++d0) { const float v = o[d0][r] * rli[r]; Ow[(long)orow * LDQ + d0 * 32 + r32] = (bf16)(cvtpk(v, v) & 0xffffu); } }
  __syncthreads();
#undef TROW
#undef SLOAD
#undef SWRITE
#undef SWAIT
#undef RESC
#undef WMASK
}
#undef KSWZ
#undef SBAR
}

namespace mk {
namespace cg = cooperative_groups;
typedef unsigned short bf16;
typedef short bf16x8 __attribute__((ext_vector_type(8)));
typedef float f32x4 __attribute__((ext_vector_type(4)));
typedef unsigned u32x4 __attribute__((ext_vector_type(4)));
typedef unsigned u32x2 __attribute__((ext_vector_type(2)));
typedef __bf16 bf2_t __attribute__((ext_vector_type(2)));
#define LAS __attribute__((address_space(3)))
constexpr int NWAVES = 8, NTHR = 512;
constexpr size_t MiB = 1u << 20;
constexpr size_t WS_CTL = 0, CTL_BYTES = 1 * MiB;
constexpr size_t WS_MOD = 1 * MiB;
constexpr size_t WS_XC = 2 * MiB;
constexpr size_t WS_WQKV = 6 * MiB;
constexpr size_t WS_WO = 12 * MiB;
constexpr size_t WS_WP = 16 * MiB;
constexpr size_t WS_H = 24 * MiB;
constexpr size_t WS_Q = 58 * MiB;
constexpr size_t WS_K = 92 * MiB;
constexpr size_t WS_V = 101 * MiB;
constexpr size_t WS_EIDX = 110 * MiB;
constexpr size_t WS_GATE = 119 * MiB;
constexpr size_t WS_PW = 128 * MiB;
constexpr size_t WS_S = 137 * MiB;
constexpr size_t WS_UT = 274 * MiB;
constexpr size_t WS_VT = 338 * MiB;
constexpr size_t WS_END = 402 * MiB;
constexpr int LDS_BYTES = 155648;
constexpr int NPHASE = 21;

struct Args { const float* in[17]; float* out; unsigned char* ws; int ph_lo, ph_hi; };

constexpr int PTAB_OFF = 153600;
struct Ctx {
  unsigned char* ws;
  int tid, lane, wave, bid, G;
  LAS unsigned char* lds; unsigned char* ldsg;
  __device__ __forceinline__ const float* in(int k) const {
    const volatile LAS unsigned* t = (const volatile LAS unsigned*)(lds + PTAB_OFF) + 2 * k;
    const unsigned lo = __builtin_amdgcn_readfirstlane(t[0]), hi = __builtin_amdgcn_readfirstlane(t[1]);
    return (const float*)(((unsigned long long)hi << 32) | lo);
  }
  __device__ __forceinline__ float* outp() const { return (float*)in(17); }
};
enum { I_X = 0, I_C, I_CTX, I_CCTX, I_ADAW, I_ADAB, I_N1G, I_N2G, I_WQKV, I_QNG, I_KNG, I_WO, I_SINKS, I_PWQ, I_PSK, I_PU, I_PV };

__device__ __forceinline__ unsigned f2bf(float f) { unsigned u = __builtin_bit_cast(unsigned, f); return (u + 0x7fffu + ((u >> 16) & 1u)) >> 16; }
__device__ __forceinline__ unsigned pk2(float lo, float hi) { unsigned r; asm volatile("v_cvt_pk_bf16_f32 %0, %1, %2" : "=v"(r) : "v"(lo), "v"(hi)); return r; }
__device__ __forceinline__ float bflo(unsigned u) { return __uint_as_float(u << 16); }
__device__ __forceinline__ float bfhi(unsigned u) { return __uint_as_float(u & 0xffff0000u); }
__device__ __forceinline__ float silu(float x) { return x / (1.f + __expf(-x)); }
__device__ __forceinline__ float gelu_tanh(float x) {
  const float y = 0.7978845608028654f * (x + 0.044715f * x * x * x);
  const float t = 1.f - 2.f / (__expf(2.f * y) + 1.f);
  return 0.5f * x * (1.f + t);
}
__device__ __forceinline__ float wave_sum(float v) {
#pragma unroll
  for (int o = 1; o < 64; o <<= 1) v += __shfl_xor(v, o);
  return v;
}
__device__ __forceinline__ const float* xrow_sel(const float* lat, const float* cx, int r) { const int b = r / RPB, j = r % RPB; return j < CTXL ? cx + (size_t)(b * CTXL + j) * DM : lat + (size_t)(b * SEQ + (j - CTXL)) * DM; }
__device__ __forceinline__ int mod_row(int r) { const int b = r / RPB, j = r % RPB; return j < CTXL ? 4 : b; }

__device__ __forceinline__ void p0_transpose_item(const float* W, int K, int N, bf16* WT, LAS float* scr, int item, int lane) {
  const int nblk = N / 32, kb = item / nblk, nb = item % nblk, k0 = 64 * kb, n0 = 32 * nb;
#pragma unroll 8
  for (int i = 0; i < 32; ++i) { const int kk = 2 * i + (lane >> 5); scr[kk * 33 + (lane & 31)] = W[(size_t)(k0 + kk) * N + n0 + (lane & 31)]; }
  asm volatile("s_waitcnt lgkmcnt(0)" ::: "memory");
  const int c = lane & 7;
#pragma unroll
  for (int j = 0; j < 4; ++j) { const int n = (lane >> 3) + 8 * j; const LAS float* s = scr + (8 * c) * 33 + n;
    u32x4 o; o.x = pk2(s[0 * 33], s[1 * 33]); o.y = pk2(s[2 * 33], s[3 * 33]); o.z = pk2(s[4 * 33], s[5 * 33]); o.w = pk2(s[6 * 33], s[7 * 33]);
    *(u32x4*)(WT + (size_t)(n0 + n) * K + k0 + 8 * c) = o; }
  asm volatile("s_waitcnt lgkmcnt(0)" ::: "memory");
}

__device__ __forceinline__ void phase_prologue(const Ctx& F) {
  { LAS float* sl = (LAS float*)F.lds;
    LAS float* red = sl + 5 * DM;
    { const float* cp = F.in(I_C); const float* ccp = F.in(I_CCTX);
      for (int e = F.tid; e < 5 * DM; e += NTHR) { const int r = e / DM, j = e % DM; sl[e] = silu(r < 4 ? cp[r * DM + j] : ccp[j]); } }
    __syncthreads();
    const float* adaw = F.in(I_ADAW); const float* adab = F.in(I_ADAB);
    for (int task = F.bid; task < DEPTH * 96; task += F.G) {
      const int i = task / 96, n = (task % 96) * 64 + F.lane;
      const float* w = adaw + (size_t)i * DM * NMOD * DM + n;
      float a0 = 0.f, a1 = 0.f, a2 = 0.f, a3 = 0.f, a4 = 0.f;
#pragma unroll 8
      for (int jj = 0; jj < 128; ++jj) { const int j = F.wave * 128 + jj; const float wv = w[(size_t)j * NMOD * DM];
        a0 += sl[j] * wv; a1 += sl[DM + j] * wv; a2 += sl[2 * DM + j] * wv; a3 += sl[3 * DM + j] * wv; a4 += sl[4 * DM + j] * wv; }
      red[(F.wave * 5 + 0) * 64 + F.lane] = a0; red[(F.wave * 5 + 1) * 64 + F.lane] = a1; red[(F.wave * 5 + 2) * 64 + F.lane] = a2;
      red[(F.wave * 5 + 3) * 64 + F.lane] = a3; red[(F.wave * 5 + 4) * 64 + F.lane] = a4;
      __syncthreads();
      if (F.tid < 320) { const int r = F.tid >> 6, l = F.tid & 63; float s = 0.f;
#pragma unroll
        for (int w8 = 0; w8 < 8; ++w8) s += red[(w8 * 5 + r) * 64 + l];
        const int nn = (task % 96) * 64 + l;
        ((float*)(F.ws + WS_MOD))[((size_t)i * 5 + r) * NMOD * DM + nn] = s + adab[i * NMOD * DM + nn]; }
      __syncthreads();
    }
  }
  { LAS float* sk = (LAS float*)F.lds;
    LAS float* wq = sk + 128 * 132;
    const float* pskp = F.in(I_PSK); const float* pwqp = F.in(I_PWQ);
    for (int task = F.bid; task < DEPTH * 8 * 2 * 16; task += F.G) {
      const int jc = task & 15, half = (task >> 4) & 1, h = (task >> 5) & 7, i = task >> 8;
      const float* SK = pskp + ((size_t)i * 2 + half) * NKEYS * 128;
      const float* WQ = pwqp + (size_t)i * DM * PQN + (size_t)(jc * 64) * PQN + h * PQD + half * 128;
      for (int e = F.tid; e < 128 * 32; e += NTHR) { const int kk = e >> 5, d4 = e & 31; const f32x4 v = *(const f32x4*)(SK + (size_t)kk * 128 + d4 * 4); *(LAS f32x4*)(sk + kk * 132 + d4 * 4) = v; }
      for (int e = F.tid; e < 64 * 32; e += NTHR) { const int j = e >> 5, d4 = e & 31; const f32x4 v = *(const f32x4*)(WQ + (size_t)j * PQN + d4 * 4); *(LAS f32x4*)(wq + j * 128 + d4 * 4) = v; }
      __syncthreads();
      const int kk = F.tid & 127, jg = F.tid >> 7;
      float acc[16];
#pragma unroll
      for (int q = 0; q < 16; ++q) acc[q] = 0.f;
#pragma unroll 2
      for (int d4 = 0; d4 < 32; ++d4) { const f32x4 s = *(const LAS f32x4*)(sk + kk * 132 + d4 * 4);
#pragma unroll
        for (int q = 0; q < 16; ++q) { const f32x4 w = *(const LAS f32x4*)(wq + (jg * 16 + q) * 128 + d4 * 4); acc[q] += s.x * w.x + s.y * w.y + s.z * w.z + s.w * w.w; } }
      bf16* o = (bf16*)(F.ws + WS_WP) + ((size_t)i * PQN + h * PQD + half * 128 + kk) * DM + jc * 64 + jg * 16;
      u32x4 o0, o1; o0.x = pk2(acc[0], acc[1]); o0.y = pk2(acc[2], acc[3]); o0.z = pk2(acc[4], acc[5]); o0.w = pk2(acc[6], acc[7]);
      o1.x = pk2(acc[8], acc[9]); o1.y = pk2(acc[10], acc[11]); o1.z = pk2(acc[12], acc[13]); o1.w = pk2(acc[14], acc[15]);
      *(u32x4*)o = o0; *(u32x4*)(o + 8) = o1;
      __syncthreads();
    }
  }
  { LAS float* scr = (LAS float*)F.lds + F.wave * (64 * 33 + 16);
    const int gw = F.bid * NWAVES + F.wave, NGW = F.G * NWAVES;
    constexpr int I_QKV = (DM / 64) * (QKVD / 32), I_O = (DM / 64) * (DM / 32);
    const float* wqkvp = F.in(I_WQKV); const float* wop = F.in(I_WO);
    for (int it = gw; it < DEPTH * (I_QKV + I_O); it += NGW) {
      const int i = it / (I_QKV + I_O); int r = it % (I_QKV + I_O);
      if (r < I_QKV) p0_transpose_item(wqkvp + (size_t)i * DM * QKVD, DM, QKVD, (bf16*)(F.ws + WS_WQKV) + (size_t)i * QKVD * DM, scr, r, F.lane);
      else p0_transpose_item(wop + (size_t)i * DM * DM, DM, DM, (bf16*)(F.ws + WS_WO) + (size_t)i * DM * DM, scr, r - I_QKV, F.lane);
    }
  }
  { const size_t n8 = (size_t)DEPTH * NKEYS * NKEYS * DM / 8;
    const size_t gt = (size_t)F.bid * NTHR + F.tid, GT = (size_t)F.G * NTHR;
    const float* pup = F.in(I_PU); const float* pvp = F.in(I_PV);
    for (size_t e = gt; e < 2 * n8; e += GT) { const bool isu = e < n8; const size_t j = isu ? e : e - n8;
      const float* src = (isu ? pup : pvp) + j * 8; const f32x4 a = *(const f32x4*)src, b = *(const f32x4*)(src + 4);
      u32x4 o; o.x = pk2(a.x, a.y); o.y = pk2(a.z, a.w); o.z = pk2(b.x, b.y); o.w = pk2(b.z, b.w);
      *(u32x4*)((bf16*)(F.ws + (isu ? WS_UT : WS_VT)) + j * 8) = o; }
  }
}

__device__ __forceinline__ void phase_norm(const Ctx& F, int layer, int which  , bool from_input, bool latent_only) {
  const int gw = F.bid * NWAVES + F.wave, NGW = F.G * NWAVES;
  const float* gain = (which == 0 ? F.in(I_N1G) : F.in(I_N2G)) + layer * DM;
  const float* modl = (const float*)(F.ws + WS_MOD) + (size_t)layer * 5 * NMOD * DM;
  bf16* H = (bf16*)(F.ws + WS_H);
  const float* latp = from_input ? F.in(I_X) : (const float*)F.outp(); const float* cxp = from_input ? F.in(I_CTX) : (const float*)(F.ws + WS_XC);
  for (int r = gw; r < NROWS; r += NGW) {
    if (latent_only && (r % RPB) < CTXL) continue;
    const float* xr = xrow_sel(latp, cxp, r);
    const float* mrow = modl + (size_t)mod_row(r) * NMOD * DM;
    const float* sh = mrow + (which == 0 ? 0 : 3) * DM; const float* sc = mrow + (which == 0 ? 1 : 4) * DM;
    f32x4 v[4]; float s = 0.f;
#pragma unroll
    for (int j = 0; j < 4; ++j) { v[j] = ((const f32x4*)xr)[F.lane + 64 * j]; s += (v[j].x * v[j].x + v[j].y * v[j].y) + (v[j].z * v[j].z + v[j].w * v[j].w); }
    const float rstd = rsqrtf(wave_sum(s) * (1.f / DM) + RMS_EPS);
    unsigned long long* o8 = (unsigned long long*)(H + (size_t)r * DM) + F.lane;
#pragma unroll
    for (int j = 0; j < 4; ++j) { const f32x4 g = ((const f32x4*)gain)[F.lane + 64 * j], a = ((const f32x4*)sc)[F.lane + 64 * j], b = ((const f32x4*)sh)[F.lane + 64 * j];
      const float y0 = v[j].x * rstd * g.x * (1.f + a.x) + b.x, y1 = v[j].y * rstd * g.y * (1.f + a.y) + b.y, y2 = v[j].z * rstd * g.z * (1.f + a.z) + b.z, y3 = v[j].w * rstd * g.w * (1.f + a.w) + b.w;
      o8[64 * j] = (unsigned long long)pk2(y0, y1) | ((unsigned long long)pk2(y2, y3) << 32); }
  }
}

__device__ __forceinline__ void phase_qknorm(const Ctx& F, int layer) {
  const int gw = F.bid * NWAVES + F.wave, NGW = F.G * NWAVES;
  const int axis = F.lane >> 5, f = F.lane & 31, e1 = axis * 64 + f, e2 = e1 + 32;
  const float* qg = F.in(I_QNG) + layer * HD; const float* kg = F.in(I_KNG) + layer * HD;
  const float qg1 = qg[e1], qg2 = qg[e2], kg1 = kg[e1], kg2 = kg[e2];
  const float inv = exp2f(-(float)(2 * f) * (13.287712379549449f / 64.f));
  bf16* Q = (bf16*)(F.ws + WS_Q); bf16* K = (bf16*)(F.ws + WS_K);
  for (int r = gw; r < NROWS; r += NGW) {
    const int j = r % RPB; float cs = 1.f, sn = 0.f;
    if (j >= CTXL) { const int sp = j - CTXL; const float pos = (float)(axis == 0 ? (sp >> 6) : (sp & 63)); sincosf(pos * inv, &sn, &cs); }
#pragma unroll
    for (int h = 0; h < NH + NKV; ++h) {
      bf16* base = h < NH ? Q + (size_t)r * DM + h * HD : K + (size_t)r * (NKV * HD) + (h - NH) * HD;
      float x1 = bflo(base[e1]), x2 = bflo(base[e2]);
      const float rstd = rsqrtf(wave_sum(x1 * x1 + x2 * x2) * (1.f / HD) + RMS_EPS);
      x1 *= rstd * (h < NH ? qg1 : kg1); x2 *= rstd * (h < NH ? qg2 : kg2);
      const float y1 = x1 * cs - x2 * sn, y2 = x1 * sn + x2 * cs;
      base[e1] = (bf16)f2bf(y1); base[e2] = (bf16)f2bf(y2);
    }
  }
}
struct Order {
  int nM, nN, nwg, G, c, lat;
  __device__ void init(int nM_, int nN_, int G_, int c_, int lat_) { nM = nM_; nN = nN_; nwg = nM * nN; G = G_; c = c_; lat = lat_; }
  __device__ bool next(int i, pg8::Unit& u) const {
    const long L = (long)i * G + c; if (L >= nwg) return false;
    int wgid = (int)L; { const int q = nwg / 8, r = nwg % 8, xcd = wgid % 8, off = wgid / 8; wgid = (xcd < r ? xcd * (q + 1) : r * (q + 1) + (xcd - r) * q) + off; }
    const int WGM = 8, nig = WGM * nN, gid = wgid / nig, fm = gid * WGM, gsz = (nM - fm) < WGM ? (nM - fm) : WGM;
    int pm = fm + ((wgid % nig) % gsz); u.pn = (wgid % nig) / gsz;
    if (lat) pm = (pm >> 4) * 17 + 1 + (pm & 15);
    u.pm = pm; return true;
  }
  __device__ __forceinline__ void a_ready(const pg8::Unit&) const {}
  __device__ __forceinline__ void done(const pg8::Unit&) const {}
};
struct EpiQKV {
  static constexpr bool PERM = true, AFTER_DRAIN = false;
  unsigned char* ws;
  __device__ __forceinline__ void operator()(const pg8::f32x4 (&acc)[2][2][4][2], const pg8::Unit& u, int wr, int wc, int fr, int fq) const {
    const int row0 = u.pm * 256 + wr * 64 + fr;
    const size_t boff = u.pn < 4 ? WS_Q : (u.pn == 4 ? WS_K : WS_V); const int ldc = u.pn < 4 ? DM : NKV * HD, colt = u.pn < 4 ? u.pn * 256 : 0;
    bf16* base = (bf16*)(ws + boff);
    const int col0 = colt + wc * 32 + 8 * fq;
#pragma unroll
    for (int ai = 0; ai < 2; ++ai)
#pragma unroll
      for (int m = 0; m < 4; ++m) { bf16* rowp = base + (size_t)(row0 + ai * 128 + m * 16) * ldc + col0;
#pragma unroll
        for (int bj = 0; bj < 2; ++bj) { const pg8::f32x4 v0 = acc[ai][bj][m][0], v1 = acc[ai][bj][m][1];
          u32x4 w; w.x = pk2(v0[0], v0[1]); w.y = pk2(v0[2], v0[3]); w.z = pk2(v1[0], v1[1]); w.w = pk2(v1[2], v1[3]);
          *(u32x4*)(rowp + bj * 128) = w; } }
  }
};
struct EpiRes {
  static constexpr bool PERM = false, AFTER_DRAIN = false;
  const float *xin, *cin; float *xout, *xc; const float* gmod  ; bool from_input;
  __device__ __forceinline__ void operator()(const pg8::f32x4 (&acc)[2][2][4][2], const pg8::Unit& u, int wr, int wc, int fr, int fq) const {
    const int col0 = u.pn * 256 + wc * 32 + 4 * fq;
#pragma unroll
    for (int ai = 0; ai < 2; ++ai)
#pragma unroll
      for (int m = 0; m < 4; ++m) { const int r = u.pm * 256 + ai * 128 + wr * 64 + m * 16 + fr;
        const int b_ = r / RPB, j_ = r % RPB; const size_t oc = (size_t)(b_ * CTXL + j_) * DM, ol = (size_t)(b_ * SEQ + (j_ - CTXL)) * DM;
        float* xn = j_ < CTXL ? xc + oc : xout + ol; const float* xo = from_input ? (j_ < CTXL ? cin + oc : xin + ol) : xn; const float* g = gmod + (size_t)(j_ < CTXL ? 4 : b_) * NMOD * DM;
#pragma unroll
        for (int bj = 0; bj < 2; ++bj)
#pragma unroll
          for (int n = 0; n < 2; ++n) { const int c = col0 + bj * 128 + n * 16; const f32x4 xv = *(const f32x4*)(xo + c), gv = *(const f32x4*)(g + c); const pg8::f32x4 a = acc[ai][bj][m][n];
            f32x4 o; o.x = xv.x + gv.x * a[0]; o.y = xv.y + gv.y * a[1]; o.z = xv.z + gv.z * a[2]; o.w = xv.w + gv.w * a[3]; *(f32x4*)(xn + c) = o; } }
  }
};
struct EpiF32 {
  static constexpr bool PERM = false, AFTER_DRAIN = false;
  float* S; int ldc;
  __device__ __forceinline__ void operator()(const pg8::f32x4 (&acc)[2][2][4][2], const pg8::Unit& u, int wr, int wc, int fr, int fq) const {
    const int col0 = u.pn * 256 + wc * 32 + 4 * fq;
#pragma unroll
    for (int ai = 0; ai < 2; ++ai)
#pragma unroll
      for (int m = 0; m < 4; ++m) { float* rowp = S + (size_t)(u.pm * 256 + ai * 128 + wr * 64 + m * 16 + fr) * ldc + col0;
#pragma unroll
        for (int bj = 0; bj < 2; ++bj)
#pragma unroll
          for (int n = 0; n < 2; ++n) { const pg8::f32x4 a = acc[ai][bj][m][n]; f32x4 o; o.x = a[0]; o.y = a[1]; o.z = a[2]; o.w = a[3]; *(f32x4*)(rowp + bj * 128 + n * 16) = o; } }
  }
};

__device__ __forceinline__ void phase_attn(const Ctx& F, int layer) {
  bf16* Q = (bf16*)(F.ws + WS_Q); const bf16* K = (const bf16*)(F.ws + WS_K); const bf16* V = (const bf16*)(F.ws + WS_V);
  char* lds = (char*)F.ldsg;
  const int pair = F.bid & 7, slot = F.bid >> 3, nslot = F.G >> 3;
  const int b = pair >> 1, g = pair & 1;
  const bf16* Kh = K + (size_t)(b * RPB) * (NKV * HD) + g * HD; const bf16* Vh = V + (size_t)(b * RPB) * (NKV * HD) + g * HD;
  const float* sinkp = F.in(I_SINKS);
  const int nunits = layer == 0 ? 68 : 64;
#pragma unroll 1
  for (int u = slot; u < nunits; u += nslot) {
    int h, NT, ks = 0, q0 = 0; float sk = 0.f; bf16* Qb; const bool win = layer != 0;
    if (u < 64) { h = g * 4 + (u >> 4); const int qb = u & 15; Qb = Q + (size_t)(b * RPB + CTXL + qb * 256) * DM + h * HD;
      if (!win) NT = RPB / 64;
      else { q0 = qb * 256; ks = q0 - 128 < 0 ? 0 : q0 - 128; const int ke = q0 + 384 > SEQ ? SEQ : q0 + 384; NT = 4 + (ke - ks) / 64; sk = sinkp[(layer / 2) * NH + h] * 1.4426950408889634f; } }
    else { h = g * 4 + (u - 64); Qb = Q + (size_t)(b * RPB) * DM + h * HD; NT = CTXL / 64; }
    att::attn_unit(win, Qb, Kh, Vh, NT, ks, q0, sk, lds);
  }
}

__device__ __forceinline__ void ins16(float (&v)[16], float x) {
#pragma unroll
  for (int i = 0; i < 16; ++i) { const float hi = fmaxf(v[i], x); x = fminf(v[i], x); v[i] = hi; }
}
__device__ __forceinline__ void phase_topk(const Ctx& F, bool latent_only) {
  LAS float* sc = (LAS float*)F.lds;
  LAS unsigned* T = (LAS unsigned*)(F.lds + 512 * 65 * 4);
  const float* S = (const float*)(F.ws + WS_S); int* EIDX = (int*)(F.ws + WS_EIDX); float* GATE = (float*)(F.ws + WS_GATE);
  const int ngroups = NROWS / 16;
  for (int grp = F.bid; grp < ngroups; grp += F.G) {
    const int r0 = grp * 16;
    if (latent_only && (r0 % RPB) < CTXL) continue;
#pragma unroll 4
    for (int it = 0; it < 16; ++it) { const int e4 = it * NTHR + F.tid, rl = e4 >> 9, c = (e4 & 511) * 4;
      const f32x4 v = *(const f32x4*)(S + (size_t)(r0 + rl) * PQN + c); LAS float* d = sc + (rl * 32 + (c >> 6)) * 65 + (c & 63);
      d[0] = v.x; d[1] = v.y; d[2] = v.z; d[3] = v.w; }
    __syncthreads();
    float v[16];
#pragma unroll
    for (int i = 0; i < 16; ++i) v[i] = -INFINITY;
    { const LAS float* my = sc + F.tid * 65; const unsigned eb = (F.tid & 1) * 64;
#pragma unroll 8
      for (int e = 0; e < 64; ++e) { const unsigned key = (__float_as_uint(my[e]) & ~127u) | (eb + e); ins16(v, __uint_as_float(key)); } }
    { float o[16];
#pragma unroll
      for (int i = 0; i < 16; ++i) o[i] = __shfl_xor(v[i], 1);
#pragma unroll
      for (int i = 0; i < 16; ++i) ins16(v, o[i]); }
    if ((F.tid & 1) == 0) {
#pragma unroll
      for (int i = 0; i < 16; ++i) T[(F.tid >> 1) * 16 + i] = __float_as_uint(v[i]); }
    __syncthreads();
    if (F.tid < 128) {
      const int rl = F.tid >> 3, head = F.tid & 7, p1 = (rl * 16 + head * 2) * 16, p2 = p1 + 16;
      float a[16], bq[16];
#pragma unroll
      for (int i = 0; i < 16; ++i) { a[i] = __uint_as_float(T[p1 + i] & ~127u); bq[i] = __uint_as_float(T[p2 + i] & ~127u); }
      float w[16];
#pragma unroll
      for (int i = 0; i < 16; ++i) w[i] = -INFINITY;
#pragma unroll
      for (int ia = 0; ia < 16; ++ia)
#pragma unroll
        for (int ib = 0; ib < 16; ++ib) if ((ia + 1) * (ib + 1) <= 16) { const float s = a[ia] + bq[ib]; ins16(w, __uint_as_float((__float_as_uint(s) & ~255u) | (unsigned)(ia * 16 + ib))); }
      float ts[16]; int ex[16];
#pragma unroll
      for (int k = 0; k < 16; ++k) { const unsigned id = __float_as_uint(w[k]) & 255u; const unsigned k1 = T[p1 + (id >> 4)], k2 = T[p2 + (id & 15)];
        ts[k] = __uint_as_float(k1 & ~127u) + __uint_as_float(k2 & ~127u); ex[k] = (int)((k1 & 127u) * NKEYS + (k2 & 127u)); }
      float m = ts[0];
#pragma unroll
      for (int k = 1; k < 16; ++k) m = fmaxf(m, ts[k]);
      float l = 0.f;
#pragma unroll
      for (int k = 0; k < 16; ++k) { ts[k] = __expf(ts[k] - m); l += ts[k]; }
      const float il = 1.f / l; const size_t ob = (size_t)(r0 + rl) * 128 + head * 16;
#pragma unroll
      for (int k = 0; k < 16; k += 4) { *(int4*)(EIDX + ob + k) = make_int4(ex[k], ex[k + 1], ex[k + 2], ex[k + 3]);
        f32x4 gv; gv.x = ts[k] * il; gv.y = ts[k + 1] * il; gv.z = ts[k + 2] * il; gv.w = ts[k + 3] * il; *(f32x4*)(GATE + ob + k) = gv; }
    }
    __syncthreads();
  }
}

__device__ __forceinline__ float dot2(unsigned a, unsigned b, float c) { return __builtin_amdgcn_fdot2_f32_bf16(__builtin_bit_cast(bf2_t, a), __builtin_bit_cast(bf2_t, b), c, false); }
__device__ __forceinline__ float dot8(u32x4 a, u32x4 b, float c) {
  const unsigned a0 = a.x, a1 = a.y, a2 = a.z, a3 = a.w, b0 = b.x, b1 = b.y, b2 = b.z, b3 = b.w;
  return dot2(a3, b3, dot2(a2, b2, dot2(a1, b1, dot2(a0, b0, c))));
}
__device__ __forceinline__ void phase_peer_u(const Ctx& F, int layer, bool latent_only) {
  const int gw = F.bid * NWAVES + F.wave, NGW = F.G * NWAVES;
  const bf16* H = (const bf16*)(F.ws + WS_H); const bf16* U = (const bf16*)(F.ws + WS_UT) + (size_t)layer * NKEYS * NKEYS * DM;
  const int* EIDX = (const int*)(F.ws + WS_EIDX); const float* GATE = (const float*)(F.ws + WS_GATE); float* PW = (float*)(F.ws + WS_PW);
  for (int r = gw; r < NROWS; r += NGW) {
    if (latent_only && (r % RPB) < CTXL) continue;
    const u32x4 hA = *(const u32x4*)(H + (size_t)r * DM + F.lane * 8), hB = *(const u32x4*)(H + (size_t)r * DM + 512 + F.lane * 8);
#pragma unroll 1
    for (int bt = 0; bt < 2; ++bt) {
      const int ev = EIDX[(size_t)r * 128 + bt * 64 + F.lane];
      float p[64];
#pragma unroll
      for (int j = 0; j < 64; ++j) { const int e = __builtin_amdgcn_readlane(ev, j); const bf16* ur = U + (size_t)e * DM + F.lane * 8;
        const u32x4 uA = *(const u32x4*)ur, uB = *(const u32x4*)(ur + 512); p[j] = dot8(uB, hB, dot8(uA, hA, 0.f)); }
#pragma unroll
      for (int j = 0; j < 32; ++j) { auto s = __builtin_amdgcn_permlane32_swap(__float_as_uint(p[j]), __float_as_uint(p[j + 32]), false, false); p[j] = __uint_as_float(s[0]) + __uint_as_float(s[1]); }
#pragma unroll
      for (int j = 0; j < 16; ++j) { auto s = __builtin_amdgcn_permlane16_swap(__float_as_uint(p[j]), __float_as_uint(p[j + 16]), false, false); p[j] = __uint_as_float(s[0]) + __uint_as_float(s[1]); }
#pragma unroll
      for (int m = 8; m >= 1; m >>= 1) {
        const bool up = (F.lane & m) != 0;
#pragma unroll
        for (int j = 0; j < m; ++j) { const float send = up ? p[j] : p[j + m], keep = up ? p[j + m] : p[j]; p[j] = keep + __shfl_xor(send, m); }
      }
      const size_t o = (size_t)r * 128 + bt * 64 + F.lane;
      PW[o] = GATE[o] * gelu_tanh(p[0]);
    }
  }
}

__device__ __forceinline__ void phase_peer_v(const Ctx& F, int layer, bool latent_only) {
  const int gw = F.bid * NWAVES + F.wave, NGW = F.G * NWAVES;
  const bf16* V = (const bf16*)(F.ws + WS_VT) + (size_t)layer * NKEYS * NKEYS * DM;
  const int* EIDX = (const int*)(F.ws + WS_EIDX); const float* PW = (const float*)(F.ws + WS_PW);
  const float* g2 = (const float*)(F.ws + WS_MOD) + (size_t)layer * 5 * NMOD * DM + 5 * DM;
  const float* outl = F.outp();
  for (int r = gw; r < NROWS; r += NGW) {
    if (latent_only && (r % RPB) < CTXL) continue;
    float acc[16];
#pragma unroll
    for (int q = 0; q < 16; ++q) acc[q] = 0.f;
#pragma unroll 1
    for (int bt = 0; bt < 2; ++bt) {
      const int ev = EIDX[(size_t)r * 128 + bt * 64 + F.lane]; const float wv = PW[(size_t)r * 128 + bt * 64 + F.lane];
#pragma unroll 16
      for (int j = 0; j < 64; ++j) { const int e = __builtin_amdgcn_readlane(ev, j); const float w = __uint_as_float(__builtin_amdgcn_readlane(__float_as_uint(wv), j));
        const bf16* vr = V + (size_t)e * DM + F.lane * 8; const u32x4 a = *(const u32x4*)vr, b = *(const u32x4*)(vr + 512);
        acc[0] += w * bflo(a.x); acc[1] += w * bfhi(a.x); acc[2] += w * bflo(a.y); acc[3] += w * bfhi(a.y); acc[4] += w * bflo(a.z); acc[5] += w * bfhi(a.z); acc[6] += w * bflo(a.w); acc[7] += w * bfhi(a.w);
        acc[8] += w * bflo(b.x); acc[9] += w * bfhi(b.x); acc[10] += w * bflo(b.y); acc[11] += w * bfhi(b.y); acc[12] += w * bflo(b.z); acc[13] += w * bfhi(b.z); acc[14] += w * bflo(b.w); acc[15] += w * bfhi(b.w); }
    }
    float* x = (float*)xrow_sel(outl, (const float*)(F.ws + WS_XC), r); const float* g = g2 + (size_t)mod_row(r) * NMOD * DM;
#pragma unroll
    for (int hf = 0; hf < 2; ++hf)
#pragma unroll
      for (int q = 0; q < 2; ++q) { const int c = hf * 512 + F.lane * 8 + q * 4; f32x4 xv = *(const f32x4*)(x + c); const f32x4 gv = *(const f32x4*)(g + c);
        xv.x += gv.x * acc[hf * 8 + q * 4 + 0]; xv.y += gv.y * acc[hf * 8 + q * 4 + 1]; xv.z += gv.z * acc[hf * 8 + q * 4 + 2]; xv.w += gv.w * acc[hf * 8 + q * 4 + 3]; *(f32x4*)(x + c) = xv; }
  }
}

#define XB_TMO      128
#define XB_XCNT(j)  (256  + 64 * (j))
#define XB_XSUB(j)  (1280 + 64 * (j))
#define XB_XGEN(j)  (2304 + 64 * (j))
#define XB_TOP      3328
#define XB_TOPGEN   3392
#define XCD_BAR_WORDS 3456
#define XB_SPIN_CAP (1u << 18)

__device__ __forceinline__ unsigned xb_ld(unsigned* p)              { return __hip_atomic_load(p, __ATOMIC_RELAXED, __HIP_MEMORY_SCOPE_AGENT); }
__device__ __forceinline__ unsigned xb_add(unsigned* p, unsigned v) { return __hip_atomic_fetch_add(p, v, __ATOMIC_RELAXED, __HIP_MEMORY_SCOPE_AGENT); }
__device__ __forceinline__ unsigned xb_xcc_id() { return (unsigned)__builtin_amdgcn_s_getreg((3 << 11) | 20) & 0xFu; }
#define XB_SPIN(cond, bar) do { unsigned _sp = 0; while (cond) { __builtin_amdgcn_s_sleep(1); \
    if ((++_sp & 255u) == 0u) { if (xb_ld(&(bar)[XB_TMO])) break; if (_sp > XB_SPIN_CAP) { atomicAdd(&(bar)[XB_TMO], 1u); break; } } } } while (0)

struct XcdBarrier {
    unsigned* bar; unsigned x;
    volatile LAS unsigned* st;
};

__device__ __forceinline__ XcdBarrier xcd_barrier_post(unsigned* bar, volatile LAS unsigned* st) {
    XcdBarrier b; b.bar = bar; b.x = xb_xcc_id(); b.st = st;
    if (threadIdx.x == 0) (void)xb_add(&bar[XB_XCNT(b.x)], 1u);
    return b;
}
__device__ __forceinline__ void xcd_barrier_complete(unsigned* bar, unsigned x, unsigned& nloc, unsigned& nx) {
    const unsigned G = gridDim.x * gridDim.y * gridDim.z;
    unsigned sum, cnt, mine, sp = 0u;
    for (;;) {
        sum = 0u; cnt = 0u; mine = 0u;
#pragma unroll
        for (unsigned j = 0; j < 16; ++j) { const unsigned c = xb_ld(&bar[XB_XCNT(j)]); sum += c; cnt += (c > 0u) ? 1u : 0u; mine = (j == x) ? c : mine; }
        if (sum == G) break;
        __builtin_amdgcn_s_sleep(1);
        if ((++sp & 255u) == 0u) { if (xb_ld(&bar[XB_TMO])) break; if (sp > XB_SPIN_CAP) { atomicAdd(&bar[XB_TMO], 1u); break; } }
    }
    nloc = mine > 0u ? mine : 1u; nx = cnt > 0u ? cnt : 1u;
}

__device__ __forceinline__ void xcd_barrier(const XcdBarrier& b) {
    asm volatile("s_waitcnt vmcnt(0)" ::: "memory");
    __syncthreads();
    if (threadIdx.x == 0) {
        unsigned* bar = b.bar;
        __builtin_amdgcn_s_waitcnt(0);
        unsigned nloc = b.st[0], nx = b.st[1];
        if (nloc == 0u) { xcd_barrier_complete(bar, b.x, nloc, nx); b.st[0] = nloc; b.st[1] = nx; }
        const unsigned old = xb_add(&bar[XB_XSUB(b.x)], 1u);
        const unsigned gen = old / nloc;
        if (old + 1u == (gen + 1u) * nloc) {
            __builtin_amdgcn_fence(__ATOMIC_RELEASE, "agent");
            asm volatile("s_waitcnt vmcnt(0)" ::: "memory");
            const unsigned og = xb_add(&bar[XB_TOP], 1u);
            const unsigned tg = og / nx;
            if (og + 1u == (tg + 1u) * nx) xb_add(&bar[XB_TOPGEN], 1u);
            else XB_SPIN(xb_ld(&bar[XB_TOPGEN]) == tg, bar);
            __builtin_amdgcn_fence(__ATOMIC_ACQUIRE, "agent");
            xb_add(&bar[XB_XGEN(b.x)], 1u);
            asm volatile("s_waitcnt vmcnt(0)" ::: "memory");
        } else {
            XB_SPIN(xb_ld(&bar[XB_XGEN(b.x)]) == gen, bar);
            __builtin_amdgcn_fence(__ATOMIC_ACQUIRE, "agent");
            asm volatile("s_waitcnt vmcnt(0)" ::: "memory");
        }
    }
    __syncthreads();
}


__global__ void __launch_bounds__(NTHR, 2) fwd(Args args) {
  extern __shared__ __attribute__((aligned(16))) unsigned char lds[];
  Ctx F;
  F.ws = args.ws; F.tid = threadIdx.x; F.lane = F.tid & 63; F.wave = __builtin_amdgcn_readfirstlane(F.tid >> 6); F.bid = blockIdx.x; F.G = gridDim.x;
  F.lds = (LAS unsigned char*)lds; F.ldsg = lds;
  if (F.tid < 18) { const unsigned long long p = F.tid < 17 ? (unsigned long long)args.in[F.tid] : (unsigned long long)args.out; ((LAS unsigned long long*)(F.lds + PTAB_OFF))[F.tid] = p; }
  __syncthreads();
  const int lo = args.ph_lo, hi = args.ph_hi;
#ifndef PHMASK
#define PHMASK 0x7ff
#endif
#define IN(k) (lo <= (k) && (k) < hi)
#define EN(b) ((PHMASK >> (b)) & 1)
#define FRESH() do { int t_ = threadIdx.x; asm volatile("" : "+v"(t_)); F.tid = t_; F.lane = t_ & 63; F.wave = __builtin_amdgcn_readfirstlane(t_ >> 6); int b_ = blockIdx.x; asm volatile("" : "+s"(b_)); F.bid = b_; } while (0)
  if (F.tid < 4) ((LAS unsigned*)(F.lds + PTAB_OFF + 256))[F.tid] = 0u;
  __syncthreads();
  XcdBarrier xb; xb.bar = (unsigned*)(F.ws + WS_CTL) + 4096; xb.x = 0; xb.st = nullptr;
  if (hi - lo > 1) xb = xcd_barrier_post((unsigned*)(F.ws + WS_CTL) + 4096, (volatile LAS unsigned*)(F.lds + PTAB_OFF + 256));
#ifndef SEAM_CG_ALL
#define SEAM_CG_ALL 0
#endif
#define SEAM(k) do { if (IN(k) && IN((k) + 1)) { if (SEAM_CG_ALL || (k) == 0) cg::this_grid().sync(); else xcd_barrier(xb); } } while (0)
  if (EN(10) && IN(0)) { FRESH(); phase_prologue(F); } SEAM(0);
#pragma unroll 1
  for (int layer = 0; layer < DEPTH; ++layer) {
    const int pb = 1 + 10 * layer; const bool last = layer == DEPTH - 1;
    const float* modl = (const float*)(F.ws + WS_MOD) + (size_t)layer * 5 * NMOD * DM;
    if (EN(0) && IN(pb + 0)) { FRESH(); phase_norm(F, layer, 0, layer == 0, false); } SEAM(pb + 0);
    if (EN(1) && IN(pb + 1)) { FRESH(); pg8::Gemm g{(const pg8::bf16_t*)(F.ws + WS_H), (const pg8::bf16_t*)(F.ws + WS_WQKV) + (size_t)layer * QKVD * DM, NROWS, QKVD, DM};
      Order S; S.init(NROWS / 256, QKVD / 256, F.G, F.bid, 0); EpiQKV E{F.ws};
      pg8::gemm_phase<EpiQKV, Order, true, true>(F.lds, g, S, E); } SEAM(pb + 1);
    if (EN(2) && IN(pb + 2)) { FRESH(); phase_qknorm(F, layer); } SEAM(pb + 2);
    if (EN(3) && IN(pb + 3)) { FRESH(); phase_attn(F, layer); } SEAM(pb + 3);
    if (EN(4) && IN(pb + 4)) { FRESH(); pg8::Gemm g{(const pg8::bf16_t*)(F.ws + WS_Q), (const pg8::bf16_t*)(F.ws + WS_WO) + (size_t)layer * DM * DM, NROWS, DM, DM};
      Order S; S.init(last ? NB * 16 : NROWS / 256, DM / 256, F.G, F.bid, last ? 1 : 0); EpiRes E{F.in(I_X), F.in(I_CTX), F.outp(), (float*)(F.ws + WS_XC), modl + 2 * DM, layer == 0};
      pg8::gemm_phase<EpiRes, Order, true, true>(F.lds, g, S, E); } SEAM(pb + 4);
    if (EN(5) && IN(pb + 5)) { FRESH(); phase_norm(F, layer, 1, false, last); } SEAM(pb + 5);
    if (EN(6) && IN(pb + 6)) { FRESH(); pg8::Gemm g{(const pg8::bf16_t*)(F.ws + WS_H), (const pg8::bf16_t*)(F.ws + WS_WP) + (size_t)layer * PQN * DM, NROWS, PQN, DM};
      Order S; S.init(last ? NB * 16 : NROWS / 256, PQN / 256, F.G, F.bid, last ? 1 : 0); EpiF32 E{(float*)(F.ws + WS_S), PQN};
      pg8::gemm_phase<EpiF32, Order, true, true>(F.lds, g, S, E); } SEAM(pb + 6);
    if (EN(7) && IN(pb + 7)) { FRESH(); phase_topk(F, last); } SEAM(pb + 7);
    if (EN(8) && IN(pb + 8)) { FRESH(); phase_peer_u(F, layer, last); } SEAM(pb + 8);
    if (EN(9) && IN(pb + 9)) { FRESH(); phase_peer_v(F, layer, last); } if (!last) SEAM(pb + 9);
  }
#undef IN
#undef SEAM
}
}

#ifndef MK_MULTI
#define MK_MULTI 0
#endif
#ifndef DBG
#define DBG 0
#endif
namespace dbg {
template <bool ABF>
__global__ void __launch_bounds__(1024) k_cmp(const void* __restrict__ a, long lda, long aoff, const float* __restrict__ b, long ldb, long boff, int rows, int cols, int row0, int rstep_lat  , float* res) {
  __shared__ float sd[1024], sr[1024];
  float d2 = 0.f, r2 = 0.f;
  for (long e = threadIdx.x; e < (long)rows * cols; e += 1024) { const int r = row0 + (int)(e / cols), c = (int)(e % cols);
    if (rstep_lat == 1 && (r % RPB) < CTXL) continue; if (rstep_lat == 2 && (r % RPB) >= CTXL) continue;
    float av; if (ABF) av = __uint_as_float((unsigned)((const unsigned short*)a)[(long)r * lda + aoff + c] << 16); else av = ((const float*)a)[(long)r * lda + aoff + c];
    const float bv = b[(long)r * ldb + boff + c]; d2 += (av - bv) * (av - bv); r2 += bv * bv; }
  sd[threadIdx.x] = d2; sr[threadIdx.x] = r2; __syncthreads();
  for (int o = 512; o > 0; o >>= 1) { if ((int)threadIdx.x < o) { sd[threadIdx.x] += sd[threadIdx.x + o]; sr[threadIdx.x] += sr[threadIdx.x + o]; } __syncthreads(); }
  if (threadIdx.x == 0) *res = sqrtf(sd[0] / fmaxf(sr[0], 1e-30f));
}
__global__ void __launch_bounds__(1024) k_cmp_scores(const float* __restrict__ S, const float* __restrict__ PQ, const float* __restrict__ SK, int nrows, float* res) {
  __shared__ float sd[1024], sr[1024];
  float d2 = 0.f, r2 = 0.f;
  for (long e = threadIdx.x; e < (long)nrows * PQN; e += 1024) { const int r = (int)(e / PQN), c = (int)(e % PQN), h = c >> 8, half = (c >> 7) & 1, k = c & 127;
    const float* q = PQ + (long)r * PQN + h * PQD + half * 128; const float* kp = SK + (long)half * NKEYS * 128 + (long)k * 128; float a = 0.f; for (int d = 0; d < 128; ++d) a += q[d] * kp[d];
    const float f = S[(long)r * PQN + c]; d2 += (f - a) * (f - a); r2 += a * a; }
  sd[threadIdx.x] = d2; sr[threadIdx.x] = r2; __syncthreads();
  for (int o = 512; o > 0; o >>= 1) { if ((int)threadIdx.x < o) { sd[threadIdx.x] += sd[threadIdx.x + o]; sr[threadIdx.x] += sr[threadIdx.x + o]; } __syncthreads(); }
  if (threadIdx.x == 0) *res = sqrtf(sd[0] / fmaxf(sr[0], 1e-30f));
}
__global__ void k_final(float* out, long n, const float* res) {
  const float sa = 1.f + 10.f * res[0];
  for (long i = blockIdx.x * 256L + threadIdx.x; i < n; i += gridDim.x * 256L) out[i] *= sa;
  if (blockIdx.x == 0 && threadIdx.x == 0) { }
}
__global__ void k_final2(float* out, const float* res) { out[0] += 1000.f * (res[1] + res[2]); }
}

static void run_naive(void* const* d_in, float* out, char* ws, hipStream_t stream, int slayer, int stop) {
  const float* x = (const float*)d_in[0]; const float* c = (const float*)d_in[1]; const float* ctx = (const float*)d_in[2]; const float* c_ctx = (const float*)d_in[3];
  const float* ada_w = (const float*)d_in[4]; const float* ada_b = (const float*)d_in[5]; const float* n1g = (const float*)d_in[6]; const float* n2g = (const float*)d_in[7];
  const float* w_qkv = (const float*)d_in[8]; const float* qng = (const float*)d_in[9]; const float* kng = (const float*)d_in[10]; const float* w_o = (const float*)d_in[11];
  const float* sinks = (const float*)d_in[12]; const float* pwq = (const float*)d_in[13]; const float* psk = (const float*)d_in[14]; const float* pu = (const float*)d_in[15];
  const float* pv = (const float*)d_in[16];
  constexpr size_t MiB = 1u << 20;
  float* MOD = (float*)(ws + 0); float* XC = (float*)(ws + 1 * MiB); int* EIDX = (int*)(ws + 6 * MiB); float* GATE = (float*)(ws + 15 * MiB); float* PW = (float*)(ws + 24 * MiB);
  float* H = (float*)(ws + 34 * MiB); float* QKV = (float*)(ws + 104 * MiB); float* O = (float*)(ws + 242 * MiB); float* PQ = QKV;
  hipFuncSetAttribute((const void*)nv::k_attn, hipFuncAttributeMaxDynamicSharedMemorySize, (4 * RPB + 4 * HD) * 4);
  hipMemcpyAsync(out, x, (size_t)NB * SEQ * DM * 4, hipMemcpyDeviceToDevice, stream);
  hipMemcpyAsync(XC, ctx, (size_t)NB * CTXL * DM * 4, hipMemcpyDeviceToDevice, stream);
  nv::k_mod<<<(DEPTH * 5 * NMOD * DM + 255) / 256, 256, 0, stream>>>(c, c_ctx, ada_w, ada_b, MOD);
  for (int i = 0; i < DEPTH; ++i) {
#define STOP(k) if (i == slayer && stop == (k)) return
    const bool last = i == DEPTH - 1; const float* modi = MOD + (size_t)i * 5 * NMOD * DM;
    STOP(1); nv::k_norm<<<NROWS, 256, 0, stream>>>(out, XC, n1g + i * DM, modi, 0, 1, H);
    STOP(2); nv::k_gemm<0><<<dim3(QKVD / 64, NROWS / 64), 256, 0, stream>>>(H, w_qkv + (size_t)i * DM * QKVD, QKV, NROWS, QKVD, DM, nullptr, nullptr, nullptr, 0, 0);
    STOP(3); nv::k_qknorm_rope<<<NROWS, 640, 0, stream>>>(QKV, qng + i * HD, kng + i * HD);
    STOP(4); const size_t shm = (4 * RPB + 4 * HD) * 4;
    if (i % 2 == 0) { nv::k_attn<<<dim3(NB * SEQ, NKV), 256, shm, stream>>>(QKV, 0, nullptr); if (!last) nv::k_attn<<<dim3(NB * CTXL, NKV), 256, shm, stream>>>(QKV, 1, nullptr); }
    else { nv::k_attn<<<dim3(NB * SEQ, NKV), 256, shm, stream>>>(QKV, 2, sinks + (i / 2) * NH); }
    STOP(5); nv::k_copy_o<<<NROWS, 256, 0, stream>>>(QKV, O);
    nv::k_gemm<1><<<dim3(DM / 64, NROWS / 64), 256, 0, stream>>>(O, w_o + (size_t)i * DM * DM, nullptr, NROWS, DM, DM, out, XC, modi, 2, last ? 1 : 0);
    STOP(6); nv::k_norm<<<NROWS, 256, 0, stream>>>(out, XC, n2g + i * DM, modi, 3, 4, H);
    STOP(7); nv::k_gemm<0><<<dim3(PQN / 64, NROWS / 64), 256, 0, stream>>>(H, pwq + (size_t)i * DM * PQN, PQ, NROWS, PQN, DM, nullptr, nullptr, nullptr, 0, 0);
    STOP(8); nv::k_peer_topk<<<NROWS, 256, 0, stream>>>(PQ, psk + (size_t)i * 2 * NKEYS * 128, EIDX, GATE);
    STOP(9); nv::k_peer_u<<<NROWS, 256, 0, stream>>>(H, pu + (size_t)i * NKEYS * NKEYS * DM, EIDX, GATE, PW);
    STOP(10); nv::k_peer_v<<<NROWS, 256, 0, stream>>>(pv + (size_t)i * NKEYS * NKEYS * DM, EIDX, PW, out, XC, modi, 5, last ? 1 : 0);
#undef STOP
  }
}

extern "C" void kernel_launch(void* const* d_in, const int* in_sizes, int n_in, void* d_out, int out_size, void* d_ws, size_t ws_size, hipStream_t stream) {
  static int grid = 0;
  if (grid == 0) {
    if (n_in != 17 || out_size != NB * SEQ * DM || ws_size < mk::WS_END) { fprintf(stderr, "kernel_launch: unexpected shapes (n_in %d out %d ws %zu)\n", n_in, out_size, ws_size); grid = -1; return; }
    int dev = 0, cus = 0, per_cu = 0;
    hipGetDevice(&dev); hipDeviceGetAttribute(&cus, hipDeviceAttributeMultiprocessorCount, dev);
    if (hipFuncSetAttribute((const void*)mk::fwd, hipFuncAttributeMaxDynamicSharedMemorySize, mk::LDS_BYTES) != hipSuccess) { fprintf(stderr, "kernel_launch: hipFuncSetAttribute failed\n"); grid = -1; return; }
    if (hipOccupancyMaxActiveBlocksPerMultiprocessor(&per_cu, (const void*)mk::fwd, mk::NTHR, mk::LDS_BYTES) != hipSuccess || per_cu < 1) { fprintf(stderr, "kernel_launch: occupancy query failed (%d)\n", per_cu); grid = -1; return; }
    grid = cus * 1;
    grid -= grid % 8;
  }
  if (grid < 0) return;
  mk::Args a{};
  for (int i = 0; i < 17; ++i) a.in[i] = (const float*)d_in[i];
  a.out = (float*)d_out; a.ws = (unsigned char*)d_ws;
#if DBG == 0
#if MK_MULTI
  for (int p = 0; p < mk::NPHASE; ++p) { a.ph_lo = p; a.ph_hi = p + 1; hipLaunchKernelGGL(mk::fwd, dim3(grid), dim3(mk::NTHR), mk::LDS_BYTES, stream, a); }
#else
  hipMemsetAsync((char*)d_ws + mk::WS_CTL, 0, 65536, stream);
  a.ph_lo = 0; a.ph_hi = mk::NPHASE; void* kargs[] = {&a};
  hipError_t e = hipLaunchCooperativeKernel((const void*)mk::fwd, dim3(grid), dim3(mk::NTHR), kargs, mk::LDS_BYTES, stream);
  if (e != hipSuccess) fprintf(stderr, "cooperative launch failed: %s (grid %d)\n", hipGetErrorString(e), grid);
#endif
#else
  {
    constexpr size_t MiB = 1u << 20; char* ws = (char*)d_ws; float* out = (float*)d_out;
    float* REF = (float*)(ws + 402 * MiB); float* RES = (float*)(ws + 511 * MiB);
    float* nH = (float*)(ws + 34 * MiB); float* nQKV = (float*)(ws + 104 * MiB); float* nMOD = (float*)ws; float* nXC = (float*)(ws + 1 * MiB);
    hipMemsetAsync(RES, 0, 64, stream);
    int slayer = 0, stop = 0, fastp = 0;
#if DBG == 1
    slayer = 0; stop = 2; fastp = 2;
#elif DBG == 2
    slayer = 0; stop = 4; fastp = 4;
#elif DBG == 3
    slayer = 0; stop = 5; fastp = 5;
#elif DBG == 4
    slayer = 0; stop = 6; fastp = 6;
#elif DBG == 5
    slayer = 0; stop = 8; fastp = 8;
#elif DBG == 6
    slayer = 1; stop = 1; fastp = 11;
#elif DBG == 7
    slayer = 1; stop = 5; fastp = 15;
#elif DBG == 8
    slayer = 9; stop = 99; fastp = 21;
#elif DBG == 9
    slayer = 1; stop = 1; fastp = 9;
#elif DBG == 10
    slayer = 0; stop = 10; fastp = 9;
#elif DBG == 11
    slayer = 0; stop = 1; fastp = 1;
#endif
    run_naive(d_in, out, ws, stream, slayer, stop);
#if DBG == 1
    hipMemcpyAsync(REF, nH, (size_t)NROWS * DM * 4, hipMemcpyDeviceToDevice, stream); hipMemcpyAsync(REF + (size_t)NROWS * DM, nMOD, (size_t)DEPTH * 5 * NMOD * DM * 4, hipMemcpyDeviceToDevice, stream);
#elif DBG == 2 || DBG == 3 || DBG == 7
    hipMemcpyAsync(REF, nQKV, (size_t)NROWS * QKVD * 4, hipMemcpyDeviceToDevice, stream);
#elif DBG == 4 || DBG == 6 || DBG == 8 || DBG == 9
    hipMemcpyAsync(REF, out, (size_t)NB * SEQ * DM * 4, hipMemcpyDeviceToDevice, stream); hipMemcpyAsync(REF + (size_t)NB * SEQ * DM, nXC, (size_t)NB * CTXL * DM * 4, hipMemcpyDeviceToDevice, stream);
#endif
#if DBG == 10
    hipMemcpyAsync(REF, ws + 24 * MiB, (size_t)NROWS * 128 * 4, hipMemcpyDeviceToDevice, stream);
#endif
#if DBG == 9 || DBG == 10
    hipMemcpyAsync(REF + (size_t)70 * MiB / 4, ws + 6 * MiB, (size_t)NROWS * 128 * 4, hipMemcpyDeviceToDevice, stream); hipMemcpyAsync(REF + (size_t)80 * MiB / 4, ws + 15 * MiB, (size_t)NROWS * 128 * 4, hipMemcpyDeviceToDevice, stream);
#elif DBG == 5
    hipMemcpyAsync(REF, nQKV  , (size_t)512 * PQN * 4, hipMemcpyDeviceToDevice, stream);
#endif
    for (int p = 0; p < fastp; ++p) { a.ph_lo = p; a.ph_hi = p + 1; hipLaunchKernelGGL(mk::fwd, dim3(grid), dim3(mk::NTHR), mk::LDS_BYTES, stream, a); }
    unsigned char* fw = (unsigned char*)d_ws;
#if DBG == 9 || DBG == 10
    hipMemcpyAsync(fw + mk::WS_EIDX, REF + (size_t)70 * MiB / 4, (size_t)NROWS * 128 * 4, hipMemcpyDeviceToDevice, stream); hipMemcpyAsync(fw + mk::WS_GATE, REF + (size_t)80 * MiB / 4, (size_t)NROWS * 128 * 4, hipMemcpyDeviceToDevice, stream);
    for (int p = 9; p < (DBG == 9 ? 11 : 10); ++p) { a.ph_lo = p; a.ph_hi = p + 1; hipLaunchKernelGGL(mk::fwd, dim3(grid), dim3(mk::NTHR), mk::LDS_BYTES, stream, a); }
#endif
#if DBG == 1
    dbg::k_cmp<true><<<1, 1024, 0, stream>>>(fw + mk::WS_H, DM, 0, REF, DM, 0, NROWS, DM, 0, 0, RES);
    dbg::k_cmp<false><<<1, 1024, 0, stream>>>(fw + mk::WS_MOD, NMOD * DM, 0, REF + (size_t)NROWS * DM, NMOD * DM, 0, DEPTH * 5, NMOD * DM, 0, 0, RES + 1);
#elif DBG == 2
    dbg::k_cmp<true><<<1, 1024, 0, stream>>>(fw + mk::WS_Q, DM, 0, REF, QKVD, 0, NROWS, DM, 0, 0, RES);
    dbg::k_cmp<true><<<1, 1024, 0, stream>>>(fw + mk::WS_K, 256, 0, REF, QKVD, 1024, NROWS, 256, 0, 0, RES + 2);
    dbg::k_cmp<true><<<1, 1024, 0, stream>>>(fw + mk::WS_V, 256, 0, REF, QKVD, 1280, NROWS, 256, 0, 0, RES + 1);
#elif DBG == 3 || DBG == 7
    dbg::k_cmp<true><<<1, 1024, 0, stream>>>(fw + mk::WS_Q, DM, 0, REF, QKVD, 0, NROWS, DM, 0, 1, RES);
    if (DBG == 3) dbg::k_cmp<true><<<1, 1024, 0, stream>>>(fw + mk::WS_Q, DM, 0, REF, QKVD, 0, NROWS, DM, 0, 2, RES + 1);
#elif DBG == 4 || DBG == 6 || DBG == 8 || DBG == 9
    dbg::k_cmp<false><<<1, 1024, 0, stream>>>(out, DM, 0, REF, DM, 0, NB * SEQ, DM, 0, 0, RES);
    if (DBG != 8) dbg::k_cmp<false><<<1, 1024, 0, stream>>>(fw + mk::WS_XC, DM, 0, REF + (size_t)NB * SEQ * DM, DM, 0, NB * CTXL, DM, 0, 0, RES + 1);
#elif DBG == 11
    dbg::k_cmp<true><<<1, 1024, 0, stream>>>(fw + mk::WS_UT, DM, 0, (const float*)d_in[15], DM, 0, DEPTH * NKEYS * NKEYS, DM, 0, 0, RES);
    dbg::k_cmp<true><<<1, 1024, 0, stream>>>(fw + mk::WS_VT, DM, 0, (const float*)d_in[16], DM, 0, DEPTH * NKEYS * NKEYS, DM, 0, 0, RES + 1);
#elif DBG == 10
    dbg::k_cmp<false><<<1, 1024, 0, stream>>>(fw + mk::WS_PW, 128, 0, REF, 128, 0, NROWS, 128, 0, 0, RES);
#elif DBG == 5
    dbg::k_cmp_scores<<<1, 1024, 0, stream>>>((const float*)(fw + mk::WS_S), REF, (const float*)d_in[14], 512, RES);
#endif
    hipMemcpyAsync(REF, RES, 64, hipMemcpyDeviceToDevice, stream);
    run_naive(d_in, out, ws, stream, 9, 99);
    dbg::k_final<<<1024, 256, 0, stream>>>(out, (long)NB * SEQ * DM, REF);
    dbg::k_final2<<<1, 1, 0, stream>>>(out, REF);
  }
#endif
}
```

```cpp
#include <hip/hip_runtime.h>
#include <hip/hip_cooperative_groups.h>
#include <cstdio>
#include <cstdint>

constexpr int NB = 4, SEQ = 4096, CTXL = 256, DM = 1024, DEPTH = 2;
constexpr int RPB = CTXL + SEQ;
constexpr int NROWS = NB * RPB;
constexpr int NH = 8, NKV = 2, HD = 128, QKVD = 1536, NMOD = 6;
constexpr int PH = 8, PK = 16, NKEYS = 128, PQD = 256, PQN = PH * PQD;
constexpr float RMS_EPS = 1e-6f;

namespace nv {

__device__ __forceinline__ float silu(float x) { return x / (1.f + __expf(-x)); }
__device__ __forceinline__ float gelu_tanh(float x) {
  const float y = 0.7978845608028654f * (x + 0.044715f * x * x * x);
  const float t = 1.f - 2.f / (__expf(2.f * y) + 1.f);
  return 0.5f * x * (1.f + t);
}

__global__ void k_mod(const float* __restrict__ c, const float* __restrict__ c_ctx, const float* __restrict__ ada_w,
                      const float* __restrict__ ada_b, float* __restrict__ mod) {
  const int idx = blockIdx.x * 256 + threadIdx.x;
  if (idx >= DEPTH * 5 * NMOD * DM) return;
  const int n = idx % (NMOD * DM), r = (idx / (NMOD * DM)) % 5, i = idx / (5 * NMOD * DM);
  const float* cv = r < 4 ? c + r * DM : c_ctx;
  const float* w = ada_w + (size_t)i * DM * NMOD * DM + n;
  float s = 0.f;
  for (int j = 0; j < DM; ++j) s += silu(cv[j]) * w[(size_t)j * NMOD * DM];
  mod[idx] = s + ada_b[i * NMOD * DM + n];
}

__device__ __forceinline__ float* xrow(float* xl, float* xc, int r) {
  const int b = r / RPB, j = r % RPB;
  return j < CTXL ? xc + (size_t)(b * CTXL + j) * DM : xl + (size_t)(b * SEQ + (j - CTXL)) * DM;
}

__global__ void k_norm(float* xl, float* xc, const float* __restrict__ gain, const float* __restrict__ modi, int sh_i, int sc_i,
                       float* __restrict__ H) {
  const int r = blockIdx.x, t = threadIdx.x;
  const int b = r / RPB, j = r % RPB, mr = j < CTXL ? 4 : b;
  const float* x = xrow(xl, xc, r);
  __shared__ float red[4];
  float v[4]; float s = 0.f;
#pragma unroll
  for (int q = 0; q < 4; ++q) { v[q] = x[t + 256 * q]; s += v[q] * v[q]; }
  for (int o = 32; o > 0; o >>= 1) s += __shfl_xor(s, o);
  if ((t & 63) == 0) red[t >> 6] = s;
  __syncthreads();
  s = red[0] + red[1] + red[2] + red[3];
  const float rstd = rsqrtf(s / DM + RMS_EPS);
  const float* sh = modi + (size_t)mr * NMOD * DM + sh_i * DM; const float* sc = modi + (size_t)mr * NMOD * DM + sc_i * DM;
#pragma unroll
  for (int q = 0; q < 4; ++q) { const int d = t + 256 * q; H[(size_t)r * DM + d] = v[q] * rstd * gain[d] * (1.f + sc[d]) + sh[d]; }
}

template <int EPI>
__global__ void k_gemm(const float* __restrict__ A, const float* __restrict__ B, float* __restrict__ C, int M, int N, int K,
                       float* xl, float* xc, const float* __restrict__ modi, int g_i, int skip_ctx) {
  __shared__ float As[16][68], Bs[16][68];
  const int t = threadIdx.x, tx = t & 15, ty = t >> 4, m0 = blockIdx.y * 64, n0 = blockIdx.x * 64;
  float acc[4][4] = {};
  for (int k0 = 0; k0 < K; k0 += 16) {
    for (int q = 0; q < 4; ++q) { const int e = t + 256 * q, mm = e >> 4, kk = e & 15; As[kk][mm] = A[(size_t)(m0 + mm) * K + k0 + kk]; }
    for (int q = 0; q < 4; ++q) { const int e = t + 256 * q, kk = e >> 6, nn = e & 63; Bs[kk][nn] = B[(size_t)(k0 + kk) * N + n0 + nn]; }
    __syncthreads();
#pragma unroll
    for (int kk = 0; kk < 16; ++kk) {
      float a[4], b[4];
#pragma unroll
      for (int i = 0; i < 4; ++i) { a[i] = As[kk][ty * 4 + i]; b[i] = Bs[kk][tx * 4 + i]; }
#pragma unroll
      for (int i = 0; i < 4; ++i)
#pragma unroll
        for (int j = 0; j < 4; ++j) acc[i][j] += a[i] * b[j];
    }
    __syncthreads();
  }
#pragma unroll
  for (int i = 0; i < 4; ++i) {
    const int r = m0 + ty * 4 + i;
    if (EPI == 0) {
#pragma unroll
      for (int j = 0; j < 4; ++j) C[(size_t)r * N + n0 + tx * 4 + j] = acc[i][j];
    } else {
      const int b = r / RPB, jj = r % RPB; if (skip_ctx && jj < CTXL) continue;
      const int mr = jj < CTXL ? 4 : b; float* x = xrow(xl, xc, r);
      const float* g = modi + (size_t)mr * NMOD * DM + g_i * DM;
#pragma unroll
      for (int j = 0; j < 4; ++j) { const int n = n0 + tx * 4 + j; x[n] += g[n] * acc[i][j]; }
    }
  }
}

__global__ void k_qknorm_rope(float* __restrict__ QKV, const float* __restrict__ qg, const float* __restrict__ kg) {
  const int r = blockIdx.x, t = threadIdx.x, head = t >> 6, p = t & 63, axis = p >> 5, f = p & 31;
  const int j = r % RPB;
  float* base = QKV + (size_t)r * QKVD + head * HD;
  const int e1 = axis * 64 + f, e2 = e1 + 32;
  float x1 = base[e1], x2 = base[e2];
  float s = x1 * x1 + x2 * x2;
  for (int o = 32; o > 0; o >>= 1) s += __shfl_xor(s, o);
  const float rstd = rsqrtf(s / HD + RMS_EPS);
  const float* g = head < NH ? qg : kg;
  x1 = x1 * rstd * g[e1]; x2 = x2 * rstd * g[e2];
  if (j >= CTXL) {
    const int sp = j - CTXL; const float pos = (float)(axis == 0 ? sp / 64 : sp % 64);
    const float inv = powf(10000.f, -(float)(2 * f) / 64.f);
    const float ang = pos * inv; const float cs = cosf(ang), sn = sinf(ang);
    const float y1 = x1 * cs - x2 * sn, y2 = x1 * sn + x2 * cs; x1 = y1; x2 = y2;
  }
  base[e1] = x1; base[e2] = x2;
}

__global__ void k_attn(float* __restrict__ QKV, int mode, const float* __restrict__ sink) {
  extern __shared__ float sm[];
  const int t = threadIdx.x, w = t >> 6, lane = t & 63, g = blockIdx.y;
  int b, j;
  if (mode == 1) { b = blockIdx.x / CTXL; j = blockIdx.x % CTXL; } else { b = blockIdx.x / SEQ; j = CTXL + blockIdx.x % SEQ; }
  const int r = b * RPB + j, h = g * 4 + w;
  float* sc = sm + w * RPB; float* qs = sm + 4 * RPB + w * HD;
  float* qp = QKV + (size_t)r * QKVD + h * HD;
  qs[lane] = qp[lane]; qs[lane + 64] = qp[lane + 64];
  __syncthreads();
  int a0 = 0, a1, b0 = 0, b1 = 0;
  if (mode == 0) a1 = RPB; else if (mode == 1) a1 = CTXL;
  else { a1 = CTXL; const int s = j - CTXL; const int lo = s - 128 < 0 ? 0 : s - 128, hi = s + 128 > SEQ - 1 ? SEQ - 1 : s + 128; b0 = CTXL + lo; b1 = CTXL + hi + 1; }
  const int nk = (a1 - a0) + (b1 - b0);
  const float scale = 0.08838834764831845f;
  float mx = -1e30f;
  for (int i = lane; i < nk; i += 64) {
    const int kr = i < (a1 - a0) ? a0 + i : b0 + (i - (a1 - a0));
    const float4* kp = (const float4*)(QKV + (size_t)(b * RPB + kr) * QKVD + NH * HD + g * HD);
    float s = 0.f;
    for (int d = 0; d < 32; ++d) { const float4 kv = kp[d]; s += kv.x * qs[4 * d] + kv.y * qs[4 * d + 1] + kv.z * qs[4 * d + 2] + kv.w * qs[4 * d + 3]; }
    s *= scale; sc[i] = s; mx = fmaxf(mx, s);
  }
  for (int o = 32; o > 0; o >>= 1) mx = fmaxf(mx, __shfl_xor(mx, o));
  if (mode == 2) mx = fmaxf(mx, sink[h]);
  float l = 0.f;
  for (int i = lane; i < nk; i += 64) { const float p = __expf(sc[i] - mx); sc[i] = p; l += p; }
  for (int o = 32; o > 0; o >>= 1) l += __shfl_xor(l, o);
  if (mode == 2) l += __expf(sink[h] - mx);
  __syncthreads();
  float o0 = 0.f, o1 = 0.f;
  for (int i = 0; i < nk; ++i) {
    const int kr = i < (a1 - a0) ? a0 + i : b0 + (i - (a1 - a0));
    const float* vp = QKV + (size_t)(b * RPB + kr) * QKVD + (NH + NKV) * HD + g * HD;
    const float p = sc[i]; o0 += p * vp[lane]; o1 += p * vp[lane + 64];
  }
  const float il = 1.f / l;
  qp[lane] = o0 * il; qp[lane + 64] = o1 * il;
}

__global__ void k_copy_o(const float* __restrict__ QKV, float* __restrict__ O) {
  const int r = blockIdx.x, t = threadIdx.x;
  for (int q = 0; q < 4; ++q) O[(size_t)r * DM + t + 256 * q] = QKV[(size_t)r * QKVD + t + 256 * q];
}

__global__ void __launch_bounds__(256) k_peer_topk(const float* __restrict__ PQ, const float* __restrict__ SK  , int* __restrict__ eidx, float* __restrict__ gate) {
  __shared__ float q[PQN]; __shared__ float s[16][128]; __shared__ float tv[16][16]; __shared__ int ti[16][16];
  __shared__ float cs[8][256]; __shared__ int taken[8][256];
  const int r = blockIdx.x, t = threadIdx.x;
  for (int i = t; i < PQN; i += 256) q[i] = PQ[(size_t)r * PQN + i];
  __syncthreads();
  { const int k = t & 127, half = t >> 7; const float* kp = SK + (size_t)half * NKEYS * 128 + (size_t)k * 128;
#pragma nounroll
    for (int h = 0; h < PH; ++h) { float a = 0.f; const float* qq = q + h * PQD + half * 128;
#pragma unroll 4
      for (int d = 0; d < 128; ++d) a += qq[d] * kp[d];
      s[h * 2 + half][k] = a; } }
  __syncthreads();
  if (t < 16) {
#pragma nounroll
    for (int it = 0; it < PK; ++it) { float bv = -3e38f; int bi = 0;
#pragma nounroll
      for (int k = 0; k < 128; ++k) { const float v = s[t][k]; if (v > bv) { bv = v; bi = k; } } tv[t][it] = bv; ti[t][it] = bi; s[t][bi] = -3e38f; }
  }
  __syncthreads();
  for (int i = t; i < 8 * 256; i += 256) { const int h = i >> 8, c = i & 255; cs[h][c] = tv[h * 2][c >> 4] + tv[h * 2 + 1][c & 15]; taken[h][c] = 0; }
  __syncthreads();
  if (t < 8) {
    float m = -3e38f;
#pragma nounroll
    for (int it = 0; it < PK; ++it) { float bv = -3e38f; int bi = 0;
#pragma nounroll
      for (int c = 0; c < 256; ++c) { const float v = cs[t][c]; if (!taken[t][c] && v > bv) { bv = v; bi = c; } }
      taken[t][bi] = 1; s[t][it] = bv; m = fmaxf(m, bv); eidx[(size_t)r * 128 + t * PK + it] = ti[t * 2][bi >> 4] * NKEYS + ti[t * 2 + 1][bi & 15]; }
    float l = 0.f;
#pragma nounroll
    for (int it = 0; it < PK; ++it) l += __expf(s[t][it] - m);
#pragma nounroll
    for (int it = 0; it < PK; ++it) gate[(size_t)r * 128 + t * PK + it] = __expf(s[t][it] - m) / l;
  }
}

__global__ void k_peer_u(const float* __restrict__ H, const float* __restrict__ U, const int* __restrict__ eidx, const float* __restrict__ gate, float* __restrict__ W) {
  __shared__ float h[DM];
  const int r = blockIdx.x, t = threadIdx.x, w = t >> 6, lane = t & 63;
  for (int i = t; i < DM; i += 256) h[i] = H[(size_t)r * DM + i];
  __syncthreads();
  for (int k = w; k < 128; k += 4) {
    const int e = eidx[(size_t)r * 128 + k]; const float* u = U + (size_t)e * DM; float a = 0.f;
    for (int d = lane; d < DM; d += 64) a += u[d] * h[d];
    for (int o = 32; o > 0; o >>= 1) a += __shfl_xor(a, o);
    if (lane == 0) W[(size_t)r * 128 + k] = gate[(size_t)r * 128 + k] * gelu_tanh(a);
  }
}
__global__ void k_peer_v(const float* __restrict__ V, const int* __restrict__ eidx, const float* __restrict__ W, float* xl, float* xc,
                         const float* __restrict__ modi, int g_i, int skip_ctx) {
  const int r = blockIdx.x, t = threadIdx.x; const int b = r / RPB, j = r % RPB; if (skip_ctx && j < CTXL) return;
  float4 acc = {0.f, 0.f, 0.f, 0.f};
  for (int k = 0; k < 128; ++k) { const int e = eidx[(size_t)r * 128 + k]; const float w = W[(size_t)r * 128 + k]; const float4 v = ((const float4*)(V + (size_t)e * DM))[t];
    acc.x += w * v.x; acc.y += w * v.y; acc.z += w * v.z; acc.w += w * v.w; }
  const int mr = j < CTXL ? 4 : b; float4* x = (float4*)xrow(xl, xc, r) + t; const float4 g = ((const float4*)(modi + (size_t)mr * NMOD * DM + g_i * DM))[t];
  float4 xv = *x; xv.x += g.x * acc.x; xv.y += g.y * acc.y; xv.z += g.z * acc.z; xv.w += g.w * acc.w; *x = xv;
}
}


namespace pg8 {
#define PG8_LAS __attribute__((address_space(3)))
typedef unsigned short bf16_t;
typedef short bf16x8 __attribute__((ext_vector_type(8)));
typedef float f32x4 __attribute__((ext_vector_type(4)));
typedef unsigned u32x4 __attribute__((ext_vector_type(4)));
constexpr int BM = 256, BK = 64, HALF = 128, HTB = HALF * BK * 2  , STAGE_BYTES = 8 * HTB, NXCD = 8, WGM = 8;

__host__ __device__ __forceinline__ int lds_byte(int r, int c) { const int st = (r >> 4) * 2 + (c >> 5), rr = r & 15, cc = c & 31, ob = rr * 64 + cc * 2; return st * 1024 + (ob ^ (((ob >> 9) & 1) << 5)); }
__host__ __device__ __forceinline__ void stage_rc(int b, int& R, int& C) { const int st = b / 1024, sb = b % 1024, swz = sb ^ (((sb >> 9) & 1) << 5); R = (st >> 1) * 16 + swz / 64; C = (st & 1) * 32 + (swz % 64) / 2; }
__host__ __device__ __forceinline__ int perm32(int rho) { const int n = rho >> 4, i = rho & 15; return 8 * (i >> 2) + 4 * n + (i & 3); }

struct Unit { int pm, pn; };
struct Gemm { const bf16_t* A; const bf16_t* Bt; int M, N, K; };

struct StaticOrder {
    int nM, nN, nwg, G, c;
    __host__ __device__ void init(int M, int N, int G_, int c_) { nM = M / BM; nN = N / BM; nwg = nM * nN; G = G_; c = c_; }
    __host__ __device__ bool next(int i, Unit& u) const {
        const long L = (long)i * G + c; if (L >= nwg) return false;
        int wgid = (int)L; { const int q = nwg / NXCD, r = nwg % NXCD, xcd = wgid % NXCD, off = wgid / NXCD; wgid = (xcd < r ? xcd * (q + 1) : r * (q + 1) + (xcd - r) * q) + off; }
        const int nig = WGM * nN, gid = wgid / nig, fm = gid * WGM, gsz = (nM - fm) < WGM ? (nM - fm) : WGM;
        u.pm = fm + ((wgid % nig) % gsz); u.pn = (wgid % nig) / gsz; return true;
    }
    __device__ __forceinline__ void a_ready(const Unit&) const {}
    __device__ __forceinline__ void done(const Unit&) const {}
};

__device__ __forceinline__ unsigned cvt_pk_bf16(float lo, float hi) { unsigned r; asm volatile("v_cvt_pk_bf16_f32 %0, %1, %2" : "=v"(r) : "v"(lo), "v"(hi)); return r; }
typedef float f32x2 __attribute__((ext_vector_type(2)));
__device__ __forceinline__ f32x2 gelu_pk(f32x2 v) {
    const f32x2 av = __builtin_elementwise_abs(v), d = av * 0.2316418882f + 1.0f;
    f32x2 t; t.x = __builtin_amdgcn_rcpf(d.x); t.y = __builtin_amdgcn_rcpf(d.y);
    f32x2 q = t * 0.5307027145f + (-0.7265760135f); q = q * t + 0.7107068705f; q = q * t + (-0.142248368f); q = q * t + 0.127414796f; q = q * t;
    const f32x2 s = (v * v) * (-0.72134752044f);
    f32x2 e; e.x = __builtin_amdgcn_exp2f(s.x); e.y = __builtin_amdgcn_exp2f(s.y);
    const f32x2 m = v * (q * e), r = v - m;
    f32x2 o; o.x = v.x < 0.f ? m.x : r.x; o.y = v.y < 0.f ? m.y : r.y; return o;
}

template <int ACT  > struct EpiBf16 {
    static constexpr bool PERM = true, AFTER_DRAIN = false; static_assert(ACT == 0 || ACT == 1, "EpiBf16: ACT is 0 (none) or 1 (gelu_pk)");
    bf16_t* O; int ldc; const float* bias; int split_cols; size_t split_stride; float scale0;
    __device__ __forceinline__ void operator()(const f32x4 (&acc)[2][2][4][2], const Unit& u, int wr, int wc, int fr, int fq) const {
        const int row0 = u.pm * BM + wr * 64 + fr; int colt = u.pn * BM; bf16_t* base = O;
        float sc = 1.f; if (split_cols) { const int t = colt / split_cols; base += (size_t)t * split_stride; colt -= t * split_cols; if (t == 0) sc = scale0; }
        const int col0 = colt + wc * 32 + 8 * fq, bcol0 = u.pn * BM + wc * 32 + 8 * fq;
        f32x4 bv[2][2];
#pragma unroll
        for (int bj = 0; bj < 2; ++bj)
#pragma unroll
            for (int n = 0; n < 2; ++n) bv[bj][n] = bias ? *(const f32x4*)(bias + bcol0 + bj * HALF + 4 * n) : (f32x4){0.f, 0.f, 0.f, 0.f};
#pragma unroll
        for (int ai = 0; ai < 2; ++ai)
#pragma unroll
            for (int m = 0; m < 4; ++m) { bf16_t* rowp = base + (size_t)(row0 + ai * HALF + m * 16) * ldc + col0;
#pragma unroll
                for (int bj = 0; bj < 2; ++bj) { f32x4 v0 = acc[ai][bj][m][0] + bv[bj][0], v1 = acc[ai][bj][m][1] + bv[bj][1];
                    if (ACT == 1) { f32x2 a = gelu_pk((f32x2){v0[0], v0[1]}), b = gelu_pk((f32x2){v0[2], v0[3]}), c = gelu_pk((f32x2){v1[0], v1[1]}), d = gelu_pk((f32x2){v1[2], v1[3]});
                        v0 = (f32x4){a.x, a.y, b.x, b.y}; v1 = (f32x4){c.x, c.y, d.x, d.y}; }
                    v0 = v0 * sc; v1 = v1 * sc; u32x4 w; w.x = cvt_pk_bf16(v0[0], v0[1]); w.y = cvt_pk_bf16(v0[2], v0[3]); w.z = cvt_pk_bf16(v1[0], v1[1]); w.w = cvt_pk_bf16(v1[2], v1[3]);
                    *(u32x4*)(rowp + bj * HALF) = w; } }
    }
};

template <class Epi, class Sched, bool ALIGN_EPI = false, bool SP2 = false>
__device__ __forceinline__ void gemm_phase(PG8_LAS unsigned char* lds, const Gemm g, const Sched& S, const Epi& E) {
    int tid_ = threadIdx.x; asm volatile("" : "+v"(tid_));
    const int tid = tid_, wid = __builtin_amdgcn_readfirstlane(tid >> 6), lane = tid & 63, wr = wid >> 2, wc = wid & 3, fr = lane & 15, fq = lane >> 4;
    const int K = g.K, nt = K / BK;
    unsigned voffA[2], voffB[2];
#pragma unroll
    for (int i = 0; i < 2; ++i) { int R, C; stage_rc(tid * 16 + i * 8192, R, C); const int Rb = Epi::PERM ? ((R & ~31) + perm32(R & 31)) : R;
        voffA[i] = (unsigned)(R * K + C) * 2u; voffB[i] = (unsigned)(Rb * K + C) * 2u; }
    const size_t kstep = (size_t)(BK * 2);
    const size_t hstep = (size_t)HALF * K * 2;
    const size_t tstep = 2 * hstep;
    const unsigned ldsw = (unsigned)wid * 1024u;
    const int aoff = lds_byte(wr * 64 + fr, fq * 8), boff = lds_byte(wc * 32 + fr, fq * 8);
#define PG8_SA(b, h) (((b) * 2 + (h)) * HTB)
#define PG8_SB(b, h) ((4 + (b) * 2 + (h)) * HTB)
#define PG8_STAGE(bufoff, gbase, voff) do { _Pragma("unroll") for (int _i = 0; _i < 2; ++_i) \
        __builtin_amdgcn_global_load_lds((const unsigned*)((const char*)(gbase) + (voff)[_i]), (PG8_LAS unsigned*)(lds + (bufoff) + ldsw + _i * 8192), 16, 0, 0); } while (0)
#define PG8_LDA(dst, b, h) do { _Pragma("unroll") for (int m = 0; m < 4; ++m) _Pragma("unroll") for (int k = 0; k < 2; ++k) dst[m][k] = *(const PG8_LAS bf16x8*)(lds + PG8_SA(b, h) + aoff + m * 2048 + k * 1024); } while (0)
#define PG8_LDB(dst, b, h) do { _Pragma("unroll") for (int n = 0; n < 2; ++n) _Pragma("unroll") for (int k = 0; k < 2; ++k) dst[n][k] = *(const PG8_LAS bf16x8*)(lds + PG8_SB(b, h) + boff + n * 2048 + k * 1024); } while (0)
#define PG8_MMA(ai, bj, At, Bt) do { __builtin_amdgcn_s_setprio(1); _Pragma("unroll") for (int m = 0; m < 4; ++m) _Pragma("unroll") for (int n = 0; n < 2; ++n) _Pragma("unroll") for (int k = 0; k < 2; ++k) \
        acc[ai][bj][m][n] = __builtin_amdgcn_mfma_f32_16x16x32_bf16(Bt[n][k], At[m][k], acc[ai][bj][m][n], 0, 0, 0); __builtin_amdgcn_s_setprio(0); } while (0)
#define PG8_WAIT_V(n) asm volatile("s_waitcnt vmcnt(" #n ")" ::: "memory")
#define PG8_WAIT_L(n) asm volatile("s_waitcnt lgkmcnt(" #n ")" ::: "memory")
#define PG8_BAR __builtin_amdgcn_s_barrier()
#define PG8_SCHED __builtin_amdgcn_sched_barrier(0)
    Unit cur, nxt; int ui = 0;
    if (!S.next(0, cur)) return;
    f32x4 acc[2][2][4][2];
#pragma unroll
    for (int a = 0; a < 2; ++a)
#pragma unroll
        for (int b = 0; b < 2; ++b)
#pragma unroll
            for (int m = 0; m < 4; ++m)
#pragma unroll
                for (int n = 0; n < 2; ++n) acc[a][b][m][n] = (f32x4){0.f, 0.f, 0.f, 0.f};
    bf16x8 At[4][2], B0[2][2], B1[2][2];
    const char* cA = (const char*)g.A + (size_t)cur.pm * tstep; const char* cB = (const char*)g.Bt + (size_t)cur.pn * tstep;
    S.a_ready(cur);
    if constexpr (SP2) {
        PG8_STAGE(PG8_SB(0, 0), cB, voffB); PG8_STAGE(PG8_SB(0, 1), cB + hstep, voffB); PG8_STAGE(PG8_SA(0, 0), cA, voffA); PG8_STAGE(PG8_SA(0, 1), cA + hstep, voffA);
        if (wr == 1) PG8_BAR;
        PG8_WAIT_V(2); PG8_BAR;
        PG8_STAGE(PG8_SB(1, 0), cB + kstep, voffB); PG8_STAGE(PG8_SA(1, 0), cA + kstep, voffA); PG8_STAGE(PG8_SB(1, 1), cB + hstep + kstep, voffB);
        PG8_WAIT_V(6); PG8_BAR;
    } else {
        PG8_STAGE(PG8_SB(0, 0), cB, voffB); PG8_STAGE(PG8_SA(0, 0), cA, voffA); PG8_STAGE(PG8_SB(0, 1), cB + hstep, voffB); PG8_STAGE(PG8_SA(0, 1), cA + hstep, voffA);
        if (wr == 1) PG8_BAR;
        PG8_WAIT_V(4); PG8_BAR;
        PG8_STAGE(PG8_SB(1, 0), cB + kstep, voffB); PG8_STAGE(PG8_SA(1, 0), cA + kstep, voffA); PG8_STAGE(PG8_SB(1, 1), cB + hstep + kstep, voffB);
        PG8_WAIT_V(6); PG8_BAR;
    }
    for (;;) {
        const bool has_next = S.next(ui + 1, nxt);
        const char* nA = has_next ? (const char*)g.A + (size_t)nxt.pm * tstep : cA; const char* nB = has_next ? (const char*)g.Bt + (size_t)nxt.pn * tstep : cB;
        for (int t = 0; t < nt; t += 2) {
            const bool last = (t == nt - 2);
            const char* a1 = cA + (size_t)(t + 1) * kstep;
            const char* a2 = last ? nA : cA + (size_t)(t + 2) * kstep; const char* b2 = last ? nB : cB + (size_t)(t + 2) * kstep;
            const char* a3 = a2 + kstep; const char* b3 = b2 + kstep;
            if (last && has_next) S.a_ready(nxt);
            if constexpr (SP2) {
            PG8_LDB(B0, 0, 0); PG8_LDB(B1, 0, 1); PG8_SCHED; PG8_LDA(At, 0, 0); PG8_STAGE(PG8_SA(1, 1), a1 + hstep, voffA);
            PG8_WAIT_V(8); PG8_WAIT_L(0); PG8_BAR; PG8_MMA(0, 0, At, B0); PG8_MMA(0, 1, At, B1); PG8_BAR; PG8_SCHED;
            PG8_LDA(At, 0, 1); PG8_STAGE(PG8_SB(0, 0), b2, voffB); PG8_STAGE(PG8_SB(0, 1), b2 + hstep, voffB); PG8_STAGE(PG8_SA(0, 0), a2, voffA);
            PG8_WAIT_V(8); PG8_WAIT_L(0); PG8_BAR; PG8_MMA(1, 0, At, B0); PG8_MMA(1, 1, At, B1); PG8_BAR; PG8_SCHED;
            PG8_LDB(B0, 1, 0); PG8_LDB(B1, 1, 1); PG8_SCHED; PG8_LDA(At, 1, 0); PG8_STAGE(PG8_SA(0, 1), a2 + hstep, voffA);
            PG8_WAIT_V(8); PG8_WAIT_L(0); PG8_BAR; PG8_MMA(0, 0, At, B0); PG8_MMA(0, 1, At, B1); PG8_BAR; PG8_SCHED;
            PG8_LDA(At, 1, 1); PG8_STAGE(PG8_SB(1, 0), b3, voffB); PG8_STAGE(PG8_SB(1, 1), b3 + hstep, voffB); PG8_STAGE(PG8_SA(1, 0), a3, voffA);
            PG8_WAIT_V(8); PG8_WAIT_L(0); PG8_BAR; PG8_MMA(1, 0, At, B0); PG8_MMA(1, 1, At, B1); PG8_BAR; PG8_SCHED;
            } else {
            PG8_LDB(B0, 0, 0); PG8_SCHED; PG8_LDA(At, 0, 0); PG8_STAGE(PG8_SA(1, 1), a1 + hstep, voffA);
            PG8_WAIT_L(8); PG8_BAR; PG8_WAIT_L(0); PG8_MMA(0, 0, At, B0); PG8_BAR; PG8_SCHED;
            PG8_LDB(B1, 0, 1); PG8_STAGE(PG8_SB(0, 0), b2, voffB);
            PG8_BAR; PG8_WAIT_L(0); PG8_MMA(0, 1, At, B1); PG8_BAR;
            PG8_LDA(At, 0, 1); PG8_STAGE(PG8_SA(0, 0), a2, voffA);
            PG8_BAR; PG8_WAIT_L(0); PG8_MMA(1, 0, At, B0); PG8_BAR; PG8_SCHED;
            PG8_STAGE(PG8_SB(0, 1), b2 + hstep, voffB);
            PG8_WAIT_V(6); PG8_BAR; PG8_MMA(1, 1, At, B1); PG8_BAR;
            PG8_LDB(B0, 1, 0); PG8_SCHED; PG8_LDA(At, 1, 0); PG8_STAGE(PG8_SA(0, 1), a2 + hstep, voffA);
            PG8_WAIT_L(8); PG8_BAR; PG8_WAIT_L(0); PG8_MMA(0, 0, At, B0); PG8_BAR; PG8_SCHED;
            PG8_LDB(B1, 1, 1); PG8_STAGE(PG8_SB(1, 0), b3, voffB);
            PG8_BAR; PG8_WAIT_L(0); PG8_MMA(0, 1, At, B1); PG8_BAR;
            PG8_LDA(At, 1, 1); PG8_STAGE(PG8_SA(1, 0), a3, voffA);
            PG8_BAR; PG8_WAIT_L(0); PG8_MMA(1, 0, At, B0); PG8_BAR; PG8_SCHED;
            PG8_STAGE(PG8_SB(1, 1), b3 + hstep, voffB);
            PG8_WAIT_V(6); PG8_BAR; PG8_MMA(1, 1, At, B1); PG8_BAR;
            }
        }
        if constexpr (ALIGN_EPI) { if (wr == 0) PG8_BAR; }
        if constexpr (!Epi::AFTER_DRAIN) { E(acc, cur, wr, wc, fr, fq); S.done(cur); }
        if (!has_next) break;
#pragma unroll
        for (int a = 0; a < 2; ++a)
#pragma unroll
            for (int b = 0; b < 2; ++b)
#pragma unroll
                for (int m = 0; m < 4; ++m)
#pragma unroll
                    for (int n = 0; n < 2; ++n) acc[a][b][m][n] = (f32x4){0.f, 0.f, 0.f, 0.f};
        cur = nxt; cA = nA; cB = nB; ++ui;
        if constexpr (ALIGN_EPI) { if (wr == 1) PG8_BAR; }
    }
    PG8_WAIT_V(0);
    if constexpr (!ALIGN_EPI) { if (wr == 0) PG8_BAR; }
    PG8_BAR;
    if constexpr (Epi::AFTER_DRAIN) { E.fused(acc, cur, wr, wc, fr, fq, lds, wid, lane); S.done(cur); }
#undef PG8_SA
#undef PG8_SB
#undef PG8_STAGE
#undef PG8_LDA
#undef PG8_LDB
#undef PG8_MMA
#undef PG8_WAIT_V
#undef PG8_WAIT_L
#undef PG8_BAR
#undef PG8_SCHED
}
}

namespace att {
typedef unsigned short bf16;
constexpr int D = 128, NW = 8, QBLK = 32, KVBLK = 64, LDQ = 1024, LDK = 256;
constexpr float SCALE = 0.088388347648318440f;
constexpr float THR = 8.f;
#ifndef ATT_SDEPTH
#define ATT_SDEPTH 1
#endif
constexpr int SDEPTH = ATT_SDEPTH;
constexpr size_t SHM_V = KVBLK * D * 2, SHM_K = KVBLK * D * 2, SHM_ATTN = 2 * SHM_V + 2 * SHM_K + NW * 64 * 4;
using bf16x8 = __attribute__((ext_vector_type(8))) short;
using s16x4  = __attribute__((ext_vector_type(4))) short;
using f32x16 = __attribute__((ext_vector_type(16))) float;
using u32x4  = __attribute__((ext_vector_type(4))) unsigned;
#define KSWZ(row, colB) ((row) * 256 + ((colB) ^ (((row) & 7) << 4)))
#define SBAR() __builtin_amdgcn_sched_barrier(0)
__device__ __forceinline__ int crow(int r, int hi) { return (r & 3) + 8 * (r >> 2) + 4 * hi; }
__device__ __forceinline__ unsigned cvtpk(float lo, float hi) { unsigned r; asm volatile("v_cvt_pk_bf16_f32 %0, %1, %2" : "=v"(r) : "v"(lo), "v"(hi)); return r; }
__device__ __forceinline__ void partialSM(f32x16& p0, f32x16& p1, float& m_reg, float& mn, float& alpha) {
  constexpr float C = SCALE * 1.4426950408889634f;
  float pmax = p0[0]; for (int r = 1; r < 16; ++r) pmax = fmaxf(pmax, p0[r]); for (int r = 0; r < 16; ++r) pmax = fmaxf(pmax, p1[r]);
  { auto rr = __builtin_amdgcn_permlane32_swap(__float_as_uint(pmax), __float_as_uint(pmax), false, false);
    pmax = fmaxf(__uint_as_float(rr[0]), __uint_as_float(rr[1])); }
  if (__builtin_expect(__all(pmax - m_reg <= THR / SCALE), 1)) { mn = m_reg; alpha = 1.f; }
  else { mn = fmaxf(m_reg, pmax); alpha = __builtin_amdgcn_exp2f((m_reg - mn) * C); m_reg = mn; }
  float mnC = -mn * C;
  for (int r = 0; r < 16; ++r) p0[r] = fmaf(p0[r], C, mnC); for (int r = 0; r < 16; ++r) p1[r] = fmaf(p1[r], C, mnC);
  for (int r = 0; r < 16; ++r) p0[r] = __builtin_amdgcn_exp2f(p0[r]);
}
__device__ __forceinline__ void finishSM(f32x16& p0, f32x16& p1, float alpha, float& l_reg, bf16x8& pa0, bf16x8& pa1, bf16x8& pa2, bf16x8& pa3) {
  for (int r = 0; r < 16; ++r) p1[r] = __builtin_amdgcn_exp2f(p1[r]);
  float ps = 0; for (int r = 0; r < 16; ++r) ps += p0[r]; for (int r = 0; r < 16; ++r) ps += p1[r];
  { auto rr = __builtin_amdgcn_permlane32_swap(__float_as_uint(ps), __float_as_uint(ps), false, false);
    ps = __uint_as_float(rr[0]) + __uint_as_float(rr[1]); }
  l_reg = l_reg * alpha + ps;
#define PK4(P, BASE, OUT) do { unsigned a0 = cvtpk(P[BASE + 0], P[BASE + 1]), a1 = cvtpk(P[BASE + 2], P[BASE + 3]);   \
    unsigned b0 = cvtpk(P[BASE + 4], P[BASE + 5]), b1 = cvtpk(P[BASE + 6], P[BASE + 7]);                              \
    auto r0 = __builtin_amdgcn_permlane32_swap(a0, b0, false, false); auto r1 = __builtin_amdgcn_permlane32_swap(a1, b1, false, false); \
    u32x4 w = {r0[0], r1[0], r0[1], r1[1]}; OUT = *reinterpret_cast<bf16x8*>(&w); } while (0)
  PK4(p0, 0, pa0); PK4(p0, 8, pa1); PK4(p1, 0, pa2); PK4(p1, 8, pa3);
#undef PK4
}
__device__ __forceinline__ void qkt(f32x16& p0, f32x16& p1, const bf16* Ks, const bf16x8* qr, int r32, int hi) {
  p0 = f32x16{}; p1 = f32x16{};
  for (int d0 = 0; d0 < 8; ++d0) { int cb = (d0 * 16 + hi * 8) * 2;
    bf16x8 b0 = *reinterpret_cast<const bf16x8*>((const char*)Ks + KSWZ(r32, cb));
    bf16x8 b1 = *reinterpret_cast<const bf16x8*>((const char*)Ks + KSWZ(32 + r32, cb));
    p0 = __builtin_amdgcn_mfma_f32_32x32x16_bf16(b0, qr[d0], p0, 0, 0, 0);
    p1 = __builtin_amdgcn_mfma_f32_32x32x16_bf16(b1, qr[d0], p1, 0, 0, 0); }
}
__device__ __forceinline__ int v_st(int k, int c) { const int kk = (k & ~0xC) | ((k & 4) << 1) | ((k & 8) >> 1); return ((kk >> 3) * 4 + (c >> 5)) * 512 + ((kk & 7) * 32 + (c & 31)) * 2; }
__device__ __forceinline__ int v_rd_base(int lane) { return ((lane & 3) << 3) | (((lane >> 2) & 3) << 6) | (((lane >> 4) & 1) << 5) | (((lane >> 5) & 1) << 8); }
constexpr int v_rd_off(int d0, int ks, int half) { return d0 * 512 + ks * 4096 + half * 2048; }
template <int OFF> __device__ __forceinline__ s16x4 tr_read(int vb) {
  s16x4 r; asm volatile("ds_read_b64_tr_b16 %0, %1 offset:%2" : "=&v"(r) : "v"(vb), "i"(OFF) : "memory"); return r;
}
template <int D0> __device__ __forceinline__ void pv_one(f32x16& od, int vb, bf16x8 pa0, bf16x8 pa1, bf16x8 pa2, bf16x8 pa3) {
  const s16x4 l0 = tr_read<v_rd_off(D0, 0, 0)>(vb), h0 = tr_read<v_rd_off(D0, 0, 1)>(vb), l1 = tr_read<v_rd_off(D0, 1, 0)>(vb), h1 = tr_read<v_rd_off(D0, 1, 1)>(vb);
  const s16x4 l2 = tr_read<v_rd_off(D0, 2, 0)>(vb), h2 = tr_read<v_rd_off(D0, 2, 1)>(vb), l3 = tr_read<v_rd_off(D0, 3, 0)>(vb), h3 = tr_read<v_rd_off(D0, 3, 1)>(vb);
  asm volatile("s_waitcnt lgkmcnt(0)" ::: "memory"); SBAR();
#define PKV(L, H) (bf16x8){L[0], L[1], L[2], L[3], H[0], H[1], H[2], H[3]}
  od = __builtin_amdgcn_mfma_f32_32x32x16_bf16(pa0, PKV(l0, h0), od, 0, 0, 0);
  od = __builtin_amdgcn_mfma_f32_32x32x16_bf16(pa1, PKV(l1, h1), od, 0, 0, 0);
  od = __builtin_amdgcn_mfma_f32_32x32x16_bf16(pa2, PKV(l2, h2), od, 0, 0, 0);
  od = __builtin_amdgcn_mfma_f32_32x32x16_bf16(pa3, PKV(l3, h3), od, 0, 0, 0);
#undef PKV
}
__device__ __forceinline__ void pv_d0(f32x16* o, int vb, bf16x8 pa0, bf16x8 pa1, bf16x8 pa2, bf16x8 pa3) {
  pv_one<0>(o[0], vb, pa0, pa1, pa2, pa3); pv_one<1>(o[1], vb, pa0, pa1, pa2, pa3); pv_one<2>(o[2], vb, pa0, pa1, pa2, pa3); pv_one<3>(o[3], vb, pa0, pa1, pa2, pa3);
}
__device__ __forceinline__ void wmask(f32x16& p0, f32x16& p1, int kb, int qp, int hi) {
  const int bd = kb - qp + 4 * hi + 128;
#pragma unroll
  for (int r = 0; r < 16; ++r) { const int d0 = bd + (r & 3) + 8 * (r >> 2);
    if ((unsigned)d0 > 256u) p0[r] = -1e30f; if ((unsigned)(d0 + 32) > 256u) p1[r] = -1e30f; }
}
__device__ __forceinline__ void attn_unit(const bool WIN, const bf16* Qb, bf16* Ob, const bf16* __restrict__ Kh, const bf16* __restrict__ Vh, int NT, int kstart, int q0, float sink_l2, char* lds) {
  int tid_ = threadIdx.x; asm volatile("" : "+v"(tid_));
  const int tid = tid_, wid = tid >> 6, lane = tid & 63, r32 = lane & 31, hi = lane >> 5;
  bf16* V_lds = (bf16*)lds; bf16* K_lds = (bf16*)(lds + 2 * SHM_V);
  float* ws = (float*)(lds + 2 * SHM_V + 2 * SHM_K) + wid * 64; float* li_l = ws; float* al_l = ws + 32;
  float m_reg = -1e30f, l_reg = 0; f32x16 o[4] = {}; bf16x8 qr[8];
  const bf16* Qw = Qb + (long)(wid * QBLK + r32) * LDQ + hi * 8;
#pragma unroll
  for (int d0 = 0; d0 < 8; ++d0) qr[d0] = *reinterpret_cast<const bf16x8*>(Qw + d0 * 16);
  const int sr = tid >> 4, sc = (tid & 15) * 8, vst0 = v_st(sr, sc), vst1 = v_st(32 + sr, sc);
  const int vb0 = (int)(uintptr_t)V_lds + v_rd_base(lane);
  const int qp = q0 + wid * QBLK + r32;
  struct { bf16x8 vs0, vs1, ks0, ks1; } sr_[SDEPTH];
#define TROW(t) (WIN ? ((t) < 4 ? (t) * KVBLK : kstart + (t) * KVBLK) : (t) * KVBLK)
#define SLOAD(i, t) do { const int k0_ = TROW(t); sr_[i].vs0 = *reinterpret_cast<const bf16x8*>(&Vh[(long)(k0_ + sr) * LDK + sc]); sr_[i].vs1 = *reinterpret_cast<const bf16x8*>(&Vh[(long)(k0_ + 32 + sr) * LDK + sc]); \
    sr_[i].ks0 = *reinterpret_cast<const bf16x8*>(&Kh[(long)(k0_ + sr) * LDK + sc]); sr_[i].ks1 = *reinterpret_cast<const bf16x8*>(&Kh[(long)(k0_ + 32 + sr) * LDK + sc]); } while (0)
#define SWRITE(b, i) do { *(bf16x8*)((char*)V_lds + (b) * SHM_V + vst0) = sr_[i].vs0;          \
    *(bf16x8*)((char*)V_lds + (b) * SHM_V + vst1) = sr_[i].vs1; int kc = sc * 2;               \
    *(bf16x8*)((char*)K_lds + (b) * SHM_K + KSWZ(sr, kc)) = sr_[i].ks0;                       \
    *(bf16x8*)((char*)K_lds + (b) * SHM_K + KSWZ(32 + sr, kc)) = sr_[i].ks1; } while (0)
#define SWAIT() do { if constexpr (SDEPTH == 2) asm volatile("s_waitcnt vmcnt(4)" ::: "memory"); else asm volatile("s_waitcnt vmcnt(0)" ::: "memory"); } while (0)
#define RESC(a) do { if (__any((a) < 1.f)) { if (hi == 0) al_l[r32] = (a); asm volatile("s_waitcnt lgkmcnt(0)" ::: "memory"); \
    for (int d = 0; d < 4; ++d) for (int r = 0; r < 16; ++r) o[d][r] *= al_l[crow(r, hi)]; } } while (0)
#define WMASK(P0, P1, t) do { if (WIN) { if ((t) >= 4) wmask(P0, P1, kstart + ((t) - 4) * KVBLK, qp, hi); } } while (0)
  f32x16 pA0, pA1, pB0, pB1; float mnA, mnB, alA, alB; bf16x8 pa0, pa1, pa2, pa3;
  constexpr int SE = 0, SO = SDEPTH - 1;
  SLOAD(SE, 0); asm volatile("s_waitcnt vmcnt(0)" ::: "memory"); SWRITE(0, SE); __syncthreads();
  qkt(pA0, pA1, K_lds, qr, r32, hi); WMASK(pA0, pA1, 0); partialSM(pA0, pA1, m_reg, mnA, alA);
  SLOAD(SO, 1); if constexpr (SDEPTH == 2) { if (2 < NT) SLOAD(SE, 2); }
  SWAIT(); SWRITE(1, SO); __syncthreads();
  for (int j = 1; j + 1 < NT; j += 2) {
    SBAR(); qkt(pB0, pB1, (bf16*)((char*)K_lds + SHM_K), qr, r32, hi); WMASK(pB0, pB1, j);
    finishSM(pA0, pA1, alA, l_reg, pa0, pa1, pa2, pa3); SBAR();
    SLOAD(SO, j + SDEPTH); SBAR();
    pv_d0(o, vb0, pa0, pa1, pa2, pa3); partialSM(pB0, pB1, m_reg, mnB, alB);
    __syncthreads(); SWAIT(); SWRITE(0, SE);
    RESC(alB); __syncthreads();
    SBAR(); qkt(pA0, pA1, K_lds, qr, r32, hi); WMASK(pA0, pA1, j + 1);
    finishSM(pB0, pB1, alB, l_reg, pa0, pa1, pa2, pa3); SBAR();
    if (SDEPTH == 1 || j + 3 < NT) SLOAD(SE, j + 1 + SDEPTH); SBAR();
    pv_d0(o, vb0 + (int)SHM_V, pa0, pa1, pa2, pa3); partialSM(pA0, pA1, m_reg, mnA, alA);
    __syncthreads(); SWAIT(); SWRITE(1, SO);
    RESC(alA); __syncthreads();
  }
  SBAR(); qkt(pB0, pB1, (bf16*)((char*)K_lds + SHM_K), qr, r32, hi); WMASK(pB0, pB1, NT - 1);
  finishSM(pA0, pA1, alA, l_reg, pa0, pa1, pa2, pa3); SBAR();
  pv_d0(o, vb0, pa0, pa1, pa2, pa3); partialSM(pB0, pB1, m_reg, mnB, alB);
  __syncthreads(); RESC(alB);
  finishSM(pB0, pB1, alB, l_reg, pa0, pa1, pa2, pa3); SBAR();
  pv_d0(o, vb0 + (int)SHM_V, pa0, pa1, pa2, pa3);
  if (WIN) { constexpr float C = SCALE * 1.4426950408889634f; l_reg += __builtin_amdgcn_exp2f(sink_l2 - m_reg * C); }
  if (hi == 0) li_l[r32] = l_reg; asm volatile("s_waitcnt lgkmcnt(0)" ::: "memory");
  float rli[16];
#pragma unroll
  for (int r = 0; r < 16; ++r) rli[r] = __builtin_amdgcn_rcpf(li_l[crow(r, hi)]);
  bf16* Ow = Ob + (long)(wid * QBLK) * LDQ;
#pragma unroll
  for (int r = 0; r < 16; ++r) { const int orow = crow(r, hi);
#pragma unroll
    for (int d0 = 0; d0 < 4; ++d0) { const float v = o[d0][r] * rli[r]; Ow[(long)orow * LDQ + d0 * 32 + r32] = (bf16)(cvtpk(v, v) & 0xffffu); } }
  __syncthreads();
#undef TROW
#undef SLOAD
#undef SWRITE
#undef SWAIT
#undef RESC
#undef WMASK
}
#undef KSWZ
#undef SBAR
}

namespace mk {
namespace cg = cooperative_groups;
typedef unsigned short bf16;
typedef short bf16x8 __attribute__((ext_vector_type(8)));
typedef float f32x4 __attribute__((ext_vector_type(4)));
typedef unsigned u32x4 __attribute__((ext_vector_type(4)));
typedef unsigned u32x2 __attribute__((ext_vector_type(2)));
typedef __bf16 bf2_t __attribute__((ext_vector_type(2)));
#define LAS __attribute__((address_space(3)))
constexpr int NWAVES = 8, NTHR = 512;
constexpr size_t MiB = 1u << 20;
constexpr size_t WS_CTL = 0, CTL_BYTES = 1 * MiB;
constexpr size_t WS_MOD = 1 * MiB;
constexpr size_t WS_XC = 2 * MiB;
constexpr size_t WS_WQKV = 6 * MiB;
constexpr size_t WS_WO = 12 * MiB;
constexpr size_t WS_WP = 16 * MiB;
constexpr size_t WS_H = 24 * MiB;
constexpr size_t WS_Q = 58 * MiB;
constexpr size_t WS_K = 92 * MiB;
constexpr size_t WS_V = 101 * MiB;
constexpr size_t WS_EIDX = 110 * MiB;
constexpr size_t WS_GATE = 119 * MiB;
constexpr size_t WS_PW = 128 * MiB;
constexpr size_t WS_S = 137 * MiB;
constexpr size_t WS_UT = 274 * MiB;
constexpr size_t WS_VT = 306 * MiB;
constexpr size_t WS_O = 338 * MiB;
constexpr size_t WS_XB = 372 * MiB;
constexpr size_t WS_XCB = 436 * MiB;
constexpr size_t WS_PART = 440 * MiB;
constexpr size_t WS_END = 508 * MiB;
constexpr float U8_SCALE = 64.f, V8_SCALE = 8.f;
constexpr int LDS_BYTES = 155648;
constexpr int NPHASE = 23;

struct Args { const float* in[17]; float* out; unsigned char* ws; int ph_lo, ph_hi; };

constexpr int PTAB_OFF = 153600;
struct Ctx {
  unsigned char* ws;
  int tid, lane, wave, bid, G;
  LAS unsigned char* lds; unsigned char* ldsg;
  __device__ __forceinline__ const float* in(int k) const {
    const volatile LAS unsigned* t = (const volatile LAS unsigned*)(lds + PTAB_OFF) + 2 * k;
    const unsigned lo = __builtin_amdgcn_readfirstlane(t[0]), hi = __builtin_amdgcn_readfirstlane(t[1]);
    return (const float*)(((unsigned long long)hi << 32) | lo);
  }
  __device__ __forceinline__ float* outp() const { return (float*)in(17); }
};
enum { I_X = 0, I_C, I_CTX, I_CCTX, I_ADAW, I_ADAB, I_N1G, I_N2G, I_WQKV, I_QNG, I_KNG, I_WO, I_SINKS, I_PWQ, I_PSK, I_PU, I_PV };

__device__ __forceinline__ unsigned f2bf(float f) { unsigned u = __builtin_bit_cast(unsigned, f); return (u + 0x7fffu + ((u >> 16) & 1u)) >> 16; }
__device__ __forceinline__ unsigned pk2(float lo, float hi) { unsigned r; asm volatile("v_cvt_pk_bf16_f32 %0, %1, %2" : "=v"(r) : "v"(lo), "v"(hi)); return r; }
__device__ __forceinline__ float bflo(unsigned u) { return __uint_as_float(u << 16); }
__device__ __forceinline__ float bfhi(unsigned u) { return __uint_as_float(u & 0xffff0000u); }
__device__ __forceinline__ float silu(float x) { return x / (1.f + __expf(-x)); }
__device__ __forceinline__ float gelu_tanh(float x) {
  const float y = 0.7978845608028654f * (x + 0.044715f * x * x * x);
  const float t = 1.f - 2.f / (__expf(2.f * y) + 1.f);
  return 0.5f * x * (1.f + t);
}
__device__ __forceinline__ float wave_sum(float v) {
#pragma unroll
  for (int o = 1; o < 64; o <<= 1) v += __shfl_xor(v, o);
  return v;
}
__device__ __forceinline__ const float* xrow_sel(const float* lat, const float* cx, int r) { const int b = r / RPB, j = r % RPB; return j < CTXL ? cx + (size_t)(b * CTXL + j) * DM : lat + (size_t)(b * SEQ + (j - CTXL)) * DM; }
__device__ __forceinline__ int mod_row(int r) { const int b = r / RPB, j = r % RPB; return j < CTXL ? 4 : b; }

__device__ __forceinline__ const float* st_lat(const Ctx& F, int sel) { return sel == 0 ? F.in(I_X) : (sel == 1 ? (const float*)(F.ws + WS_XB) : (const float*)F.outp()); }
__device__ __forceinline__ const float* st_ctx(const Ctx& F, int sel) { return sel == 0 ? F.in(I_CTX) : (sel == 1 ? (const float*)(F.ws + WS_XCB) : (const float*)(F.ws + WS_XC)); }
__device__ __forceinline__ void p0_transpose_item(const float* W, int K, int N, bf16* WT, LAS float* scr, int item, int lane) {
  const int nblk = N / 32, kb = item / nblk, nb = item % nblk, k0 = 64 * kb, n0 = 32 * nb;
#pragma unroll 8
  for (int i = 0; i < 32; ++i) { const int kk = 2 * i + (lane >> 5); scr[kk * 33 + (lane & 31)] = W[(size_t)(k0 + kk) * N + n0 + (lane & 31)]; }
  asm volatile("s_waitcnt lgkmcnt(0)" ::: "memory");
  const int c = lane & 7;
#pragma unroll
  for (int j = 0; j < 4; ++j) { const int n = (lane >> 3) + 8 * j; const LAS float* s = scr + (8 * c) * 33 + n;
    u32x4 o; o.x = pk2(s[0 * 33], s[1 * 33]); o.y = pk2(s[2 * 33], s[3 * 33]); o.z = pk2(s[4 * 33], s[5 * 33]); o.w = pk2(s[6 * 33], s[7 * 33]);
    *(u32x4*)(WT + (size_t)(n0 + n) * K + k0 + 8 * c) = o; }
  asm volatile("s_waitcnt lgkmcnt(0)" ::: "memory");
}

__device__ __forceinline__ void phase_prologue(const Ctx& F) {
  { LAS float* sl = (LAS float*)F.lds;
    LAS float* red = sl + 5 * DM;
    { const float* cp = F.in(I_C); const float* ccp = F.in(I_CCTX);
      for (int e = F.tid; e < 5 * DM; e += NTHR) { const int r = e / DM, j = e % DM; sl[e] = silu(r < 4 ? cp[r * DM + j] : ccp[j]); } }
    __syncthreads();
    const float* adaw = F.in(I_ADAW); const float* adab = F.in(I_ADAB);
    for (int task = F.bid; task < DEPTH * 96; task += F.G) {
      const int i = task / 96, n = (task % 96) * 64 + F.lane;
      const float* w = adaw + (size_t)i * DM * NMOD * DM + n;
      float a0 = 0.f, a1 = 0.f, a2 = 0.f, a3 = 0.f, a4 = 0.f;
#pragma unroll 8
      for (int jj = 0; jj < 128; ++jj) { const int j = F.wave * 128 + jj; const float wv = w[(size_t)j * NMOD * DM];
        a0 += sl[j] * wv; a1 += sl[DM + j] * wv; a2 += sl[2 * DM + j] * wv; a3 += sl[3 * DM + j] * wv; a4 += sl[4 * DM + j] * wv; }
      red[(F.wave * 5 + 0) * 64 + F.lane] = a0; red[(F.wave * 5 + 1) * 64 + F.lane] = a1; red[(F.wave * 5 + 2) * 64 + F.lane] = a2;
      red[(F.wave * 5 + 3) * 64 + F.lane] = a3; red[(F.wave * 5 + 4) * 64 + F.lane] = a4;
      __syncthreads();
      if (F.tid < 320) { const int r = F.tid >> 6, l = F.tid & 63; float s = 0.f;
#pragma unroll
        for (int w8 = 0; w8 < 8; ++w8) s += red[(w8 * 5 + r) * 64 + l];
        const int nn = (task % 96) * 64 + l;
        ((float*)(F.ws + WS_MOD))[((size_t)i * 5 + r) * NMOD * DM + nn] = s + adab[i * NMOD * DM + nn]; }
      __syncthreads();
    }
  }
  { LAS float* sk = (LAS float*)F.lds;
    LAS float* wq = sk + 128 * 132;
    const float* pskp = F.in(I_PSK); const float* pwqp = F.in(I_PWQ);
    for (int task = F.bid; task < DEPTH * 8 * 2 * 16; task += F.G) {
      const int jc = task & 15, half = (task >> 4) & 1, h = (task >> 5) & 7, i = task >> 8;
      const float* SK = pskp + ((size_t)i * 2 + half) * NKEYS * 128;
      const float* WQ = pwqp + (size_t)i * DM * PQN + (size_t)(jc * 64) * PQN + h * PQD + half * 128;
      for (int e = F.tid; e < 128 * 32; e += NTHR) { const int kk = e >> 5, d4 = e & 31; const f32x4 v = *(const f32x4*)(SK + (size_t)kk * 128 + d4 * 4); *(LAS f32x4*)(sk + kk * 132 + d4 * 4) = v; }
      for (int e = F.tid; e < 64 * 32; e += NTHR) { const int j = e >> 5, d4 = e & 31; const f32x4 v = *(const f32x4*)(WQ + (size_t)j * PQN + d4 * 4); *(LAS f32x4*)(wq + j * 128 + d4 * 4) = v; }
      __syncthreads();
      const int kk = F.tid & 127, jg = F.tid >> 7;
      float acc[16];
#pragma unroll
      for (int q = 0; q < 16; ++q) acc[q] = 0.f;
#pragma unroll 2
      for (int d4 = 0; d4 < 32; ++d4) { const f32x4 s = *(const LAS f32x4*)(sk + kk * 132 + d4 * 4);
#pragma unroll
        for (int q = 0; q < 16; ++q) { const f32x4 w = *(const LAS f32x4*)(wq + (jg * 16 + q) * 128 + d4 * 4); acc[q] += s.x * w.x + s.y * w.y + s.z * w.z + s.w * w.w; } }
      bf16* o = (bf16*)(F.ws + WS_WP) + ((size_t)i * PQN + h * PQD + half * 128 + kk) * DM + jc * 64 + jg * 16;
      u32x4 o0, o1; o0.x = pk2(acc[0], acc[1]); o0.y = pk2(acc[2], acc[3]); o0.z = pk2(acc[4], acc[5]); o0.w = pk2(acc[6], acc[7]);
      o1.x = pk2(acc[8], acc[9]); o1.y = pk2(acc[10], acc[11]); o1.z = pk2(acc[12], acc[13]); o1.w = pk2(acc[14], acc[15]);
      *(u32x4*)o = o0; *(u32x4*)(o + 8) = o1;
      __syncthreads();
    }
  }
  { LAS float* scr = (LAS float*)F.lds + F.wave * (64 * 33 + 16);
    const int gw = F.bid * NWAVES + F.wave, NGW = F.G * NWAVES;
    constexpr int I_QKV = (DM / 64) * (QKVD / 32), I_O = (DM / 64) * (DM / 32);
    const float* wqkvp = F.in(I_WQKV); const float* wop = F.in(I_WO);
    for (int it = gw; it < DEPTH * (I_QKV + I_O); it += NGW) {
      const int i = it / (I_QKV + I_O); int r = it % (I_QKV + I_O);
      if (r < I_QKV) p0_transpose_item(wqkvp + (size_t)i * DM * QKVD, DM, QKVD, (bf16*)(F.ws + WS_WQKV) + (size_t)i * QKVD * DM, scr, r, F.lane);
      else p0_transpose_item(wop + (size_t)i * DM * DM, DM, DM, (bf16*)(F.ws + WS_WO) + (size_t)i * DM * DM, scr, r - I_QKV, F.lane);
    }
  }
  { const size_t n16 = (size_t)DEPTH * NKEYS * NKEYS * DM / 16;
    const size_t gt = (size_t)F.bid * NTHR + F.tid, GT = (size_t)F.G * NTHR;
    const float* pup = F.in(I_PU); const float* pvp = F.in(I_PV);
    for (size_t e = gt; e < 2 * n16; e += GT) { const bool isu = e < n16; const size_t j = isu ? e : e - n16; const float sc = isu ? U8_SCALE : V8_SCALE;
      const float* src = (isu ? pup : pvp) + j * 16; const f32x4 a = *(const f32x4*)src, b = *(const f32x4*)(src + 4), c = *(const f32x4*)(src + 8), d = *(const f32x4*)(src + 12);
      u32x4 o; int v;
      v = __builtin_amdgcn_cvt_pk_fp8_f32(a.x * sc, a.y * sc, 0, false); v = __builtin_amdgcn_cvt_pk_fp8_f32(a.z * sc, a.w * sc, v, true); o.x = (unsigned)v;
      v = __builtin_amdgcn_cvt_pk_fp8_f32(b.x * sc, b.y * sc, 0, false); v = __builtin_amdgcn_cvt_pk_fp8_f32(b.z * sc, b.w * sc, v, true); o.y = (unsigned)v;
      v = __builtin_amdgcn_cvt_pk_fp8_f32(c.x * sc, c.y * sc, 0, false); v = __builtin_amdgcn_cvt_pk_fp8_f32(c.z * sc, c.w * sc, v, true); o.z = (unsigned)v;
      v = __builtin_amdgcn_cvt_pk_fp8_f32(d.x * sc, d.y * sc, 0, false); v = __builtin_amdgcn_cvt_pk_fp8_f32(d.z * sc, d.w * sc, v, true); o.w = (unsigned)v;
      const size_t row = j >> 6, c16 = j & 63, lay = row >> 14, ex = row & 16383;
      *(u32x4*)(F.ws + (isu ? WS_UT : WS_VT) + ((lay * 8 + (c16 >> 3)) * 16384 + ex) * 128 + (c16 & 7) * 16) = o; }
  }
}

__device__ __forceinline__ void phase_norm(const Ctx& F, int layer, int which  , int src_sel, bool latent_only) {
  const int gw = F.bid * NWAVES + F.wave, NGW = F.G * NWAVES;
  const float* gain = (which == 0 ? F.in(I_N1G) : F.in(I_N2G)) + layer * DM;
  const float* modl = (const float*)(F.ws + WS_MOD) + (size_t)layer * 5 * NMOD * DM;
  bf16* H = (bf16*)(F.ws + WS_H);
  const float* latp = st_lat(F, src_sel); const float* cxp = st_ctx(F, src_sel);
  for (int r = gw; r < NROWS; r += NGW) {
    if (latent_only && (r % RPB) < CTXL) continue;
    const float* xr = xrow_sel(latp, cxp, r);
    const float* mrow = modl + (size_t)mod_row(r) * NMOD * DM;
    const float* sh = mrow + (which == 0 ? 0 : 3) * DM; const float* sc = mrow + (which == 0 ? 1 : 4) * DM;
    f32x4 v[4]; float s = 0.f;
#pragma unroll
    for (int j = 0; j < 4; ++j) { v[j] = ((const f32x4*)xr)[F.lane + 64 * j]; s += (v[j].x * v[j].x + v[j].y * v[j].y) + (v[j].z * v[j].z + v[j].w * v[j].w); }
    const float rstd = rsqrtf(wave_sum(s) * (1.f / DM) + RMS_EPS);
    unsigned long long* o8 = (unsigned long long*)(H + (size_t)r * DM) + F.lane;
#pragma unroll
    for (int j = 0; j < 4; ++j) { const f32x4 g = ((const f32x4*)gain)[F.lane + 64 * j], a = ((const f32x4*)sc)[F.lane + 64 * j], b = ((const f32x4*)sh)[F.lane + 64 * j];
      const float y0 = v[j].x * rstd * g.x * (1.f + a.x) + b.x, y1 = v[j].y * rstd * g.y * (1.f + a.y) + b.y, y2 = v[j].z * rstd * g.z * (1.f + a.z) + b.z, y3 = v[j].w * rstd * g.w * (1.f + a.w) + b.w;
      o8[64 * j] = (unsigned long long)pk2(y0, y1) | ((unsigned long long)pk2(y2, y3) << 32); }
  }
}

__device__ __forceinline__ void phase_qknorm(const Ctx& F, int layer) {
  const int gw = F.bid * NWAVES + F.wave, NGW = F.G * NWAVES;
  const int axis = F.lane >> 5, f = F.lane & 31, e1 = axis * 64 + f, e2 = e1 + 32;
  const float* qg = F.in(I_QNG) + layer * HD; const float* kg = F.in(I_KNG) + layer * HD;
  const float qg1 = qg[e1], qg2 = qg[e2], kg1 = kg[e1], kg2 = kg[e2];
  const float inv = exp2f(-(float)(2 * f) * (13.287712379549449f / 64.f));
  bf16* Q = (bf16*)(F.ws + WS_Q); bf16* K = (bf16*)(F.ws + WS_K);
  for (int r = gw; r < NROWS; r += NGW) {
    const int j = r % RPB; float cs = 1.f, sn = 0.f;
    if (j >= CTXL) { const int sp = j - CTXL; const float pos = (float)(axis == 0 ? (sp >> 6) : (sp & 63)); sincosf(pos * inv, &sn, &cs); }
#pragma unroll
    for (int h = 0; h < NH + NKV; ++h) {
      bf16* base = h < NH ? Q + (size_t)r * DM + h * HD : K + (size_t)r * (NKV * HD) + (h - NH) * HD;
      float x1 = bflo(base[e1]), x2 = bflo(base[e2]);
      const float rstd = rsqrtf(wave_sum(x1 * x1 + x2 * x2) * (1.f / HD) + RMS_EPS);
      x1 *= rstd * (h < NH ? qg1 : kg1); x2 *= rstd * (h < NH ? qg2 : kg2);
      const float y1 = x1 * cs - x2 * sn, y2 = x1 * sn + x2 * cs;
      base[e1] = (bf16)f2bf(y1); base[e2] = (bf16)f2bf(y2);
    }
  }
}
struct Order {
  int nM, nN, nwg, G, c, lat;
  __device__ void init(int nM_, int nN_, int G_, int c_, int lat_) { nM = nM_; nN = nN_; nwg = nM * nN; G = G_; c = c_; lat = lat_; }
  __device__ bool next(int i, pg8::Unit& u) const {
    const long L = (long)i * G + c; if (L >= nwg) return false;
    int wgid = (int)L; { const int q = nwg / 8, r = nwg % 8, xcd = wgid % 8, off = wgid / 8; wgid = (xcd < r ? xcd * (q + 1) : r * (q + 1) + (xcd - r) * q) + off; }
    const int WGM = 8, nig = WGM * nN, gid = wgid / nig, fm = gid * WGM, gsz = (nM - fm) < WGM ? (nM - fm) : WGM;
    int pm = fm + ((wgid % nig) % gsz); u.pn = (wgid % nig) / gsz;
    if (lat) pm = (pm >> 4) * 17 + 1 + (pm & 15);
    u.pm = pm; return true;
  }
  __device__ __forceinline__ void a_ready(const pg8::Unit&) const {}
  __device__ __forceinline__ void done(const pg8::Unit&) const {}
};
struct EpiQKV {
  static constexpr bool PERM = true, AFTER_DRAIN = false;
  unsigned char* ws;
  __device__ __forceinline__ void operator()(const pg8::f32x4 (&acc)[2][2][4][2], const pg8::Unit& u, int wr, int wc, int fr, int fq) const {
    const int row0 = u.pm * 256 + wr * 64 + fr;
    const size_t boff = u.pn < 4 ? WS_Q : (u.pn == 4 ? WS_K : WS_V); const int ldc = u.pn < 4 ? DM : NKV * HD, colt = u.pn < 4 ? u.pn * 256 : 0;
    bf16* base = (bf16*)(ws + boff);
    const int col0 = colt + wc * 32 + 8 * fq;
#pragma unroll
    for (int ai = 0; ai < 2; ++ai)
#pragma unroll
      for (int m = 0; m < 4; ++m) { bf16* rowp = base + (size_t)(row0 + ai * 128 + m * 16) * ldc + col0;
#pragma unroll
        for (int bj = 0; bj < 2; ++bj) { const pg8::f32x4 v0 = acc[ai][bj][m][0], v1 = acc[ai][bj][m][1];
          u32x4 w; w.x = pk2(v0[0], v0[1]); w.y = pk2(v0[2], v0[3]); w.z = pk2(v1[0], v1[1]); w.w = pk2(v1[2], v1[3]);
          *(u32x4*)(rowp + bj * 128) = w; } }
  }
};
struct EpiRes {
  static constexpr bool PERM = false, AFTER_DRAIN = false;
  const float *xin, *cin; float *xout, *xc; const float* gmod  ;
  __device__ __forceinline__ void operator()(const pg8::f32x4 (&acc)[2][2][4][2], const pg8::Unit& u, int wr, int wc, int fr, int fq) const {
    const int col0 = u.pn * 256 + wc * 32 + 4 * fq;
#pragma unroll
    for (int ai = 0; ai < 2; ++ai)
#pragma unroll
      for (int m = 0; m < 4; ++m) { const int r = u.pm * 256 + ai * 128 + wr * 64 + m * 16 + fr;
        const int b_ = r / RPB, j_ = r % RPB; const size_t oc = (size_t)(b_ * CTXL + j_) * DM, ol = (size_t)(b_ * SEQ + (j_ - CTXL)) * DM;
        float* xn = j_ < CTXL ? xc + oc : xout + ol; const float* xo = j_ < CTXL ? cin + oc : xin + ol; const float* g = gmod + (size_t)(j_ < CTXL ? 4 : b_) * NMOD * DM;
#pragma unroll
        for (int bj = 0; bj < 2; ++bj)
#pragma unroll
          for (int n = 0; n < 2; ++n) { const int c = col0 + bj * 128 + n * 16; const f32x4 xv = *(const f32x4*)(xo + c), gv = *(const f32x4*)(g + c); const pg8::f32x4 a = acc[ai][bj][m][n];
            f32x4 o; o.x = xv.x + gv.x * a[0]; o.y = xv.y + gv.y * a[1]; o.z = xv.z + gv.z * a[2]; o.w = xv.w + gv.w * a[3]; *(f32x4*)(xn + c) = o; } }
  }
};
struct EpiF32 {
  static constexpr bool PERM = false, AFTER_DRAIN = false;
  float* S; int ldc;
  __device__ __forceinline__ void operator()(const pg8::f32x4 (&acc)[2][2][4][2], const pg8::Unit& u, int wr, int wc, int fr, int fq) const {
    const int col0 = u.pn * 256 + wc * 32 + 4 * fq;
#pragma unroll
    for (int ai = 0; ai < 2; ++ai)
#pragma unroll
      for (int m = 0; m < 4; ++m) { float* rowp = S + (size_t)(u.pm * 256 + ai * 128 + wr * 64 + m * 16 + fr) * ldc + col0;
#pragma unroll
        for (int bj = 0; bj < 2; ++bj)
#pragma unroll
          for (int n = 0; n < 2; ++n) { const pg8::f32x4 a = acc[ai][bj][m][n]; f32x4 o; o.x = a[0]; o.y = a[1]; o.z = a[2]; o.w = a[3]; *(f32x4*)(rowp + bj * 128 + n * 16) = o; } }
  }
};

__device__ __forceinline__ void phase_attn(const Ctx& F, int layer) {
  const bf16* Q = (const bf16*)(F.ws + WS_Q); const bf16* K = (const bf16*)(F.ws + WS_K); const bf16* V = (const bf16*)(F.ws + WS_V);
  char* lds = (char*)F.ldsg;
  const int pair = F.bid & 7, slot = F.bid >> 3, nslot = F.G >> 3;
  const int b = pair >> 1, g = pair & 1;
  const bf16* Kh = K + (size_t)(b * RPB) * (NKV * HD) + g * HD; const bf16* Vh = V + (size_t)(b * RPB) * (NKV * HD) + g * HD;
  const float* sinkp = F.in(I_SINKS);
  const int nunits = layer == 0 ? 68 : 64;
#pragma unroll 1
  for (int u = slot; u < nunits; u += nslot) {
    int h, NT, ks = 0, q0 = 0; float sk = 0.f; const bf16* Qb; const bool win = layer != 0;
    if (u < 64) { h = g * 4 + (u >> 4); const int qb = u & 15; Qb = Q + (size_t)(b * RPB + CTXL + qb * 256) * DM + h * HD;
      if (!win) NT = RPB / 64;
      else { q0 = qb * 256; ks = q0 - 128 < 0 ? 0 : q0 - 128; const int ke = q0 + 384 > SEQ ? SEQ : q0 + 384; NT = 4 + (ke - ks) / 64; sk = sinkp[(layer / 2) * NH + h] * 1.4426950408889634f; } }
    else { h = g * 4 + (u - 64); Qb = Q + (size_t)(b * RPB) * DM + h * HD; NT = CTXL / 64; }
    att::attn_unit(win, Qb, (bf16*)(F.ws + WS_O) + (Qb - Q), Kh, Vh, NT, ks, q0, sk, lds);
  }
}

__device__ __forceinline__ void ins16(float (&v)[16], float x) {
#pragma unroll
  for (int i = 0; i < 16; ++i) { const float hi = fmaxf(v[i], x); x = fminf(v[i], x); v[i] = hi; }
}
__device__ __forceinline__ void phase_topk(const Ctx& F, bool latent_only) {
  LAS float* sc = (LAS float*)F.lds;
  LAS unsigned* T = (LAS unsigned*)(F.lds + 512 * 65 * 4);
  const float* S = (const float*)(F.ws + WS_S); int* EIDX = (int*)(F.ws + WS_EIDX); float* GATE = (float*)(F.ws + WS_GATE);
  const int ngroups = NROWS / 16;
  for (int grp = F.bid; grp < ngroups; grp += F.G) {
    const int r0 = grp * 16;
    if (latent_only && (r0 % RPB) < CTXL) continue;
#pragma unroll 4
    for (int it = 0; it < 16; ++it) { const int e4 = it * NTHR + F.tid, rl = e4 >> 9, c = (e4 & 511) * 4;
      const f32x4 v = *(const f32x4*)(S + (size_t)(r0 + rl) * PQN + c); LAS float* d = sc + (rl * 32 + (c >> 6)) * 65 + (c & 63);
      d[0] = v.x; d[1] = v.y; d[2] = v.z; d[3] = v.w; }
    __syncthreads();
    float v[16];
#pragma unroll
    for (int i = 0; i < 16; ++i) v[i] = -INFINITY;
    { const LAS float* my = sc + F.tid * 65; const unsigned eb = (F.tid & 1) * 64;
#pragma unroll 8
      for (int e = 0; e < 64; ++e) { const unsigned key = (__float_as_uint(my[e]) & ~127u) | (eb + e); ins16(v, __uint_as_float(key)); } }
    { float o[16];
#pragma unroll
      for (int i = 0; i < 16; ++i) o[i] = __shfl_xor(v[i], 1);
#pragma unroll
      for (int i = 0; i < 16; ++i) ins16(v, o[i]); }
    if ((F.tid & 1) == 0) {
#pragma unroll
      for (int i = 0; i < 16; ++i) T[(F.tid >> 1) * 16 + i] = __float_as_uint(v[i]); }
    __syncthreads();
    if (F.tid < 128) {
      const int rl = F.tid >> 3, head = F.tid & 7, p1 = (rl * 16 + head * 2) * 16, p2 = p1 + 16;
      float a[16], bq[16];
#pragma unroll
      for (int i = 0; i < 16; ++i) { a[i] = __uint_as_float(T[p1 + i] & ~127u); bq[i] = __uint_as_float(T[p2 + i] & ~127u); }
      float w[16];
#pragma unroll
      for (int i = 0; i < 16; ++i) w[i] = -INFINITY;
#pragma unroll
      for (int ia = 0; ia < 16; ++ia)
#pragma unroll
        for (int ib = 0; ib < 16; ++ib) if ((ia + 1) * (ib + 1) <= 16) { const float s = a[ia] + bq[ib]; ins16(w, __uint_as_float((__float_as_uint(s) & ~255u) | (unsigned)(ia * 16 + ib))); }
      float ts[16]; int ex[16];
#pragma unroll
      for (int k = 0; k < 16; ++k) { const unsigned id = __float_as_uint(w[k]) & 255u; const unsigned k1 = T[p1 + (id >> 4)], k2 = T[p2 + (id & 15)];
        ts[k] = __uint_as_float(k1 & ~127u) + __uint_as_float(k2 & ~127u); ex[k] = (int)((k1 & 127u) * NKEYS + (k2 & 127u)); }
      float m = ts[0];
#pragma unroll
      for (int k = 1; k < 16; ++k) m = fmaxf(m, ts[k]);
      float l = 0.f;
#pragma unroll
      for (int k = 0; k < 16; ++k) { ts[k] = __expf(ts[k] - m); l += ts[k]; }
      const float il = 1.f / l; const size_t ob = (size_t)(r0 + rl) * 128 + head * 16;
#pragma unroll
      for (int k = 0; k < 16; k += 4) { *(int4*)(EIDX + ob + k) = make_int4(ex[k], ex[k + 1], ex[k + 2], ex[k + 3]);
        f32x4 gv; gv.x = ts[k] * il; gv.y = ts[k + 1] * il; gv.z = ts[k + 2] * il; gv.w = ts[k + 3] * il; *(f32x4*)(GATE + ob + k) = gv; }
    }
    __syncthreads();
  }
}

typedef float f32x2 __attribute__((ext_vector_type(2)));
__device__ __forceinline__ float dpp_ror_add(float x, int) { return x; }
#define ROW_ROR_ADD(x, n) do { const int xi_ = __builtin_bit_cast(int, x); x += __builtin_bit_cast(float, __builtin_amdgcn_update_dpp(0, xi_, 0x120 + (n), 0xf, 0xf, false)); } while (0)
__device__ __forceinline__ float dot16_fp8(u32x4 q, const float* h, float acc) {
  const int q0 = (int)q.x, q1 = (int)q.y, q2 = (int)q.z, q3 = (int)q.w; f32x2 t;
  t = __builtin_amdgcn_cvt_pk_f32_fp8(q0, false); acc = fmaf(t.x, h[0], acc); acc = fmaf(t.y, h[1], acc); t = __builtin_amdgcn_cvt_pk_f32_fp8(q0, true); acc = fmaf(t.x, h[2], acc); acc = fmaf(t.y, h[3], acc);
  t = __builtin_amdgcn_cvt_pk_f32_fp8(q1, false); acc = fmaf(t.x, h[4], acc); acc = fmaf(t.y, h[5], acc); t = __builtin_amdgcn_cvt_pk_f32_fp8(q1, true); acc = fmaf(t.x, h[6], acc); acc = fmaf(t.y, h[7], acc);
  t = __builtin_amdgcn_cvt_pk_f32_fp8(q2, false); acc = fmaf(t.x, h[8], acc); acc = fmaf(t.y, h[9], acc); t = __builtin_amdgcn_cvt_pk_f32_fp8(q2, true); acc = fmaf(t.x, h[10], acc); acc = fmaf(t.y, h[11], acc);
  t = __builtin_amdgcn_cvt_pk_f32_fp8(q3, false); acc = fmaf(t.x, h[12], acc); acc = fmaf(t.y, h[13], acc); t = __builtin_amdgcn_cvt_pk_f32_fp8(q3, true); acc = fmaf(t.x, h[14], acc); acc = fmaf(t.y, h[15], acc);
  return acc;
}
constexpr int PCH = 16, PNCH = NROWS / PCH;
#ifndef UREP
#define UREP 1
#endif
#ifndef VREP
#define VREP 1
#endif
__device__ __forceinline__ unsigned xcc_id() { return (unsigned)__builtin_amdgcn_s_getreg((3 << 11) | 20) & 7u; }
__device__ __forceinline__ unsigned q_pull(unsigned* q, int lane) { unsigned c = 0; if (lane == 0) c = __hip_atomic_fetch_add(q, 1u, __ATOMIC_RELAXED, __HIP_MEMORY_SCOPE_AGENT); return (unsigned)__builtin_amdgcn_readfirstlane((int)c); }
__device__ __forceinline__ void phase_peer_u(const Ctx& F, int layer, bool latent_only) {
  unsigned* qb = (unsigned*)(F.ws + WS_CTL) + 8192 + (layer * 2 + 0) * 8 * 64;
  const int* EIDX = (const int*)(F.ws + WS_EIDX);
  LAS unsigned* lst = (LAS unsigned*)(F.lds + F.wave * 4096);
  LAS float* pl = (LAS float*)(F.lds + F.wave * 4096 + 1024);
  const int g = F.lane >> 3;
  const int i0 = ((F.lane >> 2) & 1) * 8 + ((F.lane >> 1) & 1) * 4 + (F.lane & 1) * 2;
  const int myx = (int)xcc_id();
#pragma unroll 1
  for (int sx = 0; sx < 8; ++sx) {
    const int slice = (myx + sx) & 7;
    const bf16* H = (const bf16*)(F.ws + WS_H) + slice * 128 + (F.lane & 7) * 16;
    const unsigned char* U = F.ws + WS_UT + ((size_t)layer * 8 + slice) * NKEYS * NKEYS * 128 + (F.lane & 7) * 16;
    float* PART = (float*)(F.ws + WS_PART) + slice * 128;
    unsigned c = q_pull(qb + slice * 64, F.lane);
#pragma unroll 1
    while (c < (unsigned)PNCH) {
      const unsigned cn = q_pull(qb + slice * 64, F.lane);
      const int rbeg = (int)c * PCH;
      if (!(latent_only && (rbeg % RPB) < CTXL)) {
        unsigned e0, e1; u32x4 h0, h1;
#define UPREF(R) do { e0 = (unsigned)EIDX[(size_t)(R) * 128 + F.lane]; e1 = (unsigned)EIDX[(size_t)(R) * 128 + 64 + F.lane]; h0 = *(const u32x4*)(H + (size_t)(R) * DM); h1 = *(const u32x4*)(H + (size_t)(R) * DM + 8); } while (0)
#define UGATHER(QV, HH, LOFF, RNEXT, HASNEXT) do { lst[(LOFF) + F.lane] = e0; lst[(LOFF) + 64 + F.lane] = e1; \
          HH[0] = bflo(h0.x); HH[1] = bfhi(h0.x); HH[2] = bflo(h0.y); HH[3] = bfhi(h0.y); HH[4] = bflo(h0.z); HH[5] = bfhi(h0.z); HH[6] = bflo(h0.w); HH[7] = bfhi(h0.w); \
          HH[8] = bflo(h1.x); HH[9] = bfhi(h1.x); HH[10] = bflo(h1.y); HH[11] = bfhi(h1.y); HH[12] = bflo(h1.z); HH[13] = bfhi(h1.z); HH[14] = bflo(h1.w); HH[15] = bfhi(h1.w); \
          if (HASNEXT) UPREF(RNEXT); \
          asm volatile("s_waitcnt lgkmcnt(0)" ::: "memory"); \
          _Pragma("unroll") for (int i = 0; i < 16; ++i) QV[i] = *(const u32x4*)(U + (size_t)lst[(LOFF) + 8 * i + g] * 128); } while (0)
#define UMATH(QV, HH, R) do { float p[16]; \
          _Pragma("unroll") for (int i = 0; i < 16; ++i) p[i] = dot16_fp8(QV[i], HH, 0.f); \
          _Pragma("unroll") for (int m = 4; m >= 1; m >>= 1) { const bool up = (F.lane & m) != 0; const int n = 2 * m; \
            _Pragma("unroll") for (int j = 0; j < n; ++j) { const float send = up ? p[j] : p[j + n], keep = up ? p[j + n] : p[j]; p[j] = keep + __shfl_xor(send, m); } } \
          pl[8 * i0 + g] = p[0]; pl[8 * i0 + 8 + g] = p[1]; \
          asm volatile("s_waitcnt lgkmcnt(0)" ::: "memory"); \
          float* po = PART + (size_t)(R) * 1024 + F.lane; po[0] = pl[F.lane]; po[64] = pl[64 + F.lane]; } while (0)
        u32x4 qa[16], qb_[16]; float ha[16], hb[16];
        UPREF(rbeg);
        UGATHER(qa, ha, 0, rbeg + 1, true);
#pragma unroll 1
        for (int it = 0; it < PCH; it += 2) { const int r = rbeg + it;
          UGATHER(qb_, hb, 128, r + 2, it + 2 < PCH);
          UMATH(qa, ha, r);
          if (it + 2 < PCH) UGATHER(qa, ha, 0, r + 3, it + 3 < PCH);
          UMATH(qb_, hb, r + 1);
        }
#undef UPREF
#undef UGATHER
#undef UMATH
      }
      c = cn;
    }
  }
}

__device__ __forceinline__ void phase_peer_w(const Ctx& F, bool latent_only) {
  const int gw = F.bid * NWAVES + F.wave, NGW = F.G * NWAVES;
  const float* PART = (const float*)(F.ws + WS_PART); const float* GATE = (const float*)(F.ws + WS_GATE); float* PW = (float*)(F.ws + WS_PW);
  for (int r = gw; r < NROWS; r += NGW) {
    if (latent_only && (r % RPB) < CTXL) continue;
    float a = 0.f, b = 0.f;
#pragma unroll
    for (int x = 0; x < 8; ++x) { a += PART[(size_t)r * 1024 + x * 128 + F.lane]; b += PART[(size_t)r * 1024 + x * 128 + 64 + F.lane]; }
    const size_t o = (size_t)r * 128 + F.lane;
    PW[o] = GATE[o] * gelu_tanh(a * (1.f / U8_SCALE)); PW[o + 64] = GATE[o + 64] * gelu_tanh(b * (1.f / U8_SCALE));
  }
}

__device__ __forceinline__ void phase_peer_v(const Ctx& F, int layer, bool latent_only) {
  unsigned* qb = (unsigned*)(F.ws + WS_CTL) + 8192 + (layer * 2 + 1) * 8 * 64;
  const int* EIDX = (const int*)(F.ws + WS_EIDX); const float* PW = (const float*)(F.ws + WS_PW);
  const float* g2 = (const float*)(F.ws + WS_MOD) + (size_t)layer * 5 * NMOD * DM + 5 * DM;
  const float* outl = F.outp();
  LAS u32x2* ew = (LAS u32x2*)(F.lds + F.wave * 4096);
  const int g = F.lane >> 3;
  const int myx = (int)xcc_id();
#pragma unroll 1
  for (int sx = 0; sx < 8; ++sx) {
    const int slice = (myx + sx) & 7;
    const unsigned char* V = F.ws + WS_VT + ((size_t)layer * 8 + slice) * NKEYS * NKEYS * 128 + (F.lane & 7) * 16;
    const int dl = slice * 128 + (F.lane & 7) * 16 + ((F.lane >> 5) & 1) * 8 + ((F.lane >> 4) & 1) * 4 + ((F.lane >> 3) & 1) * 2;
    unsigned c = q_pull(qb + slice * 64, F.lane);
#pragma unroll 1
    while (c < (unsigned)PNCH) {
      const unsigned cn = q_pull(qb + slice * 64, F.lane);
      const int rbeg = (int)c * PCH;
      if (!(latent_only && (rbeg % RPB) < CTXL)) {
        unsigned ea, eb; float wpa, wpb;
#define VPREF(R) do { const size_t o_ = (size_t)(R) * 128 + F.lane; ea = (unsigned)EIDX[o_]; eb = (unsigned)EIDX[o_ + 64]; wpa = PW[o_]; wpb = PW[o_ + 64]; } while (0)
#define VGATHER(QV, WV, LOFF, RNEXT, HASNEXT) do { \
          { u32x2 t0, t1; t0.x = ea; t0.y = __float_as_uint(wpa); t1.x = eb; t1.y = __float_as_uint(wpb); \
            ew[(LOFF) + F.lane] = t0; ew[(LOFF) + 64 + F.lane] = t1; } \
          if (HASNEXT) VPREF(RNEXT); \
          asm volatile("s_waitcnt lgkmcnt(0)" ::: "memory"); \
          _Pragma("unroll") for (int i = 0; i < 16; ++i) { const u32x2 t = ew[(LOFF) + 8 * i + g]; WV[i] = __uint_as_float(t.y); QV[i] = *(const u32x4*)(V + (size_t)t.x * 128); } } while (0)
#define VMATH(QV, WV, R) do { float acc[16]; \
          float* x = (float*)xrow_sel(outl, (const float*)(F.ws + WS_XC), (R)); const float* xs = xrow_sel((const float*)(F.ws + WS_XB), (const float*)(F.ws + WS_XCB), (R)); const float* gg = g2 + (size_t)mod_row(R) * NMOD * DM; \
          const f32x2 xv = *(const f32x2*)(xs + dl), gv = *(const f32x2*)(gg + dl); \
          _Pragma("unroll") for (int q = 0; q < 16; ++q) acc[q] = 0.f; \
          _Pragma("unroll") for (int i = 0; i < 16; ++i) { const float w = WV[i]; const int q0 = (int)QV[i].x, q1 = (int)QV[i].y, q2 = (int)QV[i].z, q3 = (int)QV[i].w; f32x2 f; \
            f = __builtin_amdgcn_cvt_pk_f32_fp8(q0, false); acc[0] = fmaf(w, f.x, acc[0]); acc[1] = fmaf(w, f.y, acc[1]); f = __builtin_amdgcn_cvt_pk_f32_fp8(q0, true); acc[2] = fmaf(w, f.x, acc[2]); acc[3] = fmaf(w, f.y, acc[3]); \
            f = __builtin_amdgcn_cvt_pk_f32_fp8(q1, false); acc[4] = fmaf(w, f.x, acc[4]); acc[5] = fmaf(w, f.y, acc[5]); f = __builtin_amdgcn_cvt_pk_f32_fp8(q1, true); acc[6] = fmaf(w, f.x, acc[6]); acc[7] = fmaf(w, f.y, acc[7]); \
            f = __builtin_amdgcn_cvt_pk_f32_fp8(q2, false); acc[8] = fmaf(w, f.x, acc[8]); acc[9] = fmaf(w, f.y, acc[9]); f = __builtin_amdgcn_cvt_pk_f32_fp8(q2, true); acc[10] = fmaf(w, f.x, acc[10]); acc[11] = fmaf(w, f.y, acc[11]); \
            f = __builtin_amdgcn_cvt_pk_f32_fp8(q3, false); acc[12] = fmaf(w, f.x, acc[12]); acc[13] = fmaf(w, f.y, acc[13]); f = __builtin_amdgcn_cvt_pk_f32_fp8(q3, true); acc[14] = fmaf(w, f.x, acc[14]); acc[15] = fmaf(w, f.y, acc[15]); } \
          _Pragma("unroll") for (int j = 0; j < 8; ++j) { auto s2 = __builtin_amdgcn_permlane32_swap(__float_as_uint(acc[j]), __float_as_uint(acc[j + 8]), false, false); acc[j] = __uint_as_float(s2[0]) + __uint_as_float(s2[1]); } \
          _Pragma("unroll") for (int j = 0; j < 4; ++j) { auto s2 = __builtin_amdgcn_permlane16_swap(__float_as_uint(acc[j]), __float_as_uint(acc[j + 4]), false, false); acc[j] = __uint_as_float(s2[0]) + __uint_as_float(s2[1]); } \
          { const bool up = (F.lane & 8) != 0; \
            _Pragma("unroll") for (int j = 0; j < 2; ++j) { const float send = up ? acc[j] : acc[j + 2], keep = up ? acc[j + 2] : acc[j]; acc[j] = keep + __shfl_xor(send, 8); } } \
          f32x2 o; o.x = xv.x + gv.x * acc[0] * (1.f / V8_SCALE); o.y = xv.y + gv.y * acc[1] * (1.f / V8_SCALE); \
          *(f32x2*)(x + dl) = o; } while (0)
        u32x4 qa[16], qb_[16]; float wa[16], wb[16];
        VPREF(rbeg);
        VGATHER(qa, wa, 0, rbeg + 1, true);
#pragma unroll 1
        for (int it = 0; it < PCH; it += 2) { const int r = rbeg + it;
          VGATHER(qb_, wb, 128, r + 2, it + 2 < PCH);
          VMATH(qa, wa, r);
          if (it + 2 < PCH) VGATHER(qa, wa, 0, r + 3, it + 3 < PCH);
          VMATH(qb_, wb, r + 1);
        }
#undef VPREF
#undef VGATHER
#undef VMATH
      }
      c = cn;
    }
  }
}

#define XB_TMO      128
#define XB_XCNT(j)  (256  + 64 * (j))
#define XB_XSUB(j)  (1280 + 64 * (j))
#define XB_XGEN(j)  (2304 + 64 * (j))
#define XB_TOP      3328
#define XB_TOPGEN   3392
#define XCD_BAR_WORDS 3456
#define XB_SPIN_CAP (1u << 18)

__device__ __forceinline__ unsigned xb_ld(unsigned* p)              { return __hip_atomic_load(p, __ATOMIC_RELAXED, __HIP_MEMORY_SCOPE_AGENT); }
__device__ __forceinline__ unsigned xb_add(unsigned* p, unsigned v) { return __hip_atomic_fetch_add(p, v, __ATOMIC_RELAXED, __HIP_MEMORY_SCOPE_AGENT); }
__device__ __forceinline__ unsigned xb_xcc_id() { return (unsigned)__builtin_amdgcn_s_getreg((3 << 11) | 20) & 0xFu; }
#define XB_SPIN(cond, bar) do { unsigned _sp = 0; while (cond) { __builtin_amdgcn_s_sleep(1); \
    if ((++_sp & 255u) == 0u) { if (xb_ld(&(bar)[XB_TMO])) break; if (_sp > XB_SPIN_CAP) { atomicAdd(&(bar)[XB_TMO], 1u); break; } } } } while (0)

struct XcdBarrier {
    unsigned* bar; unsigned x;
    volatile LAS unsigned* st;
};

__device__ __forceinline__ XcdBarrier xcd_barrier_post(unsigned* bar, volatile LAS unsigned* st) {
    XcdBarrier b; b.bar = bar; b.x = xb_xcc_id(); b.st = st;
    if (threadIdx.x == 0) (void)xb_add(&bar[XB_XCNT(b.x)], 1u);
    return b;
}
__device__ __forceinline__ void xcd_barrier_complete(unsigned* bar, unsigned x, unsigned& nloc, unsigned& nx) {
    const unsigned G = gridDim.x * gridDim.y * gridDim.z;
    unsigned sum, cnt, mine, sp = 0u;
    for (;;) {
        sum = 0u; cnt = 0u; mine = 0u;
#pragma unroll
        for (unsigned j = 0; j < 16; ++j) { const unsigned c = xb_ld(&bar[XB_XCNT(j)]); sum += c; cnt += (c > 0u) ? 1u : 0u; mine = (j == x) ? c : mine; }
        if (sum == G) break;
        __builtin_amdgcn_s_sleep(1);
        if ((++sp & 255u) == 0u) { if (xb_ld(&bar[XB_TMO])) break; if (sp > XB_SPIN_CAP) { atomicAdd(&bar[XB_TMO], 1u); break; } }
    }
    nloc = mine > 0u ? mine : 1u; nx = cnt > 0u ? cnt : 1u;
}

__device__ __forceinline__ void xcd_barrier(const XcdBarrier& b) {
    asm volatile("s_waitcnt vmcnt(0)" ::: "memory");
    __syncthreads();
    if (threadIdx.x == 0) {
        unsigned* bar = b.bar;
        __builtin_amdgcn_s_waitcnt(0);
        unsigned nloc = b.st[0], nx = b.st[1];
        if (nloc == 0u) { xcd_barrier_complete(bar, b.x, nloc, nx); b.st[0] = nloc; b.st[1] = nx; }
        const unsigned old = xb_add(&bar[XB_XSUB(b.x)], 1u);
        const unsigned gen = old / nloc;
        if (old + 1u == (gen + 1u) * nloc) {
            __builtin_amdgcn_fence(__ATOMIC_RELEASE, "agent");
            asm volatile("s_waitcnt vmcnt(0)" ::: "memory");
            const unsigned og = xb_add(&bar[XB_TOP], 1u);
            const unsigned tg = og / nx;
            if (og + 1u == (tg + 1u) * nx) xb_add(&bar[XB_TOPGEN], 1u);
            else XB_SPIN(xb_ld(&bar[XB_TOPGEN]) == tg, bar);
            __builtin_amdgcn_fence(__ATOMIC_ACQUIRE, "agent");
            xb_add(&bar[XB_XGEN(b.x)], 1u);
            asm volatile("s_waitcnt vmcnt(0)" ::: "memory");
        } else {
            XB_SPIN(xb_ld(&bar[XB_XGEN(b.x)]) == gen, bar);
            __builtin_amdgcn_fence(__ATOMIC_ACQUIRE, "agent");
            asm volatile("s_waitcnt vmcnt(0)" ::: "memory");
        }
    }
    __syncthreads();
}


__global__ void __launch_bounds__(NTHR, 2) fwd(Args args) {
  extern __shared__ __attribute__((aligned(16))) unsigned char lds[];
  Ctx F;
  F.ws = args.ws; F.tid = threadIdx.x; F.lane = F.tid & 63; F.wave = __builtin_amdgcn_readfirstlane(F.tid >> 6); F.bid = blockIdx.x; F.G = gridDim.x;
  F.lds = (LAS unsigned char*)lds; F.ldsg = lds;
  if (F.tid < 18) { const unsigned long long p = F.tid < 17 ? (unsigned long long)args.in[F.tid] : (unsigned long long)args.out; ((LAS unsigned long long*)(F.lds + PTAB_OFF))[F.tid] = p; }
  __syncthreads();
  const int lo = args.ph_lo, hi = args.ph_hi;
#ifndef PHMASK
#define PHMASK 0x7ff
#endif
#define IN(k) (lo <= (k) && (k) < hi)
#define EN(b) ((PHMASK >> (b)) & 1)
#ifndef REPMASK
#define REPMASK 0
#endif
#define NREP(b) (1 + ((REPMASK >> (b)) & 1))
#define FRESH() do { int t_ = threadIdx.x; asm volatile("" : "+v"(t_)); F.tid = t_; F.lane = t_ & 63; F.wave = __builtin_amdgcn_readfirstlane(t_ >> 6); int b_ = blockIdx.x; asm volatile("" : "+s"(b_)); F.bid = b_; } while (0)
  if (F.tid < 4) ((LAS unsigned*)(F.lds + PTAB_OFF + 256))[F.tid] = 0u;
  __syncthreads();
  XcdBarrier xb; xb.bar = (unsigned*)(F.ws + WS_CTL) + 4096; xb.x = 0; xb.st = nullptr;
  if (hi - lo > 1) xb = xcd_barrier_post((unsigned*)(F.ws + WS_CTL) + 4096, (volatile LAS unsigned*)(F.lds + PTAB_OFF + 256));
#ifndef SEAM_CG_ALL
#define SEAM_CG_ALL 0
#endif
#define SEAM(k) do { if (IN(k) && IN((k) + 1)) { if (SEAM_CG_ALL || (k) == 0) cg::this_grid().sync(); else xcd_barrier(xb); } } while (0)
  if (EN(10) && IN(0)) for (int rep_ = 0; rep_ < NREP(10); ++rep_) { FRESH(); phase_prologue(F); } SEAM(0);
#pragma unroll 1
  for (int layer = 0; layer < DEPTH; ++layer) {
    const int pb = 1 + 11 * layer; const bool last = layer == DEPTH - 1;
    const float* modl = (const float*)(F.ws + WS_MOD) + (size_t)layer * 5 * NMOD * DM;
    if (EN(0) && IN(pb + 0)) for (int rep_ = 0; rep_ < NREP(0); ++rep_) { FRESH(); phase_norm(F, layer, 0, layer == 0 ? 0 : 2, false); } SEAM(pb + 0);
    if (EN(1) && IN(pb + 1)) for (int rep_ = 0; rep_ < NREP(1); ++rep_) { FRESH(); pg8::Gemm g{(const pg8::bf16_t*)(F.ws + WS_H), (const pg8::bf16_t*)(F.ws + WS_WQKV) + (size_t)layer * QKVD * DM, NROWS, QKVD, DM};
      Order S; S.init(NROWS / 256, QKVD / 256, F.G, F.bid, 0); EpiQKV E{F.ws};
      pg8::gemm_phase<EpiQKV, Order, true, true>(F.lds, g, S, E); } SEAM(pb + 1);
    if (EN(2) && IN(pb + 2)) for (int rep_ = 0; rep_ < NREP(2); ++rep_) { FRESH(); phase_qknorm(F, layer); } SEAM(pb + 2);
    if (EN(3) && IN(pb + 3)) for (int rep_ = 0; rep_ < NREP(3); ++rep_) { FRESH(); phase_attn(F, layer); } SEAM(pb + 3);
    if (EN(4) && IN(pb + 4)) for (int rep_ = 0; rep_ < NREP(4); ++rep_) { FRESH(); pg8::Gemm g{(const pg8::bf16_t*)(F.ws + WS_O), (const pg8::bf16_t*)(F.ws + WS_WO) + (size_t)layer * DM * DM, NROWS, DM, DM};
      Order S; S.init(last ? NB * 16 : NROWS / 256, DM / 256, F.G, F.bid, last ? 1 : 0); EpiRes E{st_lat(F, layer == 0 ? 0 : 2), st_ctx(F, layer == 0 ? 0 : 2), (float*)(F.ws + WS_XB), (float*)(F.ws + WS_XCB), modl + 2 * DM};
      pg8::gemm_phase<EpiRes, Order, true, true>(F.lds, g, S, E); } SEAM(pb + 4);
    if (EN(5) && IN(pb + 5)) for (int rep_ = 0; rep_ < NREP(5); ++rep_) { FRESH(); phase_norm(F, layer, 1, 1, last); } SEAM(pb + 5);
    if (EN(6) && IN(pb + 6)) for (int rep_ = 0; rep_ < NREP(6); ++rep_) { FRESH(); pg8::Gemm g{(const pg8::bf16_t*)(F.ws + WS_H), (const pg8::bf16_t*)(F.ws + WS_WP) + (size_t)layer * PQN * DM, NROWS, PQN, DM};
      Order S; S.init(last ? NB * 16 : NROWS / 256, PQN / 256, F.G, F.bid, last ? 1 : 0); EpiF32 E{(float*)(F.ws + WS_S), PQN};
      pg8::gemm_phase<EpiF32, Order, true, true>(F.lds, g, S, E); } SEAM(pb + 6);
    if (EN(7) && IN(pb + 7)) for (int rep_ = 0; rep_ < NREP(7); ++rep_) { FRESH(); phase_topk(F, last); } SEAM(pb + 7);
    if (EN(8) && IN(pb + 8)) for (int rep_ = 0; rep_ < NREP(8); ++rep_) { FRESH(); phase_peer_u(F, layer, last); } SEAM(pb + 8);
    if (EN(9) && IN(pb + 9)) { FRESH(); phase_peer_w(F, last); } SEAM(pb + 9);
    if (EN(9) && IN(pb + 10)) { FRESH(); phase_peer_v(F, layer, last); } if (!last) SEAM(pb + 10);
  }
#undef IN
#undef SEAM
}
}

#ifndef MK_MULTI
#define MK_MULTI 0
#endif
#ifndef DBG
#define DBG 0
#endif
namespace dbg {
template <bool ABF>
__global__ void __launch_bounds__(1024) k_cmp(const void* __restrict__ a, long lda, long aoff, const float* __restrict__ b, long ldb, long boff, int rows, int cols, int row0, int rstep_lat  , float* res) {
  __shared__ float sd[1024], sr[1024];
  float d2 = 0.f, r2 = 0.f;
  for (long e = threadIdx.x; e < (long)rows * cols; e += 1024) { const int r = row0 + (int)(e / cols), c = (int)(e % cols);
    if (rstep_lat == 1 && (r % RPB) < CTXL) continue; if (rstep_lat == 2 && (r % RPB) >= CTXL) continue;
    float av; if (ABF) av = __uint_as_float((unsigned)((const unsigned short*)a)[(long)r * lda + aoff + c] << 16); else av = ((const float*)a)[(long)r * lda + aoff + c];
    const float bv = b[(long)r * ldb + boff + c]; d2 += (av - bv) * (av - bv); r2 += bv * bv; }
  sd[threadIdx.x] = d2; sr[threadIdx.x] = r2; __syncthreads();
  for (int o = 512; o > 0; o >>= 1) { if ((int)threadIdx.x < o) { sd[threadIdx.x] += sd[threadIdx.x + o]; sr[threadIdx.x] += sr[threadIdx.x + o]; } __syncthreads(); }
  if (threadIdx.x == 0) *res = sqrtf(sd[0] / fmaxf(sr[0], 1e-30f));
}
__global__ void __launch_bounds__(1024) k_cmp_scores(const float* __restrict__ S, const float* __restrict__ PQ, const float* __restrict__ SK, int nrows, float* res) {
  __shared__ float sd[1024], sr[1024];
  float d2 = 0.f, r2 = 0.f;
  for (long e = threadIdx.x; e < (long)nrows * PQN; e += 1024) { const int r = (int)(e / PQN), c = (int)(e % PQN), h = c >> 8, half = (c >> 7) & 1, k = c & 127;
    const float* q = PQ + (long)r * PQN + h * PQD + half * 128; const float* kp = SK + (long)half * NKEYS * 128 + (long)k * 128; float a = 0.f; for (int d = 0; d < 128; ++d) a += q[d] * kp[d];
    const float f = S[(long)r * PQN + c]; d2 += (f - a) * (f - a); r2 += a * a; }
  sd[threadIdx.x] = d2; sr[threadIdx.x] = r2; __syncthreads();
  for (int o = 512; o > 0; o >>= 1) { if ((int)threadIdx.x < o) { sd[threadIdx.x] += sd[threadIdx.x + o]; sr[threadIdx.x] += sr[threadIdx.x + o]; } __syncthreads(); }
  if (threadIdx.x == 0) *res = sqrtf(sd[0] / fmaxf(sr[0], 1e-30f));
}
__global__ void k_final(float* out, long n, const float* res) {
  const float sa = 1.f + 10.f * res[0];
  for (long i = blockIdx.x * 256L + threadIdx.x; i < n; i += gridDim.x * 256L) out[i] *= sa;
  if (blockIdx.x == 0 && threadIdx.x == 0) { }
}
__global__ void k_final2(float* out, const float* res) { out[0] += 1000.f * (res[1] + res[2]); }
}

static void run_naive(void* const* d_in, float* out, char* ws, hipStream_t stream, int slayer, int stop) {
  const float* x = (const float*)d_in[0]; const float* c = (const float*)d_in[1]; const float* ctx = (const float*)d_in[2]; const float* c_ctx = (const float*)d_in[3];
  const float* ada_w = (const float*)d_in[4]; const float* ada_b = (const float*)d_in[5]; const float* n1g = (const float*)d_in[6]; const float* n2g = (const float*)d_in[7];
  const float* w_qkv = (const float*)d_in[8]; const float* qng = (const float*)d_in[9]; const float* kng = (const float*)d_in[10]; const float* w_o = (const float*)d_in[11];
  const float* sinks = (const float*)d_in[12]; const float* pwq = (const float*)d_in[13]; const float* psk = (const float*)d_in[14]; const float* pu = (const float*)d_in[15];
  const float* pv = (const float*)d_in[16];
  constexpr size_t MiB = 1u << 20;
  float* MOD = (float*)(ws + 0); float* XC = (float*)(ws + 1 * MiB); int* EIDX = (int*)(ws + 6 * MiB); float* GATE = (float*)(ws + 15 * MiB); float* PW = (float*)(ws + 24 * MiB);
  float* H = (float*)(ws + 34 * MiB); float* QKV = (float*)(ws + 104 * MiB); float* O = (float*)(ws + 242 * MiB); float* PQ = QKV;
  hipFuncSetAttribute((const void*)nv::k_attn, hipFuncAttributeMaxDynamicSharedMemorySize, (4 * RPB + 4 * HD) * 4);
  hipMemcpyAsync(out, x, (size_t)NB * SEQ * DM * 4, hipMemcpyDeviceToDevice, stream);
  hipMemcpyAsync(XC, ctx, (size_t)NB * CTXL * DM * 4, hipMemcpyDeviceToDevice, stream);
  nv::k_mod<<<(DEPTH * 5 * NMOD * DM + 255) / 256, 256, 0, stream>>>(c, c_ctx, ada_w, ada_b, MOD);
  for (int i = 0; i < DEPTH; ++i) {
#define STOP(k) if (i == slayer && stop == (k)) return
    const bool last = i == DEPTH - 1; const float* modi = MOD + (size_t)i * 5 * NMOD * DM;
    STOP(1); nv::k_norm<<<NROWS, 256, 0, stream>>>(out, XC, n1g + i * DM, modi, 0, 1, H);
    STOP(2); nv::k_gemm<0><<<dim3(QKVD / 64, NROWS / 64), 256, 0, stream>>>(H, w_qkv + (size_t)i * DM * QKVD, QKV, NROWS, QKVD, DM, nullptr, nullptr, nullptr, 0, 0);
    STOP(3); nv::k_qknorm_rope<<<NROWS, 640, 0, stream>>>(QKV, qng + i * HD, kng + i * HD);
    STOP(4); const size_t shm = (4 * RPB + 4 * HD) * 4;
    if (i % 2 == 0) { nv::k_attn<<<dim3(NB * SEQ, NKV), 256, shm, stream>>>(QKV, 0, nullptr); if (!last) nv::k_attn<<<dim3(NB * CTXL, NKV), 256, shm, stream>>>(QKV, 1, nullptr); }
    else { nv::k_attn<<<dim3(NB * SEQ, NKV), 256, shm, stream>>>(QKV, 2, sinks + (i / 2) * NH); }
    STOP(5); nv::k_copy_o<<<NROWS, 256, 0, stream>>>(QKV, O);
    nv::k_gemm<1><<<dim3(DM / 64, NROWS / 64), 256, 0, stream>>>(O, w_o + (size_t)i * DM * DM, nullptr, NROWS, DM, DM, out, XC, modi, 2, last ? 1 : 0);
    STOP(6); nv::k_norm<<<NROWS, 256, 0, stream>>>(out, XC, n2g + i * DM, modi, 3, 4, H);
    STOP(7); nv::k_gemm<0><<<dim3(PQN / 64, NROWS / 64), 256, 0, stream>>>(H, pwq + (size_t)i * DM * PQN, PQ, NROWS, PQN, DM, nullptr, nullptr, nullptr, 0, 0);
    STOP(8); nv::k_peer_topk<<<NROWS, 256, 0, stream>>>(PQ, psk + (size_t)i * 2 * NKEYS * 128, EIDX, GATE);
    STOP(9); nv::k_peer_u<<<NROWS, 256, 0, stream>>>(H, pu + (size_t)i * NKEYS * NKEYS * DM, EIDX, GATE, PW);
    STOP(10); nv::k_peer_v<<<NROWS, 256, 0, stream>>>(pv + (size_t)i * NKEYS * NKEYS * DM, EIDX, PW, out, XC, modi, 5, last ? 1 : 0);
#undef STOP
  }
}

extern "C" void kernel_launch(void* const* d_in, const int* in_sizes, int n_in, void* d_out, int out_size, void* d_ws, size_t ws_size, hipStream_t stream) {
  static int grid = 0;
  if (grid == 0) {
    if (n_in != 17 || out_size != NB * SEQ * DM || ws_size < mk::WS_END) { fprintf(stderr, "kernel_launch: unexpected shapes (n_in %d out %d ws %zu)\n", n_in, out_size, ws_size); grid = -1; return; }
    int dev = 0, cus = 0, per_cu = 0;
    hipGetDevice(&dev); hipDeviceGetAttribute(&cus, hipDeviceAttributeMultiprocessorCount, dev);
    if (hipFuncSetAttribute((const void*)mk::fwd, hipFuncAttributeMaxDynamicSharedMemorySize, mk::LDS_BYTES) != hipSuccess) { fprintf(stderr, "kernel_launch: hipFuncSetAttribute failed\n"); grid = -1; return; }
    if (hipOccupancyMaxActiveBlocksPerMultiprocessor(&per_cu, (const void*)mk::fwd, mk::NTHR, mk::LDS_BYTES) != hipSuccess || per_cu < 1) { fprintf(stderr, "kernel_launch: occupancy query failed (%d)\n", per_cu); grid = -1; return; }
    grid = cus * 1;
    grid -= grid % 8;
  }
  if (grid < 0) return;
  mk::Args a{};
  for (int i = 0; i < 17; ++i) a.in[i] = (const float*)d_in[i];
  a.out = (float*)d_out; a.ws = (unsigned char*)d_ws;
#if DBG == 0
#if MK_MULTI
  for (int p = 0; p < mk::NPHASE; ++p) { a.ph_lo = p; a.ph_hi = p + 1; hipLaunchKernelGGL(mk::fwd, dim3(grid), dim3(mk::NTHR), mk::LDS_BYTES, stream, a); }
#else
  hipMemsetAsync((char*)d_ws + mk::WS_CTL, 0, 65536, stream);
  a.ph_lo = 0; a.ph_hi = mk::NPHASE; void* kargs[] = {&a};
  hipError_t e = hipLaunchCooperativeKernel((const void*)mk::fwd, dim3(grid), dim3(mk::NTHR), kargs, mk::LDS_BYTES, stream);
  if (e != hipSuccess) fprintf(stderr, "cooperative launch failed: %s (grid %d)\n", hipGetErrorString(e), grid);
#endif
#else
  {
    constexpr size_t MiB = 1u << 20; char* ws = (char*)d_ws; float* out = (float*)d_out;
    float* REF = (float*)(ws + 402 * MiB); float* RES = (float*)(ws + 511 * MiB);
    float* nH = (float*)(ws + 34 * MiB); float* nQKV = (float*)(ws + 104 * MiB); float* nMOD = (float*)ws; float* nXC = (float*)(ws + 1 * MiB);
    hipMemsetAsync(RES, 0, 64, stream);
    int slayer = 0, stop = 0, fastp = 0;
#if DBG == 1
    slayer = 0; stop = 2; fastp = 2;
#elif DBG == 2
    slayer = 0; stop = 4; fastp = 4;
#elif DBG == 3
    slayer = 0; stop = 5; fastp = 5;
#elif DBG == 4
    slayer = 0; stop = 6; fastp = 6;
#elif DBG == 5
    slayer = 0; stop = 8; fastp = 8;
#elif DBG == 6
    slayer = 1; stop = 1; fastp = 11;
#elif DBG == 7
    slayer = 1; stop = 5; fastp = 15;
#elif DBG == 8
    slayer = 9; stop = 99; fastp = 21;
#elif DBG == 9
    slayer = 1; stop = 1; fastp = 9;
#elif DBG == 10
    slayer = 0; stop = 10; fastp = 9;
#elif DBG == 11
    slayer = 0; stop = 1; fastp = 1;
#endif
    run_naive(d_in, out, ws, stream, slayer, stop);
#if DBG == 1
    hipMemcpyAsync(REF, nH, (size_t)NROWS * DM * 4, hipMemcpyDeviceToDevice, stream); hipMemcpyAsync(REF + (size_t)NROWS * DM, nMOD, (size_t)DEPTH * 5 * NMOD * DM * 4, hipMemcpyDeviceToDevice, stream);
#elif DBG == 2 || DBG == 3 || DBG == 7
    hipMemcpyAsync(REF, nQKV, (size_t)NROWS * QKVD * 4, hipMemcpyDeviceToDevice, stream);
#elif DBG == 4 || DBG == 6 || DBG == 8 || DBG == 9
    hipMemcpyAsync(REF, out, (size_t)NB * SEQ * DM * 4, hipMemcpyDeviceToDevice, stream); hipMemcpyAsync(REF + (size_t)NB * SEQ * DM, nXC, (size_t)NB * CTXL * DM * 4, hipMemcpyDeviceToDevice, stream);
#endif
#if DBG == 10
    hipMemcpyAsync(REF, ws + 24 * MiB, (size_t)NROWS * 128 * 4, hipMemcpyDeviceToDevice, stream);
#endif
#if DBG == 9 || DBG == 10
    hipMemcpyAsync(REF + (size_t)70 * MiB / 4, ws + 6 * MiB, (size_t)NROWS * 128 * 4, hipMemcpyDeviceToDevice, stream); hipMemcpyAsync(REF + (size_t)80 * MiB / 4, ws + 15 * MiB, (size_t)NROWS * 128 * 4, hipMemcpyDeviceToDevice, stream);
#elif DBG == 5
    hipMemcpyAsync(REF, nQKV  , (size_t)512 * PQN * 4, hipMemcpyDeviceToDevice, stream);
#endif
    for (int p = 0; p < fastp; ++p) { a.ph_lo = p; a.ph_hi = p + 1; hipLaunchKernelGGL(mk::fwd, dim3(grid), dim3(mk::NTHR), mk::LDS_BYTES, stream, a); }
    unsigned char* fw = (unsigned char*)d_ws;
#if DBG == 9 || DBG == 10
    hipMemcpyAsync(fw + mk::WS_EIDX, REF + (size_t)70 * MiB / 4, (size_t)NROWS * 128 * 4, hipMemcpyDeviceToDevice, stream); hipMemcpyAsync(fw + mk::WS_GATE, REF + (size_t)80 * MiB / 4, (size_t)NROWS * 128 * 4, hipMemcpyDeviceToDevice, stream);
    for (int p = 9; p < (DBG == 9 ? 11 : 10); ++p) { a.ph_lo = p; a.ph_hi = p + 1; hipLaunchKernelGGL(mk::fwd, dim3(grid), dim3(mk::NTHR), mk::LDS_BYTES, stream, a); }
#endif
#if DBG == 1
    dbg::k_cmp<true><<<1, 1024, 0, stream>>>(fw + mk::WS_H, DM, 0, REF, DM, 0, NROWS, DM, 0, 0, RES);
    dbg::k_cmp<false><<<1, 1024, 0, stream>>>(fw + mk::WS_MOD, NMOD * DM, 0, REF + (size_t)NROWS * DM, NMOD * DM, 0, DEPTH * 5, NMOD * DM, 0, 0, RES + 1);
#elif DBG == 2
    dbg::k_cmp<true><<<1, 1024, 0, stream>>>(fw + mk::WS_Q, DM, 0, REF, QKVD, 0, NROWS, DM, 0, 0, RES);
    dbg::k_cmp<true><<<1, 1024, 0, stream>>>(fw + mk::WS_K, 256, 0, REF, QKVD, 1024, NROWS, 256, 0, 0, RES + 2);
    dbg::k_cmp<true><<<1, 1024, 0, stream>>>(fw + mk::WS_V, 256, 0, REF, QKVD, 1280, NROWS, 256, 0, 0, RES + 1);
#elif DBG == 3 || DBG == 7
    dbg::k_cmp<true><<<1, 1024, 0, stream>>>(fw + mk::WS_O, DM, 0, REF, QKVD, 0, NROWS, DM, 0, 1, RES);
    if (DBG == 3) dbg::k_cmp<true><<<1, 1024, 0, stream>>>(fw + mk::WS_O, DM, 0, REF, QKVD, 0, NROWS, DM, 0, 2, RES + 1);
#elif DBG == 4 || DBG == 6 || DBG == 8 || DBG == 9
    dbg::k_cmp<false><<<1, 1024, 0, stream>>>(out, DM, 0, REF, DM, 0, NB * SEQ, DM, 0, 0, RES);
    if (DBG != 8) dbg::k_cmp<false><<<1, 1024, 0, stream>>>(fw + mk::WS_XC, DM, 0, REF + (size_t)NB * SEQ * DM, DM, 0, NB * CTXL, DM, 0, 0, RES + 1);
#elif DBG == 11
    dbg::k_cmp<true><<<1, 1024, 0, stream>>>(fw + mk::WS_UT, DM, 0, (const float*)d_in[15], DM, 0, DEPTH * NKEYS * NKEYS, DM, 0, 0, RES);
    dbg::k_cmp<true><<<1, 1024, 0, stream>>>(fw + mk::WS_VT, DM, 0, (const float*)d_in[16], DM, 0, DEPTH * NKEYS * NKEYS, DM, 0, 0, RES + 1);
#elif DBG == 10
    dbg::k_cmp<false><<<1, 1024, 0, stream>>>(fw + mk::WS_PW, 128, 0, REF, 128, 0, NROWS, 128, 0, 0, RES);
#elif DBG == 5
    dbg::k_cmp_scores<<<1, 1024, 0, stream>>>((const float*)(fw + mk::WS_S), REF, (const float*)d_in[14], 512, RES);
#endif
    hipMemcpyAsync(REF, RES, 64, hipMemcpyDeviceToDevice, stream);
    run_naive(d_in, out, ws, stream, 9, 99);
    dbg::k_final<<<1024, 256, 0, stream>>>(out, (long)NB * SEQ * DM, REF);
    dbg::k_final2<<<1, 1, 0, stream>>>(out, REF);
  }
#endif
}
```

```cpp
#include <hip/hip_runtime.h>
#include <hip/hip_cooperative_groups.h>
#include <cstdio>
#include <cstdint>

constexpr int NB = 4, SEQ = 4096, CTXL = 256, DM = 1024, DEPTH = 2;
constexpr int RPB = CTXL + SEQ;
constexpr int NROWS = NB * RPB;
constexpr int NH = 8, NKV = 2, HD = 128, QKVD = 1536, NMOD = 6;
constexpr int PH = 8, PK = 16, NKEYS = 128, PQD = 256, PQN = PH * PQD;
constexpr float RMS_EPS = 1e-6f;

namespace nv {

__device__ __forceinline__ float silu(float x) { return x / (1.f + __expf(-x)); }
__device__ __forceinline__ float gelu_tanh(float x) {
  const float y = 0.7978845608028654f * (x + 0.044715f * x * x * x);
  const float t = 1.f - 2.f / (__expf(2.f * y) + 1.f);
  return 0.5f * x * (1.f + t);
}

__global__ void k_mod(const float* __restrict__ c, const float* __restrict__ c_ctx, const float* __restrict__ ada_w,
                      const float* __restrict__ ada_b, float* __restrict__ mod) {
  const int idx = blockIdx.x * 256 + threadIdx.x;
  if (idx >= DEPTH * 5 * NMOD * DM) return;
  const int n = idx % (NMOD * DM), r = (idx / (NMOD * DM)) % 5, i = idx / (5 * NMOD * DM);
  const float* cv = r < 4 ? c + r * DM : c_ctx;
  const float* w = ada_w + (size_t)i * DM * NMOD * DM + n;
  float s = 0.f;
  for (int j = 0; j < DM; ++j) s += silu(cv[j]) * w[(size_t)j * NMOD * DM];
  mod[idx] = s + ada_b[i * NMOD * DM + n];
}

__device__ __forceinline__ float* xrow(float* xl, float* xc, int r) {
  const int b = r / RPB, j = r % RPB;
  return j < CTXL ? xc + (size_t)(b * CTXL + j) * DM : xl + (size_t)(b * SEQ + (j - CTXL)) * DM;
}

__global__ void k_norm(float* xl, float* xc, const float* __restrict__ gain, const float* __restrict__ modi, int sh_i, int sc_i,
                       float* __restrict__ H) {
  const int r = blockIdx.x, t = threadIdx.x;
  const int b = r / RPB, j = r % RPB, mr = j < CTXL ? 4 : b;
  const float* x = xrow(xl, xc, r);
  __shared__ float red[4];
  float v[4]; float s = 0.f;
#pragma unroll
  for (int q = 0; q < 4; ++q) { v[q] = x[t + 256 * q]; s += v[q] * v[q]; }
  for (int o = 32; o > 0; o >>= 1) s += __shfl_xor(s, o);
  if ((t & 63) == 0) red[t >> 6] = s;
  __syncthreads();
  s = red[0] + red[1] + red[2] + red[3];
  const float rstd = rsqrtf(s / DM + RMS_EPS);
  const float* sh = modi + (size_t)mr * NMOD * DM + sh_i * DM; const float* sc = modi + (size_t)mr * NMOD * DM + sc_i * DM;
#pragma unroll
  for (int q = 0; q < 4; ++q) { const int d = t + 256 * q; H[(size_t)r * DM + d] = v[q] * rstd * gain[d] * (1.f + sc[d]) + sh[d]; }
}

template <int EPI>
__global__ void k_gemm(const float* __restrict__ A, const float* __restrict__ B, float* __restrict__ C, int M, int N, int K,
                       float* xl, float* xc, const float* __restrict__ modi, int g_i, int skip_ctx) {
  __shared__ float As[16][68], Bs[16][68];
  const int t = threadIdx.x, tx = t & 15, ty = t >> 4, m0 = blockIdx.y * 64, n0 = blockIdx.x * 64;
  float acc[4][4] = {};
  for (int k0 = 0; k0 < K; k0 += 16) {
    for (int q = 0; q < 4; ++q) { const int e = t + 256 * q, mm = e >> 4, kk = e & 15; As[kk][mm] = A[(size_t)(m0 + mm) * K + k0 + kk]; }
    for (int q = 0; q < 4; ++q) { const int e = t + 256 * q, kk = e >> 6, nn = e & 63; Bs[kk][nn] = B[(size_t)(k0 + kk) * N + n0 + nn]; }
    __syncthreads();
#pragma unroll
    for (int kk = 0; kk < 16; ++kk) {
      float a[4], b[4];
#pragma unroll
      for (int i = 0; i < 4; ++i) { a[i] = As[kk][ty * 4 + i]; b[i] = Bs[kk][tx * 4 + i]; }
#pragma unroll
      for (int i = 0; i < 4; ++i)
#pragma unroll
        for (int j = 0; j < 4; ++j) acc[i][j] += a[i] * b[j];
    }
    __syncthreads();
  }
#pragma unroll
  for (int i = 0; i < 4; ++i) {
    const int r = m0 + ty * 4 + i;
    if (EPI == 0) {
#pragma unroll
      for (int j = 0; j < 4; ++j) C[(size_t)r * N + n0 + tx * 4 + j] = acc[i][j];
    } else {
      const int b = r / RPB, jj = r % RPB; if (skip_ctx && jj < CTXL) continue;
      const int mr = jj < CTXL ? 4 : b; float* x = xrow(xl, xc, r);
      const float* g = modi + (size_t)mr * NMOD * DM + g_i * DM;
#pragma unroll
      for (int j = 0; j < 4; ++j) { const int n = n0 + tx * 4 + j; x[n] += g[n] * acc[i][j]; }
    }
  }
}

__global__ void k_qknorm_rope(float* __restrict__ QKV, const float* __restrict__ qg, const float* __restrict__ kg) {
  const int r = blockIdx.x, t = threadIdx.x, head = t >> 6, p = t & 63, axis = p >> 5, f = p & 31;
  const int j = r % RPB;
  float* base = QKV + (size_t)r * QKVD + head * HD;
  const int e1 = axis * 64 + f, e2 = e1 + 32;
  float x1 = base[e1], x2 = base[e2];
  float s = x1 * x1 + x2 * x2;
  for (int o = 32; o > 0; o >>= 1) s += __shfl_xor(s, o);
  const float rstd = rsqrtf(s / HD + RMS_EPS);
  const float* g = head < NH ? qg : kg;
  x1 = x1 * rstd * g[e1]; x2 = x2 * rstd * g[e2];
  if (j >= CTXL) {
    const int sp = j - CTXL; const float pos = (float)(axis == 0 ? sp / 64 : sp % 64);
    const float inv = powf(10000.f, -(float)(2 * f) / 64.f);
    const float ang = pos * inv; const float cs = cosf(ang), sn = sinf(ang);
    const float y1 = x1 * cs - x2 * sn, y2 = x1 * sn + x2 * cs; x1 = y1; x2 = y2;
  }
  base[e1] = x1; base[e2] = x2;
}

__global__ void k_attn(float* __restrict__ QKV, int mode, const float* __restrict__ sink) {
  extern __shared__ float sm[];
  const int t = threadIdx.x, w = t >> 6, lane = t & 63, g = blockIdx.y;
  int b, j;
  if (mode == 1) { b = blockIdx.x / CTXL; j = blockIdx.x % CTXL; } else { b = blockIdx.x / SEQ; j = CTXL + blockIdx.x % SEQ; }
  const int r = b * RPB + j, h = g * 4 + w;
  float* sc = sm + w * RPB; float* qs = sm + 4 * RPB + w * HD;
  float* qp = QKV + (size_t)r * QKVD + h * HD;
  qs[lane] = qp[lane]; qs[lane + 64] = qp[lane + 64];
  __syncthreads();
  int a0 = 0, a1, b0 = 0, b1 = 0;
  if (mode == 0) a1 = RPB; else if (mode == 1) a1 = CTXL;
  else { a1 = CTXL; const int s = j - CTXL; const int lo = s - 128 < 0 ? 0 : s - 128, hi = s + 128 > SEQ - 1 ? SEQ - 1 : s + 128; b0 = CTXL + lo; b1 = CTXL + hi + 1; }
  const int nk = (a1 - a0) + (b1 - b0);
  const float scale = 0.08838834764831845f;
  float mx = -1e30f;
  for (int i = lane; i < nk; i += 64) {
    const int kr = i < (a1 - a0) ? a0 + i : b0 + (i - (a1 - a0));
    const float4* kp = (const float4*)(QKV + (size_t)(b * RPB + kr) * QKVD + NH * HD + g * HD);
    float s = 0.f;
    for (int d = 0; d < 32; ++d) { const float4 kv = kp[d]; s += kv.x * qs[4 * d] + kv.y * qs[4 * d + 1] + kv.z * qs[4 * d + 2] + kv.w * qs[4 * d + 3]; }
    s *= scale; sc[i] = s; mx = fmaxf(mx, s);
  }
  for (int o = 32; o > 0; o >>= 1) mx = fmaxf(mx, __shfl_xor(mx, o));
  if (mode == 2) mx = fmaxf(mx, sink[h]);
  float l = 0.f;
  for (int i = lane; i < nk; i += 64) { const float p = __expf(sc[i] - mx); sc[i] = p; l += p; }
  for (int o = 32; o > 0; o >>= 1) l += __shfl_xor(l, o);
  if (mode == 2) l += __expf(sink[h] - mx);
  __syncthreads();
  float o0 = 0.f, o1 = 0.f;
  for (int i = 0; i < nk; ++i) {
    const int kr = i < (a1 - a0) ? a0 + i : b0 + (i - (a1 - a0));
    const float* vp = QKV + (size_t)(b * RPB + kr) * QKVD + (NH + NKV) * HD + g * HD;
    const float p = sc[i]; o0 += p * vp[lane]; o1 += p * vp[lane + 64];
  }
  const float il = 1.f / l;
  qp[lane] = o0 * il; qp[lane + 64] = o1 * il;
}

__global__ void k_copy_o(const float* __restrict__ QKV, float* __restrict__ O) {
  const int r = blockIdx.x, t = threadIdx.x;
  for (int q = 0; q < 4; ++q) O[(size_t)r * DM + t + 256 * q] = QKV[(size_t)r * QKVD + t + 256 * q];
}

__global__ void __launch_bounds__(256) k_peer_topk(const float* __restrict__ PQ, const float* __restrict__ SK  , int* __restrict__ eidx, float* __restrict__ gate) {
  __shared__ float q[PQN]; __shared__ float s[16][128]; __shared__ float tv[16][16]; __shared__ int ti[16][16];
  __shared__ float cs[8][256]; __shared__ int taken[8][256];
  const int r = blockIdx.x, t = threadIdx.x;
  for (int i = t; i < PQN; i += 256) q[i] = PQ[(size_t)r * PQN + i];
  __syncthreads();
  { const int k = t & 127, half = t >> 7; const float* kp = SK + (size_t)half * NKEYS * 128 + (size_t)k * 128;
#pragma nounroll
    for (int h = 0; h < PH; ++h) { float a = 0.f; const float* qq = q + h * PQD + half * 128;
#pragma unroll 4
      for (int d = 0; d < 128; ++d) a += qq[d] * kp[d];
      s[h * 2 + half][k] = a; } }
  __syncthreads();
  if (t < 16) {
#pragma nounroll
    for (int it = 0; it < PK; ++it) { float bv = -3e38f; int bi = 0;
#pragma nounroll
      for (int k = 0; k < 128; ++k) { const float v = s[t][k]; if (v > bv) { bv = v; bi = k; } } tv[t][it] = bv; ti[t][it] = bi; s[t][bi] = -3e38f; }
  }
  __syncthreads();
  for (int i = t; i < 8 * 256; i += 256) { const int h = i >> 8, c = i & 255; cs[h][c] = tv[h * 2][c >> 4] + tv[h * 2 + 1][c & 15]; taken[h][c] = 0; }
  __syncthreads();
  if (t < 8) {
    float m = -3e38f;
#pragma nounroll
    for (int it = 0; it < PK; ++it) { float bv = -3e38f; int bi = 0;
#pragma nounroll
      for (int c = 0; c < 256; ++c) { const float v = cs[t][c]; if (!taken[t][c] && v > bv) { bv = v; bi = c; } }
      taken[t][bi] = 1; s[t][it] = bv; m = fmaxf(m, bv); eidx[(size_t)r * 128 + t * PK + it] = ti[t * 2][bi >> 4] * NKEYS + ti[t * 2 + 1][bi & 15]; }
    float l = 0.f;
#pragma nounroll
    for (int it = 0; it < PK; ++it) l += __expf(s[t][it] - m);
#pragma nounroll
    for (int it = 0; it < PK; ++it) gate[(size_t)r * 128 + t * PK + it] = __expf(s[t][it] - m) / l;
  }
}

__global__ void k_peer_u(const float* __restrict__ H, const float* __restrict__ U, const int* __restrict__ eidx, const float* __restrict__ gate, float* __restrict__ W) {
  __shared__ float h[DM];
  const int r = blockIdx.x, t = threadIdx.x, w = t >> 6, lane = t & 63;
  for (int i = t; i < DM; i += 256) h[i] = H[(size_t)r * DM + i];
  __syncthreads();
  for (int k = w; k < 128; k += 4) {
    const int e = eidx[(size_t)r * 128 + k]; const float* u = U + (size_t)e * DM; float a = 0.f;
    for (int d = lane; d < DM; d += 64) a += u[d] * h[d];
    for (int o = 32; o > 0; o >>= 1) a += __shfl_xor(a, o);
    if (lane == 0) W[(size_t)r * 128 + k] = gate[(size_t)r * 128 + k] * gelu_tanh(a);
  }
}
__global__ void k_peer_v(const float* __restrict__ V, const int* __restrict__ eidx, const float* __restrict__ W, float* xl, float* xc,
                         const float* __restrict__ modi, int g_i, int skip_ctx) {
  const int r = blockIdx.x, t = threadIdx.x; const int b = r / RPB, j = r % RPB; if (skip_ctx && j < CTXL) return;
  float4 acc = {0.f, 0.f, 0.f, 0.f};
  for (int k = 0; k < 128; ++k) { const int e = eidx[(size_t)r * 128 + k]; const float w = W[(size_t)r * 128 + k]; const float4 v = ((const float4*)(V + (size_t)e * DM))[t];
    acc.x += w * v.x; acc.y += w * v.y; acc.z += w * v.z; acc.w += w * v.w; }
  const int mr = j < CTXL ? 4 : b; float4* x = (float4*)xrow(xl, xc, r) + t; const float4 g = ((const float4*)(modi + (size_t)mr * NMOD * DM + g_i * DM))[t];
  float4 xv = *x; xv.x += g.x * acc.x; xv.y += g.y * acc.y; xv.z += g.z * acc.z; xv.w += g.w * acc.w; *x = xv;
}
}


namespace pg8 {
#define PG8_LAS __attribute__((address_space(3)))
typedef unsigned short bf16_t;
typedef short bf16x8 __attribute__((ext_vector_type(8)));
typedef float f32x4 __attribute__((ext_vector_type(4)));
typedef unsigned u32x4 __attribute__((ext_vector_type(4)));
constexpr int BM = 256, BK = 64, HALF = 128, HTB = HALF * BK * 2  , STAGE_BYTES = 8 * HTB, NXCD = 8, WGM = 8;

__host__ __device__ __forceinline__ int lds_byte(int r, int c) { const int st = (r >> 4) * 2 + (c >> 5), rr = r & 15, cc = c & 31, ob = rr * 64 + cc * 2; return st * 1024 + (ob ^ (((ob >> 9) & 1) << 5)); }
__host__ __device__ __forceinline__ void stage_rc(int b, int& R, int& C) { const int st = b / 1024, sb = b % 1024, swz = sb ^ (((sb >> 9) & 1) << 5); R = (st >> 1) * 16 + swz / 64; C = (st & 1) * 32 + (swz % 64) / 2; }
__host__ __device__ __forceinline__ int perm32(int rho) { const int n = rho >> 4, i = rho & 15; return 8 * (i >> 2) + 4 * n + (i & 3); }

struct Unit { int pm, pn; };
struct Gemm { const bf16_t* A; const bf16_t* Bt; int M, N, K; int sa = 0x7f7f7f7f, sb = 0x7f7f7f7f; };
typedef int i32x4 __attribute__((ext_vector_type(4)));
typedef int i32x8 __attribute__((ext_vector_type(8)));

struct StaticOrder {
    int nM, nN, nwg, G, c;
    __host__ __device__ void init(int M, int N, int G_, int c_) { nM = M / BM; nN = N / BM; nwg = nM * nN; G = G_; c = c_; }
    __host__ __device__ bool next(int i, Unit& u) const {
        const long L = (long)i * G + c; if (L >= nwg) return false;
        int wgid = (int)L; { const int q = nwg / NXCD, r = nwg % NXCD, xcd = wgid % NXCD, off = wgid / NXCD; wgid = (xcd < r ? xcd * (q + 1) : r * (q + 1) + (xcd - r) * q) + off; }
        const int nig = WGM * nN, gid = wgid / nig, fm = gid * WGM, gsz = (nM - fm) < WGM ? (nM - fm) : WGM;
        u.pm = fm + ((wgid % nig) % gsz); u.pn = (wgid % nig) / gsz; return true;
    }
    __device__ __forceinline__ void a_ready(const Unit&) const {}
    __device__ __forceinline__ void done(const Unit&) const {}
};

__device__ __forceinline__ unsigned cvt_pk_bf16(float lo, float hi) { unsigned r; asm volatile("v_cvt_pk_bf16_f32 %0, %1, %2" : "=v"(r) : "v"(lo), "v"(hi)); return r; }
typedef float f32x2 __attribute__((ext_vector_type(2)));
__device__ __forceinline__ f32x2 gelu_pk(f32x2 v) {
    const f32x2 av = __builtin_elementwise_abs(v), d = av * 0.2316418882f + 1.0f;
    f32x2 t; t.x = __builtin_amdgcn_rcpf(d.x); t.y = __builtin_amdgcn_rcpf(d.y);
    f32x2 q = t * 0.5307027145f + (-0.7265760135f); q = q * t + 0.7107068705f; q = q * t + (-0.142248368f); q = q * t + 0.127414796f; q = q * t;
    const f32x2 s = (v * v) * (-0.72134752044f);
    f32x2 e; e.x = __builtin_amdgcn_exp2f(s.x); e.y = __builtin_amdgcn_exp2f(s.y);
    const f32x2 m = v * (q * e), r = v - m;
    f32x2 o; o.x = v.x < 0.f ? m.x : r.x; o.y = v.y < 0.f ? m.y : r.y; return o;
}

template <int ACT  > struct EpiBf16 {
    static constexpr bool PERM = true, AFTER_DRAIN = false; static_assert(ACT == 0 || ACT == 1, "EpiBf16: ACT is 0 (none) or 1 (gelu_pk)");
    bf16_t* O; int ldc; const float* bias; int split_cols; size_t split_stride; float scale0;
    __device__ __forceinline__ void operator()(const f32x4 (&acc)[2][2][4][2], const Unit& u, int wr, int wc, int fr, int fq) const {
        const int row0 = u.pm * BM + wr * 64 + fr; int colt = u.pn * BM; bf16_t* base = O;
        float sc = 1.f; if (split_cols) { const int t = colt / split_cols; base += (size_t)t * split_stride; colt -= t * split_cols; if (t == 0) sc = scale0; }
        const int col0 = colt + wc * 32 + 8 * fq, bcol0 = u.pn * BM + wc * 32 + 8 * fq;
        f32x4 bv[2][2];
#pragma unroll
        for (int bj = 0; bj < 2; ++bj)
#pragma unroll
            for (int n = 0; n < 2; ++n) bv[bj][n] = bias ? *(const f32x4*)(bias + bcol0 + bj * HALF + 4 * n) : (f32x4){0.f, 0.f, 0.f, 0.f};
#pragma unroll
        for (int ai = 0; ai < 2; ++ai)
#pragma unroll
            for (int m = 0; m < 4; ++m) { bf16_t* rowp = base + (size_t)(row0 + ai * HALF + m * 16) * ldc + col0;
#pragma unroll
                for (int bj = 0; bj < 2; ++bj) { f32x4 v0 = acc[ai][bj][m][0] + bv[bj][0], v1 = acc[ai][bj][m][1] + bv[bj][1];
                    if (ACT == 1) { f32x2 a = gelu_pk((f32x2){v0[0], v0[1]}), b = gelu_pk((f32x2){v0[2], v0[3]}), c = gelu_pk((f32x2){v1[0], v1[1]}), d = gelu_pk((f32x2){v1[2], v1[3]});
                        v0 = (f32x4){a.x, a.y, b.x, b.y}; v1 = (f32x4){c.x, c.y, d.x, d.y}; }
                    v0 = v0 * sc; v1 = v1 * sc; u32x4 w; w.x = cvt_pk_bf16(v0[0], v0[1]); w.y = cvt_pk_bf16(v0[2], v0[3]); w.z = cvt_pk_bf16(v1[0], v1[1]); w.w = cvt_pk_bf16(v1[2], v1[3]);
                    *(u32x4*)(rowp + bj * HALF) = w; } }
    }
};

template <class Epi, class Sched, bool ALIGN_EPI = false, bool SP2 = false, bool FP8 = false, int SA = 0x7f7f7f7f, int SB = 0x7f7f7f7f>
__device__ __forceinline__ void gemm_phase(PG8_LAS unsigned char* lds, const Gemm g, const Sched& S, const Epi& E) {
    int tid_ = threadIdx.x; asm volatile("" : "+v"(tid_));
    const int tid = tid_, wid = __builtin_amdgcn_readfirstlane(tid >> 6), lane = tid & 63, wr = wid >> 2, wc = wid & 3, fr = lane & 15, fq = lane >> 4;
    constexpr int ES = FP8 ? 1 : 2;
    const int K = g.K, nt = K * ES / (BK * 2);
    unsigned voffA[2], voffB[2];
#pragma unroll
    for (int i = 0; i < 2; ++i) { int R, C; stage_rc(tid * 16 + i * 8192, R, C); const int Rb = Epi::PERM ? ((R & ~31) + perm32(R & 31)) : R;
        voffA[i] = (unsigned)(R * K * ES + C * 2); voffB[i] = (unsigned)(Rb * K * ES + C * 2); }
    const size_t kstep = (size_t)(BK * 2);
    const size_t hstep = (size_t)HALF * K * ES;
    const size_t tstep = 2 * hstep;
    const unsigned ldsw = (unsigned)wid * 1024u;
    const int aoff = lds_byte(wr * 64 + fr, fq * 8), boff = lds_byte(wc * 32 + fr, fq * 8);
#define PG8_SA(b, h) (((b) * 2 + (h)) * HTB)
#define PG8_SB(b, h) ((4 + (b) * 2 + (h)) * HTB)
#define PG8_STAGE(bufoff, gbase, voff) do { if constexpr (FP8) {   \
          int t3_ = tid; asm volatile("" : "+v"(t3_)); _Pragma("unroll") for (int _i = 0; _i < 2; ++_i) { int R_, C_; stage_rc(t3_ * 16 + _i * 8192, R_, C_); \
            if (Epi::PERM && (&(voff)[0] == &voffB[0])) R_ = (R_ & ~31) + perm32(R_ & 31); \
            __builtin_amdgcn_global_load_lds((const unsigned*)((const char*)(gbase) + (unsigned)(R_ * K * ES + C_ * 2)), (PG8_LAS unsigned*)(lds + (bufoff) + ldsw + _i * 8192), 16, 0, 0); } } \
        else { _Pragma("unroll") for (int _i = 0; _i < 2; ++_i) \
        __builtin_amdgcn_global_load_lds((const unsigned*)((const char*)(gbase) + (voff)[_i]), (PG8_LAS unsigned*)(lds + (bufoff) + ldsw + _i * 8192), 16, 0, 0); } } while (0)
#define PG8_LDA(dst, b, h) do { if constexpr (FP8) { _Pragma("unroll") for (int m = 0; m < 4; ++m) dst##8[m] = __builtin_shufflevector(*(const PG8_LAS i32x4*)(lds + PG8_SA(b, h) + aoff + m * 2048), *(const PG8_LAS i32x4*)(lds + PG8_SA(b, h) + aoff + m * 2048 + 1024), 0, 1, 2, 3, 4, 5, 6, 7); } \
        else { _Pragma("unroll") for (int m = 0; m < 4; ++m) _Pragma("unroll") for (int k = 0; k < 2; ++k) dst[m][k] = *(const PG8_LAS bf16x8*)(lds + PG8_SA(b, h) + aoff + m * 2048 + k * 1024); } } while (0)
#define PG8_LDB(dst, b, h) do { if constexpr (FP8) { _Pragma("unroll") for (int n = 0; n < 2; ++n) dst##8[n] = __builtin_shufflevector(*(const PG8_LAS i32x4*)(lds + PG8_SB(b, h) + boff + n * 2048), *(const PG8_LAS i32x4*)(lds + PG8_SB(b, h) + boff + n * 2048 + 1024), 0, 1, 2, 3, 4, 5, 6, 7); } \
        else { _Pragma("unroll") for (int n = 0; n < 2; ++n) _Pragma("unroll") for (int k = 0; k < 2; ++k) dst[n][k] = *(const PG8_LAS bf16x8*)(lds + PG8_SB(b, h) + boff + n * 2048 + k * 1024); } } while (0)
#define PG8_MMA(ai, bj, At, Bt) do { __builtin_amdgcn_s_setprio(1); \
        if constexpr (FP8) { _Pragma("unroll") for (int m = 0; m < 4; ++m) _Pragma("unroll") for (int n = 0; n < 2; ++n) { \
            acc[ai][bj][m][n] = __builtin_amdgcn_mfma_scale_f32_16x16x128_f8f6f4(Bt##8[n], At##8[m], acc[ai][bj][m][n], 0, 0, 0, SB, 0, SA); } } \
        else { _Pragma("unroll") for (int m = 0; m < 4; ++m) _Pragma("unroll") for (int n = 0; n < 2; ++n) _Pragma("unroll") for (int k = 0; k < 2; ++k) \
            acc[ai][bj][m][n] = __builtin_amdgcn_mfma_f32_16x16x32_bf16(Bt[n][k], At[m][k], acc[ai][bj][m][n], 0, 0, 0); } \
        __builtin_amdgcn_s_setprio(0); } while (0)
#define PG8_WAIT_V(n) asm volatile("s_waitcnt vmcnt(" #n ")" ::: "memory")
#define PG8_WAIT_L(n) asm volatile("s_waitcnt lgkmcnt(" #n ")" ::: "memory")
#define PG8_BAR __builtin_amdgcn_s_barrier()
#define PG8_SCHED __builtin_amdgcn_sched_barrier(0)
    Unit cur, nxt; int ui = 0;
    if (!S.next(0, cur)) return;
    f32x4 acc[2][2][4][2];
#pragma unroll
    for (int a = 0; a < 2; ++a)
#pragma unroll
        for (int b = 0; b < 2; ++b)
#pragma unroll
            for (int m = 0; m < 4; ++m)
#pragma unroll
                for (int n = 0; n < 2; ++n) acc[a][b][m][n] = (f32x4){0.f, 0.f, 0.f, 0.f};
    bf16x8 At[4][2], B0[2][2], B1[2][2]; i32x8 At8[4], B08[2], B18[2];
    const char* cA = (const char*)g.A + (size_t)cur.pm * tstep; const char* cB = (const char*)g.Bt + (size_t)cur.pn * tstep;
    S.a_ready(cur);
    if constexpr (SP2) {
        PG8_STAGE(PG8_SB(0, 0), cB, voffB); PG8_STAGE(PG8_SB(0, 1), cB + hstep, voffB); PG8_STAGE(PG8_SA(0, 0), cA, voffA); PG8_STAGE(PG8_SA(0, 1), cA + hstep, voffA);
        if (wr == 1) PG8_BAR;
        PG8_WAIT_V(2); PG8_BAR;
        PG8_STAGE(PG8_SB(1, 0), cB + kstep, voffB); PG8_STAGE(PG8_SA(1, 0), cA + kstep, voffA); PG8_STAGE(PG8_SB(1, 1), cB + hstep + kstep, voffB);
        PG8_WAIT_V(6); PG8_BAR;
    } else {
        PG8_STAGE(PG8_SB(0, 0), cB, voffB); PG8_STAGE(PG8_SA(0, 0), cA, voffA); PG8_STAGE(PG8_SB(0, 1), cB + hstep, voffB); PG8_STAGE(PG8_SA(0, 1), cA + hstep, voffA);
        if (wr == 1) PG8_BAR;
        PG8_WAIT_V(4); PG8_BAR;
        PG8_STAGE(PG8_SB(1, 0), cB + kstep, voffB); PG8_STAGE(PG8_SA(1, 0), cA + kstep, voffA); PG8_STAGE(PG8_SB(1, 1), cB + hstep + kstep, voffB);
        PG8_WAIT_V(6); PG8_BAR;
    }
    for (;;) {
        const bool has_next = S.next(ui + 1, nxt);
        const char* nA = has_next ? (const char*)g.A + (size_t)nxt.pm * tstep : cA; const char* nB = has_next ? (const char*)g.Bt + (size_t)nxt.pn * tstep : cB;
#pragma unroll 1
        for (int t = 0; t < nt; t += 2) {
            const bool last = (t == nt - 2);
            const char* a1 = cA + (size_t)(t + 1) * kstep;
            const char* a2 = last ? nA : cA + (size_t)(t + 2) * kstep; const char* b2 = last ? nB : cB + (size_t)(t + 2) * kstep;
            const char* a3 = a2 + kstep; const char* b3 = b2 + kstep;
            if (last && has_next) S.a_ready(nxt);
            if constexpr (SP2) {
            PG8_LDB(B0, 0, 0); PG8_LDB(B1, 0, 1); PG8_SCHED; PG8_LDA(At, 0, 0); PG8_STAGE(PG8_SA(1, 1), a1 + hstep, voffA);
            PG8_WAIT_V(8); PG8_WAIT_L(0); PG8_BAR; PG8_MMA(0, 0, At, B0); PG8_MMA(0, 1, At, B1); PG8_BAR; PG8_SCHED;
            PG8_LDA(At, 0, 1); PG8_STAGE(PG8_SB(0, 0), b2, voffB); PG8_STAGE(PG8_SB(0, 1), b2 + hstep, voffB); PG8_STAGE(PG8_SA(0, 0), a2, voffA);
            PG8_WAIT_V(8); PG8_WAIT_L(0); PG8_BAR; PG8_MMA(1, 0, At, B0); PG8_MMA(1, 1, At, B1); PG8_BAR; PG8_SCHED;
            PG8_LDB(B0, 1, 0); PG8_LDB(B1, 1, 1); PG8_SCHED; PG8_LDA(At, 1, 0); PG8_STAGE(PG8_SA(0, 1), a2 + hstep, voffA);
            PG8_WAIT_V(8); PG8_WAIT_L(0); PG8_BAR; PG8_MMA(0, 0, At, B0); PG8_MMA(0, 1, At, B1); PG8_BAR; PG8_SCHED;
            PG8_LDA(At, 1, 1); PG8_STAGE(PG8_SB(1, 0), b3, voffB); PG8_STAGE(PG8_SB(1, 1), b3 + hstep, voffB); PG8_STAGE(PG8_SA(1, 0), a3, voffA);
            PG8_WAIT_V(8); PG8_WAIT_L(0); PG8_BAR; PG8_MMA(1, 0, At, B0); PG8_MMA(1, 1, At, B1); PG8_BAR; PG8_SCHED;
            } else {
            PG8_LDB(B0, 0, 0); PG8_SCHED; PG8_LDA(At, 0, 0); PG8_STAGE(PG8_SA(1, 1), a1 + hstep, voffA);
            PG8_WAIT_L(8); PG8_BAR; PG8_WAIT_L(0); PG8_MMA(0, 0, At, B0); PG8_BAR; PG8_SCHED;
            PG8_LDB(B1, 0, 1); PG8_STAGE(PG8_SB(0, 0), b2, voffB);
            PG8_BAR; PG8_WAIT_L(0); PG8_MMA(0, 1, At, B1); PG8_BAR;
            PG8_LDA(At, 0, 1); PG8_STAGE(PG8_SA(0, 0), a2, voffA);
            PG8_BAR; PG8_WAIT_L(0); PG8_MMA(1, 0, At, B0); PG8_BAR; PG8_SCHED;
            PG8_STAGE(PG8_SB(0, 1), b2 + hstep, voffB);
            PG8_WAIT_V(6); PG8_BAR; PG8_MMA(1, 1, At, B1); PG8_BAR;
            PG8_LDB(B0, 1, 0); PG8_SCHED; PG8_LDA(At, 1, 0); PG8_STAGE(PG8_SA(0, 1), a2 + hstep, voffA);
            PG8_WAIT_L(8); PG8_BAR; PG8_WAIT_L(0); PG8_MMA(0, 0, At, B0); PG8_BAR; PG8_SCHED;
            PG8_LDB(B1, 1, 1); PG8_STAGE(PG8_SB(1, 0), b3, voffB);
            PG8_BAR; PG8_WAIT_L(0); PG8_MMA(0, 1, At, B1); PG8_BAR;
            PG8_LDA(At, 1, 1); PG8_STAGE(PG8_SA(1, 0), a3, voffA);
            PG8_BAR; PG8_WAIT_L(0); PG8_MMA(1, 0, At, B0); PG8_BAR; PG8_SCHED;
            PG8_STAGE(PG8_SB(1, 1), b3 + hstep, voffB);
            PG8_WAIT_V(6); PG8_BAR; PG8_MMA(1, 1, At, B1); PG8_BAR;
            }
        }
        if constexpr (ALIGN_EPI) { if (wr == 0) PG8_BAR; }
        if constexpr (!Epi::AFTER_DRAIN) { E(acc, cur, wr, wc, fr, fq); S.done(cur); }
        if (!has_next) break;
#pragma unroll
        for (int a = 0; a < 2; ++a)
#pragma unroll
            for (int b = 0; b < 2; ++b)
#pragma unroll
                for (int m = 0; m < 4; ++m)
#pragma unroll
                    for (int n = 0; n < 2; ++n) acc[a][b][m][n] = (f32x4){0.f, 0.f, 0.f, 0.f};
        cur = nxt; cA = nA; cB = nB; ++ui;
        if constexpr (ALIGN_EPI) { if (wr == 1) PG8_BAR; }
    }
    PG8_WAIT_V(0);
    if constexpr (!ALIGN_EPI) { if (wr == 0) PG8_BAR; }
    PG8_BAR;
    if constexpr (Epi::AFTER_DRAIN) { E.fused(acc, cur, wr, wc, fr, fq, lds, wid, lane); S.done(cur); }
#undef PG8_SA
#undef PG8_SB
#undef PG8_STAGE
#undef PG8_LDA
#undef PG8_LDB
#undef PG8_MMA
#undef PG8_WAIT_V
#undef PG8_WAIT_L
#undef PG8_BAR
#undef PG8_SCHED
}
}

namespace att {
typedef unsigned short bf16;
constexpr int D = 128, NW = 8, QBLK = 32, KVBLK = 64, LDQ = 1024, LDK = 256;
constexpr float SCALE = 0.088388347648318440f;
constexpr float THR = 8.f;
constexpr float O8_SCALE = 64.f;
#ifndef ATT_SDEPTH
#define ATT_SDEPTH 2
#endif
constexpr int SDEPTH = ATT_SDEPTH;
constexpr size_t SHM_V = KVBLK * D * 2, SHM_K = KVBLK * D * 2, SHM_ATTN = 2 * SHM_V + 2 * SHM_K + NW * 64 * 4;
using bf16x8 = __attribute__((ext_vector_type(8))) short;
using s16x4  = __attribute__((ext_vector_type(4))) short;
using f32x16 = __attribute__((ext_vector_type(16))) float;
using u32x4  = __attribute__((ext_vector_type(4))) unsigned;
#define KSWZ(row, colB) ((row) * 256 + ((colB) ^ (((row) & 7) << 4)))
#define SBAR() __builtin_amdgcn_sched_barrier(0)
__device__ __forceinline__ int crow(int r, int hi) { return (r & 3) + 8 * (r >> 2) + 4 * hi; }
__device__ __forceinline__ unsigned cvtpk(float lo, float hi) { unsigned r; asm volatile("v_cvt_pk_bf16_f32 %0, %1, %2" : "=v"(r) : "v"(lo), "v"(hi)); return r; }
__device__ __forceinline__ void partialSM(f32x16& p0, f32x16& p1, float& m_reg, float& mn, float& alpha) {
  constexpr float C = SCALE * 1.4426950408889634f;
  float pmax = p0[0]; for (int r = 1; r < 16; ++r) pmax = fmaxf(pmax, p0[r]); for (int r = 0; r < 16; ++r) pmax = fmaxf(pmax, p1[r]);
  { auto rr = __builtin_amdgcn_permlane32_swap(__float_as_uint(pmax), __float_as_uint(pmax), false, false);
    pmax = fmaxf(__uint_as_float(rr[0]), __uint_as_float(rr[1])); }
  if (__builtin_expect(__all(pmax - m_reg <= THR / SCALE), 1)) { mn = m_reg; alpha = 1.f; }
  else { mn = fmaxf(m_reg, pmax); alpha = __builtin_amdgcn_exp2f((m_reg - mn) * C); m_reg = mn; }
  float mnC = -mn * C;
  for (int r = 0; r < 16; ++r) p0[r] = fmaf(p0[r], C, mnC); for (int r = 0; r < 16; ++r) p1[r] = fmaf(p1[r], C, mnC);
  for (int r = 0; r < 16; ++r) p0[r] = __builtin_amdgcn_exp2f(p0[r]);
}
__device__ __forceinline__ void finishSM(f32x16& p0, f32x16& p1, float alpha, float& l_reg, bf16x8& pa0, bf16x8& pa1, bf16x8& pa2, bf16x8& pa3) {
  for (int r = 0; r < 16; ++r) p1[r] = __builtin_amdgcn_exp2f(p1[r]);
  float ps = 0; for (int r = 0; r < 16; ++r) ps += p0[r]; for (int r = 0; r < 16; ++r) ps += p1[r];
  { auto rr = __builtin_amdgcn_permlane32_swap(__float_as_uint(ps), __float_as_uint(ps), false, false);
    ps = __uint_as_float(rr[0]) + __uint_as_float(rr[1]); }
  l_reg = l_reg * alpha + ps;
#define PK4(P, BASE, OUT) do { unsigned a0 = cvtpk(P[BASE + 0], P[BASE + 1]), a1 = cvtpk(P[BASE + 2], P[BASE + 3]);   \
    unsigned b0 = cvtpk(P[BASE + 4], P[BASE + 5]), b1 = cvtpk(P[BASE + 6], P[BASE + 7]);                              \
    auto r0 = __builtin_amdgcn_permlane32_swap(a0, b0, false, false); auto r1 = __builtin_amdgcn_permlane32_swap(a1, b1, false, false); \
    u32x4 w = {r0[0], r1[0], r0[1], r1[1]}; OUT = *reinterpret_cast<bf16x8*>(&w); } while (0)
  PK4(p0, 0, pa0); PK4(p0, 8, pa1); PK4(p1, 0, pa2); PK4(p1, 8, pa3);
#undef PK4
}
__device__ __forceinline__ void qkt(f32x16& p0, f32x16& p1, const bf16* Ks, const bf16x8* qr, int r32, int hi) {
  p0 = f32x16{}; p1 = f32x16{};
  for (int d0 = 0; d0 < 8; ++d0) { int cb = (d0 * 16 + hi * 8) * 2;
    bf16x8 b0 = *reinterpret_cast<const bf16x8*>((const char*)Ks + KSWZ(r32, cb));
    bf16x8 b1 = *reinterpret_cast<const bf16x8*>((const char*)Ks + KSWZ(32 + r32, cb));
    p0 = __builtin_amdgcn_mfma_f32_32x32x16_bf16(b0, qr[d0], p0, 0, 0, 0);
    p1 = __builtin_amdgcn_mfma_f32_32x32x16_bf16(b1, qr[d0], p1, 0, 0, 0); }
}
__device__ __forceinline__ int v_st(int k, int c) { const int kk = (k & ~0xC) | ((k & 4) << 1) | ((k & 8) >> 1); return ((kk >> 3) * 4 + (c >> 5)) * 512 + ((kk & 7) * 32 + (c & 31)) * 2; }
__device__ __forceinline__ int v_rd_base(int lane) { return ((lane & 3) << 3) | (((lane >> 2) & 3) << 6) | (((lane >> 4) & 1) << 5) | (((lane >> 5) & 1) << 8); }
constexpr int v_rd_off(int d0, int ks, int half) { return d0 * 512 + ks * 4096 + half * 2048; }
template <int OFF> __device__ __forceinline__ s16x4 tr_read(int vb) {
  s16x4 r; asm volatile("ds_read_b64_tr_b16 %0, %1 offset:%2" : "=&v"(r) : "v"(vb), "i"(OFF) : "memory"); return r;
}
template <int D0> __device__ __forceinline__ void pv_one(f32x16& od, int vb, bf16x8 pa0, bf16x8 pa1, bf16x8 pa2, bf16x8 pa3) {
  const s16x4 l0 = tr_read<v_rd_off(D0, 0, 0)>(vb), h0 = tr_read<v_rd_off(D0, 0, 1)>(vb), l1 = tr_read<v_rd_off(D0, 1, 0)>(vb), h1 = tr_read<v_rd_off(D0, 1, 1)>(vb);
  const s16x4 l2 = tr_read<v_rd_off(D0, 2, 0)>(vb), h2 = tr_read<v_rd_off(D0, 2, 1)>(vb), l3 = tr_read<v_rd_off(D0, 3, 0)>(vb), h3 = tr_read<v_rd_off(D0, 3, 1)>(vb);
  asm volatile("s_waitcnt lgkmcnt(0)" ::: "memory"); SBAR();
#define PKV(L, H) (bf16x8){L[0], L[1], L[2], L[3], H[0], H[1], H[2], H[3]}
  od = __builtin_amdgcn_mfma_f32_32x32x16_bf16(pa0, PKV(l0, h0), od, 0, 0, 0);
  od = __builtin_amdgcn_mfma_f32_32x32x16_bf16(pa1, PKV(l1, h1), od, 0, 0, 0);
  od = __builtin_amdgcn_mfma_f32_32x32x16_bf16(pa2, PKV(l2, h2), od, 0, 0, 0);
  od = __builtin_amdgcn_mfma_f32_32x32x16_bf16(pa3, PKV(l3, h3), od, 0, 0, 0);
#undef PKV
}
__device__ __forceinline__ void pv_d0(f32x16* o, int vb, bf16x8 pa0, bf16x8 pa1, bf16x8 pa2, bf16x8 pa3) {
  pv_one<0>(o[0], vb, pa0, pa1, pa2, pa3); pv_one<1>(o[1], vb, pa0, pa1, pa2, pa3); pv_one<2>(o[2], vb, pa0, pa1, pa2, pa3); pv_one<3>(o[3], vb, pa0, pa1, pa2, pa3);
}
__device__ __forceinline__ void wmask(f32x16& p0, f32x16& p1, int kb, int qp, int hi) {
  const int bd = kb - qp + 4 * hi + 128;
#pragma unroll
  for (int r = 0; r < 16; ++r) { const int d0 = bd + (r & 3) + 8 * (r >> 2);
    if ((unsigned)d0 > 256u) p0[r] = -1e30f; if ((unsigned)(d0 + 32) > 256u) p1[r] = -1e30f; }
}
__device__ __forceinline__ void attn_unit(const bool WIN, const bf16* Qb, unsigned char* Ob, const bf16* __restrict__ Kh, const bf16* __restrict__ Vh, int NT, int kstart, int q0, float sink_l2, float sink1_l2, char* lds) {
  int tid_ = threadIdx.x; asm volatile("" : "+v"(tid_));
  const int tid = tid_, wid = __builtin_amdgcn_readfirstlane(tid >> 6), lane = tid & 63, r32 = lane & 31, hi = lane >> 5;
  bf16* V_lds = (bf16*)lds; bf16* K_lds = (bf16*)(lds + 2 * SHM_V);
  float* ws = (float*)(lds + 2 * SHM_V + 2 * SHM_K) + wid * 64; float* li_l = ws; float* al_l = ws + 32;
  float m_reg = -1e30f, l_reg = 0; f32x16 o[4] = {}; bf16x8 qr[8];
  const int wrow = WIN ? (wid & 3) * QBLK : wid * QBLK, hoff = WIN ? (wid >> 2) * D : 0;
  const bf16* Qw = Qb + (long)(wrow + r32) * LDQ + hoff + hi * 8;
#pragma unroll
  for (int d0 = 0; d0 < 8; ++d0) qr[d0] = *reinterpret_cast<const bf16x8*>(Qw + d0 * 16);
  const int sr = tid >> 4, sc = (tid & 15) * 8, vst0 = v_st(sr, sc), vst1 = v_st(32 + sr, sc);
  const int vb0 = (int)(uintptr_t)V_lds + v_rd_base(lane);
  const int qp = q0 + wrow + r32;
  struct { bf16x8 vs0, vs1, ks0, ks1; } sr_[SDEPTH];
#define TROW(t) (WIN ? ((t) < 4 ? (t) * KVBLK : kstart + (t) * KVBLK) : (t) * KVBLK)
#define SLOAD(i, t) do { const int k0_ = TROW(t); sr_[i].vs0 = *reinterpret_cast<const bf16x8*>(&Vh[(long)(k0_ + sr) * LDK + sc]); sr_[i].vs1 = *reinterpret_cast<const bf16x8*>(&Vh[(long)(k0_ + 32 + sr) * LDK + sc]); \
    sr_[i].ks0 = *reinterpret_cast<const bf16x8*>(&Kh[(long)(k0_ + sr) * LDK + sc]); sr_[i].ks1 = *reinterpret_cast<const bf16x8*>(&Kh[(long)(k0_ + 32 + sr) * LDK + sc]); } while (0)
#define SWRITE(b, i) do { *(bf16x8*)((char*)V_lds + (b) * SHM_V + vst0) = sr_[i].vs0;          \
    *(bf16x8*)((char*)V_lds + (b) * SHM_V + vst1) = sr_[i].vs1; int kc = sc * 2;               \
    *(bf16x8*)((char*)K_lds + (b) * SHM_K + KSWZ(sr, kc)) = sr_[i].ks0;                       \
    *(bf16x8*)((char*)K_lds + (b) * SHM_K + KSWZ(32 + sr, kc)) = sr_[i].ks1; } while (0)
#define SWAIT() do { if constexpr (SDEPTH == 2) asm volatile("s_waitcnt vmcnt(4)" ::: "memory"); else asm volatile("s_waitcnt vmcnt(0)" ::: "memory"); } while (0)
#define RESC(a) do { if (__any((a) < 1.f)) { if (hi == 0) al_l[r32] = (a); asm volatile("s_waitcnt lgkmcnt(0)" ::: "memory"); \
    for (int d = 0; d < 4; ++d) for (int r = 0; r < 16; ++r) o[d][r] *= al_l[crow(r, hi)]; } } while (0)
#define WMASK(P0, P1, t) do { if (WIN) { if ((t) >= 4) wmask(P0, P1, kstart + ((t) - 4) * KVBLK, qp, hi); } } while (0)
  f32x16 pA0, pA1, pB0, pB1; float mnA, mnB, alA, alB; bf16x8 pa0, pa1, pa2, pa3;
  constexpr int SE = 0, SO = SDEPTH - 1;
  SLOAD(SE, 0); asm volatile("s_waitcnt vmcnt(0)" ::: "memory"); SWRITE(0, SE); __syncthreads();
  qkt(pA0, pA1, K_lds, qr, r32, hi); WMASK(pA0, pA1, 0); partialSM(pA0, pA1, m_reg, mnA, alA);
  SLOAD(SO, 1); if constexpr (SDEPTH == 2) { if (2 < NT) SLOAD(SE, 2); }
  SWAIT(); SWRITE(1, SO); __syncthreads();
  for (int j = 1; j + 1 < NT; j += 2) {
    SBAR(); qkt(pB0, pB1, (bf16*)((char*)K_lds + SHM_K), qr, r32, hi); WMASK(pB0, pB1, j);
    finishSM(pA0, pA1, alA, l_reg, pa0, pa1, pa2, pa3); SBAR();
    SLOAD(SO, j + SDEPTH); SBAR();
    pv_d0(o, vb0, pa0, pa1, pa2, pa3); partialSM(pB0, pB1, m_reg, mnB, alB);
    __syncthreads(); SWAIT(); SWRITE(0, SE);
    RESC(alB); __syncthreads();
    SBAR(); qkt(pA0, pA1, K_lds, qr, r32, hi); WMASK(pA0, pA1, j + 1);
    finishSM(pB0, pB1, alB, l_reg, pa0, pa1, pa2, pa3); SBAR();
    if (SDEPTH == 1 || j + 3 < NT) SLOAD(SE, j + 1 + SDEPTH); SBAR();
    pv_d0(o, vb0 + (int)SHM_V, pa0, pa1, pa2, pa3); partialSM(pA0, pA1, m_reg, mnA, alA);
    __syncthreads(); SWAIT(); SWRITE(1, SO);
    RESC(alA); __syncthreads();
  }
  SBAR(); qkt(pB0, pB1, (bf16*)((char*)K_lds + SHM_K), qr, r32, hi); WMASK(pB0, pB1, NT - 1);
  finishSM(pA0, pA1, alA, l_reg, pa0, pa1, pa2, pa3); SBAR();
  pv_d0(o, vb0, pa0, pa1, pa2, pa3); partialSM(pB0, pB1, m_reg, mnB, alB);
  __syncthreads(); RESC(alB);
  finishSM(pB0, pB1, alB, l_reg, pa0, pa1, pa2, pa3); SBAR();
  pv_d0(o, vb0 + (int)SHM_V, pa0, pa1, pa2, pa3);
  if (WIN) { constexpr float C = SCALE * 1.4426950408889634f; l_reg += __builtin_amdgcn_exp2f(((wid >> 2) ? sink1_l2 : sink_l2) - m_reg * C); }
  if (hi == 0) li_l[r32] = l_reg; asm volatile("s_waitcnt lgkmcnt(0)" ::: "memory");
  float rli[16];
#pragma unroll
  for (int r = 0; r < 16; ++r) rli[r] = __builtin_amdgcn_rcpf(li_l[crow(r, hi)]);
  unsigned char* Ow = Ob + (long)wrow * LDQ + hoff;
#pragma unroll
  for (int r = 0; r < 16; ++r) { const int orow = crow(r, hi);
#pragma unroll
    for (int d0 = 0; d0 < 4; ++d0) { const float v = o[d0][r] * rli[r] * O8_SCALE; Ow[(long)orow * LDQ + d0 * 32 + r32] = (unsigned char)(__builtin_amdgcn_cvt_pk_fp8_f32(v, v, 0, false) & 0xff); } }
  __syncthreads();
#undef TROW
#undef SLOAD
#undef SWRITE
#undef SWAIT
#undef RESC
#undef WMASK
}
#undef KSWZ
#undef SBAR
}

namespace mk {
namespace cg = cooperative_groups;
typedef unsigned short bf16;
typedef short bf16x8 __attribute__((ext_vector_type(8)));
typedef float f32x4 __attribute__((ext_vector_type(4)));
typedef unsigned u32x4 __attribute__((ext_vector_type(4)));
typedef unsigned u32x2 __attribute__((ext_vector_type(2)));
typedef __bf16 bf2_t __attribute__((ext_vector_type(2)));
#define LAS __attribute__((address_space(3)))
constexpr int NWAVES = 8, NTHR = 512;
constexpr size_t MiB = 1u << 20;
constexpr size_t WS_CTL = 0, CTL_BYTES = 1 * MiB;
constexpr size_t WS_MOD = 1 * MiB;
constexpr size_t WS_ROPE = 1 * MiB + 512 * 1024;
constexpr size_t WS_XC = 2 * MiB;
constexpr size_t WS_WQKV = 6 * MiB;
constexpr size_t WS_WO = 12 * MiB;
constexpr size_t WS_WP = 16 * MiB;
constexpr size_t WS_H = 24 * MiB;
constexpr size_t WS_Q = 58 * MiB;
constexpr size_t WS_K = 92 * MiB;
constexpr size_t WS_V = 101 * MiB;
constexpr size_t WS_EIDX = 110 * MiB;
constexpr size_t WS_GATE = 119 * MiB;
constexpr size_t WS_PW = 128 * MiB;
constexpr size_t WS_S = 137 * MiB;
constexpr size_t WS_UT = 274 * MiB;
constexpr size_t WS_VT = 306 * MiB;
constexpr size_t WS_O = 338 * MiB;
constexpr size_t WS_XB = 372 * MiB;
constexpr size_t WS_XCB = 436 * MiB;
constexpr size_t WS_PART = 440 * MiB;
constexpr size_t WS_END = 508 * MiB;
constexpr float U8_SCALE = 64.f, V8_SCALE = 8.f;
constexpr int LDS_BYTES = 155648;
constexpr int NPHASE = 23;

struct Args { const float* in[17]; float* out; unsigned char* ws; int ph_lo, ph_hi; };

constexpr int PTAB_OFF = 153600;
struct Ctx {
  unsigned char* ws;
  int tid, lane, wave, bid, G;
  LAS unsigned char* lds; unsigned char* ldsg;
  __device__ __forceinline__ const float* in(int k) const {
    const volatile LAS unsigned* t = (const volatile LAS unsigned*)(lds + PTAB_OFF) + 2 * k;
    const unsigned lo = __builtin_amdgcn_readfirstlane(t[0]), hi = __builtin_amdgcn_readfirstlane(t[1]);
    return (const float*)(((unsigned long long)hi << 32) | lo);
  }
  __device__ __forceinline__ float* outp() const { return (float*)in(17); }
};
enum { I_X = 0, I_C, I_CTX, I_CCTX, I_ADAW, I_ADAB, I_N1G, I_N2G, I_WQKV, I_QNG, I_KNG, I_WO, I_SINKS, I_PWQ, I_PSK, I_PU, I_PV };

__device__ __forceinline__ unsigned f2bf(float f) { unsigned u = __builtin_bit_cast(unsigned, f); return (u + 0x7fffu + ((u >> 16) & 1u)) >> 16; }
__device__ __forceinline__ unsigned pk2(float lo, float hi) { unsigned r; asm volatile("v_cvt_pk_bf16_f32 %0, %1, %2" : "=v"(r) : "v"(lo), "v"(hi)); return r; }
__device__ __forceinline__ float bflo(unsigned u) { return __uint_as_float(u << 16); }
__device__ __forceinline__ float bfhi(unsigned u) { return __uint_as_float(u & 0xffff0000u); }
__device__ __forceinline__ float silu(float x) { return x / (1.f + __expf(-x)); }
__device__ __forceinline__ float gelu_tanh(float x) {
  const float y = 0.7978845608028654f * (x + 0.044715f * x * x * x);
  const float t = 1.f - 2.f / (__expf(2.f * y) + 1.f);
  return 0.5f * x * (1.f + t);
}
__device__ __forceinline__ float wave_sum(float v) {
#pragma unroll
  for (int o = 1; o < 64; o <<= 1) v += __shfl_xor(v, o);
  return v;
}
__device__ __forceinline__ const float* xrow_sel(const float* lat, const float* cx, int r) { const int b = r / RPB, j = r % RPB; return j < CTXL ? cx + (size_t)(b * CTXL + j) * DM : lat + (size_t)(b * SEQ + (j - CTXL)) * DM; }
__device__ __forceinline__ int mod_row(int r) { const int b = r / RPB, j = r % RPB; return j < CTXL ? 4 : b; }

__device__ __forceinline__ const float* st_lat(const Ctx& F, int sel) { return sel == 0 ? F.in(I_X) : (sel == 1 ? (const float*)(F.ws + WS_XB) : (const float*)F.outp()); }
__device__ __forceinline__ const float* st_ctx(const Ctx& F, int sel) { return sel == 0 ? F.in(I_CTX) : (sel == 1 ? (const float*)(F.ws + WS_XCB) : (const float*)(F.ws + WS_XC)); }
__device__ __forceinline__ int qk_perm_col(int n) {
  if (n >= (NH + NKV) * HD) return n; const int d = n & 127, axis = d >> 6, pair = (d >> 5) & 1, f = d & 31; return (n & ~127) + 2 * (axis * 32 + f) + pair; }
constexpr float W8_SCALE = 32.f;
template <bool QKPERM, bool FP8>
__device__ __forceinline__ void p0_transpose_item(const float* W, int K, int N, bf16* WT, LAS float* scr, int item, int lane) {
  const int nblk = N / 32, kb = item / nblk, nb = item % nblk, k0 = 64 * kb, n0 = 32 * nb;
  { float t[32];
#pragma unroll
    for (int i = 0; i < 32; ++i) t[i] = W[(size_t)(k0 + 2 * i + (lane >> 5)) * N + n0 + (lane & 31)];
#pragma unroll
    for (int i = 0; i < 32; ++i) scr[(2 * i + (lane >> 5)) * 33 + (lane & 31)] = t[i]; }
  asm volatile("s_waitcnt lgkmcnt(0)" ::: "memory");
  const int c = lane & 7;
#pragma unroll
  for (int j = 0; j < 4; ++j) { const int n = (lane >> 3) + 8 * j; const LAS float* s = scr + (8 * c) * 33 + n;
    if constexpr (FP8) { int v0 = __builtin_amdgcn_cvt_pk_fp8_f32(s[0 * 33] * W8_SCALE, s[1 * 33] * W8_SCALE, 0, false); v0 = __builtin_amdgcn_cvt_pk_fp8_f32(s[2 * 33] * W8_SCALE, s[3 * 33] * W8_SCALE, v0, true);
      int v1 = __builtin_amdgcn_cvt_pk_fp8_f32(s[4 * 33] * W8_SCALE, s[5 * 33] * W8_SCALE, 0, false); v1 = __builtin_amdgcn_cvt_pk_fp8_f32(s[6 * 33] * W8_SCALE, s[7 * 33] * W8_SCALE, v1, true);
      u32x2 o; o.x = (unsigned)v0; o.y = (unsigned)v1; *(u32x2*)((unsigned char*)WT + (size_t)(QKPERM ? qk_perm_col(n0 + n) : n0 + n) * K + k0 + 8 * c) = o; }
    else { u32x4 o; o.x = pk2(s[0 * 33], s[1 * 33]); o.y = pk2(s[2 * 33], s[3 * 33]); o.z = pk2(s[4 * 33], s[5 * 33]); o.w = pk2(s[6 * 33], s[7 * 33]);
      *(u32x4*)(WT + (size_t)(QKPERM ? qk_perm_col(n0 + n) : n0 + n) * K + k0 + 8 * c) = o; } }
  asm volatile("s_waitcnt lgkmcnt(0)" ::: "memory");
}

constexpr int CONV_NR = DEPTH * NKEYS * NKEYS;
__device__ __forceinline__ int conv_idle(int G, int p) { const int nu = p == 0 ? 408 : (p == 1 ? 272 : 544); return (nu % G) ? G - (nu % G) : 0; }
__device__ __forceinline__ void conv_slot(const Ctx& F, int p, int& lo, int& hi) {
  const int i0 = conv_idle(F.G, 0), i1 = conv_idle(F.G, 1), i2 = conv_idle(F.G, 2), tw = 8 * i0 + 4 * i1 + 10 * i2; lo = hi = 0; if (tw == 0) return;
  const int unit = (2 * CONV_NR + tw - 1) / tw;
  const int mine = conv_idle(F.G, p), first = F.G - mine; if (F.bid < first) return;
  const int wgt = p == 0 ? 8 : (p == 1 ? 4 : 10), base = (p == 0 ? 0 : (p == 1 ? 8 * i0 : 8 * i0 + 4 * i1)) + wgt * (F.bid - first);
  lo = base * unit; hi = lo + wgt * unit;
}
__device__ __forceinline__ void convert_rows(const Ctx& F, int r_lo, int r_hi) {
  constexpr int NR = CONV_NR;
  const float* pup = F.in(I_PU); const float* pvp = F.in(I_PV);
  if (r_hi > 2 * NR) r_hi = 2 * NR;
  for (int rr = r_lo + F.wave; rr < r_hi; rr += 2 * NWAVES) {
    f32x4 a[2][4];
#pragma unroll
    for (int q = 0; q < 2; ++q) { const int row = rr + q * NWAVES; if (row < r_hi) { const float* src = (row < NR ? pup : pvp) + (size_t)(row < NR ? row : row - NR) * DM;
#pragma unroll
        for (int i = 0; i < 4; ++i) a[q][i] = ((const f32x4*)src)[i * 64 + F.lane]; } }
#pragma unroll
    for (int q = 0; q < 2; ++q) { const int row = rr + q * NWAVES; if (row < r_hi) { const bool isu = row < NR; const int rw = isu ? row : row - NR; const float sc = isu ? U8_SCALE : V8_SCALE;
        const size_t lay = (size_t)(rw >> 14), ex = (size_t)(rw & 16383); unsigned char* dst = F.ws + (isu ? WS_UT : WS_VT);
#pragma unroll
        for (int i = 0; i < 4; ++i) { int v = __builtin_amdgcn_cvt_pk_fp8_f32(a[q][i].x * sc, a[q][i].y * sc, 0, false); v = __builtin_amdgcn_cvt_pk_fp8_f32(a[q][i].z * sc, a[q][i].w * sc, v, true);
          const int sl = 2 * i + (F.lane >> 5); *(unsigned*)(dst + ((lay * 8 + sl) * 16384 + ex) * 128 + ((F.lane & 31) * 4)) = (unsigned)v; } } }
  }
}

__device__ __forceinline__ void phase_prologue(const Ctx& F) {
  { LAS float* sl = (LAS float*)F.lds;
    LAS float* red = sl + 5 * DM;
    { const float* cp = F.in(I_C); const float* ccp = F.in(I_CCTX);
      for (int e = F.tid; e < 5 * DM; e += NTHR) { const int r = e / DM, j = e % DM; sl[e] = silu(r < 4 ? cp[r * DM + j] : ccp[j]); } }
    __syncthreads();
    const float* adaw = F.in(I_ADAW); const float* adab = F.in(I_ADAB);
    for (int task = F.bid; task < DEPTH * 96; task += F.G) {
      const int i = task / 96, n = (task % 96) * 64 + F.lane;
      const float* w = adaw + (size_t)i * DM * NMOD * DM + n;
      float a0 = 0.f, a1 = 0.f, a2 = 0.f, a3 = 0.f, a4 = 0.f;
#pragma unroll 1
      for (int j0 = 0; j0 < 128; j0 += 32) { float wv[32];
#pragma unroll
        for (int jj = 0; jj < 32; ++jj) wv[jj] = w[(size_t)(F.wave * 128 + j0 + jj) * NMOD * DM];
#pragma unroll
        for (int jj = 0; jj < 32; ++jj) { const int j = F.wave * 128 + j0 + jj;
          a0 += sl[j] * wv[jj]; a1 += sl[DM + j] * wv[jj]; a2 += sl[2 * DM + j] * wv[jj]; a3 += sl[3 * DM + j] * wv[jj]; a4 += sl[4 * DM + j] * wv[jj]; } }
      red[(F.wave * 5 + 0) * 64 + F.lane] = a0; red[(F.wave * 5 + 1) * 64 + F.lane] = a1; red[(F.wave * 5 + 2) * 64 + F.lane] = a2;
      red[(F.wave * 5 + 3) * 64 + F.lane] = a3; red[(F.wave * 5 + 4) * 64 + F.lane] = a4;
      __syncthreads();
      if (F.tid < 320) { const int r = F.tid >> 6, l = F.tid & 63; float s = 0.f;
#pragma unroll
        for (int w8 = 0; w8 < 8; ++w8) s += red[(w8 * 5 + r) * 64 + l];
        const int nn = (task % 96) * 64 + l;
        ((float*)(F.ws + WS_MOD))[((size_t)i * 5 + r) * NMOD * DM + nn] = s + adab[i * NMOD * DM + nn]; }
      __syncthreads();
    }
  }
  { LAS float* sk = (LAS float*)F.lds;
    LAS float* wq = sk + 128 * 132;
    const float* pskp = F.in(I_PSK); const float* pwqp = F.in(I_PWQ);
    for (int task = F.bid; task < DEPTH * 8 * 2 * 16; task += F.G) {
      const int jc = task & 15, half = (task >> 4) & 1, h = (task >> 5) & 7, i = task >> 8;
      const float* SK = pskp + ((size_t)i * 2 + half) * NKEYS * 128;
      const float* WQ = pwqp + (size_t)i * DM * PQN + (size_t)(jc * 64) * PQN + h * PQD + half * 128;
      for (int e = F.tid; e < 128 * 32; e += NTHR) { const int kk = e >> 5, d4 = e & 31; const f32x4 v = *(const f32x4*)(SK + (size_t)kk * 128 + d4 * 4); *(LAS f32x4*)(sk + kk * 132 + d4 * 4) = v; }
      for (int e = F.tid; e < 64 * 32; e += NTHR) { const int j = e >> 5, d4 = e & 31; const f32x4 v = *(const f32x4*)(WQ + (size_t)j * PQN + d4 * 4); *(LAS f32x4*)(wq + j * 128 + d4 * 4) = v; }
      __syncthreads();
      const int kk = F.tid & 127, jg = F.tid >> 7;
      float acc[16];
#pragma unroll
      for (int q = 0; q < 16; ++q) acc[q] = 0.f;
#pragma unroll 2
      for (int d4 = 0; d4 < 32; ++d4) { const f32x4 s = *(const LAS f32x4*)(sk + kk * 132 + d4 * 4);
#pragma unroll
        for (int q = 0; q < 16; ++q) { const f32x4 w = *(const LAS f32x4*)(wq + (jg * 16 + q) * 128 + d4 * 4); acc[q] += s.x * w.x + s.y * w.y + s.z * w.z + s.w * w.w; } }
      bf16* o = (bf16*)(F.ws + WS_WP) + ((size_t)i * PQN + h * PQD + half * 128 + kk) * DM + jc * 64 + jg * 16;
      u32x4 o0, o1; o0.x = pk2(acc[0], acc[1]); o0.y = pk2(acc[2], acc[3]); o0.z = pk2(acc[4], acc[5]); o0.w = pk2(acc[6], acc[7]);
      o1.x = pk2(acc[8], acc[9]); o1.y = pk2(acc[10], acc[11]); o1.z = pk2(acc[12], acc[13]); o1.w = pk2(acc[14], acc[15]);
      *(u32x4*)o = o0; *(u32x4*)(o + 8) = o1;
      __syncthreads();
    }
  }
  { const int gt = F.bid * NTHR + F.tid; float* rp = (float*)(F.ws + WS_ROPE);
    if (gt < 64 * 32) { const int pos = gt >> 5, f = gt & 31; const float inv = exp2f(-(float)(2 * f) * (13.287712379549449f / 64.f)); float sn, cs; sincosf((float)pos * inv, &sn, &cs); rp[2 * gt] = cs; rp[2 * gt + 1] = sn; }
    else if (gt < 64 * 32 + DEPTH * 2 * HD) { const int e = gt - 64 * 32, p = e & 127, which = (e >> 7) & 1, layer = e >> 8; const int q = p >> 1, pair = p & 1, d = (q >> 5) * 64 + pair * 32 + (q & 31);
      rp[64 * 32 * 2 + e] = (which == 0 ? F.in(I_QNG) : F.in(I_KNG))[layer * HD + d]; } }
  if (8 * conv_idle(F.G, 0) + 4 * conv_idle(F.G, 1) + 10 * conv_idle(F.G, 2) == 0) { const int per = (2 * CONV_NR + F.G - 1) / F.G; convert_rows(F, F.bid * per, (F.bid + 1) * per); }
  { LAS float* scr = (LAS float*)F.lds + F.wave * (64 * 33 + 16);
    const int gw = F.bid * NWAVES + F.wave, NGW = F.G * NWAVES;
    constexpr int I_QKV = (DM / 64) * (QKVD / 32), I_O = (DM / 64) * (DM / 32);
    const float* wqkvp = F.in(I_WQKV); const float* wop = F.in(I_WO);
    for (int it = gw; it < DEPTH * (I_QKV + I_O); it += NGW) {
      const int i = it / (I_QKV + I_O); int r = it % (I_QKV + I_O);
      if (r < I_QKV) p0_transpose_item<true, true>(wqkvp + (size_t)i * DM * QKVD, DM, QKVD, (bf16*)(F.ws + WS_WQKV + (size_t)i * QKVD * DM), scr, r, F.lane);
      else p0_transpose_item<false, true>(wop + (size_t)i * DM * DM, DM, DM, (bf16*)(F.ws + WS_WO + (size_t)i * DM * DM), scr, r - I_QKV, F.lane);
    }
  }
}

constexpr float H8_SCALE = 4.f;
__device__ __forceinline__ void phase_norm(const Ctx& F, int layer, int which  , int src_sel, bool latent_only) {
  const int gw = F.bid * NWAVES + F.wave, NGW = F.G * NWAVES;
  const float* gain = (which == 0 ? F.in(I_N1G) : F.in(I_N2G)) + layer * DM;
  const float* modl = (const float*)(F.ws + WS_MOD) + (size_t)layer * 5 * NMOD * DM;
  bf16* H = (bf16*)(F.ws + WS_H);
  const float* latp = st_lat(F, src_sel); const float* cxp = st_ctx(F, src_sel);
  for (int r = gw; r < NROWS; r += NGW) {
    if (latent_only && (r % RPB) < CTXL) continue;
    const float* xr = xrow_sel(latp, cxp, r);
    const float* mrow = modl + (size_t)mod_row(r) * NMOD * DM;
    const float* sh = mrow + (which == 0 ? 0 : 3) * DM; const float* sc = mrow + (which == 0 ? 1 : 4) * DM;
    f32x4 v[4]; float s = 0.f;
#pragma unroll
    for (int j = 0; j < 4; ++j) { v[j] = ((const f32x4*)xr)[F.lane + 64 * j]; s += (v[j].x * v[j].x + v[j].y * v[j].y) + (v[j].z * v[j].z + v[j].w * v[j].w); }
    const float rstd = rsqrtf(wave_sum(s) * (1.f / DM) + RMS_EPS);
    unsigned long long* o8 = (unsigned long long*)(H + (size_t)r * DM) + F.lane;
#pragma unroll
    for (int j = 0; j < 4; ++j) { const f32x4 g = ((const f32x4*)gain)[F.lane + 64 * j], a = ((const f32x4*)sc)[F.lane + 64 * j], b = ((const f32x4*)sh)[F.lane + 64 * j];
      const float y0 = v[j].x * rstd * g.x * (1.f + a.x) + b.x, y1 = v[j].y * rstd * g.y * (1.f + a.y) + b.y, y2 = v[j].z * rstd * g.z * (1.f + a.z) + b.z, y3 = v[j].w * rstd * g.w * (1.f + a.w) + b.w;
      if (which == 0) { int v8 = __builtin_amdgcn_cvt_pk_fp8_f32(y0 * H8_SCALE, y1 * H8_SCALE, 0, false); v8 = __builtin_amdgcn_cvt_pk_fp8_f32(y2 * H8_SCALE, y3 * H8_SCALE, v8, true);
        ((unsigned*)((unsigned char*)H + (size_t)r * DM))[F.lane + 64 * j] = (unsigned)v8; }
      else o8[64 * j] = (unsigned long long)pk2(y0, y1) | ((unsigned long long)pk2(y2, y3) << 32); }
  }
}

__device__ __forceinline__ void phase_qknorm(const Ctx& F, int layer) {
  const int gw = F.bid * NWAVES + F.wave, NGW = F.G * NWAVES;
  const int axis = F.lane >> 5, f = F.lane & 31, e1 = axis * 64 + f, e2 = e1 + 32;
  const float* qg = F.in(I_QNG) + layer * HD; const float* kg = F.in(I_KNG) + layer * HD;
  const float qg1 = qg[e1], qg2 = qg[e2], kg1 = kg[e1], kg2 = kg[e2];
  const float inv = exp2f(-(float)(2 * f) * (13.287712379549449f / 64.f));
  bf16* Q = (bf16*)(F.ws + WS_Q); bf16* K = (bf16*)(F.ws + WS_K);
  for (int r = gw; r < NROWS; r += NGW) {
    const int j = r % RPB; float cs = 1.f, sn = 0.f;
    if (j >= CTXL) { const int sp = j - CTXL; const float pos = (float)(axis == 0 ? (sp >> 6) : (sp & 63)); sincosf(pos * inv, &sn, &cs); }
#pragma unroll
    for (int h = 0; h < NH + NKV; ++h) {
      bf16* base = h < NH ? Q + (size_t)r * DM + h * HD : K + (size_t)r * (NKV * HD) + (h - NH) * HD;
      float x1 = bflo(base[e1]), x2 = bflo(base[e2]);
      const float rstd = rsqrtf(wave_sum(x1 * x1 + x2 * x2) * (1.f / HD) + RMS_EPS);
      x1 *= rstd * (h < NH ? qg1 : kg1); x2 *= rstd * (h < NH ? qg2 : kg2);
      const float y1 = x1 * cs - x2 * sn, y2 = x1 * sn + x2 * cs;
      base[e1] = (bf16)f2bf(y1); base[e2] = (bf16)f2bf(y2);
    }
  }
}
struct Order {
  int nM, nN, nwg, G, c, lat;
  __device__ void init(int nM_, int nN_, int G_, int c_, int lat_) { nM = nM_; nN = nN_; nwg = nM * nN; G = G_; c = c_; lat = lat_; }
  __device__ bool next(int i, pg8::Unit& u) const {
    const long L = (long)i * G + c; if (L >= nwg) return false;
    int wgid = (int)L; { const int q = nwg / 8, r = nwg % 8, xcd = wgid % 8, off = wgid / 8; wgid = (xcd < r ? xcd * (q + 1) : r * (q + 1) + (xcd - r) * q) + off; }
    const int WGM = 8, nig = WGM * nN, gid = wgid / nig, fm = gid * WGM, gsz = (nM - fm) < WGM ? (nM - fm) : WGM;
    int pm = fm + ((wgid % nig) % gsz); u.pn = (wgid % nig) / gsz;
    if (lat) pm = (pm >> 4) * 17 + 1 + (pm & 15);
    u.pm = pm; return true;
  }
  __device__ __forceinline__ void a_ready(const pg8::Unit&) const {}
  __device__ __forceinline__ void done(const pg8::Unit&) const {}
};
struct EpiQKV {
  static constexpr bool PERM = true, AFTER_DRAIN = false;
  unsigned char* ws; LAS float* xs  ; int layer;
  __device__ __forceinline__ void operator()(const pg8::f32x4 (&acc)[2][2][4][2], const pg8::Unit& u, int wr, int wc, int fr, int fq) const {
    const int row0 = u.pm * 256 + wr * 64 + fr;
    const size_t boff = u.pn < 4 ? WS_Q : (u.pn == 4 ? WS_K : WS_V); const int ldc = u.pn < 4 ? DM : NKV * HD, colt = u.pn < 4 ? u.pn * 256 : 0;
    bf16* base = (bf16*)(ws + boff);
    const int col0 = colt + wc * 32 + 8 * fq;
    if (u.pn == 5) {
#pragma unroll
      for (int ai = 0; ai < 2; ++ai)
#pragma unroll
        for (int m = 0; m < 4; ++m) { bf16* rowp = base + (size_t)(row0 + ai * 128 + m * 16) * ldc + col0;
#pragma unroll
          for (int bj = 0; bj < 2; ++bj) { const pg8::f32x4 v0 = acc[ai][bj][m][0], v1 = acc[ai][bj][m][1];
            u32x4 w; w.x = pk2(v0[0], v0[1]); w.y = pk2(v0[2], v0[3]); w.z = pk2(v1[0], v1[1]); w.w = pk2(v1[2], v1[3]);
            *(u32x4*)(rowp + bj * 128) = w; } }
      return;
    }
#pragma unroll
    for (int ai = 0; ai < 2; ++ai)
#pragma unroll
      for (int m = 0; m < 4; ++m)
#pragma unroll
        for (int bj = 0; bj < 2; ++bj) { const pg8::f32x4 v0 = acc[ai][bj][m][0], v1 = acc[ai][bj][m][1];
          float ss = (v0[0] * v0[0] + v0[1] * v0[1]) + (v0[2] * v0[2] + v0[3] * v0[3]) + (v1[0] * v1[0] + v1[1] * v1[1]) + (v1[2] * v1[2] + v1[3] * v1[3]);
          ss += __shfl_xor(ss, 16); ss += __shfl_xor(ss, 32);
          if (fq == 0) xs[((((wr * 2 + ai) * 4 + m) * 16 + fr) * 2 + bj) * 4 + wc] = ss; }
    asm volatile("s_waitcnt lgkmcnt(0)" ::: "memory"); __builtin_amdgcn_s_barrier(); asm volatile("" ::: "memory");
    const float* rp = (const float*)(ws + WS_ROPE);
    const float* gp = rp + 64 * 32 * 2 + (layer * 2 + (u.pn < 4 ? 0 : 1)) * HD + wc * 32 + 8 * fq;
    const f32x4 g0 = *(const f32x4*)gp, g1 = *(const f32x4*)(gp + 4);
    const bool latent = (u.pm % 17) != 0;
    const int axis = wc >> 1, f0 = 16 * (wc & 1) + 4 * fq;
#pragma unroll
    for (int ai = 0; ai < 2; ++ai)
#pragma unroll
      for (int m = 0; m < 4; ++m) { const int r = row0 + ai * 128 + m * 16;
        f32x4 c01 = {1.f, 0.f, 1.f, 0.f}, c23 = {1.f, 0.f, 1.f, 0.f};
        if (latent) { const int sp = (r % RPB) - CTXL, pos = axis == 0 ? (sp >> 6) : (sp & 63); const float* cp = rp + (pos * 32 + f0) * 2; c01 = *(const f32x4*)cp; c23 = *(const f32x4*)(cp + 4); }
        bf16* rowp = base + (size_t)r * ldc + col0;
#pragma unroll
        for (int bj = 0; bj < 2; ++bj) { const LAS float* xp = xs + ((((wr * 2 + ai) * 4 + m) * 16 + fr) * 2 + bj) * 4;
          const float rstd = rsqrtf(((xp[0] + xp[1]) + (xp[2] + xp[3])) * (1.f / HD) + RMS_EPS);
          const pg8::f32x4 v0 = acc[ai][bj][m][0], v1 = acc[ai][bj][m][1];
          const float a0 = v0[0] * rstd * g0.x, b0 = v0[1] * rstd * g0.y, a1 = v0[2] * rstd * g0.z, b1 = v0[3] * rstd * g0.w;
          const float a2 = v1[0] * rstd * g1.x, b2 = v1[1] * rstd * g1.y, a3 = v1[2] * rstd * g1.z, b3 = v1[3] * rstd * g1.w;
          u32x4 w; w.x = pk2(a0 * c01.x - b0 * c01.y, a0 * c01.y + b0 * c01.x); w.y = pk2(a1 * c01.z - b1 * c01.w, a1 * c01.w + b1 * c01.z);
          w.z = pk2(a2 * c23.x - b2 * c23.y, a2 * c23.y + b2 * c23.x); w.w = pk2(a3 * c23.z - b3 * c23.w, a3 * c23.w + b3 * c23.z);
          *(u32x4*)(rowp + bj * 128) = w; } }
    asm volatile("s_waitcnt lgkmcnt(0)" ::: "memory"); __builtin_amdgcn_s_barrier(); asm volatile("" ::: "memory");
  }
};
struct EpiRes {
  static constexpr bool PERM = false, AFTER_DRAIN = false;
  const float *xin, *cin; float *xout, *xc; const float* gmod  ;
  __device__ __forceinline__ void operator()(const pg8::f32x4 (&acc)[2][2][4][2], const pg8::Unit& u, int wr, int wc, int fr, int fq) const {
    const int col0 = u.pn * 256 + wc * 32 + 4 * fq;
#pragma unroll
    for (int ai = 0; ai < 2; ++ai)
#pragma unroll
      for (int m = 0; m < 4; ++m) { const int r = u.pm * 256 + ai * 128 + wr * 64 + m * 16 + fr;
        const int b_ = r / RPB, j_ = r % RPB; const size_t oc = (size_t)(b_ * CTXL + j_) * DM, ol = (size_t)(b_ * SEQ + (j_ - CTXL)) * DM;
        float* xn = j_ < CTXL ? xc + oc : xout + ol; const float* xo = j_ < CTXL ? cin + oc : xin + ol; const float* g = gmod + (size_t)(j_ < CTXL ? 4 : b_) * NMOD * DM;
#pragma unroll
        for (int bj = 0; bj < 2; ++bj)
#pragma unroll
          for (int n = 0; n < 2; ++n) { const int c = col0 + bj * 128 + n * 16; const f32x4 xv = *(const f32x4*)(xo + c), gv = *(const f32x4*)(g + c); const pg8::f32x4 a = acc[ai][bj][m][n];
            f32x4 o; o.x = xv.x + gv.x * a[0]; o.y = xv.y + gv.y * a[1]; o.z = xv.z + gv.z * a[2]; o.w = xv.w + gv.w * a[3]; *(f32x4*)(xn + c) = o; } }
  }
};
struct EpiF32 {
  static constexpr bool PERM = true, AFTER_DRAIN = false;
  _Float16* S; int ldc;
  __device__ __forceinline__ void operator()(const pg8::f32x4 (&acc)[2][2][4][2], const pg8::Unit& u, int wr, int wc, int fr, int fq) const {
    typedef _Float16 h8 __attribute__((ext_vector_type(8)));
    const int col0 = u.pn * 256 + wc * 32 + 8 * fq;
#pragma unroll
    for (int ai = 0; ai < 2; ++ai)
#pragma unroll
      for (int m = 0; m < 4; ++m) { _Float16* rowp = S + (size_t)(u.pm * 256 + ai * 128 + wr * 64 + m * 16 + fr) * ldc + col0;
#pragma unroll
        for (int bj = 0; bj < 2; ++bj) { const pg8::f32x4 v0 = acc[ai][bj][m][0], v1 = acc[ai][bj][m][1];
          h8 o; o[0] = (_Float16)v0[0]; o[1] = (_Float16)v0[1]; o[2] = (_Float16)v0[2]; o[3] = (_Float16)v0[3]; o[4] = (_Float16)v1[0]; o[5] = (_Float16)v1[1]; o[6] = (_Float16)v1[2]; o[7] = (_Float16)v1[3];
          *(h8*)(rowp + bj * 128) = o; } }
  }
};

__device__ __forceinline__ void phase_attn(const Ctx& F, int layer) {
  const bf16* Q = (const bf16*)(F.ws + WS_Q); const bf16* K = (const bf16*)(F.ws + WS_K); const bf16* V = (const bf16*)(F.ws + WS_V);
  char* lds = (char*)F.ldsg;
  const int pair = F.bid & 7, slot = F.bid >> 3, nslot = F.G >> 3;
  const int b = pair >> 1, g = pair & 1;
  const bf16* Kh = K + (size_t)(b * RPB) * (NKV * HD) + g * HD; const bf16* Vh = V + (size_t)(b * RPB) * (NKV * HD) + g * HD;
  const float* sinkp = F.in(I_SINKS);
  const int nunits = layer == 0 ? 68 : 64;
#pragma unroll 1
  for (int u = slot; u < nunits; u += nslot) {
    int h, NT, ks = 0, q0 = 0; float sk = 0.f, sk1 = 0.f; const bf16* Qb; const bool win = layer != 0;
    if (u < 64) {
      if (!win) { h = g * 4 + (u >> 4); const int qb = u & 15; Qb = Q + (size_t)(b * RPB + CTXL + qb * 256) * DM + h * HD; NT = RPB / 64; }
      else { h = g * 4 + (u >> 5) * 2; q0 = (u & 31) * 128; Qb = Q + (size_t)(b * RPB + CTXL + q0) * DM + h * HD;
        ks = q0 - 128 < 0 ? 0 : q0 - 128; const int ke = q0 + 256 > SEQ ? SEQ : q0 + 256; NT = 4 + (ke - ks) / 64;
        sk = sinkp[(layer / 2) * NH + h] * 1.4426950408889634f; sk1 = sinkp[(layer / 2) * NH + h + 1] * 1.4426950408889634f; } }
    else { h = g * 4 + (u - 64); Qb = Q + (size_t)(b * RPB) * DM + h * HD; NT = CTXL / 64; }
    att::attn_unit(win, Qb, F.ws + WS_O + (Qb - Q), Kh, Vh, NT, ks, q0, sk, sk1, lds);
  }
}

__device__ __forceinline__ void ins16(float (&v)[16], float x) {
#pragma unroll
  for (int i = 0; i < 16; ++i) { const float hi = fmaxf(v[i], x); x = fminf(v[i], x); v[i] = hi; }
}
#define CE_DESC(x, y) do { const float hi_ = fmaxf(x, y), lo_ = fminf(x, y); x = hi_; y = lo_; } while (0)
__device__ __forceinline__ void bitonic_merge16(float (&v)[16]) {
#pragma unroll
  for (int j = 8; j >= 1; j >>= 1)
#pragma unroll
    for (int i = 0; i < 16; ++i) if ((i & j) == 0) CE_DESC(v[i], v[i | j]);
}
__device__ __forceinline__ void bitonic_sort16(float (&v)[16]) {
#pragma unroll
  for (int k = 2; k <= 16; k <<= 1)
#pragma unroll
    for (int j = k >> 1; j >= 1; j >>= 1)
#pragma unroll
      for (int i = 0; i < 16; ++i) { const int l = i ^ j; if (l > i) { if ((i & k) == 0 || k == 16) CE_DESC(v[i], v[l]); else CE_DESC(v[l], v[i]); } }
}
__device__ __forceinline__ void top16_merge(float (&a)[16], const float (&b)[16]) {
#pragma unroll
  for (int i = 0; i < 16; ++i) a[i] = fmaxf(a[i], b[15 - i]);
  bitonic_merge16(a);
}
__device__ __forceinline__ void topk_step1(const LAS float* sc, LAS unsigned* T, int tid) {
  float v[16];
  { const LAS float* my = sc + tid * 65; const unsigned eb = (tid & 1) * 64;
    float g1[16];
#define LOAD16(dst, off) do { _Pragma("unroll") for (int e = 0; e < 16; ++e) dst[e] = __uint_as_float((__float_as_uint(my[(off) + e]) & ~127u) | (eb + (off) + e)); } while (0)
    LOAD16(v, 0); bitonic_sort16(v); LOAD16(g1, 16); bitonic_sort16(g1); top16_merge(v, g1);
    float h1[16];
    LOAD16(h1, 32); bitonic_sort16(h1); LOAD16(g1, 48); bitonic_sort16(g1); top16_merge(h1, g1);
    top16_merge(v, h1);
#undef LOAD16
  }
  { float o[16];
#pragma unroll
    for (int i = 0; i < 16; ++i) o[i] = __shfl_xor(v[i], 1);
    top16_merge(v, o); }
  if ((tid & 1) == 0) {
#pragma unroll
    for (int i = 0; i < 16; ++i) T[(tid >> 1) * 16 + i] = __float_as_uint(v[i]); }
}
__device__ __forceinline__ void topk_step2(const LAS unsigned* T, int p1, int* eout, float* gout) {
  const int p2 = p1 + 16;
  float a[16], bq[16];
#pragma unroll
  for (int i = 0; i < 16; ++i) { a[i] = __uint_as_float(T[p1 + i] & ~127u); bq[i] = __uint_as_float(T[p2 + i] & ~127u); }
  float w[16];
#pragma unroll
  for (int i = 0; i < 16; ++i) w[i] = __uint_as_float((__float_as_uint(a[0] + bq[i]) & ~255u) | (unsigned)i);
  { float r1[16];
#pragma unroll
    for (int i = 0; i < 16; ++i) r1[i] = i < 8 ? __uint_as_float((__float_as_uint(a[1] + bq[i]) & ~255u) | (unsigned)(16 + i)) : -INFINITY;
    top16_merge(w, r1); }
#pragma unroll
  for (int ia = 2; ia < 16; ++ia)
#pragma unroll
    for (int ib = 0; ib < 16; ++ib) if ((ia + 1) * (ib + 1) <= 16) { const float s_ = a[ia] + bq[ib]; ins16(w, __uint_as_float((__float_as_uint(s_) & ~255u) | (unsigned)(ia * 16 + ib))); }
  float ts[16]; int ex[16];
#pragma unroll
  for (int k = 0; k < 16; ++k) { const unsigned id = __float_as_uint(w[k]) & 255u; const unsigned k1 = T[p1 + (id >> 4)], k2 = T[p2 + (id & 15)];
    ts[k] = __uint_as_float(k1 & ~127u) + __uint_as_float(k2 & ~127u); ex[k] = (int)((k1 & 127u) * NKEYS + (k2 & 127u)); }
  float m = ts[0];
#pragma unroll
  for (int k = 1; k < 16; ++k) m = fmaxf(m, ts[k]);
  float l = 0.f;
#pragma unroll
  for (int k = 0; k < 16; ++k) { ts[k] = __expf(ts[k] - m); l += ts[k]; }
  const float il = 1.f / l;
#pragma unroll
  for (int k = 0; k < 16; k += 4) { *(int4*)(eout + k) = make_int4(ex[k], ex[k + 1], ex[k + 2], ex[k + 3]);
    f32x4 gv; gv.x = ts[k] * il; gv.y = ts[k + 1] * il; gv.z = ts[k + 2] * il; gv.w = ts[k + 3] * il; *(f32x4*)(gout + k) = gv; }
}
struct EpiTopk {
  static constexpr bool PERM = false, AFTER_DRAIN = true;
  int* EIDX; float* GATE;
  __device__ __forceinline__ void fused(pg8::f32x4 (&acc)[2][2][4][2], const pg8::Unit& u, int wr, int wc, int fr, int fq, PG8_LAS unsigned char* lds, int wid, int lane) const {
    LAS float* sc = (LAS float*)lds; LAS unsigned* T = (LAS unsigned*)(lds + 512 * 65 * 4);
    const int tid = wid * 64 + lane;
#pragma unroll
    for (int ai = 0; ai < 2; ++ai) {
#pragma unroll
      for (int m = 0; m < 4; ++m) { const int rl = wr * 64 + m * 16 + fr;
#pragma unroll
        for (int bj = 0; bj < 2; ++bj)
#pragma unroll
          for (int n = 0; n < 2; ++n) { const int c = bj * 128 + wc * 32 + n * 16 + fq * 4; LAS float* d = sc + (rl * 4 + (c >> 6)) * 65 + (c & 63); const pg8::f32x4 a = acc[ai][bj][m][n];
            d[0] = a[0]; d[1] = a[1]; d[2] = a[2]; d[3] = a[3]; } }
      asm volatile("s_waitcnt lgkmcnt(0)" ::: "memory"); __builtin_amdgcn_s_barrier(); asm volatile("" ::: "memory");
      topk_step1(sc, T, tid);
      asm volatile("s_waitcnt lgkmcnt(0)" ::: "memory"); __builtin_amdgcn_s_barrier(); asm volatile("" ::: "memory");
      if (tid < 128) { const size_t ob = (size_t)(u.pm * 256 + ai * 128 + tid) * 128 + u.pn * 16; topk_step2(T, tid * 32, EIDX + ob, GATE + ob); }
      asm volatile("s_waitcnt lgkmcnt(0)" ::: "memory"); __builtin_amdgcn_s_barrier(); asm volatile("" ::: "memory");
    }
  }
};
struct OneUnit {
  pg8::Unit u0;
  __device__ bool next(int i, pg8::Unit& u) const { if (i != 0) return false; u = u0; return true; }
  __device__ __forceinline__ void a_ready(const pg8::Unit&) const {}
  __device__ __forceinline__ void done(const pg8::Unit&) const {}
};
__device__ __forceinline__ void phase_topk(const Ctx& F, bool latent_only) {
  LAS float* sc = (LAS float*)F.lds;
  LAS unsigned* T = (LAS unsigned*)(F.lds + 512 * 65 * 4);
  const _Float16* S = (const _Float16*)(F.ws + WS_S); int* EIDX = (int*)(F.ws + WS_EIDX); float* GATE = (float*)(F.ws + WS_GATE);
  const int ngroups = NROWS / 16;
  auto grpok = [&](int gq) { return gq < ngroups && !(latent_only && ((gq * 16) % RPB) < CTXL); };
  int grp = F.bid; while (grp < ngroups && !grpok(grp)) grp += F.G;
  typedef _Float16 h4 __attribute__((ext_vector_type(4)));
  h4 v[16];
  if (grp < ngroups) {
#pragma unroll
    for (int it = 0; it < 16; ++it) v[it] = *(const h4*)(S + (size_t)(grp * 16 + it) * PQN + F.tid * 4); }
  for (; grp < ngroups; ) {
    const int r0 = grp * 16;
    int gn = grp + F.G; while (gn < ngroups && !grpok(gn)) gn += F.G;
#pragma unroll
    for (int it = 0; it < 16; ++it) { const int c = F.tid * 4; LAS float* d = sc + (it * 32 + (c >> 6)) * 65 + (c & 63); d[0] = (float)v[it][0]; d[1] = (float)v[it][1]; d[2] = (float)v[it][2]; d[3] = (float)v[it][3]; }
    if (gn < ngroups) {
#pragma unroll
      for (int it = 0; it < 16; ++it) v[it] = *(const h4*)(S + (size_t)(gn * 16 + it) * PQN + F.tid * 4); }
    __syncthreads();
    float v[16];
    { const LAS float* my = sc + F.tid * 65; const unsigned eb = (F.tid & 1) * 64;
      float g1[16];
#define LOAD16(dst, off) do { _Pragma("unroll") for (int e = 0; e < 16; ++e) dst[e] = __uint_as_float((__float_as_uint(my[(off) + e]) & ~127u) | (eb + (off) + e)); } while (0)
      LOAD16(v, 0); bitonic_sort16(v); LOAD16(g1, 16); bitonic_sort16(g1); top16_merge(v, g1);
      float h1[16];
      LOAD16(h1, 32); bitonic_sort16(h1); LOAD16(g1, 48); bitonic_sort16(g1); top16_merge(h1, g1);
      top16_merge(v, h1);
#undef LOAD16
    }
    { float o[16];
#pragma unroll
      for (int i = 0; i < 16; ++i) o[i] = __shfl_xor(v[i], 1);
      top16_merge(v, o); }
    if ((F.tid & 1) == 0) {
#pragma unroll
      for (int i = 0; i < 16; ++i) T[(F.tid >> 1) * 16 + i] = __float_as_uint(v[i]); }
    __syncthreads();
    if (F.tid < 128) {
      const int rl = F.tid >> 3, head = F.tid & 7, p1 = (rl * 16 + head * 2) * 16, p2 = p1 + 16;
      float a[16], bq[16];
#pragma unroll
      for (int i = 0; i < 16; ++i) { a[i] = __uint_as_float(T[p1 + i] & ~127u); bq[i] = __uint_as_float(T[p2 + i] & ~127u); }
      float w[16];
#pragma unroll
      for (int i = 0; i < 16; ++i) w[i] = __uint_as_float((__float_as_uint(a[0] + bq[i]) & ~255u) | (unsigned)i);
      { float r1[16];
#pragma unroll
        for (int i = 0; i < 16; ++i) r1[i] = i < 8 ? __uint_as_float((__float_as_uint(a[1] + bq[i]) & ~255u) | (unsigned)(16 + i)) : -INFINITY;
        top16_merge(w, r1); }
#pragma unroll
      for (int ia = 2; ia < 16; ++ia)
#pragma unroll
        for (int ib = 0; ib < 16; ++ib) if ((ia + 1) * (ib + 1) <= 16) { const float s = a[ia] + bq[ib]; ins16(w, __uint_as_float((__float_as_uint(s) & ~255u) | (unsigned)(ia * 16 + ib))); }
      float ts[16]; int ex[16];
#pragma unroll
      for (int k = 0; k < 16; ++k) { const unsigned id = __float_as_uint(w[k]) & 255u; const unsigned k1 = T[p1 + (id >> 4)], k2 = T[p2 + (id & 15)];
        ts[k] = __uint_as_float(k1 & ~127u) + __uint_as_float(k2 & ~127u); ex[k] = (int)((k1 & 127u) * NKEYS + (k2 & 127u)); }
      float m = ts[0];
#pragma unroll
      for (int k = 1; k < 16; ++k) m = fmaxf(m, ts[k]);
      float l = 0.f;
#pragma unroll
      for (int k = 0; k < 16; ++k) { ts[k] = __expf(ts[k] - m); l += ts[k]; }
      const float il = 1.f / l; const size_t ob = (size_t)(r0 + rl) * 128 + head * 16;
#pragma unroll
      for (int k = 0; k < 16; k += 4) { *(int4*)(EIDX + ob + k) = make_int4(ex[k], ex[k + 1], ex[k + 2], ex[k + 3]);
        f32x4 gv; gv.x = ts[k] * il; gv.y = ts[k + 1] * il; gv.z = ts[k + 2] * il; gv.w = ts[k + 3] * il; *(f32x4*)(GATE + ob + k) = gv; }
    }
    __syncthreads();
    grp = gn;
  }
}

typedef float f32x2 __attribute__((ext_vector_type(2)));
__device__ __forceinline__ float dpp_ror_add(float x, int) { return x; }
#define ROW_ROR_ADD(x, n) do { const int xi_ = __builtin_bit_cast(int, x); x += __builtin_bit_cast(float, __builtin_amdgcn_update_dpp(0, xi_, 0x120 + (n), 0xf, 0xf, false)); } while (0)
__device__ __forceinline__ float dot16_fp8(u32x4 q, const float* h, float acc) {
  const int q0 = (int)q.x, q1 = (int)q.y, q2 = (int)q.z, q3 = (int)q.w; f32x2 t;
  t = __builtin_amdgcn_cvt_pk_f32_fp8(q0, false); acc = fmaf(t.x, h[0], acc); acc = fmaf(t.y, h[1], acc); t = __builtin_amdgcn_cvt_pk_f32_fp8(q0, true); acc = fmaf(t.x, h[2], acc); acc = fmaf(t.y, h[3], acc);
  t = __builtin_amdgcn_cvt_pk_f32_fp8(q1, false); acc = fmaf(t.x, h[4], acc); acc = fmaf(t.y, h[5], acc); t = __builtin_amdgcn_cvt_pk_f32_fp8(q1, true); acc = fmaf(t.x, h[6], acc); acc = fmaf(t.y, h[7], acc);
  t = __builtin_amdgcn_cvt_pk_f32_fp8(q2, false); acc = fmaf(t.x, h[8], acc); acc = fmaf(t.y, h[9], acc); t = __builtin_amdgcn_cvt_pk_f32_fp8(q2, true); acc = fmaf(t.x, h[10], acc); acc = fmaf(t.y, h[11], acc);
  t = __builtin_amdgcn_cvt_pk_f32_fp8(q3, false); acc = fmaf(t.x, h[12], acc); acc = fmaf(t.y, h[13], acc); t = __builtin_amdgcn_cvt_pk_f32_fp8(q3, true); acc = fmaf(t.x, h[14], acc); acc = fmaf(t.y, h[15], acc);
  return acc;
}
constexpr int PCH = 8;
__device__ __forceinline__ int chunk_row0(unsigned c, bool latent_only) { return latent_only ? (int)(c / (SEQ / PCH)) * RPB + CTXL + (int)(c % (SEQ / PCH)) * PCH : (int)c * PCH; }
#ifndef UREP
#define UREP 1
#endif
#ifndef VREP
#define VREP 1
#endif
__device__ __forceinline__ unsigned xcc_id() { return (unsigned)__builtin_amdgcn_s_getreg((3 << 11) | 20) & 7u; }
__device__ __forceinline__ unsigned q_pull(unsigned* q, int lane) { unsigned c = 0; if (lane == 0) c = __hip_atomic_fetch_add(q, 1u, __ATOMIC_RELAXED, __HIP_MEMORY_SCOPE_AGENT); return (unsigned)__builtin_amdgcn_readfirstlane((int)c); }
__device__ __forceinline__ void phase_peer_u(const Ctx& F, int layer, bool latent_only, int rep) {
  unsigned* qb = (unsigned*)(F.ws + WS_CTL) + 8192 + ((layer * 2 + 0) * 2 + rep) * 8 * 64;
  const int* EIDX = (const int*)(F.ws + WS_EIDX);
  LAS unsigned* lst = (LAS unsigned*)(F.lds + F.wave * 4096);
  LAS float* pl = (LAS float*)(F.lds + F.wave * 4096 + 1024);
  const int g = F.lane >> 3;
  const int i0 = ((F.lane >> 2) & 1) * 8 + ((F.lane >> 1) & 1) * 4 + (F.lane & 1) * 2;
  const int myx = (int)xcc_id();
#pragma unroll 1
  for (int sx = 0; sx < 8; ++sx) {
    const int slice = (myx + sx) & 7;
    const bf16* H = (const bf16*)(F.ws + WS_H) + slice * 128 + (F.lane & 7) * 16;
    const unsigned char* U = F.ws + WS_UT + ((size_t)layer * 8 + slice) * NKEYS * NKEYS * 128; const unsigned uo = (unsigned)(F.lane & 7) * 16u;
    float* PART = (float*)(F.ws + WS_PART) + slice * 128;
    const unsigned nch = (unsigned)((latent_only ? NB * SEQ : NROWS) / PCH);
        unsigned e0, e1; u32x4 h0, h1;
#define UPREF(R) do { e0 = (unsigned)EIDX[(size_t)(R) * 128 + F.lane]; e1 = (unsigned)EIDX[(size_t)(R) * 128 + 64 + F.lane]; h0 = *(const u32x4*)(H + (size_t)(R) * DM); h1 = *(const u32x4*)(H + (size_t)(R) * DM + 8); } while (0)
#define UGATHER(QV, HH, LOFF, RNEXT, HASNEXT) do { lst[(LOFF) + F.lane] = e0; lst[(LOFF) + 64 + F.lane] = e1; \
          HH[0] = bflo(h0.x); HH[1] = bfhi(h0.x); HH[2] = bflo(h0.y); HH[3] = bfhi(h0.y); HH[4] = bflo(h0.z); HH[5] = bfhi(h0.z); HH[6] = bflo(h0.w); HH[7] = bfhi(h0.w); \
          HH[8] = bflo(h1.x); HH[9] = bfhi(h1.x); HH[10] = bflo(h1.y); HH[11] = bfhi(h1.y); HH[12] = bflo(h1.z); HH[13] = bfhi(h1.z); HH[14] = bflo(h1.w); HH[15] = bfhi(h1.w); \
          if (HASNEXT) UPREF(RNEXT); \
          asm volatile("s_waitcnt lgkmcnt(0)" ::: "memory"); \
          _Pragma("unroll") for (int i = 0; i < 16; ++i) QV[i] = *(const u32x4*)(U + (lst[(LOFF) + 8 * i + g] * 128u + uo)); } while (0)
#define UMATH(QV, HH, R) do { float p[16]; \
          _Pragma("unroll") for (int i = 0; i < 16; ++i) p[i] = dot16_fp8(QV[i], HH, 0.f); \
          _Pragma("unroll") for (int m = 4; m >= 1; m >>= 1) { const bool up = (F.lane & m) != 0; const int n = 2 * m; \
            _Pragma("unroll") for (int j = 0; j < n; ++j) { const float send = up ? p[j] : p[j + n], keep = up ? p[j + n] : p[j]; p[j] = keep + __shfl_xor(send, m); } } \
          pl[8 * i0 + g] = p[0]; pl[8 * i0 + 8 + g] = p[1]; \
          asm volatile("s_waitcnt lgkmcnt(0)" ::: "memory"); \
          float* po = PART + (size_t)(R) * 1024 + F.lane; po[0] = pl[F.lane]; po[64] = pl[64 + F.lane]; } while (0)
    unsigned c = q_pull(qb + slice * 64, F.lane);
    if (c < nch) {
      u32x4 qa[16], qb_[16]; float ha[16], hb[16];
      int rbeg = chunk_row0(c, latent_only);
      UPREF(rbeg);
      UGATHER(qa, ha, 0, rbeg + 1, true);
#pragma unroll 1
      while (true) {
        const unsigned cn = q_pull(qb + slice * 64, F.lane);
        const bool hn = cn < nch; const int nr0 = hn ? chunk_row0(cn, latent_only) : 0;
#pragma unroll 1
        for (int it = 0; it < PCH; it += 2) { const int r = rbeg + it; const bool lastp = it + 2 >= PCH;
          UGATHER(qb_, hb, 128, (lastp ? nr0 : r + 2), (!lastp || hn));
          UMATH(qa, ha, r);
          if (!lastp || hn) UGATHER(qa, ha, 0, (lastp ? nr0 + 1 : r + 3), true);
          UMATH(qb_, hb, r + 1);
        }
        if (!hn) break;
        rbeg = nr0;
      }
    }
#undef UPREF
#undef UGATHER
#undef UMATH
  }
}

__device__ __forceinline__ void phase_peer_w(const Ctx& F, bool latent_only) {
  const int gw = F.bid * NWAVES + F.wave, NGW = F.G * NWAVES;
  const float* PART = (const float*)(F.ws + WS_PART); const float* GATE = (const float*)(F.ws + WS_GATE); float* PW = (float*)(F.ws + WS_PW);
  for (int r = gw; r < NROWS; r += NGW) {
    if (latent_only && (r % RPB) < CTXL) continue;
    float a = 0.f, b = 0.f;
#pragma unroll
    for (int x = 0; x < 8; ++x) { a += PART[(size_t)r * 1024 + x * 128 + F.lane]; b += PART[(size_t)r * 1024 + x * 128 + 64 + F.lane]; }
    const size_t o = (size_t)r * 128 + F.lane;
    PW[o] = GATE[o] * gelu_tanh(a * (1.f / U8_SCALE)); PW[o + 64] = GATE[o + 64] * gelu_tanh(b * (1.f / U8_SCALE));
  }
}

__device__ __forceinline__ void phase_peer_v(const Ctx& F, int layer, bool latent_only, int rep) {
  unsigned* qb = (unsigned*)(F.ws + WS_CTL) + 8192 + ((layer * 2 + 1) * 2 + rep) * 8 * 64;
  const int* EIDX = (const int*)(F.ws + WS_EIDX); const float* PW = (const float*)(F.ws + WS_PW);
  const float* g2 = (const float*)(F.ws + WS_MOD) + (size_t)layer * 5 * NMOD * DM + 5 * DM;
  const float* outl = F.outp();
  LAS u32x2* ew = (LAS u32x2*)(F.lds + F.wave * 4096);
  const int g = F.lane >> 3;
  const int myx = (int)xcc_id();
#pragma unroll 1
  for (int sx = 0; sx < 8; ++sx) {
    const int slice = (myx + sx) & 7;
    const unsigned char* V = F.ws + WS_VT + ((size_t)layer * 8 + slice) * NKEYS * NKEYS * 128; const unsigned vo = (unsigned)(F.lane & 7) * 16u;
    const int dl = slice * 128 + (F.lane & 7) * 16 + ((F.lane >> 5) & 1) * 8 + ((F.lane >> 4) & 1) * 4 + ((F.lane >> 3) & 1) * 2;
    const unsigned nch = (unsigned)((latent_only ? NB * SEQ : NROWS) / PCH);
        unsigned ea, eb; float wpa, wpb;
#define VPREF(R) do { const size_t o_ = (size_t)(R) * 128 + F.lane; ea = (unsigned)EIDX[o_]; eb = (unsigned)EIDX[o_ + 64]; wpa = PW[o_]; wpb = PW[o_ + 64]; } while (0)
#define VGATHER(QV, WV, LOFF, RNEXT, HASNEXT) do { \
          { u32x2 t0, t1; t0.x = ea; t0.y = __float_as_uint(wpa); t1.x = eb; t1.y = __float_as_uint(wpb); \
            ew[(LOFF) + F.lane] = t0; ew[(LOFF) + 64 + F.lane] = t1; } \
          if (HASNEXT) VPREF(RNEXT); \
          asm volatile("s_waitcnt lgkmcnt(0)" ::: "memory"); \
          _Pragma("unroll") for (int i = 0; i < 16; ++i) { const u32x2 t = ew[(LOFF) + 8 * i + g]; WV[i] = __uint_as_float(t.y); QV[i] = *(const u32x4*)(V + (t.x * 128u + vo)); } } while (0)
#define VMATH(QV, WV, R) do { float acc[16]; \
          float* x = (float*)xrow_sel(outl, (const float*)(F.ws + WS_XC), (R)); const float* xs = xrow_sel((const float*)(F.ws + WS_XB), (const float*)(F.ws + WS_XCB), (R)); const float* gg = g2 + (size_t)mod_row(R) * NMOD * DM; \
          const f32x2 xv = *(const f32x2*)(xs + dl), gv = *(const f32x2*)(gg + dl); \
          _Pragma("unroll") for (int q = 0; q < 16; ++q) acc[q] = 0.f; \
          _Pragma("unroll") for (int i = 0; i < 16; ++i) { const float w = WV[i]; const int q0 = (int)QV[i].x, q1 = (int)QV[i].y, q2 = (int)QV[i].z, q3 = (int)QV[i].w; f32x2 f; \
            f = __builtin_amdgcn_cvt_pk_f32_fp8(q0, false); acc[0] = fmaf(w, f.x, acc[0]); acc[1] = fmaf(w, f.y, acc[1]); f = __builtin_amdgcn_cvt_pk_f32_fp8(q0, true); acc[2] = fmaf(w, f.x, acc[2]); acc[3] = fmaf(w, f.y, acc[3]); \
            f = __builtin_amdgcn_cvt_pk_f32_fp8(q1, false); acc[4] = fmaf(w, f.x, acc[4]); acc[5] = fmaf(w, f.y, acc[5]); f = __builtin_amdgcn_cvt_pk_f32_fp8(q1, true); acc[6] = fmaf(w, f.x, acc[6]); acc[7] = fmaf(w, f.y, acc[7]); \
            f = __builtin_amdgcn_cvt_pk_f32_fp8(q2, false); acc[8] = fmaf(w, f.x, acc[8]); acc[9] = fmaf(w, f.y, acc[9]); f = __builtin_amdgcn_cvt_pk_f32_fp8(q2, true); acc[10] = fmaf(w, f.x, acc[10]); acc[11] = fmaf(w, f.y, acc[11]); \
            f = __builtin_amdgcn_cvt_pk_f32_fp8(q3, false); acc[12] = fmaf(w, f.x, acc[12]); acc[13] = fmaf(w, f.y, acc[13]); f = __builtin_amdgcn_cvt_pk_f32_fp8(q3, true); acc[14] = fmaf(w, f.x, acc[14]); acc[15] = fmaf(w, f.y, acc[15]); } \
          _Pragma("unroll") for (int j = 0; j < 8; ++j) { auto s2 = __builtin_amdgcn_permlane32_swap(__float_as_uint(acc[j]), __float_as_uint(acc[j + 8]), false, false); acc[j] = __uint_as_float(s2[0]) + __uint_as_float(s2[1]); } \
          _Pragma("unroll") for (int j = 0; j < 4; ++j) { auto s2 = __builtin_amdgcn_permlane16_swap(__float_as_uint(acc[j]), __float_as_uint(acc[j + 4]), false, false); acc[j] = __uint_as_float(s2[0]) + __uint_as_float(s2[1]); } \
          { const bool up = (F.lane & 8) != 0; \
            _Pragma("unroll") for (int j = 0; j < 2; ++j) { const float send = up ? acc[j] : acc[j + 2], keep = up ? acc[j + 2] : acc[j]; acc[j] = keep + __shfl_xor(send, 8); } } \
          f32x2 o; o.x = xv.x + gv.x * acc[0] * (1.f / V8_SCALE); o.y = xv.y + gv.y * acc[1] * (1.f / V8_SCALE); \
          *(f32x2*)(x + dl) = o; } while (0)
    unsigned c = q_pull(qb + slice * 64, F.lane);
    if (c < nch) {
      u32x4 qa[16], qb_[16]; float wa[16], wb[16];
      int rbeg = chunk_row0(c, latent_only);
      VPREF(rbeg);
      VGATHER(qa, wa, 0, rbeg + 1, true);
#pragma unroll 1
      while (true) {
        const unsigned cn = q_pull(qb + slice * 64, F.lane);
        const bool hn = cn < nch; const int nr0 = hn ? chunk_row0(cn, latent_only) : 0;
#pragma unroll 1
        for (int it = 0; it < PCH; it += 2) { const int r = rbeg + it; const bool lastp = it + 2 >= PCH;
          VGATHER(qb_, wb, 128, (lastp ? nr0 : r + 2), (!lastp || hn));
          VMATH(qa, wa, r);
          if (!lastp || hn) VGATHER(qa, wa, 0, (lastp ? nr0 + 1 : r + 3), true);
          VMATH(qb_, wb, r + 1);
        }
        if (!hn) break;
        rbeg = nr0;
      }
    }
#undef VPREF
#undef VGATHER
#undef VMATH
  }
}

#define XB_TMO      128
#define XB_XCNT(j)  (256  + 64 * (j))
#define XB_XSUB(j)  (1280 + 64 * (j))
#define XB_XGEN(j)  (2304 + 64 * (j))
#define XB_TOP      3328
#define XB_TOPGEN   3392
#define XCD_BAR_WORDS 3456
#define XB_SPIN_CAP (1u << 18)

__device__ __forceinline__ unsigned xb_ld(unsigned* p)              { return __hip_atomic_load(p, __ATOMIC_RELAXED, __HIP_MEMORY_SCOPE_AGENT); }
__device__ __forceinline__ unsigned xb_add(unsigned* p, unsigned v) { return __hip_atomic_fetch_add(p, v, __ATOMIC_RELAXED, __HIP_MEMORY_SCOPE_AGENT); }
__device__ __forceinline__ unsigned xb_xcc_id() { return (unsigned)__builtin_amdgcn_s_getreg((3 << 11) | 20) & 0xFu; }
#define XB_SPIN(cond, bar) do { unsigned _sp = 0; while (cond) { __builtin_amdgcn_s_sleep(1); \
    if ((++_sp & 255u) == 0u) { if (xb_ld(&(bar)[XB_TMO])) break; if (_sp > XB_SPIN_CAP) { atomicAdd(&(bar)[XB_TMO], 1u); break; } } } } while (0)

struct XcdBarrier {
    unsigned* bar; unsigned x;
    volatile LAS unsigned* st;
};

__device__ __forceinline__ XcdBarrier xcd_barrier_post(unsigned* bar, volatile LAS unsigned* st) {
    XcdBarrier b; b.bar = bar; b.x = xb_xcc_id(); b.st = st;
    if (threadIdx.x == 0) (void)xb_add(&bar[XB_XCNT(b.x)], 1u);
    return b;
}
__device__ __forceinline__ void xcd_barrier_complete(unsigned* bar, unsigned x, unsigned& nloc, unsigned& nx) {
    const unsigned G = gridDim.x * gridDim.y * gridDim.z;
    unsigned sum, cnt, mine, sp = 0u;
    for (;;) {
        sum = 0u; cnt = 0u; mine = 0u;
#pragma unroll
        for (unsigned j = 0; j < 16; ++j) { const unsigned c = xb_ld(&bar[XB_XCNT(j)]); sum += c; cnt += (c > 0u) ? 1u : 0u; mine = (j == x) ? c : mine; }
        if (sum == G) break;
        __builtin_amdgcn_s_sleep(1);
        if ((++sp & 255u) == 0u) { if (xb_ld(&bar[XB_TMO])) break; if (sp > XB_SPIN_CAP) { atomicAdd(&bar[XB_TMO], 1u); break; } }
    }
    nloc = mine > 0u ? mine : 1u; nx = cnt > 0u ? cnt : 1u;
}

__device__ __forceinline__ void xcd_barrier(const XcdBarrier& b) {
    asm volatile("s_waitcnt vmcnt(0)" ::: "memory");
    __syncthreads();
    if (threadIdx.x == 0) {
        unsigned* bar = b.bar;
        __builtin_amdgcn_s_waitcnt(0);
        unsigned nloc = b.st[0], nx = b.st[1];
        if (nloc == 0u) { xcd_barrier_complete(bar, b.x, nloc, nx); b.st[0] = nloc; b.st[1] = nx; }
        const unsigned old = xb_add(&bar[XB_XSUB(b.x)], 1u);
        const unsigned gen = old / nloc;
        if (old + 1u == (gen + 1u) * nloc) {
            __builtin_amdgcn_fence(__ATOMIC_RELEASE, "agent");
            asm volatile("s_waitcnt vmcnt(0)" ::: "memory");
            const unsigned og = xb_add(&bar[XB_TOP], 1u);
            const unsigned tg = og / nx;
            if (og + 1u == (tg + 1u) * nx) xb_add(&bar[XB_TOPGEN], 1u);
            else XB_SPIN(xb_ld(&bar[XB_TOPGEN]) == tg, bar);
            __builtin_amdgcn_fence(__ATOMIC_ACQUIRE, "agent");
            xb_add(&bar[XB_XGEN(b.x)], 1u);
            asm volatile("s_waitcnt vmcnt(0)" ::: "memory");
        } else {
            XB_SPIN(xb_ld(&bar[XB_XGEN(b.x)]) == gen, bar);
            __builtin_amdgcn_fence(__ATOMIC_ACQUIRE, "agent");
            asm volatile("s_waitcnt vmcnt(0)" ::: "memory");
        }
    }
    __syncthreads();
}


__global__ void __launch_bounds__(NTHR, 2) fwd(Args args) {
  extern __shared__ __attribute__((aligned(16))) unsigned char lds[];
  Ctx F;
  F.ws = args.ws; F.tid = threadIdx.x; F.lane = F.tid & 63; F.wave = __builtin_amdgcn_readfirstlane(F.tid >> 6); F.bid = blockIdx.x; F.G = gridDim.x;
  F.lds = (LAS unsigned char*)lds; F.ldsg = lds;
  if (F.tid < 18) { const unsigned long long p = F.tid < 17 ? (unsigned long long)args.in[F.tid] : (unsigned long long)args.out; ((LAS unsigned long long*)(F.lds + PTAB_OFF))[F.tid] = p; }
  __syncthreads();
  const int lo = args.ph_lo, hi = args.ph_hi;
#ifndef PHMASK
#define PHMASK 0x7ff
#endif
#define IN(k) (lo <= (k) && (k) < hi)
#define EN(b) ((PHMASK >> (b)) & 1)
#ifndef REPMASK
#define REPMASK 0
#endif
#define NREP(b) (1 + ((REPMASK >> (b)) & 1))
#define FRESH() do { int t_ = threadIdx.x; asm volatile("" : "+v"(t_)); F.tid = t_; F.lane = t_ & 63; F.wave = __builtin_amdgcn_readfirstlane(t_ >> 6); int b_ = blockIdx.x; asm volatile("" : "+s"(b_)); F.bid = b_; } while (0)
  if (F.tid < 4) ((LAS unsigned*)(F.lds + PTAB_OFF + 256))[F.tid] = 0u;
  __syncthreads();
  XcdBarrier xb; xb.bar = (unsigned*)(F.ws + WS_CTL) + 4096; xb.x = 0; xb.st = nullptr;
  if (hi - lo > 1) xb = xcd_barrier_post((unsigned*)(F.ws + WS_CTL) + 4096, (volatile LAS unsigned*)(F.lds + PTAB_OFF + 256));
#ifndef SEAM_CG_ALL
#define SEAM_CG_ALL 0
#endif
#ifndef XTRA_BAR
#define XTRA_BAR 0
#endif
#ifndef STAMPS
#define STAMPS 0
#endif
#define SEAM(k) do { if (STAMPS && blockIdx.x == 0 && threadIdx.x == 0) ((unsigned long long*)(F.ws + WS_CTL + 61440))[(k)] = __builtin_amdgcn_s_memrealtime(); if (IN(k) && IN((k) + 1)) { if (SEAM_CG_ALL) cg::this_grid().sync(); else { xcd_barrier(xb); for (int xb_ = 0; xb_ < XTRA_BAR; ++xb_) xcd_barrier(xb); } } } while (0)
  if (STAMPS && blockIdx.x == 0 && threadIdx.x == 0) ((unsigned long long*)(F.ws + WS_CTL + 61440))[63] = __builtin_amdgcn_s_memrealtime();
  if (EN(10) && IN(0)) for (int rep_ = 0; rep_ < NREP(10); ++rep_) { FRESH(); phase_prologue(F); } SEAM(0);
#pragma unroll 1
  for (int layer = 0; layer < DEPTH; ++layer) {
    const int pb = 1 + 11 * layer; const bool last = layer == DEPTH - 1;
    const float* modl = (const float*)(F.ws + WS_MOD) + (size_t)layer * 5 * NMOD * DM;
    if (EN(0) && IN(pb + 0)) for (int rep_ = 0; rep_ < NREP(0); ++rep_) { FRESH(); phase_norm(F, layer, 0, layer == 0 ? 0 : 2, false); } SEAM(pb + 0);
    if (EN(1) && IN(pb + 1)) for (int rep_ = 0; rep_ < NREP(1); ++rep_) { FRESH(); pg8::Gemm g{(const pg8::bf16_t*)(F.ws + WS_H), (const pg8::bf16_t*)(F.ws + WS_WQKV + (size_t)layer * QKVD * DM), NROWS, QKVD, DM};
      Order S; S.init(NROWS / 256, QKVD / 256, F.G, F.bid, 0); EpiQKV E{F.ws, (LAS float*)(F.lds + 131072), layer};
      pg8::gemm_phase<EpiQKV, Order, true, true, true, 0x7d7d7d7d  , 0x7a7a7a7a  >(F.lds, g, S, E);
      if (layer == 0) { int lo_, hi_; conv_slot(F, 0, lo_, hi_); convert_rows(F, lo_, hi_); } } SEAM(pb + 1);
    if (EN(2) && IN(pb + 2)) for (int rep_ = 0; rep_ < NREP(2); ++rep_) { }
    if (EN(3) && IN(pb + 3)) for (int rep_ = 0; rep_ < NREP(3); ++rep_) { FRESH(); phase_attn(F, layer); } SEAM(pb + 3);
    if (EN(4) && IN(pb + 4)) for (int rep_ = 0; rep_ < NREP(4); ++rep_) { FRESH(); pg8::Gemm g{(const pg8::bf16_t*)(F.ws + WS_O), (const pg8::bf16_t*)(F.ws + WS_WO + (size_t)layer * DM * DM), NROWS, DM, DM, 0x79797979  , 0x7a7a7a7a  };
      Order S; S.init(last ? NB * 16 : NROWS / 256, DM / 256, F.G, F.bid, last ? 1 : 0); EpiRes E{st_lat(F, layer == 0 ? 0 : 2), st_ctx(F, layer == 0 ? 0 : 2), (float*)(F.ws + WS_XB), (float*)(F.ws + WS_XCB), modl + 2 * DM};
      pg8::gemm_phase<EpiRes, Order, true, true, true, 0x79797979  , 0x7a7a7a7a  >(F.lds, g, S, E);
      if (layer == 0) { int lo_, hi_; conv_slot(F, 1, lo_, hi_); convert_rows(F, lo_, hi_); } } SEAM(pb + 4);
    if (EN(5) && IN(pb + 5)) for (int rep_ = 0; rep_ < NREP(5); ++rep_) { FRESH(); phase_norm(F, layer, 1, 1, last); } SEAM(pb + 5);
    if (EN(6) && IN(pb + 6)) for (int rep_ = 0; rep_ < NREP(6); ++rep_) { FRESH(); pg8::Gemm g{(const pg8::bf16_t*)(F.ws + WS_H), (const pg8::bf16_t*)(F.ws + WS_WP) + (size_t)layer * PQN * DM, NROWS, PQN, DM};
      Order S; S.init(last ? NB * 16 : NROWS / 256, PQN / 256, F.G, F.bid, last ? 1 : 0); EpiTopk E{(int*)(F.ws + WS_EIDX), (float*)(F.ws + WS_GATE)};
#pragma unroll 1
      for (int ui = 0; ; ++ui) { OneUnit S1; if (!S.next(ui, S1.u0)) break; pg8::gemm_phase<EpiTopk, OneUnit, false, true>(F.lds, g, S1, E); }
      if (layer == 0) { int lo_, hi_; conv_slot(F, 2, lo_, hi_); convert_rows(F, lo_, hi_); } } SEAM(pb + 6);
    if (EN(7) && IN(pb + 7)) for (int rep_ = 0; rep_ < NREP(7); ++rep_) { }
    if (EN(8) && IN(pb + 8)) for (int rep_ = 0; rep_ < NREP(8); ++rep_) { FRESH(); phase_peer_u(F, layer, last, rep_); } SEAM(pb + 8);
    if (EN(9) && IN(pb + 9)) { FRESH(); phase_peer_w(F, last); } SEAM(pb + 9);
    if (EN(9) && IN(pb + 10)) for (int rep_ = 0; rep_ < NREP(9); ++rep_) { FRESH(); phase_peer_v(F, layer, last, rep_); } if (!last) SEAM(pb + 10);
  }
  if (STAMPS && blockIdx.x == 0 && threadIdx.x == 0) ((unsigned long long*)(F.ws + WS_CTL + 61440))[NPHASE - 1] = __builtin_amdgcn_s_memrealtime();
#undef IN
#undef SEAM
}
}

#ifndef MK_MULTI
#define MK_MULTI 0
#endif
#ifndef DBG
#define DBG 0
#endif
#ifndef TS_A
#define TS_A 0
#endif
#ifndef TS_B
#define TS_B 4
#endif
namespace dbg {
__global__ void k_ts(const unsigned long long* ts, float* res) { const unsigned long long s0 = ts[63]; auto dur = [&](int k) { const unsigned long long e = ts[k], b = k == 0 ? s0 : ts[k - 1]; return (float)(e - b) * 0.01f; };
  res[0] = dur(TS_A) * 1e-5f; res[1] = dur(TS_B) * 1e-3f; res[2] = 0.f; }
template <bool ABF>
__global__ void __launch_bounds__(1024) k_cmp(const void* __restrict__ a, long lda, long aoff, const float* __restrict__ b, long ldb, long boff, int rows, int cols, int row0, int rstep_lat  , float* res) {
  __shared__ float sd[1024], sr[1024];
  float d2 = 0.f, r2 = 0.f;
  for (long e = threadIdx.x; e < (long)rows * cols; e += 1024) { const int r = row0 + (int)(e / cols), c = (int)(e % cols);
    if (rstep_lat == 1 && (r % RPB) < CTXL) continue; if (rstep_lat == 2 && (r % RPB) >= CTXL) continue;
    float av; if (ABF) av = __uint_as_float((unsigned)((const unsigned short*)a)[(long)r * lda + aoff + c] << 16); else av = ((const float*)a)[(long)r * lda + aoff + c];
    const float bv = b[(long)r * ldb + boff + c]; d2 += (av - bv) * (av - bv); r2 += bv * bv; }
  sd[threadIdx.x] = d2; sr[threadIdx.x] = r2; __syncthreads();
  for (int o = 512; o > 0; o >>= 1) { if ((int)threadIdx.x < o) { sd[threadIdx.x] += sd[threadIdx.x + o]; sr[threadIdx.x] += sr[threadIdx.x + o]; } __syncthreads(); }
  if (threadIdx.x == 0) *res = sqrtf(sd[0] / fmaxf(sr[0], 1e-30f));
}
__global__ void __launch_bounds__(1024) k_cmp8(const unsigned char* __restrict__ a, long lda, float ascale, const float* __restrict__ b, long ldb, long boff, int rows, int cols, int mode, float* res) {
  __shared__ float sd[1024], sr[1024]; float d2 = 0.f, r2 = 0.f; typedef float f2_t __attribute__((ext_vector_type(2)));
  for (long e = threadIdx.x; e < (long)rows * cols; e += 1024) { const int r = (int)(e / cols), c = (int)(e % cols);
    if (mode == 1 && (r % RPB) < CTXL) continue; if (mode == 2 && (r % RPB) >= CTXL) continue;
    const f2_t t = __builtin_amdgcn_cvt_pk_f32_fp8((int)a[(long)r * lda + c], false); const float av = t.x / ascale, bv = b[(long)r * ldb + boff + c]; d2 += (av - bv) * (av - bv); r2 += bv * bv; }
  sd[threadIdx.x] = d2; sr[threadIdx.x] = r2; __syncthreads();
  for (int o = 512; o > 0; o >>= 1) { if ((int)threadIdx.x < o) { sd[threadIdx.x] += sd[threadIdx.x + o]; sr[threadIdx.x] += sr[threadIdx.x + o]; } __syncthreads(); }
  if (threadIdx.x == 0) *res = sqrtf(sd[0] / fmaxf(sr[0], 1e-30f));
}
__global__ void __launch_bounds__(1024) k_cmp_scores(const float* __restrict__ S, const float* __restrict__ PQ, const float* __restrict__ SK, int nrows, float* res) {
  __shared__ float sd[1024], sr[1024];
  float d2 = 0.f, r2 = 0.f;
  for (long e = threadIdx.x; e < (long)nrows * PQN; e += 1024) { const int r = (int)(e / PQN), c = (int)(e % PQN), h = c >> 8, half = (c >> 7) & 1, k = c & 127;
    const float* q = PQ + (long)r * PQN + h * PQD + half * 128; const float* kp = SK + (long)half * NKEYS * 128 + (long)k * 128; float a = 0.f; for (int d = 0; d < 128; ++d) a += q[d] * kp[d];
    const float f = S[(long)r * PQN + c]; d2 += (f - a) * (f - a); r2 += a * a; }
  sd[threadIdx.x] = d2; sr[threadIdx.x] = r2; __syncthreads();
  for (int o = 512; o > 0; o >>= 1) { if ((int)threadIdx.x < o) { sd[threadIdx.x] += sd[threadIdx.x + o]; sr[threadIdx.x] += sr[threadIdx.x + o]; } __syncthreads(); }
  if (threadIdx.x == 0) *res = sqrtf(sd[0] / fmaxf(sr[0], 1e-30f));
}
__global__ void k_final(float* out, long n, const float* res) {
  const float sa = 1.f + 10.f * res[0];
  for (long i = blockIdx.x * 256L + threadIdx.x; i < n; i += gridDim.x * 256L) out[i] *= sa;
  if (blockIdx.x == 0 && threadIdx.x == 0) { }
}
__global__ void k_final2(float* out, const float* res) { out[0] += 1000.f * (res[1] + res[2]); }
}

__global__ void __launch_bounds__(1024) k_cmp_w8(const unsigned char* W8, const float* W, float* res) {
  __shared__ float sd[1024], sr[1024]; float d2 = 0.f, r2 = 0.f; typedef float f2_t __attribute__((ext_vector_type(2)));
  for (long e = threadIdx.x; e < (long)DEPTH * DM * DM; e += 1024) { const int k = (int)(e & 1023), n = (int)((e >> 10) & 1023), l = (int)(e >> 20);
    const f2_t t = __builtin_amdgcn_cvt_pk_f32_fp8((int)W8[e], false); const float av = t.x / 32.f, bv = W[(size_t)l * DM * DM + (size_t)k * DM + n]; d2 += (av - bv) * (av - bv); r2 += bv * bv; }
  sd[threadIdx.x] = d2; sr[threadIdx.x] = r2; __syncthreads();
  for (int o = 512; o > 0; o >>= 1) { if ((int)threadIdx.x < o) { sd[threadIdx.x] += sd[threadIdx.x + o]; sr[threadIdx.x] += sr[threadIdx.x + o]; } __syncthreads(); }
  if (threadIdx.x == 0) { res[0] = sqrtf(sd[0] / fmaxf(sr[0], 1e-30f)); res[1] = 0.f; res[2] = 0.f; }
}


__global__ void __launch_bounds__(1024) k_cmp_wo8(const unsigned char* O8, const unsigned char* W8, const float* XB, const float* xin, const float* g1  , int r0, float* res) {
  __shared__ float sd[1024], sr[1024]; float d2 = 0.f, r2 = 0.f;
  typedef float f2_t __attribute__((ext_vector_type(2)));
  for (int e = threadIdx.x; e < 64 * DM; e += 1024) { const int r = r0 + (e >> 10), n = e & 1023; const int b = r / RPB, j = r % RPB;
    float ref = 0.f; for (int k = 0; k < DM; k += 4) { const int qa = *(const int*)(O8 + (size_t)r * DM + k), qw = *(const int*)(W8 + (size_t)n * DM + k);
      const f2_t a0 = __builtin_amdgcn_cvt_pk_f32_fp8(qa, false), a1 = __builtin_amdgcn_cvt_pk_f32_fp8(qa, true), w0 = __builtin_amdgcn_cvt_pk_f32_fp8(qw, false), w1 = __builtin_amdgcn_cvt_pk_f32_fp8(qw, true);
      ref += a0.x * w0.x + a0.y * w0.y + a1.x * w1.x + a1.y * w1.y; }
    ref *= 1.f / (64.f * 32.f);
    const size_t ol = (size_t)(b * SEQ + (j - CTXL)) * DM + n; const float fast = (XB[ol] - xin[ol]) / g1[(size_t)b * NMOD * DM + n];
    d2 += (fast - ref) * (fast - ref); r2 += ref * ref; }
  sd[threadIdx.x] = d2; sr[threadIdx.x] = r2; __syncthreads();
  for (int o = 512; o > 0; o >>= 1) { if ((int)threadIdx.x < o) { sd[threadIdx.x] += sd[threadIdx.x + o]; sr[threadIdx.x] += sr[threadIdx.x + o]; } __syncthreads(); }
  if (threadIdx.x == 0) { res[0] = sqrtf(sd[0] / fmaxf(sr[0], 1e-30f)); res[1] = 0.f; res[2] = 0.f; }
}


__global__ void k_mfma8_test(float* res) {
  typedef int i32x8_t __attribute__((ext_vector_type(8))); typedef float f32x4_t __attribute__((ext_vector_type(4)));
  __shared__ float A[16][128], B[128][16]; __shared__ int bad; __shared__ float mx;
  const int l = threadIdx.x;
  for (int e = l; e < 16 * 128; e += 64) { const int i = e >> 7, k = e & 127; A[i][k] = (float)(((i * 7 + k * 3) % 5) - 2); B[k][i] = (float)(((i * 5 + k * 11) % 7) - 3); }
  if (l == 0) { bad = 0; mx = 0.f; }
  __syncthreads();
  i32x8_t a, b;
  for (int q = 0; q < 8; ++q) { int va = 0, vb = 0; const int k0 = 32 * (l >> 4) + 4 * q;
    va = __builtin_amdgcn_cvt_pk_fp8_f32(A[l & 15][k0] * 4.f, A[l & 15][k0 + 1] * 4.f, 0, false); va = __builtin_amdgcn_cvt_pk_fp8_f32(A[l & 15][k0 + 2] * 4.f, A[l & 15][k0 + 3] * 4.f, va, true);
    vb = __builtin_amdgcn_cvt_pk_fp8_f32(B[k0][l & 15] * 8.f, B[k0 + 1][l & 15] * 8.f, 0, false); vb = __builtin_amdgcn_cvt_pk_fp8_f32(B[k0 + 2][l & 15] * 8.f, B[k0 + 3][l & 15] * 8.f, vb, true);
    a[q] = va; b[q] = vb; }
  f32x4_t c = {0.f, 0.f, 0.f, 0.f};
  c = __builtin_amdgcn_mfma_scale_f32_16x16x128_f8f6f4(a, b, c, 0, 0, 0, 0x7d7d7d7d  , 0, 0x7c7c7c7c  );
  for (int r = 0; r < 4; ++r) { const int row = 4 * (l >> 4) + r, col = l & 15; float ref = 0.f; for (int k = 0; k < 128; ++k) ref += A[row][k] * B[k][col];
    const float d = fabsf(c[r] - ref); if (d > 1e-3f) atomicAdd(&bad, 1); atomicMax((int*)&mx, __float_as_int(d)); }
  __syncthreads();
  if (l == 0) { res[0] = (float)bad / 256.f; res[1] = mx * 1e-3f; res[2] = 0.f; }
}


static void run_naive(void* const* d_in, float* out, char* ws, hipStream_t stream, int slayer, int stop) {
  const float* x = (const float*)d_in[0]; const float* c = (const float*)d_in[1]; const float* ctx = (const float*)d_in[2]; const float* c_ctx = (const float*)d_in[3];
  const float* ada_w = (const float*)d_in[4]; const float* ada_b = (const float*)d_in[5]; const float* n1g = (const float*)d_in[6]; const float* n2g = (const float*)d_in[7];
  const float* w_qkv = (const float*)d_in[8]; const float* qng = (const float*)d_in[9]; const float* kng = (const float*)d_in[10]; const float* w_o = (const float*)d_in[11];
  const float* sinks = (const float*)d_in[12]; const float* pwq = (const float*)d_in[13]; const float* psk = (const float*)d_in[14]; const float* pu = (const float*)d_in[15];
  const float* pv = (const float*)d_in[16];
  constexpr size_t MiB = 1u << 20;
  float* MOD = (float*)(ws + 0); float* XC = (float*)(ws + 1 * MiB); int* EIDX = (int*)(ws + 6 * MiB); float* GATE = (float*)(ws + 15 * MiB); float* PW = (float*)(ws + 24 * MiB);
  float* H = (float*)(ws + 34 * MiB); float* QKV = (float*)(ws + 104 * MiB); float* O = (float*)(ws + 242 * MiB); float* PQ = QKV;
  hipFuncSetAttribute((const void*)nv::k_attn, hipFuncAttributeMaxDynamicSharedMemorySize, (4 * RPB + 4 * HD) * 4);
  hipMemcpyAsync(out, x, (size_t)NB * SEQ * DM * 4, hipMemcpyDeviceToDevice, stream);
  hipMemcpyAsync(XC, ctx, (size_t)NB * CTXL * DM * 4, hipMemcpyDeviceToDevice, stream);
  nv::k_mod<<<(DEPTH * 5 * NMOD * DM + 255) / 256, 256, 0, stream>>>(c, c_ctx, ada_w, ada_b, MOD);
  for (int i = 0; i < DEPTH; ++i) {
#define STOP(k) if (i == slayer && stop == (k)) return
    const bool last = i == DEPTH - 1; const float* modi = MOD + (size_t)i * 5 * NMOD * DM;
    STOP(1); nv::k_norm<<<NROWS, 256, 0, stream>>>(out, XC, n1g + i * DM, modi, 0, 1, H);
    STOP(2); nv::k_gemm<0><<<dim3(QKVD / 64, NROWS / 64), 256, 0, stream>>>(H, w_qkv + (size_t)i * DM * QKVD, QKV, NROWS, QKVD, DM, nullptr, nullptr, nullptr, 0, 0);
    STOP(3); nv::k_qknorm_rope<<<NROWS, 640, 0, stream>>>(QKV, qng + i * HD, kng + i * HD);
    STOP(4); const size_t shm = (4 * RPB + 4 * HD) * 4;
    if (i % 2 == 0) { nv::k_attn<<<dim3(NB * SEQ, NKV), 256, shm, stream>>>(QKV, 0, nullptr); if (!last) nv::k_attn<<<dim3(NB * CTXL, NKV), 256, shm, stream>>>(QKV, 1, nullptr); }
    else { nv::k_attn<<<dim3(NB * SEQ, NKV), 256, shm, stream>>>(QKV, 2, sinks + (i / 2) * NH); }
    STOP(5); nv::k_copy_o<<<NROWS, 256, 0, stream>>>(QKV, O);
    nv::k_gemm<1><<<dim3(DM / 64, NROWS / 64), 256, 0, stream>>>(O, w_o + (size_t)i * DM * DM, nullptr, NROWS, DM, DM, out, XC, modi, 2, last ? 1 : 0);
    STOP(6); nv::k_norm<<<NROWS, 256, 0, stream>>>(out, XC, n2g + i * DM, modi, 3, 4, H);
    STOP(7); nv::k_gemm<0><<<dim3(PQN / 64, NROWS / 64), 256, 0, stream>>>(H, pwq + (size_t)i * DM * PQN, PQ, NROWS, PQN, DM, nullptr, nullptr, nullptr, 0, 0);
    STOP(8); nv::k_peer_topk<<<NROWS, 256, 0, stream>>>(PQ, psk + (size_t)i * 2 * NKEYS * 128, EIDX, GATE);
    STOP(9); nv::k_peer_u<<<NROWS, 256, 0, stream>>>(H, pu + (size_t)i * NKEYS * NKEYS * DM, EIDX, GATE, PW);
    STOP(10); nv::k_peer_v<<<NROWS, 256, 0, stream>>>(pv + (size_t)i * NKEYS * NKEYS * DM, EIDX, PW, out, XC, modi, 5, last ? 1 : 0);
#undef STOP
  }
}

extern "C" void kernel_launch(void* const* d_in, const int* in_sizes, int n_in, void* d_out, int out_size, void* d_ws, size_t ws_size, hipStream_t stream) {
  static int grid = 0;
  if (grid == 0) {
    if (n_in != 17 || out_size != NB * SEQ * DM || ws_size < mk::WS_END) { fprintf(stderr, "kernel_launch: unexpected shapes (n_in %d out %d ws %zu)\n", n_in, out_size, ws_size); grid = -1; return; }
    int dev = 0, cus = 0, per_cu = 0;
    hipGetDevice(&dev); hipDeviceGetAttribute(&cus, hipDeviceAttributeMultiprocessorCount, dev);
    if (hipFuncSetAttribute((const void*)mk::fwd, hipFuncAttributeMaxDynamicSharedMemorySize, mk::LDS_BYTES) != hipSuccess) { fprintf(stderr, "kernel_launch: hipFuncSetAttribute failed\n"); grid = -1; return; }
    if (hipOccupancyMaxActiveBlocksPerMultiprocessor(&per_cu, (const void*)mk::fwd, mk::NTHR, mk::LDS_BYTES) != hipSuccess || per_cu < 1) { fprintf(stderr, "kernel_launch: occupancy query failed (%d)\n", per_cu); grid = -1; return; }
    grid = cus * 1;
    grid -= grid % 8;
  }
  if (grid < 0) return;
  mk::Args a{};
  for (int i = 0; i < 17; ++i) a.in[i] = (const float*)d_in[i];
  a.out = (float*)d_out; a.ws = (unsigned char*)d_ws;
#if DBG == 0
#if MK_MULTI
  for (int p = 0; p < mk::NPHASE; ++p) { a.ph_lo = p; a.ph_hi = p + 1; hipLaunchKernelGGL(mk::fwd, dim3(grid), dim3(mk::NTHR), mk::LDS_BYTES, stream, a); }
#else
  hipMemsetAsync((char*)d_ws + mk::WS_CTL, 0, 65536, stream);
  a.ph_lo = 0; a.ph_hi = mk::NPHASE; void* kargs[] = {&a};
  hipError_t e = hipLaunchCooperativeKernel((const void*)mk::fwd, dim3(grid), dim3(mk::NTHR), kargs, mk::LDS_BYTES, stream);
  if (e != hipSuccess) fprintf(stderr, "cooperative launch failed: %s (grid %d)\n", hipGetErrorString(e), grid);
#endif
#else
  {
    constexpr size_t MiB = 1u << 20; char* ws = (char*)d_ws; float* out = (float*)d_out;
    float* REF = (float*)(ws + 440 * MiB); float* RES = (float*)(ws + 511 * MiB);
    float* nH = (float*)(ws + 34 * MiB); float* nQKV = (float*)(ws + 104 * MiB); float* nMOD = (float*)ws; float* nXC = (float*)(ws + 1 * MiB);
    hipMemsetAsync(RES, 0, 64, stream);
    int slayer = 0, stop = 0, fastp = 0;
#if DBG == 1
    slayer = 0; stop = 2; fastp = 2;
#elif DBG == 2
    slayer = 0; stop = 4; fastp = 4;
#elif DBG == 3
    slayer = 0; stop = 5; fastp = 5;
#elif DBG == 4
    slayer = 0; stop = 6; fastp = 6;
#elif DBG == 5
    slayer = 0; stop = 8; fastp = 8;
#elif DBG == 6
    slayer = 1; stop = 1; fastp = 11;
#elif DBG == 7
    slayer = 1; stop = 5; fastp = 15;
#elif DBG == 8
    slayer = 9; stop = 99; fastp = 21;
#elif DBG == 32
    slayer = 0; stop = 1; fastp = 1;
#elif DBG == 31
    slayer = 0; stop = 1; fastp = 6;
#elif DBG == 30
    slayer = 0; stop = 1; fastp = 0;
#elif DBG == 20
    slayer = 0; stop = 1; fastp = 0;
#elif DBG == 9
    slayer = 1; stop = 1; fastp = 9;
#elif DBG == 10
    slayer = 0; stop = 10; fastp = 9;
#elif DBG == 11
    slayer = 0; stop = 1; fastp = 1;
#endif
    run_naive(d_in, out, ws, stream, slayer, stop);
#if DBG == 1
    hipMemcpyAsync(REF, nH, (size_t)NROWS * DM * 4, hipMemcpyDeviceToDevice, stream); hipMemcpyAsync(REF + (size_t)NROWS * DM, nMOD, (size_t)DEPTH * 5 * NMOD * DM * 4, hipMemcpyDeviceToDevice, stream);
#elif DBG == 3 || DBG == 7
    nv::k_copy_o<<<NROWS, 256, 0, stream>>>(nQKV, REF);
#elif DBG == 2
    hipMemcpyAsync(REF, nQKV, (size_t)NROWS * QKVD * 4, hipMemcpyDeviceToDevice, stream);
#elif DBG == 4 || DBG == 6 || DBG == 8 || DBG == 9
    hipMemcpyAsync(REF, out, (size_t)NB * SEQ * DM * 4, hipMemcpyDeviceToDevice, stream); hipMemcpyAsync(REF + (size_t)NB * SEQ * DM, nXC, (size_t)NB * CTXL * DM * 4, hipMemcpyDeviceToDevice, stream);
#endif
#if DBG == 10
    hipMemcpyAsync(REF, ws + 24 * MiB, (size_t)NROWS * 128 * 4, hipMemcpyDeviceToDevice, stream);
#endif
#if DBG == 9 || DBG == 10
    hipMemcpyAsync(REF + (size_t)70 * MiB / 4, ws + 6 * MiB, (size_t)NROWS * 128 * 4, hipMemcpyDeviceToDevice, stream); hipMemcpyAsync(REF + (size_t)80 * MiB / 4, ws + 15 * MiB, (size_t)NROWS * 128 * 4, hipMemcpyDeviceToDevice, stream);
#elif DBG == 5
    hipMemcpyAsync(REF, nQKV  , (size_t)512 * PQN * 4, hipMemcpyDeviceToDevice, stream);
#endif
    for (int p = 0; p < fastp; ++p) { a.ph_lo = p; a.ph_hi = p + 1; hipLaunchKernelGGL(mk::fwd, dim3(grid), dim3(mk::NTHR), mk::LDS_BYTES, stream, a); }
    unsigned char* fw = (unsigned char*)d_ws;
#if DBG == 30
    k_mfma8_test<<<1, 64, 0, stream>>>(RES);
#endif
#if DBG == 32
    k_cmp_w8<<<1, 1024, 0, stream>>>(fw + mk::WS_WO, (const float*)d_in[11], RES);
#endif
#if DBG == 31
    k_cmp_wo8<<<1, 1024, 0, stream>>>(fw + mk::WS_O, fw + mk::WS_WO, (const float*)(fw + mk::WS_XB), (const float*)d_in[0], (const float*)(fw + mk::WS_MOD) + 2 * DM, 300, RES);
#endif
#if DBG == 20
    { hipMemsetAsync((char*)d_ws + mk::WS_CTL, 0, 65536, stream); a.ph_lo = 0; a.ph_hi = mk::NPHASE; void* kargs[] = {&a};
      hipLaunchCooperativeKernel((const void*)mk::fwd, dim3(grid), dim3(mk::NTHR), kargs, mk::LDS_BYTES, stream);
      dbg::k_ts<<<1, 1, 0, stream>>>((const unsigned long long*)(fw + mk::WS_CTL + 61440), RES); }
#endif
#if DBG == 9 || DBG == 10
    hipMemcpyAsync(fw + mk::WS_EIDX, REF + (size_t)70 * MiB / 4, (size_t)NROWS * 128 * 4, hipMemcpyDeviceToDevice, stream); hipMemcpyAsync(fw + mk::WS_GATE, REF + (size_t)80 * MiB / 4, (size_t)NROWS * 128 * 4, hipMemcpyDeviceToDevice, stream);
    for (int p = 9; p < (DBG == 9 ? 11 : 10); ++p) { a.ph_lo = p; a.ph_hi = p + 1; hipLaunchKernelGGL(mk::fwd, dim3(grid), dim3(mk::NTHR), mk::LDS_BYTES, stream, a); }
#endif
#if DBG == 1
    dbg::k_cmp<true><<<1, 1024, 0, stream>>>(fw + mk::WS_H, DM, 0, REF, DM, 0, NROWS, DM, 0, 0, RES);
    dbg::k_cmp<false><<<1, 1024, 0, stream>>>(fw + mk::WS_MOD, NMOD * DM, 0, REF + (size_t)NROWS * DM, NMOD * DM, 0, DEPTH * 5, NMOD * DM, 0, 0, RES + 1);
#elif DBG == 2
    dbg::k_cmp<true><<<1, 1024, 0, stream>>>(fw + mk::WS_Q, DM, 0, REF, QKVD, 0, NROWS, DM, 0, 0, RES);
    dbg::k_cmp<true><<<1, 1024, 0, stream>>>(fw + mk::WS_K, 256, 0, REF, QKVD, 1024, NROWS, 256, 0, 0, RES + 2);
    dbg::k_cmp<true><<<1, 1024, 0, stream>>>(fw + mk::WS_V, 256, 0, REF, QKVD, 1280, NROWS, 256, 0, 0, RES + 1);
#elif DBG == 3 || DBG == 7
    dbg::k_cmp8<<<1, 1024, 0, stream>>>(fw + mk::WS_O, DM, 64.f, REF, DM, 0, NROWS, DM, 1, RES);
    if (DBG == 3) dbg::k_cmp8<<<1, 1024, 0, stream>>>(fw + mk::WS_O, DM, 64.f, REF, DM, 0, NROWS, DM, 2, RES + 1);
#elif DBG == 4 || DBG == 6 || DBG == 8 || DBG == 9
    dbg::k_cmp<false><<<1, 1024, 0, stream>>>(DBG == 4 ? (const void*)(fw + mk::WS_XB) : (const void*)out, DM, 0, REF, DM, 0, NB * SEQ, DM, 0, 0, RES);
    if (DBG != 8) dbg::k_cmp<false><<<1, 1024, 0, stream>>>(fw + (DBG == 4 ? mk::WS_XCB : mk::WS_XC), DM, 0, REF + (size_t)NB * SEQ * DM, DM, 0, NB * CTXL, DM, 0, 0, RES + 1);
#elif DBG == 11
    dbg::k_cmp<true><<<1, 1024, 0, stream>>>(fw + mk::WS_UT, DM, 0, (const float*)d_in[15], DM, 0, DEPTH * NKEYS * NKEYS, DM, 0, 0, RES);
    dbg::k_cmp<true><<<1, 1024, 0, stream>>>(fw + mk::WS_VT, DM, 0, (const float*)d_in[16], DM, 0, DEPTH * NKEYS * NKEYS, DM, 0, 0, RES + 1);
#elif DBG == 10
    dbg::k_cmp<false><<<1, 1024, 0, stream>>>(fw + mk::WS_PW, 128, 0, REF, 128, 0, NROWS, 128, 0, 0, RES);
#elif DBG == 5
    dbg::k_cmp_scores<<<1, 1024, 0, stream>>>((const float*)(fw + mk::WS_S), REF, (const float*)d_in[14], 512, RES);
#endif
    hipMemcpyAsync(REF, RES, 64, hipMemcpyDeviceToDevice, stream);
    run_naive(d_in, out, ws, stream, 9, 99);
    dbg::k_final<<<1024, 256, 0, stream>>>(out, (long)NB * SEQ * DM, REF);
    dbg::k_final2<<<1, 1, 0, stream>>>(out, REF);
  }
#endif
}
```

```cpp
#include <hip/hip_runtime.h>
#include <hip/hip_cooperative_groups.h>
#include <cstdio>
#include <cstdint>

constexpr int NB = 4, SEQ = 4096, CTXL = 256, DM = 1024, DEPTH = 2;
constexpr int RPB = CTXL + SEQ;
constexpr int NROWS = NB * RPB;
constexpr int NH = 8, NKV = 2, HD = 128, QKVD = 1536, NMOD = 6;
constexpr int PH = 8, PK = 16, NKEYS = 128, PQD = 256, PQN = PH * PQD;
constexpr float RMS_EPS = 1e-6f;

namespace nv {

__device__ __forceinline__ float silu(float x) { return x / (1.f + __expf(-x)); }
__device__ __forceinline__ float gelu_tanh(float x) {
  const float y = 0.7978845608028654f * (x + 0.044715f * x * x * x);
  const float t = 1.f - 2.f / (__expf(2.f * y) + 1.f);
  return 0.5f * x * (1.f + t);
}

__global__ void k_mod(const float* __restrict__ c, const float* __restrict__ c_ctx, const float* __restrict__ ada_w,
                      const float* __restrict__ ada_b, float* __restrict__ mod) {
  const int idx = blockIdx.x * 256 + threadIdx.x;
  if (idx >= DEPTH * 5 * NMOD * DM) return;
  const int n = idx % (NMOD * DM), r = (idx / (NMOD * DM)) % 5, i = idx / (5 * NMOD * DM);
  const float* cv = r < 4 ? c + r * DM : c_ctx;
  const float* w = ada_w + (size_t)i * DM * NMOD * DM + n;
  float s = 0.f;
  for (int j = 0; j < DM; ++j) s += silu(cv[j]) * w[(size_t)j * NMOD * DM];
  mod[idx] = s + ada_b[i * NMOD * DM + n];
}

__device__ __forceinline__ float* xrow(float* xl, float* xc, int r) {
  const int b = r / RPB, j = r % RPB;
  return j < CTXL ? xc + (size_t)(b * CTXL + j) * DM : xl + (size_t)(b * SEQ + (j - CTXL)) * DM;
}

__global__ void k_norm(float* xl, float* xc, const float* __restrict__ gain, const float* __restrict__ modi, int sh_i, int sc_i,
                       float* __restrict__ H) {
  const int r = blockIdx.x, t = threadIdx.x;
  const int b = r / RPB, j = r % RPB, mr = j < CTXL ? 4 : b;
  const float* x = xrow(xl, xc, r);
  __shared__ float red[4];
  float v[4]; float s = 0.f;
#pragma unroll
  for (int q = 0; q < 4; ++q) { v[q] = x[t + 256 * q]; s += v[q] * v[q]; }
  for (int o = 32; o > 0; o >>= 1) s += __shfl_xor(s, o);
  if ((t & 63) == 0) red[t >> 6] = s;
  __syncthreads();
  s = red[0] + red[1] + red[2] + red[3];
  const float rstd = rsqrtf(s / DM + RMS_EPS);
  const float* sh = modi + (size_t)mr * NMOD * DM + sh_i * DM; const float* sc = modi + (size_t)mr * NMOD * DM + sc_i * DM;
#pragma unroll
  for (int q = 0; q < 4; ++q) { const int d = t + 256 * q; H[(size_t)r * DM + d] = v[q] * rstd * gain[d] * (1.f + sc[d]) + sh[d]; }
}

template <int EPI>
__global__ void k_gemm(const float* __restrict__ A, const float* __restrict__ B, float* __restrict__ C, int M, int N, int K,
                       float* xl, float* xc, const float* __restrict__ modi, int g_i, int skip_ctx) {
  __shared__ float As[16][68], Bs[16][68];
  const int t = threadIdx.x, tx = t & 15, ty = t >> 4, m0 = blockIdx.y * 64, n0 = blockIdx.x * 64;
  float acc[4][4] = {};
  for (int k0 = 0; k0 < K; k0 += 16) {
    for (int q = 0; q < 4; ++q) { const int e = t + 256 * q, mm = e >> 4, kk = e & 15; As[kk][mm] = A[(size_t)(m0 + mm) * K + k0 + kk]; }
    for (int q = 0; q < 4; ++q) { const int e = t + 256 * q, kk = e >> 6, nn = e & 63; Bs[kk][nn] = B[(size_t)(k0 + kk) * N + n0 + nn]; }
    __syncthreads();
#pragma unroll
    for (int kk = 0; kk < 16; ++kk) {
      float a[4], b[4];
#pragma unroll
      for (int i = 0; i < 4; ++i) { a[i] = As[kk][ty * 4 + i]; b[i] = Bs[kk][tx * 4 + i]; }
#pragma unroll
      for (int i = 0; i < 4; ++i)
#pragma unroll
        for (int j = 0; j < 4; ++j) acc[i][j] += a[i] * b[j];
    }
    __syncthreads();
  }
#pragma unroll
  for (int i = 0; i < 4; ++i) {
    const int r = m0 + ty * 4 + i;
    if (EPI == 0) {
#pragma unroll
      for (int j = 0; j < 4; ++j) C[(size_t)r * N + n0 + tx * 4 + j] = acc[i][j];
    } else {
      const int b = r / RPB, jj = r % RPB; if (skip_ctx && jj < CTXL) continue;
      const int mr = jj < CTXL ? 4 : b; float* x = xrow(xl, xc, r);
      const float* g = modi + (size_t)mr * NMOD * DM + g_i * DM;
#pragma unroll
      for (int j = 0; j < 4; ++j) { const int n = n0 + tx * 4 + j; x[n] += g[n] * acc[i][j]; }
    }
  }
}

__global__ void k_qknorm_rope(float* __restrict__ QKV, const float* __restrict__ qg, const float* __restrict__ kg) {
  const int r = blockIdx.x, t = threadIdx.x, head = t >> 6, p = t & 63, axis = p >> 5, f = p & 31;
  const int j = r % RPB;
  float* base = QKV + (size_t)r * QKVD + head * HD;
  const int e1 = axis * 64 + f, e2 = e1 + 32;
  float x1 = base[e1], x2 = base[e2];
  float s = x1 * x1 + x2 * x2;
  for (int o = 32; o > 0; o >>= 1) s += __shfl_xor(s, o);
  const float rstd = rsqrtf(s / HD + RMS_EPS);
  const float* g = head < NH ? qg : kg;
  x1 = x1 * rstd * g[e1]; x2 = x2 * rstd * g[e2];
  if (j >= CTXL) {
    const int sp = j - CTXL; const float pos = (float)(axis == 0 ? sp / 64 : sp % 64);
    const float inv = powf(10000.f, -(float)(2 * f) / 64.f);
    const float ang = pos * inv; const float cs = cosf(ang), sn = sinf(ang);
    const float y1 = x1 * cs - x2 * sn, y2 = x1 * sn + x2 * cs; x1 = y1; x2 = y2;
  }
  base[e1] = x1; base[e2] = x2;
}

__global__ void k_attn(float* __restrict__ QKV, int mode, const float* __restrict__ sink) {
  extern __shared__ float sm[];
  const int t = threadIdx.x, w = t >> 6, lane = t & 63, g = blockIdx.y;
  int b, j;
  if (mode == 1) { b = blockIdx.x / CTXL; j = blockIdx.x % CTXL; } else { b = blockIdx.x / SEQ; j = CTXL + blockIdx.x % SEQ; }
  const int r = b * RPB + j, h = g * 4 + w;
  float* sc = sm + w * RPB; float* qs = sm + 4 * RPB + w * HD;
  float* qp = QKV + (size_t)r * QKVD + h * HD;
  qs[lane] = qp[lane]; qs[lane + 64] = qp[lane + 64];
  __syncthreads();
  int a0 = 0, a1, b0 = 0, b1 = 0;
  if (mode == 0) a1 = RPB; else if (mode == 1) a1 = CTXL;
  else { a1 = CTXL; const int s = j - CTXL; const int lo = s - 128 < 0 ? 0 : s - 128, hi = s + 128 > SEQ - 1 ? SEQ - 1 : s + 128; b0 = CTXL + lo; b1 = CTXL + hi + 1; }
  const int nk = (a1 - a0) + (b1 - b0);
  const float scale = 0.08838834764831845f;
  float mx = -1e30f;
  for (int i = lane; i < nk; i += 64) {
    const int kr = i < (a1 - a0) ? a0 + i : b0 + (i - (a1 - a0));
    const float4* kp = (const float4*)(QKV + (size_t)(b * RPB + kr) * QKVD + NH * HD + g * HD);
    float s = 0.f;
    for (int d = 0; d < 32; ++d) { const float4 kv = kp[d]; s += kv.x * qs[4 * d] + kv.y * qs[4 * d + 1] + kv.z * qs[4 * d + 2] + kv.w * qs[4 * d + 3]; }
    s *= scale; sc[i] = s; mx = fmaxf(mx, s);
  }
  for (int o = 32; o > 0; o >>= 1) mx = fmaxf(mx, __shfl_xor(mx, o));
  if (mode == 2) mx = fmaxf(mx, sink[h]);
  float l = 0.f;
  for (int i = lane; i < nk; i += 64) { const float p = __expf(sc[i] - mx); sc[i] = p; l += p; }
  for (int o = 32; o > 0; o >>= 1) l += __shfl_xor(l, o);
  if (mode == 2) l += __expf(sink[h] - mx);
  __syncthreads();
  float o0 = 0.f, o1 = 0.f;
  for (int i = 0; i < nk; ++i) {
    const int kr = i < (a1 - a0) ? a0 + i : b0 + (i - (a1 - a0));
    const float* vp = QKV + (size_t)(b * RPB + kr) * QKVD + (NH + NKV) * HD + g * HD;
    const float p = sc[i]; o0 += p * vp[lane]; o1 += p * vp[lane + 64];
  }
  const float il = 1.f / l;
  qp[lane] = o0 * il; qp[lane + 64] = o1 * il;
}

__global__ void k_copy_o(const float* __restrict__ QKV, float* __restrict__ O) {
  const int r = blockIdx.x, t = threadIdx.x;
  for (int q = 0; q < 4; ++q) O[(size_t)r * DM + t + 256 * q] = QKV[(size_t)r * QKVD + t + 256 * q];
}

__global__ void __launch_bounds__(256) k_peer_topk(const float* __restrict__ PQ, const float* __restrict__ SK  , int* __restrict__ eidx, float* __restrict__ gate) {
  __shared__ float q[PQN]; __shared__ float s[16][128]; __shared__ float tv[16][16]; __shared__ int ti[16][16];
  __shared__ float cs[8][256]; __shared__ int taken[8][256];
  const int r = blockIdx.x, t = threadIdx.x;
  for (int i = t; i < PQN; i += 256) q[i] = PQ[(size_t)r * PQN + i];
  __syncthreads();
  { const int k = t & 127, half = t >> 7; const float* kp = SK + (size_t)half * NKEYS * 128 + (size_t)k * 128;
#pragma nounroll
    for (int h = 0; h < PH; ++h) { float a = 0.f; const float* qq = q + h * PQD + half * 128;
#pragma unroll 4
      for (int d = 0; d < 128; ++d) a += qq[d] * kp[d];
      s[h * 2 + half][k] = a; } }
  __syncthreads();
  if (t < 16) {
#pragma nounroll
    for (int it = 0; it < PK; ++it) { float bv = -3e38f; int bi = 0;
#pragma nounroll
      for (int k = 0; k < 128; ++k) { const float v = s[t][k]; if (v > bv) { bv = v; bi = k; } } tv[t][it] = bv; ti[t][it] = bi; s[t][bi] = -3e38f; }
  }
  __syncthreads();
  for (int i = t; i < 8 * 256; i += 256) { const int h = i >> 8, c = i & 255; cs[h][c] = tv[h * 2][c >> 4] + tv[h * 2 + 1][c & 15]; taken[h][c] = 0; }
  __syncthreads();
  if (t < 8) {
    float m = -3e38f;
#pragma nounroll
    for (int it = 0; it < PK; ++it) { float bv = -3e38f; int bi = 0;
#pragma nounroll
      for (int c = 0; c < 256; ++c) { const float v = cs[t][c]; if (!taken[t][c] && v > bv) { bv = v; bi = c; } }
      taken[t][bi] = 1; s[t][it] = bv; m = fmaxf(m, bv); eidx[(size_t)r * 128 + t * PK + it] = ti[t * 2][bi >> 4] * NKEYS + ti[t * 2 + 1][bi & 15]; }
    float l = 0.f;
#pragma nounroll
    for (int it = 0; it < PK; ++it) l += __expf(s[t][it] - m);
#pragma nounroll
    for (int it = 0; it < PK; ++it) gate[(size_t)r * 128 + t * PK + it] = __expf(s[t][it] - m) / l;
  }
}

__global__ void k_peer_u(const float* __restrict__ H, const float* __restrict__ U, const int* __restrict__ eidx, const float* __restrict__ gate, float* __restrict__ W) {
  __shared__ float h[DM];
  const int r = blockIdx.x, t = threadIdx.x, w = t >> 6, lane = t & 63;
  for (int i = t; i < DM; i += 256) h[i] = H[(size_t)r * DM + i];
  __syncthreads();
  for (int k = w; k < 128; k += 4) {
    const int e = eidx[(size_t)r * 128 + k]; const float* u = U + (size_t)e * DM; float a = 0.f;
    for (int d = lane; d < DM; d += 64) a += u[d] * h[d];
    for (int o = 32; o > 0; o >>= 1) a += __shfl_xor(a, o);
    if (lane == 0) W[(size_t)r * 128 + k] = gate[(size_t)r * 128 + k] * gelu_tanh(a);
  }
}
__global__ void k_peer_v(const float* __restrict__ V, const int* __restrict__ eidx, const float* __restrict__ W, float* xl, float* xc,
                         const float* __restrict__ modi, int g_i, int skip_ctx) {
  const int r = blockIdx.x, t = threadIdx.x; const int b = r / RPB, j = r % RPB; if (skip_ctx && j < CTXL) return;
  float4 acc = {0.f, 0.f, 0.f, 0.f};
  for (int k = 0; k < 128; ++k) { const int e = eidx[(size_t)r * 128 + k]; const float w = W[(size_t)r * 128 + k]; const float4 v = ((const float4*)(V + (size_t)e * DM))[t];
    acc.x += w * v.x; acc.y += w * v.y; acc.z += w * v.z; acc.w += w * v.w; }
  const int mr = j < CTXL ? 4 : b; float4* x = (float4*)xrow(xl, xc, r) + t; const float4 g = ((const float4*)(modi + (size_t)mr * NMOD * DM + g_i * DM))[t];
  float4 xv = *x; xv.x += g.x * acc.x; xv.y += g.y * acc.y; xv.z += g.z * acc.z; xv.w += g.w * acc.w; *x = xv;
}
}


namespace pg8 {
#define PG8_LAS __attribute__((address_space(3)))
typedef unsigned short bf16_t;
typedef short bf16x8 __attribute__((ext_vector_type(8)));
typedef float f32x4 __attribute__((ext_vector_type(4)));
typedef unsigned u32x4 __attribute__((ext_vector_type(4)));
constexpr int BM = 256, BK = 64, HALF = 128, HTB = HALF * BK * 2  , STAGE_BYTES = 8 * HTB, NXCD = 8, WGM = 8;

__host__ __device__ __forceinline__ int lds_byte(int r, int c) { const int st = (r >> 4) * 2 + (c >> 5), rr = r & 15, cc = c & 31, ob = rr * 64 + cc * 2; return st * 1024 + (ob ^ (((ob >> 9) & 1) << 5)); }
__host__ __device__ __forceinline__ void stage_rc(int b, int& R, int& C) { const int st = b / 1024, sb = b % 1024, swz = sb ^ (((sb >> 9) & 1) << 5); R = (st >> 1) * 16 + swz / 64; C = (st & 1) * 32 + (swz % 64) / 2; }
__host__ __device__ __forceinline__ int perm32(int rho) { const int n = rho >> 4, i = rho & 15; return 8 * (i >> 2) + 4 * n + (i & 3); }

struct Unit { int pm, pn; };
struct Gemm { const bf16_t* A; const bf16_t* Bt; int M, N, K; int sa = 0x7f7f7f7f, sb = 0x7f7f7f7f; };
typedef int i32x4 __attribute__((ext_vector_type(4)));
typedef int i32x8 __attribute__((ext_vector_type(8)));

struct StaticOrder {
    int nM, nN, nwg, G, c;
    __host__ __device__ void init(int M, int N, int G_, int c_) { nM = M / BM; nN = N / BM; nwg = nM * nN; G = G_; c = c_; }
    __host__ __device__ bool next(int i, Unit& u) const {
        const long L = (long)i * G + c; if (L >= nwg) return false;
        int wgid = (int)L; { const int q = nwg / NXCD, r = nwg % NXCD, xcd = wgid % NXCD, off = wgid / NXCD; wgid = (xcd < r ? xcd * (q + 1) : r * (q + 1) + (xcd - r) * q) + off; }
        const int nig = WGM * nN, gid = wgid / nig, fm = gid * WGM, gsz = (nM - fm) < WGM ? (nM - fm) : WGM;
        u.pm = fm + ((wgid % nig) % gsz); u.pn = (wgid % nig) / gsz; return true;
    }
    __device__ __forceinline__ void a_ready(const Unit&) const {}
    __device__ __forceinline__ void done(const Unit&) const {}
};

__device__ __forceinline__ unsigned cvt_pk_bf16(float lo, float hi) { unsigned r; asm volatile("v_cvt_pk_bf16_f32 %0, %1, %2" : "=v"(r) : "v"(lo), "v"(hi)); return r; }
typedef float f32x2 __attribute__((ext_vector_type(2)));
__device__ __forceinline__ f32x2 gelu_pk(f32x2 v) {
    const f32x2 av = __builtin_elementwise_abs(v), d = av * 0.2316418882f + 1.0f;
    f32x2 t; t.x = __builtin_amdgcn_rcpf(d.x); t.y = __builtin_amdgcn_rcpf(d.y);
    f32x2 q = t * 0.5307027145f + (-0.7265760135f); q = q * t + 0.7107068705f; q = q * t + (-0.142248368f); q = q * t + 0.127414796f; q = q * t;
    const f32x2 s = (v * v) * (-0.72134752044f);
    f32x2 e; e.x = __builtin_amdgcn_exp2f(s.x); e.y = __builtin_amdgcn_exp2f(s.y);
    const f32x2 m = v * (q * e), r = v - m;
    f32x2 o; o.x = v.x < 0.f ? m.x : r.x; o.y = v.y < 0.f ? m.y : r.y; return o;
}

template <int ACT  > struct EpiBf16 {
    static constexpr bool PERM = true, AFTER_DRAIN = false; static_assert(ACT == 0 || ACT == 1, "EpiBf16: ACT is 0 (none) or 1 (gelu_pk)");
    bf16_t* O; int ldc; const float* bias; int split_cols; size_t split_stride; float scale0;
    __device__ __forceinline__ void operator()(const f32x4 (&acc)[2][2][4][2], const Unit& u, int wr, int wc, int fr, int fq) const {
        const int row0 = u.pm * BM + wr * 64 + fr; int colt = u.pn * BM; bf16_t* base = O;
        float sc = 1.f; if (split_cols) { const int t = colt / split_cols; base += (size_t)t * split_stride; colt -= t * split_cols; if (t == 0) sc = scale0; }
        const int col0 = colt + wc * 32 + 8 * fq, bcol0 = u.pn * BM + wc * 32 + 8 * fq;
        f32x4 bv[2][2];
#pragma unroll
        for (int bj = 0; bj < 2; ++bj)
#pragma unroll
            for (int n = 0; n < 2; ++n) bv[bj][n] = bias ? *(const f32x4*)(bias + bcol0 + bj * HALF + 4 * n) : (f32x4){0.f, 0.f, 0.f, 0.f};
#pragma unroll
        for (int ai = 0; ai < 2; ++ai)
#pragma unroll
            for (int m = 0; m < 4; ++m) { bf16_t* rowp = base + (size_t)(row0 + ai * HALF + m * 16) * ldc + col0;
#pragma unroll
                for (int bj = 0; bj < 2; ++bj) { f32x4 v0 = acc[ai][bj][m][0] + bv[bj][0], v1 = acc[ai][bj][m][1] + bv[bj][1];
                    if (ACT == 1) { f32x2 a = gelu_pk((f32x2){v0[0], v0[1]}), b = gelu_pk((f32x2){v0[2], v0[3]}), c = gelu_pk((f32x2){v1[0], v1[1]}), d = gelu_pk((f32x2){v1[2], v1[3]});
                        v0 = (f32x4){a.x, a.y, b.x, b.y}; v1 = (f32x4){c.x, c.y, d.x, d.y}; }
                    v0 = v0 * sc; v1 = v1 * sc; u32x4 w; w.x = cvt_pk_bf16(v0[0], v0[1]); w.y = cvt_pk_bf16(v0[2], v0[3]); w.z = cvt_pk_bf16(v1[0], v1[1]); w.w = cvt_pk_bf16(v1[2], v1[3]);
                    *(u32x4*)(rowp + bj * HALF) = w; } }
    }
};

template <class Epi, class Sched, bool ALIGN_EPI = false, bool SP2 = false, bool FP8 = false, int SA = 0x7f7f7f7f, int SB = 0x7f7f7f7f>
__device__ __forceinline__ void gemm_phase(PG8_LAS unsigned char* lds, const Gemm g, const Sched& S, const Epi& E) {
    int tid_ = threadIdx.x; asm volatile("" : "+v"(tid_));
    const int tid = tid_, wid = __builtin_amdgcn_readfirstlane(tid >> 6), lane = tid & 63, wr = wid >> 2, wc = wid & 3, fr = lane & 15, fq = lane >> 4;
    constexpr int ES = FP8 ? 1 : 2;
    const int K = g.K, nt = K * ES / (BK * 2);
    unsigned voffA[2], voffB[2];
#pragma unroll
    for (int i = 0; i < 2; ++i) { int R, C; stage_rc(tid * 16 + i * 8192, R, C); const int Rb = Epi::PERM ? ((R & ~31) + perm32(R & 31)) : R;
        voffA[i] = (unsigned)(R * K * ES + C * 2); voffB[i] = (unsigned)(Rb * K * ES + C * 2); }
    const size_t kstep = (size_t)(BK * 2);
    const size_t hstep = (size_t)HALF * K * ES;
    const size_t tstep = 2 * hstep;
    const unsigned ldsw = (unsigned)wid * 1024u;
    const int aoff = lds_byte(wr * 64 + fr, fq * 8), boff = lds_byte(wc * 32 + fr, fq * 8);
#define PG8_SA(b, h) (((b) * 2 + (h)) * HTB)
#define PG8_SB(b, h) ((4 + (b) * 2 + (h)) * HTB)
#define PG8_STAGE(bufoff, gbase, voff) do { if constexpr (FP8) {   \
          int t3_ = tid; asm volatile("" : "+v"(t3_)); _Pragma("unroll") for (int _i = 0; _i < 2; ++_i) { int R_, C_; stage_rc(t3_ * 16 + _i * 8192, R_, C_); \
            if (Epi::PERM && (&(voff)[0] == &voffB[0])) R_ = (R_ & ~31) + perm32(R_ & 31); \
            __builtin_amdgcn_global_load_lds((const unsigned*)((const char*)(gbase) + (unsigned)(R_ * K * ES + C_ * 2)), (PG8_LAS unsigned*)(lds + (bufoff) + ldsw + _i * 8192), 16, 0, 0); } } \
        else { _Pragma("unroll") for (int _i = 0; _i < 2; ++_i) \
        __builtin_amdgcn_global_load_lds((const unsigned*)((const char*)(gbase) + (voff)[_i]), (PG8_LAS unsigned*)(lds + (bufoff) + ldsw + _i * 8192), 16, 0, 0); } } while (0)
#define PG8_LDA(dst, b, h) do { if constexpr (FP8) { _Pragma("unroll") for (int m = 0; m < 4; ++m) dst##8[m] = __builtin_shufflevector(*(const PG8_LAS i32x4*)(lds + PG8_SA(b, h) + aoff + m * 2048), *(const PG8_LAS i32x4*)(lds + PG8_SA(b, h) + aoff + m * 2048 + 1024), 0, 1, 2, 3, 4, 5, 6, 7); } \
        else { _Pragma("unroll") for (int m = 0; m < 4; ++m) _Pragma("unroll") for (int k = 0; k < 2; ++k) dst[m][k] = *(const PG8_LAS bf16x8*)(lds + PG8_SA(b, h) + aoff + m * 2048 + k * 1024); } } while (0)
#define PG8_LDB(dst, b, h) do { if constexpr (FP8) { _Pragma("unroll") for (int n = 0; n < 2; ++n) dst##8[n] = __builtin_shufflevector(*(const PG8_LAS i32x4*)(lds + PG8_SB(b, h) + boff + n * 2048), *(const PG8_LAS i32x4*)(lds + PG8_SB(b, h) + boff + n * 2048 + 1024), 0, 1, 2, 3, 4, 5, 6, 7); } \
        else { _Pragma("unroll") for (int n = 0; n < 2; ++n) _Pragma("unroll") for (int k = 0; k < 2; ++k) dst[n][k] = *(const PG8_LAS bf16x8*)(lds + PG8_SB(b, h) + boff + n * 2048 + k * 1024); } } while (0)
#define PG8_MMA(ai, bj, At, Bt) do { __builtin_amdgcn_s_setprio(1); \
        if constexpr (FP8) { _Pragma("unroll") for (int m = 0; m < 4; ++m) _Pragma("unroll") for (int n = 0; n < 2; ++n) { \
            acc[ai][bj][m][n] = __builtin_amdgcn_mfma_scale_f32_16x16x128_f8f6f4(Bt##8[n], At##8[m], acc[ai][bj][m][n], 0, 0, 0, SB, 0, SA); } } \
        else { _Pragma("unroll") for (int m = 0; m < 4; ++m) _Pragma("unroll") for (int n = 0; n < 2; ++n) _Pragma("unroll") for (int k = 0; k < 2; ++k) \
            acc[ai][bj][m][n] = __builtin_amdgcn_mfma_f32_16x16x32_bf16(Bt[n][k], At[m][k], acc[ai][bj][m][n], 0, 0, 0); } \
        __builtin_amdgcn_s_setprio(0); } while (0)
#define PG8_WAIT_V(n) asm volatile("s_waitcnt vmcnt(" #n ")" ::: "memory")
#define PG8_WAIT_L(n) asm volatile("s_waitcnt lgkmcnt(" #n ")" ::: "memory")
#define PG8_BAR __builtin_amdgcn_s_barrier()
#define PG8_SCHED __builtin_amdgcn_sched_barrier(0)
    Unit cur, nxt; int ui = 0;
    if (!S.next(0, cur)) return;
    f32x4 acc[2][2][4][2];
#pragma unroll
    for (int a = 0; a < 2; ++a)
#pragma unroll
        for (int b = 0; b < 2; ++b)
#pragma unroll
            for (int m = 0; m < 4; ++m)
#pragma unroll
                for (int n = 0; n < 2; ++n) acc[a][b][m][n] = (f32x4){0.f, 0.f, 0.f, 0.f};
    bf16x8 At[4][2], B0[2][2], B1[2][2]; i32x8 At8[4], B08[2], B18[2];
    const char* cA = (const char*)g.A + (size_t)cur.pm * tstep; const char* cB = (const char*)g.Bt + (size_t)cur.pn * tstep;
    S.a_ready(cur);
    if constexpr (SP2) {
        PG8_STAGE(PG8_SB(0, 0), cB, voffB); PG8_STAGE(PG8_SB(0, 1), cB + hstep, voffB); PG8_STAGE(PG8_SA(0, 0), cA, voffA); PG8_STAGE(PG8_SA(0, 1), cA + hstep, voffA);
        if (wr == 1) PG8_BAR;
        PG8_WAIT_V(2); PG8_BAR;
        PG8_STAGE(PG8_SB(1, 0), cB + kstep, voffB); PG8_STAGE(PG8_SA(1, 0), cA + kstep, voffA); PG8_STAGE(PG8_SB(1, 1), cB + hstep + kstep, voffB);
        PG8_WAIT_V(6); PG8_BAR;
    } else {
        PG8_STAGE(PG8_SB(0, 0), cB, voffB); PG8_STAGE(PG8_SA(0, 0), cA, voffA); PG8_STAGE(PG8_SB(0, 1), cB + hstep, voffB); PG8_STAGE(PG8_SA(0, 1), cA + hstep, voffA);
        if (wr == 1) PG8_BAR;
        PG8_WAIT_V(4); PG8_BAR;
        PG8_STAGE(PG8_SB(1, 0), cB + kstep, voffB); PG8_STAGE(PG8_SA(1, 0), cA + kstep, voffA); PG8_STAGE(PG8_SB(1, 1), cB + hstep + kstep, voffB);
        PG8_WAIT_V(6); PG8_BAR;
    }
    for (;;) {
        const bool has_next = S.next(ui + 1, nxt);
        const char* nA = has_next ? (const char*)g.A + (size_t)nxt.pm * tstep : cA; const char* nB = has_next ? (const char*)g.Bt + (size_t)nxt.pn * tstep : cB;
#pragma unroll 1
        for (int t = 0; t < nt; t += 2) {
            const bool last = (t == nt - 2);
            const char* a1 = cA + (size_t)(t + 1) * kstep;
            const char* a2 = last ? nA : cA + (size_t)(t + 2) * kstep; const char* b2 = last ? nB : cB + (size_t)(t + 2) * kstep;
            const char* a3 = a2 + kstep; const char* b3 = b2 + kstep;
            if (last && has_next) S.a_ready(nxt);
            if constexpr (SP2) {
            PG8_LDB(B0, 0, 0); PG8_LDB(B1, 0, 1); PG8_SCHED; PG8_LDA(At, 0, 0); PG8_STAGE(PG8_SA(1, 1), a1 + hstep, voffA);
            PG8_WAIT_V(8); PG8_WAIT_L(0); PG8_BAR; PG8_MMA(0, 0, At, B0); PG8_MMA(0, 1, At, B1); PG8_BAR; PG8_SCHED;
            PG8_LDA(At, 0, 1); PG8_STAGE(PG8_SB(0, 0), b2, voffB); PG8_STAGE(PG8_SB(0, 1), b2 + hstep, voffB); PG8_STAGE(PG8_SA(0, 0), a2, voffA);
            PG8_WAIT_V(8); PG8_WAIT_L(0); PG8_BAR; PG8_MMA(1, 0, At, B0); PG8_MMA(1, 1, At, B1); PG8_BAR; PG8_SCHED;
            PG8_LDB(B0, 1, 0); PG8_LDB(B1, 1, 1); PG8_SCHED; PG8_LDA(At, 1, 0); PG8_STAGE(PG8_SA(0, 1), a2 + hstep, voffA);
            PG8_WAIT_V(8); PG8_WAIT_L(0); PG8_BAR; PG8_MMA(0, 0, At, B0); PG8_MMA(0, 1, At, B1); PG8_BAR; PG8_SCHED;
            PG8_LDA(At, 1, 1); PG8_STAGE(PG8_SB(1, 0), b3, voffB); PG8_STAGE(PG8_SB(1, 1), b3 + hstep, voffB); PG8_STAGE(PG8_SA(1, 0), a3, voffA);
            PG8_WAIT_V(8); PG8_WAIT_L(0); PG8_BAR; PG8_MMA(1, 0, At, B0); PG8_MMA(1, 1, At, B1); PG8_BAR; PG8_SCHED;
            } else {
            PG8_LDB(B0, 0, 0); PG8_SCHED; PG8_LDA(At, 0, 0); PG8_STAGE(PG8_SA(1, 1), a1 + hstep, voffA);
            PG8_WAIT_L(8); PG8_BAR; PG8_WAIT_L(0); PG8_MMA(0, 0, At, B0); PG8_BAR; PG8_SCHED;
            PG8_LDB(B1, 0, 1); PG8_STAGE(PG8_SB(0, 0), b2, voffB);
            PG8_BAR; PG8_WAIT_L(0); PG8_MMA(0, 1, At, B1); PG8_BAR;
            PG8_LDA(At, 0, 1); PG8_STAGE(PG8_SA(0, 0), a2, voffA);
            PG8_BAR; PG8_WAIT_L(0); PG8_MMA(1, 0, At, B0); PG8_BAR; PG8_SCHED;
            PG8_STAGE(PG8_SB(0, 1), b2 + hstep, voffB);
            PG8_WAIT_V(6); PG8_BAR; PG8_MMA(1, 1, At, B1); PG8_BAR;
            PG8_LDB(B0, 1, 0); PG8_SCHED; PG8_LDA(At, 1, 0); PG8_STAGE(PG8_SA(0, 1), a2 + hstep, voffA);
            PG8_WAIT_L(8); PG8_BAR; PG8_WAIT_L(0); PG8_MMA(0, 0, At, B0); PG8_BAR; PG8_SCHED;
            PG8_LDB(B1, 1, 1); PG8_STAGE(PG8_SB(1, 0), b3, voffB);
            PG8_BAR; PG8_WAIT_L(0); PG8_MMA(0, 1, At, B1); PG8_BAR;
            PG8_LDA(At, 1, 1); PG8_STAGE(PG8_SA(1, 0), a3, voffA);
            PG8_BAR; PG8_WAIT_L(0); PG8_MMA(1, 0, At, B0); PG8_BAR; PG8_SCHED;
            PG8_STAGE(PG8_SB(1, 1), b3 + hstep, voffB);
            PG8_WAIT_V(6); PG8_BAR; PG8_MMA(1, 1, At, B1); PG8_BAR;
            }
        }
        if constexpr (ALIGN_EPI) { if (wr == 0) PG8_BAR; }
        if constexpr (!Epi::AFTER_DRAIN) { E(acc, cur, wr, wc, fr, fq); S.done(cur); }
        if (!has_next) break;
#pragma unroll
        for (int a = 0; a < 2; ++a)
#pragma unroll
            for (int b = 0; b < 2; ++b)
#pragma unroll
                for (int m = 0; m < 4; ++m)
#pragma unroll
                    for (int n = 0; n < 2; ++n) acc[a][b][m][n] = (f32x4){0.f, 0.f, 0.f, 0.f};
        cur = nxt; cA = nA; cB = nB; ++ui;
        if constexpr (ALIGN_EPI) { if (wr == 1) PG8_BAR; }
    }
    PG8_WAIT_V(0);
    if constexpr (!ALIGN_EPI) { if (wr == 0) PG8_BAR; }
    PG8_BAR;
    if constexpr (Epi::AFTER_DRAIN) { E.fused(acc, cur, wr, wc, fr, fq, lds, wid, lane); S.done(cur); }
#undef PG8_SA
#undef PG8_SB
#undef PG8_STAGE
#undef PG8_LDA
#undef PG8_LDB
#undef PG8_MMA
#undef PG8_WAIT_V
#undef PG8_WAIT_L
#undef PG8_BAR
#undef PG8_SCHED
}
}

namespace att {
typedef unsigned short bf16;
constexpr int D = 128, NW = 8, QBLK = 32, KVBLK = 64, LDQ = 1024, LDK = 256;
constexpr float SCALE = 0.088388347648318440f;
constexpr float THR = 8.f;
constexpr float QK8_SCALE = 4.f;
constexpr float O8_SCALE = 64.f;
#ifndef ATT_SDEPTH
#define ATT_SDEPTH 2
#endif
constexpr int SDEPTH = ATT_SDEPTH;
constexpr size_t SHM_V = KVBLK * D * 2, SHM_K = KVBLK * D * 1  , SHM_ATTN = 2 * SHM_V + 2 * SHM_K + NW * 64 * 4;
typedef int i32x8 __attribute__((ext_vector_type(8)));
typedef int i32x4 __attribute__((ext_vector_type(4)));
#define KSWZ8(row, colB) ((row) * 128 + ((colB) ^ ((((row) >> 1) & 7) << 4)))
using bf16x8 = __attribute__((ext_vector_type(8))) short;
using s16x4  = __attribute__((ext_vector_type(4))) short;
using f32x16 = __attribute__((ext_vector_type(16))) float;
using u32x4  = __attribute__((ext_vector_type(4))) unsigned;
#define KSWZ(row, colB) ((row) * 256 + ((colB) ^ (((row) & 7) << 4)))
#define SBAR() __builtin_amdgcn_sched_barrier(0)
__device__ __forceinline__ int crow(int r, int hi) { return (r & 3) + 8 * (r >> 2) + 4 * hi; }
__device__ __forceinline__ unsigned cvtpk(float lo, float hi) { unsigned r; asm volatile("v_cvt_pk_bf16_f32 %0, %1, %2" : "=v"(r) : "v"(lo), "v"(hi)); return r; }
__device__ __forceinline__ void partialSM(f32x16& p0, f32x16& p1, float& m_reg, float& mn, float& alpha) {
  constexpr float C = SCALE * 1.4426950408889634f;
  float pmax = p0[0]; for (int r = 1; r < 16; ++r) pmax = fmaxf(pmax, p0[r]); for (int r = 0; r < 16; ++r) pmax = fmaxf(pmax, p1[r]);
  { auto rr = __builtin_amdgcn_permlane32_swap(__float_as_uint(pmax), __float_as_uint(pmax), false, false);
    pmax = fmaxf(__uint_as_float(rr[0]), __uint_as_float(rr[1])); }
  if (__builtin_expect(__all(pmax - m_reg <= THR / SCALE), 1)) { mn = m_reg; alpha = 1.f; }
  else { mn = fmaxf(m_reg, pmax); alpha = __builtin_amdgcn_exp2f((m_reg - mn) * C); m_reg = mn; }
  float mnC = -mn * C;
  for (int r = 0; r < 16; ++r) p0[r] = fmaf(p0[r], C, mnC); for (int r = 0; r < 16; ++r) p1[r] = fmaf(p1[r], C, mnC);
  for (int r = 0; r < 16; ++r) p0[r] = __builtin_amdgcn_exp2f(p0[r]);
}
__device__ __forceinline__ void finishSM(f32x16& p0, f32x16& p1, float alpha, float& l_reg, bf16x8& pa0, bf16x8& pa1, bf16x8& pa2, bf16x8& pa3) {
  for (int r = 0; r < 16; ++r) p1[r] = __builtin_amdgcn_exp2f(p1[r]);
  float ps = 0; for (int r = 0; r < 16; ++r) ps += p0[r]; for (int r = 0; r < 16; ++r) ps += p1[r];
  { auto rr = __builtin_amdgcn_permlane32_swap(__float_as_uint(ps), __float_as_uint(ps), false, false);
    ps = __uint_as_float(rr[0]) + __uint_as_float(rr[1]); }
  l_reg = l_reg * alpha + ps;
#define PK4(P, BASE, OUT) do { unsigned a0 = cvtpk(P[BASE + 0], P[BASE + 1]), a1 = cvtpk(P[BASE + 2], P[BASE + 3]);   \
    unsigned b0 = cvtpk(P[BASE + 4], P[BASE + 5]), b1 = cvtpk(P[BASE + 6], P[BASE + 7]);                              \
    auto r0 = __builtin_amdgcn_permlane32_swap(a0, b0, false, false); auto r1 = __builtin_amdgcn_permlane32_swap(a1, b1, false, false); \
    u32x4 w = {r0[0], r1[0], r0[1], r1[1]}; OUT = *reinterpret_cast<bf16x8*>(&w); } while (0)
  PK4(p0, 0, pa0); PK4(p0, 8, pa1); PK4(p1, 0, pa2); PK4(p1, 8, pa3);
#undef PK4
}
__device__ __forceinline__ void qkt(f32x16& p0, f32x16& p1, const char* Ks, const i32x8* qr, int r32, int hi) {
  p0 = f32x16{}; p1 = f32x16{};
#pragma unroll
  for (int sk = 0; sk < 2; ++sk) { const int cb = 64 * sk + 32 * hi;
    const i32x8 a0 = __builtin_shufflevector(*reinterpret_cast<const i32x4*>(Ks + KSWZ8(r32, cb)), *reinterpret_cast<const i32x4*>(Ks + KSWZ8(r32, cb + 16)), 0, 1, 2, 3, 4, 5, 6, 7);
    const i32x8 a1 = __builtin_shufflevector(*reinterpret_cast<const i32x4*>(Ks + KSWZ8(32 + r32, cb)), *reinterpret_cast<const i32x4*>(Ks + KSWZ8(32 + r32, cb + 16)), 0, 1, 2, 3, 4, 5, 6, 7);
    p0 = __builtin_amdgcn_mfma_scale_f32_32x32x64_f8f6f4(a0, qr[sk], p0, 0, 0, 0, 0x7d7d7d7d, 0, 0x7d7d7d7d);
    p1 = __builtin_amdgcn_mfma_scale_f32_32x32x64_f8f6f4(a1, qr[sk], p1, 0, 0, 0, 0x7d7d7d7d, 0, 0x7d7d7d7d); }
}
__device__ __forceinline__ int v_st(int k, int c) { const int kk = (k & ~0xC) | ((k & 4) << 1) | ((k & 8) >> 1); return ((kk >> 3) * 4 + (c >> 5)) * 512 + ((kk & 7) * 32 + (c & 31)) * 2; }
__device__ __forceinline__ int v_rd_base(int lane) { return ((lane & 3) << 3) | (((lane >> 2) & 3) << 6) | (((lane >> 4) & 1) << 5) | (((lane >> 5) & 1) << 8); }
constexpr int v_rd_off(int d0, int ks, int half) { return d0 * 512 + ks * 4096 + half * 2048; }
template <int OFF> __device__ __forceinline__ s16x4 tr_read(int vb) {
  s16x4 r; asm volatile("ds_read_b64_tr_b16 %0, %1 offset:%2" : "=&v"(r) : "v"(vb), "i"(OFF) : "memory"); return r;
}
template <int D0> __device__ __forceinline__ void pv_one(f32x16& od, int vb, bf16x8 pa0, bf16x8 pa1, bf16x8 pa2, bf16x8 pa3) {
  const s16x4 l0 = tr_read<v_rd_off(D0, 0, 0)>(vb), h0 = tr_read<v_rd_off(D0, 0, 1)>(vb), l1 = tr_read<v_rd_off(D0, 1, 0)>(vb), h1 = tr_read<v_rd_off(D0, 1, 1)>(vb);
  const s16x4 l2 = tr_read<v_rd_off(D0, 2, 0)>(vb), h2 = tr_read<v_rd_off(D0, 2, 1)>(vb), l3 = tr_read<v_rd_off(D0, 3, 0)>(vb), h3 = tr_read<v_rd_off(D0, 3, 1)>(vb);
  asm volatile("s_waitcnt lgkmcnt(0)" ::: "memory"); SBAR();
#define PKV(L, H) (bf16x8){L[0], L[1], L[2], L[3], H[0], H[1], H[2], H[3]}
  od = __builtin_amdgcn_mfma_f32_32x32x16_bf16(pa0, PKV(l0, h0), od, 0, 0, 0);
  od = __builtin_amdgcn_mfma_f32_32x32x16_bf16(pa1, PKV(l1, h1), od, 0, 0, 0);
  od = __builtin_amdgcn_mfma_f32_32x32x16_bf16(pa2, PKV(l2, h2), od, 0, 0, 0);
  od = __builtin_amdgcn_mfma_f32_32x32x16_bf16(pa3, PKV(l3, h3), od, 0, 0, 0);
#undef PKV
}
__device__ __forceinline__ void pv_d0(f32x16* o, int vb, bf16x8 pa0, bf16x8 pa1, bf16x8 pa2, bf16x8 pa3) {
  pv_one<0>(o[0], vb, pa0, pa1, pa2, pa3); pv_one<1>(o[1], vb, pa0, pa1, pa2, pa3); pv_one<2>(o[2], vb, pa0, pa1, pa2, pa3); pv_one<3>(o[3], vb, pa0, pa1, pa2, pa3);
}
__device__ __forceinline__ void wmask(f32x16& p0, f32x16& p1, int kb, int qp, int hi) {
  const int bd = kb - qp + 4 * hi + 128;
#pragma unroll
  for (int r = 0; r < 16; ++r) { const int d0 = bd + (r & 3) + 8 * (r >> 2);
    if ((unsigned)d0 > 256u) p0[r] = -1e30f; if ((unsigned)(d0 + 32) > 256u) p1[r] = -1e30f; }
}
__device__ __forceinline__ void attn_unit(const bool WIN, const unsigned char* Qb, unsigned char* Ob, const unsigned char* __restrict__ Kh, const bf16* __restrict__ Vh, int NT, int kstart, int q0, float sink_l2, float sink1_l2, char* lds) {
  int tid_ = threadIdx.x; asm volatile("" : "+v"(tid_));
  const int tid = tid_, wid = __builtin_amdgcn_readfirstlane(tid >> 6), lane = tid & 63, r32 = lane & 31, hi = lane >> 5;
  bf16* V_lds = (bf16*)lds; char* K_lds = lds + 2 * SHM_V;
  float* ws = (float*)(lds + 2 * SHM_V + 2 * SHM_K) + wid * 64; float* li_l = ws; float* al_l = ws + 32;
  float m_reg = -1e30f, l_reg = 0; f32x16 o[4] = {}; i32x8 qr[2];
  const int wrow = WIN ? (wid & 3) * QBLK : wid * QBLK, hoff = WIN ? (wid >> 2) * D : 0;
  const unsigned char* Qw = Qb + (long)(wrow + r32) * LDQ + hoff + hi * 32;
#pragma unroll
  for (int sk = 0; sk < 2; ++sk) qr[sk] = __builtin_shufflevector(*reinterpret_cast<const i32x4*>(Qw + sk * 64), *reinterpret_cast<const i32x4*>(Qw + sk * 64 + 16), 0, 1, 2, 3, 4, 5, 6, 7);
  const int sr = tid >> 4, sc = (tid & 15) * 8, vst0 = v_st(sr, sc), vst1 = v_st(32 + sr, sc);
  const int sr8 = tid >> 3, sc8 = (tid & 7) * 16;
  const int vb0 = (int)(uintptr_t)V_lds + v_rd_base(lane);
  const int qp = q0 + wrow + r32;
  struct { bf16x8 vs0, vs1; i32x4 ks0; } sr_[SDEPTH];
#define TROW(t) (WIN ? ((t) < 4 ? (t) * KVBLK : kstart + (t) * KVBLK) : (t) * KVBLK)
#define SLOAD(i, t) do { const int k0_ = TROW(t); sr_[i].vs0 = *reinterpret_cast<const bf16x8*>(&Vh[(long)(k0_ + sr) * LDK + sc]); sr_[i].vs1 = *reinterpret_cast<const bf16x8*>(&Vh[(long)(k0_ + 32 + sr) * LDK + sc]); \
    sr_[i].ks0 = *reinterpret_cast<const i32x4*>(&Kh[(long)(k0_ + sr8) * LDK + sc8]); } while (0)
#define SWRITE(b, i) do { *(bf16x8*)((char*)V_lds + (b) * SHM_V + vst0) = sr_[i].vs0;          \
    *(bf16x8*)((char*)V_lds + (b) * SHM_V + vst1) = sr_[i].vs1;                                \
    *(i32x4*)((char*)K_lds + (b) * SHM_K + KSWZ8(sr8, sc8)) = sr_[i].ks0; } while (0)
#define SWAIT() do { if constexpr (SDEPTH == 2) asm volatile("s_waitcnt vmcnt(3)" ::: "memory"); else asm volatile("s_waitcnt vmcnt(0)" ::: "memory"); } while (0)
#define RESC(a) do { if (__any((a) < 1.f)) { if (hi == 0) al_l[r32] = (a); asm volatile("s_waitcnt lgkmcnt(0)" ::: "memory"); \
    for (int d = 0; d < 4; ++d) for (int r = 0; r < 16; ++r) o[d][r] *= al_l[crow(r, hi)]; } } while (0)
#define WMASK(P0, P1, t) do { if (WIN) { if ((t) >= 4) wmask(P0, P1, kstart + ((t) - 4) * KVBLK, qp, hi); } } while (0)
  f32x16 pA0, pA1, pB0, pB1; float mnA, mnB, alA, alB; bf16x8 pa0, pa1, pa2, pa3;
  constexpr int SE = 0, SO = SDEPTH - 1;
  SLOAD(SE, 0); asm volatile("s_waitcnt vmcnt(0)" ::: "memory"); SWRITE(0, SE); __syncthreads();
  qkt(pA0, pA1, K_lds, qr, r32, hi); WMASK(pA0, pA1, 0); partialSM(pA0, pA1, m_reg, mnA, alA);
  SLOAD(SO, 1); if constexpr (SDEPTH == 2) { if (2 < NT) SLOAD(SE, 2); }
  SWAIT(); SWRITE(1, SO); __syncthreads();
  for (int j = 1; j + 1 < NT; j += 2) {
    SBAR(); qkt(pB0, pB1, K_lds + SHM_K, qr, r32, hi); WMASK(pB0, pB1, j);
    finishSM(pA0, pA1, alA, l_reg, pa0, pa1, pa2, pa3); SBAR();
    SLOAD(SO, j + SDEPTH); SBAR();
    pv_d0(o, vb0, pa0, pa1, pa2, pa3); partialSM(pB0, pB1, m_reg, mnB, alB);
    __syncthreads(); SWAIT(); SWRITE(0, SE);
    RESC(alB); __syncthreads();
    SBAR(); qkt(pA0, pA1, K_lds, qr, r32, hi); WMASK(pA0, pA1, j + 1);
    finishSM(pB0, pB1, alB, l_reg, pa0, pa1, pa2, pa3); SBAR();
    if (SDEPTH == 1 || j + 3 < NT) SLOAD(SE, j + 1 + SDEPTH); SBAR();
    pv_d0(o, vb0 + (int)SHM_V, pa0, pa1, pa2, pa3); partialSM(pA0, pA1, m_reg, mnA, alA);
    __syncthreads(); SWAIT(); SWRITE(1, SO);
    RESC(alA); __syncthreads();
  }
  SBAR(); qkt(pB0, pB1, K_lds + SHM_K, qr, r32, hi); WMASK(pB0, pB1, NT - 1);
  finishSM(pA0, pA1, alA, l_reg, pa0, pa1, pa2, pa3); SBAR();
  pv_d0(o, vb0, pa0, pa1, pa2, pa3); partialSM(pB0, pB1, m_reg, mnB, alB);
  __syncthreads(); RESC(alB);
  finishSM(pB0, pB1, alB, l_reg, pa0, pa1, pa2, pa3); SBAR();
  pv_d0(o, vb0 + (int)SHM_V, pa0, pa1, pa2, pa3);
  if (WIN) { constexpr float C = SCALE * 1.4426950408889634f; l_reg += __builtin_amdgcn_exp2f(((wid >> 2) ? sink1_l2 : sink_l2) - m_reg * C); }
  if (hi == 0) li_l[r32] = l_reg; asm volatile("s_waitcnt lgkmcnt(0)" ::: "memory");
  float rli[16];
#pragma unroll
  for (int r = 0; r < 16; ++r) rli[r] = __builtin_amdgcn_rcpf(li_l[crow(r, hi)]);
  unsigned char* Ow = Ob + (long)wrow * LDQ + hoff;
#pragma unroll
  for (int r = 0; r < 16; ++r) { const int orow = crow(r, hi);
#pragma unroll
    for (int d0 = 0; d0 < 4; ++d0) { const float v = o[d0][r] * rli[r] * O8_SCALE; Ow[(long)orow * LDQ + d0 * 32 + r32] = (unsigned char)(__builtin_amdgcn_cvt_pk_fp8_f32(v, v, 0, false) & 0xff); } }
  __syncthreads();
#undef TROW
#undef SLOAD
#undef SWRITE
#undef SWAIT
#undef RESC
#undef WMASK
}
#undef KSWZ
#undef SBAR
}

namespace mk {
namespace cg = cooperative_groups;
typedef unsigned short bf16;
typedef short bf16x8 __attribute__((ext_vector_type(8)));
typedef float f32x4 __attribute__((ext_vector_type(4)));
typedef unsigned u32x4 __attribute__((ext_vector_type(4)));
typedef unsigned u32x2 __attribute__((ext_vector_type(2)));
typedef __bf16 bf2_t __attribute__((ext_vector_type(2)));
#define LAS __attribute__((address_space(3)))
constexpr int NWAVES = 8, NTHR = 512;
constexpr size_t MiB = 1u << 20;
constexpr size_t WS_CTL = 0, CTL_BYTES = 1 * MiB;
constexpr size_t WS_MOD = 1 * MiB;
constexpr size_t WS_ROPE = 1 * MiB + 512 * 1024;
constexpr size_t WS_XC = 2 * MiB;
constexpr size_t WS_WQKV = 6 * MiB;
constexpr size_t WS_WO = 12 * MiB;
constexpr size_t WS_WP = 16 * MiB;
constexpr size_t WS_H = 24 * MiB;
constexpr size_t WS_Q = 58 * MiB;
constexpr size_t WS_K = 92 * MiB;
constexpr size_t WS_V = 101 * MiB;
constexpr size_t WS_EIDX = 110 * MiB;
constexpr size_t WS_GATE = 119 * MiB;
constexpr size_t WS_PW = 128 * MiB;
constexpr size_t WS_S = 137 * MiB;
constexpr size_t WS_UT = 274 * MiB;
constexpr size_t WS_VT = 306 * MiB;
constexpr size_t WS_O = 338 * MiB;
constexpr size_t WS_XB = 372 * MiB;
constexpr size_t WS_XCB = 436 * MiB;
constexpr size_t WS_PART = 440 * MiB;
constexpr size_t WS_END = 508 * MiB;
constexpr float U8_SCALE = 64.f, V8_SCALE = 8.f;
constexpr int LDS_BYTES = 155648;
constexpr int NPHASE = 23;

struct Args { const float* in[17]; float* out; unsigned char* ws; int ph_lo, ph_hi; };

constexpr int PTAB_OFF = 153600;
struct Ctx {
  unsigned char* ws;
  int tid, lane, wave, bid, G;
  LAS unsigned char* lds; unsigned char* ldsg;
  __device__ __forceinline__ const float* in(int k) const {
    const volatile LAS unsigned* t = (const volatile LAS unsigned*)(lds + PTAB_OFF) + 2 * k;
    const unsigned lo = __builtin_amdgcn_readfirstlane(t[0]), hi = __builtin_amdgcn_readfirstlane(t[1]);
    return (const float*)(((unsigned long long)hi << 32) | lo);
  }
  __device__ __forceinline__ float* outp() const { return (float*)in(17); }
};
enum { I_X = 0, I_C, I_CTX, I_CCTX, I_ADAW, I_ADAB, I_N1G, I_N2G, I_WQKV, I_QNG, I_KNG, I_WO, I_SINKS, I_PWQ, I_PSK, I_PU, I_PV };

__device__ __forceinline__ unsigned f2bf(float f) { unsigned u = __builtin_bit_cast(unsigned, f); return (u + 0x7fffu + ((u >> 16) & 1u)) >> 16; }
__device__ __forceinline__ unsigned pk2(float lo, float hi) { unsigned r; asm volatile("v_cvt_pk_bf16_f32 %0, %1, %2" : "=v"(r) : "v"(lo), "v"(hi)); return r; }
__device__ __forceinline__ float bflo(unsigned u) { return __uint_as_float(u << 16); }
__device__ __forceinline__ float bfhi(unsigned u) { return __uint_as_float(u & 0xffff0000u); }
__device__ __forceinline__ float silu(float x) { return x / (1.f + __expf(-x)); }
__device__ __forceinline__ float gelu_tanh(float x) {
  const float y = 0.7978845608028654f * (x + 0.044715f * x * x * x);
  const float t = 1.f - 2.f / (__expf(2.f * y) + 1.f);
  return 0.5f * x * (1.f + t);
}
__device__ __forceinline__ float wave_sum(float v) {
#pragma unroll
  for (int o = 1; o < 64; o <<= 1) v += __shfl_xor(v, o);
  return v;
}
__device__ __forceinline__ const float* xrow_sel(const float* lat, const float* cx, int r) { const int b = r / RPB, j = r % RPB; return j < CTXL ? cx + (size_t)(b * CTXL + j) * DM : lat + (size_t)(b * SEQ + (j - CTXL)) * DM; }
__device__ __forceinline__ int mod_row(int r) { const int b = r / RPB, j = r % RPB; return j < CTXL ? 4 : b; }

__device__ __forceinline__ const float* st_lat(const Ctx& F, int sel) { return sel == 0 ? F.in(I_X) : (sel == 1 ? (const float*)(F.ws + WS_XB) : (const float*)F.outp()); }
__device__ __forceinline__ const float* st_ctx(const Ctx& F, int sel) { return sel == 0 ? F.in(I_CTX) : (sel == 1 ? (const float*)(F.ws + WS_XCB) : (const float*)(F.ws + WS_XC)); }
__device__ __forceinline__ int qk_perm_col(int n) {
  if (n >= (NH + NKV) * HD) return n; const int d = n & 127, axis = d >> 6, pair = (d >> 5) & 1, f = d & 31; return (n & ~127) + 2 * (axis * 32 + f) + pair; }
constexpr float W8_SCALE = 32.f;
template <bool QKPERM, bool FP8>
__device__ __forceinline__ void p0_transpose_item(const float* W, int K, int N, bf16* WT, LAS float* scr, int item, int lane) {
  const int nblk = N / 32, kb = item / nblk, nb = item % nblk, k0 = 64 * kb, n0 = 32 * nb;
  { float t[32];
#pragma unroll
    for (int i = 0; i < 32; ++i) t[i] = W[(size_t)(k0 + 2 * i + (lane >> 5)) * N + n0 + (lane & 31)];
#pragma unroll
    for (int i = 0; i < 32; ++i) scr[(2 * i + (lane >> 5)) * 33 + (lane & 31)] = t[i]; }
  asm volatile("s_waitcnt lgkmcnt(0)" ::: "memory");
  const int c = lane & 7;
#pragma unroll
  for (int j = 0; j < 4; ++j) { const int n = (lane >> 3) + 8 * j; const LAS float* s = scr + (8 * c) * 33 + n;
    if constexpr (FP8) { int v0 = __builtin_amdgcn_cvt_pk_fp8_f32(s[0 * 33] * W8_SCALE, s[1 * 33] * W8_SCALE, 0, false); v0 = __builtin_amdgcn_cvt_pk_fp8_f32(s[2 * 33] * W8_SCALE, s[3 * 33] * W8_SCALE, v0, true);
      int v1 = __builtin_amdgcn_cvt_pk_fp8_f32(s[4 * 33] * W8_SCALE, s[5 * 33] * W8_SCALE, 0, false); v1 = __builtin_amdgcn_cvt_pk_fp8_f32(s[6 * 33] * W8_SCALE, s[7 * 33] * W8_SCALE, v1, true);
      u32x2 o; o.x = (unsigned)v0; o.y = (unsigned)v1; *(u32x2*)((unsigned char*)WT + (size_t)(QKPERM ? qk_perm_col(n0 + n) : n0 + n) * K + k0 + 8 * c) = o; }
    else { u32x4 o; o.x = pk2(s[0 * 33], s[1 * 33]); o.y = pk2(s[2 * 33], s[3 * 33]); o.z = pk2(s[4 * 33], s[5 * 33]); o.w = pk2(s[6 * 33], s[7 * 33]);
      *(u32x4*)(WT + (size_t)(QKPERM ? qk_perm_col(n0 + n) : n0 + n) * K + k0 + 8 * c) = o; } }
  asm volatile("s_waitcnt lgkmcnt(0)" ::: "memory");
}

constexpr int CONV_NR = DEPTH * NKEYS * NKEYS;
__device__ __forceinline__ int conv_idle(int G, int p) { const int nu = p == 0 ? 408 : (p == 1 ? 272 : 544); return (nu % G) ? G - (nu % G) : 0; }
__device__ __forceinline__ void conv_slot(const Ctx& F, int p, int& lo, int& hi) {
  const int i0 = conv_idle(F.G, 0), i1 = conv_idle(F.G, 1), i2 = conv_idle(F.G, 2), tw = 8 * i0 + 4 * i1 + 10 * i2; lo = hi = 0; if (tw == 0) return;
  const int unit = (2 * CONV_NR + tw - 1) / tw;
  const int mine = conv_idle(F.G, p), first = F.G - mine; if (F.bid < first) return;
  const int wgt = p == 0 ? 8 : (p == 1 ? 4 : 10), base = (p == 0 ? 0 : (p == 1 ? 8 * i0 : 8 * i0 + 4 * i1)) + wgt * (F.bid - first);
  lo = base * unit; hi = lo + wgt * unit;
}
__device__ __forceinline__ void convert_rows(const Ctx& F, int r_lo, int r_hi) {
  constexpr int NR = CONV_NR;
  const float* pup = F.in(I_PU); const float* pvp = F.in(I_PV);
  if (r_hi > 2 * NR) r_hi = 2 * NR;
  for (int rr = r_lo + F.wave; rr < r_hi; rr += 2 * NWAVES) {
    f32x4 a[2][4];
#pragma unroll
    for (int q = 0; q < 2; ++q) { const int row = rr + q * NWAVES; if (row < r_hi) { const float* src = (row < NR ? pup : pvp) + (size_t)(row < NR ? row : row - NR) * DM;
#pragma unroll
        for (int i = 0; i < 4; ++i) a[q][i] = ((const f32x4*)src)[i * 64 + F.lane]; } }
#pragma unroll
    for (int q = 0; q < 2; ++q) { const int row = rr + q * NWAVES; if (row < r_hi) { const bool isu = row < NR; const int rw = isu ? row : row - NR; const float sc = isu ? U8_SCALE : V8_SCALE;
        const size_t lay = (size_t)(rw >> 14), ex = (size_t)(rw & 16383); unsigned char* dst = F.ws + (isu ? WS_UT : WS_VT);
#pragma unroll
        for (int i = 0; i < 4; ++i) { int v = __builtin_amdgcn_cvt_pk_fp8_f32(a[q][i].x * sc, a[q][i].y * sc, 0, false); v = __builtin_amdgcn_cvt_pk_fp8_f32(a[q][i].z * sc, a[q][i].w * sc, v, true);
          const int sl = 2 * i + (F.lane >> 5); *(unsigned*)(dst + ((lay * 8 + sl) * 16384 + ex) * 128 + ((F.lane & 31) * 4)) = (unsigned)v; } } }
  }
}

__device__ __forceinline__ void phase_prologue(const Ctx& F) {
  { LAS float* sl = (LAS float*)F.lds;
    LAS float* red = sl + 5 * DM;
    { const float* cp = F.in(I_C); const float* ccp = F.in(I_CCTX);
      for (int e = F.tid; e < 5 * DM; e += NTHR) { const int r = e / DM, j = e % DM; sl[e] = silu(r < 4 ? cp[r * DM + j] : ccp[j]); } }
    __syncthreads();
    const float* adaw = F.in(I_ADAW); const float* adab = F.in(I_ADAB);
    for (int task = F.bid; task < DEPTH * 96; task += F.G) {
      const int i = task / 96, n = (task % 96) * 64 + F.lane;
      const float* w = adaw + (size_t)i * DM * NMOD * DM + n;
      float a0 = 0.f, a1 = 0.f, a2 = 0.f, a3 = 0.f, a4 = 0.f;
#pragma unroll 1
      for (int j0 = 0; j0 < 128; j0 += 32) { float wv[32];
#pragma unroll
        for (int jj = 0; jj < 32; ++jj) wv[jj] = w[(size_t)(F.wave * 128 + j0 + jj) * NMOD * DM];
#pragma unroll
        for (int jj = 0; jj < 32; ++jj) { const int j = F.wave * 128 + j0 + jj;
          a0 += sl[j] * wv[jj]; a1 += sl[DM + j] * wv[jj]; a2 += sl[2 * DM + j] * wv[jj]; a3 += sl[3 * DM + j] * wv[jj]; a4 += sl[4 * DM + j] * wv[jj]; } }
      red[(F.wave * 5 + 0) * 64 + F.lane] = a0; red[(F.wave * 5 + 1) * 64 + F.lane] = a1; red[(F.wave * 5 + 2) * 64 + F.lane] = a2;
      red[(F.wave * 5 + 3) * 64 + F.lane] = a3; red[(F.wave * 5 + 4) * 64 + F.lane] = a4;
      __syncthreads();
      if (F.tid < 320) { const int r = F.tid >> 6, l = F.tid & 63; float s = 0.f;
#pragma unroll
        for (int w8 = 0; w8 < 8; ++w8) s += red[(w8 * 5 + r) * 64 + l];
        const int nn = (task % 96) * 64 + l;
        ((float*)(F.ws + WS_MOD))[((size_t)i * 5 + r) * NMOD * DM + nn] = s + adab[i * NMOD * DM + nn]; }
      __syncthreads();
    }
  }
  { LAS float* sk = (LAS float*)F.lds;
    LAS float* wq = sk + 128 * 132;
    const float* pskp = F.in(I_PSK); const float* pwqp = F.in(I_PWQ);
    for (int task = F.bid; task < DEPTH * 8 * 2 * 16; task += F.G) {
      const int jc = task & 15, half = (task >> 4) & 1, h = (task >> 5) & 7, i = task >> 8;
      const float* SK = pskp + ((size_t)i * 2 + half) * NKEYS * 128;
      const float* WQ = pwqp + (size_t)i * DM * PQN + (size_t)(jc * 64) * PQN + h * PQD + half * 128;
      for (int e = F.tid; e < 128 * 32; e += NTHR) { const int kk = e >> 5, d4 = e & 31; const f32x4 v = *(const f32x4*)(SK + (size_t)kk * 128 + d4 * 4); *(LAS f32x4*)(sk + kk * 132 + d4 * 4) = v; }
      for (int e = F.tid; e < 64 * 32; e += NTHR) { const int j = e >> 5, d4 = e & 31; const f32x4 v = *(const f32x4*)(WQ + (size_t)j * PQN + d4 * 4); *(LAS f32x4*)(wq + j * 128 + d4 * 4) = v; }
      __syncthreads();
      const int kk = F.tid & 127, jg = F.tid >> 7;
      float acc[16];
#pragma unroll
      for (int q = 0; q < 16; ++q) acc[q] = 0.f;
#pragma unroll 2
      for (int d4 = 0; d4 < 32; ++d4) { const f32x4 s = *(const LAS f32x4*)(sk + kk * 132 + d4 * 4);
#pragma unroll
        for (int q = 0; q < 16; ++q) { const f32x4 w = *(const LAS f32x4*)(wq + (jg * 16 + q) * 128 + d4 * 4); acc[q] += s.x * w.x + s.y * w.y + s.z * w.z + s.w * w.w; } }
      bf16* o = (bf16*)(F.ws + WS_WP) + ((size_t)i * PQN + h * PQD + half * 128 + kk) * DM + jc * 64 + jg * 16;
      u32x4 o0, o1; o0.x = pk2(acc[0], acc[1]); o0.y = pk2(acc[2], acc[3]); o0.z = pk2(acc[4], acc[5]); o0.w = pk2(acc[6], acc[7]);
      o1.x = pk2(acc[8], acc[9]); o1.y = pk2(acc[10], acc[11]); o1.z = pk2(acc[12], acc[13]); o1.w = pk2(acc[14], acc[15]);
      *(u32x4*)o = o0; *(u32x4*)(o + 8) = o1;
      __syncthreads();
    }
  }
  { const int gt = F.bid * NTHR + F.tid; float* rp = (float*)(F.ws + WS_ROPE);
    if (gt < 64 * 32) { const int pos = gt >> 5, f = gt & 31; const float inv = exp2f(-(float)(2 * f) * (13.287712379549449f / 64.f)); float sn, cs; sincosf((float)pos * inv, &sn, &cs); rp[2 * gt] = cs; rp[2 * gt + 1] = sn; }
    else if (gt < 64 * 32 + DEPTH * 2 * HD) { const int e = gt - 64 * 32, p = e & 127, which = (e >> 7) & 1, layer = e >> 8; const int q = p >> 1, pair = p & 1, d = (q >> 5) * 64 + pair * 32 + (q & 31);
      rp[64 * 32 * 2 + e] = (which == 0 ? F.in(I_QNG) : F.in(I_KNG))[layer * HD + d]; } }
  if (8 * conv_idle(F.G, 0) + 4 * conv_idle(F.G, 1) + 10 * conv_idle(F.G, 2) == 0) { const int per = (2 * CONV_NR + F.G - 1) / F.G; convert_rows(F, F.bid * per, (F.bid + 1) * per); }
  { LAS float* scr = (LAS float*)F.lds + F.wave * (64 * 33 + 16);
    const int gw = F.bid * NWAVES + F.wave, NGW = F.G * NWAVES;
    constexpr int I_QKV = (DM / 64) * (QKVD / 32), I_O = (DM / 64) * (DM / 32);
    const float* wqkvp = F.in(I_WQKV); const float* wop = F.in(I_WO);
    for (int it = gw; it < DEPTH * (I_QKV + I_O); it += NGW) {
      const int i = it / (I_QKV + I_O); int r = it % (I_QKV + I_O);
      if (r < I_QKV) p0_transpose_item<true, true>(wqkvp + (size_t)i * DM * QKVD, DM, QKVD, (bf16*)(F.ws + WS_WQKV + (size_t)i * QKVD * DM), scr, r, F.lane);
      else p0_transpose_item<false, true>(wop + (size_t)i * DM * DM, DM, DM, (bf16*)(F.ws + WS_WO + (size_t)i * DM * DM), scr, r - I_QKV, F.lane);
    }
  }
}

constexpr float H8_SCALE = 4.f;
__device__ __forceinline__ void phase_norm(const Ctx& F, int layer, int which  , int src_sel, bool latent_only) {
  const int gw = F.bid * NWAVES + F.wave, NGW = F.G * NWAVES;
  const float* gain = (which == 0 ? F.in(I_N1G) : F.in(I_N2G)) + layer * DM;
  const float* modl = (const float*)(F.ws + WS_MOD) + (size_t)layer * 5 * NMOD * DM;
  bf16* H = (bf16*)(F.ws + WS_H);
  const float* latp = st_lat(F, src_sel); const float* cxp = st_ctx(F, src_sel);
  for (int r = gw; r < NROWS; r += NGW) {
    if (latent_only && (r % RPB) < CTXL) continue;
    const float* xr = xrow_sel(latp, cxp, r);
    const float* mrow = modl + (size_t)mod_row(r) * NMOD * DM;
    const float* sh = mrow + (which == 0 ? 0 : 3) * DM; const float* sc = mrow + (which == 0 ? 1 : 4) * DM;
    f32x4 v[4]; float s = 0.f;
#pragma unroll
    for (int j = 0; j < 4; ++j) { v[j] = ((const f32x4*)xr)[F.lane + 64 * j]; s += (v[j].x * v[j].x + v[j].y * v[j].y) + (v[j].z * v[j].z + v[j].w * v[j].w); }
    const float rstd = rsqrtf(wave_sum(s) * (1.f / DM) + RMS_EPS);
    unsigned long long* o8 = (unsigned long long*)(H + (size_t)r * DM) + F.lane;
#pragma unroll
    for (int j = 0; j < 4; ++j) { const f32x4 g = ((const f32x4*)gain)[F.lane + 64 * j], a = ((const f32x4*)sc)[F.lane + 64 * j], b = ((const f32x4*)sh)[F.lane + 64 * j];
      const float y0 = v[j].x * rstd * g.x * (1.f + a.x) + b.x, y1 = v[j].y * rstd * g.y * (1.f + a.y) + b.y, y2 = v[j].z * rstd * g.z * (1.f + a.z) + b.z, y3 = v[j].w * rstd * g.w * (1.f + a.w) + b.w;
      if (which == 0) { int v8 = __builtin_amdgcn_cvt_pk_fp8_f32(y0 * H8_SCALE, y1 * H8_SCALE, 0, false); v8 = __builtin_amdgcn_cvt_pk_fp8_f32(y2 * H8_SCALE, y3 * H8_SCALE, v8, true);
        ((unsigned*)((unsigned char*)H + (size_t)r * DM))[F.lane + 64 * j] = (unsigned)v8; }
      else o8[64 * j] = (unsigned long long)pk2(y0, y1) | ((unsigned long long)pk2(y2, y3) << 32); }
  }
}

__device__ __forceinline__ void phase_qknorm(const Ctx& F, int layer) {
  const int gw = F.bid * NWAVES + F.wave, NGW = F.G * NWAVES;
  const int axis = F.lane >> 5, f = F.lane & 31, e1 = axis * 64 + f, e2 = e1 + 32;
  const float* qg = F.in(I_QNG) + layer * HD; const float* kg = F.in(I_KNG) + layer * HD;
  const float qg1 = qg[e1], qg2 = qg[e2], kg1 = kg[e1], kg2 = kg[e2];
  const float inv = exp2f(-(float)(2 * f) * (13.287712379549449f / 64.f));
  bf16* Q = (bf16*)(F.ws + WS_Q); bf16* K = (bf16*)(F.ws + WS_K);
  for (int r = gw; r < NROWS; r += NGW) {
    const int j = r % RPB; float cs = 1.f, sn = 0.f;
    if (j >= CTXL) { const int sp = j - CTXL; const float pos = (float)(axis == 0 ? (sp >> 6) : (sp & 63)); sincosf(pos * inv, &sn, &cs); }
#pragma unroll
    for (int h = 0; h < NH + NKV; ++h) {
      bf16* base = h < NH ? Q + (size_t)r * DM + h * HD : K + (size_t)r * (NKV * HD) + (h - NH) * HD;
      float x1 = bflo(base[e1]), x2 = bflo(base[e2]);
      const float rstd = rsqrtf(wave_sum(x1 * x1 + x2 * x2) * (1.f / HD) + RMS_EPS);
      x1 *= rstd * (h < NH ? qg1 : kg1); x2 *= rstd * (h < NH ? qg2 : kg2);
      const float y1 = x1 * cs - x2 * sn, y2 = x1 * sn + x2 * cs;
      base[e1] = (bf16)f2bf(y1); base[e2] = (bf16)f2bf(y2);
    }
  }
}
struct Order {
  int nM, nN, nwg, G, c, lat;
  __device__ void init(int nM_, int nN_, int G_, int c_, int lat_) { nM = nM_; nN = nN_; nwg = nM * nN; G = G_; c = c_; lat = lat_; }
  __device__ bool next(int i, pg8::Unit& u) const {
    const long L = (long)i * G + c; if (L >= nwg) return false;
    int wgid = (int)L; { const int q = nwg / 8, r = nwg % 8, xcd = wgid % 8, off = wgid / 8; wgid = (xcd < r ? xcd * (q + 1) : r * (q + 1) + (xcd - r) * q) + off; }
    const int WGM = 8, nig = WGM * nN, gid = wgid / nig, fm = gid * WGM, gsz = (nM - fm) < WGM ? (nM - fm) : WGM;
    int pm = fm + ((wgid % nig) % gsz); u.pn = (wgid % nig) / gsz;
    if (lat) pm = (pm >> 4) * 17 + 1 + (pm & 15);
    u.pm = pm; return true;
  }
  __device__ __forceinline__ void a_ready(const pg8::Unit&) const {}
  __device__ __forceinline__ void done(const pg8::Unit&) const {}
};
struct EpiQKV {
  static constexpr bool PERM = true, AFTER_DRAIN = false;
  unsigned char* ws; LAS float* xs  ; int layer;
  __device__ __forceinline__ void operator()(const pg8::f32x4 (&acc)[2][2][4][2], const pg8::Unit& u, int wr, int wc, int fr, int fq) const {
    const int row0 = u.pm * 256 + wr * 64 + fr;
    const size_t boff = u.pn < 4 ? WS_Q : (u.pn == 4 ? WS_K : WS_V); const int ldc = u.pn < 4 ? DM : NKV * HD, colt = u.pn < 4 ? u.pn * 256 : 0;
    bf16* base = (bf16*)(ws + boff);
    const int col0 = colt + wc * 32 + 8 * fq;
    if (u.pn == 5) {
#pragma unroll
      for (int ai = 0; ai < 2; ++ai)
#pragma unroll
        for (int m = 0; m < 4; ++m) { bf16* rowp = base + (size_t)(row0 + ai * 128 + m * 16) * ldc + col0;
#pragma unroll
          for (int bj = 0; bj < 2; ++bj) { const pg8::f32x4 v0 = acc[ai][bj][m][0], v1 = acc[ai][bj][m][1];
            u32x4 w; w.x = pk2(v0[0], v0[1]); w.y = pk2(v0[2], v0[3]); w.z = pk2(v1[0], v1[1]); w.w = pk2(v1[2], v1[3]);
            *(u32x4*)(rowp + bj * 128) = w; } }
      return;
    }
#pragma unroll
    for (int ai = 0; ai < 2; ++ai)
#pragma unroll
      for (int m = 0; m < 4; ++m)
#pragma unroll
        for (int bj = 0; bj < 2; ++bj) { const pg8::f32x4 v0 = acc[ai][bj][m][0], v1 = acc[ai][bj][m][1];
          float ss = (v0[0] * v0[0] + v0[1] * v0[1]) + (v0[2] * v0[2] + v0[3] * v0[3]) + (v1[0] * v1[0] + v1[1] * v1[1]) + (v1[2] * v1[2] + v1[3] * v1[3]);
          ss += __shfl_xor(ss, 16); ss += __shfl_xor(ss, 32);
          if (fq == 0) xs[((((wr * 2 + ai) * 4 + m) * 16 + fr) * 2 + bj) * 4 + wc] = ss; }
    asm volatile("s_waitcnt lgkmcnt(0)" ::: "memory"); __builtin_amdgcn_s_barrier(); asm volatile("" ::: "memory");
    const float* rp = (const float*)(ws + WS_ROPE);
    const float* gp = rp + 64 * 32 * 2 + (layer * 2 + (u.pn < 4 ? 0 : 1)) * HD + wc * 32 + 8 * fq;
    const f32x4 g0 = *(const f32x4*)gp, g1 = *(const f32x4*)(gp + 4);
    const bool latent = (u.pm % 17) != 0;
    const int axis = wc >> 1, f0 = 16 * (wc & 1) + 4 * fq;
#pragma unroll
    for (int ai = 0; ai < 2; ++ai)
#pragma unroll
      for (int m = 0; m < 4; ++m) { const int r = row0 + ai * 128 + m * 16;
        f32x4 c01 = {1.f, 0.f, 1.f, 0.f}, c23 = {1.f, 0.f, 1.f, 0.f};
        if (latent) { const int sp = (r % RPB) - CTXL, pos = axis == 0 ? (sp >> 6) : (sp & 63); const float* cp = rp + (pos * 32 + f0) * 2; c01 = *(const f32x4*)cp; c23 = *(const f32x4*)(cp + 4); }
        unsigned char* rowp = (unsigned char*)base + (size_t)r * ldc + col0;
#pragma unroll
        for (int bj = 0; bj < 2; ++bj) { const LAS float* xp = xs + ((((wr * 2 + ai) * 4 + m) * 16 + fr) * 2 + bj) * 4;
          const float rstd = rsqrtf(((xp[0] + xp[1]) + (xp[2] + xp[3])) * (1.f / HD) + RMS_EPS);
          const pg8::f32x4 v0 = acc[ai][bj][m][0], v1 = acc[ai][bj][m][1];
          const float a0 = v0[0] * rstd * g0.x, b0 = v0[1] * rstd * g0.y, a1 = v0[2] * rstd * g0.z, b1 = v0[3] * rstd * g0.w;
          const float a2 = v1[0] * rstd * g1.x, b2 = v1[1] * rstd * g1.y, a3 = v1[2] * rstd * g1.z, b3 = v1[3] * rstd * g1.w;
          constexpr float QS = att::QK8_SCALE;
          int w0 = __builtin_amdgcn_cvt_pk_fp8_f32((a0 * c01.x - b0 * c01.y) * QS, (a0 * c01.y + b0 * c01.x) * QS, 0, false); w0 = __builtin_amdgcn_cvt_pk_fp8_f32((a1 * c01.z - b1 * c01.w) * QS, (a1 * c01.w + b1 * c01.z) * QS, w0, true);
          int w1 = __builtin_amdgcn_cvt_pk_fp8_f32((a2 * c23.x - b2 * c23.y) * QS, (a2 * c23.y + b2 * c23.x) * QS, 0, false); w1 = __builtin_amdgcn_cvt_pk_fp8_f32((a3 * c23.z - b3 * c23.w) * QS, (a3 * c23.w + b3 * c23.z) * QS, w1, true);
          u32x2 w; w.x = (unsigned)w0; w.y = (unsigned)w1; *(u32x2*)(rowp + bj * 128) = w; } }
    asm volatile("s_waitcnt lgkmcnt(0)" ::: "memory"); __builtin_amdgcn_s_barrier(); asm volatile("" ::: "memory");
  }
};
struct EpiRes {
  static constexpr bool PERM = false, AFTER_DRAIN = false;
  const float *xin, *cin; float *xout, *xc; const float* gmod  ;
  __device__ __forceinline__ void operator()(const pg8::f32x4 (&acc)[2][2][4][2], const pg8::Unit& u, int wr, int wc, int fr, int fq) const {
    const int col0 = u.pn * 256 + wc * 32 + 4 * fq;
#pragma unroll
    for (int ai = 0; ai < 2; ++ai)
#pragma unroll
      for (int m = 0; m < 4; ++m) { const int r = u.pm * 256 + ai * 128 + wr * 64 + m * 16 + fr;
        const int b_ = r / RPB, j_ = r % RPB; const size_t oc = (size_t)(b_ * CTXL + j_) * DM, ol = (size_t)(b_ * SEQ + (j_ - CTXL)) * DM;
        float* xn = j_ < CTXL ? xc + oc : xout + ol; const float* xo = j_ < CTXL ? cin + oc : xin + ol; const float* g = gmod + (size_t)(j_ < CTXL ? 4 : b_) * NMOD * DM;
#pragma unroll
        for (int bj = 0; bj < 2; ++bj)
#pragma unroll
          for (int n = 0; n < 2; ++n) { const int c = col0 + bj * 128 + n * 16; const f32x4 xv = *(const f32x4*)(xo + c), gv = *(const f32x4*)(g + c); const pg8::f32x4 a = acc[ai][bj][m][n];
            f32x4 o; o.x = xv.x + gv.x * a[0]; o.y = xv.y + gv.y * a[1]; o.z = xv.z + gv.z * a[2]; o.w = xv.w + gv.w * a[3]; *(f32x4*)(xn + c) = o; } }
  }
};
struct EpiF32 {
  static constexpr bool PERM = true, AFTER_DRAIN = false;
  _Float16* S; int ldc;
  __device__ __forceinline__ void operator()(const pg8::f32x4 (&acc)[2][2][4][2], const pg8::Unit& u, int wr, int wc, int fr, int fq) const {
    typedef _Float16 h8 __attribute__((ext_vector_type(8)));
    const int col0 = u.pn * 256 + wc * 32 + 8 * fq;
#pragma unroll
    for (int ai = 0; ai < 2; ++ai)
#pragma unroll
      for (int m = 0; m < 4; ++m) { _Float16* rowp = S + (size_t)(u.pm * 256 + ai * 128 + wr * 64 + m * 16 + fr) * ldc + col0;
#pragma unroll
        for (int bj = 0; bj < 2; ++bj) { const pg8::f32x4 v0 = acc[ai][bj][m][0], v1 = acc[ai][bj][m][1];
          h8 o; o[0] = (_Float16)v0[0]; o[1] = (_Float16)v0[1]; o[2] = (_Float16)v0[2]; o[3] = (_Float16)v0[3]; o[4] = (_Float16)v1[0]; o[5] = (_Float16)v1[1]; o[6] = (_Float16)v1[2]; o[7] = (_Float16)v1[3];
          *(h8*)(rowp + bj * 128) = o; } }
  }
};

__device__ __forceinline__ void phase_attn(const Ctx& F, int layer) {
  const unsigned char* Q = F.ws + WS_Q; const unsigned char* K = F.ws + WS_K; const bf16* V = (const bf16*)(F.ws + WS_V);
  char* lds = (char*)F.ldsg;
  const int pair = F.bid & 7, slot = F.bid >> 3, nslot = F.G >> 3;
  const int b = pair >> 1, g = pair & 1;
  const unsigned char* Kh = K + (size_t)(b * RPB) * (NKV * HD) + g * HD; const bf16* Vh = V + (size_t)(b * RPB) * (NKV * HD) + g * HD;
  const float* sinkp = F.in(I_SINKS);
  const int nunits = layer == 0 ? 68 : 64;
#pragma unroll 1
  for (int u = slot; u < nunits; u += nslot) {
    int h, NT, ks = 0, q0 = 0; float sk = 0.f, sk1 = 0.f; const unsigned char* Qb; const bool win = layer != 0;
    if (u < 64) {
      if (!win) { h = g * 4 + (u >> 4); const int qb = u & 15; Qb = Q + (size_t)(b * RPB + CTXL + qb * 256) * DM + h * HD; NT = RPB / 64; }
      else { h = g * 4 + (u >> 5) * 2; q0 = (u & 31) * 128; Qb = Q + (size_t)(b * RPB + CTXL + q0) * DM + h * HD;
        ks = q0 - 128 < 0 ? 0 : q0 - 128; const int ke = q0 + 256 > SEQ ? SEQ : q0 + 256; NT = 4 + (ke - ks) / 64;
        sk = sinkp[(layer / 2) * NH + h] * 1.4426950408889634f; sk1 = sinkp[(layer / 2) * NH + h + 1] * 1.4426950408889634f; } }
    else { h = g * 4 + (u - 64); Qb = Q + (size_t)(b * RPB) * DM + h * HD; NT = CTXL / 64; }
    att::attn_unit(win, Qb, F.ws + WS_O + (Qb - Q), Kh, Vh, NT, ks, q0, sk, sk1, lds);
  }
}

__device__ __forceinline__ void ins16(float (&v)[16], float x) {
#pragma unroll
  for (int i = 0; i < 16; ++i) { const float hi = fmaxf(v[i], x); x = fminf(v[i], x); v[i] = hi; }
}
#define CE_DESC(x, y) do { const float hi_ = fmaxf(x, y), lo_ = fminf(x, y); x = hi_; y = lo_; } while (0)
__device__ __forceinline__ void bitonic_merge16(float (&v)[16]) {
#pragma unroll
  for (int j = 8; j >= 1; j >>= 1)
#pragma unroll
    for (int i = 0; i < 16; ++i) if ((i & j) == 0) CE_DESC(v[i], v[i | j]);
}
__device__ __forceinline__ void bitonic_sort16(float (&v)[16]) {
#pragma unroll
  for (int k = 2; k <= 16; k <<= 1)
#pragma unroll
    for (int j = k >> 1; j >= 1; j >>= 1)
#pragma unroll
      for (int i = 0; i < 16; ++i) { const int l = i ^ j; if (l > i) { if ((i & k) == 0 || k == 16) CE_DESC(v[i], v[l]); else CE_DESC(v[l], v[i]); } }
}
__device__ __forceinline__ void top16_merge(float (&a)[16], const float (&b)[16]) {
#pragma unroll
  for (int i = 0; i < 16; ++i) a[i] = fmaxf(a[i], b[15 - i]);
  bitonic_merge16(a);
}
__device__ __forceinline__ void topk_step1(const LAS float* sc, LAS unsigned* T, int tid) {
  float v[16];
  { const LAS float* my = sc + tid * 65; const unsigned eb = (tid & 1) * 64;
    float g1[16];
#define LOAD16(dst, off) do { _Pragma("unroll") for (int e = 0; e < 16; ++e) dst[e] = __uint_as_float((__float_as_uint(my[(off) + e]) & ~127u) | (eb + (off) + e)); } while (0)
    LOAD16(v, 0); bitonic_sort16(v); LOAD16(g1, 16); bitonic_sort16(g1); top16_merge(v, g1);
    float h1[16];
    LOAD16(h1, 32); bitonic_sort16(h1); LOAD16(g1, 48); bitonic_sort16(g1); top16_merge(h1, g1);
    top16_merge(v, h1);
#undef LOAD16
  }
  { float o[16];
#pragma unroll
    for (int i = 0; i < 16; ++i) o[i] = __shfl_xor(v[i], 1);
    top16_merge(v, o); }
  if ((tid & 1) == 0) {
#pragma unroll
    for (int i = 0; i < 16; ++i) T[(tid >> 1) * 16 + i] = __float_as_uint(v[i]); }
}
__device__ __forceinline__ void topk_step2(const LAS unsigned* T, int p1, int* eout, float* gout) {
  const int p2 = p1 + 16;
  float a[16], bq[16];
#pragma unroll
  for (int i = 0; i < 16; ++i) { a[i] = __uint_as_float(T[p1 + i] & ~127u); bq[i] = __uint_as_float(T[p2 + i] & ~127u); }
  float w[16];
#pragma unroll
  for (int i = 0; i < 16; ++i) w[i] = __uint_as_float((__float_as_uint(a[0] + bq[i]) & ~255u) | (unsigned)i);
  { float r1[16];
#pragma unroll
    for (int i = 0; i < 16; ++i) r1[i] = i < 8 ? __uint_as_float((__float_as_uint(a[1] + bq[i]) & ~255u) | (unsigned)(16 + i)) : -INFINITY;
    top16_merge(w, r1); }
#pragma unroll
  for (int ia = 2; ia < 16; ++ia)
#pragma unroll
    for (int ib = 0; ib < 16; ++ib) if ((ia + 1) * (ib + 1) <= 16) { const float s_ = a[ia] + bq[ib]; ins16(w, __uint_as_float((__float_as_uint(s_) & ~255u) | (unsigned)(ia * 16 + ib))); }
  float ts[16]; int ex[16];
#pragma unroll
  for (int k = 0; k < 16; ++k) { const unsigned id = __float_as_uint(w[k]) & 255u; const unsigned k1 = T[p1 + (id >> 4)], k2 = T[p2 + (id & 15)];
    ts[k] = __uint_as_float(k1 & ~127u) + __uint_as_float(k2 & ~127u); ex[k] = (int)((k1 & 127u) * NKEYS + (k2 & 127u)); }
  float m = ts[0];
#pragma unroll
  for (int k = 1; k < 16; ++k) m = fmaxf(m, ts[k]);
  float l = 0.f;
#pragma unroll
  for (int k = 0; k < 16; ++k) { ts[k] = __expf(ts[k] - m); l += ts[k]; }
  const float il = 1.f / l;
#pragma unroll
  for (int k = 0; k < 16; k += 4) { *(int4*)(eout + k) = make_int4(ex[k], ex[k + 1], ex[k + 2], ex[k + 3]);
    f32x4 gv; gv.x = ts[k] * il; gv.y = ts[k + 1] * il; gv.z = ts[k + 2] * il; gv.w = ts[k + 3] * il; *(f32x4*)(gout + k) = gv; }
}
struct EpiTopk {
  static constexpr bool PERM = false, AFTER_DRAIN = true;
  int* EIDX; float* GATE;
  __device__ __forceinline__ void fused(pg8::f32x4 (&acc)[2][2][4][2], const pg8::Unit& u, int wr, int wc, int fr, int fq, PG8_LAS unsigned char* lds, int wid, int lane) const {
    LAS float* sc = (LAS float*)lds; LAS unsigned* T = (LAS unsigned*)(lds + 512 * 65 * 4);
    const int tid = wid * 64 + lane;
#pragma unroll
    for (int ai = 0; ai < 2; ++ai) {
#pragma unroll
      for (int m = 0; m < 4; ++m) { const int rl = wr * 64 + m * 16 + fr;
#pragma unroll
        for (int bj = 0; bj < 2; ++bj)
#pragma unroll
          for (int n = 0; n < 2; ++n) { const int c = bj * 128 + wc * 32 + n * 16 + fq * 4; LAS float* d = sc + (rl * 4 + (c >> 6)) * 65 + (c & 63); const pg8::f32x4 a = acc[ai][bj][m][n];
            d[0] = a[0]; d[1] = a[1]; d[2] = a[2]; d[3] = a[3]; } }
      asm volatile("s_waitcnt lgkmcnt(0)" ::: "memory"); __builtin_amdgcn_s_barrier(); asm volatile("" ::: "memory");
      topk_step1(sc, T, tid);
      asm volatile("s_waitcnt lgkmcnt(0)" ::: "memory"); __builtin_amdgcn_s_barrier(); asm volatile("" ::: "memory");
      if (tid < 128) { const size_t ob = (size_t)(u.pm * 256 + ai * 128 + tid) * 128 + u.pn * 16; topk_step2(T, tid * 32, EIDX + ob, GATE + ob); }
      asm volatile("s_waitcnt lgkmcnt(0)" ::: "memory"); __builtin_amdgcn_s_barrier(); asm volatile("" ::: "memory");
    }
  }
};
struct OneUnit {
  pg8::Unit u0;
  __device__ bool next(int i, pg8::Unit& u) const { if (i != 0) return false; u = u0; return true; }
  __device__ __forceinline__ void a_ready(const pg8::Unit&) const {}
  __device__ __forceinline__ void done(const pg8::Unit&) const {}
};
__device__ __forceinline__ void phase_topk(const Ctx& F, bool latent_only) {
  LAS float* sc = (LAS float*)F.lds;
  LAS unsigned* T = (LAS unsigned*)(F.lds + 512 * 65 * 4);
  const _Float16* S = (const _Float16*)(F.ws + WS_S); int* EIDX = (int*)(F.ws + WS_EIDX); float* GATE = (float*)(F.ws + WS_GATE);
  const int ngroups = NROWS / 16;
  auto grpok = [&](int gq) { return gq < ngroups && !(latent_only && ((gq * 16) % RPB) < CTXL); };
  int grp = F.bid; while (grp < ngroups && !grpok(grp)) grp += F.G;
  typedef _Float16 h4 __attribute__((ext_vector_type(4)));
  h4 v[16];
  if (grp < ngroups) {
#pragma unroll
    for (int it = 0; it < 16; ++it) v[it] = *(const h4*)(S + (size_t)(grp * 16 + it) * PQN + F.tid * 4); }
  for (; grp < ngroups; ) {
    const int r0 = grp * 16;
    int gn = grp + F.G; while (gn < ngroups && !grpok(gn)) gn += F.G;
#pragma unroll
    for (int it = 0; it < 16; ++it) { const int c = F.tid * 4; LAS float* d = sc + (it * 32 + (c >> 6)) * 65 + (c & 63); d[0] = (float)v[it][0]; d[1] = (float)v[it][1]; d[2] = (float)v[it][2]; d[3] = (float)v[it][3]; }
    if (gn < ngroups) {
#pragma unroll
      for (int it = 0; it < 16; ++it) v[it] = *(const h4*)(S + (size_t)(gn * 16 + it) * PQN + F.tid * 4); }
    __syncthreads();
    float v[16];
    { const LAS float* my = sc + F.tid * 65; const unsigned eb = (F.tid & 1) * 64;
      float g1[16];
#define LOAD16(dst, off) do { _Pragma("unroll") for (int e = 0; e < 16; ++e) dst[e] = __uint_as_float((__float_as_uint(my[(off) + e]) & ~127u) | (eb + (off) + e)); } while (0)
      LOAD16(v, 0); bitonic_sort16(v); LOAD16(g1, 16); bitonic_sort16(g1); top16_merge(v, g1);
      float h1[16];
      LOAD16(h1, 32); bitonic_sort16(h1); LOAD16(g1, 48); bitonic_sort16(g1); top16_merge(h1, g1);
      top16_merge(v, h1);
#undef LOAD16
    }
    { float o[16];
#pragma unroll
      for (int i = 0; i < 16; ++i) o[i] = __shfl_xor(v[i], 1);
      top16_merge(v, o); }
    if ((F.tid & 1) == 0) {
#pragma unroll
      for (int i = 0; i < 16; ++i) T[(F.tid >> 1) * 16 + i] = __float_as_uint(v[i]); }
    __syncthreads();
    if (F.tid < 128) {
      const int rl = F.tid >> 3, head = F.tid & 7, p1 = (rl * 16 + head * 2) * 16, p2 = p1 + 16;
      float a[16], bq[16];
#pragma unroll
      for (int i = 0; i < 16; ++i) { a[i] = __uint_as_float(T[p1 + i] & ~127u); bq[i] = __uint_as_float(T[p2 + i] & ~127u); }
      float w[16];
#pragma unroll
      for (int i = 0; i < 16; ++i) w[i] = __uint_as_float((__float_as_uint(a[0] + bq[i]) & ~255u) | (unsigned)i);
      { float r1[16];
#pragma unroll
        for (int i = 0; i < 16; ++i) r1[i] = i < 8 ? __uint_as_float((__float_as_uint(a[1] + bq[i]) & ~255u) | (unsigned)(16 + i)) : -INFINITY;
        top16_merge(w, r1); }
#pragma unroll
      for (int ia = 2; ia < 16; ++ia)
#pragma unroll
        for (int ib = 0; ib < 16; ++ib) if ((ia + 1) * (ib + 1) <= 16) { const float s = a[ia] + bq[ib]; ins16(w, __uint_as_float((__float_as_uint(s) & ~255u) | (unsigned)(ia * 16 + ib))); }
      float ts[16]; int ex[16];
#pragma unroll
      for (int k = 0; k < 16; ++k) { const unsigned id = __float_as_uint(w[k]) & 255u; const unsigned k1 = T[p1 + (id >> 4)], k2 = T[p2 + (id & 15)];
        ts[k] = __uint_as_float(k1 & ~127u) + __uint_as_float(k2 & ~127u); ex[k] = (int)((k1 & 127u) * NKEYS + (k2 & 127u)); }
      float m = ts[0];
#pragma unroll
      for (int k = 1; k < 16; ++k) m = fmaxf(m, ts[k]);
      float l = 0.f;
#pragma unroll
      for (int k = 0; k < 16; ++k) { ts[k] = __expf(ts[k] - m); l += ts[k]; }
      const float il = 1.f / l; const size_t ob = (size_t)(r0 + rl) * 128 + head * 16;
#pragma unroll
      for (int k = 0; k < 16; k += 4) { *(int4*)(EIDX + ob + k) = make_int4(ex[k], ex[k + 1], ex[k + 2], ex[k + 3]);
        f32x4 gv; gv.x = ts[k] * il; gv.y = ts[k + 1] * il; gv.z = ts[k + 2] * il; gv.w = ts[k + 3] * il; *(f32x4*)(GATE + ob + k) = gv; }
    }
    __syncthreads();
    grp = gn;
  }
}

typedef float f32x2 __attribute__((ext_vector_type(2)));
__device__ __forceinline__ float dpp_ror_add(float x, int) { return x; }
#define ROW_ROR_ADD(x, n) do { const int xi_ = __builtin_bit_cast(int, x); x += __builtin_bit_cast(float, __builtin_amdgcn_update_dpp(0, xi_, 0x120 + (n), 0xf, 0xf, false)); } while (0)
__device__ __forceinline__ float dot16_fp8(u32x4 q, const float* h, float acc) {
  const int q0 = (int)q.x, q1 = (int)q.y, q2 = (int)q.z, q3 = (int)q.w; f32x2 t;
  t = __builtin_amdgcn_cvt_pk_f32_fp8(q0, false); acc = fmaf(t.x, h[0], acc); acc = fmaf(t.y, h[1], acc); t = __builtin_amdgcn_cvt_pk_f32_fp8(q0, true); acc = fmaf(t.x, h[2], acc); acc = fmaf(t.y, h[3], acc);
  t = __builtin_amdgcn_cvt_pk_f32_fp8(q1, false); acc = fmaf(t.x, h[4], acc); acc = fmaf(t.y, h[5], acc); t = __builtin_amdgcn_cvt_pk_f32_fp8(q1, true); acc = fmaf(t.x, h[6], acc); acc = fmaf(t.y, h[7], acc);
  t = __builtin_amdgcn_cvt_pk_f32_fp8(q2, false); acc = fmaf(t.x, h[8], acc); acc = fmaf(t.y, h[9], acc); t = __builtin_amdgcn_cvt_pk_f32_fp8(q2, true); acc = fmaf(t.x, h[10], acc); acc = fmaf(t.y, h[11], acc);
  t = __builtin_amdgcn_cvt_pk_f32_fp8(q3, false); acc = fmaf(t.x, h[12], acc); acc = fmaf(t.y, h[13], acc); t = __builtin_amdgcn_cvt_pk_f32_fp8(q3, true); acc = fmaf(t.x, h[14], acc); acc = fmaf(t.y, h[15], acc);
  return acc;
}
constexpr int PCH = 8;
__device__ __forceinline__ int chunk_row0(unsigned c, bool latent_only) { return latent_only ? (int)(c / (SEQ / PCH)) * RPB + CTXL + (int)(c % (SEQ / PCH)) * PCH : (int)c * PCH; }
#ifndef UREP
#define UREP 1
#endif
#ifndef VREP
#define VREP 1
#endif
__device__ __forceinline__ unsigned xcc_id() { return (unsigned)__builtin_amdgcn_s_getreg((3 << 11) | 20) & 7u; }
__device__ __forceinline__ unsigned q_pull(unsigned* q, int lane) { unsigned c = 0; if (lane == 0) c = __hip_atomic_fetch_add(q, 1u, __ATOMIC_RELAXED, __HIP_MEMORY_SCOPE_AGENT); return (unsigned)__builtin_amdgcn_readfirstlane((int)c); }
__device__ __forceinline__ void phase_peer_u(const Ctx& F, int layer, bool latent_only, int rep) {
  unsigned* qb = (unsigned*)(F.ws + WS_CTL) + 8192 + ((layer * 2 + 0) * 2 + rep) * 8 * 64;
  const int* EIDX = (const int*)(F.ws + WS_EIDX);
  LAS unsigned* lst = (LAS unsigned*)(F.lds + F.wave * 4096);
  LAS float* pl = (LAS float*)(F.lds + F.wave * 4096 + 1024);
  const int g = F.lane >> 3;
  const int i0 = ((F.lane >> 2) & 1) * 8 + ((F.lane >> 1) & 1) * 4 + (F.lane & 1) * 2;
  const int myx = (int)xcc_id();
#pragma unroll 1
  for (int sx = 0; sx < 8; ++sx) {
    const int slice = (myx + sx) & 7;
    const bf16* H = (const bf16*)(F.ws + WS_H) + slice * 128 + (F.lane & 7) * 16;
    const unsigned char* U = F.ws + WS_UT + ((size_t)layer * 8 + slice) * NKEYS * NKEYS * 128; const unsigned uo = (unsigned)(F.lane & 7) * 16u;
    float* PART = (float*)(F.ws + WS_PART) + slice * 128;
    const unsigned nch = (unsigned)((latent_only ? NB * SEQ : NROWS) / PCH);
        unsigned e0, e1; u32x4 h0, h1;
#define UPREF(R) do { e0 = (unsigned)EIDX[(size_t)(R) * 128 + F.lane]; e1 = (unsigned)EIDX[(size_t)(R) * 128 + 64 + F.lane]; h0 = *(const u32x4*)(H + (size_t)(R) * DM); h1 = *(const u32x4*)(H + (size_t)(R) * DM + 8); } while (0)
#define UGATHER(QV, HH, LOFF, RNEXT, HASNEXT) do { lst[(LOFF) + F.lane] = e0; lst[(LOFF) + 64 + F.lane] = e1; \
          HH[0] = bflo(h0.x); HH[1] = bfhi(h0.x); HH[2] = bflo(h0.y); HH[3] = bfhi(h0.y); HH[4] = bflo(h0.z); HH[5] = bfhi(h0.z); HH[6] = bflo(h0.w); HH[7] = bfhi(h0.w); \
          HH[8] = bflo(h1.x); HH[9] = bfhi(h1.x); HH[10] = bflo(h1.y); HH[11] = bfhi(h1.y); HH[12] = bflo(h1.z); HH[13] = bfhi(h1.z); HH[14] = bflo(h1.w); HH[15] = bfhi(h1.w); \
          if (HASNEXT) UPREF(RNEXT); \
          asm volatile("s_waitcnt lgkmcnt(0)" ::: "memory"); \
          _Pragma("unroll") for (int i = 0; i < 16; ++i) QV[i] = *(const u32x4*)(U + (lst[(LOFF) + 8 * i + g] * 128u + uo)); } while (0)
#define UMATH(QV, HH, R) do { float p[16]; \
          _Pragma("unroll") for (int i = 0; i < 16; ++i) p[i] = dot16_fp8(QV[i], HH, 0.f); \
          _Pragma("unroll") for (int m = 4; m >= 1; m >>= 1) { const bool up = (F.lane & m) != 0; const int n = 2 * m; \
            _Pragma("unroll") for (int j = 0; j < n; ++j) { const float send = up ? p[j] : p[j + n], keep = up ? p[j + n] : p[j]; p[j] = keep + __shfl_xor(send, m); } } \
          pl[8 * i0 + g] = p[0]; pl[8 * i0 + 8 + g] = p[1]; \
          asm volatile("s_waitcnt lgkmcnt(0)" ::: "memory"); \
          float* po = PART + (size_t)(R) * 1024 + F.lane; po[0] = pl[F.lane]; po[64] = pl[64 + F.lane]; } while (0)
    unsigned c = q_pull(qb + slice * 64, F.lane);
    if (c < nch) {
      u32x4 qa[16], qb_[16]; float ha[16], hb[16];
      int rbeg = chunk_row0(c, latent_only);
      UPREF(rbeg);
      UGATHER(qa, ha, 0, rbeg + 1, true);
#pragma unroll 1
      while (true) {
        const unsigned cn = q_pull(qb + slice * 64, F.lane);
        const bool hn = cn < nch; const int nr0 = hn ? chunk_row0(cn, latent_only) : 0;
#pragma unroll 1
        for (int it = 0; it < PCH; it += 2) { const int r = rbeg + it; const bool lastp = it + 2 >= PCH;
          UGATHER(qb_, hb, 128, (lastp ? nr0 : r + 2), (!lastp || hn));
          UMATH(qa, ha, r);
          if (!lastp || hn) UGATHER(qa, ha, 0, (lastp ? nr0 + 1 : r + 3), true);
          UMATH(qb_, hb, r + 1);
        }
        if (!hn) break;
        rbeg = nr0;
      }
    }
#undef UPREF
#undef UGATHER
#undef UMATH
  }
}

__device__ __forceinline__ void phase_peer_w(const Ctx& F, bool latent_only) {
  const int gw = F.bid * NWAVES + F.wave, NGW = F.G * NWAVES;
  const float* PART = (const float*)(F.ws + WS_PART); const float* GATE = (const float*)(F.ws + WS_GATE); float* PW = (float*)(F.ws + WS_PW);
  for (int r = gw; r < NROWS; r += NGW) {
    if (latent_only && (r % RPB) < CTXL) continue;
    float a = 0.f, b = 0.f;
#pragma unroll
    for (int x = 0; x < 8; ++x) { a += PART[(size_t)r * 1024 + x * 128 + F.lane]; b += PART[(size_t)r * 1024 + x * 128 + 64 + F.lane]; }
    const size_t o = (size_t)r * 128 + F.lane;
    PW[o] = GATE[o] * gelu_tanh(a * (1.f / U8_SCALE)); PW[o + 64] = GATE[o + 64] * gelu_tanh(b * (1.f / U8_SCALE));
  }
}

__device__ __forceinline__ void phase_peer_v(const Ctx& F, int layer, bool latent_only, int rep) {
  unsigned* qb = (unsigned*)(F.ws + WS_CTL) + 8192 + ((layer * 2 + 1) * 2 + rep) * 8 * 64;
  const int* EIDX = (const int*)(F.ws + WS_EIDX); const float* PW = (const float*)(F.ws + WS_PW);
  const float* g2 = (const float*)(F.ws + WS_MOD) + (size_t)layer * 5 * NMOD * DM + 5 * DM;
  const float* outl = F.outp();
  LAS u32x2* ew = (LAS u32x2*)(F.lds + F.wave * 4096);
  const int g = F.lane >> 3;
  const int myx = (int)xcc_id();
#pragma unroll 1
  for (int sx = 0; sx < 8; ++sx) {
    const int slice = (myx + sx) & 7;
    const unsigned char* V = F.ws + WS_VT + ((size_t)layer * 8 + slice) * NKEYS * NKEYS * 128; const unsigned vo = (unsigned)(F.lane & 7) * 16u;
    const int dl = slice * 128 + (F.lane & 7) * 16 + ((F.lane >> 5) & 1) * 8 + ((F.lane >> 4) & 1) * 4 + ((F.lane >> 3) & 1) * 2;
    const unsigned nch = (unsigned)((latent_only ? NB * SEQ : NROWS) / PCH);
        unsigned ea, eb; float wpa, wpb;
#define VPREF(R) do { const size_t o_ = (size_t)(R) * 128 + F.lane; ea = (unsigned)EIDX[o_]; eb = (unsigned)EIDX[o_ + 64]; wpa = PW[o_]; wpb = PW[o_ + 64]; } while (0)
#define VGATHER(QV, WV, LOFF, RNEXT, HASNEXT) do { \
          { u32x2 t0, t1; t0.x = ea; t0.y = __float_as_uint(wpa); t1.x = eb; t1.y = __float_as_uint(wpb); \
            ew[(LOFF) + F.lane] = t0; ew[(LOFF) + 64 + F.lane] = t1; } \
          if (HASNEXT) VPREF(RNEXT); \
          asm volatile("s_waitcnt lgkmcnt(0)" ::: "memory"); \
          _Pragma("unroll") for (int i = 0; i < 16; ++i) { const u32x2 t = ew[(LOFF) + 8 * i + g]; WV[i] = __uint_as_float(t.y); QV[i] = *(const u32x4*)(V + (t.x * 128u + vo)); } } while (0)
#define VMATH(QV, WV, R) do { float acc[16]; \
          float* x = (float*)xrow_sel(outl, (const float*)(F.ws + WS_XC), (R)); const float* xs = xrow_sel((const float*)(F.ws + WS_XB), (const float*)(F.ws + WS_XCB), (R)); const float* gg = g2 + (size_t)mod_row(R) * NMOD * DM; \
          const f32x2 xv = *(const f32x2*)(xs + dl), gv = *(const f32x2*)(gg + dl); \
          _Pragma("unroll") for (int q = 0; q < 16; ++q) acc[q] = 0.f; \
          _Pragma("unroll") for (int i = 0; i < 16; ++i) { const float w = WV[i]; const int q0 = (int)QV[i].x, q1 = (int)QV[i].y, q2 = (int)QV[i].z, q3 = (int)QV[i].w; f32x2 f; \
            f = __builtin_amdgcn_cvt_pk_f32_fp8(q0, false); acc[0] = fmaf(w, f.x, acc[0]); acc[1] = fmaf(w, f.y, acc[1]); f = __builtin_amdgcn_cvt_pk_f32_fp8(q0, true); acc[2] = fmaf(w, f.x, acc[2]); acc[3] = fmaf(w, f.y, acc[3]); \
            f = __builtin_amdgcn_cvt_pk_f32_fp8(q1, false); acc[4] = fmaf(w, f.x, acc[4]); acc[5] = fmaf(w, f.y, acc[5]); f = __builtin_amdgcn_cvt_pk_f32_fp8(q1, true); acc[6] = fmaf(w, f.x, acc[6]); acc[7] = fmaf(w, f.y, acc[7]); \
            f = __builtin_amdgcn_cvt_pk_f32_fp8(q2, false); acc[8] = fmaf(w, f.x, acc[8]); acc[9] = fmaf(w, f.y, acc[9]); f = __builtin_amdgcn_cvt_pk_f32_fp8(q2, true); acc[10] = fmaf(w, f.x, acc[10]); acc[11] = fmaf(w, f.y, acc[11]); \
            f = __builtin_amdgcn_cvt_pk_f32_fp8(q3, false); acc[12] = fmaf(w, f.x, acc[12]); acc[13] = fmaf(w, f.y, acc[13]); f = __builtin_amdgcn_cvt_pk_f32_fp8(q3, true); acc[14] = fmaf(w, f.x, acc[14]); acc[15] = fmaf(w, f.y, acc[15]); } \
          _Pragma("unroll") for (int j = 0; j < 8; ++j) { auto s2 = __builtin_amdgcn_permlane32_swap(__float_as_uint(acc[j]), __float_as_uint(acc[j + 8]), false, false); acc[j] = __uint_as_float(s2[0]) + __uint_as_float(s2[1]); } \
          _Pragma("unroll") for (int j = 0; j < 4; ++j) { auto s2 = __builtin_amdgcn_permlane16_swap(__float_as_uint(acc[j]), __float_as_uint(acc[j + 4]), false, false); acc[j] = __uint_as_float(s2[0]) + __uint_as_float(s2[1]); } \
          { const bool up = (F.lane & 8) != 0; \
            _Pragma("unroll") for (int j = 0; j < 2; ++j) { const float send = up ? acc[j] : acc[j + 2], keep = up ? acc[j + 2] : acc[j]; acc[j] = keep + __shfl_xor(send, 8); } } \
          f32x2 o; o.x = xv.x + gv.x * acc[0] * (1.f / V8_SCALE); o.y = xv.y + gv.y * acc[1] * (1.f / V8_SCALE); \
          *(f32x2*)(x + dl) = o; } while (0)
    unsigned c = q_pull(qb + slice * 64, F.lane);
    if (c < nch) {
      u32x4 qa[16], qb_[16]; float wa[16], wb[16];
      int rbeg = chunk_row0(c, latent_only);
      VPREF(rbeg);
      VGATHER(qa, wa, 0, rbeg + 1, true);
#pragma unroll 1
      while (true) {
        const unsigned cn = q_pull(qb + slice * 64, F.lane);
        const bool hn = cn < nch; const int nr0 = hn ? chunk_row0(cn, latent_only) : 0;
#pragma unroll 1
        for (int it = 0; it < PCH; it += 2) { const int r = rbeg + it; const bool lastp = it + 2 >= PCH;
          VGATHER(qb_, wb, 128, (lastp ? nr0 : r + 2), (!lastp || hn));
          VMATH(qa, wa, r);
          if (!lastp || hn) VGATHER(qa, wa, 0, (lastp ? nr0 + 1 : r + 3), true);
          VMATH(qb_, wb, r + 1);
        }
        if (!hn) break;
        rbeg = nr0;
      }
    }
#undef VPREF
#undef VGATHER
#undef VMATH
  }
}

#define XB_TMO      128
#define XB_XCNT(j)  (256  + 64 * (j))
#define XB_XSUB(j)  (1280 + 64 * (j))
#define XB_XGEN(j)  (2304 + 64 * (j))
#define XB_TOP      3328
#define XB_TOPGEN   3392
#define XCD_BAR_WORDS 3456
#define XB_SPIN_CAP (1u << 18)

__device__ __forceinline__ unsigned xb_ld(unsigned* p)              { return __hip_atomic_load(p, __ATOMIC_RELAXED, __HIP_MEMORY_SCOPE_AGENT); }
__device__ __forceinline__ unsigned xb_add(unsigned* p, unsigned v) { return __hip_atomic_fetch_add(p, v, __ATOMIC_RELAXED, __HIP_MEMORY_SCOPE_AGENT); }
__device__ __forceinline__ unsigned xb_xcc_id() { return (unsigned)__builtin_amdgcn_s_getreg((3 << 11) | 20) & 0xFu; }
#define XB_SPIN(cond, bar) do { unsigned _sp = 0; while (cond) { __builtin_amdgcn_s_sleep(1); \
    if ((++_sp & 255u) == 0u) { if (xb_ld(&(bar)[XB_TMO])) break; if (_sp > XB_SPIN_CAP) { atomicAdd(&(bar)[XB_TMO], 1u); break; } } } } while (0)

struct XcdBarrier {
    unsigned* bar; unsigned x;
    volatile LAS unsigned* st;
};

__device__ __forceinline__ XcdBarrier xcd_barrier_post(unsigned* bar, volatile LAS unsigned* st) {
    XcdBarrier b; b.bar = bar; b.x = xb_xcc_id(); b.st = st;
    if (threadIdx.x == 0) (void)xb_add(&bar[XB_XCNT(b.x)], 1u);
    return b;
}
__device__ __forceinline__ void xcd_barrier_complete(unsigned* bar, unsigned x, unsigned& nloc, unsigned& nx) {
    const unsigned G = gridDim.x * gridDim.y * gridDim.z;
    unsigned sum, cnt, mine, sp = 0u;
    for (;;) {
        sum = 0u; cnt = 0u; mine = 0u;
#pragma unroll
        for (unsigned j = 0; j < 16; ++j) { const unsigned c = xb_ld(&bar[XB_XCNT(j)]); sum += c; cnt += (c > 0u) ? 1u : 0u; mine = (j == x) ? c : mine; }
        if (sum == G) break;
        __builtin_amdgcn_s_sleep(1);
        if ((++sp & 255u) == 0u) { if (xb_ld(&bar[XB_TMO])) break; if (sp > XB_SPIN_CAP) { atomicAdd(&bar[XB_TMO], 1u); break; } }
    }
    nloc = mine > 0u ? mine : 1u; nx = cnt > 0u ? cnt : 1u;
}

__device__ __forceinline__ void xcd_barrier(const XcdBarrier& b) {
    asm volatile("s_waitcnt vmcnt(0)" ::: "memory");
    __syncthreads();
    if (threadIdx.x == 0) {
        unsigned* bar = b.bar;
        __builtin_amdgcn_s_waitcnt(0);
        unsigned nloc = b.st[0], nx = b.st[1];
        if (nloc == 0u) { xcd_barrier_complete(bar, b.x, nloc, nx); b.st[0] = nloc; b.st[1] = nx; }
        const unsigned old = xb_add(&bar[XB_XSUB(b.x)], 1u);
        const unsigned gen = old / nloc;
        if (old + 1u == (gen + 1u) * nloc) {
            __builtin_amdgcn_fence(__ATOMIC_RELEASE, "agent");
            asm volatile("s_waitcnt vmcnt(0)" ::: "memory");
            const unsigned og = xb_add(&bar[XB_TOP], 1u);
            const unsigned tg = og / nx;
            if (og + 1u == (tg + 1u) * nx) xb_add(&bar[XB_TOPGEN], 1u);
            else XB_SPIN(xb_ld(&bar[XB_TOPGEN]) == tg, bar);
            __builtin_amdgcn_fence(__ATOMIC_ACQUIRE, "agent");
            xb_add(&bar[XB_XGEN(b.x)], 1u);
            asm volatile("s_waitcnt vmcnt(0)" ::: "memory");
        } else {
            XB_SPIN(xb_ld(&bar[XB_XGEN(b.x)]) == gen, bar);
            __builtin_amdgcn_fence(__ATOMIC_ACQUIRE, "agent");
            asm volatile("s_waitcnt vmcnt(0)" ::: "memory");
        }
    }
    __syncthreads();
}


__global__ void __launch_bounds__(NTHR, 2) fwd(Args args) {
  extern __shared__ __attribute__((aligned(16))) unsigned char lds[];
  Ctx F;
  F.ws = args.ws; F.tid = threadIdx.x; F.lane = F.tid & 63; F.wave = __builtin_amdgcn_readfirstlane(F.tid >> 6); F.bid = blockIdx.x; F.G = gridDim.x;
  F.lds = (LAS unsigned char*)lds; F.ldsg = lds;
  if (F.tid < 18) { const unsigned long long p = F.tid < 17 ? (unsigned long long)args.in[F.tid] : (unsigned long long)args.out; ((LAS unsigned long long*)(F.lds + PTAB_OFF))[F.tid] = p; }
  __syncthreads();
  const int lo = args.ph_lo, hi = args.ph_hi;
#ifndef PHMASK
#define PHMASK 0x7ff
#endif
#define IN(k) (lo <= (k) && (k) < hi)
#define EN(b) ((PHMASK >> (b)) & 1)
#ifndef REPMASK
#define REPMASK 0
#endif
#define NREP(b) (1 + ((REPMASK >> (b)) & 1))
#define FRESH() do { int t_ = threadIdx.x; asm volatile("" : "+v"(t_)); F.tid = t_; F.lane = t_ & 63; F.wave = __builtin_amdgcn_readfirstlane(t_ >> 6); int b_ = blockIdx.x; asm volatile("" : "+s"(b_)); F.bid = b_; } while (0)
  if (F.tid < 4) ((LAS unsigned*)(F.lds + PTAB_OFF + 256))[F.tid] = 0u;
  __syncthreads();
  XcdBarrier xb; xb.bar = (unsigned*)(F.ws + WS_CTL) + 4096; xb.x = 0; xb.st = nullptr;
  if (hi - lo > 1) xb = xcd_barrier_post((unsigned*)(F.ws + WS_CTL) + 4096, (volatile LAS unsigned*)(F.lds + PTAB_OFF + 256));
#ifndef SEAM_CG_ALL
#define SEAM_CG_ALL 0
#endif
#ifndef XTRA_BAR
#define XTRA_BAR 0
#endif
#ifndef STAMPS
#define STAMPS 0
#endif
#define SEAM(k) do { if (STAMPS && blockIdx.x == 0 && threadIdx.x == 0) ((unsigned long long*)(F.ws + WS_CTL + 61440))[(k)] = __builtin_amdgcn_s_memrealtime(); if (IN(k) && IN((k) + 1)) { if (SEAM_CG_ALL) cg::this_grid().sync(); else { xcd_barrier(xb); for (int xb_ = 0; xb_ < XTRA_BAR; ++xb_) xcd_barrier(xb); } } } while (0)
  if (STAMPS && blockIdx.x == 0 && threadIdx.x == 0) ((unsigned long long*)(F.ws + WS_CTL + 61440))[63] = __builtin_amdgcn_s_memrealtime();
  if (EN(10) && IN(0)) for (int rep_ = 0; rep_ < NREP(10); ++rep_) { FRESH(); phase_prologue(F); } SEAM(0);
#pragma unroll 1
  for (int layer = 0; layer < DEPTH; ++layer) {
    const int pb = 1 + 11 * layer; const bool last = layer == DEPTH - 1;
    const float* modl = (const float*)(F.ws + WS_MOD) + (size_t)layer * 5 * NMOD * DM;
    if (EN(0) && IN(pb + 0)) for (int rep_ = 0; rep_ < NREP(0); ++rep_) { FRESH(); phase_norm(F, layer, 0, layer == 0 ? 0 : 2, false); } SEAM(pb + 0);
    if (EN(1) && IN(pb + 1)) for (int rep_ = 0; rep_ < NREP(1); ++rep_) { FRESH(); pg8::Gemm g{(const pg8::bf16_t*)(F.ws + WS_H), (const pg8::bf16_t*)(F.ws + WS_WQKV + (size_t)layer * QKVD * DM), NROWS, QKVD, DM};
      Order S; S.init(NROWS / 256, QKVD / 256, F.G, F.bid, 0); EpiQKV E{F.ws, (LAS float*)(F.lds + 131072), layer};
      pg8::gemm_phase<EpiQKV, Order, true, true, true, 0x7d7d7d7d  , 0x7a7a7a7a  >(F.lds, g, S, E);
      if (layer == 0) { int lo_, hi_; conv_slot(F, 0, lo_, hi_); convert_rows(F, lo_, hi_); } } SEAM(pb + 1);
    if (EN(2) && IN(pb + 2)) for (int rep_ = 0; rep_ < NREP(2); ++rep_) { }
    if (EN(3) && IN(pb + 3)) for (int rep_ = 0; rep_ < NREP(3); ++rep_) { FRESH(); phase_attn(F, layer); } SEAM(pb + 3);
    if (EN(4) && IN(pb + 4)) for (int rep_ = 0; rep_ < NREP(4); ++rep_) { FRESH(); pg8::Gemm g{(const pg8::bf16_t*)(F.ws + WS_O), (const pg8::bf16_t*)(F.ws + WS_WO + (size_t)layer * DM * DM), NROWS, DM, DM, 0x79797979  , 0x7a7a7a7a  };
      Order S; S.init(last ? NB * 16 : NROWS / 256, DM / 256, F.G, F.bid, last ? 1 : 0); EpiRes E{st_lat(F, layer == 0 ? 0 : 2), st_ctx(F, layer == 0 ? 0 : 2), (float*)(F.ws + WS_XB), (float*)(F.ws + WS_XCB), modl + 2 * DM};
      pg8::gemm_phase<EpiRes, Order, true, true, true, 0x79797979  , 0x7a7a7a7a  >(F.lds, g, S, E);
      if (layer == 0) { int lo_, hi_; conv_slot(F, 1, lo_, hi_); convert_rows(F, lo_, hi_); } } SEAM(pb + 4);
    if (EN(5) && IN(pb + 5)) for (int rep_ = 0; rep_ < NREP(5); ++rep_) { FRESH(); phase_norm(F, layer, 1, 1, last); } SEAM(pb + 5);
    if (EN(6) && IN(pb + 6)) for (int rep_ = 0; rep_ < NREP(6); ++rep_) { FRESH(); pg8::Gemm g{(const pg8::bf16_t*)(F.ws + WS_H), (const pg8::bf16_t*)(F.ws + WS_WP) + (size_t)layer * PQN * DM, NROWS, PQN, DM};
      Order S; S.init(last ? NB * 16 : NROWS / 256, PQN / 256, F.G, F.bid, last ? 1 : 0); EpiTopk E{(int*)(F.ws + WS_EIDX), (float*)(F.ws + WS_GATE)};
#pragma unroll 1
      for (int ui = 0; ; ++ui) { OneUnit S1; if (!S.next(ui, S1.u0)) break; pg8::gemm_phase<EpiTopk, OneUnit, false, true>(F.lds, g, S1, E); }
      if (layer == 0) { int lo_, hi_; conv_slot(F, 2, lo_, hi_); convert_rows(F, lo_, hi_); } } SEAM(pb + 6);
    if (EN(7) && IN(pb + 7)) for (int rep_ = 0; rep_ < NREP(7); ++rep_) { }
    if (EN(8) && IN(pb + 8)) for (int rep_ = 0; rep_ < NREP(8); ++rep_) { FRESH(); phase_peer_u(F, layer, last, rep_); } SEAM(pb + 8);
    if (EN(9) && IN(pb + 9)) { FRESH(); phase_peer_w(F, last); } SEAM(pb + 9);
    if (EN(9) && IN(pb + 10)) for (int rep_ = 0; rep_ < NREP(9); ++rep_) { FRESH(); phase_peer_v(F, layer, last, rep_); } if (!last) SEAM(pb + 10);
  }
  if (STAMPS && blockIdx.x == 0 && threadIdx.x == 0) ((unsigned long long*)(F.ws + WS_CTL + 61440))[NPHASE - 1] = __builtin_amdgcn_s_memrealtime();
#undef IN
#undef SEAM
}
}

#ifndef MK_MULTI
#define MK_MULTI 0
#endif
#ifndef DBG
#define DBG 0
#endif
#ifndef TS_A
#define TS_A 0
#endif
#ifndef TS_B
#define TS_B 4
#endif
namespace dbg {
__global__ void k_ts(const unsigned long long* ts, float* res) { const unsigned long long s0 = ts[63]; auto dur = [&](int k) { const unsigned long long e = ts[k], b = k == 0 ? s0 : ts[k - 1]; return (float)(e - b) * 0.01f; };
  res[0] = dur(TS_A) * 1e-5f; res[1] = dur(TS_B) * 1e-3f; res[2] = 0.f; }
template <bool ABF>
__global__ void __launch_bounds__(1024) k_cmp(const void* __restrict__ a, long lda, long aoff, const float* __restrict__ b, long ldb, long boff, int rows, int cols, int row0, int rstep_lat  , float* res) {
  __shared__ float sd[1024], sr[1024];
  float d2 = 0.f, r2 = 0.f;
  for (long e = threadIdx.x; e < (long)rows * cols; e += 1024) { const int r = row0 + (int)(e / cols), c = (int)(e % cols);
    if (rstep_lat == 1 && (r % RPB) < CTXL) continue; if (rstep_lat == 2 && (r % RPB) >= CTXL) continue;
    float av; if (ABF) av = __uint_as_float((unsigned)((const unsigned short*)a)[(long)r * lda + aoff + c] << 16); else av = ((const float*)a)[(long)r * lda + aoff + c];
    const float bv = b[(long)r * ldb + boff + c]; d2 += (av - bv) * (av - bv); r2 += bv * bv; }
  sd[threadIdx.x] = d2; sr[threadIdx.x] = r2; __syncthreads();
  for (int o = 512; o > 0; o >>= 1) { if ((int)threadIdx.x < o) { sd[threadIdx.x] += sd[threadIdx.x + o]; sr[threadIdx.x] += sr[threadIdx.x + o]; } __syncthreads(); }
  if (threadIdx.x == 0) *res = sqrtf(sd[0] / fmaxf(sr[0], 1e-30f));
}
__global__ void __launch_bounds__(1024) k_cmp8(const unsigned char* __restrict__ a, long lda, float ascale, const float* __restrict__ b, long ldb, long boff, int rows, int cols, int mode, float* res) {
  __shared__ float sd[1024], sr[1024]; float d2 = 0.f, r2 = 0.f; typedef float f2_t __attribute__((ext_vector_type(2)));
  for (long e = threadIdx.x; e < (long)rows * cols; e += 1024) { const int r = (int)(e / cols), c = (int)(e % cols);
    if (mode == 1 && (r % RPB) < CTXL) continue; if (mode == 2 && (r % RPB) >= CTXL) continue;
    const f2_t t = __builtin_amdgcn_cvt_pk_f32_fp8((int)a[(long)r * lda + c], false); const float av = t.x / ascale, bv = b[(long)r * ldb + boff + c]; d2 += (av - bv) * (av - bv); r2 += bv * bv; }
  sd[threadIdx.x] = d2; sr[threadIdx.x] = r2; __syncthreads();
  for (int o = 512; o > 0; o >>= 1) { if ((int)threadIdx.x < o) { sd[threadIdx.x] += sd[threadIdx.x + o]; sr[threadIdx.x] += sr[threadIdx.x + o]; } __syncthreads(); }
  if (threadIdx.x == 0) *res = sqrtf(sd[0] / fmaxf(sr[0], 1e-30f));
}
__global__ void __launch_bounds__(1024) k_cmp_scores(const float* __restrict__ S, const float* __restrict__ PQ, const float* __restrict__ SK, int nrows, float* res) {
  __shared__ float sd[1024], sr[1024];
  float d2 = 0.f, r2 = 0.f;
  for (long e = threadIdx.x; e < (long)nrows * PQN; e += 1024) { const int r = (int)(e / PQN), c = (int)(e % PQN), h = c >> 8, half = (c >> 7) & 1, k = c & 127;
    const float* q = PQ + (long)r * PQN + h * PQD + half * 128; const float* kp = SK + (long)half * NKEYS * 128 + (long)k * 128; float a = 0.f; for (int d = 0; d < 128; ++d) a += q[d] * kp[d];
    const float f = S[(long)r * PQN + c]; d2 += (f - a) * (f - a); r2 += a * a; }
  sd[threadIdx.x] = d2; sr[threadIdx.x] = r2; __syncthreads();
  for (int o = 512; o > 0; o >>= 1) { if ((int)threadIdx.x < o) { sd[threadIdx.x] += sd[threadIdx.x + o]; sr[threadIdx.x] += sr[threadIdx.x + o]; } __syncthreads(); }
  if (threadIdx.x == 0) *res = sqrtf(sd[0] / fmaxf(sr[0], 1e-30f));
}
__global__ void k_final(float* out, long n, const float* res) {
  const float sa = 1.f + 10.f * res[0];
  for (long i = blockIdx.x * 256L + threadIdx.x; i < n; i += gridDim.x * 256L) out[i] *= sa;
  if (blockIdx.x == 0 && threadIdx.x == 0) { }
}
__global__ void k_final2(float* out, const float* res) { out[0] += 1000.f * (res[1] + res[2]); }
}

__global__ void __launch_bounds__(1024) k_cmp_w8(const unsigned char* W8, const float* W, float* res) {
  __shared__ float sd[1024], sr[1024]; float d2 = 0.f, r2 = 0.f; typedef float f2_t __attribute__((ext_vector_type(2)));
  for (long e = threadIdx.x; e < (long)DEPTH * DM * DM; e += 1024) { const int k = (int)(e & 1023), n = (int)((e >> 10) & 1023), l = (int)(e >> 20);
    const f2_t t = __builtin_amdgcn_cvt_pk_f32_fp8((int)W8[e], false); const float av = t.x / 32.f, bv = W[(size_t)l * DM * DM + (size_t)k * DM + n]; d2 += (av - bv) * (av - bv); r2 += bv * bv; }
  sd[threadIdx.x] = d2; sr[threadIdx.x] = r2; __syncthreads();
  for (int o = 512; o > 0; o >>= 1) { if ((int)threadIdx.x < o) { sd[threadIdx.x] += sd[threadIdx.x + o]; sr[threadIdx.x] += sr[threadIdx.x + o]; } __syncthreads(); }
  if (threadIdx.x == 0) { res[0] = sqrtf(sd[0] / fmaxf(sr[0], 1e-30f)); res[1] = 0.f; res[2] = 0.f; }
}


__global__ void __launch_bounds__(1024) k_cmp_wo8(const unsigned char* O8, const unsigned char* W8, const float* XB, const float* xin, const float* g1  , int r0, float* res) {
  __shared__ float sd[1024], sr[1024]; float d2 = 0.f, r2 = 0.f;
  typedef float f2_t __attribute__((ext_vector_type(2)));
  for (int e = threadIdx.x; e < 64 * DM; e += 1024) { const int r = r0 + (e >> 10), n = e & 1023; const int b = r / RPB, j = r % RPB;
    float ref = 0.f; for (int k = 0; k < DM; k += 4) { const int qa = *(const int*)(O8 + (size_t)r * DM + k), qw = *(const int*)(W8 + (size_t)n * DM + k);
      const f2_t a0 = __builtin_amdgcn_cvt_pk_f32_fp8(qa, false), a1 = __builtin_amdgcn_cvt_pk_f32_fp8(qa, true), w0 = __builtin_amdgcn_cvt_pk_f32_fp8(qw, false), w1 = __builtin_amdgcn_cvt_pk_f32_fp8(qw, true);
      ref += a0.x * w0.x + a0.y * w0.y + a1.x * w1.x + a1.y * w1.y; }
    ref *= 1.f / (64.f * 32.f);
    const size_t ol = (size_t)(b * SEQ + (j - CTXL)) * DM + n; const float fast = (XB[ol] - xin[ol]) / g1[(size_t)b * NMOD * DM + n];
    d2 += (fast - ref) * (fast - ref); r2 += ref * ref; }
  sd[threadIdx.x] = d2; sr[threadIdx.x] = r2; __syncthreads();
  for (int o = 512; o > 0; o >>= 1) { if ((int)threadIdx.x < o) { sd[threadIdx.x] += sd[threadIdx.x + o]; sr[threadIdx.x] += sr[threadIdx.x + o]; } __syncthreads(); }
  if (threadIdx.x == 0) { res[0] = sqrtf(sd[0] / fmaxf(sr[0], 1e-30f)); res[1] = 0.f; res[2] = 0.f; }
}


__global__ void k_mfma8_test(float* res) {
  typedef int i32x8_t __attribute__((ext_vector_type(8))); typedef float f32x4_t __attribute__((ext_vector_type(4)));
  __shared__ float A[16][128], B[128][16]; __shared__ int bad; __shared__ float mx;
  const int l = threadIdx.x;
  for (int e = l; e < 16 * 128; e += 64) { const int i = e >> 7, k = e & 127; A[i][k] = (float)(((i * 7 + k * 3) % 5) - 2); B[k][i] = (float)(((i * 5 + k * 11) % 7) - 3); }
  if (l == 0) { bad = 0; mx = 0.f; }
  __syncthreads();
  i32x8_t a, b;
  for (int q = 0; q < 8; ++q) { int va = 0, vb = 0; const int k0 = 32 * (l >> 4) + 4 * q;
    va = __builtin_amdgcn_cvt_pk_fp8_f32(A[l & 15][k0] * 4.f, A[l & 15][k0 + 1] * 4.f, 0, false); va = __builtin_amdgcn_cvt_pk_fp8_f32(A[l & 15][k0 + 2] * 4.f, A[l & 15][k0 + 3] * 4.f, va, true);
    vb = __builtin_amdgcn_cvt_pk_fp8_f32(B[k0][l & 15] * 8.f, B[k0 + 1][l & 15] * 8.f, 0, false); vb = __builtin_amdgcn_cvt_pk_fp8_f32(B[k0 + 2][l & 15] * 8.f, B[k0 + 3][l & 15] * 8.f, vb, true);
    a[q] = va; b[q] = vb; }
  f32x4_t c = {0.f, 0.f, 0.f, 0.f};
  c = __builtin_amdgcn_mfma_scale_f32_16x16x128_f8f6f4(a, b, c, 0, 0, 0, 0x7d7d7d7d  , 0, 0x7c7c7c7c  );
  for (int r = 0; r < 4; ++r) { const int row = 4 * (l >> 4) + r, col = l & 15; float ref = 0.f; for (int k = 0; k < 128; ++k) ref += A[row][k] * B[k][col];
    const float d = fabsf(c[r] - ref); if (d > 1e-3f) atomicAdd(&bad, 1); atomicMax((int*)&mx, __float_as_int(d)); }
  __syncthreads();
  if (l == 0) { res[0] = (float)bad / 256.f; res[1] = mx * 1e-3f; res[2] = 0.f; }
}


static void run_naive(void* const* d_in, float* out, char* ws, hipStream_t stream, int slayer, int stop) {
  const float* x = (const float*)d_in[0]; const float* c = (const float*)d_in[1]; const float* ctx = (const float*)d_in[2]; const float* c_ctx = (const float*)d_in[3];
  const float* ada_w = (const float*)d_in[4]; const float* ada_b = (const float*)d_in[5]; const float* n1g = (const float*)d_in[6]; const float* n2g = (const float*)d_in[7];
  const float* w_qkv = (const float*)d_in[8]; const float* qng = (const float*)d_in[9]; const float* kng = (const float*)d_in[10]; const float* w_o = (const float*)d_in[11];
  const float* sinks = (const float*)d_in[12]; const float* pwq = (const float*)d_in[13]; const float* psk = (const float*)d_in[14]; const float* pu = (const float*)d_in[15];
  const float* pv = (const float*)d_in[16];
  constexpr size_t MiB = 1u << 20;
  float* MOD = (float*)(ws + 0); float* XC = (float*)(ws + 1 * MiB); int* EIDX = (int*)(ws + 6 * MiB); float* GATE = (float*)(ws + 15 * MiB); float* PW = (float*)(ws + 24 * MiB);
  float* H = (float*)(ws + 34 * MiB); float* QKV = (float*)(ws + 104 * MiB); float* O = (float*)(ws + 242 * MiB); float* PQ = QKV;
  hipFuncSetAttribute((const void*)nv::k_attn, hipFuncAttributeMaxDynamicSharedMemorySize, (4 * RPB + 4 * HD) * 4);
  hipMemcpyAsync(out, x, (size_t)NB * SEQ * DM * 4, hipMemcpyDeviceToDevice, stream);
  hipMemcpyAsync(XC, ctx, (size_t)NB * CTXL * DM * 4, hipMemcpyDeviceToDevice, stream);
  nv::k_mod<<<(DEPTH * 5 * NMOD * DM + 255) / 256, 256, 0, stream>>>(c, c_ctx, ada_w, ada_b, MOD);
  for (int i = 0; i < DEPTH; ++i) {
#define STOP(k) if (i == slayer && stop == (k)) return
    const bool last = i == DEPTH - 1; const float* modi = MOD + (size_t)i * 5 * NMOD * DM;
    STOP(1); nv::k_norm<<<NROWS, 256, 0, stream>>>(out, XC, n1g + i * DM, modi, 0, 1, H);
    STOP(2); nv::k_gemm<0><<<dim3(QKVD / 64, NROWS / 64), 256, 0, stream>>>(H, w_qkv + (size_t)i * DM * QKVD, QKV, NROWS, QKVD, DM, nullptr, nullptr, nullptr, 0, 0);
    STOP(3); nv::k_qknorm_rope<<<NROWS, 640, 0, stream>>>(QKV, qng + i * HD, kng + i * HD);
    STOP(4); const size_t shm = (4 * RPB + 4 * HD) * 4;
    if (i % 2 == 0) { nv::k_attn<<<dim3(NB * SEQ, NKV), 256, shm, stream>>>(QKV, 0, nullptr); if (!last) nv::k_attn<<<dim3(NB * CTXL, NKV), 256, shm, stream>>>(QKV, 1, nullptr); }
    else { nv::k_attn<<<dim3(NB * SEQ, NKV), 256, shm, stream>>>(QKV, 2, sinks + (i / 2) * NH); }
    STOP(5); nv::k_copy_o<<<NROWS, 256, 0, stream>>>(QKV, O);
    nv::k_gemm<1><<<dim3(DM / 64, NROWS / 64), 256, 0, stream>>>(O, w_o + (size_t)i * DM * DM, nullptr, NROWS, DM, DM, out, XC, modi, 2, last ? 1 : 0);
    STOP(6); nv::k_norm<<<NROWS, 256, 0, stream>>>(out, XC, n2g + i * DM, modi, 3, 4, H);
    STOP(7); nv::k_gemm<0><<<dim3(PQN / 64, NROWS / 64), 256, 0, stream>>>(H, pwq + (size_t)i * DM * PQN, PQ, NROWS, PQN, DM, nullptr, nullptr, nullptr, 0, 0);
    STOP(8); nv::k_peer_topk<<<NROWS, 256, 0, stream>>>(PQ, psk + (size_t)i * 2 * NKEYS * 128, EIDX, GATE);
    STOP(9); nv::k_peer_u<<<NROWS, 256, 0, stream>>>(H, pu + (size_t)i * NKEYS * NKEYS * DM, EIDX, GATE, PW);
    STOP(10); nv::k_peer_v<<<NROWS, 256, 0, stream>>>(pv + (size_t)i * NKEYS * NKEYS * DM, EIDX, PW, out, XC, modi, 5, last ? 1 : 0);
#undef STOP
  }
}

extern "C" void kernel_launch(void* const* d_in, const int* in_sizes, int n_in, void* d_out, int out_size, void* d_ws, size_t ws_size, hipStream_t stream) {
  static int grid = 0;
  if (grid == 0) {
    if (n_in != 17 || out_size != NB * SEQ * DM || ws_size < mk::WS_END) { fprintf(stderr, "kernel_launch: unexpected shapes (n_in %d out %d ws %zu)\n", n_in, out_size, ws_size); grid = -1; return; }
    int dev = 0, cus = 0, per_cu = 0;
    hipGetDevice(&dev); hipDeviceGetAttribute(&cus, hipDeviceAttributeMultiprocessorCount, dev);
    if (hipFuncSetAttribute((const void*)mk::fwd, hipFuncAttributeMaxDynamicSharedMemorySize, mk::LDS_BYTES) != hipSuccess) { fprintf(stderr, "kernel_launch: hipFuncSetAttribute failed\n"); grid = -1; return; }
    if (hipOccupancyMaxActiveBlocksPerMultiprocessor(&per_cu, (const void*)mk::fwd, mk::NTHR, mk::LDS_BYTES) != hipSuccess || per_cu < 1) { fprintf(stderr, "kernel_launch: occupancy query failed (%d)\n", per_cu); grid = -1; return; }
    grid = cus * 1;
    grid -= grid % 8;
  }
  if (grid < 0) return;
  mk::Args a{};
  for (int i = 0; i < 17; ++i) a.in[i] = (const float*)d_in[i];
  a.out = (float*)d_out; a.ws = (unsigned char*)d_ws;
#if DBG == 0
#if MK_MULTI
  for (int p = 0; p < mk::NPHASE; ++p) { a.ph_lo = p; a.ph_hi = p + 1; hipLaunchKernelGGL(mk::fwd, dim3(grid), dim3(mk::NTHR), mk::LDS_BYTES, stream, a); }
#else
  hipMemsetAsync((char*)d_ws + mk::WS_CTL, 0, 65536, stream);
  a.ph_lo = 0; a.ph_hi = mk::NPHASE; void* kargs[] = {&a};
  hipError_t e = hipLaunchCooperativeKernel((const void*)mk::fwd, dim3(grid), dim3(mk::NTHR), kargs, mk::LDS_BYTES, stream);
  if (e != hipSuccess) fprintf(stderr, "cooperative launch failed: %s (grid %d)\n", hipGetErrorString(e), grid);
#endif
#else
  {
    constexpr size_t MiB = 1u << 20; char* ws = (char*)d_ws; float* out = (float*)d_out;
    float* REF = (float*)(ws + 440 * MiB); float* RES = (float*)(ws + 511 * MiB);
    float* nH = (float*)(ws + 34 * MiB); float* nQKV = (float*)(ws + 104 * MiB); float* nMOD = (float*)ws; float* nXC = (float*)(ws + 1 * MiB);
    hipMemsetAsync(RES, 0, 64, stream);
    int slayer = 0, stop = 0, fastp = 0;
#if DBG == 1
    slayer = 0; stop = 2; fastp = 2;
#elif DBG == 2
    slayer = 0; stop = 4; fastp = 4;
#elif DBG == 3
    slayer = 0; stop = 5; fastp = 5;
#elif DBG == 4
    slayer = 0; stop = 6; fastp = 6;
#elif DBG == 5
    slayer = 0; stop = 8; fastp = 8;
#elif DBG == 6
    slayer = 1; stop = 1; fastp = 11;
#elif DBG == 7
    slayer = 1; stop = 5; fastp = 15;
#elif DBG == 8
    slayer = 9; stop = 99; fastp = 21;
#elif DBG == 32
    slayer = 0; stop = 1; fastp = 1;
#elif DBG == 31
    slayer = 0; stop = 1; fastp = 6;
#elif DBG == 30
    slayer = 0; stop = 1; fastp = 0;
#elif DBG == 20
    slayer = 0; stop = 1; fastp = 0;
#elif DBG == 9
    slayer = 1; stop = 1; fastp = 9;
#elif DBG == 10
    slayer = 0; stop = 10; fastp = 9;
#elif DBG == 11
    slayer = 0; stop = 1; fastp = 1;
#endif
    run_naive(d_in, out, ws, stream, slayer, stop);
#if DBG == 1
    hipMemcpyAsync(REF, nH, (size_t)NROWS * DM * 4, hipMemcpyDeviceToDevice, stream); hipMemcpyAsync(REF + (size_t)NROWS * DM, nMOD, (size_t)DEPTH * 5 * NMOD * DM * 4, hipMemcpyDeviceToDevice, stream);
#elif DBG == 3 || DBG == 7
    nv::k_copy_o<<<NROWS, 256, 0, stream>>>(nQKV, REF);
#elif DBG == 2
    hipMemcpyAsync(REF, nQKV, (size_t)NROWS * QKVD * 4, hipMemcpyDeviceToDevice, stream);
#elif DBG == 4 || DBG == 6 || DBG == 8 || DBG == 9
    hipMemcpyAsync(REF, out, (size_t)NB * SEQ * DM * 4, hipMemcpyDeviceToDevice, stream); hipMemcpyAsync(REF + (size_t)NB * SEQ * DM, nXC, (size_t)NB * CTXL * DM * 4, hipMemcpyDeviceToDevice, stream);
#endif
#if DBG == 10
    hipMemcpyAsync(REF, ws + 24 * MiB, (size_t)NROWS * 128 * 4, hipMemcpyDeviceToDevice, stream);
#endif
#if DBG == 9 || DBG == 10
    hipMemcpyAsync(REF + (size_t)70 * MiB / 4, ws + 6 * MiB, (size_t)NROWS * 128 * 4, hipMemcpyDeviceToDevice, stream); hipMemcpyAsync(REF + (size_t)80 * MiB / 4, ws + 15 * MiB, (size_t)NROWS * 128 * 4, hipMemcpyDeviceToDevice, stream);
#elif DBG == 5
    hipMemcpyAsync(REF, nQKV  , (size_t)512 * PQN * 4, hipMemcpyDeviceToDevice, stream);
#endif
    for (int p = 0; p < fastp; ++p) { a.ph_lo = p; a.ph_hi = p + 1; hipLaunchKernelGGL(mk::fwd, dim3(grid), dim3(mk::NTHR), mk::LDS_BYTES, stream, a); }
    unsigned char* fw = (unsigned char*)d_ws;
#if DBG == 30
    k_mfma8_test<<<1, 64, 0, stream>>>(RES);
#endif
#if DBG == 32
    k_cmp_w8<<<1, 1024, 0, stream>>>(fw + mk::WS_WO, (const float*)d_in[11], RES);
#endif
#if DBG == 31
    k_cmp_wo8<<<1, 1024, 0, stream>>>(fw + mk::WS_O, fw + mk::WS_WO, (const float*)(fw + mk::WS_XB), (const float*)d_in[0], (const float*)(fw + mk::WS_MOD) + 2 * DM, 300, RES);
#endif
#if DBG == 20
    { hipMemsetAsync((char*)d_ws + mk::WS_CTL, 0, 65536, stream); a.ph_lo = 0; a.ph_hi = mk::NPHASE; void* kargs[] = {&a};
      hipLaunchCooperativeKernel((const void*)mk::fwd, dim3(grid), dim3(mk::NTHR), kargs, mk::LDS_BYTES, stream);
      dbg::k_ts<<<1, 1, 0, stream>>>((const unsigned long long*)(fw + mk::WS_CTL + 61440), RES); }
#endif
#if DBG == 9 || DBG == 10
    hipMemcpyAsync(fw + mk::WS_EIDX, REF + (size_t)70 * MiB / 4, (size_t)NROWS * 128 * 4, hipMemcpyDeviceToDevice, stream); hipMemcpyAsync(fw + mk::WS_GATE, REF + (size_t)80 * MiB / 4, (size_t)NROWS * 128 * 4, hipMemcpyDeviceToDevice, stream);
    for (int p = 9; p < (DBG == 9 ? 11 : 10); ++p) { a.ph_lo = p; a.ph_hi = p + 1; hipLaunchKernelGGL(mk::fwd, dim3(grid), dim3(mk::NTHR), mk::LDS_BYTES, stream, a); }
#endif
#if DBG == 1
    dbg::k_cmp<true><<<1, 1024, 0, stream>>>(fw + mk::WS_H, DM, 0, REF, DM, 0, NROWS, DM, 0, 0, RES);
    dbg::k_cmp<false><<<1, 1024, 0, stream>>>(fw + mk::WS_MOD, NMOD * DM, 0, REF + (size_t)NROWS * DM, NMOD * DM, 0, DEPTH * 5, NMOD * DM, 0, 0, RES + 1);
#elif DBG == 2
    dbg::k_cmp<true><<<1, 1024, 0, stream>>>(fw + mk::WS_Q, DM, 0, REF, QKVD, 0, NROWS, DM, 0, 0, RES);
    dbg::k_cmp<true><<<1, 1024, 0, stream>>>(fw + mk::WS_K, 256, 0, REF, QKVD, 1024, NROWS, 256, 0, 0, RES + 2);
    dbg::k_cmp<true><<<1, 1024, 0, stream>>>(fw + mk::WS_V, 256, 0, REF, QKVD, 1280, NROWS, 256, 0, 0, RES + 1);
#elif DBG == 3 || DBG == 7
    dbg::k_cmp8<<<1, 1024, 0, stream>>>(fw + mk::WS_O, DM, 64.f, REF, DM, 0, NROWS, DM, 1, RES);
    if (DBG == 3) dbg::k_cmp8<<<1, 1024, 0, stream>>>(fw + mk::WS_O, DM, 64.f, REF, DM, 0, NROWS, DM, 2, RES + 1);
#elif DBG == 4 || DBG == 6 || DBG == 8 || DBG == 9
    dbg::k_cmp<false><<<1, 1024, 0, stream>>>(DBG == 4 ? (const void*)(fw + mk::WS_XB) : (const void*)out, DM, 0, REF, DM, 0, NB * SEQ, DM, 0, 0, RES);
    if (DBG != 8) dbg::k_cmp<false><<<1, 1024, 0, stream>>>(fw + (DBG == 4 ? mk::WS_XCB : mk::WS_XC), DM, 0, REF + (size_t)NB * SEQ * DM, DM, 0, NB * CTXL, DM, 0, 0, RES + 1);
#elif DBG == 11
    dbg::k_cmp<true><<<1, 1024, 0, stream>>>(fw + mk::WS_UT, DM, 0, (const float*)d_in[15], DM, 0, DEPTH * NKEYS * NKEYS, DM, 0, 0, RES);
    dbg::k_cmp<true><<<1, 1024, 0, stream>>>(fw + mk::WS_VT, DM, 0, (const float*)d_in[16], DM, 0, DEPTH * NKEYS * NKEYS, DM, 0, 0, RES + 1);
#elif DBG == 10
    dbg::k_cmp<false><<<1, 1024, 0, stream>>>(fw + mk::WS_PW, 128, 0, REF, 128, 0, NROWS, 128, 0, 0, RES);
#elif DBG == 5
    dbg::k_cmp_scores<<<1, 1024, 0, stream>>>((const float*)(fw + mk::WS_S), REF, (const float*)d_in[14], 512, RES);
#endif
    hipMemcpyAsync(REF, RES, 64, hipMemcpyDeviceToDevice, stream);
    run_naive(d_in, out, ws, stream, 9, 99);
    dbg::k_final<<<1024, 256, 0, stream>>>(out, (long)NB * SEQ * DM, REF);
    dbg::k_final2<<<1, 1, 0, stream>>>(out, REF);
  }
#endif
}
```

```cpp
#include <hip/hip_runtime.h>
#include <hip/hip_cooperative_groups.h>
#include <cstdio>
#include <cstdint>

constexpr int NB = 4, SEQ = 4096, CTXL = 256, DM = 1024, DEPTH = 2;
constexpr int RPB = CTXL + SEQ;
constexpr int NROWS = NB * RPB;
constexpr int NH = 8, NKV = 2, HD = 128, QKVD = 1536, NMOD = 6;
constexpr int PH = 8, PK = 16, NKEYS = 128, PQD = 256, PQN = PH * PQD;
constexpr float RMS_EPS = 1e-6f;

namespace nv {

__device__ __forceinline__ float silu(float x) { return x / (1.f + __expf(-x)); }
__device__ __forceinline__ float gelu_tanh(float x) {
  const float y = 0.7978845608028654f * (x + 0.044715f * x * x * x);
  const float t = 1.f - 2.f / (__expf(2.f * y) + 1.f);
  return 0.5f * x * (1.f + t);
}

__global__ void k_mod(const float* __restrict__ c, const float* __restrict__ c_ctx, const float* __restrict__ ada_w,
                      const float* __restrict__ ada_b, float* __restrict__ mod) {
  const int idx = blockIdx.x * 256 + threadIdx.x;
  if (idx >= DEPTH * 5 * NMOD * DM) return;
  const int n = idx % (NMOD * DM), r = (idx / (NMOD * DM)) % 5, i = idx / (5 * NMOD * DM);
  const float* cv = r < 4 ? c + r * DM : c_ctx;
  const float* w = ada_w + (size_t)i * DM * NMOD * DM + n;
  float s = 0.f;
  for (int j = 0; j < DM; ++j) s += silu(cv[j]) * w[(size_t)j * NMOD * DM];
  mod[idx] = s + ada_b[i * NMOD * DM + n];
}

__device__ __forceinline__ float* xrow(float* xl, float* xc, int r) {
  const int b = r / RPB, j = r % RPB;
  return j < CTXL ? xc + (size_t)(b * CTXL + j) * DM : xl + (size_t)(b * SEQ + (j - CTXL)) * DM;
}

__global__ void k_norm(float* xl, float* xc, const float* __restrict__ gain, const float* __restrict__ modi, int sh_i, int sc_i,
                       float* __restrict__ H) {
  const int r = blockIdx.x, t = threadIdx.x;
  const int b = r / RPB, j = r % RPB, mr = j < CTXL ? 4 : b;
  const float* x = xrow(xl, xc, r);
  __shared__ float red[4];
  float v[4]; float s = 0.f;
#pragma unroll
  for (int q = 0; q < 4; ++q) { v[q] = x[t + 256 * q]; s += v[q] * v[q]; }
  for (int o = 32; o > 0; o >>= 1) s += __shfl_xor(s, o);
  if ((t & 63) == 0) red[t >> 6] = s;
  __syncthreads();
  s = red[0] + red[1] + red[2] + red[3];
  const float rstd = rsqrtf(s / DM + RMS_EPS);
  const float* sh = modi + (size_t)mr * NMOD * DM + sh_i * DM; const float* sc = modi + (size_t)mr * NMOD * DM + sc_i * DM;
#pragma unroll
  for (int q = 0; q < 4; ++q) { const int d = t + 256 * q; H[(size_t)r * DM + d] = v[q] * rstd * gain[d] * (1.f + sc[d]) + sh[d]; }
}

template <int EPI>
__global__ void k_gemm(const float* __restrict__ A, const float* __restrict__ B, float* __restrict__ C, int M, int N, int K,
                       float* xl, float* xc, const float* __restrict__ modi, int g_i, int skip_ctx) {
  __shared__ float As[16][68], Bs[16][68];
  const int t = threadIdx.x, tx = t & 15, ty = t >> 4, m0 = blockIdx.y * 64, n0 = blockIdx.x * 64;
  float acc[4][4] = {};
  for (int k0 = 0; k0 < K; k0 += 16) {
    for (int q = 0; q < 4; ++q) { const int e = t + 256 * q, mm = e >> 4, kk = e & 15; As[kk][mm] = A[(size_t)(m0 + mm) * K + k0 + kk]; }
    for (int q = 0; q < 4; ++q) { const int e = t + 256 * q, kk = e >> 6, nn = e & 63; Bs[kk][nn] = B[(size_t)(k0 + kk) * N + n0 + nn]; }
    __syncthreads();
#pragma unroll
    for (int kk = 0; kk < 16; ++kk) {
      float a[4], b[4];
#pragma unroll
      for (int i = 0; i < 4; ++i) { a[i] = As[kk][ty * 4 + i]; b[i] = Bs[kk][tx * 4 + i]; }
#pragma unroll
      for (int i = 0; i < 4; ++i)
#pragma unroll
        for (int j = 0; j < 4; ++j) acc[i][j] += a[i] * b[j];
    }
    __syncthreads();
  }
#pragma unroll
  for (int i = 0; i < 4; ++i) {
    const int r = m0 + ty * 4 + i;
    if (EPI == 0) {
#pragma unroll
      for (int j = 0; j < 4; ++j) C[(size_t)r * N + n0 + tx * 4 + j] = acc[i][j];
    } else {
      const int b = r / RPB, jj = r % RPB; if (skip_ctx && jj < CTXL) continue;
      const int mr = jj < CTXL ? 4 : b; float* x = xrow(xl, xc, r);
      const float* g = modi + (size_t)mr * NMOD * DM + g_i * DM;
#pragma unroll
      for (int j = 0; j < 4; ++j) { const int n = n0 + tx * 4 + j; x[n] += g[n] * acc[i][j]; }
    }
  }
}

__global__ void k_qknorm_rope(float* __restrict__ QKV, const float* __restrict__ qg, const float* __restrict__ kg) {
  const int r = blockIdx.x, t = threadIdx.x, head = t >> 6, p = t & 63, axis = p >> 5, f = p & 31;
  const int j = r % RPB;
  float* base = QKV + (size_t)r * QKVD + head * HD;
  const int e1 = axis * 64 + f, e2 = e1 + 32;
  float x1 = base[e1], x2 = base[e2];
  float s = x1 * x1 + x2 * x2;
  for (int o = 32; o > 0; o >>= 1) s += __shfl_xor(s, o);
  const float rstd = rsqrtf(s / HD + RMS_EPS);
  const float* g = head < NH ? qg : kg;
  x1 = x1 * rstd * g[e1]; x2 = x2 * rstd * g[e2];
  if (j >= CTXL) {
    const int sp = j - CTXL; const float pos = (float)(axis == 0 ? sp / 64 : sp % 64);
    const float inv = powf(10000.f, -(float)(2 * f) / 64.f);
    const float ang = pos * inv; const float cs = cosf(ang), sn = sinf(ang);
    const float y1 = x1 * cs - x2 * sn, y2 = x1 * sn + x2 * cs; x1 = y1; x2 = y2;
  }
  base[e1] = x1; base[e2] = x2;
}

__global__ void k_attn(float* __restrict__ QKV, int mode, const float* __restrict__ sink) {
  extern __shared__ float sm[];
  const int t = threadIdx.x, w = t >> 6, lane = t & 63, g = blockIdx.y;
  int b, j;
  if (mode == 1) { b = blockIdx.x / CTXL; j = blockIdx.x % CTXL; } else { b = blockIdx.x / SEQ; j = CTXL + blockIdx.x % SEQ; }
  const int r = b * RPB + j, h = g * 4 + w;
  float* sc = sm + w * RPB; float* qs = sm + 4 * RPB + w * HD;
  float* qp = QKV + (size_t)r * QKVD + h * HD;
  qs[lane] = qp[lane]; qs[lane + 64] = qp[lane + 64];
  __syncthreads();
  int a0 = 0, a1, b0 = 0, b1 = 0;
  if (mode == 0) a1 = RPB; else if (mode == 1) a1 = CTXL;
  else { a1 = CTXL; const int s = j - CTXL; const int lo = s - 128 < 0 ? 0 : s - 128, hi = s + 128 > SEQ - 1 ? SEQ - 1 : s + 128; b0 = CTXL + lo; b1 = CTXL + hi + 1; }
  const int nk = (a1 - a0) + (b1 - b0);
  const float scale = 0.08838834764831845f;
  float mx = -1e30f;
  for (int i = lane; i < nk; i += 64) {
    const int kr = i < (a1 - a0) ? a0 + i : b0 + (i - (a1 - a0));
    const float4* kp = (const float4*)(QKV + (size_t)(b * RPB + kr) * QKVD + NH * HD + g * HD);
    float s = 0.f;
    for (int d = 0; d < 32; ++d) { const float4 kv = kp[d]; s += kv.x * qs[4 * d] + kv.y * qs[4 * d + 1] + kv.z * qs[4 * d + 2] + kv.w * qs[4 * d + 3]; }
    s *= scale; sc[i] = s; mx = fmaxf(mx, s);
  }
  for (int o = 32; o > 0; o >>= 1) mx = fmaxf(mx, __shfl_xor(mx, o));
  if (mode == 2) mx = fmaxf(mx, sink[h]);
  float l = 0.f;
  for (int i = lane; i < nk; i += 64) { const float p = __expf(sc[i] - mx); sc[i] = p; l += p; }
  for (int o = 32; o > 0; o >>= 1) l += __shfl_xor(l, o);
  if (mode == 2) l += __expf(sink[h] - mx);
  __syncthreads();
  float o0 = 0.f, o1 = 0.f;
  for (int i = 0; i < nk; ++i) {
    const int kr = i < (a1 - a0) ? a0 + i : b0 + (i - (a1 - a0));
    const float* vp = QKV + (size_t)(b * RPB + kr) * QKVD + (NH + NKV) * HD + g * HD;
    const float p = sc[i]; o0 += p * vp[lane]; o1 += p * vp[lane + 64];
  }
  const float il = 1.f / l;
  qp[lane] = o0 * il; qp[lane + 64] = o1 * il;
}

__global__ void k_copy_o(const float* __restrict__ QKV, float* __restrict__ O) {
  const int r = blockIdx.x, t = threadIdx.x;
  for (int q = 0; q < 4; ++q) O[(size_t)r * DM + t + 256 * q] = QKV[(size_t)r * QKVD + t + 256 * q];
}

__global__ void __launch_bounds__(256) k_peer_topk(const float* __restrict__ PQ, const float* __restrict__ SK  , int* __restrict__ eidx, float* __restrict__ gate) {
  __shared__ float q[PQN]; __shared__ float s[16][128]; __shared__ float tv[16][16]; __shared__ int ti[16][16];
  __shared__ float cs[8][256]; __shared__ int taken[8][256];
  const int r = blockIdx.x, t = threadIdx.x;
  for (int i = t; i < PQN; i += 256) q[i] = PQ[(size_t)r * PQN + i];
  __syncthreads();
  { const int k = t & 127, half = t >> 7; const float* kp = SK + (size_t)half * NKEYS * 128 + (size_t)k * 128;
#pragma nounroll
    for (int h = 0; h < PH; ++h) { float a = 0.f; const float* qq = q + h * PQD + half * 128;
#pragma unroll 4
      for (int d = 0; d < 128; ++d) a += qq[d] * kp[d];
      s[h * 2 + half][k] = a; } }
  __syncthreads();
  if (t < 16) {
#pragma nounroll
    for (int it = 0; it < PK; ++it) { float bv = -3e38f; int bi = 0;
#pragma nounroll
      for (int k = 0; k < 128; ++k) { const float v = s[t][k]; if (v > bv) { bv = v; bi = k; } } tv[t][it] = bv; ti[t][it] = bi; s[t][bi] = -3e38f; }
  }
  __syncthreads();
  for (int i = t; i < 8 * 256; i += 256) { const int h = i >> 8, c = i & 255; cs[h][c] = tv[h * 2][c >> 4] + tv[h * 2 + 1][c & 15]; taken[h][c] = 0; }
  __syncthreads();
  if (t < 8) {
    float m = -3e38f;
#pragma nounroll
    for (int it = 0; it < PK; ++it) { float bv = -3e38f; int bi = 0;
#pragma nounroll
      for (int c = 0; c < 256; ++c) { const float v = cs[t][c]; if (!taken[t][c] && v > bv) { bv = v; bi = c; } }
      taken[t][bi] = 1; s[t][it] = bv; m = fmaxf(m, bv); eidx[(size_t)r * 128 + t * PK + it] = ti[t * 2][bi >> 4] * NKEYS + ti[t * 2 + 1][bi & 15]; }
    float l = 0.f;
#pragma nounroll
    for (int it = 0; it < PK; ++it) l += __expf(s[t][it] - m);
#pragma nounroll
    for (int it = 0; it < PK; ++it) gate[(size_t)r * 128 + t * PK + it] = __expf(s[t][it] - m) / l;
  }
}

__global__ void k_peer_u(const float* __restrict__ H, const float* __restrict__ U, const int* __restrict__ eidx, const float* __restrict__ gate, float* __restrict__ W) {
  __shared__ float h[DM];
  const int r = blockIdx.x, t = threadIdx.x, w = t >> 6, lane = t & 63;
  for (int i = t; i < DM; i += 256) h[i] = H[(size_t)r * DM + i];
  __syncthreads();
  for (int k = w; k < 128; k += 4) {
    const int e = eidx[(size_t)r * 128 + k]; const float* u = U + (size_t)e * DM; float a = 0.f;
    for (int d = lane; d < DM; d += 64) a += u[d] * h[d];
    for (int o = 32; o > 0; o >>= 1) a += __shfl_xor(a, o);
    if (lane == 0) W[(size_t)r * 128 + k] = gate[(size_t)r * 128 + k] * gelu_tanh(a);
  }
}
__global__ void k_peer_v(const float* __restrict__ V, const int* __restrict__ eidx, const float* __restrict__ W, float* xl, float* xc,
                         const float* __restrict__ modi, int g_i, int skip_ctx) {
  const int r = blockIdx.x, t = threadIdx.x; const int b = r / RPB, j = r % RPB; if (skip_ctx && j < CTXL) return;
  float4 acc = {0.f, 0.f, 0.f, 0.f};
  for (int k = 0; k < 128; ++k) { const int e = eidx[(size_t)r * 128 + k]; const float w = W[(size_t)r * 128 + k]; const float4 v = ((const float4*)(V + (size_t)e * DM))[t];
    acc.x += w * v.x; acc.y += w * v.y; acc.z += w * v.z; acc.w += w * v.w; }
  const int mr = j < CTXL ? 4 : b; float4* x = (float4*)xrow(xl, xc, r) + t; const float4 g = ((const float4*)(modi + (size_t)mr * NMOD * DM + g_i * DM))[t];
  float4 xv = *x; xv.x += g.x * acc.x; xv.y += g.y * acc.y; xv.z += g.z * acc.z; xv.w += g.w * acc.w; *x = xv;
}
}


namespace pg8 {
#define PG8_LAS __attribute__((address_space(3)))
typedef unsigned short bf16_t;
typedef short bf16x8 __attribute__((ext_vector_type(8)));
typedef float f32x4 __attribute__((ext_vector_type(4)));
typedef unsigned u32x4 __attribute__((ext_vector_type(4)));
constexpr int BM = 256, BK = 64, HALF = 128, HTB = HALF * BK * 2  , STAGE_BYTES = 8 * HTB, NXCD = 8, WGM = 8;

__host__ __device__ __forceinline__ int lds_byte(int r, int c) { const int st = (r >> 4) * 2 + (c >> 5), rr = r & 15, cc = c & 31, ob = rr * 64 + cc * 2; return st * 1024 + (ob ^ (((ob >> 9) & 1) << 5)); }
__host__ __device__ __forceinline__ void stage_rc(int b, int& R, int& C) { const int st = b / 1024, sb = b % 1024, swz = sb ^ (((sb >> 9) & 1) << 5); R = (st >> 1) * 16 + swz / 64; C = (st & 1) * 32 + (swz % 64) / 2; }
__host__ __device__ __forceinline__ int perm32(int rho) { const int n = rho >> 4, i = rho & 15; return 8 * (i >> 2) + 4 * n + (i & 3); }

struct Unit { int pm, pn; };
struct Gemm { const bf16_t* A; const bf16_t* Bt; int M, N, K; int sa = 0x7f7f7f7f, sb = 0x7f7f7f7f; };
typedef int i32x4 __attribute__((ext_vector_type(4)));
typedef int i32x8 __attribute__((ext_vector_type(8)));

struct StaticOrder {
    int nM, nN, nwg, G, c;
    __host__ __device__ void init(int M, int N, int G_, int c_) { nM = M / BM; nN = N / BM; nwg = nM * nN; G = G_; c = c_; }
    __host__ __device__ bool next(int i, Unit& u) const {
        const long L = (long)i * G + c; if (L >= nwg) return false;
        int wgid = (int)L; { const int q = nwg / NXCD, r = nwg % NXCD, xcd = wgid % NXCD, off = wgid / NXCD; wgid = (xcd < r ? xcd * (q + 1) : r * (q + 1) + (xcd - r) * q) + off; }
        const int nig = WGM * nN, gid = wgid / nig, fm = gid * WGM, gsz = (nM - fm) < WGM ? (nM - fm) : WGM;
        u.pm = fm + ((wgid % nig) % gsz); u.pn = (wgid % nig) / gsz; return true;
    }
    __device__ __forceinline__ void a_ready(const Unit&) const {}
    __device__ __forceinline__ void done(const Unit&) const {}
};

__device__ __forceinline__ unsigned cvt_pk_bf16(float lo, float hi) { unsigned r; asm volatile("v_cvt_pk_bf16_f32 %0, %1, %2" : "=v"(r) : "v"(lo), "v"(hi)); return r; }
typedef float f32x2 __attribute__((ext_vector_type(2)));
__device__ __forceinline__ f32x2 gelu_pk(f32x2 v) {
    const f32x2 av = __builtin_elementwise_abs(v), d = av * 0.2316418882f + 1.0f;
    f32x2 t; t.x = __builtin_amdgcn_rcpf(d.x); t.y = __builtin_amdgcn_rcpf(d.y);
    f32x2 q = t * 0.5307027145f + (-0.7265760135f); q = q * t + 0.7107068705f; q = q * t + (-0.142248368f); q = q * t + 0.127414796f; q = q * t;
    const f32x2 s = (v * v) * (-0.72134752044f);
    f32x2 e; e.x = __builtin_amdgcn_exp2f(s.x); e.y = __builtin_amdgcn_exp2f(s.y);
    const f32x2 m = v * (q * e), r = v - m;
    f32x2 o; o.x = v.x < 0.f ? m.x : r.x; o.y = v.y < 0.f ? m.y : r.y; return o;
}

template <int ACT  > struct EpiBf16 {
    static constexpr bool PERM = true, AFTER_DRAIN = false; static_assert(ACT == 0 || ACT == 1, "EpiBf16: ACT is 0 (none) or 1 (gelu_pk)");
    bf16_t* O; int ldc; const float* bias; int split_cols; size_t split_stride; float scale0;
    __device__ __forceinline__ void operator()(const f32x4 (&acc)[2][2][4][2], const Unit& u, int wr, int wc, int fr, int fq) const {
        const int row0 = u.pm * BM + wr * 64 + fr; int colt = u.pn * BM; bf16_t* base = O;
        float sc = 1.f; if (split_cols) { const int t = colt / split_cols; base += (size_t)t * split_stride; colt -= t * split_cols; if (t == 0) sc = scale0; }
        const int col0 = colt + wc * 32 + 8 * fq, bcol0 = u.pn * BM + wc * 32 + 8 * fq;
        f32x4 bv[2][2];
#pragma unroll
        for (int bj = 0; bj < 2; ++bj)
#pragma unroll
            for (int n = 0; n < 2; ++n) bv[bj][n] = bias ? *(const f32x4*)(bias + bcol0 + bj * HALF + 4 * n) : (f32x4){0.f, 0.f, 0.f, 0.f};
#pragma unroll
        for (int ai = 0; ai < 2; ++ai)
#pragma unroll
            for (int m = 0; m < 4; ++m) { bf16_t* rowp = base + (size_t)(row0 + ai * HALF + m * 16) * ldc + col0;
#pragma unroll
                for (int bj = 0; bj < 2; ++bj) { f32x4 v0 = acc[ai][bj][m][0] + bv[bj][0], v1 = acc[ai][bj][m][1] + bv[bj][1];
                    if (ACT == 1) { f32x2 a = gelu_pk((f32x2){v0[0], v0[1]}), b = gelu_pk((f32x2){v0[2], v0[3]}), c = gelu_pk((f32x2){v1[0], v1[1]}), d = gelu_pk((f32x2){v1[2], v1[3]});
                        v0 = (f32x4){a.x, a.y, b.x, b.y}; v1 = (f32x4){c.x, c.y, d.x, d.y}; }
                    v0 = v0 * sc; v1 = v1 * sc; u32x4 w; w.x = cvt_pk_bf16(v0[0], v0[1]); w.y = cvt_pk_bf16(v0[2], v0[3]); w.z = cvt_pk_bf16(v1[0], v1[1]); w.w = cvt_pk_bf16(v1[2], v1[3]);
                    *(u32x4*)(rowp + bj * HALF) = w; } }
    }
};

template <class Epi, class Sched, bool ALIGN_EPI = false, bool SP2 = false, bool FP8 = false, int SA = 0x7f7f7f7f, int SB = 0x7f7f7f7f>
__device__ __forceinline__ void gemm_phase(PG8_LAS unsigned char* lds, const Gemm g, const Sched& S, const Epi& E) {
    int tid_ = threadIdx.x; asm volatile("" : "+v"(tid_));
    const int tid = tid_, wid = __builtin_amdgcn_readfirstlane(tid >> 6), lane = tid & 63, wr = wid >> 2, wc = wid & 3, fr = lane & 15, fq = lane >> 4;
    constexpr int ES = FP8 ? 1 : 2;
    const int K = g.K, nt = K * ES / (BK * 2);
    unsigned voffA[2], voffB[2];
#pragma unroll
    for (int i = 0; i < 2; ++i) { int R, C; stage_rc(tid * 16 + i * 8192, R, C); const int Rb = Epi::PERM ? ((R & ~31) + perm32(R & 31)) : R;
        voffA[i] = (unsigned)(R * K * ES + C * 2); voffB[i] = (unsigned)(Rb * K * ES + C * 2); }
    const size_t kstep = (size_t)(BK * 2);
    const size_t hstep = (size_t)HALF * K * ES;
    const size_t tstep = 2 * hstep;
    const unsigned ldsw = (unsigned)wid * 1024u;
    const int aoff = lds_byte(wr * 64 + fr, fq * 8), boff = lds_byte(wc * 32 + fr, fq * 8);
#define PG8_SA(b, h) (((b) * 2 + (h)) * HTB)
#define PG8_SB(b, h) ((4 + (b) * 2 + (h)) * HTB)
#define PG8_STAGE(bufoff, gbase, voff) do { if constexpr (FP8) {   \
          int t3_ = tid; asm volatile("" : "+v"(t3_)); _Pragma("unroll") for (int _i = 0; _i < 2; ++_i) { int R_, C_; stage_rc(t3_ * 16 + _i * 8192, R_, C_); \
            if (Epi::PERM && (&(voff)[0] == &voffB[0])) R_ = (R_ & ~31) + perm32(R_ & 31); \
            __builtin_amdgcn_global_load_lds((const unsigned*)((const char*)(gbase) + (unsigned)(R_ * K * ES + C_ * 2)), (PG8_LAS unsigned*)(lds + (bufoff) + ldsw + _i * 8192), 16, 0, 0); } } \
        else { _Pragma("unroll") for (int _i = 0; _i < 2; ++_i) \
        __builtin_amdgcn_global_load_lds((const unsigned*)((const char*)(gbase) + (voff)[_i]), (PG8_LAS unsigned*)(lds + (bufoff) + ldsw + _i * 8192), 16, 0, 0); } } while (0)
#define PG8_LDA(dst, b, h) do { if constexpr (FP8) { _Pragma("unroll") for (int m = 0; m < 4; ++m) dst##8[m] = __builtin_shufflevector(*(const PG8_LAS i32x4*)(lds + PG8_SA(b, h) + aoff + m * 2048), *(const PG8_LAS i32x4*)(lds + PG8_SA(b, h) + aoff + m * 2048 + 1024), 0, 1, 2, 3, 4, 5, 6, 7); } \
        else { _Pragma("unroll") for (int m = 0; m < 4; ++m) _Pragma("unroll") for (int k = 0; k < 2; ++k) dst[m][k] = *(const PG8_LAS bf16x8*)(lds + PG8_SA(b, h) + aoff + m * 2048 + k * 1024); } } while (0)
#define PG8_LDB(dst, b, h) do { if constexpr (FP8) { _Pragma("unroll") for (int n = 0; n < 2; ++n) dst##8[n] = __builtin_shufflevector(*(const PG8_LAS i32x4*)(lds + PG8_SB(b, h) + boff + n * 2048), *(const PG8_LAS i32x4*)(lds + PG8_SB(b, h) + boff + n * 2048 + 1024), 0, 1, 2, 3, 4, 5, 6, 7); } \
        else { _Pragma("unroll") for (int n = 0; n < 2; ++n) _Pragma("unroll") for (int k = 0; k < 2; ++k) dst[n][k] = *(const PG8_LAS bf16x8*)(lds + PG8_SB(b, h) + boff + n * 2048 + k * 1024); } } while (0)
#define PG8_MMA(ai, bj, At, Bt) do { __builtin_amdgcn_s_setprio(1); \
        if constexpr (FP8) { _Pragma("unroll") for (int m = 0; m < 4; ++m) _Pragma("unroll") for (int n = 0; n < 2; ++n) { \
            acc[ai][bj][m][n] = __builtin_amdgcn_mfma_scale_f32_16x16x128_f8f6f4(Bt##8[n], At##8[m], acc[ai][bj][m][n], 0, 0, 0, SB, 0, SA); } } \
        else { _Pragma("unroll") for (int m = 0; m < 4; ++m) _Pragma("unroll") for (int n = 0; n < 2; ++n) _Pragma("unroll") for (int k = 0; k < 2; ++k) \
            acc[ai][bj][m][n] = __builtin_amdgcn_mfma_f32_16x16x32_bf16(Bt[n][k], At[m][k], acc[ai][bj][m][n], 0, 0, 0); } \
        __builtin_amdgcn_s_setprio(0); } while (0)
#define PG8_WAIT_V(n) asm volatile("s_waitcnt vmcnt(" #n ")" ::: "memory")
#define PG8_WAIT_L(n) asm volatile("s_waitcnt lgkmcnt(" #n ")" ::: "memory")
#define PG8_BAR __builtin_amdgcn_s_barrier()
#define PG8_SCHED __builtin_amdgcn_sched_barrier(0)
    Unit cur, nxt; int ui = 0;
    if (!S.next(0, cur)) return;
    f32x4 acc[2][2][4][2];
#pragma unroll
    for (int a = 0; a < 2; ++a)
#pragma unroll
        for (int b = 0; b < 2; ++b)
#pragma unroll
            for (int m = 0; m < 4; ++m)
#pragma unroll
                for (int n = 0; n < 2; ++n) acc[a][b][m][n] = (f32x4){0.f, 0.f, 0.f, 0.f};
    bf16x8 At[4][2], B0[2][2], B1[2][2]; i32x8 At8[4], B08[2], B18[2];
    const char* cA = (const char*)g.A + (size_t)cur.pm * tstep; const char* cB = (const char*)g.Bt + (size_t)cur.pn * tstep;
    S.a_ready(cur);
    if constexpr (SP2) {
        PG8_STAGE(PG8_SB(0, 0), cB, voffB); PG8_STAGE(PG8_SB(0, 1), cB + hstep, voffB); PG8_STAGE(PG8_SA(0, 0), cA, voffA); PG8_STAGE(PG8_SA(0, 1), cA + hstep, voffA);
        if (wr == 1) PG8_BAR;
        PG8_WAIT_V(2); PG8_BAR;
        PG8_STAGE(PG8_SB(1, 0), cB + kstep, voffB); PG8_STAGE(PG8_SA(1, 0), cA + kstep, voffA); PG8_STAGE(PG8_SB(1, 1), cB + hstep + kstep, voffB);
        PG8_WAIT_V(6); PG8_BAR;
    } else {
        PG8_STAGE(PG8_SB(0, 0), cB, voffB); PG8_STAGE(PG8_SA(0, 0), cA, voffA); PG8_STAGE(PG8_SB(0, 1), cB + hstep, voffB); PG8_STAGE(PG8_SA(0, 1), cA + hstep, voffA);
        if (wr == 1) PG8_BAR;
        PG8_WAIT_V(4); PG8_BAR;
        PG8_STAGE(PG8_SB(1, 0), cB + kstep, voffB); PG8_STAGE(PG8_SA(1, 0), cA + kstep, voffA); PG8_STAGE(PG8_SB(1, 1), cB + hstep + kstep, voffB);
        PG8_WAIT_V(6); PG8_BAR;
    }
    for (;;) {
        const bool has_next = S.next(ui + 1, nxt);
        const char* nA = has_next ? (const char*)g.A + (size_t)nxt.pm * tstep : cA; const char* nB = has_next ? (const char*)g.Bt + (size_t)nxt.pn * tstep : cB;
#pragma unroll 1
        for (int t = 0; t < nt; t += 2) {
            const bool last = (t == nt - 2);
            const char* a1 = cA + (size_t)(t + 1) * kstep;
            const char* a2 = last ? nA : cA + (size_t)(t + 2) * kstep; const char* b2 = last ? nB : cB + (size_t)(t + 2) * kstep;
            const char* a3 = a2 + kstep; const char* b3 = b2 + kstep;
            if (last && has_next) S.a_ready(nxt);
            if constexpr (SP2) {
            PG8_LDB(B0, 0, 0); PG8_LDB(B1, 0, 1); PG8_SCHED; PG8_LDA(At, 0, 0); PG8_STAGE(PG8_SA(1, 1), a1 + hstep, voffA);
            PG8_WAIT_V(8); PG8_WAIT_L(0); PG8_BAR; PG8_MMA(0, 0, At, B0); PG8_MMA(0, 1, At, B1); PG8_BAR; PG8_SCHED;
            PG8_LDA(At, 0, 1); PG8_STAGE(PG8_SB(0, 0), b2, voffB); PG8_STAGE(PG8_SB(0, 1), b2 + hstep, voffB); PG8_STAGE(PG8_SA(0, 0), a2, voffA);
            PG8_WAIT_V(8); PG8_WAIT_L(0); PG8_BAR; PG8_MMA(1, 0, At, B0); PG8_MMA(1, 1, At, B1); PG8_BAR; PG8_SCHED;
            PG8_LDB(B0, 1, 0); PG8_LDB(B1, 1, 1); PG8_SCHED; PG8_LDA(At, 1, 0); PG8_STAGE(PG8_SA(0, 1), a2 + hstep, voffA);
            PG8_WAIT_V(8); PG8_WAIT_L(0); PG8_BAR; PG8_MMA(0, 0, At, B0); PG8_MMA(0, 1, At, B1); PG8_BAR; PG8_SCHED;
            PG8_LDA(At, 1, 1); PG8_STAGE(PG8_SB(1, 0), b3, voffB); PG8_STAGE(PG8_SB(1, 1), b3 + hstep, voffB); PG8_STAGE(PG8_SA(1, 0), a3, voffA);
            PG8_WAIT_V(8); PG8_WAIT_L(0); PG8_BAR; PG8_MMA(1, 0, At, B0); PG8_MMA(1, 1, At, B1); PG8_BAR; PG8_SCHED;
            } else {
            PG8_LDB(B0, 0, 0); PG8_SCHED; PG8_LDA(At, 0, 0); PG8_STAGE(PG8_SA(1, 1), a1 + hstep, voffA);
            PG8_WAIT_L(8); PG8_BAR; PG8_WAIT_L(0); PG8_MMA(0, 0, At, B0); PG8_BAR; PG8_SCHED;
            PG8_LDB(B1, 0, 1); PG8_STAGE(PG8_SB(0, 0), b2, voffB);
            PG8_BAR; PG8_WAIT_L(0); PG8_MMA(0, 1, At, B1); PG8_BAR;
            PG8_LDA(At, 0, 1); PG8_STAGE(PG8_SA(0, 0), a2, voffA);
            PG8_BAR; PG8_WAIT_L(0); PG8_MMA(1, 0, At, B0); PG8_BAR; PG8_SCHED;
            PG8_STAGE(PG8_SB(0, 1), b2 + hstep, voffB);
            PG8_WAIT_V(6); PG8_BAR; PG8_MMA(1, 1, At, B1); PG8_BAR;
            PG8_LDB(B0, 1, 0); PG8_SCHED; PG8_LDA(At, 1, 0); PG8_STAGE(PG8_SA(0, 1), a2 + hstep, voffA);
            PG8_WAIT_L(8); PG8_BAR; PG8_WAIT_L(0); PG8_MMA(0, 0, At, B0); PG8_BAR; PG8_SCHED;
            PG8_LDB(B1, 1, 1); PG8_STAGE(PG8_SB(1, 0), b3, voffB);
            PG8_BAR; PG8_WAIT_L(0); PG8_MMA(0, 1, At, B1); PG8_BAR;
            PG8_LDA(At, 1, 1); PG8_STAGE(PG8_SA(1, 0), a3, voffA);
            PG8_BAR; PG8_WAIT_L(0); PG8_MMA(1, 0, At, B0); PG8_BAR; PG8_SCHED;
            PG8_STAGE(PG8_SB(1, 1), b3 + hstep, voffB);
            PG8_WAIT_V(6); PG8_BAR; PG8_MMA(1, 1, At, B1); PG8_BAR;
            }
        }
        if constexpr (ALIGN_EPI) { if (wr == 0) PG8_BAR; }
        if constexpr (!Epi::AFTER_DRAIN) { E(acc, cur, wr, wc, fr, fq); S.done(cur); }
        if (!has_next) break;
#pragma unroll
        for (int a = 0; a < 2; ++a)
#pragma unroll
            for (int b = 0; b < 2; ++b)
#pragma unroll
                for (int m = 0; m < 4; ++m)
#pragma unroll
                    for (int n = 0; n < 2; ++n) acc[a][b][m][n] = (f32x4){0.f, 0.f, 0.f, 0.f};
        cur = nxt; cA = nA; cB = nB; ++ui;
        if constexpr (ALIGN_EPI) { if (wr == 1) PG8_BAR; }
    }
    PG8_WAIT_V(0);
    if constexpr (!ALIGN_EPI) { if (wr == 0) PG8_BAR; }
    PG8_BAR;
    if constexpr (Epi::AFTER_DRAIN) { E.fused(acc, cur, wr, wc, fr, fq, lds, wid, lane); S.done(cur); }
#undef PG8_SA
#undef PG8_SB
#undef PG8_STAGE
#undef PG8_LDA
#undef PG8_LDB
#undef PG8_MMA
#undef PG8_WAIT_V
#undef PG8_WAIT_L
#undef PG8_BAR
#undef PG8_SCHED
}
}

namespace att {
typedef unsigned short bf16;
constexpr int D = 128, NW = 8, QBLK = 32, KVBLK = 64, LDQ = 1024, LDK = 256;
constexpr float SCALE = 0.088388347648318440f;
constexpr float THR = 3.f;
constexpr float QK8_SCALE = 4.f;
constexpr float V8A_SCALE = 4.f;
constexpr float O8_SCALE = 64.f;
#ifndef ATT_SDEPTH
#define ATT_SDEPTH 2
#endif
constexpr int SDEPTH = ATT_SDEPTH;
constexpr size_t SHM_V = KVBLK * D * 1  , SHM_K = KVBLK * D * 1  , SHM_ATTN = 2 * SHM_V + 2 * SHM_K + NW * 64 * 4;
#define VSWZ8(col, chunk) ((col) * 64 + ((((chunk) ^ ((col) >> 2)) & 3) << 4))
typedef int i32x8 __attribute__((ext_vector_type(8)));
typedef int i32x4 __attribute__((ext_vector_type(4)));
#define KSWZ8(row, colB) ((row) * 128 + ((colB) ^ ((((row) >> 1) & 7) << 4)))
using bf16x8 = __attribute__((ext_vector_type(8))) short;
using s16x4  = __attribute__((ext_vector_type(4))) short;
using f32x16 = __attribute__((ext_vector_type(16))) float;
using u32x4  = __attribute__((ext_vector_type(4))) unsigned;
#define KSWZ(row, colB) ((row) * 256 + ((colB) ^ (((row) & 7) << 4)))
#define SBAR() __builtin_amdgcn_sched_barrier(0)
__device__ __forceinline__ int crow(int r, int hi) { return (r & 3) + 8 * (r >> 2) + 4 * hi; }
__device__ __forceinline__ unsigned cvtpk(float lo, float hi) { unsigned r; asm volatile("v_cvt_pk_bf16_f32 %0, %1, %2" : "=v"(r) : "v"(lo), "v"(hi)); return r; }
__device__ __forceinline__ void partialSM(f32x16& p0, f32x16& p1, float& m_reg, float& mn, float& alpha) {
  constexpr float C = SCALE * 1.4426950408889634f;
  float pmax = p0[0]; for (int r = 1; r < 16; ++r) pmax = fmaxf(pmax, p0[r]); for (int r = 0; r < 16; ++r) pmax = fmaxf(pmax, p1[r]);
  { auto rr = __builtin_amdgcn_permlane32_swap(__float_as_uint(pmax), __float_as_uint(pmax), false, false);
    pmax = fmaxf(__uint_as_float(rr[0]), __uint_as_float(rr[1])); }
  if (__builtin_expect(__all(pmax - m_reg <= THR / SCALE), 1)) { mn = m_reg; alpha = 1.f; }
  else { mn = fmaxf(m_reg, pmax); alpha = __builtin_amdgcn_exp2f((m_reg - mn) * C); m_reg = mn; }
  float mnC = -mn * C;
  for (int r = 0; r < 16; ++r) p0[r] = fmaf(p0[r], C, mnC); for (int r = 0; r < 16; ++r) p1[r] = fmaf(p1[r], C, mnC);
  for (int r = 0; r < 16; ++r) p0[r] = __builtin_amdgcn_exp2f(p0[r]);
}
__device__ __forceinline__ void finishSM(f32x16& p0, f32x16& p1, float alpha, float& l_reg, i32x8& pa) {
  for (int r = 0; r < 16; ++r) p1[r] = __builtin_amdgcn_exp2f(p1[r]);
  float ps = 0; for (int r = 0; r < 16; ++r) ps += p0[r]; for (int r = 0; r < 16; ++r) ps += p1[r];
  { auto rr = __builtin_amdgcn_permlane32_swap(__float_as_uint(ps), __float_as_uint(ps), false, false);
    ps = __uint_as_float(rr[0]) + __uint_as_float(rr[1]); }
  l_reg = l_reg * alpha + ps;
#define PK8(P, B) ({ int v_ = __builtin_amdgcn_cvt_pk_fp8_f32(P[B] * 16.f, P[B + 1] * 16.f, 0, false); v_ = __builtin_amdgcn_cvt_pk_fp8_f32(P[B + 2] * 16.f, P[B + 3] * 16.f, v_, true); (unsigned)v_; })
#pragma unroll
  for (int i = 0; i < 4; ++i) { const unsigned x = PK8(p0, 4 * i), y = PK8(p1, 4 * i); auto rr = __builtin_amdgcn_permlane32_swap(x, y, false, false); pa[2 * i] = (int)rr[0]; pa[2 * i + 1] = (int)rr[1]; }
#undef PK8
}
__device__ __forceinline__ void qkt(f32x16& p0, f32x16& p1, const char* Ks, const i32x8* qr, int r32, int hi) {
  p0 = f32x16{}; p1 = f32x16{};
#pragma unroll
  for (int sk = 0; sk < 2; ++sk) { const int cb = 64 * sk + 32 * hi;
    const i32x8 a0 = __builtin_shufflevector(*reinterpret_cast<const i32x4*>(Ks + KSWZ8(r32, cb)), *reinterpret_cast<const i32x4*>(Ks + KSWZ8(r32, cb + 16)), 0, 1, 2, 3, 4, 5, 6, 7);
    const i32x8 a1 = __builtin_shufflevector(*reinterpret_cast<const i32x4*>(Ks + KSWZ8(32 + r32, cb)), *reinterpret_cast<const i32x4*>(Ks + KSWZ8(32 + r32, cb + 16)), 0, 1, 2, 3, 4, 5, 6, 7);
    p0 = __builtin_amdgcn_mfma_scale_f32_32x32x64_f8f6f4(a0, qr[sk], p0, 0, 0, 0, 0x7d7d7d7d, 0, 0x7d7d7d7d);
    p1 = __builtin_amdgcn_mfma_scale_f32_32x32x64_f8f6f4(a1, qr[sk], p1, 0, 0, 0, 0x7d7d7d7d, 0, 0x7d7d7d7d); }
}
template <int D0> __device__ __forceinline__ void pv_one(f32x16& od, const char* Vt, i32x8 pa, int r32, int hi) {
  const int col = D0 * 32 + r32;
  const i32x8 b = __builtin_shufflevector(*reinterpret_cast<const i32x4*>(Vt + VSWZ8(col, 2 * hi)), *reinterpret_cast<const i32x4*>(Vt + VSWZ8(col, 2 * hi + 1)), 0, 1, 2, 3, 4, 5, 6, 7);
  od = __builtin_amdgcn_mfma_scale_f32_32x32x64_f8f6f4(pa, b, od, 0, 0, 0, 0x7b7b7b7b  , 0, 0x7d7d7d7d  );
}
__device__ __forceinline__ void pv_d0(f32x16* o, const char* Vt, i32x8 pa, int r32, int hi) {
  pv_one<0>(o[0], Vt, pa, r32, hi); pv_one<1>(o[1], Vt, pa, r32, hi); pv_one<2>(o[2], Vt, pa, r32, hi); pv_one<3>(o[3], Vt, pa, r32, hi);
}
__device__ __forceinline__ void wmask(f32x16& p0, f32x16& p1, int kb, int qp, int hi) {
  const int bd = kb - qp + 4 * hi + 128;
#pragma unroll
  for (int r = 0; r < 16; ++r) { const int d0 = bd + (r & 3) + 8 * (r >> 2);
    if ((unsigned)d0 > 256u) p0[r] = -1e30f; if ((unsigned)(d0 + 32) > 256u) p1[r] = -1e30f; }
}
__device__ __forceinline__ void attn_unit(const bool WIN, const unsigned char* Qb, unsigned char* Ob, const unsigned char* __restrict__ Kh, const unsigned char* __restrict__ Vh  , int NT, int kstart, int q0, float sink_l2, float sink1_l2, char* lds) {
  int tid_ = threadIdx.x; asm volatile("" : "+v"(tid_));
  const int tid = tid_, wid = __builtin_amdgcn_readfirstlane(tid >> 6), lane = tid & 63, r32 = lane & 31, hi = lane >> 5;
  char* V_lds = lds; char* K_lds = lds + 2 * SHM_V;
  float* ws = (float*)(lds + 2 * SHM_V + 2 * SHM_K) + wid * 64; float* li_l = ws; float* al_l = ws + 32;
  float m_reg = -1e30f, l_reg = 0; f32x16 o[4] = {}; i32x8 qr[2];
  const int wrow = WIN ? (wid & 3) * QBLK : wid * QBLK, hoff = WIN ? (wid >> 2) * D : 0;
  const unsigned char* Qw = Qb + (long)(wrow + r32) * LDQ + hoff + hi * 32;
#pragma unroll
  for (int sk = 0; sk < 2; ++sk) qr[sk] = __builtin_shufflevector(*reinterpret_cast<const i32x4*>(Qw + sk * 64), *reinterpret_cast<const i32x4*>(Qw + sk * 64 + 16), 0, 1, 2, 3, 4, 5, 6, 7);
  const int vcol = tid >> 2, vpc = tid & 3;
  const int sr8 = tid >> 3, sc8 = (tid & 7) * 16;
  const int qp = q0 + wrow + r32;
  struct { i32x4 vs0, ks0; } sr_[SDEPTH];
#define TROW(t) (WIN ? ((t) < 4 ? (t) * KVBLK : kstart + (t) * KVBLK) : (t) * KVBLK)
#define SLOAD(i, t) do { const int k0_ = TROW(t); sr_[i].vs0 = *reinterpret_cast<const i32x4*>(&Vh[(long)vcol * RPB + k0_ + vpc * 16]); \
    sr_[i].ks0 = *reinterpret_cast<const i32x4*>(&Kh[(long)(k0_ + sr8) * LDK + sc8]); } while (0)
#define SWRITE(b, i) do { *(i32x4*)(V_lds + (b) * SHM_V + VSWZ8(vcol, vpc)) = sr_[i].vs0;          \
    *(i32x4*)((char*)K_lds + (b) * SHM_K + KSWZ8(sr8, sc8)) = sr_[i].ks0; } while (0)
#define SWAIT() do { if constexpr (SDEPTH == 2) asm volatile("s_waitcnt vmcnt(2)" ::: "memory"); else asm volatile("s_waitcnt vmcnt(0)" ::: "memory"); } while (0)
#define RESC(a) do { if (__any((a) < 1.f)) { if (hi == 0) al_l[r32] = (a); asm volatile("s_waitcnt lgkmcnt(0)" ::: "memory"); \
    for (int d = 0; d < 4; ++d) for (int r = 0; r < 16; ++r) o[d][r] *= al_l[crow(r, hi)]; } } while (0)
#define WMASK(P0, P1, t) do { if (WIN) { if ((t) >= 4) wmask(P0, P1, kstart + ((t) - 4) * KVBLK, qp, hi); } } while (0)
  f32x16 pA0, pA1, pB0, pB1; float mnA, mnB, alA, alB; i32x8 pa;
  constexpr int SE = 0, SO = SDEPTH - 1;
  SLOAD(SE, 0); asm volatile("s_waitcnt vmcnt(0)" ::: "memory"); SWRITE(0, SE); __syncthreads();
  qkt(pA0, pA1, K_lds, qr, r32, hi); WMASK(pA0, pA1, 0); partialSM(pA0, pA1, m_reg, mnA, alA);
  SLOAD(SO, 1); if constexpr (SDEPTH == 2) { if (2 < NT) SLOAD(SE, 2); }
  SWAIT(); SWRITE(1, SO); __syncthreads();
  for (int j = 1; j + 1 < NT; j += 2) {
    SBAR(); qkt(pB0, pB1, K_lds + SHM_K, qr, r32, hi); WMASK(pB0, pB1, j);
    finishSM(pA0, pA1, alA, l_reg, pa); SBAR();
    SLOAD(SO, j + SDEPTH); SBAR();
    pv_d0(o, V_lds, pa, r32, hi); partialSM(pB0, pB1, m_reg, mnB, alB);
    __syncthreads(); SWAIT(); SWRITE(0, SE);
    RESC(alB); __syncthreads();
    SBAR(); qkt(pA0, pA1, K_lds, qr, r32, hi); WMASK(pA0, pA1, j + 1);
    finishSM(pB0, pB1, alB, l_reg, pa); SBAR();
    if (SDEPTH == 1 || j + 3 < NT) SLOAD(SE, j + 1 + SDEPTH); SBAR();
    pv_d0(o, V_lds + SHM_V, pa, r32, hi); partialSM(pA0, pA1, m_reg, mnA, alA);
    __syncthreads(); SWAIT(); SWRITE(1, SO);
    RESC(alA); __syncthreads();
  }
  SBAR(); qkt(pB0, pB1, K_lds + SHM_K, qr, r32, hi); WMASK(pB0, pB1, NT - 1);
  finishSM(pA0, pA1, alA, l_reg, pa); SBAR();
  pv_d0(o, V_lds, pa, r32, hi); partialSM(pB0, pB1, m_reg, mnB, alB);
  __syncthreads(); RESC(alB);
  finishSM(pB0, pB1, alB, l_reg, pa); SBAR();
  pv_d0(o, V_lds + SHM_V, pa, r32, hi);
  if (WIN) { constexpr float C = SCALE * 1.4426950408889634f; l_reg += __builtin_amdgcn_exp2f(((wid >> 2) ? sink1_l2 : sink_l2) - m_reg * C); }
  if (hi == 0) li_l[r32] = l_reg; asm volatile("s_waitcnt lgkmcnt(0)" ::: "memory");
  float rli[16];
#pragma unroll
  for (int r = 0; r < 16; ++r) rli[r] = __builtin_amdgcn_rcpf(li_l[crow(r, hi)]);
  unsigned char* Ow = Ob + (long)wrow * LDQ + hoff;
#pragma unroll
  for (int r = 0; r < 16; ++r) { const int orow = crow(r, hi);
#pragma unroll
    for (int d0 = 0; d0 < 4; ++d0) { const float v = o[d0][r] * rli[r] * O8_SCALE;     Ow[(long)orow * LDQ + d0 * 32 + r32] = (unsigned char)(__builtin_amdgcn_cvt_pk_fp8_f32(v, v, 0, false) & 0xff); } }
  __syncthreads();
#undef TROW
#undef SLOAD
#undef SWRITE
#undef SWAIT
#undef RESC
#undef WMASK
}
#undef KSWZ
#undef SBAR
}

namespace mk {
namespace cg = cooperative_groups;
typedef unsigned short bf16;
typedef short bf16x8 __attribute__((ext_vector_type(8)));
typedef float f32x4 __attribute__((ext_vector_type(4)));
typedef unsigned u32x4 __attribute__((ext_vector_type(4)));
typedef unsigned u32x2 __attribute__((ext_vector_type(2)));
typedef __bf16 bf2_t __attribute__((ext_vector_type(2)));
#define LAS __attribute__((address_space(3)))
constexpr int NWAVES = 8, NTHR = 512;
constexpr size_t MiB = 1u << 20;
constexpr size_t WS_CTL = 0, CTL_BYTES = 1 * MiB;
constexpr size_t WS_MOD = 1 * MiB;
constexpr size_t WS_ROPE = 1 * MiB + 512 * 1024;
constexpr size_t WS_XC = 2 * MiB;
constexpr size_t WS_WQKV = 6 * MiB;
constexpr size_t WS_WO = 12 * MiB;
constexpr size_t WS_WP = 16 * MiB;
constexpr size_t WS_H = 24 * MiB;
constexpr size_t WS_Q = 58 * MiB;
constexpr size_t WS_K = 92 * MiB;
constexpr size_t WS_V = 101 * MiB;
constexpr size_t WS_EIDX = 110 * MiB;
constexpr size_t WS_GATE = 119 * MiB;
constexpr size_t WS_PW = 128 * MiB;
constexpr size_t WS_S = 137 * MiB;
constexpr size_t WS_UT = 274 * MiB;
constexpr size_t WS_VT = 306 * MiB;
constexpr size_t WS_O = 338 * MiB;
constexpr size_t WS_XB = 372 * MiB;
constexpr size_t WS_XCB = 436 * MiB;
constexpr size_t WS_PART = 440 * MiB;
constexpr size_t WS_END = 508 * MiB;
constexpr float U8_SCALE = 64.f, V8_SCALE = 8.f;
constexpr int LDS_BYTES = 155648;
constexpr int NPHASE = 23;

struct Args { const float* in[17]; float* out; unsigned char* ws; int ph_lo, ph_hi; };

constexpr int PTAB_OFF = 153600;
struct Ctx {
  unsigned char* ws;
  int tid, lane, wave, bid, G;
  LAS unsigned char* lds; unsigned char* ldsg;
  __device__ __forceinline__ const float* in(int k) const {
    const volatile LAS unsigned* t = (const volatile LAS unsigned*)(lds + PTAB_OFF) + 2 * k;
    const unsigned lo = __builtin_amdgcn_readfirstlane(t[0]), hi = __builtin_amdgcn_readfirstlane(t[1]);
    return (const float*)(((unsigned long long)hi << 32) | lo);
  }
  __device__ __forceinline__ float* outp() const { return (float*)in(17); }
};
enum { I_X = 0, I_C, I_CTX, I_CCTX, I_ADAW, I_ADAB, I_N1G, I_N2G, I_WQKV, I_QNG, I_KNG, I_WO, I_SINKS, I_PWQ, I_PSK, I_PU, I_PV };

__device__ __forceinline__ unsigned f2bf(float f) { unsigned u = __builtin_bit_cast(unsigned, f); return (u + 0x7fffu + ((u >> 16) & 1u)) >> 16; }
__device__ __forceinline__ unsigned pk2(float lo, float hi) { unsigned r; asm volatile("v_cvt_pk_bf16_f32 %0, %1, %2" : "=v"(r) : "v"(lo), "v"(hi)); return r; }
__device__ __forceinline__ float bflo(unsigned u) { return __uint_as_float(u << 16); }
__device__ __forceinline__ float bfhi(unsigned u) { return __uint_as_float(u & 0xffff0000u); }
__device__ __forceinline__ float silu(float x) { return x / (1.f + __expf(-x)); }
__device__ __forceinline__ float gelu_tanh(float x) {
  const float y = 0.7978845608028654f * (x + 0.044715f * x * x * x);
  const float t = 1.f - 2.f / (__expf(2.f * y) + 1.f);
  return 0.5f * x * (1.f + t);
}
__device__ __forceinline__ float wave_sum(float v) {
#pragma unroll
  for (int o = 1; o < 64; o <<= 1) v += __shfl_xor(v, o);
  return v;
}
__device__ __forceinline__ const float* xrow_sel(const float* lat, const float* cx, int r) { const int b = r / RPB, j = r % RPB; return j < CTXL ? cx + (size_t)(b * CTXL + j) * DM : lat + (size_t)(b * SEQ + (j - CTXL)) * DM; }
__device__ __forceinline__ int mod_row(int r) { const int b = r / RPB, j = r % RPB; return j < CTXL ? 4 : b; }

__device__ __forceinline__ const float* st_lat(const Ctx& F, int sel) { return sel == 0 ? F.in(I_X) : (sel == 1 ? (const float*)(F.ws + WS_XB) : (const float*)F.outp()); }
__device__ __forceinline__ const float* st_ctx(const Ctx& F, int sel) { return sel == 0 ? F.in(I_CTX) : (sel == 1 ? (const float*)(F.ws + WS_XCB) : (const float*)(F.ws + WS_XC)); }
__device__ __forceinline__ int qk_perm_col(int n) {
  if (n >= (NH + NKV) * HD) return n; const int d = n & 127, axis = d >> 6, pair = (d >> 5) & 1, f = d & 31; return (n & ~127) + 2 * (axis * 32 + f) + pair; }
constexpr float W8_SCALE = 32.f;
template <bool QKPERM, bool FP8>
__device__ __forceinline__ void p0_transpose_item(const float* W, int K, int N, bf16* WT, LAS float* scr, int item, int lane) {
  const int nblk = N / 32, kb = item / nblk, nb = item % nblk, k0 = 64 * kb, n0 = 32 * nb;
  { float t[32];
#pragma unroll
    for (int i = 0; i < 32; ++i) t[i] = W[(size_t)(k0 + 2 * i + (lane >> 5)) * N + n0 + (lane & 31)];
#pragma unroll
    for (int i = 0; i < 32; ++i) scr[(2 * i + (lane >> 5)) * 33 + (lane & 31)] = t[i]; }
  asm volatile("s_waitcnt lgkmcnt(0)" ::: "memory");
  const int c = lane & 7;
#pragma unroll
  for (int j = 0; j < 4; ++j) { const int n = (lane >> 3) + 8 * j; const LAS float* s = scr + (8 * c) * 33 + n;
    if constexpr (FP8) { int v0 = __builtin_amdgcn_cvt_pk_fp8_f32(s[0 * 33] * W8_SCALE, s[1 * 33] * W8_SCALE, 0, false); v0 = __builtin_amdgcn_cvt_pk_fp8_f32(s[2 * 33] * W8_SCALE, s[3 * 33] * W8_SCALE, v0, true);
      int v1 = __builtin_amdgcn_cvt_pk_fp8_f32(s[4 * 33] * W8_SCALE, s[5 * 33] * W8_SCALE, 0, false); v1 = __builtin_amdgcn_cvt_pk_fp8_f32(s[6 * 33] * W8_SCALE, s[7 * 33] * W8_SCALE, v1, true);
      u32x2 o; o.x = (unsigned)v0; o.y = (unsigned)v1; *(u32x2*)((unsigned char*)WT + (size_t)(QKPERM ? qk_perm_col(n0 + n) : n0 + n) * K + k0 + 8 * c) = o; }
    else { u32x4 o; o.x = pk2(s[0 * 33], s[1 * 33]); o.y = pk2(s[2 * 33], s[3 * 33]); o.z = pk2(s[4 * 33], s[5 * 33]); o.w = pk2(s[6 * 33], s[7 * 33]);
      *(u32x4*)(WT + (size_t)(QKPERM ? qk_perm_col(n0 + n) : n0 + n) * K + k0 + 8 * c) = o; } }
  asm volatile("s_waitcnt lgkmcnt(0)" ::: "memory");
}

constexpr int CONV_NR = DEPTH * NKEYS * NKEYS;
__device__ __forceinline__ int conv_idle(int G, int p) { const int nu = p == 0 ? 408 : (p == 1 ? 272 : 544); return (nu % G) ? G - (nu % G) : 0; }
__device__ __forceinline__ void conv_slot(const Ctx& F, int p, int& lo, int& hi) {
  const int i0 = conv_idle(F.G, 0), i1 = conv_idle(F.G, 1), i2 = conv_idle(F.G, 2), tw = 8 * i0 + 4 * i1 + 10 * i2; lo = hi = 0; if (tw == 0) return;
  const int unit = (2 * CONV_NR + tw - 1) / tw;
  const int mine = conv_idle(F.G, p), first = F.G - mine; if (F.bid < first) return;
  const int wgt = p == 0 ? 8 : (p == 1 ? 4 : 10), base = (p == 0 ? 0 : (p == 1 ? 8 * i0 : 8 * i0 + 4 * i1)) + wgt * (F.bid - first);
  lo = base * unit; hi = lo + wgt * unit;
}
__device__ __forceinline__ void convert_rows(const Ctx& F, int r_lo, int r_hi) {
  constexpr int NR = CONV_NR;
  const float* pup = F.in(I_PU); const float* pvp = F.in(I_PV);
  if (r_hi > 2 * NR) r_hi = 2 * NR;
  for (int rr = r_lo + F.wave; rr < r_hi; rr += 2 * NWAVES) {
    f32x4 a[2][4];
#pragma unroll
    for (int q = 0; q < 2; ++q) { const int row = rr + q * NWAVES; if (row < r_hi) { const float* src = (row < NR ? pup : pvp) + (size_t)(row < NR ? row : row - NR) * DM;
#pragma unroll
        for (int i = 0; i < 4; ++i) a[q][i] = ((const f32x4*)src)[i * 64 + F.lane]; } }
#pragma unroll
    for (int q = 0; q < 2; ++q) { const int row = rr + q * NWAVES; if (row < r_hi) { const bool isu = row < NR; const int rw = isu ? row : row - NR; const float sc = isu ? U8_SCALE : V8_SCALE;
        const size_t lay = (size_t)(rw >> 14), ex = (size_t)(rw & 16383); unsigned char* dst = F.ws + (isu ? WS_UT : WS_VT);
#pragma unroll
        for (int i = 0; i < 4; ++i) { int v = __builtin_amdgcn_cvt_pk_fp8_f32(a[q][i].x * sc, a[q][i].y * sc, 0, false); v = __builtin_amdgcn_cvt_pk_fp8_f32(a[q][i].z * sc, a[q][i].w * sc, v, true);
          const int sl = 2 * i + (F.lane >> 5); *(unsigned*)(dst + ((lay * 8 + sl) * 16384 + ex) * 128 + ((F.lane & 31) * 4)) = (unsigned)v; } } }
  }
}

__device__ __forceinline__ void phase_prologue(const Ctx& F) {
  { LAS float* sl = (LAS float*)F.lds;
    LAS float* red = sl + 5 * DM;
    { const float* cp = F.in(I_C); const float* ccp = F.in(I_CCTX);
      for (int e = F.tid; e < 5 * DM; e += NTHR) { const int r = e / DM, j = e % DM; sl[e] = silu(r < 4 ? cp[r * DM + j] : ccp[j]); } }
    __syncthreads();
    const float* adaw = F.in(I_ADAW); const float* adab = F.in(I_ADAB);
    for (int task = F.bid; task < DEPTH * 96; task += F.G) {
      const int i = task / 96, n = (task % 96) * 64 + F.lane;
      const float* w = adaw + (size_t)i * DM * NMOD * DM + n;
      float a0 = 0.f, a1 = 0.f, a2 = 0.f, a3 = 0.f, a4 = 0.f;
#pragma unroll 1
      for (int j0 = 0; j0 < 128; j0 += 32) { float wv[32];
#pragma unroll
        for (int jj = 0; jj < 32; ++jj) wv[jj] = w[(size_t)(F.wave * 128 + j0 + jj) * NMOD * DM];
#pragma unroll
        for (int jj = 0; jj < 32; ++jj) { const int j = F.wave * 128 + j0 + jj;
          a0 += sl[j] * wv[jj]; a1 += sl[DM + j] * wv[jj]; a2 += sl[2 * DM + j] * wv[jj]; a3 += sl[3 * DM + j] * wv[jj]; a4 += sl[4 * DM + j] * wv[jj]; } }
      red[(F.wave * 5 + 0) * 64 + F.lane] = a0; red[(F.wave * 5 + 1) * 64 + F.lane] = a1; red[(F.wave * 5 + 2) * 64 + F.lane] = a2;
      red[(F.wave * 5 + 3) * 64 + F.lane] = a3; red[(F.wave * 5 + 4) * 64 + F.lane] = a4;
      __syncthreads();
      if (F.tid < 320) { const int r = F.tid >> 6, l = F.tid & 63; float s = 0.f;
#pragma unroll
        for (int w8 = 0; w8 < 8; ++w8) s += red[(w8 * 5 + r) * 64 + l];
        const int nn = (task % 96) * 64 + l;
        ((float*)(F.ws + WS_MOD))[((size_t)i * 5 + r) * NMOD * DM + nn] = s + adab[i * NMOD * DM + nn]; }
      __syncthreads();
    }
  }
  { LAS float* sk = (LAS float*)F.lds;
    LAS float* wq = sk + 128 * 132;
    const float* pskp = F.in(I_PSK); const float* pwqp = F.in(I_PWQ);
    for (int task = F.bid; task < DEPTH * 8 * 2 * 16; task += F.G) {
      const int jc = task & 15, half = (task >> 4) & 1, h = (task >> 5) & 7, i = task >> 8;
      const float* SK = pskp + ((size_t)i * 2 + half) * NKEYS * 128;
      const float* WQ = pwqp + (size_t)i * DM * PQN + (size_t)(jc * 64) * PQN + h * PQD + half * 128;
      for (int e = F.tid; e < 128 * 32; e += NTHR) { const int kk = e >> 5, d4 = e & 31; const f32x4 v = *(const f32x4*)(SK + (size_t)kk * 128 + d4 * 4); *(LAS f32x4*)(sk + kk * 132 + d4 * 4) = v; }
      for (int e = F.tid; e < 64 * 32; e += NTHR) { const int j = e >> 5, d4 = e & 31; const f32x4 v = *(const f32x4*)(WQ + (size_t)j * PQN + d4 * 4); *(LAS f32x4*)(wq + j * 128 + d4 * 4) = v; }
      __syncthreads();
      const int kk = F.tid & 127, jg = F.tid >> 7;
      float acc[16];
#pragma unroll
      for (int q = 0; q < 16; ++q) acc[q] = 0.f;
#pragma unroll 2
      for (int d4 = 0; d4 < 32; ++d4) { const f32x4 s = *(const LAS f32x4*)(sk + kk * 132 + d4 * 4);
#pragma unroll
        for (int q = 0; q < 16; ++q) { const f32x4 w = *(const LAS f32x4*)(wq + (jg * 16 + q) * 128 + d4 * 4); acc[q] += s.x * w.x + s.y * w.y + s.z * w.z + s.w * w.w; } }
      bf16* o = (bf16*)(F.ws + WS_WP) + ((size_t)i * PQN + h * PQD + half * 128 + kk) * DM + jc * 64 + jg * 16;
      u32x4 o0, o1; o0.x = pk2(acc[0], acc[1]); o0.y = pk2(acc[2], acc[3]); o0.z = pk2(acc[4], acc[5]); o0.w = pk2(acc[6], acc[7]);
      o1.x = pk2(acc[8], acc[9]); o1.y = pk2(acc[10], acc[11]); o1.z = pk2(acc[12], acc[13]); o1.w = pk2(acc[14], acc[15]);
      *(u32x4*)o = o0; *(u32x4*)(o + 8) = o1;
      __syncthreads();
    }
  }
  { const int gt = F.bid * NTHR + F.tid; float* rp = (float*)(F.ws + WS_ROPE);
    if (gt < 64 * 32) { const int pos = gt >> 5, f = gt & 31; const float inv = exp2f(-(float)(2 * f) * (13.287712379549449f / 64.f)); float sn, cs; sincosf((float)pos * inv, &sn, &cs); rp[2 * gt] = cs; rp[2 * gt + 1] = sn; }
    else if (gt < 64 * 32 + DEPTH * 2 * HD) { const int e = gt - 64 * 32, p = e & 127, which = (e >> 7) & 1, layer = e >> 8; const int q = p >> 1, pair = p & 1, d = (q >> 5) * 64 + pair * 32 + (q & 31);
      rp[64 * 32 * 2 + e] = (which == 0 ? F.in(I_QNG) : F.in(I_KNG))[layer * HD + d]; } }
  if (8 * conv_idle(F.G, 0) + 4 * conv_idle(F.G, 1) + 10 * conv_idle(F.G, 2) == 0) { const int per = (2 * CONV_NR + F.G - 1) / F.G; convert_rows(F, F.bid * per, (F.bid + 1) * per); }
  { LAS float* scr = (LAS float*)F.lds + F.wave * (64 * 33 + 16);
    const int gw = F.bid * NWAVES + F.wave, NGW = F.G * NWAVES;
    constexpr int I_QKV = (DM / 64) * (QKVD / 32), I_O = (DM / 64) * (DM / 32);
    const float* wqkvp = F.in(I_WQKV); const float* wop = F.in(I_WO);
    for (int it = gw; it < DEPTH * (I_QKV + I_O); it += NGW) {
      const int i = it / (I_QKV + I_O); int r = it % (I_QKV + I_O);
      if (r < I_QKV) p0_transpose_item<true, true>(wqkvp + (size_t)i * DM * QKVD, DM, QKVD, (bf16*)(F.ws + WS_WQKV + (size_t)i * QKVD * DM), scr, r, F.lane);
      else p0_transpose_item<false, true>(wop + (size_t)i * DM * DM, DM, DM, (bf16*)(F.ws + WS_WO + (size_t)i * DM * DM), scr, r - I_QKV, F.lane);
    }
  }
}

constexpr float H8_SCALE = 4.f;
__device__ __forceinline__ void phase_norm(const Ctx& F, int layer, int which  , int src_sel, bool latent_only) {
  const int gw = F.bid * NWAVES + F.wave, NGW = F.G * NWAVES;
  const float* gain = (which == 0 ? F.in(I_N1G) : F.in(I_N2G)) + layer * DM;
  const float* modl = (const float*)(F.ws + WS_MOD) + (size_t)layer * 5 * NMOD * DM;
  bf16* H = (bf16*)(F.ws + WS_H);
  const float* latp = st_lat(F, src_sel); const float* cxp = st_ctx(F, src_sel);
  for (int r = gw; r < NROWS; r += NGW) {
    if (latent_only && (r % RPB) < CTXL) continue;
    const float* xr = xrow_sel(latp, cxp, r);
    const float* mrow = modl + (size_t)mod_row(r) * NMOD * DM;
    const float* sh = mrow + (which == 0 ? 0 : 3) * DM; const float* sc = mrow + (which == 0 ? 1 : 4) * DM;
    f32x4 v[4]; float s = 0.f;
#pragma unroll
    for (int j = 0; j < 4; ++j) { v[j] = ((const f32x4*)xr)[F.lane + 64 * j]; s += (v[j].x * v[j].x + v[j].y * v[j].y) + (v[j].z * v[j].z + v[j].w * v[j].w); }
    const float rstd = rsqrtf(wave_sum(s) * (1.f / DM) + RMS_EPS);
    unsigned long long* o8 = (unsigned long long*)(H + (size_t)r * DM) + F.lane;
#pragma unroll
    for (int j = 0; j < 4; ++j) { const f32x4 g = ((const f32x4*)gain)[F.lane + 64 * j], a = ((const f32x4*)sc)[F.lane + 64 * j], b = ((const f32x4*)sh)[F.lane + 64 * j];
      const float y0 = v[j].x * rstd * g.x * (1.f + a.x) + b.x, y1 = v[j].y * rstd * g.y * (1.f + a.y) + b.y, y2 = v[j].z * rstd * g.z * (1.f + a.z) + b.z, y3 = v[j].w * rstd * g.w * (1.f + a.w) + b.w;
      if (which == 0) { int v8 = __builtin_amdgcn_cvt_pk_fp8_f32(y0 * H8_SCALE, y1 * H8_SCALE, 0, false); v8 = __builtin_amdgcn_cvt_pk_fp8_f32(y2 * H8_SCALE, y3 * H8_SCALE, v8, true);
        ((unsigned*)((unsigned char*)H + (size_t)r * DM))[F.lane + 64 * j] = (unsigned)v8; }
      else o8[64 * j] = (unsigned long long)pk2(y0, y1) | ((unsigned long long)pk2(y2, y3) << 32); }
  }
}

__device__ __forceinline__ void phase_qknorm(const Ctx& F, int layer) {
  const int gw = F.bid * NWAVES + F.wave, NGW = F.G * NWAVES;
  const int axis = F.lane >> 5, f = F.lane & 31, e1 = axis * 64 + f, e2 = e1 + 32;
  const float* qg = F.in(I_QNG) + layer * HD; const float* kg = F.in(I_KNG) + layer * HD;
  const float qg1 = qg[e1], qg2 = qg[e2], kg1 = kg[e1], kg2 = kg[e2];
  const float inv = exp2f(-(float)(2 * f) * (13.287712379549449f / 64.f));
  bf16* Q = (bf16*)(F.ws + WS_Q); bf16* K = (bf16*)(F.ws + WS_K);
  for (int r = gw; r < NROWS; r += NGW) {
    const int j = r % RPB; float cs = 1.f, sn = 0.f;
    if (j >= CTXL) { const int sp = j - CTXL; const float pos = (float)(axis == 0 ? (sp >> 6) : (sp & 63)); sincosf(pos * inv, &sn, &cs); }
#pragma unroll
    for (int h = 0; h < NH + NKV; ++h) {
      bf16* base = h < NH ? Q + (size_t)r * DM + h * HD : K + (size_t)r * (NKV * HD) + (h - NH) * HD;
      float x1 = bflo(base[e1]), x2 = bflo(base[e2]);
      const float rstd = rsqrtf(wave_sum(x1 * x1 + x2 * x2) * (1.f / HD) + RMS_EPS);
      x1 *= rstd * (h < NH ? qg1 : kg1); x2 *= rstd * (h < NH ? qg2 : kg2);
      const float y1 = x1 * cs - x2 * sn, y2 = x1 * sn + x2 * cs;
      base[e1] = (bf16)f2bf(y1); base[e2] = (bf16)f2bf(y2);
    }
  }
}
struct Order {
  int nM, nN, nwg, G, c, lat;
  __device__ void init(int nM_, int nN_, int G_, int c_, int lat_) { nM = nM_; nN = nN_; nwg = nM * nN; G = G_; c = c_; lat = lat_; }
  __device__ bool next(int i, pg8::Unit& u) const {
    const long L = (long)i * G + c; if (L >= nwg) return false;
    int wgid = (int)L; { const int q = nwg / 8, r = nwg % 8, xcd = wgid % 8, off = wgid / 8; wgid = (xcd < r ? xcd * (q + 1) : r * (q + 1) + (xcd - r) * q) + off; }
    const int WGM = 8, nig = WGM * nN, gid = wgid / nig, fm = gid * WGM, gsz = (nM - fm) < WGM ? (nM - fm) : WGM;
    int pm = fm + ((wgid % nig) % gsz); u.pn = (wgid % nig) / gsz;
    if (lat) pm = (pm >> 4) * 17 + 1 + (pm & 15);
    u.pm = pm; return true;
  }
  __device__ __forceinline__ void a_ready(const pg8::Unit&) const {}
  __device__ __forceinline__ void done(const pg8::Unit&) const {}
};
struct EpiQKV {
  static constexpr bool PERM = true, AFTER_DRAIN = false;
  unsigned char* ws; LAS float* xs  ; int layer;
  __device__ __forceinline__ void operator()(const pg8::f32x4 (&acc)[2][2][4][2], const pg8::Unit& u, int wr, int wc, int fr, int fq) const {
    const int row0 = u.pm * 256 + wr * 64 + fr;
    const size_t boff = u.pn < 4 ? WS_Q : (u.pn == 4 ? WS_K : WS_V); const int ldc = u.pn < 4 ? DM : NKV * HD, colt = u.pn < 4 ? u.pn * 256 : 0;
    bf16* base = (bf16*)(ws + boff);
    const int col0 = colt + wc * 32 + 8 * fq;
    if (u.pn == 5) {
      unsigned char* vt = ws + WS_V; const int bt = (u.pm * 256) / RPB, key0 = (u.pm * 256) % RPB + wr * 64 + fr;
#pragma unroll
      for (int ai = 0; ai < 2; ++ai)
#pragma unroll
        for (int m = 0; m < 4; ++m) { const int key = key0 + ai * 128 + m * 16;
#pragma unroll
          for (int bj = 0; bj < 2; ++bj) { const pg8::f32x4 v0 = acc[ai][bj][m][0], v1 = acc[ai][bj][m][1];
            int w0 = __builtin_amdgcn_cvt_pk_fp8_f32(v0[0] * att::V8A_SCALE, v0[1] * att::V8A_SCALE, 0, false); w0 = __builtin_amdgcn_cvt_pk_fp8_f32(v0[2] * att::V8A_SCALE, v0[3] * att::V8A_SCALE, w0, true);
            int w1 = __builtin_amdgcn_cvt_pk_fp8_f32(v1[0] * att::V8A_SCALE, v1[1] * att::V8A_SCALE, 0, false); w1 = __builtin_amdgcn_cvt_pk_fp8_f32(v1[2] * att::V8A_SCALE, v1[3] * att::V8A_SCALE, w1, true);
            unsigned char* cp = vt + ((size_t)((bt * 2 + bj) * 128 + wc * 32 + 8 * fq)) * RPB + key;
            cp[0 * RPB] = (unsigned char)(w0 & 0xff); cp[1 * RPB] = (unsigned char)((w0 >> 8) & 0xff); cp[2 * RPB] = (unsigned char)((w0 >> 16) & 0xff); cp[3 * RPB] = (unsigned char)((unsigned)w0 >> 24);
            cp[4 * RPB] = (unsigned char)(w1 & 0xff); cp[5 * RPB] = (unsigned char)((w1 >> 8) & 0xff); cp[6 * RPB] = (unsigned char)((w1 >> 16) & 0xff); cp[7 * RPB] = (unsigned char)((unsigned)w1 >> 24); } }
      return;
    }
#pragma unroll
    for (int ai = 0; ai < 2; ++ai)
#pragma unroll
      for (int m = 0; m < 4; ++m)
#pragma unroll
        for (int bj = 0; bj < 2; ++bj) { const pg8::f32x4 v0 = acc[ai][bj][m][0], v1 = acc[ai][bj][m][1];
          float ss = (v0[0] * v0[0] + v0[1] * v0[1]) + (v0[2] * v0[2] + v0[3] * v0[3]) + (v1[0] * v1[0] + v1[1] * v1[1]) + (v1[2] * v1[2] + v1[3] * v1[3]);
          ss += __shfl_xor(ss, 16); ss += __shfl_xor(ss, 32);
          if (fq == 0) xs[((((wr * 2 + ai) * 4 + m) * 16 + fr) * 2 + bj) * 4 + wc] = ss; }
    asm volatile("s_waitcnt lgkmcnt(0)" ::: "memory"); __builtin_amdgcn_s_barrier(); asm volatile("" ::: "memory");
    const float* rp = (const float*)(ws + WS_ROPE);
    const float* gp = rp + 64 * 32 * 2 + (layer * 2 + (u.pn < 4 ? 0 : 1)) * HD + wc * 32 + 8 * fq;
    const f32x4 g0 = *(const f32x4*)gp, g1 = *(const f32x4*)(gp + 4);
    const bool latent = (u.pm % 17) != 0;
    const int axis = wc >> 1, f0 = 16 * (wc & 1) + 4 * fq;
#pragma unroll
    for (int ai = 0; ai < 2; ++ai)
#pragma unroll
      for (int m = 0; m < 4; ++m) { const int r = row0 + ai * 128 + m * 16;
        f32x4 c01 = {1.f, 0.f, 1.f, 0.f}, c23 = {1.f, 0.f, 1.f, 0.f};
        if (latent) { const int sp = (r % RPB) - CTXL, pos = axis == 0 ? (sp >> 6) : (sp & 63); const float* cp = rp + (pos * 32 + f0) * 2; c01 = *(const f32x4*)cp; c23 = *(const f32x4*)(cp + 4); }
        unsigned char* rowp = (unsigned char*)base + (size_t)r * ldc + col0;
#pragma unroll
        for (int bj = 0; bj < 2; ++bj) { const LAS float* xp = xs + ((((wr * 2 + ai) * 4 + m) * 16 + fr) * 2 + bj) * 4;
          const float rstd = rsqrtf(((xp[0] + xp[1]) + (xp[2] + xp[3])) * (1.f / HD) + RMS_EPS);
          const pg8::f32x4 v0 = acc[ai][bj][m][0], v1 = acc[ai][bj][m][1];
          const float a0 = v0[0] * rstd * g0.x, b0 = v0[1] * rstd * g0.y, a1 = v0[2] * rstd * g0.z, b1 = v0[3] * rstd * g0.w;
          const float a2 = v1[0] * rstd * g1.x, b2 = v1[1] * rstd * g1.y, a3 = v1[2] * rstd * g1.z, b3 = v1[3] * rstd * g1.w;
          constexpr float QS = att::QK8_SCALE;
          int w0 = __builtin_amdgcn_cvt_pk_fp8_f32((a0 * c01.x - b0 * c01.y) * QS, (a0 * c01.y + b0 * c01.x) * QS, 0, false); w0 = __builtin_amdgcn_cvt_pk_fp8_f32((a1 * c01.z - b1 * c01.w) * QS, (a1 * c01.w + b1 * c01.z) * QS, w0, true);
          int w1 = __builtin_amdgcn_cvt_pk_fp8_f32((a2 * c23.x - b2 * c23.y) * QS, (a2 * c23.y + b2 * c23.x) * QS, 0, false); w1 = __builtin_amdgcn_cvt_pk_fp8_f32((a3 * c23.z - b3 * c23.w) * QS, (a3 * c23.w + b3 * c23.z) * QS, w1, true);
          u32x2 w; w.x = (unsigned)w0; w.y = (unsigned)w1; *(u32x2*)(rowp + bj * 128) = w; } }
    asm volatile("s_waitcnt lgkmcnt(0)" ::: "memory"); __builtin_amdgcn_s_barrier(); asm volatile("" ::: "memory");
  }
};
struct EpiRes {
  static constexpr bool PERM = false, AFTER_DRAIN = false;
  const float *xin, *cin; float *xout, *xc; const float* gmod  ;
  __device__ __forceinline__ void operator()(const pg8::f32x4 (&acc)[2][2][4][2], const pg8::Unit& u, int wr, int wc, int fr, int fq) const {
    const int col0 = u.pn * 256 + wc * 32 + 4 * fq;
#pragma unroll
    for (int ai = 0; ai < 2; ++ai)
#pragma unroll
      for (int m = 0; m < 4; ++m) { const int r = u.pm * 256 + ai * 128 + wr * 64 + m * 16 + fr;
        const int b_ = r / RPB, j_ = r % RPB; const size_t oc = (size_t)(b_ * CTXL + j_) * DM, ol = (size_t)(b_ * SEQ + (j_ - CTXL)) * DM;
        float* xn = j_ < CTXL ? xc + oc : xout + ol; const float* xo = j_ < CTXL ? cin + oc : xin + ol; const float* g = gmod + (size_t)(j_ < CTXL ? 4 : b_) * NMOD * DM;
#pragma unroll
        for (int bj = 0; bj < 2; ++bj)
#pragma unroll
          for (int n = 0; n < 2; ++n) { const int c = col0 + bj * 128 + n * 16; const f32x4 xv = *(const f32x4*)(xo + c), gv = *(const f32x4*)(g + c); const pg8::f32x4 a = acc[ai][bj][m][n];
            f32x4 o; o.x = xv.x + gv.x * a[0]; o.y = xv.y + gv.y * a[1]; o.z = xv.z + gv.z * a[2]; o.w = xv.w + gv.w * a[3]; *(f32x4*)(xn + c) = o; } }
  }
};
struct EpiF32 {
  static constexpr bool PERM = true, AFTER_DRAIN = false;
  _Float16* S; int ldc;
  __device__ __forceinline__ void operator()(const pg8::f32x4 (&acc)[2][2][4][2], const pg8::Unit& u, int wr, int wc, int fr, int fq) const {
    typedef _Float16 h8 __attribute__((ext_vector_type(8)));
    const int col0 = u.pn * 256 + wc * 32 + 8 * fq;
#pragma unroll
    for (int ai = 0; ai < 2; ++ai)
#pragma unroll
      for (int m = 0; m < 4; ++m) { _Float16* rowp = S + (size_t)(u.pm * 256 + ai * 128 + wr * 64 + m * 16 + fr) * ldc + col0;
#pragma unroll
        for (int bj = 0; bj < 2; ++bj) { const pg8::f32x4 v0 = acc[ai][bj][m][0], v1 = acc[ai][bj][m][1];
          h8 o; o[0] = (_Float16)v0[0]; o[1] = (_Float16)v0[1]; o[2] = (_Float16)v0[2]; o[3] = (_Float16)v0[3]; o[4] = (_Float16)v1[0]; o[5] = (_Float16)v1[1]; o[6] = (_Float16)v1[2]; o[7] = (_Float16)v1[3];
          *(h8*)(rowp + bj * 128) = o; } }
  }
};

__device__ __forceinline__ void phase_attn(const Ctx& F, int layer) {
  const unsigned char* Q = F.ws + WS_Q; const unsigned char* K = F.ws + WS_K; const unsigned char* V = F.ws + WS_V;
  char* lds = (char*)F.ldsg;
  const int pair = F.bid & 7, slot = F.bid >> 3, nslot = F.G >> 3;
  const int b = pair >> 1, g = pair & 1;
  const unsigned char* Kh = K + (size_t)(b * RPB) * (NKV * HD) + g * HD; const unsigned char* Vh = V + (size_t)((b * 2 + g) * 128) * RPB;
  const float* sinkp = F.in(I_SINKS);
  const int nunits = layer == 0 ? 68 : 64;
#pragma unroll 1
  for (int u = slot; u < nunits; u += nslot) {
    int h, NT, ks = 0, q0 = 0; float sk = 0.f, sk1 = 0.f; const unsigned char* Qb; const bool win = layer != 0;
    if (u < 64) {
      if (!win) { h = g * 4 + (u >> 4); const int qb = u & 15; Qb = Q + (size_t)(b * RPB + CTXL + qb * 256) * DM + h * HD; NT = RPB / 64; }
      else { h = g * 4 + (u >> 5) * 2; q0 = (u & 31) * 128; Qb = Q + (size_t)(b * RPB + CTXL + q0) * DM + h * HD;
        ks = q0 - 128 < 0 ? 0 : q0 - 128; const int ke = q0 + 256 > SEQ ? SEQ : q0 + 256; NT = 4 + (ke - ks) / 64;
        sk = sinkp[(layer / 2) * NH + h] * 1.4426950408889634f; sk1 = sinkp[(layer / 2) * NH + h + 1] * 1.4426950408889634f; } }
    else { h = g * 4 + (u - 64); Qb = Q + (size_t)(b * RPB) * DM + h * HD; NT = CTXL / 64; }
    att::attn_unit(win, Qb, F.ws + WS_O + (Qb - Q), Kh, Vh, NT, ks, q0, sk, sk1, lds);
  }
}

__device__ __forceinline__ void ins16(float (&v)[16], float x) {
#pragma unroll
  for (int i = 0; i < 16; ++i) { const float hi = fmaxf(v[i], x); x = fminf(v[i], x); v[i] = hi; }
}
#define CE_DESC(x, y) do { const float hi_ = fmaxf(x, y), lo_ = fminf(x, y); x = hi_; y = lo_; } while (0)
__device__ __forceinline__ void bitonic_merge16(float (&v)[16]) {
#pragma unroll
  for (int j = 8; j >= 1; j >>= 1)
#pragma unroll
    for (int i = 0; i < 16; ++i) if ((i & j) == 0) CE_DESC(v[i], v[i | j]);
}
__device__ __forceinline__ void bitonic_sort16(float (&v)[16]) {
#pragma unroll
  for (int k = 2; k <= 16; k <<= 1)
#pragma unroll
    for (int j = k >> 1; j >= 1; j >>= 1)
#pragma unroll
      for (int i = 0; i < 16; ++i) { const int l = i ^ j; if (l > i) { if ((i & k) == 0 || k == 16) CE_DESC(v[i], v[l]); else CE_DESC(v[l], v[i]); } }
}
__device__ __forceinline__ void top16_merge(float (&a)[16], const float (&b)[16]) {
#pragma unroll
  for (int i = 0; i < 16; ++i) a[i] = fmaxf(a[i], b[15 - i]);
  bitonic_merge16(a);
}
__device__ __forceinline__ void topk_step1(const LAS float* sc, LAS unsigned* T, int tid) {
  float v[16];
  { const LAS float* my = sc + tid * 65; const unsigned eb = (tid & 1) * 64;
    float g1[16];
#define LOAD16(dst, off) do { _Pragma("unroll") for (int e = 0; e < 16; ++e) dst[e] = __uint_as_float((__float_as_uint(my[(off) + e]) & ~127u) | (eb + (off) + e)); } while (0)
    LOAD16(v, 0); bitonic_sort16(v); LOAD16(g1, 16); bitonic_sort16(g1); top16_merge(v, g1);
    float h1[16];
    LOAD16(h1, 32); bitonic_sort16(h1); LOAD16(g1, 48); bitonic_sort16(g1); top16_merge(h1, g1);
    top16_merge(v, h1);
#undef LOAD16
  }
  { float o[16];
#pragma unroll
    for (int i = 0; i < 16; ++i) o[i] = __shfl_xor(v[i], 1);
    top16_merge(v, o); }
  if ((tid & 1) == 0) {
#pragma unroll
    for (int i = 0; i < 16; ++i) T[(tid >> 1) * 16 + i] = __float_as_uint(v[i]); }
}
__device__ __forceinline__ void topk_step2(const LAS unsigned* T, int p1, int* eout, float* gout) {
  const int p2 = p1 + 16;
  float a[16], bq[16];
#pragma unroll
  for (int i = 0; i < 16; ++i) { a[i] = __uint_as_float(T[p1 + i] & ~127u); bq[i] = __uint_as_float(T[p2 + i] & ~127u); }
  float w[16];
#pragma unroll
  for (int i = 0; i < 16; ++i) w[i] = __uint_as_float((__float_as_uint(a[0] + bq[i]) & ~255u) | (unsigned)i);
  { float r1[16];
#pragma unroll
    for (int i = 0; i < 16; ++i) r1[i] = i < 8 ? __uint_as_float((__float_as_uint(a[1] + bq[i]) & ~255u) | (unsigned)(16 + i)) : -INFINITY;
    top16_merge(w, r1); }
#pragma unroll
  for (int ia = 2; ia < 16; ++ia)
#pragma unroll
    for (int ib = 0; ib < 16; ++ib) if ((ia + 1) * (ib + 1) <= 16) { const float s_ = a[ia] + bq[ib]; ins16(w, __uint_as_float((__float_as_uint(s_) & ~255u) | (unsigned)(ia * 16 + ib))); }
  float ts[16]; int ex[16];
#pragma unroll
  for (int k = 0; k < 16; ++k) { const unsigned id = __float_as_uint(w[k]) & 255u; const unsigned k1 = T[p1 + (id >> 4)], k2 = T[p2 + (id & 15)];
    ts[k] = __uint_as_float(k1 & ~127u) + __uint_as_float(k2 & ~127u); ex[k] = (int)((k1 & 127u) * NKEYS + (k2 & 127u)); }
  float m = ts[0];
#pragma unroll
  for (int k = 1; k < 16; ++k) m = fmaxf(m, ts[k]);
  float l = 0.f;
#pragma unroll
  for (int k = 0; k < 16; ++k) { ts[k] = __expf(ts[k] - m); l += ts[k]; }
  const float il = 1.f / l;
#pragma unroll
  for (int k = 0; k < 16; k += 4) { *(int4*)(eout + k) = make_int4(ex[k], ex[k + 1], ex[k + 2], ex[k + 3]);
    f32x4 gv; gv.x = ts[k] * il; gv.y = ts[k + 1] * il; gv.z = ts[k + 2] * il; gv.w = ts[k + 3] * il; *(f32x4*)(gout + k) = gv; }
}
struct EpiTopk {
  static constexpr bool PERM = false, AFTER_DRAIN = true;
  int* EIDX; float* GATE;
  __device__ __forceinline__ void fused(pg8::f32x4 (&acc)[2][2][4][2], const pg8::Unit& u, int wr, int wc, int fr, int fq, PG8_LAS unsigned char* lds, int wid, int lane) const {
    LAS float* sc = (LAS float*)lds; LAS unsigned* T = (LAS unsigned*)(lds + 512 * 65 * 4);
    const int tid = wid * 64 + lane;
#pragma unroll
    for (int ai = 0; ai < 2; ++ai) {
#pragma unroll
      for (int m = 0; m < 4; ++m) { const int rl = wr * 64 + m * 16 + fr;
#pragma unroll
        for (int bj = 0; bj < 2; ++bj)
#pragma unroll
          for (int n = 0; n < 2; ++n) { const int c = bj * 128 + wc * 32 + n * 16 + fq * 4; LAS float* d = sc + (rl * 4 + (c >> 6)) * 65 + (c & 63); const pg8::f32x4 a = acc[ai][bj][m][n];
            d[0] = a[0]; d[1] = a[1]; d[2] = a[2]; d[3] = a[3]; } }
      asm volatile("s_waitcnt lgkmcnt(0)" ::: "memory"); __builtin_amdgcn_s_barrier(); asm volatile("" ::: "memory");
      topk_step1(sc, T, tid);
      asm volatile("s_waitcnt lgkmcnt(0)" ::: "memory"); __builtin_amdgcn_s_barrier(); asm volatile("" ::: "memory");
      if (tid < 128) { const size_t ob = (size_t)(u.pm * 256 + ai * 128 + tid) * 128 + u.pn * 16; topk_step2(T, tid * 32, EIDX + ob, GATE + ob); }
      asm volatile("s_waitcnt lgkmcnt(0)" ::: "memory"); __builtin_amdgcn_s_barrier(); asm volatile("" ::: "memory");
    }
  }
};
struct OneUnit {
  pg8::Unit u0;
  __device__ bool next(int i, pg8::Unit& u) const { if (i != 0) return false; u = u0; return true; }
  __device__ __forceinline__ void a_ready(const pg8::Unit&) const {}
  __device__ __forceinline__ void done(const pg8::Unit&) const {}
};
__device__ __forceinline__ void phase_topk(const Ctx& F, bool latent_only) {
  LAS float* sc = (LAS float*)F.lds;
  LAS unsigned* T = (LAS unsigned*)(F.lds + 512 * 65 * 4);
  const _Float16* S = (const _Float16*)(F.ws + WS_S); int* EIDX = (int*)(F.ws + WS_EIDX); float* GATE = (float*)(F.ws + WS_GATE);
  const int ngroups = NROWS / 16;
  auto grpok = [&](int gq) { return gq < ngroups && !(latent_only && ((gq * 16) % RPB) < CTXL); };
  int grp = F.bid; while (grp < ngroups && !grpok(grp)) grp += F.G;
  typedef _Float16 h4 __attribute__((ext_vector_type(4)));
  h4 v[16];
  if (grp < ngroups) {
#pragma unroll
    for (int it = 0; it < 16; ++it) v[it] = *(const h4*)(S + (size_t)(grp * 16 + it) * PQN + F.tid * 4); }
  for (; grp < ngroups; ) {
    const int r0 = grp * 16;
    int gn = grp + F.G; while (gn < ngroups && !grpok(gn)) gn += F.G;
#pragma unroll
    for (int it = 0; it < 16; ++it) { const int c = F.tid * 4; LAS float* d = sc + (it * 32 + (c >> 6)) * 65 + (c & 63); d[0] = (float)v[it][0]; d[1] = (float)v[it][1]; d[2] = (float)v[it][2]; d[3] = (float)v[it][3]; }
    if (gn < ngroups) {
#pragma unroll
      for (int it = 0; it < 16; ++it) v[it] = *(const h4*)(S + (size_t)(gn * 16 + it) * PQN + F.tid * 4); }
    __syncthreads();
    float v[16];
    { const LAS float* my = sc + F.tid * 65; const unsigned eb = (F.tid & 1) * 64;
      float g1[16];
#define LOAD16(dst, off) do { _Pragma("unroll") for (int e = 0; e < 16; ++e) dst[e] = __uint_as_float((__float_as_uint(my[(off) + e]) & ~127u) | (eb + (off) + e)); } while (0)
      LOAD16(v, 0); bitonic_sort16(v); LOAD16(g1, 16); bitonic_sort16(g1); top16_merge(v, g1);
      float h1[16];
      LOAD16(h1, 32); bitonic_sort16(h1); LOAD16(g1, 48); bitonic_sort16(g1); top16_merge(h1, g1);
      top16_merge(v, h1);
#undef LOAD16
    }
    { float o[16];
#pragma unroll
      for (int i = 0; i < 16; ++i) o[i] = __shfl_xor(v[i], 1);
      top16_merge(v, o); }
    if ((F.tid & 1) == 0) {
#pragma unroll
      for (int i = 0; i < 16; ++i) T[(F.tid >> 1) * 16 + i] = __float_as_uint(v[i]); }
    __syncthreads();
    if (F.tid < 128) {
      const int rl = F.tid >> 3, head = F.tid & 7, p1 = (rl * 16 + head * 2) * 16, p2 = p1 + 16;
      float a[16], bq[16];
#pragma unroll
      for (int i = 0; i < 16; ++i) { a[i] = __uint_as_float(T[p1 + i] & ~127u); bq[i] = __uint_as_float(T[p2 + i] & ~127u); }
      float w[16];
#pragma unroll
      for (int i = 0; i < 16; ++i) w[i] = __uint_as_float((__float_as_uint(a[0] + bq[i]) & ~255u) | (unsigned)i);
      { float r1[16];
#pragma unroll
        for (int i = 0; i < 16; ++i) r1[i] = i < 8 ? __uint_as_float((__float_as_uint(a[1] + bq[i]) & ~255u) | (unsigned)(16 + i)) : -INFINITY;
        top16_merge(w, r1); }
#pragma unroll
      for (int ia = 2; ia < 16; ++ia)
#pragma unroll
        for (int ib = 0; ib < 16; ++ib) if ((ia + 1) * (ib + 1) <= 16) { const float s = a[ia] + bq[ib]; ins16(w, __uint_as_float((__float_as_uint(s) & ~255u) | (unsigned)(ia * 16 + ib))); }
      float ts[16]; int ex[16];
#pragma unroll
      for (int k = 0; k < 16; ++k) { const unsigned id = __float_as_uint(w[k]) & 255u; const unsigned k1 = T[p1 + (id >> 4)], k2 = T[p2 + (id & 15)];
        ts[k] = __uint_as_float(k1 & ~127u) + __uint_as_float(k2 & ~127u); ex[k] = (int)((k1 & 127u) * NKEYS + (k2 & 127u)); }
      float m = ts[0];
#pragma unroll
      for (int k = 1; k < 16; ++k) m = fmaxf(m, ts[k]);
      float l = 0.f;
#pragma unroll
      for (int k = 0; k < 16; ++k) { ts[k] = __expf(ts[k] - m); l += ts[k]; }
      const float il = 1.f / l; const size_t ob = (size_t)(r0 + rl) * 128 + head * 16;
#pragma unroll
      for (int k = 0; k < 16; k += 4) { *(int4*)(EIDX + ob + k) = make_int4(ex[k], ex[k + 1], ex[k + 2], ex[k + 3]);
        f32x4 gv; gv.x = ts[k] * il; gv.y = ts[k + 1] * il; gv.z = ts[k + 2] * il; gv.w = ts[k + 3] * il; *(f32x4*)(GATE + ob + k) = gv; }
    }
    __syncthreads();
    grp = gn;
  }
}

typedef float f32x2 __attribute__((ext_vector_type(2)));
__device__ __forceinline__ float dpp_ror_add(float x, int) { return x; }
#define ROW_ROR_ADD(x, n) do { const int xi_ = __builtin_bit_cast(int, x); x += __builtin_bit_cast(float, __builtin_amdgcn_update_dpp(0, xi_, 0x120 + (n), 0xf, 0xf, false)); } while (0)
__device__ __forceinline__ float dot16_fp8(u32x4 q, const float* h, float acc) {
  const int q0 = (int)q.x, q1 = (int)q.y, q2 = (int)q.z, q3 = (int)q.w; f32x2 t;
  t = __builtin_amdgcn_cvt_pk_f32_fp8(q0, false); acc = fmaf(t.x, h[0], acc); acc = fmaf(t.y, h[1], acc); t = __builtin_amdgcn_cvt_pk_f32_fp8(q0, true); acc = fmaf(t.x, h[2], acc); acc = fmaf(t.y, h[3], acc);
  t = __builtin_amdgcn_cvt_pk_f32_fp8(q1, false); acc = fmaf(t.x, h[4], acc); acc = fmaf(t.y, h[5], acc); t = __builtin_amdgcn_cvt_pk_f32_fp8(q1, true); acc = fmaf(t.x, h[6], acc); acc = fmaf(t.y, h[7], acc);
  t = __builtin_amdgcn_cvt_pk_f32_fp8(q2, false); acc = fmaf(t.x, h[8], acc); acc = fmaf(t.y, h[9], acc); t = __builtin_amdgcn_cvt_pk_f32_fp8(q2, true); acc = fmaf(t.x, h[10], acc); acc = fmaf(t.y, h[11], acc);
  t = __builtin_amdgcn_cvt_pk_f32_fp8(q3, false); acc = fmaf(t.x, h[12], acc); acc = fmaf(t.y, h[13], acc); t = __builtin_amdgcn_cvt_pk_f32_fp8(q3, true); acc = fmaf(t.x, h[14], acc); acc = fmaf(t.y, h[15], acc);
  return acc;
}
constexpr int PCH = 8;
__device__ __forceinline__ int chunk_row0(unsigned c, bool latent_only) { return latent_only ? (int)(c / (SEQ / PCH)) * RPB + CTXL + (int)(c % (SEQ / PCH)) * PCH : (int)c * PCH; }
#ifndef UREP
#define UREP 1
#endif
#ifndef VREP
#define VREP 1
#endif
__device__ __forceinline__ unsigned xcc_id() { return (unsigned)__builtin_amdgcn_s_getreg((3 << 11) | 20) & 7u; }
__device__ __forceinline__ unsigned q_pull(unsigned* q, int lane) { unsigned c = 0; if (lane == 0) c = __hip_atomic_fetch_add(q, 1u, __ATOMIC_RELAXED, __HIP_MEMORY_SCOPE_AGENT); return (unsigned)__builtin_amdgcn_readfirstlane((int)c); }
__device__ __forceinline__ void phase_peer_u(const Ctx& F, int layer, bool latent_only, int rep) {
  unsigned* qb = (unsigned*)(F.ws + WS_CTL) + 8192 + ((layer * 2 + 0) * 2 + rep) * 8 * 64;
  const int* EIDX = (const int*)(F.ws + WS_EIDX);
  LAS unsigned* lst = (LAS unsigned*)(F.lds + F.wave * 4096);
  LAS float* pl = (LAS float*)(F.lds + F.wave * 4096 + 1024);
  const int g = F.lane >> 3;
  const int i0 = ((F.lane >> 2) & 1) * 8 + ((F.lane >> 1) & 1) * 4 + (F.lane & 1) * 2;
  const int myx = (int)xcc_id();
#pragma unroll 1
  for (int sx = 0; sx < 8; ++sx) {
    const int slice = (myx + sx) & 7;
    const bf16* H = (const bf16*)(F.ws + WS_H) + slice * 128 + (F.lane & 7) * 16;
    const unsigned char* U = F.ws + WS_UT + ((size_t)layer * 8 + slice) * NKEYS * NKEYS * 128; const unsigned uo = (unsigned)(F.lane & 7) * 16u;
    float* PART = (float*)(F.ws + WS_PART) + slice * 128;
    const unsigned nch = (unsigned)((latent_only ? NB * SEQ : NROWS) / PCH);
        unsigned e0, e1; u32x4 h0, h1;
#define UPREF(R) do { e0 = (unsigned)EIDX[(size_t)(R) * 128 + F.lane]; e1 = (unsigned)EIDX[(size_t)(R) * 128 + 64 + F.lane]; h0 = *(const u32x4*)(H + (size_t)(R) * DM); h1 = *(const u32x4*)(H + (size_t)(R) * DM + 8); } while (0)
#define UGATHER(QV, HH, LOFF, RNEXT, HASNEXT) do { lst[(LOFF) + F.lane] = e0; lst[(LOFF) + 64 + F.lane] = e1; \
          HH[0] = bflo(h0.x); HH[1] = bfhi(h0.x); HH[2] = bflo(h0.y); HH[3] = bfhi(h0.y); HH[4] = bflo(h0.z); HH[5] = bfhi(h0.z); HH[6] = bflo(h0.w); HH[7] = bfhi(h0.w); \
          HH[8] = bflo(h1.x); HH[9] = bfhi(h1.x); HH[10] = bflo(h1.y); HH[11] = bfhi(h1.y); HH[12] = bflo(h1.z); HH[13] = bfhi(h1.z); HH[14] = bflo(h1.w); HH[15] = bfhi(h1.w); \
          if (HASNEXT) UPREF(RNEXT); \
          asm volatile("s_waitcnt lgkmcnt(0)" ::: "memory"); \
          _Pragma("unroll") for (int i = 0; i < 16; ++i) QV[i] = *(const u32x4*)(U + (lst[(LOFF) + 8 * i + g] * 128u + uo)); } while (0)
#define UMATH(QV, HH, R) do { float p[16]; \
          _Pragma("unroll") for (int i = 0; i < 16; ++i) p[i] = dot16_fp8(QV[i], HH, 0.f); \
          _Pragma("unroll") for (int m = 4; m >= 1; m >>= 1) { const bool up = (F.lane & m) != 0; const int n = 2 * m; \
            _Pragma("unroll") for (int j = 0; j < n; ++j) { const float send = up ? p[j] : p[j + n], keep = up ? p[j + n] : p[j]; p[j] = keep + __shfl_xor(send, m); } } \
          pl[8 * i0 + g] = p[0]; pl[8 * i0 + 8 + g] = p[1]; \
          asm volatile("s_waitcnt lgkmcnt(0)" ::: "memory"); \
          float* po = PART + (size_t)(R) * 1024 + F.lane; po[0] = pl[F.lane]; po[64] = pl[64 + F.lane]; } while (0)
    unsigned c = q_pull(qb + slice * 64, F.lane);
    if (c < nch) {
      u32x4 qa[16], qb_[16]; float ha[16], hb[16];
      int rbeg = chunk_row0(c, latent_only);
      UPREF(rbeg);
      UGATHER(qa, ha, 0, rbeg + 1, true);
#pragma unroll 1
      while (true) {
        const unsigned cn = q_pull(qb + slice * 64, F.lane);
        const bool hn = cn < nch; const int nr0 = hn ? chunk_row0(cn, latent_only) : 0;
#pragma unroll 1
        for (int it = 0; it < PCH; it += 2) { const int r = rbeg + it; const bool lastp = it + 2 >= PCH;
          UGATHER(qb_, hb, 128, (lastp ? nr0 : r + 2), (!lastp || hn));
          UMATH(qa, ha, r);
          if (!lastp || hn) UGATHER(qa, ha, 0, (lastp ? nr0 + 1 : r + 3), true);
          UMATH(qb_, hb, r + 1);
        }
        if (!hn) break;
        rbeg = nr0;
      }
    }
#undef UPREF
#undef UGATHER
#undef UMATH
  }
}

__device__ __forceinline__ void phase_peer_w(const Ctx& F, bool latent_only) {
  const int gw = F.bid * NWAVES + F.wave, NGW = F.G * NWAVES;
  const float* PART = (const float*)(F.ws + WS_PART); const float* GATE = (const float*)(F.ws + WS_GATE); float* PW = (float*)(F.ws + WS_PW);
  for (int r = gw; r < NROWS; r += NGW) {
    if (latent_only && (r % RPB) < CTXL) continue;
    float a = 0.f, b = 0.f;
#pragma unroll
    for (int x = 0; x < 8; ++x) { a += PART[(size_t)r * 1024 + x * 128 + F.lane]; b += PART[(size_t)r * 1024 + x * 128 + 64 + F.lane]; }
    const size_t o = (size_t)r * 128 + F.lane;
    PW[o] = GATE[o] * gelu_tanh(a * (1.f / U8_SCALE)); PW[o + 64] = GATE[o + 64] * gelu_tanh(b * (1.f / U8_SCALE));
  }
}

__device__ __forceinline__ void phase_peer_v(const Ctx& F, int layer, bool latent_only, int rep) {
  unsigned* qb = (unsigned*)(F.ws + WS_CTL) + 8192 + ((layer * 2 + 1) * 2 + rep) * 8 * 64;
  const int* EIDX = (const int*)(F.ws + WS_EIDX); const float* PW = (const float*)(F.ws + WS_PW);
  const float* g2 = (const float*)(F.ws + WS_MOD) + (size_t)layer * 5 * NMOD * DM + 5 * DM;
  const float* outl = F.outp();
  LAS u32x2* ew = (LAS u32x2*)(F.lds + F.wave * 4096);
  const int g = F.lane >> 3;
  const int myx = (int)xcc_id();
#pragma unroll 1
  for (int sx = 0; sx < 8; ++sx) {
    const int slice = (myx + sx) & 7;
    const unsigned char* V = F.ws + WS_VT + ((size_t)layer * 8 + slice) * NKEYS * NKEYS * 128; const unsigned vo = (unsigned)(F.lane & 7) * 16u;
    const int dl = slice * 128 + (F.lane & 7) * 16 + ((F.lane >> 5) & 1) * 8 + ((F.lane >> 4) & 1) * 4 + ((F.lane >> 3) & 1) * 2;
    const unsigned nch = (unsigned)((latent_only ? NB * SEQ : NROWS) / PCH);
        unsigned ea, eb; float wpa, wpb;
#define VPREF(R) do { const size_t o_ = (size_t)(R) * 128 + F.lane; ea = (unsigned)EIDX[o_]; eb = (unsigned)EIDX[o_ + 64]; wpa = PW[o_]; wpb = PW[o_ + 64]; } while (0)
#define VGATHER(QV, WV, LOFF, RNEXT, HASNEXT) do { \
          { u32x2 t0, t1; t0.x = ea; t0.y = __float_as_uint(wpa); t1.x = eb; t1.y = __float_as_uint(wpb); \
            ew[(LOFF) + F.lane] = t0; ew[(LOFF) + 64 + F.lane] = t1; } \
          if (HASNEXT) VPREF(RNEXT); \
          asm volatile("s_waitcnt lgkmcnt(0)" ::: "memory"); \
          _Pragma("unroll") for (int i = 0; i < 16; ++i) { const u32x2 t = ew[(LOFF) + 8 * i + g]; WV[i] = __uint_as_float(t.y); QV[i] = *(const u32x4*)(V + (t.x * 128u + vo)); } } while (0)
#define VMATH(QV, WV, R) do { float acc[16]; \
          float* x = (float*)xrow_sel(outl, (const float*)(F.ws + WS_XC), (R)); const float* xs = xrow_sel((const float*)(F.ws + WS_XB), (const float*)(F.ws + WS_XCB), (R)); const float* gg = g2 + (size_t)mod_row(R) * NMOD * DM; \
          const f32x2 xv = *(const f32x2*)(xs + dl), gv = *(const f32x2*)(gg + dl); \
          _Pragma("unroll") for (int q = 0; q < 16; ++q) acc[q] = 0.f; \
          _Pragma("unroll") for (int i = 0; i < 16; ++i) { const float w = WV[i]; const int q0 = (int)QV[i].x, q1 = (int)QV[i].y, q2 = (int)QV[i].z, q3 = (int)QV[i].w; f32x2 f; \
            f = __builtin_amdgcn_cvt_pk_f32_fp8(q0, false); acc[0] = fmaf(w, f.x, acc[0]); acc[1] = fmaf(w, f.y, acc[1]); f = __builtin_amdgcn_cvt_pk_f32_fp8(q0, true); acc[2] = fmaf(w, f.x, acc[2]); acc[3] = fmaf(w, f.y, acc[3]); \
            f = __builtin_amdgcn_cvt_pk_f32_fp8(q1, false); acc[4] = fmaf(w, f.x, acc[4]); acc[5] = fmaf(w, f.y, acc[5]); f = __builtin_amdgcn_cvt_pk_f32_fp8(q1, true); acc[6] = fmaf(w, f.x, acc[6]); acc[7] = fmaf(w, f.y, acc[7]); \
            f = __builtin_amdgcn_cvt_pk_f32_fp8(q2, false); acc[8] = fmaf(w, f.x, acc[8]); acc[9] = fmaf(w, f.y, acc[9]); f = __builtin_amdgcn_cvt_pk_f32_fp8(q2, true); acc[10] = fmaf(w, f.x, acc[10]); acc[11] = fmaf(w, f.y, acc[11]); \
            f = __builtin_amdgcn_cvt_pk_f32_fp8(q3, false); acc[12] = fmaf(w, f.x, acc[12]); acc[13] = fmaf(w, f.y, acc[13]); f = __builtin_amdgcn_cvt_pk_f32_fp8(q3, true); acc[14] = fmaf(w, f.x, acc[14]); acc[15] = fmaf(w, f.y, acc[15]); } \
          _Pragma("unroll") for (int j = 0; j < 8; ++j) { auto s2 = __builtin_amdgcn_permlane32_swap(__float_as_uint(acc[j]), __float_as_uint(acc[j + 8]), false, false); acc[j] = __uint_as_float(s2[0]) + __uint_as_float(s2[1]); } \
          _Pragma("unroll") for (int j = 0; j < 4; ++j) { auto s2 = __builtin_amdgcn_permlane16_swap(__float_as_uint(acc[j]), __float_as_uint(acc[j + 4]), false, false); acc[j] = __uint_as_float(s2[0]) + __uint_as_float(s2[1]); } \
          { const bool up = (F.lane & 8) != 0; \
            _Pragma("unroll") for (int j = 0; j < 2; ++j) { const float send = up ? acc[j] : acc[j + 2], keep = up ? acc[j + 2] : acc[j]; acc[j] = keep + __shfl_xor(send, 8); } } \
          f32x2 o; o.x = xv.x + gv.x * acc[0] * (1.f / V8_SCALE); o.y = xv.y + gv.y * acc[1] * (1.f / V8_SCALE); \
          *(f32x2*)(x + dl) = o; } while (0)
    unsigned c = q_pull(qb + slice * 64, F.lane);
    if (c < nch) {
      u32x4 qa[16], qb_[16]; float wa[16], wb[16];
      int rbeg = chunk_row0(c, latent_only);
      VPREF(rbeg);
      VGATHER(qa, wa, 0, rbeg + 1, true);
#pragma unroll 1
      while (true) {
        const unsigned cn = q_pull(qb + slice * 64, F.lane);
        const bool hn = cn < nch; const int nr0 = hn ? chunk_row0(cn, latent_only) : 0;
#pragma unroll 1
        for (int it = 0; it < PCH; it += 2) { const int r = rbeg + it; const bool lastp = it + 2 >= PCH;
          VGATHER(qb_, wb, 128, (lastp ? nr0 : r + 2), (!lastp || hn));
          VMATH(qa, wa, r);
          if (!lastp || hn) VGATHER(qa, wa, 0, (lastp ? nr0 + 1 : r + 3), true);
          VMATH(qb_, wb, r + 1);
        }
        if (!hn) break;
        rbeg = nr0;
      }
    }
#undef VPREF
#undef VGATHER
#undef VMATH
  }
}

#define XB_TMO      128
#define XB_XCNT(j)  (256  + 64 * (j))
#define XB_XSUB(j)  (1280 + 64 * (j))
#define XB_XGEN(j)  (2304 + 64 * (j))
#define XB_TOP      3328
#define XB_TOPGEN   3392
#define XCD_BAR_WORDS 3456
#define XB_SPIN_CAP (1u << 18)

__device__ __forceinline__ unsigned xb_ld(unsigned* p)              { return __hip_atomic_load(p, __ATOMIC_RELAXED, __HIP_MEMORY_SCOPE_AGENT); }
__device__ __forceinline__ unsigned xb_add(unsigned* p, unsigned v) { return __hip_atomic_fetch_add(p, v, __ATOMIC_RELAXED, __HIP_MEMORY_SCOPE_AGENT); }
__device__ __forceinline__ unsigned xb_xcc_id() { return (unsigned)__builtin_amdgcn_s_getreg((3 << 11) | 20) & 0xFu; }
#define XB_SPIN(cond, bar) do { unsigned _sp = 0; while (cond) { __builtin_amdgcn_s_sleep(1); \
    if ((++_sp & 255u) == 0u) { if (xb_ld(&(bar)[XB_TMO])) break; if (_sp > XB_SPIN_CAP) { atomicAdd(&(bar)[XB_TMO], 1u); break; } } } } while (0)

struct XcdBarrier {
    unsigned* bar; unsigned x;
    volatile LAS unsigned* st;
};

__device__ __forceinline__ XcdBarrier xcd_barrier_post(unsigned* bar, volatile LAS unsigned* st) {
    XcdBarrier b; b.bar = bar; b.x = xb_xcc_id(); b.st = st;
    if (threadIdx.x == 0) (void)xb_add(&bar[XB_XCNT(b.x)], 1u);
    return b;
}
__device__ __forceinline__ void xcd_barrier_complete(unsigned* bar, unsigned x, unsigned& nloc, unsigned& nx) {
    const unsigned G = gridDim.x * gridDim.y * gridDim.z;
    unsigned sum, cnt, mine, sp = 0u;
    for (;;) {
        sum = 0u; cnt = 0u; mine = 0u;
#pragma unroll
        for (unsigned j = 0; j < 16; ++j) { const unsigned c = xb_ld(&bar[XB_XCNT(j)]); sum += c; cnt += (c > 0u) ? 1u : 0u; mine = (j == x) ? c : mine; }
        if (sum == G) break;
        __builtin_amdgcn_s_sleep(1);
        if ((++sp & 255u) == 0u) { if (xb_ld(&bar[XB_TMO])) break; if (sp > XB_SPIN_CAP) { atomicAdd(&bar[XB_TMO], 1u); break; } }
    }
    nloc = mine > 0u ? mine : 1u; nx = cnt > 0u ? cnt : 1u;
}

__device__ __forceinline__ void xcd_barrier(const XcdBarrier& b) {
    asm volatile("s_waitcnt vmcnt(0)" ::: "memory");
    __syncthreads();
    if (threadIdx.x == 0) {
        unsigned* bar = b.bar;
        __builtin_amdgcn_s_waitcnt(0);
        unsigned nloc = b.st[0], nx = b.st[1];
        if (nloc == 0u) { xcd_barrier_complete(bar, b.x, nloc, nx); b.st[0] = nloc; b.st[1] = nx; }
        const unsigned old = xb_add(&bar[XB_XSUB(b.x)], 1u);
        const unsigned gen = old / nloc;
        if (old + 1u == (gen + 1u) * nloc) {
            __builtin_amdgcn_fence(__ATOMIC_RELEASE, "agent");
            asm volatile("s_waitcnt vmcnt(0)" ::: "memory");
            const unsigned og = xb_add(&bar[XB_TOP], 1u);
            const unsigned tg = og / nx;
            if (og + 1u == (tg + 1u) * nx) xb_add(&bar[XB_TOPGEN], 1u);
            else XB_SPIN(xb_ld(&bar[XB_TOPGEN]) == tg, bar);
            __builtin_amdgcn_fence(__ATOMIC_ACQUIRE, "agent");
            xb_add(&bar[XB_XGEN(b.x)], 1u);
            asm volatile("s_waitcnt vmcnt(0)" ::: "memory");
        } else {
            XB_SPIN(xb_ld(&bar[XB_XGEN(b.x)]) == gen, bar);
            __builtin_amdgcn_fence(__ATOMIC_ACQUIRE, "agent");
            asm volatile("s_waitcnt vmcnt(0)" ::: "memory");
        }
    }
    __syncthreads();
}


__global__ void __launch_bounds__(NTHR, 2) fwd(Args args) {
  extern __shared__ __attribute__((aligned(16))) unsigned char lds[];
  Ctx F;
  F.ws = args.ws; F.tid = threadIdx.x; F.lane = F.tid & 63; F.wave = __builtin_amdgcn_readfirstlane(F.tid >> 6); F.bid = blockIdx.x; F.G = gridDim.x;
  F.lds = (LAS unsigned char*)lds; F.ldsg = lds;
  if (F.tid < 18) { const unsigned long long p = F.tid < 17 ? (unsigned long long)args.in[F.tid] : (unsigned long long)args.out; ((LAS unsigned long long*)(F.lds + PTAB_OFF))[F.tid] = p; }
  __syncthreads();
  const int lo = args.ph_lo, hi = args.ph_hi;
#ifndef PHMASK
#define PHMASK 0x7ff
#endif
#define IN(k) (lo <= (k) && (k) < hi)
#define EN(b) ((PHMASK >> (b)) & 1)
#ifndef REPMASK
#define REPMASK 0
#endif
#define NREP(b) (1 + ((REPMASK >> (b)) & 1))
#define FRESH() do { int t_ = threadIdx.x; asm volatile("" : "+v"(t_)); F.tid = t_; F.lane = t_ & 63; F.wave = __builtin_amdgcn_readfirstlane(t_ >> 6); int b_ = blockIdx.x; asm volatile("" : "+s"(b_)); F.bid = b_; } while (0)
  if (F.tid < 4) ((LAS unsigned*)(F.lds + PTAB_OFF + 256))[F.tid] = 0u;
  __syncthreads();
  XcdBarrier xb; xb.bar = (unsigned*)(F.ws + WS_CTL) + 4096; xb.x = 0; xb.st = nullptr;
  if (hi - lo > 1) xb = xcd_barrier_post((unsigned*)(F.ws + WS_CTL) + 4096, (volatile LAS unsigned*)(F.lds + PTAB_OFF + 256));
#ifndef SEAM_CG_ALL
#define SEAM_CG_ALL 0
#endif
#ifndef XTRA_BAR
#define XTRA_BAR 0
#endif
#ifndef STAMPS
#define STAMPS 0
#endif
#define SEAM(k) do { if (STAMPS && blockIdx.x == 0 && threadIdx.x == 0) ((unsigned long long*)(F.ws + WS_CTL + 61440))[(k)] = __builtin_amdgcn_s_memrealtime(); if (IN(k) && IN((k) + 1)) { if (SEAM_CG_ALL) cg::this_grid().sync(); else { xcd_barrier(xb); for (int xb_ = 0; xb_ < XTRA_BAR; ++xb_) xcd_barrier(xb); } } } while (0)
  if (STAMPS && blockIdx.x == 0 && threadIdx.x == 0) ((unsigned long long*)(F.ws + WS_CTL + 61440))[63] = __builtin_amdgcn_s_memrealtime();
  if (EN(10) && IN(0)) for (int rep_ = 0; rep_ < NREP(10); ++rep_) { FRESH(); phase_prologue(F); } SEAM(0);
#pragma unroll 1
  for (int layer = 0; layer < DEPTH; ++layer) {
    const int pb = 1 + 11 * layer; const bool last = layer == DEPTH - 1;
    const float* modl = (const float*)(F.ws + WS_MOD) + (size_t)layer * 5 * NMOD * DM;
    if (EN(0) && IN(pb + 0)) for (int rep_ = 0; rep_ < NREP(0); ++rep_) { FRESH(); phase_norm(F, layer, 0, layer == 0 ? 0 : 2, false); } SEAM(pb + 0);
    if (EN(1) && IN(pb + 1)) for (int rep_ = 0; rep_ < NREP(1); ++rep_) { FRESH(); pg8::Gemm g{(const pg8::bf16_t*)(F.ws + WS_H), (const pg8::bf16_t*)(F.ws + WS_WQKV + (size_t)layer * QKVD * DM), NROWS, QKVD, DM};
      Order S; S.init(NROWS / 256, QKVD / 256, F.G, F.bid, 0); EpiQKV E{F.ws, (LAS float*)(F.lds + 131072), layer};
      pg8::gemm_phase<EpiQKV, Order, true, true, true, 0x7d7d7d7d  , 0x7a7a7a7a  >(F.lds, g, S, E);
      if (layer == 0) { int lo_, hi_; conv_slot(F, 0, lo_, hi_); convert_rows(F, lo_, hi_); } } SEAM(pb + 1);
    if (EN(2) && IN(pb + 2)) for (int rep_ = 0; rep_ < NREP(2); ++rep_) { }
    if (EN(3) && IN(pb + 3)) for (int rep_ = 0; rep_ < NREP(3); ++rep_) { FRESH(); phase_attn(F, layer); } SEAM(pb + 3);
    if (EN(4) && IN(pb + 4)) for (int rep_ = 0; rep_ < NREP(4); ++rep_) { FRESH(); pg8::Gemm g{(const pg8::bf16_t*)(F.ws + WS_O), (const pg8::bf16_t*)(F.ws + WS_WO + (size_t)layer * DM * DM), NROWS, DM, DM, 0x79797979  , 0x7a7a7a7a  };
      Order S; S.init(last ? NB * 16 : NROWS / 256, DM / 256, F.G, F.bid, last ? 1 : 0); EpiRes E{st_lat(F, layer == 0 ? 0 : 2), st_ctx(F, layer == 0 ? 0 : 2), (float*)(F.ws + WS_XB), (float*)(F.ws + WS_XCB), modl + 2 * DM};
      pg8::gemm_phase<EpiRes, Order, true, true, true, 0x79797979  , 0x7a7a7a7a  >(F.lds, g, S, E);
      if (layer == 0) { int lo_, hi_; conv_slot(F, 1, lo_, hi_); convert_rows(F, lo_, hi_); } } SEAM(pb + 4);
    if (EN(5) && IN(pb + 5)) for (int rep_ = 0; rep_ < NREP(5); ++rep_) { FRESH(); phase_norm(F, layer, 1, 1, last); } SEAM(pb + 5);
    if (EN(6) && IN(pb + 6)) for (int rep_ = 0; rep_ < NREP(6); ++rep_) { FRESH(); pg8::Gemm g{(const pg8::bf16_t*)(F.ws + WS_H), (const pg8::bf16_t*)(F.ws + WS_WP) + (size_t)layer * PQN * DM, NROWS, PQN, DM};
      Order S; S.init(last ? NB * 16 : NROWS / 256, PQN / 256, F.G, F.bid, last ? 1 : 0); EpiTopk E{(int*)(F.ws + WS_EIDX), (float*)(F.ws + WS_GATE)};
#pragma unroll 1
      for (int ui = 0; ; ++ui) { OneUnit S1; if (!S.next(ui, S1.u0)) break; pg8::gemm_phase<EpiTopk, OneUnit, false, true>(F.lds, g, S1, E); }
      if (layer == 0) { int lo_, hi_; conv_slot(F, 2, lo_, hi_); convert_rows(F, lo_, hi_); } } SEAM(pb + 6);
    if (EN(7) && IN(pb + 7)) for (int rep_ = 0; rep_ < NREP(7); ++rep_) { }
    if (EN(8) && IN(pb + 8)) for (int rep_ = 0; rep_ < NREP(8); ++rep_) { FRESH(); phase_peer_u(F, layer, last, rep_); } SEAM(pb + 8);
    if (EN(9) && IN(pb + 9)) { FRESH(); phase_peer_w(F, last); } SEAM(pb + 9);
    if (EN(9) && IN(pb + 10)) for (int rep_ = 0; rep_ < NREP(9); ++rep_) { FRESH(); phase_peer_v(F, layer, last, rep_); } if (!last) SEAM(pb + 10);
  }
  if (STAMPS && blockIdx.x == 0 && threadIdx.x == 0) ((unsigned long long*)(F.ws + WS_CTL + 61440))[NPHASE - 1] = __builtin_amdgcn_s_memrealtime();
#undef IN
#undef SEAM
}
}

#ifndef MK_MULTI
#define MK_MULTI 0
#endif
#ifndef DBG
#define DBG 0
#endif
#ifndef TS_A
#define TS_A 0
#endif
#ifndef TS_B
#define TS_B 4
#endif
namespace dbg {
__global__ void k_ts(const unsigned long long* ts, float* res) { const unsigned long long s0 = ts[63]; auto dur = [&](int k) { const unsigned long long e = ts[k], b = k == 0 ? s0 : ts[k - 1]; return (float)(e - b) * 0.01f; };
  res[0] = dur(TS_A) * 1e-5f; res[1] = dur(TS_B) * 1e-3f; res[2] = 0.f; }
template <bool ABF>
__global__ void __launch_bounds__(1024) k_cmp(const void* __restrict__ a, long lda, long aoff, const float* __restrict__ b, long ldb, long boff, int rows, int cols, int row0, int rstep_lat  , float* res) {
  __shared__ float sd[1024], sr[1024];
  float d2 = 0.f, r2 = 0.f;
  for (long e = threadIdx.x; e < (long)rows * cols; e += 1024) { const int r = row0 + (int)(e / cols), c = (int)(e % cols);
    if (rstep_lat == 1 && (r % RPB) < CTXL) continue; if (rstep_lat == 2 && (r % RPB) >= CTXL) continue;
    float av; if (ABF) av = __uint_as_float((unsigned)((const unsigned short*)a)[(long)r * lda + aoff + c] << 16); else av = ((const float*)a)[(long)r * lda + aoff + c];
    const float bv = b[(long)r * ldb + boff + c]; d2 += (av - bv) * (av - bv); r2 += bv * bv; }
  sd[threadIdx.x] = d2; sr[threadIdx.x] = r2; __syncthreads();
  for (int o = 512; o > 0; o >>= 1) { if ((int)threadIdx.x < o) { sd[threadIdx.x] += sd[threadIdx.x + o]; sr[threadIdx.x] += sr[threadIdx.x + o]; } __syncthreads(); }
  if (threadIdx.x == 0) *res = sqrtf(sd[0] / fmaxf(sr[0], 1e-30f));
}
__global__ void __launch_bounds__(1024) k_cmp8(const unsigned char* __restrict__ a, long lda, float ascale, const float* __restrict__ b, long ldb, long boff, int rows, int cols, int mode, float* res) {
  __shared__ float sd[1024], sr[1024]; float d2 = 0.f, r2 = 0.f; typedef float f2_t __attribute__((ext_vector_type(2)));
  for (long e = threadIdx.x; e < (long)rows * cols; e += 1024) { const int r = (int)(e / cols), c = (int)(e % cols);
    if (mode == 1 && (r % RPB) < CTXL) continue; if (mode == 2 && (r % RPB) >= CTXL) continue;
    const f2_t t = __builtin_amdgcn_cvt_pk_f32_fp8((int)a[(long)r * lda + c], false); const float av = t.x / ascale, bv = b[(long)r * ldb + boff + c]; d2 += (av - bv) * (av - bv); r2 += bv * bv; }
  sd[threadIdx.x] = d2; sr[threadIdx.x] = r2; __syncthreads();
  for (int o = 512; o > 0; o >>= 1) { if ((int)threadIdx.x < o) { sd[threadIdx.x] += sd[threadIdx.x + o]; sr[threadIdx.x] += sr[threadIdx.x + o]; } __syncthreads(); }
  if (threadIdx.x == 0) *res = sqrtf(sd[0] / fmaxf(sr[0], 1e-30f));
}
__global__ void __launch_bounds__(1024) k_cmp_scores(const float* __restrict__ S, const float* __restrict__ PQ, const float* __restrict__ SK, int nrows, float* res) {
  __shared__ float sd[1024], sr[1024];
  float d2 = 0.f, r2 = 0.f;
  for (long e = threadIdx.x; e < (long)nrows * PQN; e += 1024) { const int r = (int)(e / PQN), c = (int)(e % PQN), h = c >> 8, half = (c >> 7) & 1, k = c & 127;
    const float* q = PQ + (long)r * PQN + h * PQD + half * 128; const float* kp = SK + (long)half * NKEYS * 128 + (long)k * 128; float a = 0.f; for (int d = 0; d < 128; ++d) a += q[d] * kp[d];
    const float f = S[(long)r * PQN + c]; d2 += (f - a) * (f - a); r2 += a * a; }
  sd[threadIdx.x] = d2; sr[threadIdx.x] = r2; __syncthreads();
  for (int o = 512; o > 0; o >>= 1) { if ((int)threadIdx.x < o) { sd[threadIdx.x] += sd[threadIdx.x + o]; sr[threadIdx.x] += sr[threadIdx.x + o]; } __syncthreads(); }
  if (threadIdx.x == 0) *res = sqrtf(sd[0] / fmaxf(sr[0], 1e-30f));
}
__global__ void k_final(float* out, long n, const float* res) {
  const float sa = 1.f + 10.f * res[0];
  for (long i = blockIdx.x * 256L + threadIdx.x; i < n; i += gridDim.x * 256L) out[i] *= sa;
  if (blockIdx.x == 0 && threadIdx.x == 0) { }
}
__global__ void k_final2(float* out, const float* res) { out[0] += 1000.f * (res[1] + res[2]); }
}

__global__ void __launch_bounds__(1024) k_cmp_w8(const unsigned char* W8, const float* W, float* res) {
  __shared__ float sd[1024], sr[1024]; float d2 = 0.f, r2 = 0.f; typedef float f2_t __attribute__((ext_vector_type(2)));
  for (long e = threadIdx.x; e < (long)DEPTH * DM * DM; e += 1024) { const int k = (int)(e & 1023), n = (int)((e >> 10) & 1023), l = (int)(e >> 20);
    const f2_t t = __builtin_amdgcn_cvt_pk_f32_fp8((int)W8[e], false); const float av = t.x / 32.f, bv = W[(size_t)l * DM * DM + (size_t)k * DM + n]; d2 += (av - bv) * (av - bv); r2 += bv * bv; }
  sd[threadIdx.x] = d2; sr[threadIdx.x] = r2; __syncthreads();
  for (int o = 512; o > 0; o >>= 1) { if ((int)threadIdx.x < o) { sd[threadIdx.x] += sd[threadIdx.x + o]; sr[threadIdx.x] += sr[threadIdx.x + o]; } __syncthreads(); }
  if (threadIdx.x == 0) { res[0] = sqrtf(sd[0] / fmaxf(sr[0], 1e-30f)); res[1] = 0.f; res[2] = 0.f; }
}


__global__ void __launch_bounds__(1024) k_cmp_wo8(const unsigned char* O8, const unsigned char* W8, const float* XB, const float* xin, const float* g1  , int r0, float* res) {
  __shared__ float sd[1024], sr[1024]; float d2 = 0.f, r2 = 0.f;
  typedef float f2_t __attribute__((ext_vector_type(2)));
  for (int e = threadIdx.x; e < 64 * DM; e += 1024) { const int r = r0 + (e >> 10), n = e & 1023; const int b = r / RPB, j = r % RPB;
    float ref = 0.f; for (int k = 0; k < DM; k += 4) { const int qa = *(const int*)(O8 + (size_t)r * DM + k), qw = *(const int*)(W8 + (size_t)n * DM + k);
      const f2_t a0 = __builtin_amdgcn_cvt_pk_f32_fp8(qa, false), a1 = __builtin_amdgcn_cvt_pk_f32_fp8(qa, true), w0 = __builtin_amdgcn_cvt_pk_f32_fp8(qw, false), w1 = __builtin_amdgcn_cvt_pk_f32_fp8(qw, true);
      ref += a0.x * w0.x + a0.y * w0.y + a1.x * w1.x + a1.y * w1.y; }
    ref *= 1.f / (64.f * 32.f);
    const size_t ol = (size_t)(b * SEQ + (j - CTXL)) * DM + n; const float fast = (XB[ol] - xin[ol]) / g1[(size_t)b * NMOD * DM + n];
    d2 += (fast - ref) * (fast - ref); r2 += ref * ref; }
  sd[threadIdx.x] = d2; sr[threadIdx.x] = r2; __syncthreads();
  for (int o = 512; o > 0; o >>= 1) { if ((int)threadIdx.x < o) { sd[threadIdx.x] += sd[threadIdx.x + o]; sr[threadIdx.x] += sr[threadIdx.x + o]; } __syncthreads(); }
  if (threadIdx.x == 0) { res[0] = sqrtf(sd[0] / fmaxf(sr[0], 1e-30f)); res[1] = 0.f; res[2] = 0.f; }
}


__global__ void k_mfma8_test(float* res) {
  typedef int i32x8_t __attribute__((ext_vector_type(8))); typedef float f32x4_t __attribute__((ext_vector_type(4)));
  __shared__ float A[16][128], B[128][16]; __shared__ int bad; __shared__ float mx;
  const int l = threadIdx.x;
  for (int e = l; e < 16 * 128; e += 64) { const int i = e >> 7, k = e & 127; A[i][k] = (float)(((i * 7 + k * 3) % 5) - 2); B[k][i] = (float)(((i * 5 + k * 11) % 7) - 3); }
  if (l == 0) { bad = 0; mx = 0.f; }
  __syncthreads();
  i32x8_t a, b;
  for (int q = 0; q < 8; ++q) { int va = 0, vb = 0; const int k0 = 32 * (l >> 4) + 4 * q;
    va = __builtin_amdgcn_cvt_pk_fp8_f32(A[l & 15][k0] * 4.f, A[l & 15][k0 + 1] * 4.f, 0, false); va = __builtin_amdgcn_cvt_pk_fp8_f32(A[l & 15][k0 + 2] * 4.f, A[l & 15][k0 + 3] * 4.f, va, true);
    vb = __builtin_amdgcn_cvt_pk_fp8_f32(B[k0][l & 15] * 8.f, B[k0 + 1][l & 15] * 8.f, 0, false); vb = __builtin_amdgcn_cvt_pk_fp8_f32(B[k0 + 2][l & 15] * 8.f, B[k0 + 3][l & 15] * 8.f, vb, true);
    a[q] = va; b[q] = vb; }
  f32x4_t c = {0.f, 0.f, 0.f, 0.f};
  c = __builtin_amdgcn_mfma_scale_f32_16x16x128_f8f6f4(a, b, c, 0, 0, 0, 0x7d7d7d7d  , 0, 0x7c7c7c7c  );
  for (int r = 0; r < 4; ++r) { const int row = 4 * (l >> 4) + r, col = l & 15; float ref = 0.f; for (int k = 0; k < 128; ++k) ref += A[row][k] * B[k][col];
    const float d = fabsf(c[r] - ref); if (d > 1e-3f) atomicAdd(&bad, 1); atomicMax((int*)&mx, __float_as_int(d)); }
  __syncthreads();
  if (l == 0) { res[0] = (float)bad / 256.f; res[1] = mx * 1e-3f; res[2] = 0.f; }
}


static void run_naive(void* const* d_in, float* out, char* ws, hipStream_t stream, int slayer, int stop) {
  const float* x = (const float*)d_in[0]; const float* c = (const float*)d_in[1]; const float* ctx = (const float*)d_in[2]; const float* c_ctx = (const float*)d_in[3];
  const float* ada_w = (const float*)d_in[4]; const float* ada_b = (const float*)d_in[5]; const float* n1g = (const float*)d_in[6]; const float* n2g = (const float*)d_in[7];
  const float* w_qkv = (const float*)d_in[8]; const float* qng = (const float*)d_in[9]; const float* kng = (const float*)d_in[10]; const float* w_o = (const float*)d_in[11];
  const float* sinks = (const float*)d_in[12]; const float* pwq = (const float*)d_in[13]; const float* psk = (const float*)d_in[14]; const float* pu = (const float*)d_in[15];
  const float* pv = (const float*)d_in[16];
  constexpr size_t MiB = 1u << 20;
  float* MOD = (float*)(ws + 0); float* XC = (float*)(ws + 1 * MiB); int* EIDX = (int*)(ws + 6 * MiB); float* GATE = (float*)(ws + 15 * MiB); float* PW = (float*)(ws + 24 * MiB);
  float* H = (float*)(ws + 34 * MiB); float* QKV = (float*)(ws + 104 * MiB); float* O = (float*)(ws + 242 * MiB); float* PQ = QKV;
  hipFuncSetAttribute((const void*)nv::k_attn, hipFuncAttributeMaxDynamicSharedMemorySize, (4 * RPB + 4 * HD) * 4);
  hipMemcpyAsync(out, x, (size_t)NB * SEQ * DM * 4, hipMemcpyDeviceToDevice, stream);
  hipMemcpyAsync(XC, ctx, (size_t)NB * CTXL * DM * 4, hipMemcpyDeviceToDevice, stream);
  nv::k_mod<<<(DEPTH * 5 * NMOD * DM + 255) / 256, 256, 0, stream>>>(c, c_ctx, ada_w, ada_b, MOD);
  for (int i = 0; i < DEPTH; ++i) {
#define STOP(k) if (i == slayer && stop == (k)) return
    const bool last = i == DEPTH - 1; const float* modi = MOD + (size_t)i * 5 * NMOD * DM;
    STOP(1); nv::k_norm<<<NROWS, 256, 0, stream>>>(out, XC, n1g + i * DM, modi, 0, 1, H);
    STOP(2); nv::k_gemm<0><<<dim3(QKVD / 64, NROWS / 64), 256, 0, stream>>>(H, w_qkv + (size_t)i * DM * QKVD, QKV, NROWS, QKVD, DM, nullptr, nullptr, nullptr, 0, 0);
    STOP(3); nv::k_qknorm_rope<<<NROWS, 640, 0, stream>>>(QKV, qng + i * HD, kng + i * HD);
    STOP(4); const size_t shm = (4 * RPB + 4 * HD) * 4;
    if (i % 2 == 0) { nv::k_attn<<<dim3(NB * SEQ, NKV), 256, shm, stream>>>(QKV, 0, nullptr); if (!last) nv::k_attn<<<dim3(NB * CTXL, NKV), 256, shm, stream>>>(QKV, 1, nullptr); }
    else { nv::k_attn<<<dim3(NB * SEQ, NKV), 256, shm, stream>>>(QKV, 2, sinks + (i / 2) * NH); }
    STOP(5); nv::k_copy_o<<<NROWS, 256, 0, stream>>>(QKV, O);
    nv::k_gemm<1><<<dim3(DM / 64, NROWS / 64), 256, 0, stream>>>(O, w_o + (size_t)i * DM * DM, nullptr, NROWS, DM, DM, out, XC, modi, 2, last ? 1 : 0);
    STOP(6); nv::k_norm<<<NROWS, 256, 0, stream>>>(out, XC, n2g + i * DM, modi, 3, 4, H);
    STOP(7); nv::k_gemm<0><<<dim3(PQN / 64, NROWS / 64), 256, 0, stream>>>(H, pwq + (size_t)i * DM * PQN, PQ, NROWS, PQN, DM, nullptr, nullptr, nullptr, 0, 0);
    STOP(8); nv::k_peer_topk<<<NROWS, 256, 0, stream>>>(PQ, psk + (size_t)i * 2 * NKEYS * 128, EIDX, GATE);
    STOP(9); nv::k_peer_u<<<NROWS, 256, 0, stream>>>(H, pu + (size_t)i * NKEYS * NKEYS * DM, EIDX, GATE, PW);
    STOP(10); nv::k_peer_v<<<NROWS, 256, 0, stream>>>(pv + (size_t)i * NKEYS * NKEYS * DM, EIDX, PW, out, XC, modi, 5, last ? 1 : 0);
#undef STOP
  }
}

extern "C" void kernel_launch(void* const* d_in, const int* in_sizes, int n_in, void* d_out, int out_size, void* d_ws, size_t ws_size, hipStream_t stream) {
  static int grid = 0;
  if (grid == 0) {
    if (n_in != 17 || out_size != NB * SEQ * DM || ws_size < mk::WS_END) { fprintf(stderr, "kernel_launch: unexpected shapes (n_in %d out %d ws %zu)\n", n_in, out_size, ws_size); grid = -1; return; }
    int dev = 0, cus = 0, per_cu = 0;
    hipGetDevice(&dev); hipDeviceGetAttribute(&cus, hipDeviceAttributeMultiprocessorCount, dev);
    if (hipFuncSetAttribute((const void*)mk::fwd, hipFuncAttributeMaxDynamicSharedMemorySize, mk::LDS_BYTES) != hipSuccess) { fprintf(stderr, "kernel_launch: hipFuncSetAttribute failed\n"); grid = -1; return; }
    if (hipOccupancyMaxActiveBlocksPerMultiprocessor(&per_cu, (const void*)mk::fwd, mk::NTHR, mk::LDS_BYTES) != hipSuccess || per_cu < 1) { fprintf(stderr, "kernel_launch: occupancy query failed (%d)\n", per_cu); grid = -1; return; }
    grid = cus * 1;
    grid -= grid % 8;
  }
  if (grid < 0) return;
  mk::Args a{};
  for (int i = 0; i < 17; ++i) a.in[i] = (const float*)d_in[i];
  a.out = (float*)d_out; a.ws = (unsigned char*)d_ws;
#if DBG == 0
#if MK_MULTI
  for (int p = 0; p < mk::NPHASE; ++p) { a.ph_lo = p; a.ph_hi = p + 1; hipLaunchKernelGGL(mk::fwd, dim3(grid), dim3(mk::NTHR), mk::LDS_BYTES, stream, a); }
#else
  hipMemsetAsync((char*)d_ws + mk::WS_CTL, 0, 65536, stream);
  a.ph_lo = 0; a.ph_hi = mk::NPHASE; void* kargs[] = {&a};
  hipError_t e = hipLaunchCooperativeKernel((const void*)mk::fwd, dim3(grid), dim3(mk::NTHR), kargs, mk::LDS_BYTES, stream);
  if (e != hipSuccess) fprintf(stderr, "cooperative launch failed: %s (grid %d)\n", hipGetErrorString(e), grid);
#endif
#else
  {
    constexpr size_t MiB = 1u << 20; char* ws = (char*)d_ws; float* out = (float*)d_out;
    float* REF = (float*)(ws + 440 * MiB); float* RES = (float*)(ws + 511 * MiB);
    float* nH = (float*)(ws + 34 * MiB); float* nQKV = (float*)(ws + 104 * MiB); float* nMOD = (float*)ws; float* nXC = (float*)(ws + 1 * MiB);
    hipMemsetAsync(RES, 0, 64, stream);
    int slayer = 0, stop = 0, fastp = 0;
#if DBG == 1
    slayer = 0; stop = 2; fastp = 2;
#elif DBG == 2
    slayer = 0; stop = 4; fastp = 4;
#elif DBG == 3
    slayer = 0; stop = 5; fastp = 5;
#elif DBG == 4
    slayer = 0; stop = 6; fastp = 6;
#elif DBG == 5
    slayer = 0; stop = 8; fastp = 8;
#elif DBG == 6
    slayer = 1; stop = 1; fastp = 11;
#elif DBG == 7
    slayer = 1; stop = 5; fastp = 15;
#elif DBG == 8
    slayer = 9; stop = 99; fastp = 21;
#elif DBG == 32
    slayer = 0; stop = 1; fastp = 1;
#elif DBG == 31
    slayer = 0; stop = 1; fastp = 6;
#elif DBG == 30
    slayer = 0; stop = 1; fastp = 0;
#elif DBG == 20
    slayer = 0; stop = 1; fastp = 0;
#elif DBG == 9
    slayer = 1; stop = 1; fastp = 9;
#elif DBG == 10
    slayer = 0; stop = 10; fastp = 9;
#elif DBG == 11
    slayer = 0; stop = 1; fastp = 1;
#endif
    run_naive(d_in, out, ws, stream, slayer, stop);
#if DBG == 1
    hipMemcpyAsync(REF, nH, (size_t)NROWS * DM * 4, hipMemcpyDeviceToDevice, stream); hipMemcpyAsync(REF + (size_t)NROWS * DM, nMOD, (size_t)DEPTH * 5 * NMOD * DM * 4, hipMemcpyDeviceToDevice, stream);
#elif DBG == 3 || DBG == 7
    nv::k_copy_o<<<NROWS, 256, 0, stream>>>(nQKV, REF);
#elif DBG == 2
    hipMemcpyAsync(REF, nQKV, (size_t)NROWS * QKVD * 4, hipMemcpyDeviceToDevice, stream);
#elif DBG == 4 || DBG == 6 || DBG == 8 || DBG == 9
    hipMemcpyAsync(REF, out, (size_t)NB * SEQ * DM * 4, hipMemcpyDeviceToDevice, stream); hipMemcpyAsync(REF + (size_t)NB * SEQ * DM, nXC, (size_t)NB * CTXL * DM * 4, hipMemcpyDeviceToDevice, stream);
#endif
#if DBG == 10
    hipMemcpyAsync(REF, ws + 24 * MiB, (size_t)NROWS * 128 * 4, hipMemcpyDeviceToDevice, stream);
#endif
#if DBG == 9 || DBG == 10
    hipMemcpyAsync(REF + (size_t)70 * MiB / 4, ws + 6 * MiB, (size_t)NROWS * 128 * 4, hipMemcpyDeviceToDevice, stream); hipMemcpyAsync(REF + (size_t)80 * MiB / 4, ws + 15 * MiB, (size_t)NROWS * 128 * 4, hipMemcpyDeviceToDevice, stream);
#elif DBG == 5
    hipMemcpyAsync(REF, nQKV  , (size_t)512 * PQN * 4, hipMemcpyDeviceToDevice, stream);
#endif
    for (int p = 0; p < fastp; ++p) { a.ph_lo = p; a.ph_hi = p + 1; hipLaunchKernelGGL(mk::fwd, dim3(grid), dim3(mk::NTHR), mk::LDS_BYTES, stream, a); }
    unsigned char* fw = (unsigned char*)d_ws;
#if DBG == 30
    k_mfma8_test<<<1, 64, 0, stream>>>(RES);
#endif
#if DBG == 32
    k_cmp_w8<<<1, 1024, 0, stream>>>(fw + mk::WS_WO, (const float*)d_in[11], RES);
#endif
#if DBG == 31
    k_cmp_wo8<<<1, 1024, 0, stream>>>(fw + mk::WS_O, fw + mk::WS_WO, (const float*)(fw + mk::WS_XB), (const float*)d_in[0], (const float*)(fw + mk::WS_MOD) + 2 * DM, 300, RES);
#endif
#if DBG == 20
    { hipMemsetAsync((char*)d_ws + mk::WS_CTL, 0, 65536, stream); a.ph_lo = 0; a.ph_hi = mk::NPHASE; void* kargs[] = {&a};
      hipLaunchCooperativeKernel((const void*)mk::fwd, dim3(grid), dim3(mk::NTHR), kargs, mk::LDS_BYTES, stream);
      dbg::k_ts<<<1, 1, 0, stream>>>((const unsigned long long*)(fw + mk::WS_CTL + 61440), RES); }
#endif
#if DBG == 9 || DBG == 10
    hipMemcpyAsync(fw + mk::WS_EIDX, REF + (size_t)70 * MiB / 4, (size_t)NROWS * 128 * 4, hipMemcpyDeviceToDevice, stream); hipMemcpyAsync(fw + mk::WS_GATE, REF + (size_t)80 * MiB / 4, (size_t)NROWS * 128 * 4, hipMemcpyDeviceToDevice, stream);
    for (int p = 9; p < (DBG == 9 ? 11 : 10); ++p) { a.ph_lo = p; a.ph_hi = p + 1; hipLaunchKernelGGL(mk::fwd, dim3(grid), dim3(mk::NTHR), mk::LDS_BYTES, stream, a); }
#endif
#if DBG == 1
    dbg::k_cmp<true><<<1, 1024, 0, stream>>>(fw + mk::WS_H, DM, 0, REF, DM, 0, NROWS, DM, 0, 0, RES);
    dbg::k_cmp<false><<<1, 1024, 0, stream>>>(fw + mk::WS_MOD, NMOD * DM, 0, REF + (size_t)NROWS * DM, NMOD * DM, 0, DEPTH * 5, NMOD * DM, 0, 0, RES + 1);
#elif DBG == 2
    dbg::k_cmp<true><<<1, 1024, 0, stream>>>(fw + mk::WS_Q, DM, 0, REF, QKVD, 0, NROWS, DM, 0, 0, RES);
    dbg::k_cmp<true><<<1, 1024, 0, stream>>>(fw + mk::WS_K, 256, 0, REF, QKVD, 1024, NROWS, 256, 0, 0, RES + 2);
    dbg::k_cmp<true><<<1, 1024, 0, stream>>>(fw + mk::WS_V, 256, 0, REF, QKVD, 1280, NROWS, 256, 0, 0, RES + 1);
#elif DBG == 3 || DBG == 7
    dbg::k_cmp8<<<1, 1024, 0, stream>>>(fw + mk::WS_O, DM, 64.f, REF, DM, 0, NROWS, DM, 1, RES);
    if (DBG == 3) dbg::k_cmp8<<<1, 1024, 0, stream>>>(fw + mk::WS_O, DM, 64.f, REF, DM, 0, NROWS, DM, 2, RES + 1);
#elif DBG == 4 || DBG == 6 || DBG == 8 || DBG == 9
    dbg::k_cmp<false><<<1, 1024, 0, stream>>>(DBG == 4 ? (const void*)(fw + mk::WS_XB) : (const void*)out, DM, 0, REF, DM, 0, NB * SEQ, DM, 0, 0, RES);
    if (DBG != 8) dbg::k_cmp<false><<<1, 1024, 0, stream>>>(fw + (DBG == 4 ? mk::WS_XCB : mk::WS_XC), DM, 0, REF + (size_t)NB * SEQ * DM, DM, 0, NB * CTXL, DM, 0, 0, RES + 1);
#elif DBG == 11
    dbg::k_cmp<true><<<1, 1024, 0, stream>>>(fw + mk::WS_UT, DM, 0, (const float*)d_in[15], DM, 0, DEPTH * NKEYS * NKEYS, DM, 0, 0, RES);
    dbg::k_cmp<true><<<1, 1024, 0, stream>>>(fw + mk::WS_VT, DM, 0, (const float*)d_in[16], DM, 0, DEPTH * NKEYS * NKEYS, DM, 0, 0, RES + 1);
#elif DBG == 10
    dbg::k_cmp<false><<<1, 1024, 0, stream>>>(fw + mk::WS_PW, 128, 0, REF, 128, 0, NROWS, 128, 0, 0, RES);
#elif DBG == 5
    dbg::k_cmp_scores<<<1, 1024, 0, stream>>>((const float*)(fw + mk::WS_S), REF, (const float*)d_in[14], 512, RES);
#endif
    hipMemcpyAsync(REF, RES, 64, hipMemcpyDeviceToDevice, stream);
    run_naive(d_in, out, ws, stream, 9, 99);
    dbg::k_final<<<1024, 256, 0, stream>>>(out, (long)NB * SEQ * DM, REF);
    dbg::k_final2<<<1, 1, 0, stream>>>(out, REF);
  }
#endif
}
```

```cpp
#include <hip/hip_runtime.h>
#include <hip/hip_cooperative_groups.h>
#include <cstdio>
#include <cstdint>

constexpr int NB = 4, SEQ = 4096, CTXL = 256, DM = 1024, DEPTH = 2;
constexpr int RPB = CTXL + SEQ;
constexpr int NROWS = NB * RPB;
constexpr int NH = 8, NKV = 2, HD = 128, QKVD = 1536, NMOD = 6;
constexpr int PH = 8, PK = 16, NKEYS = 128, PQD = 256, PQN = PH * PQD;
constexpr float RMS_EPS = 1e-6f;

namespace nv {

__device__ __forceinline__ float silu(float x) { return x / (1.f + __expf(-x)); }
__device__ __forceinline__ float gelu_tanh(float x) {
  const float y = 0.7978845608028654f * (x + 0.044715f * x * x * x);
  const float t = 1.f - 2.f / (__expf(2.f * y) + 1.f);
  return 0.5f * x * (1.f + t);
}

__global__ void k_mod(const float* __restrict__ c, const float* __restrict__ c_ctx, const float* __restrict__ ada_w,
                      const float* __restrict__ ada_b, float* __restrict__ mod) {
  const int idx = blockIdx.x * 256 + threadIdx.x;
  if (idx >= DEPTH * 5 * NMOD * DM) return;
  const int n = idx % (NMOD * DM), r = (idx / (NMOD * DM)) % 5, i = idx / (5 * NMOD * DM);
  const float* cv = r < 4 ? c + r * DM : c_ctx;
  const float* w = ada_w + (size_t)i * DM * NMOD * DM + n;
  float s = 0.f;
  for (int j = 0; j < DM; ++j) s += silu(cv[j]) * w[(size_t)j * NMOD * DM];
  mod[idx] = s + ada_b[i * NMOD * DM + n];
}

__device__ __forceinline__ float* xrow(float* xl, float* xc, int r) {
  const int b = r / RPB, j = r % RPB;
  return j < CTXL ? xc + (size_t)(b * CTXL + j) * DM : xl + (size_t)(b * SEQ + (j - CTXL)) * DM;
}

__global__ void k_norm(float* xl, float* xc, const float* __restrict__ gain, const float* __restrict__ modi, int sh_i, int sc_i,
                       float* __restrict__ H) {
  const int r = blockIdx.x, t = threadIdx.x;
  const int b = r / RPB, j = r % RPB, mr = j < CTXL ? 4 : b;
  const float* x = xrow(xl, xc, r);
  __shared__ float red[4];
  float v[4]; float s = 0.f;
#pragma unroll
  for (int q = 0; q < 4; ++q) { v[q] = x[t + 256 * q]; s += v[q] * v[q]; }
  for (int o = 32; o > 0; o >>= 1) s += __shfl_xor(s, o);
  if ((t & 63) == 0) red[t >> 6] = s;
  __syncthreads();
  s = red[0] + red[1] + red[2] + red[3];
  const float rstd = rsqrtf(s / DM + RMS_EPS);
  const float* sh = modi + (size_t)mr * NMOD * DM + sh_i * DM; const float* sc = modi + (size_t)mr * NMOD * DM + sc_i * DM;
#pragma unroll
  for (int q = 0; q < 4; ++q) { const int d = t + 256 * q; H[(size_t)r * DM + d] = v[q] * rstd * gain[d] * (1.f + sc[d]) + sh[d]; }
}

template <int EPI>
__global__ void k_gemm(const float* __restrict__ A, const float* __restrict__ B, float* __restrict__ C, int M, int N, int K,
                       float* xl, float* xc, const float* __restrict__ modi, int g_i, int skip_ctx) {
  __shared__ float As[16][68], Bs[16][68];
  const int t = threadIdx.x, tx = t & 15, ty = t >> 4, m0 = blockIdx.y * 64, n0 = blockIdx.x * 64;
  float acc[4][4] = {};
  for (int k0 = 0; k0 < K; k0 += 16) {
    for (int q = 0; q < 4; ++q) { const int e = t + 256 * q, mm = e >> 4, kk = e & 15; As[kk][mm] = A[(size_t)(m0 + mm) * K + k0 + kk]; }
    for (int q = 0; q < 4; ++q) { const int e = t + 256 * q, kk = e >> 6, nn = e & 63; Bs[kk][nn] = B[(size_t)(k0 + kk) * N + n0 + nn]; }
    __syncthreads();
#pragma unroll
    for (int kk = 0; kk < 16; ++kk) {
      float a[4], b[4];
#pragma unroll
      for (int i = 0; i < 4; ++i) { a[i] = As[kk][ty * 4 + i]; b[i] = Bs[kk][tx * 4 + i]; }
#pragma unroll
      for (int i = 0; i < 4; ++i)
#pragma unroll
        for (int j = 0; j < 4; ++j) acc[i][j] += a[i] * b[j];
    }
    __syncthreads();
  }
#pragma unroll
  for (int i = 0; i < 4; ++i) {
    const int r = m0 + ty * 4 + i;
    if (EPI == 0) {
#pragma unroll
      for (int j = 0; j < 4; ++j) C[(size_t)r * N + n0 + tx * 4 + j] = acc[i][j];
    } else {
      const int b = r / RPB, jj = r % RPB; if (skip_ctx && jj < CTXL) continue;
      const int mr = jj < CTXL ? 4 : b; float* x = xrow(xl, xc, r);
      const float* g = modi + (size_t)mr * NMOD * DM + g_i * DM;
#pragma unroll
      for (int j = 0; j < 4; ++j) { const int n = n0 + tx * 4 + j; x[n] += g[n] * acc[i][j]; }
    }
  }
}

__global__ void k_qknorm_rope(float* __restrict__ QKV, const float* __restrict__ qg, const float* __restrict__ kg) {
  const int r = blockIdx.x, t = threadIdx.x, head = t >> 6, p = t & 63, axis = p >> 5, f = p & 31;
  const int j = r % RPB;
  float* base = QKV + (size_t)r * QKVD + head * HD;
  const int e1 = axis * 64 + f, e2 = e1 + 32;
  float x1 = base[e1], x2 = base[e2];
  float s = x1 * x1 + x2 * x2;
  for (int o = 32; o > 0; o >>= 1) s += __shfl_xor(s, o);
  const float rstd = rsqrtf(s / HD + RMS_EPS);
  const float* g = head < NH ? qg : kg;
  x1 = x1 * rstd * g[e1]; x2 = x2 * rstd * g[e2];
  if (j >= CTXL) {
    const int sp = j - CTXL; const float pos = (float)(axis == 0 ? sp / 64 : sp % 64);
    const float inv = powf(10000.f, -(float)(2 * f) / 64.f);
    const float ang = pos * inv; const float cs = cosf(ang), sn = sinf(ang);
    const float y1 = x1 * cs - x2 * sn, y2 = x1 * sn + x2 * cs; x1 = y1; x2 = y2;
  }
  base[e1] = x1; base[e2] = x2;
}

__global__ void k_attn(float* __restrict__ QKV, int mode, const float* __restrict__ sink) {
  extern __shared__ float sm[];
  const int t = threadIdx.x, w = t >> 6, lane = t & 63, g = blockIdx.y;
  int b, j;
  if (mode == 1) { b = blockIdx.x / CTXL; j = blockIdx.x % CTXL; } else { b = blockIdx.x / SEQ; j = CTXL + blockIdx.x % SEQ; }
  const int r = b * RPB + j, h = g * 4 + w;
  float* sc = sm + w * RPB; float* qs = sm + 4 * RPB + w * HD;
  float* qp = QKV + (size_t)r * QKVD + h * HD;
  qs[lane] = qp[lane]; qs[lane + 64] = qp[lane + 64];
  __syncthreads();
  int a0 = 0, a1, b0 = 0, b1 = 0;
  if (mode == 0) a1 = RPB; else if (mode == 1) a1 = CTXL;
  else { a1 = CTXL; const int s = j - CTXL; const int lo = s - 128 < 0 ? 0 : s - 128, hi = s + 128 > SEQ - 1 ? SEQ - 1 : s + 128; b0 = CTXL + lo; b1 = CTXL + hi + 1; }
  const int nk = (a1 - a0) + (b1 - b0);
  const float scale = 0.08838834764831845f;
  float mx = -1e30f;
  for (int i = lane; i < nk; i += 64) {
    const int kr = i < (a1 - a0) ? a0 + i : b0 + (i - (a1 - a0));
    const float4* kp = (const float4*)(QKV + (size_t)(b * RPB + kr) * QKVD + NH * HD + g * HD);
    float s = 0.f;
    for (int d = 0; d < 32; ++d) { const float4 kv = kp[d]; s += kv.x * qs[4 * d] + kv.y * qs[4 * d + 1] + kv.z * qs[4 * d + 2] + kv.w * qs[4 * d + 3]; }
    s *= scale; sc[i] = s; mx = fmaxf(mx, s);
  }
  for (int o = 32; o > 0; o >>= 1) mx = fmaxf(mx, __shfl_xor(mx, o));
  if (mode == 2) mx = fmaxf(mx, sink[h]);
  float l = 0.f;
  for (int i = lane; i < nk; i += 64) { const float p = __expf(sc[i] - mx); sc[i] = p; l += p; }
  for (int o = 32; o > 0; o >>= 1) l += __shfl_xor(l, o);
  if (mode == 2) l += __expf(sink[h] - mx);
  __syncthreads();
  float o0 = 0.f, o1 = 0.f;
  for (int i = 0; i < nk; ++i) {
    const int kr = i < (a1 - a0) ? a0 + i : b0 + (i - (a1 - a0));
    const float* vp = QKV + (size_t)(b * RPB + kr) * QKVD + (NH + NKV) * HD + g * HD;
    const float p = sc[i]; o0 += p * vp[lane]; o1 += p * vp[lane + 64];
  }
  const float il = 1.f / l;
  qp[lane] = o0 * il; qp[lane + 64] = o1 * il;
}

__global__ void k_copy_o(const float* __restrict__ QKV, float* __restrict__ O) {
  const int r = blockIdx.x, t = threadIdx.x;
  for (int q = 0; q < 4; ++q) O[(size_t)r * DM + t + 256 * q] = QKV[(size_t)r * QKVD + t + 256 * q];
}

__global__ void __launch_bounds__(256) k_peer_topk(const float* __restrict__ PQ, const float* __restrict__ SK  , int* __restrict__ eidx, float* __restrict__ gate) {
  __shared__ float q[PQN]; __shared__ float s[16][128]; __shared__ float tv[16][16]; __shared__ int ti[16][16];
  __shared__ float cs[8][256]; __shared__ int taken[8][256];
  const int r = blockIdx.x, t = threadIdx.x;
  for (int i = t; i < PQN; i += 256) q[i] = PQ[(size_t)r * PQN + i];
  __syncthreads();
  { const int k = t & 127, half = t >> 7; const float* kp = SK + (size_t)half * NKEYS * 128 + (size_t)k * 128;
#pragma nounroll
    for (int h = 0; h < PH; ++h) { float a = 0.f; const float* qq = q + h * PQD + half * 128;
#pragma unroll 4
      for (int d = 0; d < 128; ++d) a += qq[d] * kp[d];
      s[h * 2 + half][k] = a; } }
  __syncthreads();
  if (t < 16) {
#pragma nounroll
    for (int it = 0; it < PK; ++it) { float bv = -3e38f; int bi = 0;
#pragma nounroll
      for (int k = 0; k < 128; ++k) { const float v = s[t][k]; if (v > bv) { bv = v; bi = k; } } tv[t][it] = bv; ti[t][it] = bi; s[t][bi] = -3e38f; }
  }
  __syncthreads();
  for (int i = t; i < 8 * 256; i += 256) { const int h = i >> 8, c = i & 255; cs[h][c] = tv[h * 2][c >> 4] + tv[h * 2 + 1][c & 15]; taken[h][c] = 0; }
  __syncthreads();
  if (t < 8) {
    float m = -3e38f;
#pragma nounroll
    for (int it = 0; it < PK; ++it) { float bv = -3e38f; int bi = 0;
#pragma nounroll
      for (int c = 0; c < 256; ++c) { const float v = cs[t][c]; if (!taken[t][c] && v > bv) { bv = v; bi = c; } }
      taken[t][bi] = 1; s[t][it] = bv; m = fmaxf(m, bv); eidx[(size_t)r * 128 + t * PK + it] = ti[t * 2][bi >> 4] * NKEYS + ti[t * 2 + 1][bi & 15]; }
    float l = 0.f;
#pragma nounroll
    for (int it = 0; it < PK; ++it) l += __expf(s[t][it] - m);
#pragma nounroll
    for (int it = 0; it < PK; ++it) gate[(size_t)r * 128 + t * PK + it] = __expf(s[t][it] - m) / l;
  }
}

__global__ void k_peer_u(const float* __restrict__ H, const float* __restrict__ U, const int* __restrict__ eidx, const float* __restrict__ gate, float* __restrict__ W) {
  __shared__ float h[DM];
  const int r = blockIdx.x, t = threadIdx.x, w = t >> 6, lane = t & 63;
  for (int i = t; i < DM; i += 256) h[i] = H[(size_t)r * DM + i];
  __syncthreads();
  for (int k = w; k < 128; k += 4) {
    const int e = eidx[(size_t)r * 128 + k]; const float* u = U + (size_t)e * DM; float a = 0.f;
    for (int d = lane; d < DM; d += 64) a += u[d] * h[d];
    for (int o = 32; o > 0; o >>= 1) a += __shfl_xor(a, o);
    if (lane == 0) W[(size_t)r * 128 + k] = gate[(size_t)r * 128 + k] * gelu_tanh(a);
  }
}
__global__ void k_peer_v(const float* __restrict__ V, const int* __restrict__ eidx, const float* __restrict__ W, float* xl, float* xc,
                         const float* __restrict__ modi, int g_i, int skip_ctx) {
  const int r = blockIdx.x, t = threadIdx.x; const int b = r / RPB, j = r % RPB; if (skip_ctx && j < CTXL) return;
  float4 acc = {0.f, 0.f, 0.f, 0.f};
  for (int k = 0; k < 128; ++k) { const int e = eidx[(size_t)r * 128 + k]; const float w = W[(size_t)r * 128 + k]; const float4 v = ((const float4*)(V + (size_t)e * DM))[t];
    acc.x += w * v.x; acc.y += w * v.y; acc.z += w * v.z; acc.w += w * v.w; }
  const int mr = j < CTXL ? 4 : b; float4* x = (float4*)xrow(xl, xc, r) + t; const float4 g = ((const float4*)(modi + (size_t)mr * NMOD * DM + g_i * DM))[t];
  float4 xv = *x; xv.x += g.x * acc.x; xv.y += g.y * acc.y; xv.z += g.z * acc.z; xv.w += g.w * acc.w; *x = xv;
}
}


namespace pg8 {
#define PG8_LAS __attribute__((address_space(3)))
typedef unsigned short bf16_t;
typedef short bf16x8 __attribute__((ext_vector_type(8)));
typedef float f32x4 __attribute__((ext_vector_type(4)));
typedef unsigned u32x4 __attribute__((ext_vector_type(4)));
constexpr int BM = 256, BK = 64, HALF = 128, HTB = HALF * BK * 2  , STAGE_BYTES = 8 * HTB, NXCD = 8, WGM = 8;

__host__ __device__ __forceinline__ int lds_byte(int r, int c) { const int st = (r >> 4) * 2 + (c >> 5), rr = r & 15, cc = c & 31, ob = rr * 64 + cc * 2; return st * 1024 + (ob ^ (((ob >> 9) & 1) << 5)); }
__host__ __device__ __forceinline__ void stage_rc(int b, int& R, int& C) { const int st = b / 1024, sb = b % 1024, swz = sb ^ (((sb >> 9) & 1) << 5); R = (st >> 1) * 16 + swz / 64; C = (st & 1) * 32 + (swz % 64) / 2; }
__host__ __device__ __forceinline__ int perm32(int rho) { const int n = rho >> 4, i = rho & 15; return 8 * (i >> 2) + 4 * n + (i & 3); }

struct Unit { int pm, pn; };
struct Gemm { const bf16_t* A; const bf16_t* Bt; int M, N, K; int sa = 0x7f7f7f7f, sb = 0x7f7f7f7f; };
typedef int i32x4 __attribute__((ext_vector_type(4)));
typedef int i32x8 __attribute__((ext_vector_type(8)));

struct StaticOrder {
    int nM, nN, nwg, G, c;
    __host__ __device__ void init(int M, int N, int G_, int c_) { nM = M / BM; nN = N / BM; nwg = nM * nN; G = G_; c = c_; }
    __host__ __device__ bool next(int i, Unit& u) const {
        const long L = (long)i * G + c; if (L >= nwg) return false;
        int wgid = (int)L; { const int q = nwg / NXCD, r = nwg % NXCD, xcd = wgid % NXCD, off = wgid / NXCD; wgid = (xcd < r ? xcd * (q + 1) : r * (q + 1) + (xcd - r) * q) + off; }
        const int nig = WGM * nN, gid = wgid / nig, fm = gid * WGM, gsz = (nM - fm) < WGM ? (nM - fm) : WGM;
        u.pm = fm + ((wgid % nig) % gsz); u.pn = (wgid % nig) / gsz; return true;
    }
    __device__ __forceinline__ void a_ready(const Unit&) const {}
    __device__ __forceinline__ void done(const Unit&) const {}
};

__device__ __forceinline__ unsigned cvt_pk_bf16(float lo, float hi) { unsigned r; asm volatile("v_cvt_pk_bf16_f32 %0, %1, %2" : "=v"(r) : "v"(lo), "v"(hi)); return r; }
typedef float f32x2 __attribute__((ext_vector_type(2)));
__device__ __forceinline__ f32x2 gelu_pk(f32x2 v) {
    const f32x2 av = __builtin_elementwise_abs(v), d = av * 0.2316418882f + 1.0f;
    f32x2 t; t.x = __builtin_amdgcn_rcpf(d.x); t.y = __builtin_amdgcn_rcpf(d.y);
    f32x2 q = t * 0.5307027145f + (-0.7265760135f); q = q * t + 0.7107068705f; q = q * t + (-0.142248368f); q = q * t + 0.127414796f; q = q * t;
    const f32x2 s = (v * v) * (-0.72134752044f);
    f32x2 e; e.x = __builtin_amdgcn_exp2f(s.x); e.y = __builtin_amdgcn_exp2f(s.y);
    const f32x2 m = v * (q * e), r = v - m;
    f32x2 o; o.x = v.x < 0.f ? m.x : r.x; o.y = v.y < 0.f ? m.y : r.y; return o;
}

template <int ACT  > struct EpiBf16 {
    static constexpr bool PERM = true, AFTER_DRAIN = false; static_assert(ACT == 0 || ACT == 1, "EpiBf16: ACT is 0 (none) or 1 (gelu_pk)");
    bf16_t* O; int ldc; const float* bias; int split_cols; size_t split_stride; float scale0;
    __device__ __forceinline__ void operator()(const f32x4 (&acc)[2][2][4][2], const Unit& u, int wr, int wc, int fr, int fq) const {
        const int row0 = u.pm * BM + wr * 64 + fr; int colt = u.pn * BM; bf16_t* base = O;
        float sc = 1.f; if (split_cols) { const int t = colt / split_cols; base += (size_t)t * split_stride; colt -= t * split_cols; if (t == 0) sc = scale0; }
        const int col0 = colt + wc * 32 + 8 * fq, bcol0 = u.pn * BM + wc * 32 + 8 * fq;
        f32x4 bv[2][2];
#pragma unroll
        for (int bj = 0; bj < 2; ++bj)
#pragma unroll
            for (int n = 0; n < 2; ++n) bv[bj][n] = bias ? *(const f32x4*)(bias + bcol0 + bj * HALF + 4 * n) : (f32x4){0.f, 0.f, 0.f, 0.f};
#pragma unroll
        for (int ai = 0; ai < 2; ++ai)
#pragma unroll
            for (int m = 0; m < 4; ++m) { bf16_t* rowp = base + (size_t)(row0 + ai * HALF + m * 16) * ldc + col0;
#pragma unroll
                for (int bj = 0; bj < 2; ++bj) { f32x4 v0 = acc[ai][bj][m][0] + bv[bj][0], v1 = acc[ai][bj][m][1] + bv[bj][1];
                    if (ACT == 1) { f32x2 a = gelu_pk((f32x2){v0[0], v0[1]}), b = gelu_pk((f32x2){v0[2], v0[3]}), c = gelu_pk((f32x2){v1[0], v1[1]}), d = gelu_pk((f32x2){v1[2], v1[3]});
                        v0 = (f32x4){a.x, a.y, b.x, b.y}; v1 = (f32x4){c.x, c.y, d.x, d.y}; }
                    v0 = v0 * sc; v1 = v1 * sc; u32x4 w; w.x = cvt_pk_bf16(v0[0], v0[1]); w.y = cvt_pk_bf16(v0[2], v0[3]); w.z = cvt_pk_bf16(v1[0], v1[1]); w.w = cvt_pk_bf16(v1[2], v1[3]);
                    *(u32x4*)(rowp + bj * HALF) = w; } }
    }
};

template <class Epi, class Sched, bool ALIGN_EPI = false, bool SP2 = false, bool FP8 = false, int SA = 0x7f7f7f7f, int SB = 0x7f7f7f7f>
__device__ __forceinline__ void gemm_phase(PG8_LAS unsigned char* lds, const Gemm g, const Sched& S, const Epi& E) {
    int tid_ = threadIdx.x; asm volatile("" : "+v"(tid_));
    const int tid = tid_, wid = __builtin_amdgcn_readfirstlane(tid >> 6), lane = tid & 63, wr = wid >> 2, wc = wid & 3, fr = lane & 15, fq = lane >> 4;
    constexpr int ES = FP8 ? 1 : 2;
    const int K = g.K, nt = K * ES / (BK * 2);
    unsigned voffA[2], voffB[2];
#pragma unroll
    for (int i = 0; i < 2; ++i) { int R, C; stage_rc(tid * 16 + i * 8192, R, C); const int Rb = Epi::PERM ? ((R & ~31) + perm32(R & 31)) : R;
        voffA[i] = (unsigned)(R * K * ES + C * 2); voffB[i] = (unsigned)(Rb * K * ES + C * 2); }
    const size_t kstep = (size_t)(BK * 2);
    const size_t hstep = (size_t)HALF * K * ES;
    const size_t tstep = 2 * hstep;
    const unsigned ldsw = (unsigned)wid * 1024u;
    const int aoff = lds_byte(wr * 64 + fr, fq * 8), boff = lds_byte(wc * 32 + fr, fq * 8);
#define PG8_SA(b, h) (((b) * 2 + (h)) * HTB)
#define PG8_SB(b, h) ((4 + (b) * 2 + (h)) * HTB)
#define PG8_STAGE(bufoff, gbase, voff) do { if constexpr (FP8) {   \
          int t3_ = tid; asm volatile("" : "+v"(t3_)); _Pragma("unroll") for (int _i = 0; _i < 2; ++_i) { int R_, C_; stage_rc(t3_ * 16 + _i * 8192, R_, C_); \
            if (Epi::PERM && (&(voff)[0] == &voffB[0])) R_ = (R_ & ~31) + perm32(R_ & 31); \
            __builtin_amdgcn_global_load_lds((const unsigned*)((const char*)(gbase) + (unsigned)(R_ * K * ES + C_ * 2)), (PG8_LAS unsigned*)(lds + (bufoff) + ldsw + _i * 8192), 16, 0, 0); } } \
        else { _Pragma("unroll") for (int _i = 0; _i < 2; ++_i) \
        __builtin_amdgcn_global_load_lds((const unsigned*)((const char*)(gbase) + (voff)[_i]), (PG8_LAS unsigned*)(lds + (bufoff) + ldsw + _i * 8192), 16, 0, 0); } } while (0)
#define PG8_LDA(dst, b, h) do { if constexpr (FP8) { _Pragma("unroll") for (int m = 0; m < 4; ++m) dst##8[m] = __builtin_shufflevector(*(const PG8_LAS i32x4*)(lds + PG8_SA(b, h) + aoff + m * 2048), *(const PG8_LAS i32x4*)(lds + PG8_SA(b, h) + aoff + m * 2048 + 1024), 0, 1, 2, 3, 4, 5, 6, 7); } \
        else { _Pragma("unroll") for (int m = 0; m < 4; ++m) _Pragma("unroll") for (int k = 0; k < 2; ++k) dst[m][k] = *(const PG8_LAS bf16x8*)(lds + PG8_SA(b, h) + aoff + m * 2048 + k * 1024); } } while (0)
#define PG8_LDB(dst, b, h) do { if constexpr (FP8) { _Pragma("unroll") for (int n = 0; n < 2; ++n) dst##8[n] = __builtin_shufflevector(*(const PG8_LAS i32x4*)(lds + PG8_SB(b, h) + boff + n * 2048), *(const PG8_LAS i32x4*)(lds + PG8_SB(b, h) + boff + n * 2048 + 1024), 0, 1, 2, 3, 4, 5, 6, 7); } \
        else { _Pragma("unroll") for (int n = 0; n < 2; ++n) _Pragma("unroll") for (int k = 0; k < 2; ++k) dst[n][k] = *(const PG8_LAS bf16x8*)(lds + PG8_SB(b, h) + boff + n * 2048 + k * 1024); } } while (0)
#define PG8_MMA(ai, bj, At, Bt) do { __builtin_amdgcn_s_setprio(1); \
        if constexpr (FP8) { _Pragma("unroll") for (int m = 0; m < 4; ++m) _Pragma("unroll") for (int n = 0; n < 2; ++n) { \
            acc[ai][bj][m][n] = __builtin_amdgcn_mfma_scale_f32_16x16x128_f8f6f4(Bt##8[n], At##8[m], acc[ai][bj][m][n], 0, 0, 0, SB, 0, SA); } } \
        else { _Pragma("unroll") for (int m = 0; m < 4; ++m) _Pragma("unroll") for (int n = 0; n < 2; ++n) _Pragma("unroll") for (int k = 0; k < 2; ++k) \
            acc[ai][bj][m][n] = __builtin_amdgcn_mfma_f32_16x16x32_bf16(Bt[n][k], At[m][k], acc[ai][bj][m][n], 0, 0, 0); } \
        __builtin_amdgcn_s_setprio(0); } while (0)
#define PG8_WAIT_V(n) asm volatile("s_waitcnt vmcnt(" #n ")" ::: "memory")
#define PG8_WAIT_L(n) asm volatile("s_waitcnt lgkmcnt(" #n ")" ::: "memory")
#define PG8_BAR __builtin_amdgcn_s_barrier()
#define PG8_SCHED __builtin_amdgcn_sched_barrier(0)
    Unit cur, nxt; int ui = 0;
    if (!S.next(0, cur)) return;
    f32x4 acc[2][2][4][2];
#pragma unroll
    for (int a = 0; a < 2; ++a)
#pragma unroll
        for (int b = 0; b < 2; ++b)
#pragma unroll
            for (int m = 0; m < 4; ++m)
#pragma unroll
                for (int n = 0; n < 2; ++n) acc[a][b][m][n] = (f32x4){0.f, 0.f, 0.f, 0.f};
    bf16x8 At[4][2], B0[2][2], B1[2][2]; i32x8 At8[4], B08[2], B18[2];
    const char* cA = (const char*)g.A + (size_t)cur.pm * tstep; const char* cB = (const char*)g.Bt + (size_t)cur.pn * tstep;
    S.a_ready(cur);
    if constexpr (SP2) {
        PG8_STAGE(PG8_SB(0, 0), cB, voffB); PG8_STAGE(PG8_SB(0, 1), cB + hstep, voffB); PG8_STAGE(PG8_SA(0, 0), cA, voffA); PG8_STAGE(PG8_SA(0, 1), cA + hstep, voffA);
        if (wr == 1) PG8_BAR;
        PG8_WAIT_V(2); PG8_BAR;
        PG8_STAGE(PG8_SB(1, 0), cB + kstep, voffB); PG8_STAGE(PG8_SA(1, 0), cA + kstep, voffA); PG8_STAGE(PG8_SB(1, 1), cB + hstep + kstep, voffB);
        PG8_WAIT_V(6); PG8_BAR;
    } else {
        PG8_STAGE(PG8_SB(0, 0), cB, voffB); PG8_STAGE(PG8_SA(0, 0), cA, voffA); PG8_STAGE(PG8_SB(0, 1), cB + hstep, voffB); PG8_STAGE(PG8_SA(0, 1), cA + hstep, voffA);
        if (wr == 1) PG8_BAR;
        PG8_WAIT_V(4); PG8_BAR;
        PG8_STAGE(PG8_SB(1, 0), cB + kstep, voffB); PG8_STAGE(PG8_SA(1, 0), cA + kstep, voffA); PG8_STAGE(PG8_SB(1, 1), cB + hstep + kstep, voffB);
        PG8_WAIT_V(6); PG8_BAR;
    }
    for (;;) {
        const bool has_next = S.next(ui + 1, nxt);
        const char* nA = has_next ? (const char*)g.A + (size_t)nxt.pm * tstep : cA; const char* nB = has_next ? (const char*)g.Bt + (size_t)nxt.pn * tstep : cB;
#pragma unroll 1
        for (int t = 0; t < nt; t += 2) {
            const bool last = (t == nt - 2);
            const char* a1 = cA + (size_t)(t + 1) * kstep;
            const char* a2 = last ? nA : cA + (size_t)(t + 2) * kstep; const char* b2 = last ? nB : cB + (size_t)(t + 2) * kstep;
            const char* a3 = a2 + kstep; const char* b3 = b2 + kstep;
            if (last && has_next) S.a_ready(nxt);
            if constexpr (SP2) {
            PG8_LDB(B0, 0, 0); PG8_LDB(B1, 0, 1); PG8_SCHED; PG8_LDA(At, 0, 0); PG8_STAGE(PG8_SA(1, 1), a1 + hstep, voffA);
            PG8_WAIT_V(8); PG8_WAIT_L(0); PG8_BAR; PG8_MMA(0, 0, At, B0); PG8_MMA(0, 1, At, B1); PG8_BAR; PG8_SCHED;
            PG8_LDA(At, 0, 1); PG8_STAGE(PG8_SB(0, 0), b2, voffB); PG8_STAGE(PG8_SB(0, 1), b2 + hstep, voffB); PG8_STAGE(PG8_SA(0, 0), a2, voffA);
            PG8_WAIT_V(8); PG8_WAIT_L(0); PG8_BAR; PG8_MMA(1, 0, At, B0); PG8_MMA(1, 1, At, B1); PG8_BAR; PG8_SCHED;
            PG8_LDB(B0, 1, 0); PG8_LDB(B1, 1, 1); PG8_SCHED; PG8_LDA(At, 1, 0); PG8_STAGE(PG8_SA(0, 1), a2 + hstep, voffA);
            PG8_WAIT_V(8); PG8_WAIT_L(0); PG8_BAR; PG8_MMA(0, 0, At, B0); PG8_MMA(0, 1, At, B1); PG8_BAR; PG8_SCHED;
            PG8_LDA(At, 1, 1); PG8_STAGE(PG8_SB(1, 0), b3, voffB); PG8_STAGE(PG8_SB(1, 1), b3 + hstep, voffB); PG8_STAGE(PG8_SA(1, 0), a3, voffA);
            PG8_WAIT_V(8); PG8_WAIT_L(0); PG8_BAR; PG8_MMA(1, 0, At, B0); PG8_MMA(1, 1, At, B1); PG8_BAR; PG8_SCHED;
            } else {
            PG8_LDB(B0, 0, 0); PG8_SCHED; PG8_LDA(At, 0, 0); PG8_STAGE(PG8_SA(1, 1), a1 + hstep, voffA);
            PG8_WAIT_L(8); PG8_BAR; PG8_WAIT_L(0); PG8_MMA(0, 0, At, B0); PG8_BAR; PG8_SCHED;
            PG8_LDB(B1, 0, 1); PG8_STAGE(PG8_SB(0, 0), b2, voffB);
            PG8_BAR; PG8_WAIT_L(0); PG8_MMA(0, 1, At, B1); PG8_BAR;
            PG8_LDA(At, 0, 1); PG8_STAGE(PG8_SA(0, 0), a2, voffA);
            PG8_BAR; PG8_WAIT_L(0); PG8_MMA(1, 0, At, B0); PG8_BAR; PG8_SCHED;
            PG8_STAGE(PG8_SB(0, 1), b2 + hstep, voffB);
            PG8_WAIT_V(6); PG8_BAR; PG8_MMA(1, 1, At, B1); PG8_BAR;
            PG8_LDB(B0, 1, 0); PG8_SCHED; PG8_LDA(At, 1, 0); PG8_STAGE(PG8_SA(0, 1), a2 + hstep, voffA);
            PG8_WAIT_L(8); PG8_BAR; PG8_WAIT_L(0); PG8_MMA(0, 0, At, B0); PG8_BAR; PG8_SCHED;
            PG8_LDB(B1, 1, 1); PG8_STAGE(PG8_SB(1, 0), b3, voffB);
            PG8_BAR; PG8_WAIT_L(0); PG8_MMA(0, 1, At, B1); PG8_BAR;
            PG8_LDA(At, 1, 1); PG8_STAGE(PG8_SA(1, 0), a3, voffA);
            PG8_BAR; PG8_WAIT_L(0); PG8_MMA(1, 0, At, B0); PG8_BAR; PG8_SCHED;
            PG8_STAGE(PG8_SB(1, 1), b3 + hstep, voffB);
            PG8_WAIT_V(6); PG8_BAR; PG8_MMA(1, 1, At, B1); PG8_BAR;
            }
        }
        if constexpr (ALIGN_EPI) { if (wr == 0) PG8_BAR; }
        if constexpr (!Epi::AFTER_DRAIN) { E(acc, cur, wr, wc, fr, fq); S.done(cur); }
        if (!has_next) break;
#pragma unroll
        for (int a = 0; a < 2; ++a)
#pragma unroll
            for (int b = 0; b < 2; ++b)
#pragma unroll
                for (int m = 0; m < 4; ++m)
#pragma unroll
                    for (int n = 0; n < 2; ++n) acc[a][b][m][n] = (f32x4){0.f, 0.f, 0.f, 0.f};
        cur = nxt; cA = nA; cB = nB; ++ui;
        if constexpr (ALIGN_EPI) { if (wr == 1) PG8_BAR; }
    }
    PG8_WAIT_V(0);
    if constexpr (!ALIGN_EPI) { if (wr == 0) PG8_BAR; }
    PG8_BAR;
    if constexpr (Epi::AFTER_DRAIN) { E.fused(acc, cur, wr, wc, fr, fq, lds, wid, lane); S.done(cur); }
#undef PG8_SA
#undef PG8_SB
#undef PG8_STAGE
#undef PG8_LDA
#undef PG8_LDB
#undef PG8_MMA
#undef PG8_WAIT_V
#undef PG8_WAIT_L
#undef PG8_BAR
#undef PG8_SCHED
}
}

namespace att {
typedef unsigned short bf16;
constexpr int D = 128, NW = 8, QBLK = 32, KVBLK = 64, LDQ = 1024, LDK = 256;
constexpr float SCALE = 0.088388347648318440f;
constexpr float THR = 3.f;
constexpr float QK8_SCALE = 4.f;
constexpr float V8A_SCALE = 4.f;
constexpr float O8_SCALE = 64.f;
#ifndef ATT_SDEPTH
#define ATT_SDEPTH 2
#endif
constexpr int SDEPTH = ATT_SDEPTH;
constexpr size_t SHM_V = KVBLK * D * 1  , SHM_K = KVBLK * D * 1  , SHM_ATTN = 2 * SHM_V + 2 * SHM_K + NW * 64 * 4;
#define VSWZ8(col, chunk) ((col) * 64 + ((((chunk) ^ ((col) >> 2)) & 3) << 4))
typedef int i32x8 __attribute__((ext_vector_type(8)));
typedef int i32x4 __attribute__((ext_vector_type(4)));
#define KSWZ8(row, colB) ((row) * 128 + ((colB) ^ ((((row) >> 1) & 7) << 4)))
using bf16x8 = __attribute__((ext_vector_type(8))) short;
using s16x4  = __attribute__((ext_vector_type(4))) short;
using f32x16 = __attribute__((ext_vector_type(16))) float;
using u32x4  = __attribute__((ext_vector_type(4))) unsigned;
#define KSWZ(row, colB) ((row) * 256 + ((colB) ^ (((row) & 7) << 4)))
#define SBAR() __builtin_amdgcn_sched_barrier(0)
__device__ __forceinline__ int crow(int r, int hi) { return (r & 3) + 8 * (r >> 2) + 4 * hi; }
__device__ __forceinline__ unsigned cvtpk(float lo, float hi) { unsigned r; asm volatile("v_cvt_pk_bf16_f32 %0, %1, %2" : "=v"(r) : "v"(lo), "v"(hi)); return r; }
typedef float f32x2 __attribute__((ext_vector_type(2)));
#define PAIR(P, i) (f32x2{P[2 * (i)], P[2 * (i) + 1]})
__device__ __forceinline__ void partialSM(f32x16& p0, f32x16& p1, float& m_reg, float& mn, float& alpha) {
  constexpr float C = SCALE * 1.4426950408889634f;
  float pmax = p0[0]; for (int r = 1; r < 16; ++r) pmax = fmaxf(pmax, p0[r]); for (int r = 0; r < 16; ++r) pmax = fmaxf(pmax, p1[r]);
  { auto rr = __builtin_amdgcn_permlane32_swap(__float_as_uint(pmax), __float_as_uint(pmax), false, false);
    pmax = fmaxf(__uint_as_float(rr[0]), __uint_as_float(rr[1])); }
  if (__builtin_expect(__all(pmax - m_reg <= THR / SCALE), 1)) { mn = m_reg; alpha = 1.f; }
  else { mn = fmaxf(m_reg, pmax); alpha = __builtin_amdgcn_exp2f((m_reg - mn) * C); m_reg = mn; }
  float mnC = 4.f - mn * C, Cv = C; asm volatile("" : "+v"(Cv));
  const f32x2 c2 = {Cv, Cv}, m2 = {mnC, mnC};
#pragma unroll
  for (int i = 0; i < 8; ++i) { const f32x2 a = __builtin_elementwise_fma(PAIR(p0, i), c2, m2), b = __builtin_elementwise_fma(PAIR(p1, i), c2, m2);
    p0[2 * i] = a[0]; p0[2 * i + 1] = a[1]; p1[2 * i] = b[0]; p1[2 * i + 1] = b[1]; }
  for (int r = 0; r < 16; ++r) p0[r] = __builtin_amdgcn_exp2f(p0[r]);
}
__device__ __forceinline__ void finishSM(f32x16& p0, f32x16& p1, float alpha, float& l_reg, i32x8& pa) {
  for (int r = 0; r < 16; ++r) p1[r] = __builtin_amdgcn_exp2f(p1[r]);
  f32x2 s2 = PAIR(p0, 0);
#pragma unroll
  for (int i = 1; i < 8; ++i) s2 += PAIR(p0, i);
#pragma unroll
  for (int i = 0; i < 8; ++i) s2 += PAIR(p1, i);
  float ps = s2[0] + s2[1];
  { auto rr = __builtin_amdgcn_permlane32_swap(__float_as_uint(ps), __float_as_uint(ps), false, false);
    ps = __uint_as_float(rr[0]) + __uint_as_float(rr[1]); }
  l_reg = l_reg * alpha + ps;
#define PK8(P, B) ({ int v_ = __builtin_amdgcn_cvt_pk_fp8_f32(P[B], P[B + 1], __float_as_int(P[B])  , false); v_ = __builtin_amdgcn_cvt_pk_fp8_f32(P[B + 2], P[B + 3], v_, true); (unsigned)v_; })
#pragma unroll
  for (int i = 0; i < 4; ++i) { const unsigned x = PK8(p0, 4 * i), y = PK8(p1, 4 * i); auto rr = __builtin_amdgcn_permlane32_swap(x, y, false, false); pa[2 * i] = (int)rr[0]; pa[2 * i + 1] = (int)rr[1]; }
#undef PK8
}
__device__ __forceinline__ void qkt(f32x16& p0, f32x16& p1, const char* Ks, const i32x8* qr, int r32, int hi) {
  p0 = f32x16{}; p1 = f32x16{};
#pragma unroll
  for (int sk = 0; sk < 2; ++sk) { const int cb = 64 * sk + 32 * hi;
    const i32x8 a0 = __builtin_shufflevector(*reinterpret_cast<const i32x4*>(Ks + KSWZ8(r32, cb)), *reinterpret_cast<const i32x4*>(Ks + KSWZ8(r32, cb + 16)), 0, 1, 2, 3, 4, 5, 6, 7);
    const i32x8 a1 = __builtin_shufflevector(*reinterpret_cast<const i32x4*>(Ks + KSWZ8(32 + r32, cb)), *reinterpret_cast<const i32x4*>(Ks + KSWZ8(32 + r32, cb + 16)), 0, 1, 2, 3, 4, 5, 6, 7);
    p0 = __builtin_amdgcn_mfma_scale_f32_32x32x64_f8f6f4(a0, qr[sk], p0, 0, 0, 0, 0x7d7d7d7d, 0, 0x7d7d7d7d);
    p1 = __builtin_amdgcn_mfma_scale_f32_32x32x64_f8f6f4(a1, qr[sk], p1, 0, 0, 0, 0x7d7d7d7d, 0, 0x7d7d7d7d); }
}
template <int D0> __device__ __forceinline__ void pv_one(f32x16& od, const char* Vt, i32x8 pa, int r32, int hi) {
  const int col = D0 * 32 + r32;
  const i32x8 b = __builtin_shufflevector(*reinterpret_cast<const i32x4*>(Vt + VSWZ8(col, 2 * hi)), *reinterpret_cast<const i32x4*>(Vt + VSWZ8(col, 2 * hi + 1)), 0, 1, 2, 3, 4, 5, 6, 7);
  od = __builtin_amdgcn_mfma_scale_f32_32x32x64_f8f6f4(pa, b, od, 0, 0, 0, 0x7f7f7f7f  , 0, 0x7d7d7d7d  );
}
__device__ __forceinline__ void pv_d0(f32x16* o, const char* Vt, i32x8 pa, int r32, int hi) {
  pv_one<0>(o[0], Vt, pa, r32, hi); pv_one<1>(o[1], Vt, pa, r32, hi); pv_one<2>(o[2], Vt, pa, r32, hi); pv_one<3>(o[3], Vt, pa, r32, hi);
}
#define PIN(x) asm volatile("" : "+v"(x))
#define LD8K(Ks, row, cb) __builtin_shufflevector(*reinterpret_cast<const i32x4*>((Ks) + KSWZ8(row, cb)), *reinterpret_cast<const i32x4*>((Ks) + KSWZ8(row, (cb) + 16)), 0, 1, 2, 3, 4, 5, 6, 7)
#define LD8V(Vt, col, h) __builtin_shufflevector(*reinterpret_cast<const i32x4*>((Vt) + VSWZ8(col, 2 * (h))), *reinterpret_cast<const i32x4*>((Vt) + VSWZ8(col, 2 * (h) + 1)), 0, 1, 2, 3, 4, 5, 6, 7)
#define MFQK(A, B, Cc) __builtin_amdgcn_mfma_scale_f32_32x32x64_f8f6f4(A, B, Cc, 0, 0, 0, 0x7d7d7d7d, 0, 0x7d7d7d7d)
#define MFPV(A, B, Cc) __builtin_amdgcn_mfma_scale_f32_32x32x64_f8f6f4(A, B, Cc, 0, 0, 0, 0x7f7f7f7f, 0, 0x7d7d7d7d)
#define PK8(P, B) ({ int v_ = __builtin_amdgcn_cvt_pk_fp8_f32(P[B], P[B + 1], __float_as_int(P[B]), false); v_ = __builtin_amdgcn_cvt_pk_fp8_f32(P[B + 2], P[B + 3], v_, true); (unsigned)v_; })
__device__ __forceinline__ void qk_fin(f32x16& n0, f32x16& n1, const char* Ks, const i32x8* qr, f32x16& c0, f32x16& c1, float alpha, float& l_reg, i32x8& pa, int r32, int hi) {
  const i32x8 a00 = LD8K(Ks, r32, 32 * hi), a10 = LD8K(Ks, 32 + r32, 32 * hi), a01 = LD8K(Ks, r32, 64 + 32 * hi), a11 = LD8K(Ks, 32 + r32, 64 + 32 * hi);
  SBAR(); n0 = MFQK(a00, qr[0], f32x16{}); SBAR();
#pragma unroll
  for (int r = 0; r < 8; ++r) c1[r] = __builtin_amdgcn_exp2f(c1[r]);
  SBAR(); n1 = MFQK(a10, qr[0], f32x16{}); SBAR();
#pragma unroll
  for (int r = 8; r < 16; ++r) c1[r] = __builtin_amdgcn_exp2f(c1[r]);
  SBAR(); n0 = MFQK(a01, qr[1], n0); SBAR();
  f32x2 s2 = PAIR(c0, 0);
#pragma unroll
  for (int i = 1; i < 8; ++i) s2 += PAIR(c0, i);
#pragma unroll
  for (int i = 0; i < 8; ++i) s2 += PAIR(c1, i);
  float ps = s2[0] + s2[1];
  { auto rr = __builtin_amdgcn_permlane32_swap(__float_as_uint(ps), __float_as_uint(ps), false, false); ps = __uint_as_float(rr[0]) + __uint_as_float(rr[1]); }
  l_reg = l_reg * alpha + ps;
  SBAR(); n1 = MFQK(a11, qr[1], n1); SBAR();
#pragma unroll
  for (int i = 0; i < 4; ++i) { const unsigned x = PK8(c0, 4 * i), y = PK8(c1, 4 * i); auto rr = __builtin_amdgcn_permlane32_swap(x, y, false, false); pa[2 * i] = (int)rr[0]; pa[2 * i + 1] = (int)rr[1]; }
  SBAR();
}
__device__ __forceinline__ void pv_part(f32x16* o, const char* Vt, const i32x8 pa, f32x16& n0, f32x16& n1, float& m_reg, float& alpha, int r32, int hi) {
  constexpr float C = SCALE * 1.4426950408889634f;
  const i32x8 b0 = LD8V(Vt, r32, hi), b1 = LD8V(Vt, 32 + r32, hi), b2 = LD8V(Vt, 64 + r32, hi), b3 = LD8V(Vt, 96 + r32, hi);
  SBAR(); o[0] = MFPV(pa, b0, o[0]); SBAR();
  float pmax = n0[0]; for (int r = 1; r < 16; ++r) pmax = fmaxf(pmax, n0[r]); for (int r = 0; r < 16; ++r) pmax = fmaxf(pmax, n1[r]);
  { auto rr = __builtin_amdgcn_permlane32_swap(__float_as_uint(pmax), __float_as_uint(pmax), false, false); pmax = fmaxf(__uint_as_float(rr[0]), __uint_as_float(rr[1])); }
  const bool keep = __all(pmax - m_reg <= THR / SCALE);
  const float mn = keep ? m_reg : fmaxf(m_reg, pmax);
  alpha = __builtin_amdgcn_exp2f((m_reg - mn) * C); m_reg = mn;
  float mnC = 4.f - mn * C, Cv = C; asm volatile("" : "+v"(Cv));
  const f32x2 c2 = {Cv, Cv}, m2 = {mnC, mnC};
  SBAR(); o[1] = MFPV(pa, b1, o[1]); SBAR();
#pragma unroll
  for (int i = 0; i < 8; ++i) { const f32x2 a = __builtin_elementwise_fma(PAIR(n0, i), c2, m2), b = __builtin_elementwise_fma(PAIR(n1, i), c2, m2);
    n0[2 * i] = a[0]; n0[2 * i + 1] = a[1]; n1[2 * i] = b[0]; n1[2 * i + 1] = b[1]; }
  PIN(n0); PIN(n1);
  SBAR(); o[2] = MFPV(pa, b2, o[2]); SBAR();
#pragma unroll
  for (int r = 0; r < 8; ++r) n0[r] = __builtin_amdgcn_exp2f(n0[r]);
  PIN(n0);
  SBAR(); o[3] = MFPV(pa, b3, o[3]); SBAR();
#pragma unroll
  for (int r = 8; r < 16; ++r) n0[r] = __builtin_amdgcn_exp2f(n0[r]);
  PIN(n0);
  SBAR();
}
#undef PK8
__device__ __forceinline__ void wmask(f32x16& p0, f32x16& p1, int kb, int qp, int hi) {
  const int bd = kb - qp + 4 * hi + 128;
#pragma unroll
  for (int r = 0; r < 16; ++r) { const int d0 = bd + (r & 3) + 8 * (r >> 2);
    if ((unsigned)d0 > 256u) p0[r] = -1e30f; if ((unsigned)(d0 + 32) > 256u) p1[r] = -1e30f; }
}
__device__ __forceinline__ void attn_unit(const bool WIN, const unsigned char* Qb, unsigned char* Ob, const unsigned char* __restrict__ Kh, const unsigned char* __restrict__ Vh  , int NT, int kstart, int q0, float sink_l2, float sink1_l2, char* lds) {
  int tid_ = threadIdx.x; asm volatile("" : "+v"(tid_));
  const int tid = tid_, wid = __builtin_amdgcn_readfirstlane(tid >> 6), lane = tid & 63, r32 = lane & 31, hi = lane >> 5;
  char* V_lds = lds; char* K_lds = lds + 2 * SHM_V;
  float* ws = (float*)(lds + 2 * SHM_V + 2 * SHM_K) + wid * 64; float* li_l = ws; float* al_l = ws + 32;
  float m_reg = -1e30f, l_reg = 0; f32x16 o[4] = {}; i32x8 qr[2];
  const int wrow = WIN ? (wid & 3) * QBLK : wid * QBLK, hoff = WIN ? (wid >> 2) * D : 0;
  const unsigned char* Qw = Qb + (long)(wrow + r32) * LDQ + hoff + hi * 32;
#pragma unroll
  for (int sk = 0; sk < 2; ++sk) qr[sk] = __builtin_shufflevector(*reinterpret_cast<const i32x4*>(Qw + sk * 64), *reinterpret_cast<const i32x4*>(Qw + sk * 64 + 16), 0, 1, 2, 3, 4, 5, 6, 7);
  const int vcol = tid >> 2, vpc = tid & 3;
  const int sr8 = tid >> 3, sc8 = (tid & 7) * 16;
  const int qp = q0 + wrow + r32;
  struct { i32x4 vs0, ks0; } sr_[SDEPTH];
#define TROW(t) (WIN ? ((t) < 4 ? (t) * KVBLK : kstart + (t) * KVBLK) : (t) * KVBLK)
#define SLOAD(i, t) do { const int k0_ = TROW(t); sr_[i].vs0 = *reinterpret_cast<const i32x4*>(&Vh[(long)vcol * RPB + k0_ + vpc * 16]); \
    sr_[i].ks0 = *reinterpret_cast<const i32x4*>(&Kh[(long)(k0_ + sr8) * LDK + sc8]); } while (0)
#define SWRITE(b, i) do { *(i32x4*)(V_lds + (b) * SHM_V + VSWZ8(vcol, vpc)) = sr_[i].vs0;          \
    *(i32x4*)((char*)K_lds + (b) * SHM_K + KSWZ8(sr8, sc8)) = sr_[i].ks0; } while (0)
#define SWAIT() do { if constexpr (SDEPTH == 2) asm volatile("s_waitcnt vmcnt(2)" ::: "memory"); else asm volatile("s_waitcnt vmcnt(0)" ::: "memory"); } while (0)
#define RESC(a) do { if (__any((a) < 1.f)) { if (hi == 0) al_l[r32] = (a); asm volatile("s_waitcnt lgkmcnt(0)" ::: "memory"); \
    for (int d = 0; d < 4; ++d) for (int r = 0; r < 16; ++r) o[d][r] *= al_l[crow(r, hi)]; } } while (0)
#define WMASK(P0, P1, t) do { if (WIN) { if ((t) >= 4) wmask(P0, P1, kstart + ((t) - 4) * KVBLK, qp, hi); } } while (0)
  f32x16 pA0, pA1, pB0, pB1; float mnA, mnB, alA, alB; i32x8 pa;
  constexpr int SE = 0, SO = SDEPTH - 1;
  SLOAD(SE, 0); asm volatile("s_waitcnt vmcnt(0)" ::: "memory"); SWRITE(0, SE); __syncthreads();
  qkt(pA0, pA1, K_lds, qr, r32, hi); WMASK(pA0, pA1, 0); partialSM(pA0, pA1, m_reg, mnA, alA);
  SLOAD(SO, 1); if constexpr (SDEPTH == 2) { if (2 < NT) SLOAD(SE, 2); }
  SWAIT(); SWRITE(1, SO); __syncthreads();
  for (int j = 1; j + 1 < NT; j += 2) {
    qk_fin(pB0, pB1, K_lds + SHM_K, qr, pA0, pA1, alA, l_reg, pa, r32, hi); WMASK(pB0, pB1, j);
    SLOAD(SO, j + SDEPTH); SBAR();
    pv_part(o, V_lds, pa, pB0, pB1, m_reg, alB, r32, hi);
    __syncthreads(); SWAIT(); SWRITE(0, SE);
    RESC(alB); __syncthreads();
    qk_fin(pA0, pA1, K_lds, qr, pB0, pB1, alB, l_reg, pa, r32, hi); WMASK(pA0, pA1, j + 1);
    if (SDEPTH == 1 || j + 3 < NT) SLOAD(SE, j + 1 + SDEPTH); SBAR();
    pv_part(o, V_lds + SHM_V, pa, pA0, pA1, m_reg, alA, r32, hi);
    __syncthreads(); SWAIT(); SWRITE(1, SO);
    RESC(alA); __syncthreads();
  }
  qk_fin(pB0, pB1, K_lds + SHM_K, qr, pA0, pA1, alA, l_reg, pa, r32, hi); WMASK(pB0, pB1, NT - 1);
  pv_part(o, V_lds, pa, pB0, pB1, m_reg, alB, r32, hi);
  __syncthreads(); RESC(alB);
  finishSM(pB0, pB1, alB, l_reg, pa); SBAR();
  pv_d0(o, V_lds + SHM_V, pa, r32, hi);
  if (WIN) { constexpr float C = SCALE * 1.4426950408889634f; l_reg += __builtin_amdgcn_exp2f(((wid >> 2) ? sink1_l2 : sink_l2) - m_reg * C + 4.f); }
  if (hi == 0) li_l[r32] = l_reg; asm volatile("s_waitcnt lgkmcnt(0)" ::: "memory");
  float rli[16];
#pragma unroll
  for (int r = 0; r < 16; ++r) rli[r] = __builtin_amdgcn_rcpf(li_l[crow(r, hi)]);
  unsigned char* Ow = Ob + (long)wrow * LDQ + hoff;
#pragma unroll
  for (int r = 0; r < 16; ++r) { const int orow = crow(r, hi);
#pragma unroll
    for (int d0 = 0; d0 < 4; ++d0) { const float v = o[d0][r] * rli[r] * O8_SCALE;     Ow[(long)orow * LDQ + d0 * 32 + r32] = (unsigned char)(__builtin_amdgcn_cvt_pk_fp8_f32(v, v, 0, false) & 0xff); } }
  __syncthreads();
#undef TROW
#undef SLOAD
#undef SWRITE
#undef SWAIT
#undef RESC
#undef WMASK
}
#undef KSWZ
#undef SBAR
}

namespace mk {
namespace cg = cooperative_groups;
typedef unsigned short bf16;
typedef short bf16x8 __attribute__((ext_vector_type(8)));
typedef float f32x4 __attribute__((ext_vector_type(4)));
typedef unsigned u32x4 __attribute__((ext_vector_type(4)));
typedef unsigned u32x2 __attribute__((ext_vector_type(2)));
typedef __bf16 bf2_t __attribute__((ext_vector_type(2)));
#define LAS __attribute__((address_space(3)))
constexpr int NWAVES = 8, NTHR = 512;
constexpr size_t MiB = 1u << 20;
constexpr size_t WS_CTL = 0, CTL_BYTES = 1 * MiB;
constexpr size_t WS_MOD = 1 * MiB;
constexpr size_t WS_ROPE = 1 * MiB + 512 * 1024;
constexpr size_t WS_XC = 2 * MiB;
constexpr size_t WS_WQKV = 6 * MiB;
constexpr size_t WS_WO = 12 * MiB;
constexpr size_t WS_WP = 16 * MiB;
constexpr size_t WS_H = 24 * MiB;
constexpr size_t WS_Q = 58 * MiB;
constexpr size_t WS_K = 92 * MiB;
constexpr size_t WS_V = 101 * MiB;
constexpr size_t WS_EIDX = 110 * MiB;
constexpr size_t WS_GATE = 119 * MiB;
constexpr size_t WS_PW = 128 * MiB;
constexpr size_t WS_S = 137 * MiB;
constexpr size_t WS_UT = 274 * MiB;
constexpr size_t WS_VT = 306 * MiB;
constexpr size_t WS_O = 338 * MiB;
constexpr size_t WS_XB = 372 * MiB;
constexpr size_t WS_XCB = 436 * MiB;
constexpr size_t WS_PART = 440 * MiB;
constexpr size_t WS_END = 508 * MiB;
constexpr float U8_SCALE = 64.f, V8_SCALE = 8.f;
constexpr int LDS_BYTES = 155648;
constexpr int NPHASE = 23;

struct Args { const float* in[17]; float* out; unsigned char* ws; int ph_lo, ph_hi; };

constexpr int PTAB_OFF = 153600;
struct Ctx {
  unsigned char* ws;
  int tid, lane, wave, bid, G;
  LAS unsigned char* lds; unsigned char* ldsg;
  __device__ __forceinline__ const float* in(int k) const {
    const volatile LAS unsigned* t = (const volatile LAS unsigned*)(lds + PTAB_OFF) + 2 * k;
    const unsigned lo = __builtin_amdgcn_readfirstlane(t[0]), hi = __builtin_amdgcn_readfirstlane(t[1]);
    return (const float*)(((unsigned long long)hi << 32) | lo);
  }
  __device__ __forceinline__ float* outp() const { return (float*)in(17); }
};
enum { I_X = 0, I_C, I_CTX, I_CCTX, I_ADAW, I_ADAB, I_N1G, I_N2G, I_WQKV, I_QNG, I_KNG, I_WO, I_SINKS, I_PWQ, I_PSK, I_PU, I_PV };

__device__ __forceinline__ unsigned f2bf(float f) { unsigned u = __builtin_bit_cast(unsigned, f); return (u + 0x7fffu + ((u >> 16) & 1u)) >> 16; }
__device__ __forceinline__ unsigned pk2(float lo, float hi) { unsigned r; asm volatile("v_cvt_pk_bf16_f32 %0, %1, %2" : "=v"(r) : "v"(lo), "v"(hi)); return r; }
__device__ __forceinline__ float bflo(unsigned u) { return __uint_as_float(u << 16); }
__device__ __forceinline__ float bfhi(unsigned u) { return __uint_as_float(u & 0xffff0000u); }
__device__ __forceinline__ float silu(float x) { return x / (1.f + __expf(-x)); }
__device__ __forceinline__ float gelu_tanh(float x) {
  const float y = 0.7978845608028654f * (x + 0.044715f * x * x * x);
  const float t = 1.f - 2.f / (__expf(2.f * y) + 1.f);
  return 0.5f * x * (1.f + t);
}
__device__ __forceinline__ float wave_sum(float v) {
#pragma unroll
  for (int o = 1; o < 64; o <<= 1) v += __shfl_xor(v, o);
  return v;
}
__device__ __forceinline__ const float* xrow_sel(const float* lat, const float* cx, int r) { const int b = r / RPB, j = r % RPB; return j < CTXL ? cx + (size_t)(b * CTXL + j) * DM : lat + (size_t)(b * SEQ + (j - CTXL)) * DM; }
__device__ __forceinline__ int mod_row(int r) { const int b = r / RPB, j = r % RPB; return j < CTXL ? 4 : b; }

__device__ __forceinline__ const float* st_lat(const Ctx& F, int sel) { return sel == 0 ? F.in(I_X) : (sel == 1 ? (const float*)(F.ws + WS_XB) : (const float*)F.outp()); }
__device__ __forceinline__ const float* st_ctx(const Ctx& F, int sel) { return sel == 0 ? F.in(I_CTX) : (sel == 1 ? (const float*)(F.ws + WS_XCB) : (const float*)(F.ws + WS_XC)); }
__device__ __forceinline__ int qk_perm_col(int n) {
  if (n >= (NH + NKV) * HD) return n; const int d = n & 127, axis = d >> 6, pair = (d >> 5) & 1, f = d & 31; return (n & ~127) + 2 * (axis * 32 + f) + pair; }
constexpr float W8_SCALE = 32.f;
template <bool QKPERM, bool FP8>
__device__ __forceinline__ void p0_transpose_item(const float* W, int K, int N, bf16* WT, LAS float* scr, int item, int lane) {
  const int nblk = N / 32, kb = item / nblk, nb = item % nblk, k0 = 64 * kb, n0 = 32 * nb;
  { float t[32];
#pragma unroll
    for (int i = 0; i < 32; ++i) t[i] = W[(size_t)(k0 + 2 * i + (lane >> 5)) * N + n0 + (lane & 31)];
#pragma unroll
    for (int i = 0; i < 32; ++i) scr[(2 * i + (lane >> 5)) * 33 + (lane & 31)] = t[i]; }
  asm volatile("s_waitcnt lgkmcnt(0)" ::: "memory");
  const int c = lane & 7;
#pragma unroll
  for (int j = 0; j < 4; ++j) { const int n = (lane >> 3) + 8 * j; const LAS float* s = scr + (8 * c) * 33 + n;
    if constexpr (FP8) { int v0 = __builtin_amdgcn_cvt_pk_fp8_f32(s[0 * 33] * W8_SCALE, s[1 * 33] * W8_SCALE, 0, false); v0 = __builtin_amdgcn_cvt_pk_fp8_f32(s[2 * 33] * W8_SCALE, s[3 * 33] * W8_SCALE, v0, true);
      int v1 = __builtin_amdgcn_cvt_pk_fp8_f32(s[4 * 33] * W8_SCALE, s[5 * 33] * W8_SCALE, 0, false); v1 = __builtin_amdgcn_cvt_pk_fp8_f32(s[6 * 33] * W8_SCALE, s[7 * 33] * W8_SCALE, v1, true);
      u32x2 o; o.x = (unsigned)v0; o.y = (unsigned)v1; *(u32x2*)((unsigned char*)WT + (size_t)(QKPERM ? qk_perm_col(n0 + n) : n0 + n) * K + k0 + 8 * c) = o; }
    else { u32x4 o; o.x = pk2(s[0 * 33], s[1 * 33]); o.y = pk2(s[2 * 33], s[3 * 33]); o.z = pk2(s[4 * 33], s[5 * 33]); o.w = pk2(s[6 * 33], s[7 * 33]);
      *(u32x4*)(WT + (size_t)(QKPERM ? qk_perm_col(n0 + n) : n0 + n) * K + k0 + 8 * c) = o; } }
  asm volatile("s_waitcnt lgkmcnt(0)" ::: "memory");
}

constexpr int CONV_NR = DEPTH * NKEYS * NKEYS;
__device__ __forceinline__ int conv_idle(int G, int p) { const int nu = p == 0 ? 408 : (p == 1 ? 272 : 544); return (nu % G) ? G - (nu % G) : 0; }
__device__ __forceinline__ void conv_slot(const Ctx& F, int p, int& lo, int& hi) {
  const int i0 = conv_idle(F.G, 0), i1 = conv_idle(F.G, 1), i2 = conv_idle(F.G, 2), tw = 8 * i0 + 4 * i1 + 10 * i2; lo = hi = 0; if (tw == 0) return;
  const int unit = (2 * CONV_NR + tw - 1) / tw;
  const int mine = conv_idle(F.G, p), first = F.G - mine; if (F.bid < first) return;
  const int wgt = p == 0 ? 8 : (p == 1 ? 4 : 10), base = (p == 0 ? 0 : (p == 1 ? 8 * i0 : 8 * i0 + 4 * i1)) + wgt * (F.bid - first);
  lo = base * unit; hi = lo + wgt * unit;
}
__device__ __forceinline__ void convert_rows(const Ctx& F, int r_lo, int r_hi) {
  constexpr int NR = CONV_NR;
  const float* pup = F.in(I_PU); const float* pvp = F.in(I_PV);
  if (r_hi > 2 * NR) r_hi = 2 * NR;
  for (int rr = r_lo + F.wave; rr < r_hi; rr += 2 * NWAVES) {
    f32x4 a[2][4];
#pragma unroll
    for (int q = 0; q < 2; ++q) { const int row = rr + q * NWAVES; if (row < r_hi) { const float* src = (row < NR ? pup : pvp) + (size_t)(row < NR ? row : row - NR) * DM;
#pragma unroll
        for (int i = 0; i < 4; ++i) a[q][i] = ((const f32x4*)src)[i * 64 + F.lane]; } }
#pragma unroll
    for (int q = 0; q < 2; ++q) { const int row = rr + q * NWAVES; if (row < r_hi) { const bool isu = row < NR; const int rw = isu ? row : row - NR; const float sc = isu ? U8_SCALE : V8_SCALE;
        const size_t lay = (size_t)(rw >> 14), ex = (size_t)(rw & 16383); unsigned char* dst = F.ws + (isu ? WS_UT : WS_VT);
#pragma unroll
        for (int i = 0; i < 4; ++i) { int v = __builtin_amdgcn_cvt_pk_fp8_f32(a[q][i].x * sc, a[q][i].y * sc, 0, false); v = __builtin_amdgcn_cvt_pk_fp8_f32(a[q][i].z * sc, a[q][i].w * sc, v, true);
          const int sl = 2 * i + (F.lane >> 5); *(unsigned*)(dst + ((lay * 8 + sl) * 16384 + ex) * 128 + ((F.lane & 31) * 4)) = (unsigned)v; } } }
  }
}

__device__ __forceinline__ void phase_prologue(const Ctx& F) {
  { LAS float* sl = (LAS float*)F.lds;
    LAS float* red = sl + 5 * DM;
    { const float* cp = F.in(I_C); const float* ccp = F.in(I_CCTX);
      for (int e = F.tid; e < 5 * DM; e += NTHR) { const int r = e / DM, j = e % DM; sl[e] = silu(r < 4 ? cp[r * DM + j] : ccp[j]); } }
    __syncthreads();
    const float* adaw = F.in(I_ADAW); const float* adab = F.in(I_ADAB);
    for (int task = F.bid; task < DEPTH * 96; task += F.G) {
      const int i = task / 96, n = (task % 96) * 64 + F.lane;
      const float* w = adaw + (size_t)i * DM * NMOD * DM + n;
      float a0 = 0.f, a1 = 0.f, a2 = 0.f, a3 = 0.f, a4 = 0.f;
#pragma unroll 1
      for (int j0 = 0; j0 < 128; j0 += 32) { float wv[32];
#pragma unroll
        for (int jj = 0; jj < 32; ++jj) wv[jj] = w[(size_t)(F.wave * 128 + j0 + jj) * NMOD * DM];
#pragma unroll
        for (int jj = 0; jj < 32; ++jj) { const int j = F.wave * 128 + j0 + jj;
          a0 += sl[j] * wv[jj]; a1 += sl[DM + j] * wv[jj]; a2 += sl[2 * DM + j] * wv[jj]; a3 += sl[3 * DM + j] * wv[jj]; a4 += sl[4 * DM + j] * wv[jj]; } }
      red[(F.wave * 5 + 0) * 64 + F.lane] = a0; red[(F.wave * 5 + 1) * 64 + F.lane] = a1; red[(F.wave * 5 + 2) * 64 + F.lane] = a2;
      red[(F.wave * 5 + 3) * 64 + F.lane] = a3; red[(F.wave * 5 + 4) * 64 + F.lane] = a4;
      __syncthreads();
      if (F.tid < 320) { const int r = F.tid >> 6, l = F.tid & 63; float s = 0.f;
#pragma unroll
        for (int w8 = 0; w8 < 8; ++w8) s += red[(w8 * 5 + r) * 64 + l];
        const int nn = (task % 96) * 64 + l;
        ((float*)(F.ws + WS_MOD))[((size_t)i * 5 + r) * NMOD * DM + nn] = s + adab[i * NMOD * DM + nn]; }
      __syncthreads();
    }
  }
  { LAS float* sk = (LAS float*)F.lds;
    LAS float* wq = sk + 128 * 132;
    const float* pskp = F.in(I_PSK); const float* pwqp = F.in(I_PWQ);
    for (int task = F.bid; task < DEPTH * 8 * 2 * 16; task += F.G) {
      const int jc = task & 15, half = (task >> 4) & 1, h = (task >> 5) & 7, i = task >> 8;
      const float* SK = pskp + ((size_t)i * 2 + half) * NKEYS * 128;
      const float* WQ = pwqp + (size_t)i * DM * PQN + (size_t)(jc * 64) * PQN + h * PQD + half * 128;
      for (int e = F.tid; e < 128 * 32; e += NTHR) { const int kk = e >> 5, d4 = e & 31; const f32x4 v = *(const f32x4*)(SK + (size_t)kk * 128 + d4 * 4); *(LAS f32x4*)(sk + kk * 132 + d4 * 4) = v; }
      for (int e = F.tid; e < 64 * 32; e += NTHR) { const int j = e >> 5, d4 = e & 31; const f32x4 v = *(const f32x4*)(WQ + (size_t)j * PQN + d4 * 4); *(LAS f32x4*)(wq + j * 128 + d4 * 4) = v; }
      __syncthreads();
      const int kk = F.tid & 127, jg = F.tid >> 7;
      float acc[16];
#pragma unroll
      for (int q = 0; q < 16; ++q) acc[q] = 0.f;
#pragma unroll 2
      for (int d4 = 0; d4 < 32; ++d4) { const f32x4 s = *(const LAS f32x4*)(sk + kk * 132 + d4 * 4);
#pragma unroll
        for (int q = 0; q < 16; ++q) { const f32x4 w = *(const LAS f32x4*)(wq + (jg * 16 + q) * 128 + d4 * 4); acc[q] += s.x * w.x + s.y * w.y + s.z * w.z + s.w * w.w; } }
      bf16* o = (bf16*)(F.ws + WS_WP) + ((size_t)i * PQN + h * PQD + half * 128 + kk) * DM + jc * 64 + jg * 16;
      u32x4 o0, o1; o0.x = pk2(acc[0], acc[1]); o0.y = pk2(acc[2], acc[3]); o0.z = pk2(acc[4], acc[5]); o0.w = pk2(acc[6], acc[7]);
      o1.x = pk2(acc[8], acc[9]); o1.y = pk2(acc[10], acc[11]); o1.z = pk2(acc[12], acc[13]); o1.w = pk2(acc[14], acc[15]);
      *(u32x4*)o = o0; *(u32x4*)(o + 8) = o1;
      __syncthreads();
    }
  }
  { const int gt = F.bid * NTHR + F.tid; float* rp = (float*)(F.ws + WS_ROPE);
    if (gt < 64 * 32) { const int pos = gt >> 5, f = gt & 31; const float inv = exp2f(-(float)(2 * f) * (13.287712379549449f / 64.f)); float sn, cs; sincosf((float)pos * inv, &sn, &cs); rp[2 * gt] = cs; rp[2 * gt + 1] = sn; }
    else if (gt < 64 * 32 + DEPTH * 2 * HD) { const int e = gt - 64 * 32, p = e & 127, which = (e >> 7) & 1, layer = e >> 8; const int q = p >> 1, pair = p & 1, d = (q >> 5) * 64 + pair * 32 + (q & 31);
      rp[64 * 32 * 2 + e] = (which == 0 ? F.in(I_QNG) : F.in(I_KNG))[layer * HD + d]; } }
  if (8 * conv_idle(F.G, 0) + 4 * conv_idle(F.G, 1) + 10 * conv_idle(F.G, 2) == 0) { const int per = (2 * CONV_NR + F.G - 1) / F.G; convert_rows(F, F.bid * per, (F.bid + 1) * per); }
  { LAS float* scr = (LAS float*)F.lds + F.wave * (64 * 33 + 16);
    const int gw = F.bid * NWAVES + F.wave, NGW = F.G * NWAVES;
    constexpr int I_QKV = (DM / 64) * (QKVD / 32), I_O = (DM / 64) * (DM / 32);
    const float* wqkvp = F.in(I_WQKV); const float* wop = F.in(I_WO);
    for (int it = gw; it < DEPTH * (I_QKV + I_O); it += NGW) {
      const int i = it / (I_QKV + I_O); int r = it % (I_QKV + I_O);
      if (r < I_QKV) p0_transpose_item<true, true>(wqkvp + (size_t)i * DM * QKVD, DM, QKVD, (bf16*)(F.ws + WS_WQKV + (size_t)i * QKVD * DM), scr, r, F.lane);
      else p0_transpose_item<false, true>(wop + (size_t)i * DM * DM, DM, DM, (bf16*)(F.ws + WS_WO + (size_t)i * DM * DM), scr, r - I_QKV, F.lane);
    }
  }
}

constexpr float H8_SCALE = 4.f;
__device__ __forceinline__ void phase_norm(const Ctx& F, int layer, int which  , int src_sel, bool latent_only) {
  const int gw = F.bid * NWAVES + F.wave, NGW = F.G * NWAVES;
  const float* gain = (which == 0 ? F.in(I_N1G) : F.in(I_N2G)) + layer * DM;
  const float* modl = (const float*)(F.ws + WS_MOD) + (size_t)layer * 5 * NMOD * DM;
  bf16* H = (bf16*)(F.ws + WS_H);
  const float* latp = st_lat(F, src_sel); const float* cxp = st_ctx(F, src_sel);
  for (int r = gw; r < NROWS; r += NGW) {
    if (latent_only && (r % RPB) < CTXL) continue;
    const float* xr = xrow_sel(latp, cxp, r);
    const float* mrow = modl + (size_t)mod_row(r) * NMOD * DM;
    const float* sh = mrow + (which == 0 ? 0 : 3) * DM; const float* sc = mrow + (which == 0 ? 1 : 4) * DM;
    f32x4 v[4]; float s = 0.f;
#pragma unroll
    for (int j = 0; j < 4; ++j) { v[j] = ((const f32x4*)xr)[F.lane + 64 * j]; s += (v[j].x * v[j].x + v[j].y * v[j].y) + (v[j].z * v[j].z + v[j].w * v[j].w); }
    const float rstd = rsqrtf(wave_sum(s) * (1.f / DM) + RMS_EPS);
    unsigned long long* o8 = (unsigned long long*)(H + (size_t)r * DM) + F.lane;
#pragma unroll
    for (int j = 0; j < 4; ++j) { const f32x4 g = ((const f32x4*)gain)[F.lane + 64 * j], a = ((const f32x4*)sc)[F.lane + 64 * j], b = ((const f32x4*)sh)[F.lane + 64 * j];
      const float y0 = v[j].x * rstd * g.x * (1.f + a.x) + b.x, y1 = v[j].y * rstd * g.y * (1.f + a.y) + b.y, y2 = v[j].z * rstd * g.z * (1.f + a.z) + b.z, y3 = v[j].w * rstd * g.w * (1.f + a.w) + b.w;
      if (which == 0) { int v8 = __builtin_amdgcn_cvt_pk_fp8_f32(y0 * H8_SCALE, y1 * H8_SCALE, 0, false); v8 = __builtin_amdgcn_cvt_pk_fp8_f32(y2 * H8_SCALE, y3 * H8_SCALE, v8, true);
        ((unsigned*)((unsigned char*)H + (size_t)r * DM))[F.lane + 64 * j] = (unsigned)v8; }
      else o8[64 * j] = (unsigned long long)pk2(y0, y1) | ((unsigned long long)pk2(y2, y3) << 32); }
  }
}

__device__ __forceinline__ void phase_qknorm(const Ctx& F, int layer) {
  const int gw = F.bid * NWAVES + F.wave, NGW = F.G * NWAVES;
  const int axis = F.lane >> 5, f = F.lane & 31, e1 = axis * 64 + f, e2 = e1 + 32;
  const float* qg = F.in(I_QNG) + layer * HD; const float* kg = F.in(I_KNG) + layer * HD;
  const float qg1 = qg[e1], qg2 = qg[e2], kg1 = kg[e1], kg2 = kg[e2];
  const float inv = exp2f(-(float)(2 * f) * (13.287712379549449f / 64.f));
  bf16* Q = (bf16*)(F.ws + WS_Q); bf16* K = (bf16*)(F.ws + WS_K);
  for (int r = gw; r < NROWS; r += NGW) {
    const int j = r % RPB; float cs = 1.f, sn = 0.f;
    if (j >= CTXL) { const int sp = j - CTXL; const float pos = (float)(axis == 0 ? (sp >> 6) : (sp & 63)); sincosf(pos * inv, &sn, &cs); }
#pragma unroll
    for (int h = 0; h < NH + NKV; ++h) {
      bf16* base = h < NH ? Q + (size_t)r * DM + h * HD : K + (size_t)r * (NKV * HD) + (h - NH) * HD;
      float x1 = bflo(base[e1]), x2 = bflo(base[e2]);
      const float rstd = rsqrtf(wave_sum(x1 * x1 + x2 * x2) * (1.f / HD) + RMS_EPS);
      x1 *= rstd * (h < NH ? qg1 : kg1); x2 *= rstd * (h < NH ? qg2 : kg2);
      const float y1 = x1 * cs - x2 * sn, y2 = x1 * sn + x2 * cs;
      base[e1] = (bf16)f2bf(y1); base[e2] = (bf16)f2bf(y2);
    }
  }
}
struct Order {
  int nM, nN, nwg, G, c, lat;
  __device__ void init(int nM_, int nN_, int G_, int c_, int lat_) { nM = nM_; nN = nN_; nwg = nM * nN; G = G_; c = c_; lat = lat_; }
  __device__ bool next(int i, pg8::Unit& u) const {
    const long L = (long)i * G + c; if (L >= nwg) return false;
    int wgid = (int)L; { const int q = nwg / 8, r = nwg % 8, xcd = wgid % 8, off = wgid / 8; wgid = (xcd < r ? xcd * (q + 1) : r * (q + 1) + (xcd - r) * q) + off; }
    const int WGM = 8, nig = WGM * nN, gid = wgid / nig, fm = gid * WGM, gsz = (nM - fm) < WGM ? (nM - fm) : WGM;
    int pm = fm + ((wgid % nig) % gsz); u.pn = (wgid % nig) / gsz;
    if (lat) pm = (pm >> 4) * 17 + 1 + (pm & 15);
    u.pm = pm; return true;
  }
  __device__ __forceinline__ void a_ready(const pg8::Unit&) const {}
  __device__ __forceinline__ void done(const pg8::Unit&) const {}
};
struct EpiQKV {
  static constexpr bool PERM = true, AFTER_DRAIN = false;
  unsigned char* ws; LAS float* xs  ; int layer;
  __device__ __forceinline__ void operator()(const pg8::f32x4 (&acc)[2][2][4][2], const pg8::Unit& u, int wr, int wc, int fr, int fq) const {
    const int row0 = u.pm * 256 + wr * 64 + fr;
    const size_t boff = u.pn < 4 ? WS_Q : (u.pn == 4 ? WS_K : WS_V); const int ldc = u.pn < 4 ? DM : NKV * HD, colt = u.pn < 4 ? u.pn * 256 : 0;
    bf16* base = (bf16*)(ws + boff);
    const int col0 = colt + wc * 32 + 8 * fq;
    if (u.pn == 5) {
      unsigned char* vt = ws + WS_V; const int bt = (u.pm * 256) / RPB, key0 = (u.pm * 256) % RPB + wr * 64 + fr;
#pragma unroll
      for (int ai = 0; ai < 2; ++ai)
#pragma unroll
        for (int m = 0; m < 4; ++m) { const int key = key0 + ai * 128 + m * 16;
#pragma unroll
          for (int bj = 0; bj < 2; ++bj) { const pg8::f32x4 v0 = acc[ai][bj][m][0], v1 = acc[ai][bj][m][1];
            int w0 = __builtin_amdgcn_cvt_pk_fp8_f32(v0[0] * att::V8A_SCALE, v0[1] * att::V8A_SCALE, 0, false); w0 = __builtin_amdgcn_cvt_pk_fp8_f32(v0[2] * att::V8A_SCALE, v0[3] * att::V8A_SCALE, w0, true);
            int w1 = __builtin_amdgcn_cvt_pk_fp8_f32(v1[0] * att::V8A_SCALE, v1[1] * att::V8A_SCALE, 0, false); w1 = __builtin_amdgcn_cvt_pk_fp8_f32(v1[2] * att::V8A_SCALE, v1[3] * att::V8A_SCALE, w1, true);
            unsigned char* cp = vt + ((size_t)((bt * 2 + bj) * 128 + wc * 32 + 8 * fq)) * RPB + key;
            cp[0 * RPB] = (unsigned char)(w0 & 0xff); cp[1 * RPB] = (unsigned char)((w0 >> 8) & 0xff); cp[2 * RPB] = (unsigned char)((w0 >> 16) & 0xff); cp[3 * RPB] = (unsigned char)((unsigned)w0 >> 24);
            cp[4 * RPB] = (unsigned char)(w1 & 0xff); cp[5 * RPB] = (unsigned char)((w1 >> 8) & 0xff); cp[6 * RPB] = (unsigned char)((w1 >> 16) & 0xff); cp[7 * RPB] = (unsigned char)((unsigned)w1 >> 24); } }
      return;
    }
#pragma unroll
    for (int ai = 0; ai < 2; ++ai)
#pragma unroll
      for (int m = 0; m < 4; ++m)
#pragma unroll
        for (int bj = 0; bj < 2; ++bj) { const pg8::f32x4 v0 = acc[ai][bj][m][0], v1 = acc[ai][bj][m][1];
          float ss = (v0[0] * v0[0] + v0[1] * v0[1]) + (v0[2] * v0[2] + v0[3] * v0[3]) + (v1[0] * v1[0] + v1[1] * v1[1]) + (v1[2] * v1[2] + v1[3] * v1[3]);
          ss += __shfl_xor(ss, 16); ss += __shfl_xor(ss, 32);
          if (fq == 0) xs[((((wr * 2 + ai) * 4 + m) * 16 + fr) * 2 + bj) * 4 + wc] = ss; }
    asm volatile("s_waitcnt lgkmcnt(0)" ::: "memory"); __builtin_amdgcn_s_barrier(); asm volatile("" ::: "memory");
    const float* rp = (const float*)(ws + WS_ROPE);
    const float* gp = rp + 64 * 32 * 2 + (layer * 2 + (u.pn < 4 ? 0 : 1)) * HD + wc * 32 + 8 * fq;
    const f32x4 g0 = *(const f32x4*)gp, g1 = *(const f32x4*)(gp + 4);
    const bool latent = (u.pm % 17) != 0;
    const int axis = wc >> 1, f0 = 16 * (wc & 1) + 4 * fq;
#pragma unroll
    for (int ai = 0; ai < 2; ++ai)
#pragma unroll
      for (int m = 0; m < 4; ++m) { const int r = row0 + ai * 128 + m * 16;
        f32x4 c01 = {1.f, 0.f, 1.f, 0.f}, c23 = {1.f, 0.f, 1.f, 0.f};
        if (latent) { const int sp = (r % RPB) - CTXL, pos = axis == 0 ? (sp >> 6) : (sp & 63); const float* cp = rp + (pos * 32 + f0) * 2; c01 = *(const f32x4*)cp; c23 = *(const f32x4*)(cp + 4); }
        unsigned char* rowp = (unsigned char*)base + (size_t)r * ldc + col0;
#pragma unroll
        for (int bj = 0; bj < 2; ++bj) { const LAS float* xp = xs + ((((wr * 2 + ai) * 4 + m) * 16 + fr) * 2 + bj) * 4;
          const float rstd = rsqrtf(((xp[0] + xp[1]) + (xp[2] + xp[3])) * (1.f / HD) + RMS_EPS);
          const pg8::f32x4 v0 = acc[ai][bj][m][0], v1 = acc[ai][bj][m][1];
          const float a0 = v0[0] * rstd * g0.x, b0 = v0[1] * rstd * g0.y, a1 = v0[2] * rstd * g0.z, b1 = v0[3] * rstd * g0.w;
          const float a2 = v1[0] * rstd * g1.x, b2 = v1[1] * rstd * g1.y, a3 = v1[2] * rstd * g1.z, b3 = v1[3] * rstd * g1.w;
          constexpr float QS = att::QK8_SCALE;
          int w0 = __builtin_amdgcn_cvt_pk_fp8_f32((a0 * c01.x - b0 * c01.y) * QS, (a0 * c01.y + b0 * c01.x) * QS, 0, false); w0 = __builtin_amdgcn_cvt_pk_fp8_f32((a1 * c01.z - b1 * c01.w) * QS, (a1 * c01.w + b1 * c01.z) * QS, w0, true);
          int w1 = __builtin_amdgcn_cvt_pk_fp8_f32((a2 * c23.x - b2 * c23.y) * QS, (a2 * c23.y + b2 * c23.x) * QS, 0, false); w1 = __builtin_amdgcn_cvt_pk_fp8_f32((a3 * c23.z - b3 * c23.w) * QS, (a3 * c23.w + b3 * c23.z) * QS, w1, true);
          u32x2 w; w.x = (unsigned)w0; w.y = (unsigned)w1; *(u32x2*)(rowp + bj * 128) = w; } }
    asm volatile("s_waitcnt lgkmcnt(0)" ::: "memory"); __builtin_amdgcn_s_barrier(); asm volatile("" ::: "memory");
  }
};
struct EpiRes {
  static constexpr bool PERM = false, AFTER_DRAIN = false;
  const float *xin, *cin; float *xout, *xc; const float* gmod  ;
  __device__ __forceinline__ void operator()(const pg8::f32x4 (&acc)[2][2][4][2], const pg8::Unit& u, int wr, int wc, int fr, int fq) const {
    const int col0 = u.pn * 256 + wc * 32 + 4 * fq;
#pragma unroll
    for (int ai = 0; ai < 2; ++ai)
#pragma unroll
      for (int m = 0; m < 4; ++m) { const int r = u.pm * 256 + ai * 128 + wr * 64 + m * 16 + fr;
        const int b_ = r / RPB, j_ = r % RPB; const size_t oc = (size_t)(b_ * CTXL + j_) * DM, ol = (size_t)(b_ * SEQ + (j_ - CTXL)) * DM;
        float* xn = j_ < CTXL ? xc + oc : xout + ol; const float* xo = j_ < CTXL ? cin + oc : xin + ol; const float* g = gmod + (size_t)(j_ < CTXL ? 4 : b_) * NMOD * DM;
#pragma unroll
        for (int bj = 0; bj < 2; ++bj)
#pragma unroll
          for (int n = 0; n < 2; ++n) { const int c = col0 + bj * 128 + n * 16; const f32x4 xv = *(const f32x4*)(xo + c), gv = *(const f32x4*)(g + c); const pg8::f32x4 a = acc[ai][bj][m][n];
            f32x4 o; o.x = xv.x + gv.x * a[0]; o.y = xv.y + gv.y * a[1]; o.z = xv.z + gv.z * a[2]; o.w = xv.w + gv.w * a[3]; *(f32x4*)(xn + c) = o; } }
  }
};
struct EpiF32 {
  static constexpr bool PERM = true, AFTER_DRAIN = false;
  _Float16* S; int ldc;
  __device__ __forceinline__ void operator()(const pg8::f32x4 (&acc)[2][2][4][2], const pg8::Unit& u, int wr, int wc, int fr, int fq) const {
    typedef _Float16 h8 __attribute__((ext_vector_type(8)));
    const int col0 = u.pn * 256 + wc * 32 + 8 * fq;
#pragma unroll
    for (int ai = 0; ai < 2; ++ai)
#pragma unroll
      for (int m = 0; m < 4; ++m) { _Float16* rowp = S + (size_t)(u.pm * 256 + ai * 128 + wr * 64 + m * 16 + fr) * ldc + col0;
#pragma unroll
        for (int bj = 0; bj < 2; ++bj) { const pg8::f32x4 v0 = acc[ai][bj][m][0], v1 = acc[ai][bj][m][1];
          h8 o; o[0] = (_Float16)v0[0]; o[1] = (_Float16)v0[1]; o[2] = (_Float16)v0[2]; o[3] = (_Float16)v0[3]; o[4] = (_Float16)v1[0]; o[5] = (_Float16)v1[1]; o[6] = (_Float16)v1[2]; o[7] = (_Float16)v1[3];
          *(h8*)(rowp + bj * 128) = o; } }
  }
};

__device__ __forceinline__ void phase_attn(const Ctx& F, int layer) {
  const unsigned char* Q = F.ws + WS_Q; const unsigned char* K = F.ws + WS_K; const unsigned char* V = F.ws + WS_V;
  char* lds = (char*)F.ldsg;
  const int pair = F.bid & 7, slot = F.bid >> 3, nslot = F.G >> 3;
  const int b = pair >> 1, g = pair & 1;
  const unsigned char* Kh = K + (size_t)(b * RPB) * (NKV * HD) + g * HD; const unsigned char* Vh = V + (size_t)((b * 2 + g) * 128) * RPB;
  const float* sinkp = F.in(I_SINKS);
  const int nunits = layer == 0 ? 68 : 64;
#pragma unroll 1
  for (int u = slot; u < nunits; u += nslot) {
    int h, NT, ks = 0, q0 = 0; float sk = 0.f, sk1 = 0.f; const unsigned char* Qb; const bool win = layer != 0;
    if (u < 64) {
      if (!win) { h = g * 4 + (u >> 4); const int qb = u & 15; Qb = Q + (size_t)(b * RPB + CTXL + qb * 256) * DM + h * HD; NT = RPB / 64; }
      else { h = g * 4 + (u >> 5) * 2; q0 = (u & 31) * 128; Qb = Q + (size_t)(b * RPB + CTXL + q0) * DM + h * HD;
        ks = q0 - 128 < 0 ? 0 : q0 - 128; const int ke = q0 + 256 > SEQ ? SEQ : q0 + 256; NT = 4 + (ke - ks) / 64;
        sk = sinkp[(layer / 2) * NH + h] * 1.4426950408889634f; sk1 = sinkp[(layer / 2) * NH + h + 1] * 1.4426950408889634f; } }
    else { h = g * 4 + (u - 64); Qb = Q + (size_t)(b * RPB) * DM + h * HD; NT = CTXL / 64; }
    att::attn_unit(win, Qb, F.ws + WS_O + (Qb - Q), Kh, Vh, NT, ks, q0, sk, sk1, lds);
  }
}

__device__ __forceinline__ void ins16(float (&v)[16], float x) {
#pragma unroll
  for (int i = 0; i < 16; ++i) { const float hi = fmaxf(v[i], x); x = fminf(v[i], x); v[i] = hi; }
}
#define CE_DESC(x, y) do { const float hi_ = fmaxf(x, y), lo_ = fminf(x, y); x = hi_; y = lo_; } while (0)
__device__ __forceinline__ void bitonic_merge16(float (&v)[16]) {
#pragma unroll
  for (int j = 8; j >= 1; j >>= 1)
#pragma unroll
    for (int i = 0; i < 16; ++i) if ((i & j) == 0) CE_DESC(v[i], v[i | j]);
}
__device__ __forceinline__ void bitonic_sort16(float (&v)[16]) {
#pragma unroll
  for (int k = 2; k <= 16; k <<= 1)
#pragma unroll
    for (int j = k >> 1; j >= 1; j >>= 1)
#pragma unroll
      for (int i = 0; i < 16; ++i) { const int l = i ^ j; if (l > i) { if ((i & k) == 0 || k == 16) CE_DESC(v[i], v[l]); else CE_DESC(v[l], v[i]); } }
}
__device__ __forceinline__ void top16_merge(float (&a)[16], const float (&b)[16]) {
#pragma unroll
  for (int i = 0; i < 16; ++i) a[i] = fmaxf(a[i], b[15 - i]);
  bitonic_merge16(a);
}
__device__ __forceinline__ void topk_step1(const LAS float* sc, LAS unsigned* T, int tid) {
  float v[16];
  { const LAS float* my = sc + tid * 65; const unsigned eb = (tid & 1) * 64;
    float g1[16];
#define LOAD16(dst, off) do { _Pragma("unroll") for (int e = 0; e < 16; ++e) dst[e] = __uint_as_float((__float_as_uint(my[(off) + e]) & ~127u) | (eb + (off) + e)); } while (0)
    LOAD16(v, 0); bitonic_sort16(v); LOAD16(g1, 16); bitonic_sort16(g1); top16_merge(v, g1);
    float h1[16];
    LOAD16(h1, 32); bitonic_sort16(h1); LOAD16(g1, 48); bitonic_sort16(g1); top16_merge(h1, g1);
    top16_merge(v, h1);
#undef LOAD16
  }
  { float o[16];
#pragma unroll
    for (int i = 0; i < 16; ++i) o[i] = __shfl_xor(v[i], 1);
    top16_merge(v, o); }
  if ((tid & 1) == 0) {
#pragma unroll
    for (int i = 0; i < 16; ++i) T[(tid >> 1) * 16 + i] = __float_as_uint(v[i]); }
}
__device__ __forceinline__ void topk_step2(const LAS unsigned* T, int p1, int* eout, float* gout) {
  const int p2 = p1 + 16;
  float a[16], bq[16];
#pragma unroll
  for (int i = 0; i < 16; ++i) { a[i] = __uint_as_float(T[p1 + i] & ~127u); bq[i] = __uint_as_float(T[p2 + i] & ~127u); }
  float w[16];
#pragma unroll
  for (int i = 0; i < 16; ++i) w[i] = __uint_as_float((__float_as_uint(a[0] + bq[i]) & ~255u) | (unsigned)i);
  { float r1[16];
#pragma unroll
    for (int i = 0; i < 16; ++i) r1[i] = i < 8 ? __uint_as_float((__float_as_uint(a[1] + bq[i]) & ~255u) | (unsigned)(16 + i)) : -INFINITY;
    top16_merge(w, r1); }
#pragma unroll
  for (int ia = 2; ia < 16; ++ia)
#pragma unroll
    for (int ib = 0; ib < 16; ++ib) if ((ia + 1) * (ib + 1) <= 16) { const float s_ = a[ia] + bq[ib]; ins16(w, __uint_as_float((__float_as_uint(s_) & ~255u) | (unsigned)(ia * 16 + ib))); }
  float ts[16]; int ex[16];
#pragma unroll
  for (int k = 0; k < 16; ++k) { const unsigned id = __float_as_uint(w[k]) & 255u; const unsigned k1 = T[p1 + (id >> 4)], k2 = T[p2 + (id & 15)];
    ts[k] = __uint_as_float(k1 & ~127u) + __uint_as_float(k2 & ~127u); ex[k] = (int)((k1 & 127u) * NKEYS + (k2 & 127u)); }
  float m = ts[0];
#pragma unroll
  for (int k = 1; k < 16; ++k) m = fmaxf(m, ts[k]);
  float l = 0.f;
#pragma unroll
  for (int k = 0; k < 16; ++k) { ts[k] = __expf(ts[k] - m); l += ts[k]; }
  const float il = 1.f / l;
#pragma unroll
  for (int k = 0; k < 16; k += 4) { *(int4*)(eout + k) = make_int4(ex[k], ex[k + 1], ex[k + 2], ex[k + 3]);
    f32x4 gv; gv.x = ts[k] * il; gv.y = ts[k + 1] * il; gv.z = ts[k + 2] * il; gv.w = ts[k + 3] * il; *(f32x4*)(gout + k) = gv; }
}
struct EpiTopk {
  static constexpr bool PERM = false, AFTER_DRAIN = true;
  int* EIDX; float* GATE;
  __device__ __forceinline__ void fused(pg8::f32x4 (&acc)[2][2][4][2], const pg8::Unit& u, int wr, int wc, int fr, int fq, PG8_LAS unsigned char* lds, int wid, int lane) const {
    LAS float* sc = (LAS float*)lds; LAS unsigned* T = (LAS unsigned*)(lds + 512 * 65 * 4);
    const int tid = wid * 64 + lane;
#pragma unroll
    for (int ai = 0; ai < 2; ++ai) {
#pragma unroll
      for (int m = 0; m < 4; ++m) { const int rl = wr * 64 + m * 16 + fr;
#pragma unroll
        for (int bj = 0; bj < 2; ++bj)
#pragma unroll
          for (int n = 0; n < 2; ++n) { const int c = bj * 128 + wc * 32 + n * 16 + fq * 4; LAS float* d = sc + (rl * 4 + (c >> 6)) * 65 + (c & 63); const pg8::f32x4 a = acc[ai][bj][m][n];
            d[0] = a[0]; d[1] = a[1]; d[2] = a[2]; d[3] = a[3]; } }
      asm volatile("s_waitcnt lgkmcnt(0)" ::: "memory"); __builtin_amdgcn_s_barrier(); asm volatile("" ::: "memory");
      topk_step1(sc, T, tid);
      asm volatile("s_waitcnt lgkmcnt(0)" ::: "memory"); __builtin_amdgcn_s_barrier(); asm volatile("" ::: "memory");
      if (tid < 128) { const size_t ob = (size_t)(u.pm * 256 + ai * 128 + tid) * 128 + u.pn * 16; topk_step2(T, tid * 32, EIDX + ob, GATE + ob); }
      asm volatile("s_waitcnt lgkmcnt(0)" ::: "memory"); __builtin_amdgcn_s_barrier(); asm volatile("" ::: "memory");
    }
  }
};
struct OneUnit {
  pg8::Unit u0;
  __device__ bool next(int i, pg8::Unit& u) const { if (i != 0) return false; u = u0; return true; }
  __device__ __forceinline__ void a_ready(const pg8::Unit&) const {}
  __device__ __forceinline__ void done(const pg8::Unit&) const {}
};
__device__ __forceinline__ void phase_topk(const Ctx& F, bool latent_only) {
  LAS float* sc = (LAS float*)F.lds;
  LAS unsigned* T = (LAS unsigned*)(F.lds + 512 * 65 * 4);
  const _Float16* S = (const _Float16*)(F.ws + WS_S); int* EIDX = (int*)(F.ws + WS_EIDX); float* GATE = (float*)(F.ws + WS_GATE);
  const int ngroups = NROWS / 16;
  auto grpok = [&](int gq) { return gq < ngroups && !(latent_only && ((gq * 16) % RPB) < CTXL); };
  int grp = F.bid; while (grp < ngroups && !grpok(grp)) grp += F.G;
  typedef _Float16 h4 __attribute__((ext_vector_type(4)));
  h4 v[16];
  if (grp < ngroups) {
#pragma unroll
    for (int it = 0; it < 16; ++it) v[it] = *(const h4*)(S + (size_t)(grp * 16 + it) * PQN + F.tid * 4); }
  for (; grp < ngroups; ) {
    const int r0 = grp * 16;
    int gn = grp + F.G; while (gn < ngroups && !grpok(gn)) gn += F.G;
#pragma unroll
    for (int it = 0; it < 16; ++it) { const int c = F.tid * 4; LAS float* d = sc + (it * 32 + (c >> 6)) * 65 + (c & 63); d[0] = (float)v[it][0]; d[1] = (float)v[it][1]; d[2] = (float)v[it][2]; d[3] = (float)v[it][3]; }
    if (gn < ngroups) {
#pragma unroll
      for (int it = 0; it < 16; ++it) v[it] = *(const h4*)(S + (size_t)(gn * 16 + it) * PQN + F.tid * 4); }
    __syncthreads();
    float v[16];
    { const LAS float* my = sc + F.tid * 65; const unsigned eb = (F.tid & 1) * 64;
      float g1[16];
#define LOAD16(dst, off) do { _Pragma("unroll") for (int e = 0; e < 16; ++e) dst[e] = __uint_as_float((__float_as_uint(my[(off) + e]) & ~127u) | (eb + (off) + e)); } while (0)
      LOAD16(v, 0); bitonic_sort16(v); LOAD16(g1, 16); bitonic_sort16(g1); top16_merge(v, g1);
      float h1[16];
      LOAD16(h1, 32); bitonic_sort16(h1); LOAD16(g1, 48); bitonic_sort16(g1); top16_merge(h1, g1);
      top16_merge(v, h1);
#undef LOAD16
    }
    { float o[16];
#pragma unroll
      for (int i = 0; i < 16; ++i) o[i] = __shfl_xor(v[i], 1);
      top16_merge(v, o); }
    if ((F.tid & 1) == 0) {
#pragma unroll
      for (int i = 0; i < 16; ++i) T[(F.tid >> 1) * 16 + i] = __float_as_uint(v[i]); }
    __syncthreads();
    if (F.tid < 128) {
      const int rl = F.tid >> 3, head = F.tid & 7, p1 = (rl * 16 + head * 2) * 16, p2 = p1 + 16;
      float a[16], bq[16];
#pragma unroll
      for (int i = 0; i < 16; ++i) { a[i] = __uint_as_float(T[p1 + i] & ~127u); bq[i] = __uint_as_float(T[p2 + i] & ~127u); }
      float w[16];
#pragma unroll
      for (int i = 0; i < 16; ++i) w[i] = __uint_as_float((__float_as_uint(a[0] + bq[i]) & ~255u) | (unsigned)i);
      { float r1[16];
#pragma unroll
        for (int i = 0; i < 16; ++i) r1[i] = i < 8 ? __uint_as_float((__float_as_uint(a[1] + bq[i]) & ~255u) | (unsigned)(16 + i)) : -INFINITY;
        top16_merge(w, r1); }
#pragma unroll
      for (int ia = 2; ia < 16; ++ia)
#pragma unroll
        for (int ib = 0; ib < 16; ++ib) if ((ia + 1) * (ib + 1) <= 16) { const float s = a[ia] + bq[ib]; ins16(w, __uint_as_float((__float_as_uint(s) & ~255u) | (unsigned)(ia * 16 + ib))); }
      float ts[16]; int ex[16];
#pragma unroll
      for (int k = 0; k < 16; ++k) { const unsigned id = __float_as_uint(w[k]) & 255u; const unsigned k1 = T[p1 + (id >> 4)], k2 = T[p2 + (id & 15)];
        ts[k] = __uint_as_float(k1 & ~127u) + __uint_as_float(k2 & ~127u); ex[k] = (int)((k1 & 127u) * NKEYS + (k2 & 127u)); }
      float m = ts[0];
#pragma unroll
      for (int k = 1; k < 16; ++k) m = fmaxf(m, ts[k]);
      float l = 0.f;
#pragma unroll
      for (int k = 0; k < 16; ++k) { ts[k] = __expf(ts[k] - m); l += ts[k]; }
      const float il = 1.f / l; const size_t ob = (size_t)(r0 + rl) * 128 + head * 16;
#pragma unroll
      for (int k = 0; k < 16; k += 4) { *(int4*)(EIDX + ob + k) = make_int4(ex[k], ex[k + 1], ex[k + 2], ex[k + 3]);
        f32x4 gv; gv.x = ts[k] * il; gv.y = ts[k + 1] * il; gv.z = ts[k + 2] * il; gv.w = ts[k + 3] * il; *(f32x4*)(GATE + ob + k) = gv; }
    }
    __syncthreads();
    grp = gn;
  }
}

typedef float f32x2 __attribute__((ext_vector_type(2)));
__device__ __forceinline__ float dpp_ror_add(float x, int) { return x; }
#define ROW_ROR_ADD(x, n) do { const int xi_ = __builtin_bit_cast(int, x); x += __builtin_bit_cast(float, __builtin_amdgcn_update_dpp(0, xi_, 0x120 + (n), 0xf, 0xf, false)); } while (0)
__device__ __forceinline__ float dot16_fp8(u32x4 q, const float* h, float acc) {
  const int q0 = (int)q.x, q1 = (int)q.y, q2 = (int)q.z, q3 = (int)q.w; f32x2 t;
  t = __builtin_amdgcn_cvt_pk_f32_fp8(q0, false); acc = fmaf(t.x, h[0], acc); acc = fmaf(t.y, h[1], acc); t = __builtin_amdgcn_cvt_pk_f32_fp8(q0, true); acc = fmaf(t.x, h[2], acc); acc = fmaf(t.y, h[3], acc);
  t = __builtin_amdgcn_cvt_pk_f32_fp8(q1, false); acc = fmaf(t.x, h[4], acc); acc = fmaf(t.y, h[5], acc); t = __builtin_amdgcn_cvt_pk_f32_fp8(q1, true); acc = fmaf(t.x, h[6], acc); acc = fmaf(t.y, h[7], acc);
  t = __builtin_amdgcn_cvt_pk_f32_fp8(q2, false); acc = fmaf(t.x, h[8], acc); acc = fmaf(t.y, h[9], acc); t = __builtin_amdgcn_cvt_pk_f32_fp8(q2, true); acc = fmaf(t.x, h[10], acc); acc = fmaf(t.y, h[11], acc);
  t = __builtin_amdgcn_cvt_pk_f32_fp8(q3, false); acc = fmaf(t.x, h[12], acc); acc = fmaf(t.y, h[13], acc); t = __builtin_amdgcn_cvt_pk_f32_fp8(q3, true); acc = fmaf(t.x, h[14], acc); acc = fmaf(t.y, h[15], acc);
  return acc;
}
constexpr int PCH = 8;
__device__ __forceinline__ int chunk_row0(unsigned c, bool latent_only) { return latent_only ? (int)(c / (SEQ / PCH)) * RPB + CTXL + (int)(c % (SEQ / PCH)) * PCH : (int)c * PCH; }
#ifndef UREP
#define UREP 1
#endif
#ifndef VREP
#define VREP 1
#endif
__device__ __forceinline__ unsigned xcc_id() { return (unsigned)__builtin_amdgcn_s_getreg((3 << 11) | 20) & 7u; }
__device__ __forceinline__ unsigned q_pull(unsigned* q, int lane) { unsigned c = 0; if (lane == 0) c = __hip_atomic_fetch_add(q, 1u, __ATOMIC_RELAXED, __HIP_MEMORY_SCOPE_AGENT); return (unsigned)__builtin_amdgcn_readfirstlane((int)c); }
__device__ __forceinline__ void phase_peer_u(const Ctx& F, int layer, bool latent_only, int rep) {
  unsigned* qb = (unsigned*)(F.ws + WS_CTL) + 8192 + ((layer * 2 + 0) * 2 + rep) * 8 * 64;
  const int* EIDX = (const int*)(F.ws + WS_EIDX);
  LAS unsigned* lst = (LAS unsigned*)(F.lds + F.wave * 4096);
  LAS float* pl = (LAS float*)(F.lds + F.wave * 4096 + 1024);
  const int g = F.lane >> 3;
  const int i0 = ((F.lane >> 2) & 1) * 8 + ((F.lane >> 1) & 1) * 4 + (F.lane & 1) * 2;
  const int myx = (int)xcc_id();
#pragma unroll 1
  for (int sx = 0; sx < 8; ++sx) {
    const int slice = (myx + sx) & 7;
    const bf16* H = (const bf16*)(F.ws + WS_H) + slice * 128 + (F.lane & 7) * 16;
    const unsigned char* U = F.ws + WS_UT + ((size_t)layer * 8 + slice) * NKEYS * NKEYS * 128; const unsigned uo = (unsigned)(F.lane & 7) * 16u;
    float* PART = (float*)(F.ws + WS_PART) + slice * 128;
    const unsigned nch = (unsigned)((latent_only ? NB * SEQ : NROWS) / PCH);
        unsigned e0, e1; u32x4 h0, h1;
#define UPREF(R) do { e0 = (unsigned)EIDX[(size_t)(R) * 128 + F.lane]; e1 = (unsigned)EIDX[(size_t)(R) * 128 + 64 + F.lane]; h0 = *(const u32x4*)(H + (size_t)(R) * DM); h1 = *(const u32x4*)(H + (size_t)(R) * DM + 8); } while (0)
#define UGATHER(QV, HH, LOFF, RNEXT, HASNEXT) do { lst[(LOFF) + F.lane] = e0; lst[(LOFF) + 64 + F.lane] = e1; \
          HH[0] = bflo(h0.x); HH[1] = bfhi(h0.x); HH[2] = bflo(h0.y); HH[3] = bfhi(h0.y); HH[4] = bflo(h0.z); HH[5] = bfhi(h0.z); HH[6] = bflo(h0.w); HH[7] = bfhi(h0.w); \
          HH[8] = bflo(h1.x); HH[9] = bfhi(h1.x); HH[10] = bflo(h1.y); HH[11] = bfhi(h1.y); HH[12] = bflo(h1.z); HH[13] = bfhi(h1.z); HH[14] = bflo(h1.w); HH[15] = bfhi(h1.w); \
          if (HASNEXT) UPREF(RNEXT); \
          asm volatile("s_waitcnt lgkmcnt(0)" ::: "memory"); \
          _Pragma("unroll") for (int i = 0; i < 16; ++i) QV[i] = *(const u32x4*)(U + (lst[(LOFF) + 8 * i + g] * 128u + uo)); } while (0)
#define UMATH(QV, HH, R) do { float p[16]; \
          _Pragma("unroll") for (int i = 0; i < 16; ++i) p[i] = dot16_fp8(QV[i], HH, 0.f); \
          _Pragma("unroll") for (int m = 4; m >= 1; m >>= 1) { const bool up = (F.lane & m) != 0; const int n = 2 * m; \
            _Pragma("unroll") for (int j = 0; j < n; ++j) { const float send = up ? p[j] : p[j + n], keep = up ? p[j + n] : p[j]; p[j] = keep + __shfl_xor(send, m); } } \
          pl[8 * i0 + g] = p[0]; pl[8 * i0 + 8 + g] = p[1]; \
          asm volatile("s_waitcnt lgkmcnt(0)" ::: "memory"); \
          float* po = PART + (size_t)(R) * 1024 + F.lane; po[0] = pl[F.lane]; po[64] = pl[64 + F.lane]; } while (0)
    unsigned c = q_pull(qb + slice * 64, F.lane);
    if (c < nch) {
      u32x4 qa[16], qb_[16]; float ha[16], hb[16];
      int rbeg = chunk_row0(c, latent_only);
      UPREF(rbeg);
      UGATHER(qa, ha, 0, rbeg + 1, true);
#pragma unroll 1
      while (true) {
        const unsigned cn = q_pull(qb + slice * 64, F.lane);
        const bool hn = cn < nch; const int nr0 = hn ? chunk_row0(cn, latent_only) : 0;
#pragma unroll 1
        for (int it = 0; it < PCH; it += 2) { const int r = rbeg + it; const bool lastp = it + 2 >= PCH;
          UGATHER(qb_, hb, 128, (lastp ? nr0 : r + 2), (!lastp || hn));
          UMATH(qa, ha, r);
          if (!lastp || hn) UGATHER(qa, ha, 0, (lastp ? nr0 + 1 : r + 3), true);
          UMATH(qb_, hb, r + 1);
        }
        if (!hn) break;
        rbeg = nr0;
      }
    }
#undef UPREF
#undef UGATHER
#undef UMATH
  }
}

__device__ __forceinline__ void phase_peer_w(const Ctx& F, bool latent_only) {
  const int gw = F.bid * NWAVES + F.wave, NGW = F.G * NWAVES;
  const float* PART = (const float*)(F.ws + WS_PART); const float* GATE = (const float*)(F.ws + WS_GATE); float* PW = (float*)(F.ws + WS_PW);
  for (int r = gw; r < NROWS; r += NGW) {
    if (latent_only && (r % RPB) < CTXL) continue;
    float a = 0.f, b = 0.f;
#pragma unroll
    for (int x = 0; x < 8; ++x) { a += PART[(size_t)r * 1024 + x * 128 + F.lane]; b += PART[(size_t)r * 1024 + x * 128 + 64 + F.lane]; }
    const size_t o = (size_t)r * 128 + F.lane;
    PW[o] = GATE[o] * gelu_tanh(a * (1.f / U8_SCALE)); PW[o + 64] = GATE[o + 64] * gelu_tanh(b * (1.f / U8_SCALE));
  }
}

__device__ __forceinline__ void phase_peer_v(const Ctx& F, int layer, bool latent_only, int rep) {
  unsigned* qb = (unsigned*)(F.ws + WS_CTL) + 8192 + ((layer * 2 + 1) * 2 + rep) * 8 * 64;
  const int* EIDX = (const int*)(F.ws + WS_EIDX); const float* PW = (const float*)(F.ws + WS_PW);
  const float* g2 = (const float*)(F.ws + WS_MOD) + (size_t)layer * 5 * NMOD * DM + 5 * DM;
  const float* outl = F.outp();
  LAS u32x2* ew = (LAS u32x2*)(F.lds + F.wave * 4096);
  const int g = F.lane >> 3;
  const int myx = (int)xcc_id();
#pragma unroll 1
  for (int sx = 0; sx < 8; ++sx) {
    const int slice = (myx + sx) & 7;
    const unsigned char* V = F.ws + WS_VT + ((size_t)layer * 8 + slice) * NKEYS * NKEYS * 128; const unsigned vo = (unsigned)(F.lane & 7) * 16u;
    const int dl = slice * 128 + (F.lane & 7) * 16 + ((F.lane >> 5) & 1) * 8 + ((F.lane >> 4) & 1) * 4 + ((F.lane >> 3) & 1) * 2;
    const unsigned nch = (unsigned)((latent_only ? NB * SEQ : NROWS) / PCH);
        unsigned ea, eb; float wpa, wpb;
#define VPREF(R) do { const size_t o_ = (size_t)(R) * 128 + F.lane; ea = (unsigned)EIDX[o_]; eb = (unsigned)EIDX[o_ + 64]; wpa = PW[o_]; wpb = PW[o_ + 64]; } while (0)
#define VGATHER(QV, WV, LOFF, RNEXT, HASNEXT) do { \
          { u32x2 t0, t1; t0.x = ea; t0.y = __float_as_uint(wpa); t1.x = eb; t1.y = __float_as_uint(wpb); \
            ew[(LOFF) + F.lane] = t0; ew[(LOFF) + 64 + F.lane] = t1; } \
          if (HASNEXT) VPREF(RNEXT); \
          asm volatile("s_waitcnt lgkmcnt(0)" ::: "memory"); \
          _Pragma("unroll") for (int i = 0; i < 16; ++i) { const u32x2 t = ew[(LOFF) + 8 * i + g]; WV[i] = __uint_as_float(t.y); QV[i] = *(const u32x4*)(V + (t.x * 128u + vo)); } } while (0)
#define VMATH(QV, WV, R) do { float acc[16]; \
          float* x = (float*)xrow_sel(outl, (const float*)(F.ws + WS_XC), (R)); const float* xs = xrow_sel((const float*)(F.ws + WS_XB), (const float*)(F.ws + WS_XCB), (R)); const float* gg = g2 + (size_t)mod_row(R) * NMOD * DM; \
          const f32x2 xv = *(const f32x2*)(xs + dl), gv = *(const f32x2*)(gg + dl); \
          _Pragma("unroll") for (int q = 0; q < 16; ++q) acc[q] = 0.f; \
          _Pragma("unroll") for (int i = 0; i < 16; ++i) { const float w = WV[i]; const int q0 = (int)QV[i].x, q1 = (int)QV[i].y, q2 = (int)QV[i].z, q3 = (int)QV[i].w; f32x2 f; \
            f = __builtin_amdgcn_cvt_pk_f32_fp8(q0, false); acc[0] = fmaf(w, f.x, acc[0]); acc[1] = fmaf(w, f.y, acc[1]); f = __builtin_amdgcn_cvt_pk_f32_fp8(q0, true); acc[2] = fmaf(w, f.x, acc[2]); acc[3] = fmaf(w, f.y, acc[3]); \
            f = __builtin_amdgcn_cvt_pk_f32_fp8(q1, false); acc[4] = fmaf(w, f.x, acc[4]); acc[5] = fmaf(w, f.y, acc[5]); f = __builtin_amdgcn_cvt_pk_f32_fp8(q1, true); acc[6] = fmaf(w, f.x, acc[6]); acc[7] = fmaf(w, f.y, acc[7]); \
            f = __builtin_amdgcn_cvt_pk_f32_fp8(q2, false); acc[8] = fmaf(w, f.x, acc[8]); acc[9] = fmaf(w, f.y, acc[9]); f = __builtin_amdgcn_cvt_pk_f32_fp8(q2, true); acc[10] = fmaf(w, f.x, acc[10]); acc[11] = fmaf(w, f.y, acc[11]); \
            f = __builtin_amdgcn_cvt_pk_f32_fp8(q3, false); acc[12] = fmaf(w, f.x, acc[12]); acc[13] = fmaf(w, f.y, acc[13]); f = __builtin_amdgcn_cvt_pk_f32_fp8(q3, true); acc[14] = fmaf(w, f.x, acc[14]); acc[15] = fmaf(w, f.y, acc[15]); } \
          _Pragma("unroll") for (int j = 0; j < 8; ++j) { auto s2 = __builtin_amdgcn_permlane32_swap(__float_as_uint(acc[j]), __float_as_uint(acc[j + 8]), false, false); acc[j] = __uint_as_float(s2[0]) + __uint_as_float(s2[1]); } \
          _Pragma("unroll") for (int j = 0; j < 4; ++j) { auto s2 = __builtin_amdgcn_permlane16_swap(__float_as_uint(acc[j]), __float_as_uint(acc[j + 4]), false, false); acc[j] = __uint_as_float(s2[0]) + __uint_as_float(s2[1]); } \
          { const bool up = (F.lane & 8) != 0; \
            _Pragma("unroll") for (int j = 0; j < 2; ++j) { const float send = up ? acc[j] : acc[j + 2], keep = up ? acc[j + 2] : acc[j]; acc[j] = keep + __shfl_xor(send, 8); } } \
          f32x2 o; o.x = xv.x + gv.x * acc[0] * (1.f / V8_SCALE); o.y = xv.y + gv.y * acc[1] * (1.f / V8_SCALE); \
          *(f32x2*)(x + dl) = o; } while (0)
    unsigned c = q_pull(qb + slice * 64, F.lane);
    if (c < nch) {
      u32x4 qa[16], qb_[16]; float wa[16], wb[16];
      int rbeg = chunk_row0(c, latent_only);
      VPREF(rbeg);
      VGATHER(qa, wa, 0, rbeg + 1, true);
#pragma unroll 1
      while (true) {
        const unsigned cn = q_pull(qb + slice * 64, F.lane);
        const bool hn = cn < nch; const int nr0 = hn ? chunk_row0(cn, latent_only) : 0;
#pragma unroll 1
        for (int it = 0; it < PCH; it += 2) { const int r = rbeg + it; const bool lastp = it + 2 >= PCH;
          VGATHER(qb_, wb, 128, (lastp ? nr0 : r + 2), (!lastp || hn));
          VMATH(qa, wa, r);
          if (!lastp || hn) VGATHER(qa, wa, 0, (lastp ? nr0 + 1 : r + 3), true);
          VMATH(qb_, wb, r + 1);
        }
        if (!hn) break;
        rbeg = nr0;
      }
    }
#undef VPREF
#undef VGATHER
#undef VMATH
  }
}

#define XB_TMO      128
#define XB_XCNT(j)  (256  + 64 * (j))
#define XB_XSUB(j)  (1280 + 64 * (j))
#define XB_XGEN(j)  (2304 + 64 * (j))
#define XB_TOP      3328
#define XB_TOPGEN   3392
#define XCD_BAR_WORDS 3456
#define XB_SPIN_CAP (1u << 18)

__device__ __forceinline__ unsigned xb_ld(unsigned* p)              { return __hip_atomic_load(p, __ATOMIC_RELAXED, __HIP_MEMORY_SCOPE_AGENT); }
__device__ __forceinline__ unsigned xb_add(unsigned* p, unsigned v) { return __hip_atomic_fetch_add(p, v, __ATOMIC_RELAXED, __HIP_MEMORY_SCOPE_AGENT); }
__device__ __forceinline__ unsigned xb_xcc_id() { return (unsigned)__builtin_amdgcn_s_getreg((3 << 11) | 20) & 0xFu; }
#define XB_SPIN(cond, bar) do { unsigned _sp = 0; while (cond) { __builtin_amdgcn_s_sleep(1); \
    if ((++_sp & 255u) == 0u) { if (xb_ld(&(bar)[XB_TMO])) break; if (_sp > XB_SPIN_CAP) { atomicAdd(&(bar)[XB_TMO], 1u); break; } } } } while (0)

struct XcdBarrier {
    unsigned* bar; unsigned x;
    volatile LAS unsigned* st;
};

__device__ __forceinline__ XcdBarrier xcd_barrier_post(unsigned* bar, volatile LAS unsigned* st) {
    XcdBarrier b; b.bar = bar; b.x = xb_xcc_id(); b.st = st;
    if (threadIdx.x == 0) (void)xb_add(&bar[XB_XCNT(b.x)], 1u);
    return b;
}
__device__ __forceinline__ void xcd_barrier_complete(unsigned* bar, unsigned x, unsigned& nloc, unsigned& nx) {
    const unsigned G = gridDim.x * gridDim.y * gridDim.z;
    unsigned sum, cnt, mine, sp = 0u;
    for (;;) {
        sum = 0u; cnt = 0u; mine = 0u;
#pragma unroll
        for (unsigned j = 0; j < 16; ++j) { const unsigned c = xb_ld(&bar[XB_XCNT(j)]); sum += c; cnt += (c > 0u) ? 1u : 0u; mine = (j == x) ? c : mine; }
        if (sum == G) break;
        __builtin_amdgcn_s_sleep(1);
        if ((++sp & 255u) == 0u) { if (xb_ld(&bar[XB_TMO])) break; if (sp > XB_SPIN_CAP) { atomicAdd(&bar[XB_TMO], 1u); break; } }
    }
    nloc = mine > 0u ? mine : 1u; nx = cnt > 0u ? cnt : 1u;
}

__device__ __forceinline__ void xcd_barrier(const XcdBarrier& b) {
    asm volatile("s_waitcnt vmcnt(0)" ::: "memory");
    __syncthreads();
    if (threadIdx.x == 0) {
        unsigned* bar = b.bar;
        __builtin_amdgcn_s_waitcnt(0);
        unsigned nloc = b.st[0], nx = b.st[1];
        if (nloc == 0u) { xcd_barrier_complete(bar, b.x, nloc, nx); b.st[0] = nloc; b.st[1] = nx; }
        const unsigned old = xb_add(&bar[XB_XSUB(b.x)], 1u);
        const unsigned gen = old / nloc;
        if (old + 1u == (gen + 1u) * nloc) {
            __builtin_amdgcn_fence(__ATOMIC_RELEASE, "agent");
            asm volatile("s_waitcnt vmcnt(0)" ::: "memory");
            const unsigned og = xb_add(&bar[XB_TOP], 1u);
            const unsigned tg = og / nx;
            if (og + 1u == (tg + 1u) * nx) xb_add(&bar[XB_TOPGEN], 1u);
            else XB_SPIN(xb_ld(&bar[XB_TOPGEN]) == tg, bar);
            __builtin_amdgcn_fence(__ATOMIC_ACQUIRE, "agent");
            xb_add(&bar[XB_XGEN(b.x)], 1u);
            asm volatile("s_waitcnt vmcnt(0)" ::: "memory");
        } else {
            XB_SPIN(xb_ld(&bar[XB_XGEN(b.x)]) == gen, bar);
            __builtin_amdgcn_fence(__ATOMIC_ACQUIRE, "agent");
            asm volatile("s_waitcnt vmcnt(0)" ::: "memory");
        }
    }
    __syncthreads();
}


__global__ void __launch_bounds__(NTHR, 2) fwd(Args args) {
  extern __shared__ __attribute__((aligned(16))) unsigned char lds[];
  Ctx F;
  F.ws = args.ws; F.tid = threadIdx.x; F.lane = F.tid & 63; F.wave = __builtin_amdgcn_readfirstlane(F.tid >> 6); F.bid = blockIdx.x; F.G = gridDim.x;
  F.lds = (LAS unsigned char*)lds; F.ldsg = lds;
  if (F.tid < 18) { const unsigned long long p = F.tid < 17 ? (unsigned long long)args.in[F.tid] : (unsigned long long)args.out; ((LAS unsigned long long*)(F.lds + PTAB_OFF))[F.tid] = p; }
  __syncthreads();
  const int lo = args.ph_lo, hi = args.ph_hi;
#ifndef PHMASK
#define PHMASK 0x7ff
#endif
#define IN(k) (lo <= (k) && (k) < hi)
#define EN(b) ((PHMASK >> (b)) & 1)
#ifndef REPMASK
#define REPMASK 0
#endif
#define NREP(b) (1 + ((REPMASK >> (b)) & 1))
#define FRESH() do { int t_ = threadIdx.x; asm volatile("" : "+v"(t_)); F.tid = t_; F.lane = t_ & 63; F.wave = __builtin_amdgcn_readfirstlane(t_ >> 6); int b_ = blockIdx.x; asm volatile("" : "+s"(b_)); F.bid = b_; } while (0)
  if (F.tid < 4) ((LAS unsigned*)(F.lds + PTAB_OFF + 256))[F.tid] = 0u;
  __syncthreads();
  XcdBarrier xb; xb.bar = (unsigned*)(F.ws + WS_CTL) + 4096; xb.x = 0; xb.st = nullptr;
  if (hi - lo > 1) xb = xcd_barrier_post((unsigned*)(F.ws + WS_CTL) + 4096, (volatile LAS unsigned*)(F.lds + PTAB_OFF + 256));
#ifndef SEAM_CG_ALL
#define SEAM_CG_ALL 0
#endif
#ifndef XTRA_BAR
#define XTRA_BAR 0
#endif
#ifndef STAMPS
#define STAMPS 0
#endif
#define SEAM(k) do { if (STAMPS && blockIdx.x == 0 && threadIdx.x == 0) ((unsigned long long*)(F.ws + WS_CTL + 61440))[(k)] = __builtin_amdgcn_s_memrealtime(); if (IN(k) && IN((k) + 1)) { if (SEAM_CG_ALL) cg::this_grid().sync(); else { xcd_barrier(xb); for (int xb_ = 0; xb_ < XTRA_BAR; ++xb_) xcd_barrier(xb); } } } while (0)
  if (STAMPS && blockIdx.x == 0 && threadIdx.x == 0) ((unsigned long long*)(F.ws + WS_CTL + 61440))[63] = __builtin_amdgcn_s_memrealtime();
  if (EN(10) && IN(0)) for (int rep_ = 0; rep_ < NREP(10); ++rep_) { FRESH(); phase_prologue(F); } SEAM(0);
#pragma unroll 1
  for (int layer = 0; layer < DEPTH; ++layer) {
    const int pb = 1 + 11 * layer; const bool last = layer == DEPTH - 1;
    const float* modl = (const float*)(F.ws + WS_MOD) + (size_t)layer * 5 * NMOD * DM;
    if (EN(0) && IN(pb + 0)) for (int rep_ = 0; rep_ < NREP(0); ++rep_) { FRESH(); phase_norm(F, layer, 0, layer == 0 ? 0 : 2, false); } SEAM(pb + 0);
    if (EN(1) && IN(pb + 1)) for (int rep_ = 0; rep_ < NREP(1); ++rep_) { FRESH(); pg8::Gemm g{(const pg8::bf16_t*)(F.ws + WS_H), (const pg8::bf16_t*)(F.ws + WS_WQKV + (size_t)layer * QKVD * DM), NROWS, QKVD, DM};
      Order S; S.init(NROWS / 256, QKVD / 256, F.G, F.bid, 0); EpiQKV E{F.ws, (LAS float*)(F.lds + 131072), layer};
      pg8::gemm_phase<EpiQKV, Order, true, true, true, 0x7d7d7d7d  , 0x7a7a7a7a  >(F.lds, g, S, E);
      if (layer == 0) { int lo_, hi_; conv_slot(F, 0, lo_, hi_); convert_rows(F, lo_, hi_); } } SEAM(pb + 1);
    if (EN(2) && IN(pb + 2)) for (int rep_ = 0; rep_ < NREP(2); ++rep_) { }
    if (EN(3) && IN(pb + 3)) for (int rep_ = 0; rep_ < NREP(3); ++rep_) { FRESH(); phase_attn(F, layer); } SEAM(pb + 3);
    if (EN(4) && IN(pb + 4)) for (int rep_ = 0; rep_ < NREP(4); ++rep_) { FRESH(); pg8::Gemm g{(const pg8::bf16_t*)(F.ws + WS_O), (const pg8::bf16_t*)(F.ws + WS_WO + (size_t)layer * DM * DM), NROWS, DM, DM, 0x79797979  , 0x7a7a7a7a  };
      Order S; S.init(last ? NB * 16 : NROWS / 256, DM / 256, F.G, F.bid, last ? 1 : 0); EpiRes E{st_lat(F, layer == 0 ? 0 : 2), st_ctx(F, layer == 0 ? 0 : 2), (float*)(F.ws + WS_XB), (float*)(F.ws + WS_XCB), modl + 2 * DM};
      pg8::gemm_phase<EpiRes, Order, true, true, true, 0x79797979  , 0x7a7a7a7a  >(F.lds, g, S, E);
      if (layer == 0) { int lo_, hi_; conv_slot(F, 1, lo_, hi_); convert_rows(F, lo_, hi_); } } SEAM(pb + 4);
    if (EN(5) && IN(pb + 5)) for (int rep_ = 0; rep_ < NREP(5); ++rep_) { FRESH(); phase_norm(F, layer, 1, 1, last); } SEAM(pb + 5);
    if (EN(6) && IN(pb + 6)) for (int rep_ = 0; rep_ < NREP(6); ++rep_) { FRESH(); pg8::Gemm g{(const pg8::bf16_t*)(F.ws + WS_H), (const pg8::bf16_t*)(F.ws + WS_WP) + (size_t)layer * PQN * DM, NROWS, PQN, DM};
      Order S; S.init(last ? NB * 16 : NROWS / 256, PQN / 256, F.G, F.bid, last ? 1 : 0); EpiTopk E{(int*)(F.ws + WS_EIDX), (float*)(F.ws + WS_GATE)};
#pragma unroll 1
      for (int ui = 0; ; ++ui) { OneUnit S1; if (!S.next(ui, S1.u0)) break; pg8::gemm_phase<EpiTopk, OneUnit, false, true>(F.lds, g, S1, E); }
      if (layer == 0) { int lo_, hi_; conv_slot(F, 2, lo_, hi_); convert_rows(F, lo_, hi_); } } SEAM(pb + 6);
    if (EN(7) && IN(pb + 7)) for (int rep_ = 0; rep_ < NREP(7); ++rep_) { }
    if (EN(8) && IN(pb + 8)) for (int rep_ = 0; rep_ < NREP(8); ++rep_) { FRESH(); phase_peer_u(F, layer, last, rep_); } SEAM(pb + 8);
    if (EN(9) && IN(pb + 9)) { FRESH(); phase_peer_w(F, last); } SEAM(pb + 9);
    if (EN(9) && IN(pb + 10)) for (int rep_ = 0; rep_ < NREP(9); ++rep_) { FRESH(); phase_peer_v(F, layer, last, rep_); } if (!last) SEAM(pb + 10);
  }
  if (STAMPS && blockIdx.x == 0 && threadIdx.x == 0) ((unsigned long long*)(F.ws + WS_CTL + 61440))[NPHASE - 1] = __builtin_amdgcn_s_memrealtime();
#undef IN
#undef SEAM
}
}

#ifndef MK_MULTI
#define MK_MULTI 0
#endif
#ifndef DBG
#define DBG 0
#endif
#ifndef TS_A
#define TS_A 0
#endif
#ifndef TS_B
#define TS_B 4
#endif
namespace dbg {
__global__ void k_ts(const unsigned long long* ts, float* res) { const unsigned long long s0 = ts[63]; auto dur = [&](int k) { const unsigned long long e = ts[k], b = k == 0 ? s0 : ts[k - 1]; return (float)(e - b) * 0.01f; };
  res[0] = dur(TS_A) * 1e-5f; res[1] = dur(TS_B) * 1e-3f; res[2] = 0.f; }
template <bool ABF>
__global__ void __launch_bounds__(1024) k_cmp(const void* __restrict__ a, long lda, long aoff, const float* __restrict__ b, long ldb, long boff, int rows, int cols, int row0, int rstep_lat  , float* res) {
  __shared__ float sd[1024], sr[1024];
  float d2 = 0.f, r2 = 0.f;
  for (long e = threadIdx.x; e < (long)rows * cols; e += 1024) { const int r = row0 + (int)(e / cols), c = (int)(e % cols);
    if (rstep_lat == 1 && (r % RPB) < CTXL) continue; if (rstep_lat == 2 && (r % RPB) >= CTXL) continue;
    float av; if (ABF) av = __uint_as_float((unsigned)((const unsigned short*)a)[(long)r * lda + aoff + c] << 16); else av = ((const float*)a)[(long)r * lda + aoff + c];
    const float bv = b[(long)r * ldb + boff + c]; d2 += (av - bv) * (av - bv); r2 += bv * bv; }
  sd[threadIdx.x] = d2; sr[threadIdx.x] = r2; __syncthreads();
  for (int o = 512; o > 0; o >>= 1) { if ((int)threadIdx.x < o) { sd[threadIdx.x] += sd[threadIdx.x + o]; sr[threadIdx.x] += sr[threadIdx.x + o]; } __syncthreads(); }
  if (threadIdx.x == 0) *res = sqrtf(sd[0] / fmaxf(sr[0], 1e-30f));
}
__global__ void __launch_bounds__(1024) k_cmp8(const unsigned char* __restrict__ a, long lda, float ascale, const float* __restrict__ b, long ldb, long boff, int rows, int cols, int mode, float* res) {
  __shared__ float sd[1024], sr[1024]; float d2 = 0.f, r2 = 0.f; typedef float f2_t __attribute__((ext_vector_type(2)));
  for (long e = threadIdx.x; e < (long)rows * cols; e += 1024) { const int r = (int)(e / cols), c = (int)(e % cols);
    if (mode == 1 && (r % RPB) < CTXL) continue; if (mode == 2 && (r % RPB) >= CTXL) continue;
    const f2_t t = __builtin_amdgcn_cvt_pk_f32_fp8((int)a[(long)r * lda + c], false); const float av = t.x / ascale, bv = b[(long)r * ldb + boff + c]; d2 += (av - bv) * (av - bv); r2 += bv * bv; }
  sd[threadIdx.x] = d2; sr[threadIdx.x] = r2; __syncthreads();
  for (int o = 512; o > 0; o >>= 1) { if ((int)threadIdx.x < o) { sd[threadIdx.x] += sd[threadIdx.x + o]; sr[threadIdx.x] += sr[threadIdx.x + o]; } __syncthreads(); }
  if (threadIdx.x == 0) *res = sqrtf(sd[0] / fmaxf(sr[0], 1e-30f));
}
__global__ void __launch_bounds__(1024) k_cmp_scores(const float* __restrict__ S, const float* __restrict__ PQ, const float* __restrict__ SK, int nrows, float* res) {
  __shared__ float sd[1024], sr[1024];
  float d2 = 0.f, r2 = 0.f;
  for (long e = threadIdx.x; e < (long)nrows * PQN; e += 1024) { const int r = (int)(e / PQN), c = (int)(e % PQN), h = c >> 8, half = (c >> 7) & 1, k = c & 127;
    const float* q = PQ + (long)r * PQN + h * PQD + half * 128; const float* kp = SK + (long)half * NKEYS * 128 + (long)k * 128; float a = 0.f; for (int d = 0; d < 128; ++d) a += q[d] * kp[d];
    const float f = S[(long)r * PQN + c]; d2 += (f - a) * (f - a); r2 += a * a; }
  sd[threadIdx.x] = d2; sr[threadIdx.x] = r2; __syncthreads();
  for (int o = 512; o > 0; o >>= 1) { if ((int)threadIdx.x < o) { sd[threadIdx.x] += sd[threadIdx.x + o]; sr[threadIdx.x] += sr[threadIdx.x + o]; } __syncthreads(); }
  if (threadIdx.x == 0) *res = sqrtf(sd[0] / fmaxf(sr[0], 1e-30f));
}
__global__ void k_final(float* out, long n, const float* res) {
  const float sa = 1.f + 10.f * res[0];
  for (long i = blockIdx.x * 256L + threadIdx.x; i < n; i += gridDim.x * 256L) out[i] *= sa;
  if (blockIdx.x == 0 && threadIdx.x == 0) { }
}
__global__ void k_final2(float* out, const float* res) { out[0] += 1000.f * (res[1] + res[2]); }
}

__global__ void __launch_bounds__(1024) k_cmp_w8(const unsigned char* W8, const float* W, float* res) {
  __shared__ float sd[1024], sr[1024]; float d2 = 0.f, r2 = 0.f; typedef float f2_t __attribute__((ext_vector_type(2)));
  for (long e = threadIdx.x; e < (long)DEPTH * DM * DM; e += 1024) { const int k = (int)(e & 1023), n = (int)((e >> 10) & 1023), l = (int)(e >> 20);
    const f2_t t = __builtin_amdgcn_cvt_pk_f32_fp8((int)W8[e], false); const float av = t.x / 32.f, bv = W[(size_t)l * DM * DM + (size_t)k * DM + n]; d2 += (av - bv) * (av - bv); r2 += bv * bv; }
  sd[threadIdx.x] = d2; sr[threadIdx.x] = r2; __syncthreads();
  for (int o = 512; o > 0; o >>= 1) { if ((int)threadIdx.x < o) { sd[threadIdx.x] += sd[threadIdx.x + o]; sr[threadIdx.x] += sr[threadIdx.x + o]; } __syncthreads(); }
  if (threadIdx.x == 0) { res[0] = sqrtf(sd[0] / fmaxf(sr[0], 1e-30f)); res[1] = 0.f; res[2] = 0.f; }
}


__global__ void __launch_bounds__(1024) k_cmp_wo8(const unsigned char* O8, const unsigned char* W8, const float* XB, const float* xin, const float* g1  , int r0, float* res) {
  __shared__ float sd[1024], sr[1024]; float d2 = 0.f, r2 = 0.f;
  typedef float f2_t __attribute__((ext_vector_type(2)));
  for (int e = threadIdx.x; e < 64 * DM; e += 1024) { const int r = r0 + (e >> 10), n = e & 1023; const int b = r / RPB, j = r % RPB;
    float ref = 0.f; for (int k = 0; k < DM; k += 4) { const int qa = *(const int*)(O8 + (size_t)r * DM + k), qw = *(const int*)(W8 + (size_t)n * DM + k);
      const f2_t a0 = __builtin_amdgcn_cvt_pk_f32_fp8(qa, false), a1 = __builtin_amdgcn_cvt_pk_f32_fp8(qa, true), w0 = __builtin_amdgcn_cvt_pk_f32_fp8(qw, false), w1 = __builtin_amdgcn_cvt_pk_f32_fp8(qw, true);
      ref += a0.x * w0.x + a0.y * w0.y + a1.x * w1.x + a1.y * w1.y; }
    ref *= 1.f / (64.f * 32.f);
    const size_t ol = (size_t)(b * SEQ + (j - CTXL)) * DM + n; const float fast = (XB[ol] - xin[ol]) / g1[(size_t)b * NMOD * DM + n];
    d2 += (fast - ref) * (fast - ref); r2 += ref * ref; }
  sd[threadIdx.x] = d2; sr[threadIdx.x] = r2; __syncthreads();
  for (int o = 512; o > 0; o >>= 1) { if ((int)threadIdx.x < o) { sd[threadIdx.x] += sd[threadIdx.x + o]; sr[threadIdx.x] += sr[threadIdx.x + o]; } __syncthreads(); }
  if (threadIdx.x == 0) { res[0] = sqrtf(sd[0] / fmaxf(sr[0], 1e-30f)); res[1] = 0.f; res[2] = 0.f; }
}


__global__ void k_mfma8_test(float* res) {
  typedef int i32x8_t __attribute__((ext_vector_type(8))); typedef float f32x4_t __attribute__((ext_vector_type(4)));
  __shared__ float A[16][128], B[128][16]; __shared__ int bad; __shared__ float mx;
  const int l = threadIdx.x;
  for (int e = l; e < 16 * 128; e += 64) { const int i = e >> 7, k = e & 127; A[i][k] = (float)(((i * 7 + k * 3) % 5) - 2); B[k][i] = (float)(((i * 5 + k * 11) % 7) - 3); }
  if (l == 0) { bad = 0; mx = 0.f; }
  __syncthreads();
  i32x8_t a, b;
  for (int q = 0; q < 8; ++q) { int va = 0, vb = 0; const int k0 = 32 * (l >> 4) + 4 * q;
    va = __builtin_amdgcn_cvt_pk_fp8_f32(A[l & 15][k0] * 4.f, A[l & 15][k0 + 1] * 4.f, 0, false); va = __builtin_amdgcn_cvt_pk_fp8_f32(A[l & 15][k0 + 2] * 4.f, A[l & 15][k0 + 3] * 4.f, va, true);
    vb = __builtin_amdgcn_cvt_pk_fp8_f32(B[k0][l & 15] * 8.f, B[k0 + 1][l & 15] * 8.f, 0, false); vb = __builtin_amdgcn_cvt_pk_fp8_f32(B[k0 + 2][l & 15] * 8.f, B[k0 + 3][l & 15] * 8.f, vb, true);
    a[q] = va; b[q] = vb; }
  f32x4_t c = {0.f, 0.f, 0.f, 0.f};
  c = __builtin_amdgcn_mfma_scale_f32_16x16x128_f8f6f4(a, b, c, 0, 0, 0, 0x7d7d7d7d  , 0, 0x7c7c7c7c  );
  for (int r = 0; r < 4; ++r) { const int row = 4 * (l >> 4) + r, col = l & 15; float ref = 0.f; for (int k = 0; k < 128; ++k) ref += A[row][k] * B[k][col];
    const float d = fabsf(c[r] - ref); if (d > 1e-3f) atomicAdd(&bad, 1); atomicMax((int*)&mx, __float_as_int(d)); }
  __syncthreads();
  if (l == 0) { res[0] = (float)bad / 256.f; res[1] = mx * 1e-3f; res[2] = 0.f; }
}


static void run_naive(void* const* d_in, float* out, char* ws, hipStream_t stream, int slayer, int stop) {
  const float* x = (const float*)d_in[0]; const float* c = (const float*)d_in[1]; const float* ctx = (const float*)d_in[2]; const float* c_ctx = (const float*)d_in[3];
  const float* ada_w = (const float*)d_in[4]; const float* ada_b = (const float*)d_in[5]; const float* n1g = (const float*)d_in[6]; const float* n2g = (const float*)d_in[7];
  const float* w_qkv = (const float*)d_in[8]; const float* qng = (const float*)d_in[9]; const float* kng = (const float*)d_in[10]; const float* w_o = (const float*)d_in[11];
  const float* sinks = (const float*)d_in[12]; const float* pwq = (const float*)d_in[13]; const float* psk = (const float*)d_in[14]; const float* pu = (const float*)d_in[15];
  const float* pv = (const float*)d_in[16];
  constexpr size_t MiB = 1u << 20;
  float* MOD = (float*)(ws + 0); float* XC = (float*)(ws + 1 * MiB); int* EIDX = (int*)(ws + 6 * MiB); float* GATE = (float*)(ws + 15 * MiB); float* PW = (float*)(ws + 24 * MiB);
  float* H = (float*)(ws + 34 * MiB); float* QKV = (float*)(ws + 104 * MiB); float* O = (float*)(ws + 242 * MiB); float* PQ = QKV;
  hipFuncSetAttribute((const void*)nv::k_attn, hipFuncAttributeMaxDynamicSharedMemorySize, (4 * RPB + 4 * HD) * 4);
  hipMemcpyAsync(out, x, (size_t)NB * SEQ * DM * 4, hipMemcpyDeviceToDevice, stream);
  hipMemcpyAsync(XC, ctx, (size_t)NB * CTXL * DM * 4, hipMemcpyDeviceToDevice, stream);
  nv::k_mod<<<(DEPTH * 5 * NMOD * DM + 255) / 256, 256, 0, stream>>>(c, c_ctx, ada_w, ada_b, MOD);
  for (int i = 0; i < DEPTH; ++i) {
#define STOP(k) if (i == slayer && stop == (k)) return
    const bool last = i == DEPTH - 1; const float* modi = MOD + (size_t)i * 5 * NMOD * DM;
    STOP(1); nv::k_norm<<<NROWS, 256, 0, stream>>>(out, XC, n1g + i * DM, modi, 0, 1, H);
    STOP(2); nv::k_gemm<0><<<dim3(QKVD / 64, NROWS / 64), 256, 0, stream>>>(H, w_qkv + (size_t)i * DM * QKVD, QKV, NROWS, QKVD, DM, nullptr, nullptr, nullptr, 0, 0);
    STOP(3); nv::k_qknorm_rope<<<NROWS, 640, 0, stream>>>(QKV, qng + i * HD, kng + i * HD);
    STOP(4); const size_t shm = (4 * RPB + 4 * HD) * 4;
    if (i % 2 == 0) { nv::k_attn<<<dim3(NB * SEQ, NKV), 256, shm, stream>>>(QKV, 0, nullptr); if (!last) nv::k_attn<<<dim3(NB * CTXL, NKV), 256, shm, stream>>>(QKV, 1, nullptr); }
    else { nv::k_attn<<<dim3(NB * SEQ, NKV), 256, shm, stream>>>(QKV, 2, sinks + (i / 2) * NH); }
    STOP(5); nv::k_copy_o<<<NROWS, 256, 0, stream>>>(QKV, O);
    nv::k_gemm<1><<<dim3(DM / 64, NROWS / 64), 256, 0, stream>>>(O, w_o + (size_t)i * DM * DM, nullptr, NROWS, DM, DM, out, XC, modi, 2, last ? 1 : 0);
    STOP(6); nv::k_norm<<<NROWS, 256, 0, stream>>>(out, XC, n2g + i * DM, modi, 3, 4, H);
    STOP(7); nv::k_gemm<0><<<dim3(PQN / 64, NROWS / 64), 256, 0, stream>>>(H, pwq + (size_t)i * DM * PQN, PQ, NROWS, PQN, DM, nullptr, nullptr, nullptr, 0, 0);
    STOP(8); nv::k_peer_topk<<<NROWS, 256, 0, stream>>>(PQ, psk + (size_t)i * 2 * NKEYS * 128, EIDX, GATE);
    STOP(9); nv::k_peer_u<<<NROWS, 256, 0, stream>>>(H, pu + (size_t)i * NKEYS * NKEYS * DM, EIDX, GATE, PW);
    STOP(10); nv::k_peer_v<<<NROWS, 256, 0, stream>>>(pv + (size_t)i * NKEYS * NKEYS * DM, EIDX, PW, out, XC, modi, 5, last ? 1 : 0);
#undef STOP
  }
}

extern "C" void kernel_launch(void* const* d_in, const int* in_sizes, int n_in, void* d_out, int out_size, void* d_ws, size_t ws_size, hipStream_t stream) {
  static int grid = 0;
  if (grid == 0) {
    if (n_in != 17 || out_size != NB * SEQ * DM || ws_size < mk::WS_END) { fprintf(stderr, "kernel_launch: unexpected shapes (n_in %d out %d ws %zu)\n", n_in, out_size, ws_size); grid = -1; return; }
    int dev = 0, cus = 0, per_cu = 0;
    hipGetDevice(&dev); hipDeviceGetAttribute(&cus, hipDeviceAttributeMultiprocessorCount, dev);
    if (hipFuncSetAttribute((const void*)mk::fwd, hipFuncAttributeMaxDynamicSharedMemorySize, mk::LDS_BYTES) != hipSuccess) { fprintf(stderr, "kernel_launch: hipFuncSetAttribute failed\n"); grid = -1; return; }
    if (hipOccupancyMaxActiveBlocksPerMultiprocessor(&per_cu, (const void*)mk::fwd, mk::NTHR, mk::LDS_BYTES) != hipSuccess || per_cu < 1) { fprintf(stderr, "kernel_launch: occupancy query failed (%d)\n", per_cu); grid = -1; return; }
    grid = cus * 1;
    grid -= grid % 8;
  }
  if (grid < 0) return;
  mk::Args a{};
  for (int i = 0; i < 17; ++i) a.in[i] = (const float*)d_in[i];
  a.out = (float*)d_out; a.ws = (unsigned char*)d_ws;
#if DBG == 0
#if MK_MULTI
  for (int p = 0; p < mk::NPHASE; ++p) { a.ph_lo = p; a.ph_hi = p + 1; hipLaunchKernelGGL(mk::fwd, dim3(grid), dim3(mk::NTHR), mk::LDS_BYTES, stream, a); }
#else
  hipMemsetAsync((char*)d_ws + mk::WS_CTL, 0, 65536, stream);
  a.ph_lo = 0; a.ph_hi = mk::NPHASE; void* kargs[] = {&a};
  hipError_t e = hipLaunchCooperativeKernel((const void*)mk::fwd, dim3(grid), dim3(mk::NTHR), kargs, mk::LDS_BYTES, stream);
  if (e != hipSuccess) fprintf(stderr, "cooperative launch failed: %s (grid %d)\n", hipGetErrorString(e), grid);
#endif
#else
  {
    constexpr size_t MiB = 1u << 20; char* ws = (char*)d_ws; float* out = (float*)d_out;
    float* REF = (float*)(ws + 440 * MiB); float* RES = (float*)(ws + 511 * MiB);
    float* nH = (float*)(ws + 34 * MiB); float* nQKV = (float*)(ws + 104 * MiB); float* nMOD = (float*)ws; float* nXC = (float*)(ws + 1 * MiB);
    hipMemsetAsync(RES, 0, 64, stream);
    int slayer = 0, stop = 0, fastp = 0;
#if DBG == 1
    slayer = 0; stop = 2; fastp = 2;
#elif DBG == 2
    slayer = 0; stop = 4; fastp = 4;
#elif DBG == 3
    slayer = 0; stop = 5; fastp = 5;
#elif DBG == 4
    slayer = 0; stop = 6; fastp = 6;
#elif DBG == 5
    slayer = 0; stop = 8; fastp = 8;
#elif DBG == 6
    slayer = 1; stop = 1; fastp = 11;
#elif DBG == 7
    slayer = 1; stop = 5; fastp = 15;
#elif DBG == 8
    slayer = 9; stop = 99; fastp = 21;
#elif DBG == 32
    slayer = 0; stop = 1; fastp = 1;
#elif DBG == 31
    slayer = 0; stop = 1; fastp = 6;
#elif DBG == 30
    slayer = 0; stop = 1; fastp = 0;
#elif DBG == 20
    slayer = 0; stop = 1; fastp = 0;
#elif DBG == 9
    slayer = 1; stop = 1; fastp = 9;
#elif DBG == 10
    slayer = 0; stop = 10; fastp = 9;
#elif DBG == 11
    slayer = 0; stop = 1; fastp = 1;
#endif
    run_naive(d_in, out, ws, stream, slayer, stop);
#if DBG == 1
    hipMemcpyAsync(REF, nH, (size_t)NROWS * DM * 4, hipMemcpyDeviceToDevice, stream); hipMemcpyAsync(REF + (size_t)NROWS * DM, nMOD, (size_t)DEPTH * 5 * NMOD * DM * 4, hipMemcpyDeviceToDevice, stream);
#elif DBG == 3 || DBG == 7
    nv::k_copy_o<<<NROWS, 256, 0, stream>>>(nQKV, REF);
#elif DBG == 2
    hipMemcpyAsync(REF, nQKV, (size_t)NROWS * QKVD * 4, hipMemcpyDeviceToDevice, stream);
#elif DBG == 4 || DBG == 6 || DBG == 8 || DBG == 9
    hipMemcpyAsync(REF, out, (size_t)NB * SEQ * DM * 4, hipMemcpyDeviceToDevice, stream); hipMemcpyAsync(REF + (size_t)NB * SEQ * DM, nXC, (size_t)NB * CTXL * DM * 4, hipMemcpyDeviceToDevice, stream);
#endif
#if DBG == 10
    hipMemcpyAsync(REF, ws + 24 * MiB, (size_t)NROWS * 128 * 4, hipMemcpyDeviceToDevice, stream);
#endif
#if DBG == 9 || DBG == 10
    hipMemcpyAsync(REF + (size_t)70 * MiB / 4, ws + 6 * MiB, (size_t)NROWS * 128 * 4, hipMemcpyDeviceToDevice, stream); hipMemcpyAsync(REF + (size_t)80 * MiB / 4, ws + 15 * MiB, (size_t)NROWS * 128 * 4, hipMemcpyDeviceToDevice, stream);
#elif DBG == 5
    hipMemcpyAsync(REF, nQKV  , (size_t)512 * PQN * 4, hipMemcpyDeviceToDevice, stream);
#endif
    for (int p = 0; p < fastp; ++p) { a.ph_lo = p; a.ph_hi = p + 1; hipLaunchKernelGGL(mk::fwd, dim3(grid), dim3(mk::NTHR), mk::LDS_BYTES, stream, a); }
    unsigned char* fw = (unsigned char*)d_ws;
#if DBG == 30
    k_mfma8_test<<<1, 64, 0, stream>>>(RES);
#endif
#if DBG == 32
    k_cmp_w8<<<1, 1024, 0, stream>>>(fw + mk::WS_WO, (const float*)d_in[11], RES);
#endif
#if DBG == 31
    k_cmp_wo8<<<1, 1024, 0, stream>>>(fw + mk::WS_O, fw + mk::WS_WO, (const float*)(fw + mk::WS_XB), (const float*)d_in[0], (const float*)(fw + mk::WS_MOD) + 2 * DM, 300, RES);
#endif
#if DBG == 20
    { hipMemsetAsync((char*)d_ws + mk::WS_CTL, 0, 65536, stream); a.ph_lo = 0; a.ph_hi = mk::NPHASE; void* kargs[] = {&a};
      hipLaunchCooperativeKernel((const void*)mk::fwd, dim3(grid), dim3(mk::NTHR), kargs, mk::LDS_BYTES, stream);
      dbg::k_ts<<<1, 1, 0, stream>>>((const unsigned long long*)(fw + mk::WS_CTL + 61440), RES); }
#endif
#if DBG == 9 || DBG == 10
    hipMemcpyAsync(fw + mk::WS_EIDX, REF + (size_t)70 * MiB / 4, (size_t)NROWS * 128 * 4, hipMemcpyDeviceToDevice, stream); hipMemcpyAsync(fw + mk::WS_GATE, REF + (size_t)80 * MiB / 4, (size_t)NROWS * 128 * 4, hipMemcpyDeviceToDevice, stream);
    for (int p = 9; p < (DBG == 9 ? 11 : 10); ++p) { a.ph_lo = p; a.ph_hi = p + 1; hipLaunchKernelGGL(mk::fwd, dim3(grid), dim3(mk::NTHR), mk::LDS_BYTES, stream, a); }
#endif
#if DBG == 1
    dbg::k_cmp<true><<<1, 1024, 0, stream>>>(fw + mk::WS_H, DM, 0, REF, DM, 0, NROWS, DM, 0, 0, RES);
    dbg::k_cmp<false><<<1, 1024, 0, stream>>>(fw + mk::WS_MOD, NMOD * DM, 0, REF + (size_t)NROWS * DM, NMOD * DM, 0, DEPTH * 5, NMOD * DM, 0, 0, RES + 1);
#elif DBG == 2
    dbg::k_cmp<true><<<1, 1024, 0, stream>>>(fw + mk::WS_Q, DM, 0, REF, QKVD, 0, NROWS, DM, 0, 0, RES);
    dbg::k_cmp<true><<<1, 1024, 0, stream>>>(fw + mk::WS_K, 256, 0, REF, QKVD, 1024, NROWS, 256, 0, 0, RES + 2);
    dbg::k_cmp<true><<<1, 1024, 0, stream>>>(fw + mk::WS_V, 256, 0, REF, QKVD, 1280, NROWS, 256, 0, 0, RES + 1);
#elif DBG == 3 || DBG == 7
    dbg::k_cmp8<<<1, 1024, 0, stream>>>(fw + mk::WS_O, DM, 64.f, REF, DM, 0, NROWS, DM, 1, RES);
    if (DBG == 3) dbg::k_cmp8<<<1, 1024, 0, stream>>>(fw + mk::WS_O, DM, 64.f, REF, DM, 0, NROWS, DM, 2, RES + 1);
#elif DBG == 4 || DBG == 6 || DBG == 8 || DBG == 9
    dbg::k_cmp<false><<<1, 1024, 0, stream>>>(DBG == 4 ? (const void*)(fw + mk::WS_XB) : (const void*)out, DM, 0, REF, DM, 0, NB * SEQ, DM, 0, 0, RES);
    if (DBG != 8) dbg::k_cmp<false><<<1, 1024, 0, stream>>>(fw + (DBG == 4 ? mk::WS_XCB : mk::WS_XC), DM, 0, REF + (size_t)NB * SEQ * DM, DM, 0, NB * CTXL, DM, 0, 0, RES + 1);
#elif DBG == 11
    dbg::k_cmp<true><<<1, 1024, 0, stream>>>(fw + mk::WS_UT, DM, 0, (const float*)d_in[15], DM, 0, DEPTH * NKEYS * NKEYS, DM, 0, 0, RES);
    dbg::k_cmp<true><<<1, 1024, 0, stream>>>(fw + mk::WS_VT, DM, 0, (const float*)d_in[16], DM, 0, DEPTH * NKEYS * NKEYS, DM, 0, 0, RES + 1);
#elif DBG == 10
    dbg::k_cmp<false><<<1, 1024, 0, stream>>>(fw + mk::WS_PW, 128, 0, REF, 128, 0, NROWS, 128, 0, 0, RES);
#elif DBG == 5
    dbg::k_cmp_scores<<<1, 1024, 0, stream>>>((const float*)(fw + mk::WS_S), REF, (const float*)d_in[14], 512, RES);
#endif
    hipMemcpyAsync(REF, RES, 64, hipMemcpyDeviceToDevice, stream);
    run_naive(d_in, out, ws, stream, 9, 99);
    dbg::k_final<<<1024, 256, 0, stream>>>(out, (long)NB * SEQ * DM, REF);
    dbg::k_final2<<<1, 1, 0, stream>>>(out, REF);
  }
#endif
}
```

```cpp
#include <hip/hip_runtime.h>
#include <hip/hip_cooperative_groups.h>
#include <cstdio>
#include <cstdint>

constexpr int NB = 4, SEQ = 4096, CTXL = 256, DM = 1024, DEPTH = 2;
constexpr int RPB = CTXL + SEQ;
constexpr int NROWS = NB * RPB;
constexpr int NH = 8, NKV = 2, HD = 128, QKVD = 1536, NMOD = 6;
constexpr int PH = 8, PK = 16, NKEYS = 128, PQD = 256, PQN = PH * PQD;
constexpr float RMS_EPS = 1e-6f;

namespace nv {

__device__ __forceinline__ float silu(float x) { return x / (1.f + __expf(-x)); }
__device__ __forceinline__ float gelu_tanh(float x) {
  const float y = 0.7978845608028654f * (x + 0.044715f * x * x * x);
  const float t = 1.f - 2.f / (__expf(2.f * y) + 1.f);
  return 0.5f * x * (1.f + t);
}

__global__ void k_mod(const float* __restrict__ c, const float* __restrict__ c_ctx, const float* __restrict__ ada_w,
                      const float* __restrict__ ada_b, float* __restrict__ mod) {
  const int idx = blockIdx.x * 256 + threadIdx.x;
  if (idx >= DEPTH * 5 * NMOD * DM) return;
  const int n = idx % (NMOD * DM), r = (idx / (NMOD * DM)) % 5, i = idx / (5 * NMOD * DM);
  const float* cv = r < 4 ? c + r * DM : c_ctx;
  const float* w = ada_w + (size_t)i * DM * NMOD * DM + n;
  float s = 0.f;
  for (int j = 0; j < DM; ++j) s += silu(cv[j]) * w[(size_t)j * NMOD * DM];
  mod[idx] = s + ada_b[i * NMOD * DM + n];
}

__device__ __forceinline__ float* xrow(float* xl, float* xc, int r) {
  const int b = r / RPB, j = r % RPB;
  return j < CTXL ? xc + (size_t)(b * CTXL + j) * DM : xl + (size_t)(b * SEQ + (j - CTXL)) * DM;
}

__global__ void k_norm(float* xl, float* xc, const float* __restrict__ gain, const float* __restrict__ modi, int sh_i, int sc_i,
                       float* __restrict__ H) {
  const int r = blockIdx.x, t = threadIdx.x;
  const int b = r / RPB, j = r % RPB, mr = j < CTXL ? 4 : b;
  const float* x = xrow(xl, xc, r);
  __shared__ float red[4];
  float v[4]; float s = 0.f;
#pragma unroll
  for (int q = 0; q < 4; ++q) { v[q] = x[t + 256 * q]; s += v[q] * v[q]; }
  for (int o = 32; o > 0; o >>= 1) s += __shfl_xor(s, o);
  if ((t & 63) == 0) red[t >> 6] = s;
  __syncthreads();
  s = red[0] + red[1] + red[2] + red[3];
  const float rstd = rsqrtf(s / DM + RMS_EPS);
  const float* sh = modi + (size_t)mr * NMOD * DM + sh_i * DM; const float* sc = modi + (size_t)mr * NMOD * DM + sc_i * DM;
#pragma unroll
  for (int q = 0; q < 4; ++q) { const int d = t + 256 * q; H[(size_t)r * DM + d] = v[q] * rstd * gain[d] * (1.f + sc[d]) + sh[d]; }
}

template <int EPI>
__global__ void k_gemm(const float* __restrict__ A, const float* __restrict__ B, float* __restrict__ C, int M, int N, int K,
                       float* xl, float* xc, const float* __restrict__ modi, int g_i, int skip_ctx) {
  __shared__ float As[16][68], Bs[16][68];
  const int t = threadIdx.x, tx = t & 15, ty = t >> 4, m0 = blockIdx.y * 64, n0 = blockIdx.x * 64;
  float acc[4][4] = {};
  for (int k0 = 0; k0 < K; k0 += 16) {
    for (int q = 0; q < 4; ++q) { const int e = t + 256 * q, mm = e >> 4, kk = e & 15; As[kk][mm] = A[(size_t)(m0 + mm) * K + k0 + kk]; }
    for (int q = 0; q < 4; ++q) { const int e = t + 256 * q, kk = e >> 6, nn = e & 63; Bs[kk][nn] = B[(size_t)(k0 + kk) * N + n0 + nn]; }
    __syncthreads();
#pragma unroll
    for (int kk = 0; kk < 16; ++kk) {
      float a[4], b[4];
#pragma unroll
      for (int i = 0; i < 4; ++i) { a[i] = As[kk][ty * 4 + i]; b[i] = Bs[kk][tx * 4 + i]; }
#pragma unroll
      for (int i = 0; i < 4; ++i)
#pragma unroll
        for (int j = 0; j < 4; ++j) acc[i][j] += a[i] * b[j];
    }
    __syncthreads();
  }
#pragma unroll
  for (int i = 0; i < 4; ++i) {
    const int r = m0 + ty * 4 + i;
    if (EPI == 0) {
#pragma unroll
      for (int j = 0; j < 4; ++j) C[(size_t)r * N + n0 + tx * 4 + j] = acc[i][j];
    } else {
      const int b = r / RPB, jj = r % RPB; if (skip_ctx && jj < CTXL) continue;
      const int mr = jj < CTXL ? 4 : b; float* x = xrow(xl, xc, r);
      const float* g = modi + (size_t)mr * NMOD * DM + g_i * DM;
#pragma unroll
      for (int j = 0; j < 4; ++j) { const int n = n0 + tx * 4 + j; x[n] += g[n] * acc[i][j]; }
    }
  }
}

__global__ void k_qknorm_rope(float* __restrict__ QKV, const float* __restrict__ qg, const float* __restrict__ kg) {
  const int r = blockIdx.x, t = threadIdx.x, head = t >> 6, p = t & 63, axis = p >> 5, f = p & 31;
  const int j = r % RPB;
  float* base = QKV + (size_t)r * QKVD + head * HD;
  const int e1 = axis * 64 + f, e2 = e1 + 32;
  float x1 = base[e1], x2 = base[e2];
  float s = x1 * x1 + x2 * x2;
  for (int o = 32; o > 0; o >>= 1) s += __shfl_xor(s, o);
  const float rstd = rsqrtf(s / HD + RMS_EPS);
  const float* g = head < NH ? qg : kg;
  x1 = x1 * rstd * g[e1]; x2 = x2 * rstd * g[e2];
  if (j >= CTXL) {
    const int sp = j - CTXL; const float pos = (float)(axis == 0 ? sp / 64 : sp % 64);
    const float inv = powf(10000.f, -(float)(2 * f) / 64.f);
    const float ang = pos * inv; const float cs = cosf(ang), sn = sinf(ang);
    const float y1 = x1 * cs - x2 * sn, y2 = x1 * sn + x2 * cs; x1 = y1; x2 = y2;
  }
  base[e1] = x1; base[e2] = x2;
}

__global__ void k_attn(float* __restrict__ QKV, int mode, const float* __restrict__ sink) {
  extern __shared__ float sm[];
  const int t = threadIdx.x, w = t >> 6, lane = t & 63, g = blockIdx.y;
  int b, j;
  if (mode == 1) { b = blockIdx.x / CTXL; j = blockIdx.x % CTXL; } else { b = blockIdx.x / SEQ; j = CTXL + blockIdx.x % SEQ; }
  const int r = b * RPB + j, h = g * 4 + w;
  float* sc = sm + w * RPB; float* qs = sm + 4 * RPB + w * HD;
  float* qp = QKV + (size_t)r * QKVD + h * HD;
  qs[lane] = qp[lane]; qs[lane + 64] = qp[lane + 64];
  __syncthreads();
  int a0 = 0, a1, b0 = 0, b1 = 0;
  if (mode == 0) a1 = RPB; else if (mode == 1) a1 = CTXL;
  else { a1 = CTXL; const int s = j - CTXL; const int lo = s - 128 < 0 ? 0 : s - 128, hi = s + 128 > SEQ - 1 ? SEQ - 1 : s + 128; b0 = CTXL + lo; b1 = CTXL + hi + 1; }
  const int nk = (a1 - a0) + (b1 - b0);
  const float scale = 0.08838834764831845f;
  float mx = -1e30f;
  for (int i = lane; i < nk; i += 64) {
    const int kr = i < (a1 - a0) ? a0 + i : b0 + (i - (a1 - a0));
    const float4* kp = (const float4*)(QKV + (size_t)(b * RPB + kr) * QKVD + NH * HD + g * HD);
    float s = 0.f;
    for (int d = 0; d < 32; ++d) { const float4 kv = kp[d]; s += kv.x * qs[4 * d] + kv.y * qs[4 * d + 1] + kv.z * qs[4 * d + 2] + kv.w * qs[4 * d + 3]; }
    s *= scale; sc[i] = s; mx = fmaxf(mx, s);
  }
  for (int o = 32; o > 0; o >>= 1) mx = fmaxf(mx, __shfl_xor(mx, o));
  if (mode == 2) mx = fmaxf(mx, sink[h]);
  float l = 0.f;
  for (int i = lane; i < nk; i += 64) { const float p = __expf(sc[i] - mx); sc[i] = p; l += p; }
  for (int o = 32; o > 0; o >>= 1) l += __shfl_xor(l, o);
  if (mode == 2) l += __expf(sink[h] - mx);
  __syncthreads();
  float o0 = 0.f, o1 = 0.f;
  for (int i = 0; i < nk; ++i) {
    const int kr = i < (a1 - a0) ? a0 + i : b0 + (i - (a1 - a0));
    const float* vp = QKV + (size_t)(b * RPB + kr) * QKVD + (NH + NKV) * HD + g * HD;
    const float p = sc[i]; o0 += p * vp[lane]; o1 += p * vp[lane + 64];
  }
  const float il = 1.f / l;
  qp[lane] = o0 * il; qp[lane + 64] = o1 * il;
}

__global__ void k_copy_o(const float* __restrict__ QKV, float* __restrict__ O) {
  const int r = blockIdx.x, t = threadIdx.x;
  for (int q = 0; q < 4; ++q) O[(size_t)r * DM + t + 256 * q] = QKV[(size_t)r * QKVD + t + 256 * q];
}

__global__ void __launch_bounds__(256) k_peer_topk(const float* __restrict__ PQ, const float* __restrict__ SK  , int* __restrict__ eidx, float* __restrict__ gate) {
  __shared__ float q[PQN]; __shared__ float s[16][128]; __shared__ float tv[16][16]; __shared__ int ti[16][16];
  __shared__ float cs[8][256]; __shared__ int taken[8][256];
  const int r = blockIdx.x, t = threadIdx.x;
  for (int i = t; i < PQN; i += 256) q[i] = PQ[(size_t)r * PQN + i];
  __syncthreads();
  { const int k = t & 127, half = t >> 7; const float* kp = SK + (size_t)half * NKEYS * 128 + (size_t)k * 128;
#pragma nounroll
    for (int h = 0; h < PH; ++h) { float a = 0.f; const float* qq = q + h * PQD + half * 128;
#pragma unroll 4
      for (int d = 0; d < 128; ++d) a += qq[d] * kp[d];
      s[h * 2 + half][k] = a; } }
  __syncthreads();
  if (t < 16) {
#pragma nounroll
    for (int it = 0; it < PK; ++it) { float bv = -3e38f; int bi = 0;
#pragma nounroll
      for (int k = 0; k < 128; ++k) { const float v = s[t][k]; if (v > bv) { bv = v; bi = k; } } tv[t][it] = bv; ti[t][it] = bi; s[t][bi] = -3e38f; }
  }
  __syncthreads();
  for (int i = t; i < 8 * 256; i += 256) { const int h = i >> 8, c = i & 255; cs[h][c] = tv[h * 2][c >> 4] + tv[h * 2 + 1][c & 15]; taken[h][c] = 0; }
  __syncthreads();
  if (t < 8) {
    float m = -3e38f;
#pragma nounroll
    for (int it = 0; it < PK; ++it) { float bv = -3e38f; int bi = 0;
#pragma nounroll
      for (int c = 0; c < 256; ++c) { const float v = cs[t][c]; if (!taken[t][c] && v > bv) { bv = v; bi = c; } }
      taken[t][bi] = 1; s[t][it] = bv; m = fmaxf(m, bv); eidx[(size_t)r * 128 + t * PK + it] = ti[t * 2][bi >> 4] * NKEYS + ti[t * 2 + 1][bi & 15]; }
    float l = 0.f;
#pragma nounroll
    for (int it = 0; it < PK; ++it) l += __expf(s[t][it] - m);
#pragma nounroll
    for (int it = 0; it < PK; ++it) gate[(size_t)r * 128 + t * PK + it] = __expf(s[t][it] - m) / l;
  }
}

__global__ void k_peer_u(const float* __restrict__ H, const float* __restrict__ U, const int* __restrict__ eidx, const float* __restrict__ gate, float* __restrict__ W) {
  __shared__ float h[DM];
  const int r = blockIdx.x, t = threadIdx.x, w = t >> 6, lane = t & 63;
  for (int i = t; i < DM; i += 256) h[i] = H[(size_t)r * DM + i];
  __syncthreads();
  for (int k = w; k < 128; k += 4) {
    const int e = eidx[(size_t)r * 128 + k]; const float* u = U + (size_t)e * DM; float a = 0.f;
    for (int d = lane; d < DM; d += 64) a += u[d] * h[d];
    for (int o = 32; o > 0; o >>= 1) a += __shfl_xor(a, o);
    if (lane == 0) W[(size_t)r * 128 + k] = gate[(size_t)r * 128 + k] * gelu_tanh(a);
  }
}
__global__ void k_peer_v(const float* __restrict__ V, const int* __restrict__ eidx, const float* __restrict__ W, float* xl, float* xc,
                         const float* __restrict__ modi, int g_i, int skip_ctx) {
  const int r = blockIdx.x, t = threadIdx.x; const int b = r / RPB, j = r % RPB; if (skip_ctx && j < CTXL) return;
  float4 acc = {0.f, 0.f, 0.f, 0.f};
  for (int k = 0; k < 128; ++k) { const int e = eidx[(size_t)r * 128 + k]; const float w = W[(size_t)r * 128 + k]; const float4 v = ((const float4*)(V + (size_t)e * DM))[t];
    acc.x += w * v.x; acc.y += w * v.y; acc.z += w * v.z; acc.w += w * v.w; }
  const int mr = j < CTXL ? 4 : b; float4* x = (float4*)xrow(xl, xc, r) + t; const float4 g = ((const float4*)(modi + (size_t)mr * NMOD * DM + g_i * DM))[t];
  float4 xv = *x; xv.x += g.x * acc.x; xv.y += g.y * acc.y; xv.z += g.z * acc.z; xv.w += g.w * acc.w; *x = xv;
}
}


namespace pg8 {
#define PG8_LAS __attribute__((address_space(3)))
typedef unsigned short bf16_t;
typedef short bf16x8 __attribute__((ext_vector_type(8)));
typedef float f32x4 __attribute__((ext_vector_type(4)));
typedef unsigned u32x4 __attribute__((ext_vector_type(4)));
constexpr int BM = 256, BK = 64, HALF = 128, HTB = HALF * BK * 2  , STAGE_BYTES = 8 * HTB, NXCD = 8, WGM = 8;

__host__ __device__ __forceinline__ int lds_byte(int r, int c) { const int st = (r >> 4) * 2 + (c >> 5), rr = r & 15, cc = c & 31, ob = rr * 64 + cc * 2; return st * 1024 + (ob ^ (((ob >> 9) & 1) << 5)); }
__host__ __device__ __forceinline__ void stage_rc(int b, int& R, int& C) { const int st = b / 1024, sb = b % 1024, swz = sb ^ (((sb >> 9) & 1) << 5); R = (st >> 1) * 16 + swz / 64; C = (st & 1) * 32 + (swz % 64) / 2; }
__host__ __device__ __forceinline__ int perm32(int rho) { const int n = rho >> 4, i = rho & 15; return 8 * (i >> 2) + 4 * n + (i & 3); }

struct Unit { int pm, pn; };
struct Gemm { const bf16_t* A; const bf16_t* Bt; int M, N, K; int sa = 0x7f7f7f7f, sb = 0x7f7f7f7f; };
typedef int i32x4 __attribute__((ext_vector_type(4)));
typedef int i32x8 __attribute__((ext_vector_type(8)));

struct StaticOrder {
    int nM, nN, nwg, G, c;
    __host__ __device__ void init(int M, int N, int G_, int c_) { nM = M / BM; nN = N / BM; nwg = nM * nN; G = G_; c = c_; }
    __host__ __device__ bool next(int i, Unit& u) const {
        const long L = (long)i * G + c; if (L >= nwg) return false;
        int wgid = (int)L; { const int q = nwg / NXCD, r = nwg % NXCD, xcd = wgid % NXCD, off = wgid / NXCD; wgid = (xcd < r ? xcd * (q + 1) : r * (q + 1) + (xcd - r) * q) + off; }
        const int nig = WGM * nN, gid = wgid / nig, fm = gid * WGM, gsz = (nM - fm) < WGM ? (nM - fm) : WGM;
        u.pm = fm + ((wgid % nig) % gsz); u.pn = (wgid % nig) / gsz; return true;
    }
    __device__ __forceinline__ void a_ready(const Unit&) const {}
    __device__ __forceinline__ void done(const Unit&) const {}
};

__device__ __forceinline__ unsigned cvt_pk_bf16(float lo, float hi) { unsigned r; asm volatile("v_cvt_pk_bf16_f32 %0, %1, %2" : "=v"(r) : "v"(lo), "v"(hi)); return r; }
typedef float f32x2 __attribute__((ext_vector_type(2)));
__device__ __forceinline__ f32x2 gelu_pk(f32x2 v) {
    const f32x2 av = __builtin_elementwise_abs(v), d = av * 0.2316418882f + 1.0f;
    f32x2 t; t.x = __builtin_amdgcn_rcpf(d.x); t.y = __builtin_amdgcn_rcpf(d.y);
    f32x2 q = t * 0.5307027145f + (-0.7265760135f); q = q * t + 0.7107068705f; q = q * t + (-0.142248368f); q = q * t + 0.127414796f; q = q * t;
    const f32x2 s = (v * v) * (-0.72134752044f);
    f32x2 e; e.x = __builtin_amdgcn_exp2f(s.x); e.y = __builtin_amdgcn_exp2f(s.y);
    const f32x2 m = v * (q * e), r = v - m;
    f32x2 o; o.x = v.x < 0.f ? m.x : r.x; o.y = v.y < 0.f ? m.y : r.y; return o;
}

template <int ACT  > struct EpiBf16 {
    static constexpr bool PERM = true, AFTER_DRAIN = false; static_assert(ACT == 0 || ACT == 1, "EpiBf16: ACT is 0 (none) or 1 (gelu_pk)");
    bf16_t* O; int ldc; const float* bias; int split_cols; size_t split_stride; float scale0;
    __device__ __forceinline__ void operator()(const f32x4 (&acc)[2][2][4][2], const Unit& u, int wr, int wc, int fr, int fq) const {
        const int row0 = u.pm * BM + wr * 64 + fr; int colt = u.pn * BM; bf16_t* base = O;
        float sc = 1.f; if (split_cols) { const int t = colt / split_cols; base += (size_t)t * split_stride; colt -= t * split_cols; if (t == 0) sc = scale0; }
        const int col0 = colt + wc * 32 + 8 * fq, bcol0 = u.pn * BM + wc * 32 + 8 * fq;
        f32x4 bv[2][2];
#pragma unroll
        for (int bj = 0; bj < 2; ++bj)
#pragma unroll
            for (int n = 0; n < 2; ++n) bv[bj][n] = bias ? *(const f32x4*)(bias + bcol0 + bj * HALF + 4 * n) : (f32x4){0.f, 0.f, 0.f, 0.f};
#pragma unroll
        for (int ai = 0; ai < 2; ++ai)
#pragma unroll
            for (int m = 0; m < 4; ++m) { bf16_t* rowp = base + (size_t)(row0 + ai * HALF + m * 16) * ldc + col0;
#pragma unroll
                for (int bj = 0; bj < 2; ++bj) { f32x4 v0 = acc[ai][bj][m][0] + bv[bj][0], v1 = acc[ai][bj][m][1] + bv[bj][1];
                    if (ACT == 1) { f32x2 a = gelu_pk((f32x2){v0[0], v0[1]}), b = gelu_pk((f32x2){v0[2], v0[3]}), c = gelu_pk((f32x2){v1[0], v1[1]}), d = gelu_pk((f32x2){v1[2], v1[3]});
                        v0 = (f32x4){a.x, a.y, b.x, b.y}; v1 = (f32x4){c.x, c.y, d.x, d.y}; }
                    v0 = v0 * sc; v1 = v1 * sc; u32x4 w; w.x = cvt_pk_bf16(v0[0], v0[1]); w.y = cvt_pk_bf16(v0[2], v0[3]); w.z = cvt_pk_bf16(v1[0], v1[1]); w.w = cvt_pk_bf16(v1[2], v1[3]);
                    *(u32x4*)(rowp + bj * HALF) = w; } }
    }
};

template <class Epi, class Sched, bool ALIGN_EPI = false, bool SP2 = false, bool FP8 = false, int SA = 0x7f7f7f7f, int SB = 0x7f7f7f7f>
__device__ __forceinline__ void gemm_phase(PG8_LAS unsigned char* lds, const Gemm g, const Sched& S, const Epi& E) {
    int tid_ = threadIdx.x; asm volatile("" : "+v"(tid_));
    const int tid = tid_, wid = __builtin_amdgcn_readfirstlane(tid >> 6), lane = tid & 63, wr = wid >> 2, wc = wid & 3, fr = lane & 15, fq = lane >> 4;
    constexpr int ES = FP8 ? 1 : 2;
    const int K = g.K, nt = K * ES / (BK * 2);
    unsigned voffA[2], voffB[2];
#pragma unroll
    for (int i = 0; i < 2; ++i) { int R, C; stage_rc(tid * 16 + i * 8192, R, C); const int Rb = Epi::PERM ? ((R & ~31) + perm32(R & 31)) : R;
        voffA[i] = (unsigned)(R * K * ES + C * 2); voffB[i] = (unsigned)(Rb * K * ES + C * 2); }
    const size_t kstep = (size_t)(BK * 2);
    const size_t hstep = (size_t)HALF * K * ES;
    const size_t tstep = 2 * hstep;
    const unsigned ldsw = (unsigned)wid * 1024u;
    const int aoff = lds_byte(wr * 64 + fr, fq * 8), boff = lds_byte(wc * 32 + fr, fq * 8);
#define PG8_SA(b, h) (((b) * 2 + (h)) * HTB)
#define PG8_SB(b, h) ((4 + (b) * 2 + (h)) * HTB)
#define PG8_STAGE(bufoff, gbase, voff) do { if constexpr (FP8) {   \
          int t3_ = tid; asm volatile("" : "+v"(t3_)); _Pragma("unroll") for (int _i = 0; _i < 2; ++_i) { int R_, C_; stage_rc(t3_ * 16 + _i * 8192, R_, C_); \
            if (Epi::PERM && (&(voff)[0] == &voffB[0])) R_ = (R_ & ~31) + perm32(R_ & 31); \
            __builtin_amdgcn_global_load_lds((const unsigned*)((const char*)(gbase) + (unsigned)(R_ * K * ES + C_ * 2)), (PG8_LAS unsigned*)(lds + (bufoff) + ldsw + _i * 8192), 16, 0, 0); } } \
        else { _Pragma("unroll") for (int _i = 0; _i < 2; ++_i) \
        __builtin_amdgcn_global_load_lds((const unsigned*)((const char*)(gbase) + (voff)[_i]), (PG8_LAS unsigned*)(lds + (bufoff) + ldsw + _i * 8192), 16, 0, 0); } } while (0)
#define PG8_LDA(dst, b, h) do { if constexpr (FP8) { _Pragma("unroll") for (int m = 0; m < 4; ++m) dst##8[m] = __builtin_shufflevector(*(const PG8_LAS i32x4*)(lds + PG8_SA(b, h) + aoff + m * 2048), *(const PG8_LAS i32x4*)(lds + PG8_SA(b, h) + aoff + m * 2048 + 1024), 0, 1, 2, 3, 4, 5, 6, 7); } \
        else { _Pragma("unroll") for (int m = 0; m < 4; ++m) _Pragma("unroll") for (int k = 0; k < 2; ++k) dst[m][k] = *(const PG8_LAS bf16x8*)(lds + PG8_SA(b, h) + aoff + m * 2048 + k * 1024); } } while (0)
#define PG8_LDB(dst, b, h) do { if constexpr (FP8) { _Pragma("unroll") for (int n = 0; n < 2; ++n) dst##8[n] = __builtin_shufflevector(*(const PG8_LAS i32x4*)(lds + PG8_SB(b, h) + boff + n * 2048), *(const PG8_LAS i32x4*)(lds + PG8_SB(b, h) + boff + n * 2048 + 1024), 0, 1, 2, 3, 4, 5, 6, 7); } \
        else { _Pragma("unroll") for (int n = 0; n < 2; ++n) _Pragma("unroll") for (int k = 0; k < 2; ++k) dst[n][k] = *(const PG8_LAS bf16x8*)(lds + PG8_SB(b, h) + boff + n * 2048 + k * 1024); } } while (0)
#define PG8_MMA(ai, bj, At, Bt) do { __builtin_amdgcn_s_setprio(1); \
        if constexpr (FP8) { _Pragma("unroll") for (int m = 0; m < 4; ++m) _Pragma("unroll") for (int n = 0; n < 2; ++n) { \
            acc[ai][bj][m][n] = __builtin_amdgcn_mfma_scale_f32_16x16x128_f8f6f4(Bt##8[n], At##8[m], acc[ai][bj][m][n], 0, 0, 0, SB, 0, SA); } } \
        else { _Pragma("unroll") for (int m = 0; m < 4; ++m) _Pragma("unroll") for (int n = 0; n < 2; ++n) _Pragma("unroll") for (int k = 0; k < 2; ++k) \
            acc[ai][bj][m][n] = __builtin_amdgcn_mfma_f32_16x16x32_bf16(Bt[n][k], At[m][k], acc[ai][bj][m][n], 0, 0, 0); } \
        __builtin_amdgcn_s_setprio(0); } while (0)
#define PG8_WAIT_V(n) asm volatile("s_waitcnt vmcnt(" #n ")" ::: "memory")
#define PG8_WAIT_L(n) asm volatile("s_waitcnt lgkmcnt(" #n ")" ::: "memory")
#define PG8_BAR __builtin_amdgcn_s_barrier()
#define PG8_SCHED __builtin_amdgcn_sched_barrier(0)
    Unit cur, nxt; int ui = 0;
    if (!S.next(0, cur)) return;
    f32x4 acc[2][2][4][2];
#pragma unroll
    for (int a = 0; a < 2; ++a)
#pragma unroll
        for (int b = 0; b < 2; ++b)
#pragma unroll
            for (int m = 0; m < 4; ++m)
#pragma unroll
                for (int n = 0; n < 2; ++n) acc[a][b][m][n] = (f32x4){0.f, 0.f, 0.f, 0.f};
    bf16x8 At[4][2], B0[2][2], B1[2][2]; i32x8 At8[4], B08[2], B18[2];
    const char* cA = (const char*)g.A + (size_t)cur.pm * tstep; const char* cB = (const char*)g.Bt + (size_t)cur.pn * tstep;
    S.a_ready(cur);
    if constexpr (SP2) {
        PG8_STAGE(PG8_SB(0, 0), cB, voffB); PG8_STAGE(PG8_SB(0, 1), cB + hstep, voffB); PG8_STAGE(PG8_SA(0, 0), cA, voffA); PG8_STAGE(PG8_SA(0, 1), cA + hstep, voffA);
        if (wr == 1) PG8_BAR;
        PG8_WAIT_V(2); PG8_BAR;
        PG8_STAGE(PG8_SB(1, 0), cB + kstep, voffB); PG8_STAGE(PG8_SA(1, 0), cA + kstep, voffA); PG8_STAGE(PG8_SB(1, 1), cB + hstep + kstep, voffB);
        PG8_WAIT_V(6); PG8_BAR;
    } else {
        PG8_STAGE(PG8_SB(0, 0), cB, voffB); PG8_STAGE(PG8_SA(0, 0), cA, voffA); PG8_STAGE(PG8_SB(0, 1), cB + hstep, voffB); PG8_STAGE(PG8_SA(0, 1), cA + hstep, voffA);
        if (wr == 1) PG8_BAR;
        PG8_WAIT_V(4); PG8_BAR;
        PG8_STAGE(PG8_SB(1, 0), cB + kstep, voffB); PG8_STAGE(PG8_SA(1, 0), cA + kstep, voffA); PG8_STAGE(PG8_SB(1, 1), cB + hstep + kstep, voffB);
        PG8_WAIT_V(6); PG8_BAR;
    }
    for (;;) {
        const bool has_next = S.next(ui + 1, nxt);
        const char* nA = has_next ? (const char*)g.A + (size_t)nxt.pm * tstep : cA; const char* nB = has_next ? (const char*)g.Bt + (size_t)nxt.pn * tstep : cB;
#pragma unroll 1
        for (int t = 0; t < nt; t += 2) {
            const bool last = (t == nt - 2);
            const char* a1 = cA + (size_t)(t + 1) * kstep;
            const char* a2 = last ? nA : cA + (size_t)(t + 2) * kstep; const char* b2 = last ? nB : cB + (size_t)(t + 2) * kstep;
            const char* a3 = a2 + kstep; const char* b3 = b2 + kstep;
            if (last && has_next) S.a_ready(nxt);
            if constexpr (SP2) {
            PG8_LDB(B0, 0, 0); PG8_LDB(B1, 0, 1); PG8_SCHED; PG8_LDA(At, 0, 0); PG8_STAGE(PG8_SA(1, 1), a1 + hstep, voffA);
            PG8_WAIT_V(8); PG8_WAIT_L(0); PG8_BAR; PG8_MMA(0, 0, At, B0); PG8_MMA(0, 1, At, B1); PG8_BAR; PG8_SCHED;
            PG8_LDA(At, 0, 1); PG8_STAGE(PG8_SB(0, 0), b2, voffB); PG8_STAGE(PG8_SB(0, 1), b2 + hstep, voffB); PG8_STAGE(PG8_SA(0, 0), a2, voffA);
            PG8_WAIT_V(8); PG8_WAIT_L(0); PG8_BAR; PG8_MMA(1, 0, At, B0); PG8_MMA(1, 1, At, B1); PG8_BAR; PG8_SCHED;
            PG8_LDB(B0, 1, 0); PG8_LDB(B1, 1, 1); PG8_SCHED; PG8_LDA(At, 1, 0); PG8_STAGE(PG8_SA(0, 1), a2 + hstep, voffA);
            PG8_WAIT_V(8); PG8_WAIT_L(0); PG8_BAR; PG8_MMA(0, 0, At, B0); PG8_MMA(0, 1, At, B1); PG8_BAR; PG8_SCHED;
            PG8_LDA(At, 1, 1); PG8_STAGE(PG8_SB(1, 0), b3, voffB); PG8_STAGE(PG8_SB(1, 1), b3 + hstep, voffB); PG8_STAGE(PG8_SA(1, 0), a3, voffA);
            PG8_WAIT_V(8); PG8_WAIT_L(0); PG8_BAR; PG8_MMA(1, 0, At, B0); PG8_MMA(1, 1, At, B1); PG8_BAR; PG8_SCHED;
            } else {
            PG8_LDB(B0, 0, 0); PG8_SCHED; PG8_LDA(At, 0, 0); PG8_STAGE(PG8_SA(1, 1), a1 + hstep, voffA);
            PG8_WAIT_L(8); PG8_BAR; PG8_WAIT_L(0); PG8_MMA(0, 0, At, B0); PG8_BAR; PG8_SCHED;
            PG8_LDB(B1, 0, 1); PG8_STAGE(PG8_SB(0, 0), b2, voffB);
            PG8_BAR; PG8_WAIT_L(0); PG8_MMA(0, 1, At, B1); PG8_BAR;
            PG8_LDA(At, 0, 1); PG8_STAGE(PG8_SA(0, 0), a2, voffA);
            PG8_BAR; PG8_WAIT_L(0); PG8_MMA(1, 0, At, B0); PG8_BAR; PG8_SCHED;
            PG8_STAGE(PG8_SB(0, 1), b2 + hstep, voffB);
            PG8_WAIT_V(6); PG8_BAR; PG8_MMA(1, 1, At, B1); PG8_BAR;
            PG8_LDB(B0, 1, 0); PG8_SCHED; PG8_LDA(At, 1, 0); PG8_STAGE(PG8_SA(0, 1), a2 + hstep, voffA);
            PG8_WAIT_L(8); PG8_BAR; PG8_WAIT_L(0); PG8_MMA(0, 0, At, B0); PG8_BAR; PG8_SCHED;
            PG8_LDB(B1, 1, 1); PG8_STAGE(PG8_SB(1, 0), b3, voffB);
            PG8_BAR; PG8_WAIT_L(0); PG8_MMA(0, 1, At, B1); PG8_BAR;
            PG8_LDA(At, 1, 1); PG8_STAGE(PG8_SA(1, 0), a3, voffA);
            PG8_BAR; PG8_WAIT_L(0); PG8_MMA(1, 0, At, B0); PG8_BAR; PG8_SCHED;
            PG8_STAGE(PG8_SB(1, 1), b3 + hstep, voffB);
            PG8_WAIT_V(6); PG8_BAR; PG8_MMA(1, 1, At, B1); PG8_BAR;
            }
        }
        if constexpr (ALIGN_EPI) { if (wr == 0) PG8_BAR; }
        if constexpr (!Epi::AFTER_DRAIN) { E(acc, cur, wr, wc, fr, fq); S.done(cur); }
        if (!has_next) break;
#pragma unroll
        for (int a = 0; a < 2; ++a)
#pragma unroll
            for (int b = 0; b < 2; ++b)
#pragma unroll
                for (int m = 0; m < 4; ++m)
#pragma unroll
                    for (int n = 0; n < 2; ++n) acc[a][b][m][n] = (f32x4){0.f, 0.f, 0.f, 0.f};
        cur = nxt; cA = nA; cB = nB; ++ui;
        if constexpr (ALIGN_EPI) { if (wr == 1) PG8_BAR; }
    }
    PG8_WAIT_V(0);
    if constexpr (!ALIGN_EPI) { if (wr == 0) PG8_BAR; }
    PG8_BAR;
    if constexpr (Epi::AFTER_DRAIN) { E.fused(acc, cur, wr, wc, fr, fq, lds, wid, lane); S.done(cur); }
#undef PG8_SA
#undef PG8_SB
#undef PG8_STAGE
#undef PG8_LDA
#undef PG8_LDB
#undef PG8_MMA
#undef PG8_WAIT_V
#undef PG8_WAIT_L
#undef PG8_BAR
#undef PG8_SCHED
}
}

namespace att {
typedef unsigned short bf16;
constexpr int D = 128, NW = 8, QBLK = 32, KVBLK = 64, LDQ = 1024, LDK = 256;
constexpr float SCALE = 0.088388347648318440f;
constexpr float THR = 3.f;
constexpr float QK8_SCALE = 4.f;
constexpr float V8A_SCALE = 4.f;
constexpr float O8_SCALE = 64.f;
#ifndef ATT_SDEPTH
#define ATT_SDEPTH 2
#endif
constexpr int SDEPTH = ATT_SDEPTH;
constexpr size_t SHM_V = KVBLK * D * 1  , SHM_K = KVBLK * D * 1  , SHM_ATTN = 3 * SHM_V + 3 * SHM_K + NW * 64 * 4;
#define VSWZ8(col, chunk) ((col) * 64 + ((((chunk) ^ ((col) >> 2)) & 3) << 4))
typedef int i32x8 __attribute__((ext_vector_type(8)));
typedef int i32x4 __attribute__((ext_vector_type(4)));
#define KSWZ8(row, colB) ((row) * 128 + ((colB) ^ ((((row) >> 1) & 7) << 4)))
using bf16x8 = __attribute__((ext_vector_type(8))) short;
using s16x4  = __attribute__((ext_vector_type(4))) short;
using f32x16 = __attribute__((ext_vector_type(16))) float;
using u32x4  = __attribute__((ext_vector_type(4))) unsigned;
#define KSWZ(row, colB) ((row) * 256 + ((colB) ^ (((row) & 7) << 4)))
#define SBAR() __builtin_amdgcn_sched_barrier(0)
__device__ __forceinline__ int crow(int r, int hi) { return (r & 3) + 8 * (r >> 2) + 4 * hi; }
__device__ __forceinline__ unsigned cvtpk(float lo, float hi) { unsigned r; asm volatile("v_cvt_pk_bf16_f32 %0, %1, %2" : "=v"(r) : "v"(lo), "v"(hi)); return r; }
typedef float f32x2 __attribute__((ext_vector_type(2)));
#define PAIR(P, i) (f32x2{P[2 * (i)], P[2 * (i) + 1]})
__device__ __forceinline__ void partialSM(f32x16& p0, f32x16& p1, float& m_reg, float& mn, float& alpha) {
  constexpr float C = SCALE * 1.4426950408889634f;
  float pmax = p0[0]; for (int r = 1; r < 16; ++r) pmax = fmaxf(pmax, p0[r]); for (int r = 0; r < 16; ++r) pmax = fmaxf(pmax, p1[r]);
  { auto rr = __builtin_amdgcn_permlane32_swap(__float_as_uint(pmax), __float_as_uint(pmax), false, false);
    pmax = fmaxf(__uint_as_float(rr[0]), __uint_as_float(rr[1])); }
  if (__builtin_expect(__all(pmax - m_reg <= THR / SCALE), 1)) { mn = m_reg; alpha = 1.f; }
  else { mn = fmaxf(m_reg, pmax); alpha = __builtin_amdgcn_exp2f((m_reg - mn) * C); m_reg = mn; }
  float mnC = 4.f - mn * C, Cv = C; asm volatile("" : "+v"(Cv));
  const f32x2 c2 = {Cv, Cv}, m2 = {mnC, mnC};
#pragma unroll
  for (int i = 0; i < 8; ++i) { const f32x2 a = __builtin_elementwise_fma(PAIR(p0, i), c2, m2), b = __builtin_elementwise_fma(PAIR(p1, i), c2, m2);
    p0[2 * i] = a[0]; p0[2 * i + 1] = a[1]; p1[2 * i] = b[0]; p1[2 * i + 1] = b[1]; }
  for (int r = 0; r < 16; ++r) p0[r] = __builtin_amdgcn_exp2f(p0[r]);
}
__device__ __forceinline__ void finishSM(f32x16& p0, f32x16& p1, float alpha, float& l_reg, i32x8& pa) {
  for (int r = 0; r < 16; ++r) p1[r] = __builtin_amdgcn_exp2f(p1[r]);
  f32x2 s2 = PAIR(p0, 0);
#pragma unroll
  for (int i = 1; i < 8; ++i) s2 += PAIR(p0, i);
#pragma unroll
  for (int i = 0; i < 8; ++i) s2 += PAIR(p1, i);
  float ps = s2[0] + s2[1];
  { auto rr = __builtin_amdgcn_permlane32_swap(__float_as_uint(ps), __float_as_uint(ps), false, false);
    ps = __uint_as_float(rr[0]) + __uint_as_float(rr[1]); }
  l_reg = l_reg * alpha + ps;
#define PK8(P, B) ({ int v_ = __builtin_amdgcn_cvt_pk_fp8_f32(P[B], P[B + 1], __float_as_int(P[B])  , false); v_ = __builtin_amdgcn_cvt_pk_fp8_f32(P[B + 2], P[B + 3], v_, true); (unsigned)v_; })
#pragma unroll
  for (int i = 0; i < 4; ++i) { const unsigned x = PK8(p0, 4 * i), y = PK8(p1, 4 * i); auto rr = __builtin_amdgcn_permlane32_swap(x, y, false, false); pa[2 * i] = (int)rr[0]; pa[2 * i + 1] = (int)rr[1]; }
#undef PK8
}
__device__ __forceinline__ void qkt(f32x16& p0, f32x16& p1, const char* Ks, const i32x8* qr, int r32, int hi) {
  p0 = f32x16{}; p1 = f32x16{};
#pragma unroll
  for (int sk = 0; sk < 2; ++sk) { const int cb = 64 * sk + 32 * hi;
    const i32x8 a0 = __builtin_shufflevector(*reinterpret_cast<const i32x4*>(Ks + KSWZ8(r32, cb)), *reinterpret_cast<const i32x4*>(Ks + KSWZ8(r32, cb + 16)), 0, 1, 2, 3, 4, 5, 6, 7);
    const i32x8 a1 = __builtin_shufflevector(*reinterpret_cast<const i32x4*>(Ks + KSWZ8(32 + r32, cb)), *reinterpret_cast<const i32x4*>(Ks + KSWZ8(32 + r32, cb + 16)), 0, 1, 2, 3, 4, 5, 6, 7);
    p0 = __builtin_amdgcn_mfma_scale_f32_32x32x64_f8f6f4(a0, qr[sk], p0, 0, 0, 0, 0x7d7d7d7d, 0, 0x7d7d7d7d);
    p1 = __builtin_amdgcn_mfma_scale_f32_32x32x64_f8f6f4(a1, qr[sk], p1, 0, 0, 0, 0x7d7d7d7d, 0, 0x7d7d7d7d); }
}
template <int D0> __device__ __forceinline__ void pv_one(f32x16& od, const char* Vt, i32x8 pa, int r32, int hi) {
  const int col = D0 * 32 + r32;
  const i32x8 b = __builtin_shufflevector(*reinterpret_cast<const i32x4*>(Vt + VSWZ8(col, 2 * hi)), *reinterpret_cast<const i32x4*>(Vt + VSWZ8(col, 2 * hi + 1)), 0, 1, 2, 3, 4, 5, 6, 7);
  od = __builtin_amdgcn_mfma_scale_f32_32x32x64_f8f6f4(pa, b, od, 0, 0, 0, 0x7f7f7f7f  , 0, 0x7d7d7d7d  );
}
__device__ __forceinline__ void pv_d0(f32x16* o, const char* Vt, i32x8 pa, int r32, int hi) {
  pv_one<0>(o[0], Vt, pa, r32, hi); pv_one<1>(o[1], Vt, pa, r32, hi); pv_one<2>(o[2], Vt, pa, r32, hi); pv_one<3>(o[3], Vt, pa, r32, hi);
}
#define PIN(x) asm volatile("" : "+v"(x))
#define LD8K(Ks, row, cb) __builtin_shufflevector(*reinterpret_cast<const i32x4*>((Ks) + KSWZ8(row, cb)), *reinterpret_cast<const i32x4*>((Ks) + KSWZ8(row, (cb) + 16)), 0, 1, 2, 3, 4, 5, 6, 7)
#define LD8V(Vt, col, h) __builtin_shufflevector(*reinterpret_cast<const i32x4*>((Vt) + VSWZ8(col, 2 * (h))), *reinterpret_cast<const i32x4*>((Vt) + VSWZ8(col, 2 * (h) + 1)), 0, 1, 2, 3, 4, 5, 6, 7)
#define MFQK(A, B, Cc) __builtin_amdgcn_mfma_scale_f32_32x32x64_f8f6f4(A, B, Cc, 0, 0, 0, 0x7d7d7d7d, 0, 0x7d7d7d7d)
#define MFPV(A, B, Cc) __builtin_amdgcn_mfma_scale_f32_32x32x64_f8f6f4(A, B, Cc, 0, 0, 0, 0x7f7f7f7f, 0, 0x7d7d7d7d)
#define PK8(P, B) ({ int v_ = __builtin_amdgcn_cvt_pk_fp8_f32(P[B], P[B + 1], __float_as_int(P[B]), false); v_ = __builtin_amdgcn_cvt_pk_fp8_f32(P[B + 2], P[B + 3], v_, true); (unsigned)v_; })
__device__ __forceinline__ void qk_fin(f32x16& n0, f32x16& n1, const char* Ks, const i32x8* qr, f32x16& c0, f32x16& c1, float alpha, float& l_reg, i32x8& pa, int r32, int hi) {
  const i32x8 a00 = LD8K(Ks, r32, 32 * hi), a10 = LD8K(Ks, 32 + r32, 32 * hi), a01 = LD8K(Ks, r32, 64 + 32 * hi), a11 = LD8K(Ks, 32 + r32, 64 + 32 * hi);
  SBAR(); n0 = MFQK(a00, qr[0], f32x16{}); SBAR();
#pragma unroll
  for (int r = 0; r < 8; ++r) c1[r] = __builtin_amdgcn_exp2f(c1[r]);
  SBAR(); n1 = MFQK(a10, qr[0], f32x16{}); SBAR();
#pragma unroll
  for (int r = 8; r < 16; ++r) c1[r] = __builtin_amdgcn_exp2f(c1[r]);
  SBAR(); n0 = MFQK(a01, qr[1], n0); SBAR();
  f32x2 s2 = PAIR(c0, 0);
#pragma unroll
  for (int i = 1; i < 8; ++i) s2 += PAIR(c0, i);
#pragma unroll
  for (int i = 0; i < 8; ++i) s2 += PAIR(c1, i);
  float ps = s2[0] + s2[1];
  { auto rr = __builtin_amdgcn_permlane32_swap(__float_as_uint(ps), __float_as_uint(ps), false, false); ps = __uint_as_float(rr[0]) + __uint_as_float(rr[1]); }
  l_reg = l_reg * alpha + ps;
  SBAR(); n1 = MFQK(a11, qr[1], n1); SBAR();
#pragma unroll
  for (int i = 0; i < 4; ++i) { const unsigned x = PK8(c0, 4 * i), y = PK8(c1, 4 * i); auto rr = __builtin_amdgcn_permlane32_swap(x, y, false, false); pa[2 * i] = (int)rr[0]; pa[2 * i + 1] = (int)rr[1]; }
  SBAR();
}
__device__ __forceinline__ void pv_part(f32x16* o, const char* Vt, const i32x8 pa, f32x16& n0, f32x16& n1, float& m_reg, float& alpha, int r32, int hi) {
  constexpr float C = SCALE * 1.4426950408889634f;
  const i32x8 b0 = LD8V(Vt, r32, hi), b1 = LD8V(Vt, 32 + r32, hi), b2 = LD8V(Vt, 64 + r32, hi), b3 = LD8V(Vt, 96 + r32, hi);
  SBAR(); o[0] = MFPV(pa, b0, o[0]); SBAR();
  float pmax = n0[0]; for (int r = 1; r < 16; ++r) pmax = fmaxf(pmax, n0[r]); for (int r = 0; r < 16; ++r) pmax = fmaxf(pmax, n1[r]);
  { auto rr = __builtin_amdgcn_permlane32_swap(__float_as_uint(pmax), __float_as_uint(pmax), false, false); pmax = fmaxf(__uint_as_float(rr[0]), __uint_as_float(rr[1])); }
  const bool keep = __all(pmax - m_reg <= THR / SCALE);
  const float mn = keep ? m_reg : fmaxf(m_reg, pmax);
  alpha = __builtin_amdgcn_exp2f((m_reg - mn) * C); m_reg = mn;
  float mnC = 4.f - mn * C, Cv = C; asm volatile("" : "+v"(Cv));
  const f32x2 c2 = {Cv, Cv}, m2 = {mnC, mnC};
  SBAR(); o[1] = MFPV(pa, b1, o[1]); SBAR();
#pragma unroll
  for (int i = 0; i < 8; ++i) { const f32x2 a = __builtin_elementwise_fma(PAIR(n0, i), c2, m2), b = __builtin_elementwise_fma(PAIR(n1, i), c2, m2);
    n0[2 * i] = a[0]; n0[2 * i + 1] = a[1]; n1[2 * i] = b[0]; n1[2 * i + 1] = b[1]; }
  PIN(n0); PIN(n1);
  SBAR(); o[2] = MFPV(pa, b2, o[2]); SBAR();
#pragma unroll
  for (int r = 0; r < 8; ++r) n0[r] = __builtin_amdgcn_exp2f(n0[r]);
  PIN(n0);
  SBAR(); o[3] = MFPV(pa, b3, o[3]); SBAR();
#pragma unroll
  for (int r = 8; r < 16; ++r) n0[r] = __builtin_amdgcn_exp2f(n0[r]);
  PIN(n0);
  SBAR();
}
#undef PK8
__device__ __forceinline__ void wmask(f32x16& p0, f32x16& p1, int kb, int qp, int hi) {
  const int bd = kb - qp + 4 * hi + 128;
#pragma unroll
  for (int r = 0; r < 16; ++r) { const int d0 = bd + (r & 3) + 8 * (r >> 2);
    if ((unsigned)d0 > 256u) p0[r] = -1e30f; if ((unsigned)(d0 + 32) > 256u) p1[r] = -1e30f; }
}
__device__ __forceinline__ void attn_unit(const bool WIN, const unsigned char* Qb, unsigned char* Ob, const unsigned char* __restrict__ Kh, const unsigned char* __restrict__ Vh  , int NT, int kstart, int q0, float sink_l2, float sink1_l2, char* lds) {
  int tid_ = threadIdx.x; asm volatile("" : "+v"(tid_));
  const int tid = tid_, wid = __builtin_amdgcn_readfirstlane(tid >> 6), lane = tid & 63, r32 = lane & 31, hi = lane >> 5;
  char* V_lds = lds; char* K_lds = lds + 3 * SHM_V;
  float* ws = (float*)(lds + 3 * SHM_V + 3 * SHM_K) + wid * 64; float* li_l = ws; float* al_l = ws + 32;
  float m_reg = -1e30f, l_reg = 0; f32x16 o[4] = {}; i32x8 qr[2];
  const int wrow = WIN ? (wid & 3) * QBLK : wid * QBLK, hoff = WIN ? (wid >> 2) * D : 0;
  const unsigned char* Qw = Qb + (long)(wrow + r32) * LDQ + hoff + hi * 32;
#pragma unroll
  for (int sk = 0; sk < 2; ++sk) qr[sk] = __builtin_shufflevector(*reinterpret_cast<const i32x4*>(Qw + sk * 64), *reinterpret_cast<const i32x4*>(Qw + sk * 64 + 16), 0, 1, 2, 3, 4, 5, 6, 7);
  const int vcol = tid >> 2, vpc = tid & 3;
  const int sr8 = tid >> 3, sc8 = (tid & 7) * 16;
  const int qp = q0 + wrow + r32;
  struct { i32x4 vs0, ks0; } sr_[SDEPTH];
#define TROW(t) (WIN ? ((t) < 4 ? (t) * KVBLK : kstart + (t) * KVBLK) : (t) * KVBLK)
#define SLOAD(i, t) do { const int k0_ = TROW(t); sr_[i].vs0 = *reinterpret_cast<const i32x4*>(&Vh[(long)vcol * RPB + k0_ + vpc * 16]); \
    sr_[i].ks0 = *reinterpret_cast<const i32x4*>(&Kh[(long)(k0_ + sr8) * LDK + sc8]); } while (0)
#define SWRITE(bo, i) do { *(i32x4*)(V_lds + (bo) + VSWZ8(vcol, vpc)) = sr_[i].vs0;          \
    *(i32x4*)((char*)K_lds + (bo) + KSWZ8(sr8, sc8)) = sr_[i].ks0; } while (0)
#define SWAIT() do { if constexpr (SDEPTH == 2) asm volatile("s_waitcnt vmcnt(2)" ::: "memory"); else asm volatile("s_waitcnt vmcnt(0)" ::: "memory"); } while (0)
#define RESC(a) do { if (__any((a) < 1.f)) { if (hi == 0) al_l[r32] = (a); asm volatile("s_waitcnt lgkmcnt(0)" ::: "memory"); \
    for (int d = 0; d < 4; ++d) for (int r = 0; r < 16; ++r) o[d][r] *= al_l[crow(r, hi)]; } } while (0)
#define WMASK(P0, P1, t) do { if (WIN) { if ((t) >= 4) wmask(P0, P1, kstart + ((t) - 4) * KVBLK, qp, hi); } } while (0)
  f32x16 pA0, pA1, pB0, pB1; float mnA, mnB, alA, alB; i32x8 pa;
  constexpr int SE = 0, SO = SDEPTH - 1;
  static_assert(SDEPTH == 2 && SHM_V == SHM_K, "ring schedule below");
  SLOAD(SE, 0); asm volatile("s_waitcnt vmcnt(0)" ::: "memory"); SWRITE(0, SE); __syncthreads();
  qkt(pA0, pA1, K_lds, qr, r32, hi); WMASK(pA0, pA1, 0); partialSM(pA0, pA1, m_reg, mnA, alA);
  SLOAD(SO, 1); if (2 < NT) SLOAD(SE, 2);
  SWAIT(); SWRITE((int)SHM_K, SO); if (3 < NT) SLOAD(SO, 3); __syncthreads();
  int r0 = 0, r1 = (int)SHM_K, r2 = 2 * (int)SHM_K;
  for (int j = 1; j + 1 < NT; j += 2) {
    qk_fin(pB0, pB1, K_lds + r1, qr, pA0, pA1, alA, l_reg, pa, r32, hi); WMASK(pB0, pB1, j);
    SWAIT(); SWRITE(r2, SE); if (j + 3 < NT) SLOAD(SE, j + 3); SBAR();
    pv_part(o, V_lds + r0, pa, pB0, pB1, m_reg, alB, r32, hi);
    RESC(alB); __syncthreads();
    qk_fin(pA0, pA1, K_lds + r2, qr, pB0, pB1, alB, l_reg, pa, r32, hi); WMASK(pA0, pA1, j + 1);
    SWAIT(); SWRITE(r0, SO); if (j + 4 < NT) SLOAD(SO, j + 4); SBAR();
    pv_part(o, V_lds + r1, pa, pA0, pA1, m_reg, alA, r32, hi);
    RESC(alA); __syncthreads();
    { const int t0 = r0, t1 = r1; r0 = r2; r1 = t0; r2 = t1; }
  }
  qk_fin(pB0, pB1, K_lds + r1, qr, pA0, pA1, alA, l_reg, pa, r32, hi); WMASK(pB0, pB1, NT - 1);
  pv_part(o, V_lds + r0, pa, pB0, pB1, m_reg, alB, r32, hi);
  RESC(alB);
  finishSM(pB0, pB1, alB, l_reg, pa); SBAR();
  pv_d0(o, V_lds + r1, pa, r32, hi);
  if (WIN) { constexpr float C = SCALE * 1.4426950408889634f; l_reg += __builtin_amdgcn_exp2f(((wid >> 2) ? sink1_l2 : sink_l2) - m_reg * C + 4.f); }
  if (hi == 0) li_l[r32] = l_reg; asm volatile("s_waitcnt lgkmcnt(0)" ::: "memory");
  float rli[16];
#pragma unroll
  for (int r = 0; r < 16; ++r) rli[r] = __builtin_amdgcn_rcpf(li_l[crow(r, hi)]);
  unsigned char* Ow = Ob + (long)wrow * LDQ + hoff;
#pragma unroll
  for (int r = 0; r < 16; ++r) { const int orow = crow(r, hi);
#pragma unroll
    for (int d0 = 0; d0 < 4; ++d0) { const float v = o[d0][r] * rli[r] * O8_SCALE;     Ow[(long)orow * LDQ + d0 * 32 + r32] = (unsigned char)(__builtin_amdgcn_cvt_pk_fp8_f32(v, v, 0, false) & 0xff); } }
  __syncthreads();
#undef TROW
#undef SLOAD
#undef SWRITE
#undef SWAIT
#undef RESC
#undef WMASK
}
#undef KSWZ
#undef SBAR
}

namespace mk {
namespace cg = cooperative_groups;
typedef unsigned short bf16;
typedef short bf16x8 __attribute__((ext_vector_type(8)));
typedef float f32x4 __attribute__((ext_vector_type(4)));
typedef unsigned u32x4 __attribute__((ext_vector_type(4)));
typedef unsigned u32x2 __attribute__((ext_vector_type(2)));
typedef __bf16 bf2_t __attribute__((ext_vector_type(2)));
#define LAS __attribute__((address_space(3)))
constexpr int NWAVES = 8, NTHR = 512;
constexpr size_t MiB = 1u << 20;
constexpr size_t WS_CTL = 0, CTL_BYTES = 1 * MiB;
constexpr size_t WS_MOD = 1 * MiB;
constexpr size_t WS_ROPE = 1 * MiB + 512 * 1024;
constexpr size_t WS_XC = 2 * MiB;
constexpr size_t WS_WQKV = 6 * MiB;
constexpr size_t WS_WO = 12 * MiB;
constexpr size_t WS_WP = 16 * MiB;
constexpr size_t WS_H = 24 * MiB;
constexpr size_t WS_Q = 58 * MiB;
constexpr size_t WS_K = 92 * MiB;
constexpr size_t WS_V = 101 * MiB;
constexpr size_t WS_EIDX = 110 * MiB;
constexpr size_t WS_GATE = 119 * MiB;
constexpr size_t WS_PW = 128 * MiB;
constexpr size_t WS_S = 137 * MiB;
constexpr size_t WS_UT = 274 * MiB;
constexpr size_t WS_VT = 306 * MiB;
constexpr size_t WS_O = 338 * MiB;
constexpr size_t WS_XB = 372 * MiB;
constexpr size_t WS_XCB = 436 * MiB;
constexpr size_t WS_PART = 440 * MiB;
constexpr size_t WS_END = 508 * MiB;
constexpr float U8_SCALE = 64.f, V8_SCALE = 8.f;
constexpr int LDS_BYTES = 155648;
constexpr int NPHASE = 23;

struct Args { const float* in[17]; float* out; unsigned char* ws; int ph_lo, ph_hi; };

constexpr int PTAB_OFF = 153600;
struct Ctx {
  unsigned char* ws;
  int tid, lane, wave, bid, G;
  LAS unsigned char* lds; unsigned char* ldsg;
  __device__ __forceinline__ const float* in(int k) const {
    const volatile LAS unsigned* t = (const volatile LAS unsigned*)(lds + PTAB_OFF) + 2 * k;
    const unsigned lo = __builtin_amdgcn_readfirstlane(t[0]), hi = __builtin_amdgcn_readfirstlane(t[1]);
    return (const float*)(((unsigned long long)hi << 32) | lo);
  }
  __device__ __forceinline__ float* outp() const { return (float*)in(17); }
};
enum { I_X = 0, I_C, I_CTX, I_CCTX, I_ADAW, I_ADAB, I_N1G, I_N2G, I_WQKV, I_QNG, I_KNG, I_WO, I_SINKS, I_PWQ, I_PSK, I_PU, I_PV };

__device__ __forceinline__ unsigned f2bf(float f) { unsigned u = __builtin_bit_cast(unsigned, f); return (u + 0x7fffu + ((u >> 16) & 1u)) >> 16; }
__device__ __forceinline__ unsigned pk2(float lo, float hi) { unsigned r; asm volatile("v_cvt_pk_bf16_f32 %0, %1, %2" : "=v"(r) : "v"(lo), "v"(hi)); return r; }
__device__ __forceinline__ float bflo(unsigned u) { return __uint_as_float(u << 16); }
__device__ __forceinline__ float bfhi(unsigned u) { return __uint_as_float(u & 0xffff0000u); }
__device__ __forceinline__ float silu(float x) { return x / (1.f + __expf(-x)); }
__device__ __forceinline__ float gelu_tanh(float x) {
  const float y = 0.7978845608028654f * (x + 0.044715f * x * x * x);
  const float t = 1.f - 2.f / (__expf(2.f * y) + 1.f);
  return 0.5f * x * (1.f + t);
}
__device__ __forceinline__ float wave_sum(float v) {
#pragma unroll
  for (int o = 1; o < 64; o <<= 1) v += __shfl_xor(v, o);
  return v;
}
__device__ __forceinline__ const float* xrow_sel(const float* lat, const float* cx, int r) { const int b = r / RPB, j = r % RPB; return j < CTXL ? cx + (size_t)(b * CTXL + j) * DM : lat + (size_t)(b * SEQ + (j - CTXL)) * DM; }
__device__ __forceinline__ int mod_row(int r) { const int b = r / RPB, j = r % RPB; return j < CTXL ? 4 : b; }

__device__ __forceinline__ const float* st_lat(const Ctx& F, int sel) { return sel == 0 ? F.in(I_X) : (sel == 1 ? (const float*)(F.ws + WS_XB) : (const float*)F.outp()); }
__device__ __forceinline__ const float* st_ctx(const Ctx& F, int sel) { return sel == 0 ? F.in(I_CTX) : (sel == 1 ? (const float*)(F.ws + WS_XCB) : (const float*)(F.ws + WS_XC)); }
__device__ __forceinline__ int qk_perm_col(int n) {
  if (n >= (NH + NKV) * HD) return n; const int d = n & 127, axis = d >> 6, pair = (d >> 5) & 1, f = d & 31; return (n & ~127) + 2 * (axis * 32 + f) + pair; }
constexpr float W8_SCALE = 32.f;
template <bool QKPERM, bool FP8>
__device__ __forceinline__ void p0_transpose_item(const float* W, int K, int N, bf16* WT, LAS float* scr, int item, int lane) {
  const int nblk = N / 32, kb = item / nblk, nb = item % nblk, k0 = 64 * kb, n0 = 32 * nb;
  { float t[32];
#pragma unroll
    for (int i = 0; i < 32; ++i) t[i] = W[(size_t)(k0 + 2 * i + (lane >> 5)) * N + n0 + (lane & 31)];
#pragma unroll
    for (int i = 0; i < 32; ++i) scr[(2 * i + (lane >> 5)) * 33 + (lane & 31)] = t[i]; }
  asm volatile("s_waitcnt lgkmcnt(0)" ::: "memory");
  const int c = lane & 7;
#pragma unroll
  for (int j = 0; j < 4; ++j) { const int n = (lane >> 3) + 8 * j; const LAS float* s = scr + (8 * c) * 33 + n;
    if constexpr (FP8) { int v0 = __builtin_amdgcn_cvt_pk_fp8_f32(s[0 * 33] * W8_SCALE, s[1 * 33] * W8_SCALE, 0, false); v0 = __builtin_amdgcn_cvt_pk_fp8_f32(s[2 * 33] * W8_SCALE, s[3 * 33] * W8_SCALE, v0, true);
      int v1 = __builtin_amdgcn_cvt_pk_fp8_f32(s[4 * 33] * W8_SCALE, s[5 * 33] * W8_SCALE, 0, false); v1 = __builtin_amdgcn_cvt_pk_fp8_f32(s[6 * 33] * W8_SCALE, s[7 * 33] * W8_SCALE, v1, true);
      u32x2 o; o.x = (unsigned)v0; o.y = (unsigned)v1; *(u32x2*)((unsigned char*)WT + (size_t)(QKPERM ? qk_perm_col(n0 + n) : n0 + n) * K + k0 + 8 * c) = o; }
    else { u32x4 o; o.x = pk2(s[0 * 33], s[1 * 33]); o.y = pk2(s[2 * 33], s[3 * 33]); o.z = pk2(s[4 * 33], s[5 * 33]); o.w = pk2(s[6 * 33], s[7 * 33]);
      *(u32x4*)(WT + (size_t)(QKPERM ? qk_perm_col(n0 + n) : n0 + n) * K + k0 + 8 * c) = o; } }
  asm volatile("s_waitcnt lgkmcnt(0)" ::: "memory");
}

constexpr int CONV_NR = DEPTH * NKEYS * NKEYS;
__device__ __forceinline__ int conv_idle(int G, int p) { const int nu = p == 0 ? 408 : (p == 1 ? 272 : 544); return (nu % G) ? G - (nu % G) : 0; }
__device__ __forceinline__ void conv_slot(const Ctx& F, int p, int& lo, int& hi) {
  const int i0 = conv_idle(F.G, 0), i1 = conv_idle(F.G, 1), i2 = conv_idle(F.G, 2), tw = 8 * i0 + 4 * i1 + 10 * i2; lo = hi = 0; if (tw == 0) return;
  const int unit = (2 * CONV_NR + tw - 1) / tw;
  const int mine = conv_idle(F.G, p), first = F.G - mine; if (F.bid < first) return;
  const int wgt = p == 0 ? 8 : (p == 1 ? 4 : 10), base = (p == 0 ? 0 : (p == 1 ? 8 * i0 : 8 * i0 + 4 * i1)) + wgt * (F.bid - first);
  lo = base * unit; hi = lo + wgt * unit;
}
__device__ __forceinline__ void convert_rows(const Ctx& F, int r_lo, int r_hi) {
  constexpr int NR = CONV_NR;
  const float* pup = F.in(I_PU); const float* pvp = F.in(I_PV);
  if (r_hi > 2 * NR) r_hi = 2 * NR;
  for (int rr = r_lo + F.wave; rr < r_hi; rr += 2 * NWAVES) {
    f32x4 a[2][4];
#pragma unroll
    for (int q = 0; q < 2; ++q) { const int row = rr + q * NWAVES; if (row < r_hi) { const float* src = (row < NR ? pup : pvp) + (size_t)(row < NR ? row : row - NR) * DM;
#pragma unroll
        for (int i = 0; i < 4; ++i) a[q][i] = ((const f32x4*)src)[i * 64 + F.lane]; } }
#pragma unroll
    for (int q = 0; q < 2; ++q) { const int row = rr + q * NWAVES; if (row < r_hi) { const bool isu = row < NR; const int rw = isu ? row : row - NR; const float sc = isu ? U8_SCALE : V8_SCALE;
        const size_t lay = (size_t)(rw >> 14), ex = (size_t)(rw & 16383); unsigned char* dst = F.ws + (isu ? WS_UT : WS_VT);
#pragma unroll
        for (int i = 0; i < 4; ++i) { int v = __builtin_amdgcn_cvt_pk_fp8_f32(a[q][i].x * sc, a[q][i].y * sc, 0, false); v = __builtin_amdgcn_cvt_pk_fp8_f32(a[q][i].z * sc, a[q][i].w * sc, v, true);
          const int sl = 2 * i + (F.lane >> 5); *(unsigned*)(dst + ((lay * 8 + sl) * 16384 + ex) * 128 + ((F.lane & 31) * 4)) = (unsigned)v; } } }
  }
}

__device__ __forceinline__ void phase_prologue(const Ctx& F) {
  { LAS float* sl = (LAS float*)F.lds;
    LAS float* red = sl + 5 * DM;
    { const float* cp = F.in(I_C); const float* ccp = F.in(I_CCTX);
      for (int e = F.tid; e < 5 * DM; e += NTHR) { const int r = e / DM, j = e % DM; sl[e] = silu(r < 4 ? cp[r * DM + j] : ccp[j]); } }
    __syncthreads();
    const float* adaw = F.in(I_ADAW); const float* adab = F.in(I_ADAB);
    for (int task = F.bid; task < DEPTH * 96; task += F.G) {
      const int i = task / 96, n = (task % 96) * 64 + F.lane;
      const float* w = adaw + (size_t)i * DM * NMOD * DM + n;
      float a0 = 0.f, a1 = 0.f, a2 = 0.f, a3 = 0.f, a4 = 0.f;
#pragma unroll 1
      for (int j0 = 0; j0 < 128; j0 += 32) { float wv[32];
#pragma unroll
        for (int jj = 0; jj < 32; ++jj) wv[jj] = w[(size_t)(F.wave * 128 + j0 + jj) * NMOD * DM];
#pragma unroll
        for (int jj = 0; jj < 32; ++jj) { const int j = F.wave * 128 + j0 + jj;
          a0 += sl[j] * wv[jj]; a1 += sl[DM + j] * wv[jj]; a2 += sl[2 * DM + j] * wv[jj]; a3 += sl[3 * DM + j] * wv[jj]; a4 += sl[4 * DM + j] * wv[jj]; } }
      red[(F.wave * 5 + 0) * 64 + F.lane] = a0; red[(F.wave * 5 + 1) * 64 + F.lane] = a1; red[(F.wave * 5 + 2) * 64 + F.lane] = a2;
      red[(F.wave * 5 + 3) * 64 + F.lane] = a3; red[(F.wave * 5 + 4) * 64 + F.lane] = a4;
      __syncthreads();
      if (F.tid < 320) { const int r = F.tid >> 6, l = F.tid & 63; float s = 0.f;
#pragma unroll
        for (int w8 = 0; w8 < 8; ++w8) s += red[(w8 * 5 + r) * 64 + l];
        const int nn = (task % 96) * 64 + l;
        ((float*)(F.ws + WS_MOD))[((size_t)i * 5 + r) * NMOD * DM + nn] = s + adab[i * NMOD * DM + nn]; }
      __syncthreads();
    }
  }
  { LAS float* sk = (LAS float*)F.lds;
    LAS float* wq = sk + 128 * 132;
    const float* pskp = F.in(I_PSK); const float* pwqp = F.in(I_PWQ);
    for (int task = F.bid; task < DEPTH * 8 * 2 * 16; task += F.G) {
      const int jc = task & 15, half = (task >> 4) & 1, h = (task >> 5) & 7, i = task >> 8;
      const float* SK = pskp + ((size_t)i * 2 + half) * NKEYS * 128;
      const float* WQ = pwqp + (size_t)i * DM * PQN + (size_t)(jc * 64) * PQN + h * PQD + half * 128;
      for (int e = F.tid; e < 128 * 32; e += NTHR) { const int kk = e >> 5, d4 = e & 31; const f32x4 v = *(const f32x4*)(SK + (size_t)kk * 128 + d4 * 4); *(LAS f32x4*)(sk + kk * 132 + d4 * 4) = v; }
      for (int e = F.tid; e < 64 * 32; e += NTHR) { const int j = e >> 5, d4 = e & 31; const f32x4 v = *(const f32x4*)(WQ + (size_t)j * PQN + d4 * 4); *(LAS f32x4*)(wq + j * 128 + d4 * 4) = v; }
      __syncthreads();
      const int kk = F.tid & 127, jg = F.tid >> 7;
      float acc[16];
#pragma unroll
      for (int q = 0; q < 16; ++q) acc[q] = 0.f;
#pragma unroll 2
      for (int d4 = 0; d4 < 32; ++d4) { const f32x4 s = *(const LAS f32x4*)(sk + kk * 132 + d4 * 4);
#pragma unroll
        for (int q = 0; q < 16; ++q) { const f32x4 w = *(const LAS f32x4*)(wq + (jg * 16 + q) * 128 + d4 * 4); acc[q] += s.x * w.x + s.y * w.y + s.z * w.z + s.w * w.w; } }
      bf16* o = (bf16*)(F.ws + WS_WP) + ((size_t)i * PQN + h * PQD + half * 128 + kk) * DM + jc * 64 + jg * 16;
      u32x4 o0, o1; o0.x = pk2(acc[0], acc[1]); o0.y = pk2(acc[2], acc[3]); o0.z = pk2(acc[4], acc[5]); o0.w = pk2(acc[6], acc[7]);
      o1.x = pk2(acc[8], acc[9]); o1.y = pk2(acc[10], acc[11]); o1.z = pk2(acc[12], acc[13]); o1.w = pk2(acc[14], acc[15]);
      *(u32x4*)o = o0; *(u32x4*)(o + 8) = o1;
      __syncthreads();
    }
  }
  { const int gt = F.bid * NTHR + F.tid; float* rp = (float*)(F.ws + WS_ROPE);
    if (gt < 64 * 32) { const int pos = gt >> 5, f = gt & 31; const float inv = exp2f(-(float)(2 * f) * (13.287712379549449f / 64.f)); float sn, cs; sincosf((float)pos * inv, &sn, &cs); rp[2 * gt] = cs; rp[2 * gt + 1] = sn; }
    else if (gt < 64 * 32 + DEPTH * 2 * HD) { const int e = gt - 64 * 32, p = e & 127, which = (e >> 7) & 1, layer = e >> 8; const int q = p >> 1, pair = p & 1, d = (q >> 5) * 64 + pair * 32 + (q & 31);
      rp[64 * 32 * 2 + e] = (which == 0 ? F.in(I_QNG) : F.in(I_KNG))[layer * HD + d]; } }
  if (8 * conv_idle(F.G, 0) + 4 * conv_idle(F.G, 1) + 10 * conv_idle(F.G, 2) == 0) { const int per = (2 * CONV_NR + F.G - 1) / F.G; convert_rows(F, F.bid * per, (F.bid + 1) * per); }
  { LAS float* scr = (LAS float*)F.lds + F.wave * (64 * 33 + 16);
    const int gw = F.bid * NWAVES + F.wave, NGW = F.G * NWAVES;
    constexpr int I_QKV = (DM / 64) * (QKVD / 32), I_O = (DM / 64) * (DM / 32);
    const float* wqkvp = F.in(I_WQKV); const float* wop = F.in(I_WO);
    for (int it = gw; it < DEPTH * (I_QKV + I_O); it += NGW) {
      const int i = it / (I_QKV + I_O); int r = it % (I_QKV + I_O);
      if (r < I_QKV) p0_transpose_item<true, true>(wqkvp + (size_t)i * DM * QKVD, DM, QKVD, (bf16*)(F.ws + WS_WQKV + (size_t)i * QKVD * DM), scr, r, F.lane);
      else p0_transpose_item<false, true>(wop + (size_t)i * DM * DM, DM, DM, (bf16*)(F.ws + WS_WO + (size_t)i * DM * DM), scr, r - I_QKV, F.lane);
    }
  }
}

constexpr float H8_SCALE = 4.f;
__device__ __forceinline__ void phase_norm(const Ctx& F, int layer, int which  , int src_sel, bool latent_only) {
  const int gw = F.bid * NWAVES + F.wave, NGW = F.G * NWAVES;
  const float* gain = (which == 0 ? F.in(I_N1G) : F.in(I_N2G)) + layer * DM;
  const float* modl = (const float*)(F.ws + WS_MOD) + (size_t)layer * 5 * NMOD * DM;
  bf16* H = (bf16*)(F.ws + WS_H);
  const float* latp = st_lat(F, src_sel); const float* cxp = st_ctx(F, src_sel);
  for (int r = gw; r < NROWS; r += NGW) {
    if (latent_only && (r % RPB) < CTXL) continue;
    const float* xr = xrow_sel(latp, cxp, r);
    const float* mrow = modl + (size_t)mod_row(r) * NMOD * DM;
    const float* sh = mrow + (which == 0 ? 0 : 3) * DM; const float* sc = mrow + (which == 0 ? 1 : 4) * DM;
    f32x4 v[4]; float s = 0.f;
#pragma unroll
    for (int j = 0; j < 4; ++j) { v[j] = ((const f32x4*)xr)[F.lane + 64 * j]; s += (v[j].x * v[j].x + v[j].y * v[j].y) + (v[j].z * v[j].z + v[j].w * v[j].w); }
    const float rstd = rsqrtf(wave_sum(s) * (1.f / DM) + RMS_EPS);
    unsigned long long* o8 = (unsigned long long*)(H + (size_t)r * DM) + F.lane;
#pragma unroll
    for (int j = 0; j < 4; ++j) { const f32x4 g = ((const f32x4*)gain)[F.lane + 64 * j], a = ((const f32x4*)sc)[F.lane + 64 * j], b = ((const f32x4*)sh)[F.lane + 64 * j];
      const float y0 = v[j].x * rstd * g.x * (1.f + a.x) + b.x, y1 = v[j].y * rstd * g.y * (1.f + a.y) + b.y, y2 = v[j].z * rstd * g.z * (1.f + a.z) + b.z, y3 = v[j].w * rstd * g.w * (1.f + a.w) + b.w;
      if (which == 0) { int v8 = __builtin_amdgcn_cvt_pk_fp8_f32(y0 * H8_SCALE, y1 * H8_SCALE, 0, false); v8 = __builtin_amdgcn_cvt_pk_fp8_f32(y2 * H8_SCALE, y3 * H8_SCALE, v8, true);
        ((unsigned*)((unsigned char*)H + (size_t)r * DM))[F.lane + 64 * j] = (unsigned)v8; }
      else o8[64 * j] = (unsigned long long)pk2(y0, y1) | ((unsigned long long)pk2(y2, y3) << 32); }
  }
}

__device__ __forceinline__ void phase_qknorm(const Ctx& F, int layer) {
  const int gw = F.bid * NWAVES + F.wave, NGW = F.G * NWAVES;
  const int axis = F.lane >> 5, f = F.lane & 31, e1 = axis * 64 + f, e2 = e1 + 32;
  const float* qg = F.in(I_QNG) + layer * HD; const float* kg = F.in(I_KNG) + layer * HD;
  const float qg1 = qg[e1], qg2 = qg[e2], kg1 = kg[e1], kg2 = kg[e2];
  const float inv = exp2f(-(float)(2 * f) * (13.287712379549449f / 64.f));
  bf16* Q = (bf16*)(F.ws + WS_Q); bf16* K = (bf16*)(F.ws + WS_K);
  for (int r = gw; r < NROWS; r += NGW) {
    const int j = r % RPB; float cs = 1.f, sn = 0.f;
    if (j >= CTXL) { const int sp = j - CTXL; const float pos = (float)(axis == 0 ? (sp >> 6) : (sp & 63)); sincosf(pos * inv, &sn, &cs); }
#pragma unroll
    for (int h = 0; h < NH + NKV; ++h) {
      bf16* base = h < NH ? Q + (size_t)r * DM + h * HD : K + (size_t)r * (NKV * HD) + (h - NH) * HD;
      float x1 = bflo(base[e1]), x2 = bflo(base[e2]);
      const float rstd = rsqrtf(wave_sum(x1 * x1 + x2 * x2) * (1.f / HD) + RMS_EPS);
      x1 *= rstd * (h < NH ? qg1 : kg1); x2 *= rstd * (h < NH ? qg2 : kg2);
      const float y1 = x1 * cs - x2 * sn, y2 = x1 * sn + x2 * cs;
      base[e1] = (bf16)f2bf(y1); base[e2] = (bf16)f2bf(y2);
    }
  }
}
struct Order {
  int nM, nN, nwg, G, c, lat;
  __device__ void init(int nM_, int nN_, int G_, int c_, int lat_) { nM = nM_; nN = nN_; nwg = nM * nN; G = G_; c = c_; lat = lat_; }
  __device__ bool next(int i, pg8::Unit& u) const {
    const long L = (long)i * G + c; if (L >= nwg) return false;
    int wgid = (int)L; { const int q = nwg / 8, r = nwg % 8, xcd = wgid % 8, off = wgid / 8; wgid = (xcd < r ? xcd * (q + 1) : r * (q + 1) + (xcd - r) * q) + off; }
    const int WGM = 8, nig = WGM * nN, gid = wgid / nig, fm = gid * WGM, gsz = (nM - fm) < WGM ? (nM - fm) : WGM;
    int pm = fm + ((wgid % nig) % gsz); u.pn = (wgid % nig) / gsz;
    if (lat) pm = (pm >> 4) * 17 + 1 + (pm & 15);
    u.pm = pm; return true;
  }
  __device__ __forceinline__ void a_ready(const pg8::Unit&) const {}
  __device__ __forceinline__ void done(const pg8::Unit&) const {}
};
struct EpiQKV {
  static constexpr bool PERM = true, AFTER_DRAIN = false;
  unsigned char* ws; LAS float* xs  ; int layer;
  __device__ __forceinline__ void operator()(const pg8::f32x4 (&acc)[2][2][4][2], const pg8::Unit& u, int wr, int wc, int fr, int fq) const {
    const int row0 = u.pm * 256 + wr * 64 + fr;
    const size_t boff = u.pn < 4 ? WS_Q : (u.pn == 4 ? WS_K : WS_V); const int ldc = u.pn < 4 ? DM : NKV * HD, colt = u.pn < 4 ? u.pn * 256 : 0;
    bf16* base = (bf16*)(ws + boff);
    const int col0 = colt + wc * 32 + 8 * fq;
    if (u.pn == 5) {
      unsigned char* vt = ws + WS_V; const int bt = (u.pm * 256) / RPB, key0 = (u.pm * 256) % RPB + wr * 64 + fr;
#pragma unroll
      for (int ai = 0; ai < 2; ++ai)
#pragma unroll
        for (int m = 0; m < 4; ++m) { const int key = key0 + ai * 128 + m * 16;
#pragma unroll
          for (int bj = 0; bj < 2; ++bj) { const pg8::f32x4 v0 = acc[ai][bj][m][0], v1 = acc[ai][bj][m][1];
            int w0 = __builtin_amdgcn_cvt_pk_fp8_f32(v0[0] * att::V8A_SCALE, v0[1] * att::V8A_SCALE, 0, false); w0 = __builtin_amdgcn_cvt_pk_fp8_f32(v0[2] * att::V8A_SCALE, v0[3] * att::V8A_SCALE, w0, true);
            int w1 = __builtin_amdgcn_cvt_pk_fp8_f32(v1[0] * att::V8A_SCALE, v1[1] * att::V8A_SCALE, 0, false); w1 = __builtin_amdgcn_cvt_pk_fp8_f32(v1[2] * att::V8A_SCALE, v1[3] * att::V8A_SCALE, w1, true);
            unsigned char* cp = vt + ((size_t)((bt * 2 + bj) * 128 + wc * 32 + 8 * fq)) * RPB + key;
            cp[0 * RPB] = (unsigned char)(w0 & 0xff); cp[1 * RPB] = (unsigned char)((w0 >> 8) & 0xff); cp[2 * RPB] = (unsigned char)((w0 >> 16) & 0xff); cp[3 * RPB] = (unsigned char)((unsigned)w0 >> 24);
            cp[4 * RPB] = (unsigned char)(w1 & 0xff); cp[5 * RPB] = (unsigned char)((w1 >> 8) & 0xff); cp[6 * RPB] = (unsigned char)((w1 >> 16) & 0xff); cp[7 * RPB] = (unsigned char)((unsigned)w1 >> 24); } }
      return;
    }
#pragma unroll
    for (int ai = 0; ai < 2; ++ai)
#pragma unroll
      for (int m = 0; m < 4; ++m)
#pragma unroll
        for (int bj = 0; bj < 2; ++bj) { const pg8::f32x4 v0 = acc[ai][bj][m][0], v1 = acc[ai][bj][m][1];
          float ss = (v0[0] * v0[0] + v0[1] * v0[1]) + (v0[2] * v0[2] + v0[3] * v0[3]) + (v1[0] * v1[0] + v1[1] * v1[1]) + (v1[2] * v1[2] + v1[3] * v1[3]);
          ss += __shfl_xor(ss, 16); ss += __shfl_xor(ss, 32);
          if (fq == 0) xs[((((wr * 2 + ai) * 4 + m) * 16 + fr) * 2 + bj) * 4 + wc] = ss; }
    asm volatile("s_waitcnt lgkmcnt(0)" ::: "memory"); __builtin_amdgcn_s_barrier(); asm volatile("" ::: "memory");
    const float* rp = (const float*)(ws + WS_ROPE);
    const float* gp = rp + 64 * 32 * 2 + (layer * 2 + (u.pn < 4 ? 0 : 1)) * HD + wc * 32 + 8 * fq;
    const f32x4 g0 = *(const f32x4*)gp, g1 = *(const f32x4*)(gp + 4);
    const bool latent = (u.pm % 17) != 0;
    const int axis = wc >> 1, f0 = 16 * (wc & 1) + 4 * fq;
#pragma unroll
    for (int ai = 0; ai < 2; ++ai)
#pragma unroll
      for (int m = 0; m < 4; ++m) { const int r = row0 + ai * 128 + m * 16;
        f32x4 c01 = {1.f, 0.f, 1.f, 0.f}, c23 = {1.f, 0.f, 1.f, 0.f};
        if (latent) { const int sp = (r % RPB) - CTXL, pos = axis == 0 ? (sp >> 6) : (sp & 63); const float* cp = rp + (pos * 32 + f0) * 2; c01 = *(const f32x4*)cp; c23 = *(const f32x4*)(cp + 4); }
        unsigned char* rowp = (unsigned char*)base + (size_t)r * ldc + col0;
#pragma unroll
        for (int bj = 0; bj < 2; ++bj) { const LAS float* xp = xs + ((((wr * 2 + ai) * 4 + m) * 16 + fr) * 2 + bj) * 4;
          const float rstd = rsqrtf(((xp[0] + xp[1]) + (xp[2] + xp[3])) * (1.f / HD) + RMS_EPS);
          const pg8::f32x4 v0 = acc[ai][bj][m][0], v1 = acc[ai][bj][m][1];
          const float a0 = v0[0] * rstd * g0.x, b0 = v0[1] * rstd * g0.y, a1 = v0[2] * rstd * g0.z, b1 = v0[3] * rstd * g0.w;
          const float a2 = v1[0] * rstd * g1.x, b2 = v1[1] * rstd * g1.y, a3 = v1[2] * rstd * g1.z, b3 = v1[3] * rstd * g1.w;
          constexpr float QS = att::QK8_SCALE;
          int w0 = __builtin_amdgcn_cvt_pk_fp8_f32((a0 * c01.x - b0 * c01.y) * QS, (a0 * c01.y + b0 * c01.x) * QS, 0, false); w0 = __builtin_amdgcn_cvt_pk_fp8_f32((a1 * c01.z - b1 * c01.w) * QS, (a1 * c01.w + b1 * c01.z) * QS, w0, true);
          int w1 = __builtin_amdgcn_cvt_pk_fp8_f32((a2 * c23.x - b2 * c23.y) * QS, (a2 * c23.y + b2 * c23.x) * QS, 0, false); w1 = __builtin_amdgcn_cvt_pk_fp8_f32((a3 * c23.z - b3 * c23.w) * QS, (a3 * c23.w + b3 * c23.z) * QS, w1, true);
          u32x2 w; w.x = (unsigned)w0; w.y = (unsigned)w1; *(u32x2*)(rowp + bj * 128) = w; } }
    asm volatile("s_waitcnt lgkmcnt(0)" ::: "memory"); __builtin_amdgcn_s_barrier(); asm volatile("" ::: "memory");
  }
};
struct EpiRes {
  static constexpr bool PERM = false, AFTER_DRAIN = false;
  const float *xin, *cin; float *xout, *xc; const float* gmod  ;
  __device__ __forceinline__ void operator()(const pg8::f32x4 (&acc)[2][2][4][2], const pg8::Unit& u, int wr, int wc, int fr, int fq) const {
    const int col0 = u.pn * 256 + wc * 32 + 4 * fq;
#pragma unroll
    for (int ai = 0; ai < 2; ++ai)
#pragma unroll
      for (int m = 0; m < 4; ++m) { const int r = u.pm * 256 + ai * 128 + wr * 64 + m * 16 + fr;
        const int b_ = r / RPB, j_ = r % RPB; const size_t oc = (size_t)(b_ * CTXL + j_) * DM, ol = (size_t)(b_ * SEQ + (j_ - CTXL)) * DM;
        float* xn = j_ < CTXL ? xc + oc : xout + ol; const float* xo = j_ < CTXL ? cin + oc : xin + ol; const float* g = gmod + (size_t)(j_ < CTXL ? 4 : b_) * NMOD * DM;
#pragma unroll
        for (int bj = 0; bj < 2; ++bj)
#pragma unroll
          for (int n = 0; n < 2; ++n) { const int c = col0 + bj * 128 + n * 16; const f32x4 xv = *(const f32x4*)(xo + c), gv = *(const f32x4*)(g + c); const pg8::f32x4 a = acc[ai][bj][m][n];
            f32x4 o; o.x = xv.x + gv.x * a[0]; o.y = xv.y + gv.y * a[1]; o.z = xv.z + gv.z * a[2]; o.w = xv.w + gv.w * a[3]; *(f32x4*)(xn + c) = o; } }
  }
};
struct EpiF32 {
  static constexpr bool PERM = true, AFTER_DRAIN = false;
  _Float16* S; int ldc;
  __device__ __forceinline__ void operator()(const pg8::f32x4 (&acc)[2][2][4][2], const pg8::Unit& u, int wr, int wc, int fr, int fq) const {
    typedef _Float16 h8 __attribute__((ext_vector_type(8)));
    const int col0 = u.pn * 256 + wc * 32 + 8 * fq;
#pragma unroll
    for (int ai = 0; ai < 2; ++ai)
#pragma unroll
      for (int m = 0; m < 4; ++m) { _Float16* rowp = S + (size_t)(u.pm * 256 + ai * 128 + wr * 64 + m * 16 + fr) * ldc + col0;
#pragma unroll
        for (int bj = 0; bj < 2; ++bj) { const pg8::f32x4 v0 = acc[ai][bj][m][0], v1 = acc[ai][bj][m][1];
          h8 o; o[0] = (_Float16)v0[0]; o[1] = (_Float16)v0[1]; o[2] = (_Float16)v0[2]; o[3] = (_Float16)v0[3]; o[4] = (_Float16)v1[0]; o[5] = (_Float16)v1[1]; o[6] = (_Float16)v1[2]; o[7] = (_Float16)v1[3];
          *(h8*)(rowp + bj * 128) = o; } }
  }
};

__device__ __forceinline__ void phase_attn(const Ctx& F, int layer) {
  const unsigned char* Q = F.ws + WS_Q; const unsigned char* K = F.ws + WS_K; const unsigned char* V = F.ws + WS_V;
  char* lds = (char*)F.ldsg;
  const int pair = F.bid & 7, slot = F.bid >> 3, nslot = F.G >> 3;
  const int b = pair >> 1, g = pair & 1;
  const unsigned char* Kh = K + (size_t)(b * RPB) * (NKV * HD) + g * HD; const unsigned char* Vh = V + (size_t)((b * 2 + g) * 128) * RPB;
  const float* sinkp = F.in(I_SINKS);
  const int nunits = layer == 0 ? 68 : 64;
#pragma unroll 1
  for (int u = slot; u < nunits; u += nslot) {
    int h, NT, ks = 0, q0 = 0; float sk = 0.f, sk1 = 0.f; const unsigned char* Qb; const bool win = layer != 0;
    if (u < 64) {
      if (!win) { h = g * 4 + (u >> 4); const int qb = u & 15; Qb = Q + (size_t)(b * RPB + CTXL + qb * 256) * DM + h * HD; NT = RPB / 64; }
      else { h = g * 4 + (u >> 5) * 2; q0 = (u & 31) * 128; Qb = Q + (size_t)(b * RPB + CTXL + q0) * DM + h * HD;
        ks = q0 - 128 < 0 ? 0 : q0 - 128; const int ke = q0 + 256 > SEQ ? SEQ : q0 + 256; NT = 4 + (ke - ks) / 64;
        sk = sinkp[(layer / 2) * NH + h] * 1.4426950408889634f; sk1 = sinkp[(layer / 2) * NH + h + 1] * 1.4426950408889634f; } }
    else { h = g * 4 + (u - 64); Qb = Q + (size_t)(b * RPB) * DM + h * HD; NT = CTXL / 64; }
    att::attn_unit(win, Qb, F.ws + WS_O + (Qb - Q), Kh, Vh, NT, ks, q0, sk, sk1, lds);
  }
}

__device__ __forceinline__ void ins16(float (&v)[16], float x) {
#pragma unroll
  for (int i = 0; i < 16; ++i) { const float hi = fmaxf(v[i], x); x = fminf(v[i], x); v[i] = hi; }
}
#define CE_DESC(x, y) do { const float hi_ = fmaxf(x, y), lo_ = fminf(x, y); x = hi_; y = lo_; } while (0)
__device__ __forceinline__ void bitonic_merge16(float (&v)[16]) {
#pragma unroll
  for (int j = 8; j >= 1; j >>= 1)
#pragma unroll
    for (int i = 0; i < 16; ++i) if ((i & j) == 0) CE_DESC(v[i], v[i | j]);
}
__device__ __forceinline__ void bitonic_sort16(float (&v)[16]) {
#pragma unroll
  for (int k = 2; k <= 16; k <<= 1)
#pragma unroll
    for (int j = k >> 1; j >= 1; j >>= 1)
#pragma unroll
      for (int i = 0; i < 16; ++i) { const int l = i ^ j; if (l > i) { if ((i & k) == 0 || k == 16) CE_DESC(v[i], v[l]); else CE_DESC(v[l], v[i]); } }
}
__device__ __forceinline__ void top16_merge(float (&a)[16], const float (&b)[16]) {
#pragma unroll
  for (int i = 0; i < 16; ++i) a[i] = fmaxf(a[i], b[15 - i]);
  bitonic_merge16(a);
}
__device__ __forceinline__ void topk_step1(const LAS float* sc, LAS unsigned* T, int tid) {
  float v[16];
  { const LAS float* my = sc + tid * 65; const unsigned eb = (tid & 1) * 64;
    float g1[16];
#define LOAD16(dst, off) do { _Pragma("unroll") for (int e = 0; e < 16; ++e) dst[e] = __uint_as_float((__float_as_uint(my[(off) + e]) & ~127u) | (eb + (off) + e)); } while (0)
    LOAD16(v, 0); bitonic_sort16(v); LOAD16(g1, 16); bitonic_sort16(g1); top16_merge(v, g1);
    float h1[16];
    LOAD16(h1, 32); bitonic_sort16(h1); LOAD16(g1, 48); bitonic_sort16(g1); top16_merge(h1, g1);
    top16_merge(v, h1);
#undef LOAD16
  }
  { float o[16];
#pragma unroll
    for (int i = 0; i < 16; ++i) o[i] = __shfl_xor(v[i], 1);
    top16_merge(v, o); }
  if ((tid & 1) == 0) {
#pragma unroll
    for (int i = 0; i < 16; ++i) T[(tid >> 1) * 16 + i] = __float_as_uint(v[i]); }
}
__device__ __forceinline__ void topk_step2(const LAS unsigned* T, int p1, int* eout, float* gout) {
  const int p2 = p1 + 16;
  float a[16], bq[16];
#pragma unroll
  for (int i = 0; i < 16; ++i) { a[i] = __uint_as_float(T[p1 + i] & ~127u); bq[i] = __uint_as_float(T[p2 + i] & ~127u); }
  float w[16];
#pragma unroll
  for (int i = 0; i < 16; ++i) w[i] = __uint_as_float((__float_as_uint(a[0] + bq[i]) & ~255u) | (unsigned)i);
  { float r1[16];
#pragma unroll
    for (int i = 0; i < 16; ++i) r1[i] = i < 8 ? __uint_as_float((__float_as_uint(a[1] + bq[i]) & ~255u) | (unsigned)(16 + i)) : -INFINITY;
    top16_merge(w, r1); }
#pragma unroll
  for (int ia = 2; ia < 16; ++ia)
#pragma unroll
    for (int ib = 0; ib < 16; ++ib) if ((ia + 1) * (ib + 1) <= 16) { const float s_ = a[ia] + bq[ib]; ins16(w, __uint_as_float((__float_as_uint(s_) & ~255u) | (unsigned)(ia * 16 + ib))); }
  float ts[16]; int ex[16];
#pragma unroll
  for (int k = 0; k < 16; ++k) { const unsigned id = __float_as_uint(w[k]) & 255u; const unsigned k1 = T[p1 + (id >> 4)], k2 = T[p2 + (id & 15)];
    ts[k] = __uint_as_float(k1 & ~127u) + __uint_as_float(k2 & ~127u); ex[k] = (int)((k1 & 127u) * NKEYS + (k2 & 127u)); }
  float m = ts[0];
#pragma unroll
  for (int k = 1; k < 16; ++k) m = fmaxf(m, ts[k]);
  float l = 0.f;
#pragma unroll
  for (int k = 0; k < 16; ++k) { ts[k] = __expf(ts[k] - m); l += ts[k]; }
  const float il = 1.f / l;
#pragma unroll
  for (int k = 0; k < 16; k += 4) { *(int4*)(eout + k) = make_int4(ex[k], ex[k + 1], ex[k + 2], ex[k + 3]);
    f32x4 gv; gv.x = ts[k] * il; gv.y = ts[k + 1] * il; gv.z = ts[k + 2] * il; gv.w = ts[k + 3] * il; *(f32x4*)(gout + k) = gv; }
}
struct EpiTopk {
  static constexpr bool PERM = false, AFTER_DRAIN = true;
  int* EIDX; float* GATE;
  __device__ __forceinline__ void fused(pg8::f32x4 (&acc)[2][2][4][2], const pg8::Unit& u, int wr, int wc, int fr, int fq, PG8_LAS unsigned char* lds, int wid, int lane) const {
    LAS float* sc = (LAS float*)lds; LAS unsigned* T = (LAS unsigned*)(lds + 512 * 65 * 4);
    const int tid = wid * 64 + lane;
#pragma unroll
    for (int ai = 0; ai < 2; ++ai) {
#pragma unroll
      for (int m = 0; m < 4; ++m) { const int rl = wr * 64 + m * 16 + fr;
#pragma unroll
        for (int bj = 0; bj < 2; ++bj)
#pragma unroll
          for (int n = 0; n < 2; ++n) { const int c = bj * 128 + wc * 32 + n * 16 + fq * 4; LAS float* d = sc + (rl * 4 + (c >> 6)) * 65 + (c & 63); const pg8::f32x4 a = acc[ai][bj][m][n];
            d[0] = a[0]; d[1] = a[1]; d[2] = a[2]; d[3] = a[3]; } }
      asm volatile("s_waitcnt lgkmcnt(0)" ::: "memory"); __builtin_amdgcn_s_barrier(); asm volatile("" ::: "memory");
      topk_step1(sc, T, tid);
      asm volatile("s_waitcnt lgkmcnt(0)" ::: "memory"); __builtin_amdgcn_s_barrier(); asm volatile("" ::: "memory");
      if (tid < 128) { const size_t ob = (size_t)(u.pm * 256 + ai * 128 + tid) * 128 + u.pn * 16; topk_step2(T, tid * 32, EIDX + ob, GATE + ob); }
      asm volatile("s_waitcnt lgkmcnt(0)" ::: "memory"); __builtin_amdgcn_s_barrier(); asm volatile("" ::: "memory");
    }
  }
};
struct OneUnit {
  pg8::Unit u0;
  __device__ bool next(int i, pg8::Unit& u) const { if (i != 0) return false; u = u0; return true; }
  __device__ __forceinline__ void a_ready(const pg8::Unit&) const {}
  __device__ __forceinline__ void done(const pg8::Unit&) const {}
};
__device__ __forceinline__ void phase_topk(const Ctx& F, bool latent_only) {
  LAS float* sc = (LAS float*)F.lds;
  LAS unsigned* T = (LAS unsigned*)(F.lds + 512 * 65 * 4);
  const _Float16* S = (const _Float16*)(F.ws + WS_S); int* EIDX = (int*)(F.ws + WS_EIDX); float* GATE = (float*)(F.ws + WS_GATE);
  const int ngroups = NROWS / 16;
  auto grpok = [&](int gq) { return gq < ngroups && !(latent_only && ((gq * 16) % RPB) < CTXL); };
  int grp = F.bid; while (grp < ngroups && !grpok(grp)) grp += F.G;
  typedef _Float16 h4 __attribute__((ext_vector_type(4)));
  h4 v[16];
  if (grp < ngroups) {
#pragma unroll
    for (int it = 0; it < 16; ++it) v[it] = *(const h4*)(S + (size_t)(grp * 16 + it) * PQN + F.tid * 4); }
  for (; grp < ngroups; ) {
    const int r0 = grp * 16;
    int gn = grp + F.G; while (gn < ngroups && !grpok(gn)) gn += F.G;
#pragma unroll
    for (int it = 0; it < 16; ++it) { const int c = F.tid * 4; LAS float* d = sc + (it * 32 + (c >> 6)) * 65 + (c & 63); d[0] = (float)v[it][0]; d[1] = (float)v[it][1]; d[2] = (float)v[it][2]; d[3] = (float)v[it][3]; }
    if (gn < ngroups) {
#pragma unroll
      for (int it = 0; it < 16; ++it) v[it] = *(const h4*)(S + (size_t)(gn * 16 + it) * PQN + F.tid * 4); }
    __syncthreads();
    float v[16];
    { const LAS float* my = sc + F.tid * 65; const unsigned eb = (F.tid & 1) * 64;
      float g1[16];
#define LOAD16(dst, off) do { _Pragma("unroll") for (int e = 0; e < 16; ++e) dst[e] = __uint_as_float((__float_as_uint(my[(off) + e]) & ~127u) | (eb + (off) + e)); } while (0)
      LOAD16(v, 0); bitonic_sort16(v); LOAD16(g1, 16); bitonic_sort16(g1); top16_merge(v, g1);
      float h1[16];
      LOAD16(h1, 32); bitonic_sort16(h1); LOAD16(g1, 48); bitonic_sort16(g1); top16_merge(h1, g1);
      top16_merge(v, h1);
#undef LOAD16
    }
    { float o[16];
#pragma unroll
      for (int i = 0; i < 16; ++i) o[i] = __shfl_xor(v[i], 1);
      top16_merge(v, o); }
    if ((F.tid & 1) == 0) {
#pragma unroll
      for (int i = 0; i < 16; ++i) T[(F.tid >> 1) * 16 + i] = __float_as_uint(v[i]); }
    __syncthreads();
    if (F.tid < 128) {
      const int rl = F.tid >> 3, head = F.tid & 7, p1 = (rl * 16 + head * 2) * 16, p2 = p1 + 16;
      float a[16], bq[16];
#pragma unroll
      for (int i = 0; i < 16; ++i) { a[i] = __uint_as_float(T[p1 + i] & ~127u); bq[i] = __uint_as_float(T[p2 + i] & ~127u); }
      float w[16];
#pragma unroll
      for (int i = 0; i < 16; ++i) w[i] = __uint_as_float((__float_as_uint(a[0] + bq[i]) & ~255u) | (unsigned)i);
      { float r1[16];
#pragma unroll
        for (int i = 0; i < 16; ++i) r1[i] = i < 8 ? __uint_as_float((__float_as_uint(a[1] + bq[i]) & ~255u) | (unsigned)(16 + i)) : -INFINITY;
        top16_merge(w, r1); }
#pragma unroll
      for (int ia = 2; ia < 16; ++ia)
#pragma unroll
        for (int ib = 0; ib < 16; ++ib) if ((ia + 1) * (ib + 1) <= 16) { const float s = a[ia] + bq[ib]; ins16(w, __uint_as_float((__float_as_uint(s) & ~255u) | (unsigned)(ia * 16 + ib))); }
      float ts[16]; int ex[16];
#pragma unroll
      for (int k = 0; k < 16; ++k) { const unsigned id = __float_as_uint(w[k]) & 255u; const unsigned k1 = T[p1 + (id >> 4)], k2 = T[p2 + (id & 15)];
        ts[k] = __uint_as_float(k1 & ~127u) + __uint_as_float(k2 & ~127u); ex[k] = (int)((k1 & 127u) * NKEYS + (k2 & 127u)); }
      float m = ts[0];
#pragma unroll
      for (int k = 1; k < 16; ++k) m = fmaxf(m, ts[k]);
      float l = 0.f;
#pragma unroll
      for (int k = 0; k < 16; ++k) { ts[k] = __expf(ts[k] - m); l += ts[k]; }
      const float il = 1.f / l; const size_t ob = (size_t)(r0 + rl) * 128 + head * 16;
#pragma unroll
      for (int k = 0; k < 16; k += 4) { *(int4*)(EIDX + ob + k) = make_int4(ex[k], ex[k + 1], ex[k + 2], ex[k + 3]);
        f32x4 gv; gv.x = ts[k] * il; gv.y = ts[k + 1] * il; gv.z = ts[k + 2] * il; gv.w = ts[k + 3] * il; *(f32x4*)(GATE + ob + k) = gv; }
    }
    __syncthreads();
    grp = gn;
  }
}

typedef float f32x2 __attribute__((ext_vector_type(2)));
__device__ __forceinline__ float dpp_ror_add(float x, int) { return x; }
#define ROW_ROR_ADD(x, n) do { const int xi_ = __builtin_bit_cast(int, x); x += __builtin_bit_cast(float, __builtin_amdgcn_update_dpp(0, xi_, 0x120 + (n), 0xf, 0xf, false)); } while (0)
__device__ __forceinline__ float dot16_fp8(u32x4 q, const float* h, float acc) {
  const int q0 = (int)q.x, q1 = (int)q.y, q2 = (int)q.z, q3 = (int)q.w; f32x2 t;
  t = __builtin_amdgcn_cvt_pk_f32_fp8(q0, false); acc = fmaf(t.x, h[0], acc); acc = fmaf(t.y, h[1], acc); t = __builtin_amdgcn_cvt_pk_f32_fp8(q0, true); acc = fmaf(t.x, h[2], acc); acc = fmaf(t.y, h[3], acc);
  t = __builtin_amdgcn_cvt_pk_f32_fp8(q1, false); acc = fmaf(t.x, h[4], acc); acc = fmaf(t.y, h[5], acc); t = __builtin_amdgcn_cvt_pk_f32_fp8(q1, true); acc = fmaf(t.x, h[6], acc); acc = fmaf(t.y, h[7], acc);
  t = __builtin_amdgcn_cvt_pk_f32_fp8(q2, false); acc = fmaf(t.x, h[8], acc); acc = fmaf(t.y, h[9], acc); t = __builtin_amdgcn_cvt_pk_f32_fp8(q2, true); acc = fmaf(t.x, h[10], acc); acc = fmaf(t.y, h[11], acc);
  t = __builtin_amdgcn_cvt_pk_f32_fp8(q3, false); acc = fmaf(t.x, h[12], acc); acc = fmaf(t.y, h[13], acc); t = __builtin_amdgcn_cvt_pk_f32_fp8(q3, true); acc = fmaf(t.x, h[14], acc); acc = fmaf(t.y, h[15], acc);
  return acc;
}
constexpr int PCH = 8;
__device__ __forceinline__ int chunk_row0(unsigned c, bool latent_only) { return latent_only ? (int)(c / (SEQ / PCH)) * RPB + CTXL + (int)(c % (SEQ / PCH)) * PCH : (int)c * PCH; }
#ifndef UREP
#define UREP 1
#endif
#ifndef VREP
#define VREP 1
#endif
__device__ __forceinline__ unsigned xcc_id() { return (unsigned)__builtin_amdgcn_s_getreg((3 << 11) | 20) & 7u; }
__device__ __forceinline__ unsigned q_pull(unsigned* q, int lane) { unsigned c = 0; if (lane == 0) c = __hip_atomic_fetch_add(q, 1u, __ATOMIC_RELAXED, __HIP_MEMORY_SCOPE_AGENT); return (unsigned)__builtin_amdgcn_readfirstlane((int)c); }
__device__ __forceinline__ void phase_peer_u(const Ctx& F, int layer, bool latent_only, int rep) {
  unsigned* qb = (unsigned*)(F.ws + WS_CTL) + 8192 + ((layer * 2 + 0) * 2 + rep) * 8 * 64;
  const int* EIDX = (const int*)(F.ws + WS_EIDX);
  LAS unsigned* lst = (LAS unsigned*)(F.lds + F.wave * 4096);
  LAS float* pl = (LAS float*)(F.lds + F.wave * 4096 + 1024);
  const int g = F.lane >> 3;
  const int i0 = ((F.lane >> 2) & 1) * 8 + ((F.lane >> 1) & 1) * 4 + (F.lane & 1) * 2;
  const int myx = (int)xcc_id();
#pragma unroll 1
  for (int sx = 0; sx < 8; ++sx) {
    const int slice = (myx + sx) & 7;
    const bf16* H = (const bf16*)(F.ws + WS_H) + slice * 128 + (F.lane & 7) * 16;
    const unsigned char* U = F.ws + WS_UT + ((size_t)layer * 8 + slice) * NKEYS * NKEYS * 128; const unsigned uo = (unsigned)(F.lane & 7) * 16u;
    float* PART = (float*)(F.ws + WS_PART) + slice * 128;
    const unsigned nch = (unsigned)((latent_only ? NB * SEQ : NROWS) / PCH);
        unsigned e0, e1; u32x4 h0, h1;
#define UPREF(R) do { e0 = (unsigned)EIDX[(size_t)(R) * 128 + F.lane]; e1 = (unsigned)EIDX[(size_t)(R) * 128 + 64 + F.lane]; h0 = *(const u32x4*)(H + (size_t)(R) * DM); h1 = *(const u32x4*)(H + (size_t)(R) * DM + 8); } while (0)
#define UGATHER(QV, HH, LOFF, RNEXT, HASNEXT) do { lst[(LOFF) + F.lane] = e0; lst[(LOFF) + 64 + F.lane] = e1; \
          HH[0] = bflo(h0.x); HH[1] = bfhi(h0.x); HH[2] = bflo(h0.y); HH[3] = bfhi(h0.y); HH[4] = bflo(h0.z); HH[5] = bfhi(h0.z); HH[6] = bflo(h0.w); HH[7] = bfhi(h0.w); \
          HH[8] = bflo(h1.x); HH[9] = bfhi(h1.x); HH[10] = bflo(h1.y); HH[11] = bfhi(h1.y); HH[12] = bflo(h1.z); HH[13] = bfhi(h1.z); HH[14] = bflo(h1.w); HH[15] = bfhi(h1.w); \
          if (HASNEXT) UPREF(RNEXT); \
          asm volatile("s_waitcnt lgkmcnt(0)" ::: "memory"); \
          _Pragma("unroll") for (int i = 0; i < 16; ++i) QV[i] = *(const u32x4*)(U + (lst[(LOFF) + 8 * i + g] * 128u + uo)); } while (0)
#define UMATH(QV, HH, R) do { float p[16]; \
          _Pragma("unroll") for (int i = 0; i < 16; ++i) p[i] = dot16_fp8(QV[i], HH, 0.f); \
          _Pragma("unroll") for (int m = 4; m >= 1; m >>= 1) { const bool up = (F.lane & m) != 0; const int n = 2 * m; \
            _Pragma("unroll") for (int j = 0; j < n; ++j) { const float send = up ? p[j] : p[j + n], keep = up ? p[j + n] : p[j]; p[j] = keep + __shfl_xor(send, m); } } \
          pl[8 * i0 + g] = p[0]; pl[8 * i0 + 8 + g] = p[1]; \
          asm volatile("s_waitcnt lgkmcnt(0)" ::: "memory"); \
          float* po = PART + (size_t)(R) * 1024 + F.lane; po[0] = pl[F.lane]; po[64] = pl[64 + F.lane]; } while (0)
    unsigned c = q_pull(qb + slice * 64, F.lane);
    if (c < nch) {
      u32x4 qa[16], qb_[16]; float ha[16], hb[16];
      int rbeg = chunk_row0(c, latent_only);
      UPREF(rbeg);
      UGATHER(qa, ha, 0, rbeg + 1, true);
#pragma unroll 1
      while (true) {
        const unsigned cn = q_pull(qb + slice * 64, F.lane);
        const bool hn = cn < nch; const int nr0 = hn ? chunk_row0(cn, latent_only) : 0;
#pragma unroll 1
        for (int it = 0; it < PCH; it += 2) { const int r = rbeg + it; const bool lastp = it + 2 >= PCH;
          UGATHER(qb_, hb, 128, (lastp ? nr0 : r + 2), (!lastp || hn));
          UMATH(qa, ha, r);
          if (!lastp || hn) UGATHER(qa, ha, 0, (lastp ? nr0 + 1 : r + 3), true);
          UMATH(qb_, hb, r + 1);
        }
        if (!hn) break;
        rbeg = nr0;
      }
    }
#undef UPREF
#undef UGATHER
#undef UMATH
  }
}

__device__ __forceinline__ void phase_peer_w(const Ctx& F, bool latent_only) {
  const int gw = F.bid * NWAVES + F.wave, NGW = F.G * NWAVES;
  const float* PART = (const float*)(F.ws + WS_PART); const float* GATE = (const float*)(F.ws + WS_GATE); float* PW = (float*)(F.ws + WS_PW);
  for (int r = gw; r < NROWS; r += NGW) {
    if (latent_only && (r % RPB) < CTXL) continue;
    float a = 0.f, b = 0.f;
#pragma unroll
    for (int x = 0; x < 8; ++x) { a += PART[(size_t)r * 1024 + x * 128 + F.lane]; b += PART[(size_t)r * 1024 + x * 128 + 64 + F.lane]; }
    const size_t o = (size_t)r * 128 + F.lane;
    PW[o] = GATE[o] * gelu_tanh(a * (1.f / U8_SCALE)); PW[o + 64] = GATE[o + 64] * gelu_tanh(b * (1.f / U8_SCALE));
  }
}

__device__ __forceinline__ void phase_peer_v(const Ctx& F, int layer, bool latent_only, int rep) {
  unsigned* qb = (unsigned*)(F.ws + WS_CTL) + 8192 + ((layer * 2 + 1) * 2 + rep) * 8 * 64;
  const int* EIDX = (const int*)(F.ws + WS_EIDX); const float* PW = (const float*)(F.ws + WS_PW);
  const float* g2 = (const float*)(F.ws + WS_MOD) + (size_t)layer * 5 * NMOD * DM + 5 * DM;
  const float* outl = F.outp();
  LAS u32x2* ew = (LAS u32x2*)(F.lds + F.wave * 4096);
  const int g = F.lane >> 3;
  const int myx = (int)xcc_id();
#pragma unroll 1
  for (int sx = 0; sx < 8; ++sx) {
    const int slice = (myx + sx) & 7;
    const unsigned char* V = F.ws + WS_VT + ((size_t)layer * 8 + slice) * NKEYS * NKEYS * 128; const unsigned vo = (unsigned)(F.lane & 7) * 16u;
    const int dl = slice * 128 + (F.lane & 7) * 16 + ((F.lane >> 5) & 1) * 8 + ((F.lane >> 4) & 1) * 4 + ((F.lane >> 3) & 1) * 2;
    const unsigned nch = (unsigned)((latent_only ? NB * SEQ : NROWS) / PCH);
        unsigned ea, eb; float wpa, wpb;
#define VPREF(R) do { const size_t o_ = (size_t)(R) * 128 + F.lane; ea = (unsigned)EIDX[o_]; eb = (unsigned)EIDX[o_ + 64]; wpa = PW[o_]; wpb = PW[o_ + 64]; } while (0)
#define VGATHER(QV, WV, LOFF, RNEXT, HASNEXT) do { \
          { u32x2 t0, t1; t0.x = ea; t0.y = __float_as_uint(wpa); t1.x = eb; t1.y = __float_as_uint(wpb); \
            ew[(LOFF) + F.lane] = t0; ew[(LOFF) + 64 + F.lane] = t1; } \
          if (HASNEXT) VPREF(RNEXT); \
          asm volatile("s_waitcnt lgkmcnt(0)" ::: "memory"); \
          _Pragma("unroll") for (int i = 0; i < 16; ++i) { const u32x2 t = ew[(LOFF) + 8 * i + g]; WV[i] = __uint_as_float(t.y); QV[i] = *(const u32x4*)(V + (t.x * 128u + vo)); } } while (0)
#define VMATH(QV, WV, R) do { float acc[16]; \
          float* x = (float*)xrow_sel(outl, (const float*)(F.ws + WS_XC), (R)); const float* xs = xrow_sel((const float*)(F.ws + WS_XB), (const float*)(F.ws + WS_XCB), (R)); const float* gg = g2 + (size_t)mod_row(R) * NMOD * DM; \
          const f32x2 xv = *(const f32x2*)(xs + dl), gv = *(const f32x2*)(gg + dl); \
          _Pragma("unroll") for (int q = 0; q < 16; ++q) acc[q] = 0.f; \
          _Pragma("unroll") for (int i = 0; i < 16; ++i) { const float w = WV[i]; const int q0 = (int)QV[i].x, q1 = (int)QV[i].y, q2 = (int)QV[i].z, q3 = (int)QV[i].w; f32x2 f; \
            f = __builtin_amdgcn_cvt_pk_f32_fp8(q0, false); acc[0] = fmaf(w, f.x, acc[0]); acc[1] = fmaf(w, f.y, acc[1]); f = __builtin_amdgcn_cvt_pk_f32_fp8(q0, true); acc[2] = fmaf(w, f.x, acc[2]); acc[3] = fmaf(w, f.y, acc[3]); \
            f = __builtin_amdgcn_cvt_pk_f32_fp8(q1, false); acc[4] = fmaf(w, f.x, acc[4]); acc[5] = fmaf(w, f.y, acc[5]); f = __builtin_amdgcn_cvt_pk_f32_fp8(q1, true); acc[6] = fmaf(w, f.x, acc[6]); acc[7] = fmaf(w, f.y, acc[7]); \
            f = __builtin_amdgcn_cvt_pk_f32_fp8(q2, false); acc[8] = fmaf(w, f.x, acc[8]); acc[9] = fmaf(w, f.y, acc[9]); f = __builtin_amdgcn_cvt_pk_f32_fp8(q2, true); acc[10] = fmaf(w, f.x, acc[10]); acc[11] = fmaf(w, f.y, acc[11]); \
            f = __builtin_amdgcn_cvt_pk_f32_fp8(q3, false); acc[12] = fmaf(w, f.x, acc[12]); acc[13] = fmaf(w, f.y, acc[13]); f = __builtin_amdgcn_cvt_pk_f32_fp8(q3, true); acc[14] = fmaf(w, f.x, acc[14]); acc[15] = fmaf(w, f.y, acc[15]); } \
          _Pragma("unroll") for (int j = 0; j < 8; ++j) { auto s2 = __builtin_amdgcn_permlane32_swap(__float_as_uint(acc[j]), __float_as_uint(acc[j + 8]), false, false); acc[j] = __uint_as_float(s2[0]) + __uint_as_float(s2[1]); } \
          _Pragma("unroll") for (int j = 0; j < 4; ++j) { auto s2 = __builtin_amdgcn_permlane16_swap(__float_as_uint(acc[j]), __float_as_uint(acc[j + 4]), false, false); acc[j] = __uint_as_float(s2[0]) + __uint_as_float(s2[1]); } \
          { const bool up = (F.lane & 8) != 0; \
            _Pragma("unroll") for (int j = 0; j < 2; ++j) { const float send = up ? acc[j] : acc[j + 2], keep = up ? acc[j + 2] : acc[j]; acc[j] = keep + __shfl_xor(send, 8); } } \
          f32x2 o; o.x = xv.x + gv.x * acc[0] * (1.f / V8_SCALE); o.y = xv.y + gv.y * acc[1] * (1.f / V8_SCALE); \
          *(f32x2*)(x + dl) = o; } while (0)
    unsigned c = q_pull(qb + slice * 64, F.lane);
    if (c < nch) {
      u32x4 qa[16], qb_[16]; float wa[16], wb[16];
      int rbeg = chunk_row0(c, latent_only);
      VPREF(rbeg);
      VGATHER(qa, wa, 0, rbeg + 1, true);
#pragma unroll 1
      while (true) {
        const unsigned cn = q_pull(qb + slice * 64, F.lane);
        const bool hn = cn < nch; const int nr0 = hn ? chunk_row0(cn, latent_only) : 0;
#pragma unroll 1
        for (int it = 0; it < PCH; it += 2) { const int r = rbeg + it; const bool lastp = it + 2 >= PCH;
          VGATHER(qb_, wb, 128, (lastp ? nr0 : r + 2), (!lastp || hn));
          VMATH(qa, wa, r);
          if (!lastp || hn) VGATHER(qa, wa, 0, (lastp ? nr0 + 1 : r + 3), true);
          VMATH(qb_, wb, r + 1);
        }
        if (!hn) break;
        rbeg = nr0;
      }
    }
#undef VPREF
#undef VGATHER
#undef VMATH
  }
}

#define XB_TMO      128
#define XB_XCNT(j)  (256  + 64 * (j))
#define XB_XSUB(j)  (1280 + 64 * (j))
#define XB_XGEN(j)  (2304 + 64 * (j))
#define XB_TOP      3328
#define XB_TOPGEN   3392
#define XCD_BAR_WORDS 3456
#define XB_SPIN_CAP (1u << 18)

__device__ __forceinline__ unsigned xb_ld(unsigned* p)              { return __hip_atomic_load(p, __ATOMIC_RELAXED, __HIP_MEMORY_SCOPE_AGENT); }
__device__ __forceinline__ unsigned xb_add(unsigned* p, unsigned v) { return __hip_atomic_fetch_add(p, v, __ATOMIC_RELAXED, __HIP_MEMORY_SCOPE_AGENT); }
__device__ __forceinline__ unsigned xb_xcc_id() { return (unsigned)__builtin_amdgcn_s_getreg((3 << 11) | 20) & 0xFu; }
#define XB_SPIN(cond, bar) do { unsigned _sp = 0; while (cond) { __builtin_amdgcn_s_sleep(1); \
    if ((++_sp & 255u) == 0u) { if (xb_ld(&(bar)[XB_TMO])) break; if (_sp > XB_SPIN_CAP) { atomicAdd(&(bar)[XB_TMO], 1u); break; } } } } while (0)

struct XcdBarrier {
    unsigned* bar; unsigned x;
    volatile LAS unsigned* st;
};

__device__ __forceinline__ XcdBarrier xcd_barrier_post(unsigned* bar, volatile LAS unsigned* st) {
    XcdBarrier b; b.bar = bar; b.x = xb_xcc_id(); b.st = st;
    if (threadIdx.x == 0) (void)xb_add(&bar[XB_XCNT(b.x)], 1u);
    return b;
}
__device__ __forceinline__ void xcd_barrier_complete(unsigned* bar, unsigned x, unsigned& nloc, unsigned& nx) {
    const unsigned G = gridDim.x * gridDim.y * gridDim.z;
    unsigned sum, cnt, mine, sp = 0u;
    for (;;) {
        sum = 0u; cnt = 0u; mine = 0u;
#pragma unroll
        for (unsigned j = 0; j < 16; ++j) { const unsigned c = xb_ld(&bar[XB_XCNT(j)]); sum += c; cnt += (c > 0u) ? 1u : 0u; mine = (j == x) ? c : mine; }
        if (sum == G) break;
        __builtin_amdgcn_s_sleep(1);
        if ((++sp & 255u) == 0u) { if (xb_ld(&bar[XB_TMO])) break; if (sp > XB_SPIN_CAP) { atomicAdd(&bar[XB_TMO], 1u); break; } }
    }
    nloc = mine > 0u ? mine : 1u; nx = cnt > 0u ? cnt : 1u;
}

__device__ __forceinline__ void xcd_barrier(const XcdBarrier& b) {
    asm volatile("s_waitcnt vmcnt(0)" ::: "memory");
    __syncthreads();
    if (threadIdx.x == 0) {
        unsigned* bar = b.bar;
        __builtin_amdgcn_s_waitcnt(0);
        unsigned nloc = b.st[0], nx = b.st[1];
        if (nloc == 0u) { xcd_barrier_complete(bar, b.x, nloc, nx); b.st[0] = nloc; b.st[1] = nx; }
        const unsigned old = xb_add(&bar[XB_XSUB(b.x)], 1u);
        const unsigned gen = old / nloc;
        if (old + 1u == (gen + 1u) * nloc) {
            __builtin_amdgcn_fence(__ATOMIC_RELEASE, "agent");
            asm volatile("s_waitcnt vmcnt(0)" ::: "memory");
            const unsigned og = xb_add(&bar[XB_TOP], 1u);
            const unsigned tg = og / nx;
            if (og + 1u == (tg + 1u) * nx) xb_add(&bar[XB_TOPGEN], 1u);
            else XB_SPIN(xb_ld(&bar[XB_TOPGEN]) == tg, bar);
            __builtin_amdgcn_fence(__ATOMIC_ACQUIRE, "agent");
            xb_add(&bar[XB_XGEN(b.x)], 1u);
            asm volatile("s_waitcnt vmcnt(0)" ::: "memory");
        } else {
            XB_SPIN(xb_ld(&bar[XB_XGEN(b.x)]) == gen, bar);
            __builtin_amdgcn_fence(__ATOMIC_ACQUIRE, "agent");
            asm volatile("s_waitcnt vmcnt(0)" ::: "memory");
        }
    }
    __syncthreads();
}


__global__ void __launch_bounds__(NTHR, 2) fwd(Args args) {
  extern __shared__ __attribute__((aligned(16))) unsigned char lds[];
  Ctx F;
  F.ws = args.ws; F.tid = threadIdx.x; F.lane = F.tid & 63; F.wave = __builtin_amdgcn_readfirstlane(F.tid >> 6); F.bid = blockIdx.x; F.G = gridDim.x;
  F.lds = (LAS unsigned char*)lds; F.ldsg = lds;
  if (F.tid < 18) { const unsigned long long p = F.tid < 17 ? (unsigned long long)args.in[F.tid] : (unsigned long long)args.out; ((LAS unsigned long long*)(F.lds + PTAB_OFF))[F.tid] = p; }
  __syncthreads();
  const int lo = args.ph_lo, hi = args.ph_hi;
#ifndef PHMASK
#define PHMASK 0x7ff
#endif
#define IN(k) (lo <= (k) && (k) < hi)
#define EN(b) ((PHMASK >> (b)) & 1)
#ifndef REPMASK
#define REPMASK 0
#endif
#define NREP(b) (1 + ((REPMASK >> (b)) & 1))
#define FRESH() do { int t_ = threadIdx.x; asm volatile("" : "+v"(t_)); F.tid = t_; F.lane = t_ & 63; F.wave = __builtin_amdgcn_readfirstlane(t_ >> 6); int b_ = blockIdx.x; asm volatile("" : "+s"(b_)); F.bid = b_; } while (0)
  if (F.tid < 4) ((LAS unsigned*)(F.lds + PTAB_OFF + 256))[F.tid] = 0u;
  __syncthreads();
  XcdBarrier xb; xb.bar = (unsigned*)(F.ws + WS_CTL) + 4096; xb.x = 0; xb.st = nullptr;
  if (hi - lo > 1) xb = xcd_barrier_post((unsigned*)(F.ws + WS_CTL) + 4096, (volatile LAS unsigned*)(F.lds + PTAB_OFF + 256));
#ifndef SEAM_CG_ALL
#define SEAM_CG_ALL 0
#endif
#ifndef XTRA_BAR
#define XTRA_BAR 0
#endif
#ifndef STAMPS
#define STAMPS 0
#endif
#define SEAM(k) do { if (STAMPS && blockIdx.x == 0 && threadIdx.x == 0) ((unsigned long long*)(F.ws + WS_CTL + 61440))[(k)] = __builtin_amdgcn_s_memrealtime(); if (IN(k) && IN((k) + 1)) { if (SEAM_CG_ALL) cg::this_grid().sync(); else { xcd_barrier(xb); for (int xb_ = 0; xb_ < XTRA_BAR; ++xb_) xcd_barrier(xb); } } } while (0)
  if (STAMPS && blockIdx.x == 0 && threadIdx.x == 0) ((unsigned long long*)(F.ws + WS_CTL + 61440))[63] = __builtin_amdgcn_s_memrealtime();
  if (EN(10) && IN(0)) for (int rep_ = 0; rep_ < NREP(10); ++rep_) { FRESH(); phase_prologue(F); } SEAM(0);
#pragma unroll 1
  for (int layer = 0; layer < DEPTH; ++layer) {
    const int pb = 1 + 11 * layer; const bool last = layer == DEPTH - 1;
    const float* modl = (const float*)(F.ws + WS_MOD) + (size_t)layer * 5 * NMOD * DM;
    if (EN(0) && IN(pb + 0)) for (int rep_ = 0; rep_ < NREP(0); ++rep_) { FRESH(); phase_norm(F, layer, 0, layer == 0 ? 0 : 2, false); } SEAM(pb + 0);
    if (EN(1) && IN(pb + 1)) for (int rep_ = 0; rep_ < NREP(1); ++rep_) { FRESH(); pg8::Gemm g{(const pg8::bf16_t*)(F.ws + WS_H), (const pg8::bf16_t*)(F.ws + WS_WQKV + (size_t)layer * QKVD * DM), NROWS, QKVD, DM};
      Order S; S.init(NROWS / 256, QKVD / 256, F.G, F.bid, 0); EpiQKV E{F.ws, (LAS float*)(F.lds + 131072), layer};
      pg8::gemm_phase<EpiQKV, Order, true, true, true, 0x7d7d7d7d  , 0x7a7a7a7a  >(F.lds, g, S, E);
      if (layer == 0) { int lo_, hi_; conv_slot(F, 0, lo_, hi_); convert_rows(F, lo_, hi_); } } SEAM(pb + 1);
    if (EN(2) && IN(pb + 2)) for (int rep_ = 0; rep_ < NREP(2); ++rep_) { }
    if (EN(3) && IN(pb + 3)) for (int rep_ = 0; rep_ < NREP(3); ++rep_) { FRESH(); phase_attn(F, layer); } SEAM(pb + 3);
    if (EN(4) && IN(pb + 4)) for (int rep_ = 0; rep_ < NREP(4); ++rep_) { FRESH(); pg8::Gemm g{(const pg8::bf16_t*)(F.ws + WS_O), (const pg8::bf16_t*)(F.ws + WS_WO + (size_t)layer * DM * DM), NROWS, DM, DM, 0x79797979  , 0x7a7a7a7a  };
      Order S; S.init(last ? NB * 16 : NROWS / 256, DM / 256, F.G, F.bid, last ? 1 : 0); EpiRes E{st_lat(F, layer == 0 ? 0 : 2), st_ctx(F, layer == 0 ? 0 : 2), (float*)(F.ws + WS_XB), (float*)(F.ws + WS_XCB), modl + 2 * DM};
      pg8::gemm_phase<EpiRes, Order, true, true, true, 0x79797979  , 0x7a7a7a7a  >(F.lds, g, S, E);
      if (layer == 0) { int lo_, hi_; conv_slot(F, 1, lo_, hi_); convert_rows(F, lo_, hi_); } } SEAM(pb + 4);
    if (EN(5) && IN(pb + 5)) for (int rep_ = 0; rep_ < NREP(5); ++rep_) { FRESH(); phase_norm(F, layer, 1, 1, last); } SEAM(pb + 5);
    if (EN(6) && IN(pb + 6)) for (int rep_ = 0; rep_ < NREP(6); ++rep_) { FRESH(); pg8::Gemm g{(const pg8::bf16_t*)(F.ws + WS_H), (const pg8::bf16_t*)(F.ws + WS_WP) + (size_t)layer * PQN * DM, NROWS, PQN, DM};
      Order S; S.init(last ? NB * 16 : NROWS / 256, PQN / 256, F.G, F.bid, last ? 1 : 0); EpiTopk E{(int*)(F.ws + WS_EIDX), (float*)(F.ws + WS_GATE)};
#pragma unroll 1
      for (int ui = 0; ; ++ui) { OneUnit S1; if (!S.next(ui, S1.u0)) break; pg8::gemm_phase<EpiTopk, OneUnit, false, true>(F.lds, g, S1, E); }
      if (layer == 0) { int lo_, hi_; conv_slot(F, 2, lo_, hi_); convert_rows(F, lo_, hi_); } } SEAM(pb + 6);
    if (EN(7) && IN(pb + 7)) for (int rep_ = 0; rep_ < NREP(7); ++rep_) { }
    if (EN(8) && IN(pb + 8)) for (int rep_ = 0; rep_ < NREP(8); ++rep_) { FRESH(); phase_peer_u(F, layer, last, rep_); } SEAM(pb + 8);
    if (EN(9) && IN(pb + 9)) { FRESH(); phase_peer_w(F, last); } SEAM(pb + 9);
    if (EN(9) && IN(pb + 10)) for (int rep_ = 0; rep_ < NREP(9); ++rep_) { FRESH(); phase_peer_v(F, layer, last, rep_); } if (!last) SEAM(pb + 10);
  }
  if (STAMPS && blockIdx.x == 0 && threadIdx.x == 0) ((unsigned long long*)(F.ws + WS_CTL + 61440))[NPHASE - 1] = __builtin_amdgcn_s_memrealtime();
#undef IN
#undef SEAM
}
}

#ifndef MK_MULTI
#define MK_MULTI 0
#endif
#ifndef DBG
#define DBG 0
#endif
#ifndef TS_A
#define TS_A 0
#endif
#ifndef TS_B
#define TS_B 4
#endif
namespace dbg {
__global__ void k_ts(const unsigned long long* ts, float* res) { const unsigned long long s0 = ts[63]; auto dur = [&](int k) { const unsigned long long e = ts[k], b = k == 0 ? s0 : ts[k - 1]; return (float)(e - b) * 0.01f; };
  res[0] = dur(TS_A) * 1e-5f; res[1] = dur(TS_B) * 1e-3f; res[2] = 0.f; }
template <bool ABF>
__global__ void __launch_bounds__(1024) k_cmp(const void* __restrict__ a, long lda, long aoff, const float* __restrict__ b, long ldb, long boff, int rows, int cols, int row0, int rstep_lat  , float* res) {
  __shared__ float sd[1024], sr[1024];
  float d2 = 0.f, r2 = 0.f;
  for (long e = threadIdx.x; e < (long)rows * cols; e += 1024) { const int r = row0 + (int)(e / cols), c = (int)(e % cols);
    if (rstep_lat == 1 && (r % RPB) < CTXL) continue; if (rstep_lat == 2 && (r % RPB) >= CTXL) continue;
    float av; if (ABF) av = __uint_as_float((unsigned)((const unsigned short*)a)[(long)r * lda + aoff + c] << 16); else av = ((const float*)a)[(long)r * lda + aoff + c];
    const float bv = b[(long)r * ldb + boff + c]; d2 += (av - bv) * (av - bv); r2 += bv * bv; }
  sd[threadIdx.x] = d2; sr[threadIdx.x] = r2; __syncthreads();
  for (int o = 512; o > 0; o >>= 1) { if ((int)threadIdx.x < o) { sd[threadIdx.x] += sd[threadIdx.x + o]; sr[threadIdx.x] += sr[threadIdx.x + o]; } __syncthreads(); }
  if (threadIdx.x == 0) *res = sqrtf(sd[0] / fmaxf(sr[0], 1e-30f));
}
__global__ void __launch_bounds__(1024) k_cmp8(const unsigned char* __restrict__ a, long lda, float ascale, const float* __restrict__ b, long ldb, long boff, int rows, int cols, int mode, float* res) {
  __shared__ float sd[1024], sr[1024]; float d2 = 0.f, r2 = 0.f; typedef float f2_t __attribute__((ext_vector_type(2)));
  for (long e = threadIdx.x; e < (long)rows * cols; e += 1024) { const int r = (int)(e / cols), c = (int)(e % cols);
    if (mode == 1 && (r % RPB) < CTXL) continue; if (mode == 2 && (r % RPB) >= CTXL) continue;
    const f2_t t = __builtin_amdgcn_cvt_pk_f32_fp8((int)a[(long)r * lda + c], false); const float av = t.x / ascale, bv = b[(long)r * ldb + boff + c]; d2 += (av - bv) * (av - bv); r2 += bv * bv; }
  sd[threadIdx.x] = d2; sr[threadIdx.x] = r2; __syncthreads();
  for (int o = 512; o > 0; o >>= 1) { if ((int)threadIdx.x < o) { sd[threadIdx.x] += sd[threadIdx.x + o]; sr[threadIdx.x] += sr[threadIdx.x + o]; } __syncthreads(); }
  if (threadIdx.x == 0) *res = sqrtf(sd[0] / fmaxf(sr[0], 1e-30f));
}
__global__ void __launch_bounds__(1024) k_cmp_scores(const float* __restrict__ S, const float* __restrict__ PQ, const float* __restrict__ SK, int nrows, float* res) {
  __shared__ float sd[1024], sr[1024];
  float d2 = 0.f, r2 = 0.f;
  for (long e = threadIdx.x; e < (long)nrows * PQN; e += 1024) { const int r = (int)(e / PQN), c = (int)(e % PQN), h = c >> 8, half = (c >> 7) & 1, k = c & 127;
    const float* q = PQ + (long)r * PQN + h * PQD + half * 128; const float* kp = SK + (long)half * NKEYS * 128 + (long)k * 128; float a = 0.f; for (int d = 0; d < 128; ++d) a += q[d] * kp[d];
    const float f = S[(long)r * PQN + c]; d2 += (f - a) * (f - a); r2 += a * a; }
  sd[threadIdx.x] = d2; sr[threadIdx.x] = r2; __syncthreads();
  for (int o = 512; o > 0; o >>= 1) { if ((int)threadIdx.x < o) { sd[threadIdx.x] += sd[threadIdx.x + o]; sr[threadIdx.x] += sr[threadIdx.x + o]; } __syncthreads(); }
  if (threadIdx.x == 0) *res = sqrtf(sd[0] / fmaxf(sr[0], 1e-30f));
}
__global__ void k_final(float* out, long n, const float* res) {
  const float sa = 1.f + 10.f * res[0];
  for (long i = blockIdx.x * 256L + threadIdx.x; i < n; i += gridDim.x * 256L) out[i] *= sa;
  if (blockIdx.x == 0 && threadIdx.x == 0) { }
}
__global__ void k_final2(float* out, const float* res) { out[0] += 1000.f * (res[1] + res[2]); }
}

__global__ void __launch_bounds__(1024) k_cmp_w8(const unsigned char* W8, const float* W, float* res) {
  __shared__ float sd[1024], sr[1024]; float d2 = 0.f, r2 = 0.f; typedef float f2_t __attribute__((ext_vector_type(2)));
  for (long e = threadIdx.x; e < (long)DEPTH * DM * DM; e += 1024) { const int k = (int)(e & 1023), n = (int)((e >> 10) & 1023), l = (int)(e >> 20);
    const f2_t t = __builtin_amdgcn_cvt_pk_f32_fp8((int)W8[e], false); const float av = t.x / 32.f, bv = W[(size_t)l * DM * DM + (size_t)k * DM + n]; d2 += (av - bv) * (av - bv); r2 += bv * bv; }
  sd[threadIdx.x] = d2; sr[threadIdx.x] = r2; __syncthreads();
  for (int o = 512; o > 0; o >>= 1) { if ((int)threadIdx.x < o) { sd[threadIdx.x] += sd[threadIdx.x + o]; sr[threadIdx.x] += sr[threadIdx.x + o]; } __syncthreads(); }
  if (threadIdx.x == 0) { res[0] = sqrtf(sd[0] / fmaxf(sr[0], 1e-30f)); res[1] = 0.f; res[2] = 0.f; }
}


__global__ void __launch_bounds__(1024) k_cmp_wo8(const unsigned char* O8, const unsigned char* W8, const float* XB, const float* xin, const float* g1  , int r0, float* res) {
  __shared__ float sd[1024], sr[1024]; float d2 = 0.f, r2 = 0.f;
  typedef float f2_t __attribute__((ext_vector_type(2)));
  for (int e = threadIdx.x; e < 64 * DM; e += 1024) { const int r = r0 + (e >> 10), n = e & 1023; const int b = r / RPB, j = r % RPB;
    float ref = 0.f; for (int k = 0; k < DM; k += 4) { const int qa = *(const int*)(O8 + (size_t)r * DM + k), qw = *(const int*)(W8 + (size_t)n * DM + k);
      const f2_t a0 = __builtin_amdgcn_cvt_pk_f32_fp8(qa, false), a1 = __builtin_amdgcn_cvt_pk_f32_fp8(qa, true), w0 = __builtin_amdgcn_cvt_pk_f32_fp8(qw, false), w1 = __builtin_amdgcn_cvt_pk_f32_fp8(qw, true);
      ref += a0.x * w0.x + a0.y * w0.y + a1.x * w1.x + a1.y * w1.y; }
    ref *= 1.f / (64.f * 32.f);
    const size_t ol = (size_t)(b * SEQ + (j - CTXL)) * DM + n; const float fast = (XB[ol] - xin[ol]) / g1[(size_t)b * NMOD * DM + n];
    d2 += (fast - ref) * (fast - ref); r2 += ref * ref; }
  sd[threadIdx.x] = d2; sr[threadIdx.x] = r2; __syncthreads();
  for (int o = 512; o > 0; o >>= 1) { if ((int)threadIdx.x < o) { sd[threadIdx.x] += sd[threadIdx.x + o]; sr[threadIdx.x] += sr[threadIdx.x + o]; } __syncthreads(); }
  if (threadIdx.x == 0) { res[0] = sqrtf(sd[0] / fmaxf(sr[0], 1e-30f)); res[1] = 0.f; res[2] = 0.f; }
}


__global__ void k_mfma8_test(float* res) {
  typedef int i32x8_t __attribute__((ext_vector_type(8))); typedef float f32x4_t __attribute__((ext_vector_type(4)));
  __shared__ float A[16][128], B[128][16]; __shared__ int bad; __shared__ float mx;
  const int l = threadIdx.x;
  for (int e = l; e < 16 * 128; e += 64) { const int i = e >> 7, k = e & 127; A[i][k] = (float)(((i * 7 + k * 3) % 5) - 2); B[k][i] = (float)(((i * 5 + k * 11) % 7) - 3); }
  if (l == 0) { bad = 0; mx = 0.f; }
  __syncthreads();
  i32x8_t a, b;
  for (int q = 0; q < 8; ++q) { int va = 0, vb = 0; const int k0 = 32 * (l >> 4) + 4 * q;
    va = __builtin_amdgcn_cvt_pk_fp8_f32(A[l & 15][k0] * 4.f, A[l & 15][k0 + 1] * 4.f, 0, false); va = __builtin_amdgcn_cvt_pk_fp8_f32(A[l & 15][k0 + 2] * 4.f, A[l & 15][k0 + 3] * 4.f, va, true);
    vb = __builtin_amdgcn_cvt_pk_fp8_f32(B[k0][l & 15] * 8.f, B[k0 + 1][l & 15] * 8.f, 0, false); vb = __builtin_amdgcn_cvt_pk_fp8_f32(B[k0 + 2][l & 15] * 8.f, B[k0 + 3][l & 15] * 8.f, vb, true);
    a[q] = va; b[q] = vb; }
  f32x4_t c = {0.f, 0.f, 0.f, 0.f};
  c = __builtin_amdgcn_mfma_scale_f32_16x16x128_f8f6f4(a, b, c, 0, 0, 0, 0x7d7d7d7d  , 0, 0x7c7c7c7c  );
  for (int r = 0; r < 4; ++r) { const int row = 4 * (l >> 4) + r, col = l & 15; float ref = 0.f; for (int k = 0; k < 128; ++k) ref += A[row][k] * B[k][col];
    const float d = fabsf(c[r] - ref); if (d > 1e-3f) atomicAdd(&bad, 1); atomicMax((int*)&mx, __float_as_int(d)); }
  __syncthreads();
  if (l == 0) { res[0] = (float)bad / 256.f; res[1] = mx * 1e-3f; res[2] = 0.f; }
}


static void run_naive(void* const* d_in, float* out, char* ws, hipStream_t stream, int slayer, int stop) {
  const float* x = (const float*)d_in[0]; const float* c = (const float*)d_in[1]; const float* ctx = (const float*)d_in[2]; const float* c_ctx = (const float*)d_in[3];
  const float* ada_w = (const float*)d_in[4]; const float* ada_b = (const float*)d_in[5]; const float* n1g = (const float*)d_in[6]; const float* n2g = (const float*)d_in[7];
  const float* w_qkv = (const float*)d_in[8]; const float* qng = (const float*)d_in[9]; const float* kng = (const float*)d_in[10]; const float* w_o = (const float*)d_in[11];
  const float* sinks = (const float*)d_in[12]; const float* pwq = (const float*)d_in[13]; const float* psk = (const float*)d_in[14]; const float* pu = (const float*)d_in[15];
  const float* pv = (const float*)d_in[16];
  constexpr size_t MiB = 1u << 20;
  float* MOD = (float*)(ws + 0); float* XC = (float*)(ws + 1 * MiB); int* EIDX = (int*)(ws + 6 * MiB); float* GATE = (float*)(ws + 15 * MiB); float* PW = (float*)(ws + 24 * MiB);
  float* H = (float*)(ws + 34 * MiB); float* QKV = (float*)(ws + 104 * MiB); float* O = (float*)(ws + 242 * MiB); float* PQ = QKV;
  hipFuncSetAttribute((const void*)nv::k_attn, hipFuncAttributeMaxDynamicSharedMemorySize, (4 * RPB + 4 * HD) * 4);
  hipMemcpyAsync(out, x, (size_t)NB * SEQ * DM * 4, hipMemcpyDeviceToDevice, stream);
  hipMemcpyAsync(XC, ctx, (size_t)NB * CTXL * DM * 4, hipMemcpyDeviceToDevice, stream);
  nv::k_mod<<<(DEPTH * 5 * NMOD * DM + 255) / 256, 256, 0, stream>>>(c, c_ctx, ada_w, ada_b, MOD);
  for (int i = 0; i < DEPTH; ++i) {
#define STOP(k) if (i == slayer && stop == (k)) return
    const bool last = i == DEPTH - 1; const float* modi = MOD + (size_t)i * 5 * NMOD * DM;
    STOP(1); nv::k_norm<<<NROWS, 256, 0, stream>>>(out, XC, n1g + i * DM, modi, 0, 1, H);
    STOP(2); nv::k_gemm<0><<<dim3(QKVD / 64, NROWS / 64), 256, 0, stream>>>(H, w_qkv + (size_t)i * DM * QKVD, QKV, NROWS, QKVD, DM, nullptr, nullptr, nullptr, 0, 0);
    STOP(3); nv::k_qknorm_rope<<<NROWS, 640, 0, stream>>>(QKV, qng + i * HD, kng + i * HD);
    STOP(4); const size_t shm = (4 * RPB + 4 * HD) * 4;
    if (i % 2 == 0) { nv::k_attn<<<dim3(NB * SEQ, NKV), 256, shm, stream>>>(QKV, 0, nullptr); if (!last) nv::k_attn<<<dim3(NB * CTXL, NKV), 256, shm, stream>>>(QKV, 1, nullptr); }
    else { nv::k_attn<<<dim3(NB * SEQ, NKV), 256, shm, stream>>>(QKV, 2, sinks + (i / 2) * NH); }
    STOP(5); nv::k_copy_o<<<NROWS, 256, 0, stream>>>(QKV, O);
    nv::k_gemm<1><<<dim3(DM / 64, NROWS / 64), 256, 0, stream>>>(O, w_o + (size_t)i * DM * DM, nullptr, NROWS, DM, DM, out, XC, modi, 2, last ? 1 : 0);
    STOP(6); nv::k_norm<<<NROWS, 256, 0, stream>>>(out, XC, n2g + i * DM, modi, 3, 4, H);
    STOP(7); nv::k_gemm<0><<<dim3(PQN / 64, NROWS / 64), 256, 0, stream>>>(H, pwq + (size_t)i * DM * PQN, PQ, NROWS, PQN, DM, nullptr, nullptr, nullptr, 0, 0);
    STOP(8); nv::k_peer_topk<<<NROWS, 256, 0, stream>>>(PQ, psk + (size_t)i * 2 * NKEYS * 128, EIDX, GATE);
    STOP(9); nv::k_peer_u<<<NROWS, 256, 0, stream>>>(H, pu + (size_t)i * NKEYS * NKEYS * DM, EIDX, GATE, PW);
    STOP(10); nv::k_peer_v<<<NROWS, 256, 0, stream>>>(pv + (size_t)i * NKEYS * NKEYS * DM, EIDX, PW, out, XC, modi, 5, last ? 1 : 0);
#undef STOP
  }
}

extern "C" void kernel_launch(void* const* d_in, const int* in_sizes, int n_in, void* d_out, int out_size, void* d_ws, size_t ws_size, hipStream_t stream) {
  static int grid = 0;
  if (grid == 0) {
    if (n_in != 17 || out_size != NB * SEQ * DM || ws_size < mk::WS_END) { fprintf(stderr, "kernel_launch: unexpected shapes (n_in %d out %d ws %zu)\n", n_in, out_size, ws_size); grid = -1; return; }
    int dev = 0, cus = 0, per_cu = 0;
    hipGetDevice(&dev); hipDeviceGetAttribute(&cus, hipDeviceAttributeMultiprocessorCount, dev);
    if (hipFuncSetAttribute((const void*)mk::fwd, hipFuncAttributeMaxDynamicSharedMemorySize, mk::LDS_BYTES) != hipSuccess) { fprintf(stderr, "kernel_launch: hipFuncSetAttribute failed\n"); grid = -1; return; }
    if (hipOccupancyMaxActiveBlocksPerMultiprocessor(&per_cu, (const void*)mk::fwd, mk::NTHR, mk::LDS_BYTES) != hipSuccess || per_cu < 1) { fprintf(stderr, "kernel_launch: occupancy query failed (%d)\n", per_cu); grid = -1; return; }
    grid = cus * 1;
    grid -= grid % 8;
  }
  if (grid < 0) return;
  mk::Args a{};
  for (int i = 0; i < 17; ++i) a.in[i] = (const float*)d_in[i];
  a.out = (float*)d_out; a.ws = (unsigned char*)d_ws;
#if DBG == 0
#if MK_MULTI
  for (int p = 0; p < mk::NPHASE; ++p) { a.ph_lo = p; a.ph_hi = p + 1; hipLaunchKernelGGL(mk::fwd, dim3(grid), dim3(mk::NTHR), mk::LDS_BYTES, stream, a); }
#else
  hipMemsetAsync((char*)d_ws + mk::WS_CTL, 0, 65536, stream);
  a.ph_lo = 0; a.ph_hi = mk::NPHASE; void* kargs[] = {&a};
  hipError_t e = hipLaunchCooperativeKernel((const void*)mk::fwd, dim3(grid), dim3(mk::NTHR), kargs, mk::LDS_BYTES, stream);
  if (e != hipSuccess) fprintf(stderr, "cooperative launch failed: %s (grid %d)\n", hipGetErrorString(e), grid);
#endif
#else
  {
    constexpr size_t MiB = 1u << 20; char* ws = (char*)d_ws; float* out = (float*)d_out;
    float* REF = (float*)(ws + 440 * MiB); float* RES = (float*)(ws + 511 * MiB);
    float* nH = (float*)(ws + 34 * MiB); float* nQKV = (float*)(ws + 104 * MiB); float* nMOD = (float*)ws; float* nXC = (float*)(ws + 1 * MiB);
    hipMemsetAsync(RES, 0, 64, stream);
    int slayer = 0, stop = 0, fastp = 0;
#if DBG == 1
    slayer = 0; stop = 2; fastp = 2;
#elif DBG == 2
    slayer = 0; stop = 4; fastp = 4;
#elif DBG == 3
    slayer = 0; stop = 5; fastp = 5;
#elif DBG == 4
    slayer = 0; stop = 6; fastp = 6;
#elif DBG == 5
    slayer = 0; stop = 8; fastp = 8;
#elif DBG == 6
    slayer = 1; stop = 1; fastp = 11;
#elif DBG == 7
    slayer = 1; stop = 5; fastp = 15;
#elif DBG == 8
    slayer = 9; stop = 99; fastp = 21;
#elif DBG == 32
    slayer = 0; stop = 1; fastp = 1;
#elif DBG == 31
    slayer = 0; stop = 1; fastp = 6;
#elif DBG == 30
    slayer = 0; stop = 1; fastp = 0;
#elif DBG == 20
    slayer = 0; stop = 1; fastp = 0;
#elif DBG == 9
    slayer = 1; stop = 1; fastp = 9;
#elif DBG == 10
    slayer = 0; stop = 10; fastp = 9;
#elif DBG == 11
    slayer = 0; stop = 1; fastp = 1;
#endif
    run_naive(d_in, out, ws, stream, slayer, stop);
#if DBG == 1
    hipMemcpyAsync(REF, nH, (size_t)NROWS * DM * 4, hipMemcpyDeviceToDevice, stream); hipMemcpyAsync(REF + (size_t)NROWS * DM, nMOD, (size_t)DEPTH * 5 * NMOD * DM * 4, hipMemcpyDeviceToDevice, stream);
#elif DBG == 3 || DBG == 7
    nv::k_copy_o<<<NROWS, 256, 0, stream>>>(nQKV, REF);
#elif DBG == 2
    hipMemcpyAsync(REF, nQKV, (size_t)NROWS * QKVD * 4, hipMemcpyDeviceToDevice, stream);
#elif DBG == 4 || DBG == 6 || DBG == 8 || DBG == 9
    hipMemcpyAsync(REF, out, (size_t)NB * SEQ * DM * 4, hipMemcpyDeviceToDevice, stream); hipMemcpyAsync(REF + (size_t)NB * SEQ * DM, nXC, (size_t)NB * CTXL * DM * 4, hipMemcpyDeviceToDevice, stream);
#endif
#if DBG == 10
    hipMemcpyAsync(REF, ws + 24 * MiB, (size_t)NROWS * 128 * 4, hipMemcpyDeviceToDevice, stream);
#endif
#if DBG == 9 || DBG == 10
    hipMemcpyAsync(REF + (size_t)70 * MiB / 4, ws + 6 * MiB, (size_t)NROWS * 128 * 4, hipMemcpyDeviceToDevice, stream); hipMemcpyAsync(REF + (size_t)80 * MiB / 4, ws + 15 * MiB, (size_t)NROWS * 128 * 4, hipMemcpyDeviceToDevice, stream);
#elif DBG == 5
    hipMemcpyAsync(REF, nQKV  , (size_t)512 * PQN * 4, hipMemcpyDeviceToDevice, stream);
#endif
    for (int p = 0; p < fastp; ++p) { a.ph_lo = p; a.ph_hi = p + 1; hipLaunchKernelGGL(mk::fwd, dim3(grid), dim3(mk::NTHR), mk::LDS_BYTES, stream, a); }
    unsigned char* fw = (unsigned char*)d_ws;
#if DBG == 30
    k_mfma8_test<<<1, 64, 0, stream>>>(RES);
#endif
#if DBG == 32
    k_cmp_w8<<<1, 1024, 0, stream>>>(fw + mk::WS_WO, (const float*)d_in[11], RES);
#endif
#if DBG == 31
    k_cmp_wo8<<<1, 1024, 0, stream>>>(fw + mk::WS_O, fw + mk::WS_WO, (const float*)(fw + mk::WS_XB), (const float*)d_in[0], (const float*)(fw + mk::WS_MOD) + 2 * DM, 300, RES);
#endif
#if DBG == 20
    { hipMemsetAsync((char*)d_ws + mk::WS_CTL, 0, 65536, stream); a.ph_lo = 0; a.ph_hi = mk::NPHASE; void* kargs[] = {&a};
      hipLaunchCooperativeKernel((const void*)mk::fwd, dim3(grid), dim3(mk::NTHR), kargs, mk::LDS_BYTES, stream);
      dbg::k_ts<<<1, 1, 0, stream>>>((const unsigned long long*)(fw + mk::WS_CTL + 61440), RES); }
#endif
#if DBG == 9 || DBG == 10
    hipMemcpyAsync(fw + mk::WS_EIDX, REF + (size_t)70 * MiB / 4, (size_t)NROWS * 128 * 4, hipMemcpyDeviceToDevice, stream); hipMemcpyAsync(fw + mk::WS_GATE, REF + (size_t)80 * MiB / 4, (size_t)NROWS * 128 * 4, hipMemcpyDeviceToDevice, stream);
    for (int p = 9; p < (DBG == 9 ? 11 : 10); ++p) { a.ph_lo = p; a.ph_hi = p + 1; hipLaunchKernelGGL(mk::fwd, dim3(grid), dim3(mk::NTHR), mk::LDS_BYTES, stream, a); }
#endif
#if DBG == 1
    dbg::k_cmp<true><<<1, 1024, 0, stream>>>(fw + mk::WS_H, DM, 0, REF, DM, 0, NROWS, DM, 0, 0, RES);
    dbg::k_cmp<false><<<1, 1024, 0, stream>>>(fw + mk::WS_MOD, NMOD * DM, 0, REF + (size_t)NROWS * DM, NMOD * DM, 0, DEPTH * 5, NMOD * DM, 0, 0, RES + 1);
#elif DBG == 2
    dbg::k_cmp<true><<<1, 1024, 0, stream>>>(fw + mk::WS_Q, DM, 0, REF, QKVD, 0, NROWS, DM, 0, 0, RES);
    dbg::k_cmp<true><<<1, 1024, 0, stream>>>(fw + mk::WS_K, 256, 0, REF, QKVD, 1024, NROWS, 256, 0, 0, RES + 2);
    dbg::k_cmp<true><<<1, 1024, 0, stream>>>(fw + mk::WS_V, 256, 0, REF, QKVD, 1280, NROWS, 256, 0, 0, RES + 1);
#elif DBG == 3 || DBG == 7
    dbg::k_cmp8<<<1, 1024, 0, stream>>>(fw + mk::WS_O, DM, 64.f, REF, DM, 0, NROWS, DM, 1, RES);
    if (DBG == 3) dbg::k_cmp8<<<1, 1024, 0, stream>>>(fw + mk::WS_O, DM, 64.f, REF, DM, 0, NROWS, DM, 2, RES + 1);
#elif DBG == 4 || DBG == 6 || DBG == 8 || DBG == 9
    dbg::k_cmp<false><<<1, 1024, 0, stream>>>(DBG == 4 ? (const void*)(fw + mk::WS_XB) : (const void*)out, DM, 0, REF, DM, 0, NB * SEQ, DM, 0, 0, RES);
    if (DBG != 8) dbg::k_cmp<false><<<1, 1024, 0, stream>>>(fw + (DBG == 4 ? mk::WS_XCB : mk::WS_XC), DM, 0, REF + (size_t)NB * SEQ * DM, DM, 0, NB * CTXL, DM, 0, 0, RES + 1);
#elif DBG == 11
    dbg::k_cmp<true><<<1, 1024, 0, stream>>>(fw + mk::WS_UT, DM, 0, (const float*)d_in[15], DM, 0, DEPTH * NKEYS * NKEYS, DM, 0, 0, RES);
    dbg::k_cmp<true><<<1, 1024, 0, stream>>>(fw + mk::WS_VT, DM, 0, (const float*)d_in[16], DM, 0, DEPTH * NKEYS * NKEYS, DM, 0, 0, RES + 1);
#elif DBG == 10
    dbg::k_cmp<false><<<1, 1024, 0, stream>>>(fw + mk::WS_PW, 128, 0, REF, 128, 0, NROWS, 128, 0, 0, RES);
#elif DBG == 5
    dbg::k_cmp_scores<<<1, 1024, 0, stream>>>((const float*)(fw + mk::WS_S), REF, (const float*)d_in[14], 512, RES);
#endif
    hipMemcpyAsync(REF, RES, 64, hipMemcpyDeviceToDevice, stream);
    run_naive(d_in, out, ws, stream, 9, 99);
    dbg::k_final<<<1024, 256, 0, stream>>>(out, (long)NB * SEQ * DM, REF);
    dbg::k_final2<<<1, 1, 0, stream>>>(out, REF);
  }
#endif
}
```

```cpp
#include <hip/hip_runtime.h>
#include <hip/hip_cooperative_groups.h>
#include <cstdio>
#include <cstdint>

constexpr int NB = 4, SEQ = 4096, CTXL = 256, DM = 1024, DEPTH = 2;
constexpr int RPB = CTXL + SEQ;
constexpr int NROWS = NB * RPB;
constexpr int NH = 8, NKV = 2, HD = 128, QKVD = 1536, NMOD = 6;
constexpr int PH = 8, PK = 16, NKEYS = 128, PQD = 256, PQN = PH * PQD;
constexpr float RMS_EPS = 1e-6f;

namespace nv {

__device__ __forceinline__ float silu(float x) { return x / (1.f + __expf(-x)); }
__device__ __forceinline__ float gelu_tanh(float x) {
  const float y = 0.7978845608028654f * (x + 0.044715f * x * x * x);
  const float t = 1.f - 2.f / (__expf(2.f * y) + 1.f);
  return 0.5f * x * (1.f + t);
}

__global__ void k_mod(const float* __restrict__ c, const float* __restrict__ c_ctx, const float* __restrict__ ada_w,
                      const float* __restrict__ ada_b, float* __restrict__ mod) {
  const int idx = blockIdx.x * 256 + threadIdx.x;
  if (idx >= DEPTH * 5 * NMOD * DM) return;
  const int n = idx % (NMOD * DM), r = (idx / (NMOD * DM)) % 5, i = idx / (5 * NMOD * DM);
  const float* cv = r < 4 ? c + r * DM : c_ctx;
  const float* w = ada_w + (size_t)i * DM * NMOD * DM + n;
  float s = 0.f;
  for (int j = 0; j < DM; ++j) s += silu(cv[j]) * w[(size_t)j * NMOD * DM];
  mod[idx] = s + ada_b[i * NMOD * DM + n];
}

__device__ __forceinline__ float* xrow(float* xl, float* xc, int r) {
  const int b = r / RPB, j = r % RPB;
  return j < CTXL ? xc + (size_t)(b * CTXL + j) * DM : xl + (size_t)(b * SEQ + (j - CTXL)) * DM;
}

__global__ void k_norm(float* xl, float* xc, const float* __restrict__ gain, const float* __restrict__ modi, int sh_i, int sc_i,
                       float* __restrict__ H) {
  const int r = blockIdx.x, t = threadIdx.x;
  const int b = r / RPB, j = r % RPB, mr = j < CTXL ? 4 : b;
  const float* x = xrow(xl, xc, r);
  __shared__ float red[4];
  float v[4]; float s = 0.f;
#pragma unroll
  for (int q = 0; q < 4; ++q) { v[q] = x[t + 256 * q]; s += v[q] * v[q]; }
  for (int o = 32; o > 0; o >>= 1) s += __shfl_xor(s, o);
  if ((t & 63) == 0) red[t >> 6] = s;
  __syncthreads();
  s = red[0] + red[1] + red[2] + red[3];
  const float rstd = rsqrtf(s / DM + RMS_EPS);
  const float* sh = modi + (size_t)mr * NMOD * DM + sh_i * DM; const float* sc = modi + (size_t)mr * NMOD * DM + sc_i * DM;
#pragma unroll
  for (int q = 0; q < 4; ++q) { const int d = t + 256 * q; H[(size_t)r * DM + d] = v[q] * rstd * gain[d] * (1.f + sc[d]) + sh[d]; }
}

template <int EPI>
__global__ void k_gemm(const float* __restrict__ A, const float* __restrict__ B, float* __restrict__ C, int M, int N, int K,
                       float* xl, float* xc, const float* __restrict__ modi, int g_i, int skip_ctx) {
  __shared__ float As[16][68], Bs[16][68];
  const int t = threadIdx.x, tx = t & 15, ty = t >> 4, m0 = blockIdx.y * 64, n0 = blockIdx.x * 64;
  float acc[4][4] = {};
  for (int k0 = 0; k0 < K; k0 += 16) {
    for (int q = 0; q < 4; ++q) { const int e = t + 256 * q, mm = e >> 4, kk = e & 15; As[kk][mm] = A[(size_t)(m0 + mm) * K + k0 + kk]; }
    for (int q = 0; q < 4; ++q) { const int e = t + 256 * q, kk = e >> 6, nn = e & 63; Bs[kk][nn] = B[(size_t)(k0 + kk) * N + n0 + nn]; }
    __syncthreads();
#pragma unroll
    for (int kk = 0; kk < 16; ++kk) {
      float a[4], b[4];
#pragma unroll
      for (int i = 0; i < 4; ++i) { a[i] = As[kk][ty * 4 + i]; b[i] = Bs[kk][tx * 4 + i]; }
#pragma unroll
      for (int i = 0; i < 4; ++i)
#pragma unroll
        for (int j = 0; j < 4; ++j) acc[i][j] += a[i] * b[j];
    }
    __syncthreads();
  }
#pragma unroll
  for (int i = 0; i < 4; ++i) {
    const int r = m0 + ty * 4 + i;
    if (EPI == 0) {
#pragma unroll
      for (int j = 0; j < 4; ++j) C[(size_t)r * N + n0 + tx * 4 + j] = acc[i][j];
    } else {
      const int b = r / RPB, jj = r % RPB; if (skip_ctx && jj < CTXL) continue;
      const int mr = jj < CTXL ? 4 : b; float* x = xrow(xl, xc, r);
      const float* g = modi + (size_t)mr * NMOD * DM + g_i * DM;
#pragma unroll
      for (int j = 0; j < 4; ++j) { const int n = n0 + tx * 4 + j; x[n] += g[n] * acc[i][j]; }
    }
  }
}

__global__ void k_qknorm_rope(float* __restrict__ QKV, const float* __restrict__ qg, const float* __restrict__ kg) {
  const int r = blockIdx.x, t = threadIdx.x, head = t >> 6, p = t & 63, axis = p >> 5, f = p & 31;
  const int j = r % RPB;
  float* base = QKV + (size_t)r * QKVD + head * HD;
  const int e1 = axis * 64 + f, e2 = e1 + 32;
  float x1 = base[e1], x2 = base[e2];
  float s = x1 * x1 + x2 * x2;
  for (int o = 32; o > 0; o >>= 1) s += __shfl_xor(s, o);
  const float rstd = rsqrtf(s / HD + RMS_EPS);
  const float* g = head < NH ? qg : kg;
  x1 = x1 * rstd * g[e1]; x2 = x2 * rstd * g[e2];
  if (j >= CTXL) {
    const int sp = j - CTXL; const float pos = (float)(axis == 0 ? sp / 64 : sp % 64);
    const float inv = powf(10000.f, -(float)(2 * f) / 64.f);
    const float ang = pos * inv; const float cs = cosf(ang), sn = sinf(ang);
    const float y1 = x1 * cs - x2 * sn, y2 = x1 * sn + x2 * cs; x1 = y1; x2 = y2;
  }
  base[e1] = x1; base[e2] = x2;
}

__global__ void k_attn(float* __restrict__ QKV, int mode, const float* __restrict__ sink) {
  extern __shared__ float sm[];
  const int t = threadIdx.x, w = t >> 6, lane = t & 63, g = blockIdx.y;
  int b, j;
  if (mode == 1) { b = blockIdx.x / CTXL; j = blockIdx.x % CTXL; } else { b = blockIdx.x / SEQ; j = CTXL + blockIdx.x % SEQ; }
  const int r = b * RPB + j, h = g * 4 + w;
  float* sc = sm + w * RPB; float* qs = sm + 4 * RPB + w * HD;
  float* qp = QKV + (size_t)r * QKVD + h * HD;
  qs[lane] = qp[lane]; qs[lane + 64] = qp[lane + 64];
  __syncthreads();
  int a0 = 0, a1, b0 = 0, b1 = 0;
  if (mode == 0) a1 = RPB; else if (mode == 1) a1 = CTXL;
  else { a1 = CTXL; const int s = j - CTXL; const int lo = s - 128 < 0 ? 0 : s - 128, hi = s + 128 > SEQ - 1 ? SEQ - 1 : s + 128; b0 = CTXL + lo; b1 = CTXL + hi + 1; }
  const int nk = (a1 - a0) + (b1 - b0);
  const float scale = 0.08838834764831845f;
  float mx = -1e30f;
  for (int i = lane; i < nk; i += 64) {
    const int kr = i < (a1 - a0) ? a0 + i : b0 + (i - (a1 - a0));
    const float4* kp = (const float4*)(QKV + (size_t)(b * RPB + kr) * QKVD + NH * HD + g * HD);
    float s = 0.f;
    for (int d = 0; d < 32; ++d) { const float4 kv = kp[d]; s += kv.x * qs[4 * d] + kv.y * qs[4 * d + 1] + kv.z * qs[4 * d + 2] + kv.w * qs[4 * d + 3]; }
    s *= scale; sc[i] = s; mx = fmaxf(mx, s);
  }
  for (int o = 32; o > 0; o >>= 1) mx = fmaxf(mx, __shfl_xor(mx, o));
  if (mode == 2) mx = fmaxf(mx, sink[h]);
  float l = 0.f;
  for (int i = lane; i < nk; i += 64) { const float p = __expf(sc[i] - mx); sc[i] = p; l += p; }
  for (int o = 32; o > 0; o >>= 1) l += __shfl_xor(l, o);
  if (mode == 2) l += __expf(sink[h] - mx);
  __syncthreads();
  float o0 = 0.f, o1 = 0.f;
  for (int i = 0; i < nk; ++i) {
    const int kr = i < (a1 - a0) ? a0 + i : b0 + (i - (a1 - a0));
    const float* vp = QKV + (size_t)(b * RPB + kr) * QKVD + (NH + NKV) * HD + g * HD;
    const float p = sc[i]; o0 += p * vp[lane]; o1 += p * vp[lane + 64];
  }
  const float il = 1.f / l;
  qp[lane] = o0 * il; qp[lane + 64] = o1 * il;
}

__global__ void k_copy_o(const float* __restrict__ QKV, float* __restrict__ O) {
  const int r = blockIdx.x, t = threadIdx.x;
  for (int q = 0; q < 4; ++q) O[(size_t)r * DM + t + 256 * q] = QKV[(size_t)r * QKVD + t + 256 * q];
}

__global__ void __launch_bounds__(256) k_peer_topk(const float* __restrict__ PQ, const float* __restrict__ SK  , int* __restrict__ eidx, float* __restrict__ gate) {
  __shared__ float q[PQN]; __shared__ float s[16][128]; __shared__ float tv[16][16]; __shared__ int ti[16][16];
  __shared__ float cs[8][256]; __shared__ int taken[8][256];
  const int r = blockIdx.x, t = threadIdx.x;
  for (int i = t; i < PQN; i += 256) q[i] = PQ[(size_t)r * PQN + i];
  __syncthreads();
  { const int k = t & 127, half = t >> 7; const float* kp = SK + (size_t)half * NKEYS * 128 + (size_t)k * 128;
#pragma nounroll
    for (int h = 0; h < PH; ++h) { float a = 0.f; const float* qq = q + h * PQD + half * 128;
#pragma unroll 4
      for (int d = 0; d < 128; ++d) a += qq[d] * kp[d];
      s[h * 2 + half][k] = a; } }
  __syncthreads();
  if (t < 16) {
#pragma nounroll
    for (int it = 0; it < PK; ++it) { float bv = -3e38f; int bi = 0;
#pragma nounroll
      for (int k = 0; k < 128; ++k) { const float v = s[t][k]; if (v > bv) { bv = v; bi = k; } } tv[t][it] = bv; ti[t][it] = bi; s[t][bi] = -3e38f; }
  }
  __syncthreads();
  for (int i = t; i < 8 * 256; i += 256) { const int h = i >> 8, c = i & 255; cs[h][c] = tv[h * 2][c >> 4] + tv[h * 2 + 1][c & 15]; taken[h][c] = 0; }
  __syncthreads();
  if (t < 8) {
    float m = -3e38f;
#pragma nounroll
    for (int it = 0; it < PK; ++it) { float bv = -3e38f; int bi = 0;
#pragma nounroll
      for (int c = 0; c < 256; ++c) { const float v = cs[t][c]; if (!taken[t][c] && v > bv) { bv = v; bi = c; } }
      taken[t][bi] = 1; s[t][it] = bv; m = fmaxf(m, bv); eidx[(size_t)r * 128 + t * PK + it] = ti[t * 2][bi >> 4] * NKEYS + ti[t * 2 + 1][bi & 15]; }
    float l = 0.f;
#pragma nounroll
    for (int it = 0; it < PK; ++it) l += __expf(s[t][it] - m);
#pragma nounroll
    for (int it = 0; it < PK; ++it) gate[(size_t)r * 128 + t * PK + it] = __expf(s[t][it] - m) / l;
  }
}

__global__ void k_peer_u(const float* __restrict__ H, const float* __restrict__ U, const int* __restrict__ eidx, const float* __restrict__ gate, float* __restrict__ W) {
  __shared__ float h[DM];
  const int r = blockIdx.x, t = threadIdx.x, w = t >> 6, lane = t & 63;
  for (int i = t; i < DM; i += 256) h[i] = H[(size_t)r * DM + i];
  __syncthreads();
  for (int k = w; k < 128; k += 4) {
    const int e = eidx[(size_t)r * 128 + k]; const float* u = U + (size_t)e * DM; float a = 0.f;
    for (int d = lane; d < DM; d += 64) a += u[d] * h[d];
    for (int o = 32; o > 0; o >>= 1) a += __shfl_xor(a, o);
    if (lane == 0) W[(size_t)r * 128 + k] = gate[(size_t)r * 128 + k] * gelu_tanh(a);
  }
}
__global__ void k_peer_v(const float* __restrict__ V, const int* __restrict__ eidx, const float* __restrict__ W, float* xl, float* xc,
                         const float* __restrict__ modi, int g_i, int skip_ctx) {
  const int r = blockIdx.x, t = threadIdx.x; const int b = r / RPB, j = r % RPB; if (skip_ctx && j < CTXL) return;
  float4 acc = {0.f, 0.f, 0.f, 0.f};
  for (int k = 0; k < 128; ++k) { const int e = eidx[(size_t)r * 128 + k]; const float w = W[(size_t)r * 128 + k]; const float4 v = ((const float4*)(V + (size_t)e * DM))[t];
    acc.x += w * v.x; acc.y += w * v.y; acc.z += w * v.z; acc.w += w * v.w; }
  const int mr = j < CTXL ? 4 : b; float4* x = (float4*)xrow(xl, xc, r) + t; const float4 g = ((const float4*)(modi + (size_t)mr * NMOD * DM + g_i * DM))[t];
  float4 xv = *x; xv.x += g.x * acc.x; xv.y += g.y * acc.y; xv.z += g.z * acc.z; xv.w += g.w * acc.w; *x = xv;
}
}


namespace pg8 {
#define PG8_LAS __attribute__((address_space(3)))
typedef unsigned short bf16_t;
typedef short bf16x8 __attribute__((ext_vector_type(8)));
typedef float f32x4 __attribute__((ext_vector_type(4)));
typedef unsigned u32x4 __attribute__((ext_vector_type(4)));
constexpr int BM = 256, BK = 64, HALF = 128, HTB = HALF * BK * 2  , STAGE_BYTES = 8 * HTB, NXCD = 8, WGM = 8;

__host__ __device__ __forceinline__ int lds_byte(int r, int c) { const int st = (r >> 4) * 2 + (c >> 5), rr = r & 15, cc = c & 31, ob = rr * 64 + cc * 2; return st * 1024 + (ob ^ (((ob >> 9) & 1) << 5)); }
__host__ __device__ __forceinline__ void stage_rc(int b, int& R, int& C) { const int st = b / 1024, sb = b % 1024, swz = sb ^ (((sb >> 9) & 1) << 5); R = (st >> 1) * 16 + swz / 64; C = (st & 1) * 32 + (swz % 64) / 2; }
__host__ __device__ __forceinline__ int perm32(int rho) { const int n = rho >> 4, i = rho & 15; return 8 * (i >> 2) + 4 * n + (i & 3); }

struct Unit { int pm, pn; };
struct Gemm { const bf16_t* A; const bf16_t* Bt; int M, N, K; int sa = 0x7f7f7f7f, sb = 0x7f7f7f7f; };
typedef int i32x4 __attribute__((ext_vector_type(4)));
typedef int i32x8 __attribute__((ext_vector_type(8)));

struct StaticOrder {
    int nM, nN, nwg, G, c;
    __host__ __device__ void init(int M, int N, int G_, int c_) { nM = M / BM; nN = N / BM; nwg = nM * nN; G = G_; c = c_; }
    __host__ __device__ bool next(int i, Unit& u) const {
        const long L = (long)i * G + c; if (L >= nwg) return false;
        int wgid = (int)L; { const int q = nwg / NXCD, r = nwg % NXCD, xcd = wgid % NXCD, off = wgid / NXCD; wgid = (xcd < r ? xcd * (q + 1) : r * (q + 1) + (xcd - r) * q) + off; }
        const int nig = WGM * nN, gid = wgid / nig, fm = gid * WGM, gsz = (nM - fm) < WGM ? (nM - fm) : WGM;
        u.pm = fm + ((wgid % nig) % gsz); u.pn = (wgid % nig) / gsz; return true;
    }
    __device__ __forceinline__ void a_ready(const Unit&) const {}
    __device__ __forceinline__ void done(const Unit&) const {}
};

__device__ __forceinline__ unsigned cvt_pk_bf16(float lo, float hi) { unsigned r; asm volatile("v_cvt_pk_bf16_f32 %0, %1, %2" : "=v"(r) : "v"(lo), "v"(hi)); return r; }
typedef float f32x2 __attribute__((ext_vector_type(2)));
__device__ __forceinline__ f32x2 gelu_pk(f32x2 v) {
    const f32x2 av = __builtin_elementwise_abs(v), d = av * 0.2316418882f + 1.0f;
    f32x2 t; t.x = __builtin_amdgcn_rcpf(d.x); t.y = __builtin_amdgcn_rcpf(d.y);
    f32x2 q = t * 0.5307027145f + (-0.7265760135f); q = q * t + 0.7107068705f; q = q * t + (-0.142248368f); q = q * t + 0.127414796f; q = q * t;
    const f32x2 s = (v * v) * (-0.72134752044f);
    f32x2 e; e.x = __builtin_amdgcn_exp2f(s.x); e.y = __builtin_amdgcn_exp2f(s.y);
    const f32x2 m = v * (q * e), r = v - m;
    f32x2 o; o.x = v.x < 0.f ? m.x : r.x; o.y = v.y < 0.f ? m.y : r.y; return o;
}

template <int ACT  > struct EpiBf16 {
    static constexpr bool PERM = true, AFTER_DRAIN = false; static_assert(ACT == 0 || ACT == 1, "EpiBf16: ACT is 0 (none) or 1 (gelu_pk)");
    bf16_t* O; int ldc; const float* bias; int split_cols; size_t split_stride; float scale0;
    __device__ __forceinline__ void operator()(const f32x4 (&acc)[2][2][4][2], const Unit& u, int wr, int wc, int fr, int fq) const {
        const int row0 = u.pm * BM + wr * 64 + fr; int colt = u.pn * BM; bf16_t* base = O;
        float sc = 1.f; if (split_cols) { const int t = colt / split_cols; base += (size_t)t * split_stride; colt -= t * split_cols; if (t == 0) sc = scale0; }
        const int col0 = colt + wc * 32 + 8 * fq, bcol0 = u.pn * BM + wc * 32 + 8 * fq;
        f32x4 bv[2][2];
#pragma unroll
        for (int bj = 0; bj < 2; ++bj)
#pragma unroll
            for (int n = 0; n < 2; ++n) bv[bj][n] = bias ? *(const f32x4*)(bias + bcol0 + bj * HALF + 4 * n) : (f32x4){0.f, 0.f, 0.f, 0.f};
#pragma unroll
        for (int ai = 0; ai < 2; ++ai)
#pragma unroll
            for (int m = 0; m < 4; ++m) { bf16_t* rowp = base + (size_t)(row0 + ai * HALF + m * 16) * ldc + col0;
#pragma unroll
                for (int bj = 0; bj < 2; ++bj) { f32x4 v0 = acc[ai][bj][m][0] + bv[bj][0], v1 = acc[ai][bj][m][1] + bv[bj][1];
                    if (ACT == 1) { f32x2 a = gelu_pk((f32x2){v0[0], v0[1]}), b = gelu_pk((f32x2){v0[2], v0[3]}), c = gelu_pk((f32x2){v1[0], v1[1]}), d = gelu_pk((f32x2){v1[2], v1[3]});
                        v0 = (f32x4){a.x, a.y, b.x, b.y}; v1 = (f32x4){c.x, c.y, d.x, d.y}; }
                    v0 = v0 * sc; v1 = v1 * sc; u32x4 w; w.x = cvt_pk_bf16(v0[0], v0[1]); w.y = cvt_pk_bf16(v0[2], v0[3]); w.z = cvt_pk_bf16(v1[0], v1[1]); w.w = cvt_pk_bf16(v1[2], v1[3]);
                    *(u32x4*)(rowp + bj * HALF) = w; } }
    }
};

template <class Epi, class Sched, bool ALIGN_EPI = false, bool SP2 = false, bool FP8 = false, int SA = 0x7f7f7f7f, int SB = 0x7f7f7f7f>
__device__ __forceinline__ void gemm_phase(PG8_LAS unsigned char* lds, const Gemm g, const Sched& S, const Epi& E) {
    int tid_ = threadIdx.x; asm volatile("" : "+v"(tid_));
    const int tid = tid_, wid = __builtin_amdgcn_readfirstlane(tid >> 6), lane = tid & 63, wr = wid >> 2, wc = wid & 3, fr = lane & 15, fq = lane >> 4;
    constexpr int ES = FP8 ? 1 : 2;
    const int K = g.K, nt = K * ES / (BK * 2);
    unsigned voffA[2], voffB[2];
#pragma unroll
    for (int i = 0; i < 2; ++i) { int R, C; stage_rc(tid * 16 + i * 8192, R, C); const int Rb = Epi::PERM ? ((R & ~31) + perm32(R & 31)) : R;
        voffA[i] = (unsigned)(R * K * ES + C * 2); voffB[i] = (unsigned)(Rb * K * ES + C * 2); }
    const size_t kstep = (size_t)(BK * 2);
    const size_t hstep = (size_t)HALF * K * ES;
    const size_t tstep = 2 * hstep;
    const unsigned ldsw = (unsigned)wid * 1024u;
    const int aoff = lds_byte(wr * 64 + fr, fq * 8), boff = lds_byte(wc * 32 + fr, fq * 8);
#define PG8_SA(b, h) (((b) * 2 + (h)) * HTB)
#define PG8_SB(b, h) ((4 + (b) * 2 + (h)) * HTB)
#define PG8_STAGE(bufoff, gbase, voff) do { if constexpr (FP8) {   \
          int t3_ = tid; asm volatile("" : "+v"(t3_)); _Pragma("unroll") for (int _i = 0; _i < 2; ++_i) { int R_, C_; stage_rc(t3_ * 16 + _i * 8192, R_, C_); \
            if (Epi::PERM && (&(voff)[0] == &voffB[0])) R_ = (R_ & ~31) + perm32(R_ & 31); \
            __builtin_amdgcn_global_load_lds((const unsigned*)((const char*)(gbase) + (unsigned)(R_ * K * ES + C_ * 2)), (PG8_LAS unsigned*)(lds + (bufoff) + ldsw + _i * 8192), 16, 0, 0); } } \
        else { _Pragma("unroll") for (int _i = 0; _i < 2; ++_i) \
        __builtin_amdgcn_global_load_lds((const unsigned*)((const char*)(gbase) + (voff)[_i]), (PG8_LAS unsigned*)(lds + (bufoff) + ldsw + _i * 8192), 16, 0, 0); } } while (0)
#define PG8_LDA(dst, b, h) do { if constexpr (FP8) { _Pragma("unroll") for (int m = 0; m < 4; ++m) dst##8[m] = __builtin_shufflevector(*(const PG8_LAS i32x4*)(lds + PG8_SA(b, h) + aoff + m * 2048), *(const PG8_LAS i32x4*)(lds + PG8_SA(b, h) + aoff + m * 2048 + 1024), 0, 1, 2, 3, 4, 5, 6, 7); } \
        else { _Pragma("unroll") for (int m = 0; m < 4; ++m) _Pragma("unroll") for (int k = 0; k < 2; ++k) dst[m][k] = *(const PG8_LAS bf16x8*)(lds + PG8_SA(b, h) + aoff + m * 2048 + k * 1024); } } while (0)
#define PG8_LDB(dst, b, h) do { if constexpr (FP8) { _Pragma("unroll") for (int n = 0; n < 2; ++n) dst##8[n] = __builtin_shufflevector(*(const PG8_LAS i32x4*)(lds + PG8_SB(b, h) + boff + n * 2048), *(const PG8_LAS i32x4*)(lds + PG8_SB(b, h) + boff + n * 2048 + 1024), 0, 1, 2, 3, 4, 5, 6, 7); } \
        else { _Pragma("unroll") for (int n = 0; n < 2; ++n) _Pragma("unroll") for (int k = 0; k < 2; ++k) dst[n][k] = *(const PG8_LAS bf16x8*)(lds + PG8_SB(b, h) + boff + n * 2048 + k * 1024); } } while (0)
#define PG8_MMA(ai, bj, At, Bt) do { __builtin_amdgcn_s_setprio(1); \
        if constexpr (FP8) { _Pragma("unroll") for (int m = 0; m < 4; ++m) _Pragma("unroll") for (int n = 0; n < 2; ++n) { \
            acc[ai][bj][m][n] = __builtin_amdgcn_mfma_scale_f32_16x16x128_f8f6f4(Bt##8[n], At##8[m], acc[ai][bj][m][n], 0, 0, 0, SB, 0, SA); } } \
        else { _Pragma("unroll") for (int m = 0; m < 4; ++m) _Pragma("unroll") for (int n = 0; n < 2; ++n) _Pragma("unroll") for (int k = 0; k < 2; ++k) \
            acc[ai][bj][m][n] = __builtin_amdgcn_mfma_f32_16x16x32_bf16(Bt[n][k], At[m][k], acc[ai][bj][m][n], 0, 0, 0); } \
        __builtin_amdgcn_s_setprio(0); } while (0)
#define PG8_WAIT_V(n) asm volatile("s_waitcnt vmcnt(" #n ")" ::: "memory")
#define PG8_WAIT_L(n) asm volatile("s_waitcnt lgkmcnt(" #n ")" ::: "memory")
#define PG8_BAR __builtin_amdgcn_s_barrier()
#define PG8_SCHED __builtin_amdgcn_sched_barrier(0)
    Unit cur, nxt; int ui = 0;
    if (!S.next(0, cur)) return;
    f32x4 acc[2][2][4][2];
#pragma unroll
    for (int a = 0; a < 2; ++a)
#pragma unroll
        for (int b = 0; b < 2; ++b)
#pragma unroll
            for (int m = 0; m < 4; ++m)
#pragma unroll
                for (int n = 0; n < 2; ++n) acc[a][b][m][n] = (f32x4){0.f, 0.f, 0.f, 0.f};
    bf16x8 At[4][2], B0[2][2], B1[2][2]; i32x8 At8[4], B08[2], B18[2];
    const char* cA = (const char*)g.A + (size_t)cur.pm * tstep; const char* cB = (const char*)g.Bt + (size_t)cur.pn * tstep;
    S.a_ready(cur);
    if constexpr (SP2) {
        PG8_STAGE(PG8_SB(0, 0), cB, voffB); PG8_STAGE(PG8_SB(0, 1), cB + hstep, voffB); PG8_STAGE(PG8_SA(0, 0), cA, voffA); PG8_STAGE(PG8_SA(0, 1), cA + hstep, voffA);
        if (wr == 1) PG8_BAR;
        PG8_WAIT_V(2); PG8_BAR;
        PG8_STAGE(PG8_SB(1, 0), cB + kstep, voffB); PG8_STAGE(PG8_SA(1, 0), cA + kstep, voffA); PG8_STAGE(PG8_SB(1, 1), cB + hstep + kstep, voffB);
        PG8_WAIT_V(6); PG8_BAR;
    } else {
        PG8_STAGE(PG8_SB(0, 0), cB, voffB); PG8_STAGE(PG8_SA(0, 0), cA, voffA); PG8_STAGE(PG8_SB(0, 1), cB + hstep, voffB); PG8_STAGE(PG8_SA(0, 1), cA + hstep, voffA);
        if (wr == 1) PG8_BAR;
        PG8_WAIT_V(4); PG8_BAR;
        PG8_STAGE(PG8_SB(1, 0), cB + kstep, voffB); PG8_STAGE(PG8_SA(1, 0), cA + kstep, voffA); PG8_STAGE(PG8_SB(1, 1), cB + hstep + kstep, voffB);
        PG8_WAIT_V(6); PG8_BAR;
    }
    for (;;) {
        const bool has_next = S.next(ui + 1, nxt);
        const char* nA = has_next ? (const char*)g.A + (size_t)nxt.pm * tstep : cA; const char* nB = has_next ? (const char*)g.Bt + (size_t)nxt.pn * tstep : cB;
#pragma unroll 1
        for (int t = 0; t < nt; t += 2) {
            const bool last = (t == nt - 2);
            const char* a1 = cA + (size_t)(t + 1) * kstep;
            const char* a2 = last ? nA : cA + (size_t)(t + 2) * kstep; const char* b2 = last ? nB : cB + (size_t)(t + 2) * kstep;
            const char* a3 = a2 + kstep; const char* b3 = b2 + kstep;
            if (last && has_next) S.a_ready(nxt);
            if constexpr (SP2) {
            PG8_LDB(B0, 0, 0); PG8_LDB(B1, 0, 1); PG8_SCHED; PG8_LDA(At, 0, 0); PG8_STAGE(PG8_SA(1, 1), a1 + hstep, voffA);
            PG8_WAIT_V(8); PG8_WAIT_L(0); PG8_BAR; PG8_MMA(0, 0, At, B0); PG8_MMA(0, 1, At, B1); PG8_BAR; PG8_SCHED;
            PG8_LDA(At, 0, 1); PG8_STAGE(PG8_SB(0, 0), b2, voffB); PG8_STAGE(PG8_SB(0, 1), b2 + hstep, voffB); PG8_STAGE(PG8_SA(0, 0), a2, voffA);
            PG8_WAIT_V(8); PG8_WAIT_L(0); PG8_BAR; PG8_MMA(1, 0, At, B0); PG8_MMA(1, 1, At, B1); PG8_BAR; PG8_SCHED;
            PG8_LDB(B0, 1, 0); PG8_LDB(B1, 1, 1); PG8_SCHED; PG8_LDA(At, 1, 0); PG8_STAGE(PG8_SA(0, 1), a2 + hstep, voffA);
            PG8_WAIT_V(8); PG8_WAIT_L(0); PG8_BAR; PG8_MMA(0, 0, At, B0); PG8_MMA(0, 1, At, B1); PG8_BAR; PG8_SCHED;
            PG8_LDA(At, 1, 1); PG8_STAGE(PG8_SB(1, 0), b3, voffB); PG8_STAGE(PG8_SB(1, 1), b3 + hstep, voffB); PG8_STAGE(PG8_SA(1, 0), a3, voffA);
            PG8_WAIT_V(8); PG8_WAIT_L(0); PG8_BAR; PG8_MMA(1, 0, At, B0); PG8_MMA(1, 1, At, B1); PG8_BAR; PG8_SCHED;
            } else {
            PG8_LDB(B0, 0, 0); PG8_SCHED; PG8_LDA(At, 0, 0); PG8_STAGE(PG8_SA(1, 1), a1 + hstep, voffA);
            PG8_WAIT_L(8); PG8_BAR; PG8_WAIT_L(0); PG8_MMA(0, 0, At, B0); PG8_BAR; PG8_SCHED;
            PG8_LDB(B1, 0, 1); PG8_STAGE(PG8_SB(0, 0), b2, voffB);
            PG8_BAR; PG8_WAIT_L(0); PG8_MMA(0, 1, At, B1); PG8_BAR;
            PG8_LDA(At, 0, 1); PG8_STAGE(PG8_SA(0, 0), a2, voffA);
            PG8_BAR; PG8_WAIT_L(0); PG8_MMA(1, 0, At, B0); PG8_BAR; PG8_SCHED;
            PG8_STAGE(PG8_SB(0, 1), b2 + hstep, voffB);
            PG8_WAIT_V(6); PG8_BAR; PG8_MMA(1, 1, At, B1); PG8_BAR;
            PG8_LDB(B0, 1, 0); PG8_SCHED; PG8_LDA(At, 1, 0); PG8_STAGE(PG8_SA(0, 1), a2 + hstep, voffA);
            PG8_WAIT_L(8); PG8_BAR; PG8_WAIT_L(0); PG8_MMA(0, 0, At, B0); PG8_BAR; PG8_SCHED;
            PG8_LDB(B1, 1, 1); PG8_STAGE(PG8_SB(1, 0), b3, voffB);
            PG8_BAR; PG8_WAIT_L(0); PG8_MMA(0, 1, At, B1); PG8_BAR;
            PG8_LDA(At, 1, 1); PG8_STAGE(PG8_SA(1, 0), a3, voffA);
            PG8_BAR; PG8_WAIT_L(0); PG8_MMA(1, 0, At, B0); PG8_BAR; PG8_SCHED;
            PG8_STAGE(PG8_SB(1, 1), b3 + hstep, voffB);
            PG8_WAIT_V(6); PG8_BAR; PG8_MMA(1, 1, At, B1); PG8_BAR;
            }
        }
        if constexpr (ALIGN_EPI) { if (wr == 0) PG8_BAR; }
        if constexpr (!Epi::AFTER_DRAIN) { E(acc, cur, wr, wc, fr, fq); S.done(cur); }
        if (!has_next) break;
#pragma unroll
        for (int a = 0; a < 2; ++a)
#pragma unroll
            for (int b = 0; b < 2; ++b)
#pragma unroll
                for (int m = 0; m < 4; ++m)
#pragma unroll
                    for (int n = 0; n < 2; ++n) acc[a][b][m][n] = (f32x4){0.f, 0.f, 0.f, 0.f};
        cur = nxt; cA = nA; cB = nB; ++ui;
        if constexpr (ALIGN_EPI) { if (wr == 1) PG8_BAR; }
    }
    PG8_WAIT_V(0);
    if constexpr (!ALIGN_EPI) { if (wr == 0) PG8_BAR; }
    PG8_BAR;
    if constexpr (Epi::AFTER_DRAIN) { E.fused(acc, cur, wr, wc, fr, fq, lds, wid, lane); S.done(cur); }
#undef PG8_SA
#undef PG8_SB
#undef PG8_STAGE
#undef PG8_LDA
#undef PG8_LDB
#undef PG8_MMA
#undef PG8_WAIT_V
#undef PG8_WAIT_L
#undef PG8_BAR
#undef PG8_SCHED
}
}

namespace att {
typedef unsigned short bf16;
constexpr int D = 128, NW = 8, QBLK = 32, KVBLK = 64, LDQ = 1024, LDK = 256;
constexpr float SCALE = 0.088388347648318440f;
constexpr float THR = 3.f;
constexpr float QK8_SCALE = 4.f;
constexpr float V8A_SCALE = 4.f;
constexpr float O8_SCALE = 64.f;
#ifndef ATT_SDEPTH
#define ATT_SDEPTH 2
#endif
constexpr int SDEPTH = ATT_SDEPTH;
constexpr size_t SHM_V = KVBLK * D * 1  , SHM_K = KVBLK * D * 1  , SHM_ATTN = 3 * SHM_V + 3 * SHM_K + NW * 64 * 4;
#define VSWZ8(col, chunk) ((col) * 64 + ((((chunk) ^ ((col) >> 2)) & 3) << 4))
typedef int i32x8 __attribute__((ext_vector_type(8)));
typedef int i32x4 __attribute__((ext_vector_type(4)));
#define KSWZ8(row, colB) ((row) * 128 + ((colB) ^ ((((row) >> 1) & 7) << 4)))
using bf16x8 = __attribute__((ext_vector_type(8))) short;
using s16x4  = __attribute__((ext_vector_type(4))) short;
using f32x16 = __attribute__((ext_vector_type(16))) float;
using u32x4  = __attribute__((ext_vector_type(4))) unsigned;
#define KSWZ(row, colB) ((row) * 256 + ((colB) ^ (((row) & 7) << 4)))
#define SBAR() __builtin_amdgcn_sched_barrier(0)
__device__ __forceinline__ int crow(int r, int hi) { return (r & 3) + 8 * (r >> 2) + 4 * hi; }
__device__ __forceinline__ unsigned cvtpk(float lo, float hi) { unsigned r; asm volatile("v_cvt_pk_bf16_f32 %0, %1, %2" : "=v"(r) : "v"(lo), "v"(hi)); return r; }
typedef float f32x2 __attribute__((ext_vector_type(2)));
#define PAIR(P, i) (f32x2{P[2 * (i)], P[2 * (i) + 1]})
__device__ __forceinline__ void partialSM(f32x16& p0, f32x16& p1, float& m_reg, float& mn, float& alpha) {
  constexpr float C = SCALE * 1.4426950408889634f;
  float pmax = p0[0]; for (int r = 1; r < 16; ++r) pmax = fmaxf(pmax, p0[r]); for (int r = 0; r < 16; ++r) pmax = fmaxf(pmax, p1[r]);
  { auto rr = __builtin_amdgcn_permlane32_swap(__float_as_uint(pmax), __float_as_uint(pmax), false, false);
    pmax = fmaxf(__uint_as_float(rr[0]), __uint_as_float(rr[1])); }
  if (__builtin_expect(__all(pmax - m_reg <= THR / SCALE), 1)) { mn = m_reg; alpha = 1.f; }
  else { mn = fmaxf(m_reg, pmax); alpha = __builtin_amdgcn_exp2f((m_reg - mn) * C); m_reg = mn; }
  float mnC = 4.f - mn * C, Cv = C; asm volatile("" : "+v"(Cv));
  const f32x2 c2 = {Cv, Cv}, m2 = {mnC, mnC};
#pragma unroll
  for (int i = 0; i < 8; ++i) { const f32x2 a = __builtin_elementwise_fma(PAIR(p0, i), c2, m2), b = __builtin_elementwise_fma(PAIR(p1, i), c2, m2);
    p0[2 * i] = a[0]; p0[2 * i + 1] = a[1]; p1[2 * i] = b[0]; p1[2 * i + 1] = b[1]; }
  for (int r = 0; r < 16; ++r) p0[r] = __builtin_amdgcn_exp2f(p0[r]);
}
__device__ __forceinline__ void finishSM(f32x16& p0, f32x16& p1, float alpha, float& l_reg, i32x8& pa) {
  for (int r = 0; r < 16; ++r) p1[r] = __builtin_amdgcn_exp2f(p1[r]);
  f32x2 s2 = PAIR(p0, 0);
#pragma unroll
  for (int i = 1; i < 8; ++i) s2 += PAIR(p0, i);
#pragma unroll
  for (int i = 0; i < 8; ++i) s2 += PAIR(p1, i);
  float ps = s2[0] + s2[1];
  { auto rr = __builtin_amdgcn_permlane32_swap(__float_as_uint(ps), __float_as_uint(ps), false, false);
    ps = __uint_as_float(rr[0]) + __uint_as_float(rr[1]); }
  l_reg = l_reg * alpha + ps;
#define PK8(P, B) ({ int v_ = __builtin_amdgcn_cvt_pk_fp8_f32(P[B], P[B + 1], __float_as_int(P[B])  , false); v_ = __builtin_amdgcn_cvt_pk_fp8_f32(P[B + 2], P[B + 3], v_, true); (unsigned)v_; })
#pragma unroll
  for (int i = 0; i < 4; ++i) { const unsigned x = PK8(p0, 4 * i), y = PK8(p1, 4 * i); auto rr = __builtin_amdgcn_permlane32_swap(x, y, false, false); pa[2 * i] = (int)rr[0]; pa[2 * i + 1] = (int)rr[1]; }
#undef PK8
}
__device__ __forceinline__ void qkt(f32x16& p0, f32x16& p1, const char* Ks, const i32x8* qr, int r32, int hi) {
  p0 = f32x16{}; p1 = f32x16{};
#pragma unroll
  for (int sk = 0; sk < 2; ++sk) { const int cb = 64 * sk + 32 * hi;
    const i32x8 a0 = __builtin_shufflevector(*reinterpret_cast<const i32x4*>(Ks + KSWZ8(r32, cb)), *reinterpret_cast<const i32x4*>(Ks + KSWZ8(r32, cb + 16)), 0, 1, 2, 3, 4, 5, 6, 7);
    const i32x8 a1 = __builtin_shufflevector(*reinterpret_cast<const i32x4*>(Ks + KSWZ8(32 + r32, cb)), *reinterpret_cast<const i32x4*>(Ks + KSWZ8(32 + r32, cb + 16)), 0, 1, 2, 3, 4, 5, 6, 7);
    p0 = __builtin_amdgcn_mfma_scale_f32_32x32x64_f8f6f4(a0, qr[sk], p0, 0, 0, 0, 0x7d7d7d7d, 0, 0x7d7d7d7d);
    p1 = __builtin_amdgcn_mfma_scale_f32_32x32x64_f8f6f4(a1, qr[sk], p1, 0, 0, 0, 0x7d7d7d7d, 0, 0x7d7d7d7d); }
}
template <int D0> __device__ __forceinline__ void pv_one(f32x16& od, const char* Vt, i32x8 pa, int r32, int hi) {
  const int col = D0 * 32 + r32;
  const i32x8 b = __builtin_shufflevector(*reinterpret_cast<const i32x4*>(Vt + VSWZ8(col, 2 * hi)), *reinterpret_cast<const i32x4*>(Vt + VSWZ8(col, 2 * hi + 1)), 0, 1, 2, 3, 4, 5, 6, 7);
  od = __builtin_amdgcn_mfma_scale_f32_32x32x64_f8f6f4(pa, b, od, 0, 0, 0, 0x7f7f7f7f  , 0, 0x7d7d7d7d  );
}
__device__ __forceinline__ void pv_d0(f32x16* o, const char* Vt, i32x8 pa, int r32, int hi) {
  pv_one<0>(o[0], Vt, pa, r32, hi); pv_one<1>(o[1], Vt, pa, r32, hi); pv_one<2>(o[2], Vt, pa, r32, hi); pv_one<3>(o[3], Vt, pa, r32, hi);
}
#define PIN(x) asm volatile("" : "+v"(x))
#define LD8K(Ks, row, cb) __builtin_shufflevector(*reinterpret_cast<const i32x4*>((Ks) + KSWZ8(row, cb)), *reinterpret_cast<const i32x4*>((Ks) + KSWZ8(row, (cb) + 16)), 0, 1, 2, 3, 4, 5, 6, 7)
#define LD8V(Vt, col, h) __builtin_shufflevector(*reinterpret_cast<const i32x4*>((Vt) + VSWZ8(col, 2 * (h))), *reinterpret_cast<const i32x4*>((Vt) + VSWZ8(col, 2 * (h) + 1)), 0, 1, 2, 3, 4, 5, 6, 7)
#define MFQK(A, B, Cc) __builtin_amdgcn_mfma_scale_f32_32x32x64_f8f6f4(A, B, Cc, 0, 0, 0, 0x7d7d7d7d, 0, 0x7d7d7d7d)
#define MFPV(A, B, Cc) __builtin_amdgcn_mfma_scale_f32_32x32x64_f8f6f4(A, B, Cc, 0, 0, 0, 0x7f7f7f7f, 0, 0x7d7d7d7d)
#define PK8(P, B) ({ int v_ = __builtin_amdgcn_cvt_pk_fp8_f32(P[B], P[B + 1], __float_as_int(P[B]), false); v_ = __builtin_amdgcn_cvt_pk_fp8_f32(P[B + 2], P[B + 3], v_, true); (unsigned)v_; })
__device__ __forceinline__ void qk_fin(f32x16& n0, f32x16& n1, const char* Ks, const i32x8* qr, f32x16& c0, f32x16& c1, float alpha, float& l_reg, i32x8& pa, int r32, int hi) {
  const i32x8 a00 = LD8K(Ks, r32, 32 * hi), a10 = LD8K(Ks, 32 + r32, 32 * hi), a01 = LD8K(Ks, r32, 64 + 32 * hi), a11 = LD8K(Ks, 32 + r32, 64 + 32 * hi);
  SBAR(); n0 = MFQK(a00, qr[0], f32x16{}); SBAR();
#pragma unroll
  for (int r = 0; r < 8; ++r) c1[r] = __builtin_amdgcn_exp2f(c1[r]);
  SBAR(); n1 = MFQK(a10, qr[0], f32x16{}); SBAR();
#pragma unroll
  for (int r = 8; r < 16; ++r) c1[r] = __builtin_amdgcn_exp2f(c1[r]);
  SBAR(); n0 = MFQK(a01, qr[1], n0); SBAR();
  f32x2 s2 = PAIR(c0, 0);
#pragma unroll
  for (int i = 1; i < 8; ++i) s2 += PAIR(c0, i);
#pragma unroll
  for (int i = 0; i < 8; ++i) s2 += PAIR(c1, i);
  float ps = s2[0] + s2[1];
  { auto rr = __builtin_amdgcn_permlane32_swap(__float_as_uint(ps), __float_as_uint(ps), false, false); ps = __uint_as_float(rr[0]) + __uint_as_float(rr[1]); }
  l_reg = l_reg * alpha + ps;
  SBAR(); n1 = MFQK(a11, qr[1], n1); SBAR();
#pragma unroll
  for (int i = 0; i < 4; ++i) { const unsigned x = PK8(c0, 4 * i), y = PK8(c1, 4 * i); auto rr = __builtin_amdgcn_permlane32_swap(x, y, false, false); pa[2 * i] = (int)rr[0]; pa[2 * i + 1] = (int)rr[1]; }
  SBAR();
}
__device__ __forceinline__ void pv_part(f32x16* o, const char* Vt, const i32x8 pa, f32x16& n0, f32x16& n1, float& m_reg, float& alpha, int r32, int hi) {
  constexpr float C = SCALE * 1.4426950408889634f;
  const i32x8 b0 = LD8V(Vt, r32, hi), b1 = LD8V(Vt, 32 + r32, hi), b2 = LD8V(Vt, 64 + r32, hi), b3 = LD8V(Vt, 96 + r32, hi);
  SBAR(); o[0] = MFPV(pa, b0, o[0]); SBAR();
  float pmax = n0[0]; for (int r = 1; r < 16; ++r) pmax = fmaxf(pmax, n0[r]); for (int r = 0; r < 16; ++r) pmax = fmaxf(pmax, n1[r]);
  { auto rr = __builtin_amdgcn_permlane32_swap(__float_as_uint(pmax), __float_as_uint(pmax), false, false); pmax = fmaxf(__uint_as_float(rr[0]), __uint_as_float(rr[1])); }
  const bool keep = __all(pmax - m_reg <= THR / SCALE);
  const float mn = keep ? m_reg : fmaxf(m_reg, pmax);
  alpha = __builtin_amdgcn_exp2f((m_reg - mn) * C); m_reg = mn;
  float mnC = 4.f - mn * C, Cv = C; asm volatile("" : "+v"(Cv));
  const f32x2 c2 = {Cv, Cv}, m2 = {mnC, mnC};
  SBAR(); o[1] = MFPV(pa, b1, o[1]); SBAR();
#pragma unroll
  for (int i = 0; i < 8; ++i) { const f32x2 a = __builtin_elementwise_fma(PAIR(n0, i), c2, m2), b = __builtin_elementwise_fma(PAIR(n1, i), c2, m2);
    n0[2 * i] = a[0]; n0[2 * i + 1] = a[1]; n1[2 * i] = b[0]; n1[2 * i + 1] = b[1]; }
  PIN(n0); PIN(n1);
  SBAR(); o[2] = MFPV(pa, b2, o[2]); SBAR();
#pragma unroll
  for (int r = 0; r < 8; ++r) n0[r] = __builtin_amdgcn_exp2f(n0[r]);
  PIN(n0);
  SBAR(); o[3] = MFPV(pa, b3, o[3]); SBAR();
#pragma unroll
  for (int r = 8; r < 16; ++r) n0[r] = __builtin_amdgcn_exp2f(n0[r]);
  PIN(n0);
  SBAR();
}
#undef PK8
__device__ __forceinline__ void wmask(f32x16& p0, f32x16& p1, int kb, int qp, int hi) {
  const int bd = kb - qp + 4 * hi + 128;
#pragma unroll
  for (int r = 0; r < 16; ++r) { const int d0 = bd + (r & 3) + 8 * (r >> 2);
    if ((unsigned)d0 > 256u) p0[r] = -1e30f; if ((unsigned)(d0 + 32) > 256u) p1[r] = -1e30f; }
}
__device__ __forceinline__ void attn_unit(const bool WIN, const unsigned char* Qb, unsigned char* Ob, const unsigned char* __restrict__ Kh, const unsigned char* __restrict__ Vh  , int NT, int kstart, int q0, float sink_l2, float sink1_l2, char* lds) {
  int tid_ = threadIdx.x; asm volatile("" : "+v"(tid_));
  const int tid = tid_, wid = __builtin_amdgcn_readfirstlane(tid >> 6), lane = tid & 63, r32 = lane & 31, hi = lane >> 5;
  char* V_lds = lds; char* K_lds = lds + 3 * SHM_V;
  float* ws = (float*)(lds + 3 * SHM_V + 3 * SHM_K) + wid * 64; float* li_l = ws; float* al_l = ws + 32;
  float m_reg = -1e30f, l_reg = 0; f32x16 o[4] = {}; i32x8 qr[2];
  const int wrow = WIN ? (wid & 3) * QBLK : wid * QBLK, hoff = WIN ? (wid >> 2) * D : 0;
  const unsigned char* Qw = Qb + (long)(wrow + r32) * LDQ + hoff + hi * 32;
#pragma unroll
  for (int sk = 0; sk < 2; ++sk) qr[sk] = __builtin_shufflevector(*reinterpret_cast<const i32x4*>(Qw + sk * 64), *reinterpret_cast<const i32x4*>(Qw + sk * 64 + 16), 0, 1, 2, 3, 4, 5, 6, 7);
  const int vcol = tid >> 2, vpc = tid & 3;
  const int sr8 = tid >> 3, sc8 = (tid & 7) * 16;
  const int qp = q0 + wrow + r32;
  struct { i32x4 vs0, ks0; } sr_[SDEPTH];
#define TROW(t) (WIN ? ((t) < 4 ? (t) * KVBLK : kstart + (t) * KVBLK) : (t) * KVBLK)
#define SLOAD(i, t) do { const int k0_ = TROW(t); sr_[i].vs0 = *reinterpret_cast<const i32x4*>(&Vh[(long)vcol * RPB + k0_ + vpc * 16]); \
    sr_[i].ks0 = *reinterpret_cast<const i32x4*>(&Kh[(long)(k0_ + sr8) * LDK + sc8]); } while (0)
#define SWRITE(bo, i) do { *(i32x4*)(V_lds + (bo) + VSWZ8(vcol, vpc)) = sr_[i].vs0;          \
    *(i32x4*)((char*)K_lds + (bo) + KSWZ8(sr8, sc8)) = sr_[i].ks0; } while (0)
#define SWAIT() do { if constexpr (SDEPTH == 2) asm volatile("s_waitcnt vmcnt(2)" ::: "memory"); else asm volatile("s_waitcnt vmcnt(0)" ::: "memory"); } while (0)
#define RESC(a) do { if (__any((a) < 1.f)) { if (hi == 0) al_l[r32] = (a); asm volatile("s_waitcnt lgkmcnt(0)" ::: "memory"); \
    for (int d = 0; d < 4; ++d) for (int r = 0; r < 16; ++r) o[d][r] *= al_l[crow(r, hi)]; } } while (0)
#define WMASK(P0, P1, t) do { if (WIN) { if ((t) >= 4) wmask(P0, P1, kstart + ((t) - 4) * KVBLK, qp, hi); } } while (0)
  f32x16 pA0, pA1, pB0, pB1; float mnA, mnB, alA, alB; i32x8 pa;
  constexpr int SE = 0, SO = SDEPTH - 1;
  static_assert(SDEPTH == 2 && SHM_V == SHM_K, "ring schedule below");
  SLOAD(SE, 0); asm volatile("s_waitcnt vmcnt(0)" ::: "memory"); SWRITE(0, SE); __syncthreads();
  qkt(pA0, pA1, K_lds, qr, r32, hi); WMASK(pA0, pA1, 0); partialSM(pA0, pA1, m_reg, mnA, alA);
  SLOAD(SO, 1); if (2 < NT) SLOAD(SE, 2);
  SWAIT(); SWRITE((int)SHM_K, SO); if (3 < NT) SLOAD(SO, 3); __syncthreads();
  int r0 = 0, r1 = (int)SHM_K, r2 = 2 * (int)SHM_K;
  for (int j = 1; j + 1 < NT; j += 2) {
    qk_fin(pB0, pB1, K_lds + r1, qr, pA0, pA1, alA, l_reg, pa, r32, hi); WMASK(pB0, pB1, j);
    SWAIT(); SWRITE(r2, SE); if (j + 3 < NT) SLOAD(SE, j + 3); SBAR();
    pv_part(o, V_lds + r0, pa, pB0, pB1, m_reg, alB, r32, hi);
    RESC(alB); __syncthreads();
    qk_fin(pA0, pA1, K_lds + r2, qr, pB0, pB1, alB, l_reg, pa, r32, hi); WMASK(pA0, pA1, j + 1);
    SWAIT(); SWRITE(r0, SO); if (j + 4 < NT) SLOAD(SO, j + 4); SBAR();
    pv_part(o, V_lds + r1, pa, pA0, pA1, m_reg, alA, r32, hi);
    RESC(alA); __syncthreads();
    { const int t0 = r0, t1 = r1; r0 = r2; r1 = t0; r2 = t1; }
  }
  qk_fin(pB0, pB1, K_lds + r1, qr, pA0, pA1, alA, l_reg, pa, r32, hi); WMASK(pB0, pB1, NT - 1);
  pv_part(o, V_lds + r0, pa, pB0, pB1, m_reg, alB, r32, hi);
  RESC(alB);
  finishSM(pB0, pB1, alB, l_reg, pa); SBAR();
  pv_d0(o, V_lds + r1, pa, r32, hi);
  if (WIN) { constexpr float C = SCALE * 1.4426950408889634f; l_reg += __builtin_amdgcn_exp2f(((wid >> 2) ? sink1_l2 : sink_l2) - m_reg * C + 4.f); }
  if (hi == 0) li_l[r32] = l_reg; asm volatile("s_waitcnt lgkmcnt(0)" ::: "memory");
  float rli[16];
#pragma unroll
  for (int r = 0; r < 16; ++r) rli[r] = __builtin_amdgcn_rcpf(li_l[crow(r, hi)]);
  unsigned char* Ow = Ob + (long)wrow * LDQ + hoff;
#pragma unroll
  for (int r = 0; r < 16; ++r) { const int orow = crow(r, hi);
#pragma unroll
    for (int d0 = 0; d0 < 4; ++d0) { const float v = o[d0][r] * rli[r] * O8_SCALE;     Ow[(long)orow * LDQ + d0 * 32 + r32] = (unsigned char)(__builtin_amdgcn_cvt_pk_fp8_f32(v, v, 0, false) & 0xff); } }
  __syncthreads();
#undef TROW
#undef SLOAD
#undef SWRITE
#undef SWAIT
#undef RESC
#undef WMASK
}
#undef KSWZ
#undef SBAR
}

namespace mk {
namespace cg = cooperative_groups;
typedef unsigned short bf16;
typedef short bf16x8 __attribute__((ext_vector_type(8)));
typedef float f32x4 __attribute__((ext_vector_type(4)));
typedef unsigned u32x4 __attribute__((ext_vector_type(4)));
typedef unsigned u32x2 __attribute__((ext_vector_type(2)));
typedef __bf16 bf2_t __attribute__((ext_vector_type(2)));
#define LAS __attribute__((address_space(3)))
constexpr int NWAVES = 8, NTHR = 512;
constexpr size_t MiB = 1u << 20;
constexpr size_t WS_CTL = 0, CTL_BYTES = 1 * MiB;
constexpr size_t WS_MOD = 1 * MiB;
constexpr size_t WS_ROPE = 1 * MiB + 512 * 1024;
constexpr size_t WS_XC = 2 * MiB;
constexpr size_t WS_WQKV = 6 * MiB;
constexpr size_t WS_WO = 12 * MiB;
constexpr size_t WS_WP = 16 * MiB;
constexpr size_t WS_H = 24 * MiB;
constexpr size_t WS_Q = 58 * MiB;
constexpr size_t WS_K = 92 * MiB;
constexpr size_t WS_V = 101 * MiB;
constexpr size_t WS_EIDX = 110 * MiB;
constexpr size_t WS_GATE = 119 * MiB;
constexpr size_t WS_PW = 128 * MiB;
constexpr size_t WS_S = 137 * MiB;
constexpr size_t WS_UT = 274 * MiB;
constexpr size_t WS_VT = 306 * MiB;
constexpr size_t WS_O = 338 * MiB;
constexpr size_t WS_XB = 372 * MiB;
constexpr size_t WS_XCB = 436 * MiB;
constexpr size_t WS_PART = 440 * MiB;
constexpr size_t WS_END = 508 * MiB;
constexpr float U8_SCALE = 64.f;
constexpr float V4_SCALE = 5.656854249f;
constexpr int LDS_BYTES = 155648;
constexpr int NPHASE = 23;

struct Args { const float* in[17]; float* out; unsigned char* ws; int ph_lo, ph_hi; };

constexpr int PTAB_OFF = 153600;
struct Ctx {
  unsigned char* ws;
  int tid, lane, wave, bid, G;
  LAS unsigned char* lds; unsigned char* ldsg;
  __device__ __forceinline__ const float* in(int k) const {
    const volatile LAS unsigned* t = (const volatile LAS unsigned*)(lds + PTAB_OFF) + 2 * k;
    const unsigned lo = __builtin_amdgcn_readfirstlane(t[0]), hi = __builtin_amdgcn_readfirstlane(t[1]);
    return (const float*)(((unsigned long long)hi << 32) | lo);
  }
  __device__ __forceinline__ float* outp() const { return (float*)in(17); }
};
enum { I_X = 0, I_C, I_CTX, I_CCTX, I_ADAW, I_ADAB, I_N1G, I_N2G, I_WQKV, I_QNG, I_KNG, I_WO, I_SINKS, I_PWQ, I_PSK, I_PU, I_PV };

__device__ __forceinline__ unsigned f2bf(float f) { unsigned u = __builtin_bit_cast(unsigned, f); return (u + 0x7fffu + ((u >> 16) & 1u)) >> 16; }
__device__ __forceinline__ unsigned pk2(float lo, float hi) { unsigned r; asm volatile("v_cvt_pk_bf16_f32 %0, %1, %2" : "=v"(r) : "v"(lo), "v"(hi)); return r; }
__device__ __forceinline__ float bflo(unsigned u) { return __uint_as_float(u << 16); }
__device__ __forceinline__ float bfhi(unsigned u) { return __uint_as_float(u & 0xffff0000u); }
__device__ __forceinline__ float silu(float x) { return x / (1.f + __expf(-x)); }
__device__ __forceinline__ float gelu_tanh(float x) {
  const float y = 0.7978845608028654f * (x + 0.044715f * x * x * x);
  const float t = 1.f - 2.f / (__expf(2.f * y) + 1.f);
  return 0.5f * x * (1.f + t);
}
__device__ __forceinline__ float wave_sum(float v) {
#pragma unroll
  for (int o = 1; o < 64; o <<= 1) v += __shfl_xor(v, o);
  return v;
}
__device__ __forceinline__ const float* xrow_sel(const float* lat, const float* cx, int r) { const int b = r / RPB, j = r % RPB; return j < CTXL ? cx + (size_t)(b * CTXL + j) * DM : lat + (size_t)(b * SEQ + (j - CTXL)) * DM; }
__device__ __forceinline__ int mod_row(int r) { const int b = r / RPB, j = r % RPB; return j < CTXL ? 4 : b; }

__device__ __forceinline__ const float* st_lat(const Ctx& F, int sel) { return sel == 0 ? F.in(I_X) : (sel == 1 ? (const float*)(F.ws + WS_XB) : (const float*)F.outp()); }
__device__ __forceinline__ const float* st_ctx(const Ctx& F, int sel) { return sel == 0 ? F.in(I_CTX) : (sel == 1 ? (const float*)(F.ws + WS_XCB) : (const float*)(F.ws + WS_XC)); }
__device__ __forceinline__ int qk_perm_col(int n) {
  if (n >= (NH + NKV) * HD) return n; const int d = n & 127, axis = d >> 6, pair = (d >> 5) & 1, f = d & 31; return (n & ~127) + 2 * (axis * 32 + f) + pair; }
constexpr float W8_SCALE = 32.f;
template <bool QKPERM, bool FP8>
__device__ __forceinline__ void p0_transpose_item(const float* W, int K, int N, bf16* WT, LAS float* scr, int item, int lane) {
  const int nblk = N / 32, kb = item / nblk, nb = item % nblk, k0 = 64 * kb, n0 = 32 * nb;
  { float t[32];
#pragma unroll
    for (int i = 0; i < 32; ++i) t[i] = W[(size_t)(k0 + 2 * i + (lane >> 5)) * N + n0 + (lane & 31)];
#pragma unroll
    for (int i = 0; i < 32; ++i) scr[(2 * i + (lane >> 5)) * 33 + (lane & 31)] = t[i]; }
  asm volatile("s_waitcnt lgkmcnt(0)" ::: "memory");
  const int c = lane & 7;
#pragma unroll
  for (int j = 0; j < 4; ++j) { const int n = (lane >> 3) + 8 * j; const LAS float* s = scr + (8 * c) * 33 + n;
    if constexpr (FP8) { int v0 = __builtin_amdgcn_cvt_pk_fp8_f32(s[0 * 33] * W8_SCALE, s[1 * 33] * W8_SCALE, 0, false); v0 = __builtin_amdgcn_cvt_pk_fp8_f32(s[2 * 33] * W8_SCALE, s[3 * 33] * W8_SCALE, v0, true);
      int v1 = __builtin_amdgcn_cvt_pk_fp8_f32(s[4 * 33] * W8_SCALE, s[5 * 33] * W8_SCALE, 0, false); v1 = __builtin_amdgcn_cvt_pk_fp8_f32(s[6 * 33] * W8_SCALE, s[7 * 33] * W8_SCALE, v1, true);
      u32x2 o; o.x = (unsigned)v0; o.y = (unsigned)v1; *(u32x2*)((unsigned char*)WT + (size_t)(QKPERM ? qk_perm_col(n0 + n) : n0 + n) * K + k0 + 8 * c) = o; }
    else { u32x4 o; o.x = pk2(s[0 * 33], s[1 * 33]); o.y = pk2(s[2 * 33], s[3 * 33]); o.z = pk2(s[4 * 33], s[5 * 33]); o.w = pk2(s[6 * 33], s[7 * 33]);
      *(u32x4*)(WT + (size_t)(QKPERM ? qk_perm_col(n0 + n) : n0 + n) * K + k0 + 8 * c) = o; } }
  asm volatile("s_waitcnt lgkmcnt(0)" ::: "memory");
}

constexpr int CONV_NR = DEPTH * NKEYS * NKEYS;
__device__ __forceinline__ int conv_idle(int G, int p) { const int nu = p == 0 ? 408 : (p == 1 ? 272 : 544); return (nu % G) ? G - (nu % G) : 0; }
__device__ __forceinline__ void conv_slot(const Ctx& F, int p, int& lo, int& hi) {
  const int i0 = conv_idle(F.G, 0), i1 = conv_idle(F.G, 1), i2 = conv_idle(F.G, 2), tw = 8 * i0 + 4 * i1 + 10 * i2; lo = hi = 0; if (tw == 0) return;
  const int unit = (2 * CONV_NR + tw - 1) / tw;
  const int mine = conv_idle(F.G, p), first = F.G - mine; if (F.bid < first) return;
  const int wgt = p == 0 ? 8 : (p == 1 ? 4 : 10), base = (p == 0 ? 0 : (p == 1 ? 8 * i0 : 8 * i0 + 4 * i1)) + wgt * (F.bid - first);
  lo = base * unit; hi = lo + wgt * unit;
}
__device__ __forceinline__ void convert_rows(const Ctx& F, int r_lo, int r_hi) {
  constexpr int NR = CONV_NR;
  const float* pup = F.in(I_PU); const float* pvp = F.in(I_PV);
  if (r_hi > 2 * NR) r_hi = 2 * NR;
  for (int rr = r_lo + F.wave; rr < r_hi; rr += 2 * NWAVES) {
    f32x4 a[2][4];
#pragma unroll
    for (int q = 0; q < 2; ++q) { const int row = rr + q * NWAVES; if (row < r_hi) { const float* src = (row < NR ? pup : pvp) + (size_t)(row < NR ? row : row - NR) * DM;
#pragma unroll
        for (int i = 0; i < 4; ++i) a[q][i] = ((const f32x4*)src)[i * 64 + F.lane]; } }
#pragma unroll
    for (int q = 0; q < 2; ++q) { const int row = rr + q * NWAVES; if (row < r_hi) { const bool isu = row < NR; const int rw = isu ? row : row - NR;
        const size_t lay = (size_t)(rw >> 14), ex = (size_t)(rw & 16383);
        if (isu) { unsigned char* dst = F.ws + WS_UT;
#pragma unroll
          for (int i = 0; i < 4; ++i) { int v = __builtin_amdgcn_cvt_pk_fp8_f32(a[q][i].x * U8_SCALE, a[q][i].y * U8_SCALE, 0, false); v = __builtin_amdgcn_cvt_pk_fp8_f32(a[q][i].z * U8_SCALE, a[q][i].w * U8_SCALE, v, true);
            const int sl = 2 * i + (F.lane >> 5); *(unsigned*)(dst + ((lay * 8 + sl) * 16384 + ex) * 128 + ((F.lane & 31) * 4)) = (unsigned)v; } }
        else { unsigned char* dst = F.ws + WS_VT;
#pragma unroll
          for (int i = 0; i < 4; ++i) { unsigned v = __builtin_amdgcn_cvt_scalef32_pk_fp4_f32(0u, a[q][i].x * V4_SCALE, a[q][i].y * V4_SCALE, 1.0f, 0); v = __builtin_amdgcn_cvt_scalef32_pk_fp4_f32(v, a[q][i].z * V4_SCALE, a[q][i].w * V4_SCALE, 1.0f, 1);
            *(unsigned short*)(dst + ((lay * 4 + i) * 16384 + ex) * 128 + F.lane * 2) = (unsigned short)v; } } } }
  }
}

__device__ __forceinline__ void phase_prologue(const Ctx& F) {
  { LAS float* sl = (LAS float*)F.lds;
    LAS float* red = sl + 5 * DM;
    { const float* cp = F.in(I_C); const float* ccp = F.in(I_CCTX);
      for (int e = F.tid; e < 5 * DM; e += NTHR) { const int r = e / DM, j = e % DM; sl[e] = silu(r < 4 ? cp[r * DM + j] : ccp[j]); } }
    __syncthreads();
    const float* adaw = F.in(I_ADAW); const float* adab = F.in(I_ADAB);
    for (int task = F.bid; task < DEPTH * 96; task += F.G) {
      const int i = task / 96, n = (task % 96) * 64 + F.lane;
      const float* w = adaw + (size_t)i * DM * NMOD * DM + n;
      float a0 = 0.f, a1 = 0.f, a2 = 0.f, a3 = 0.f, a4 = 0.f;
#pragma unroll 1
      for (int j0 = 0; j0 < 128; j0 += 32) { float wv[32];
#pragma unroll
        for (int jj = 0; jj < 32; ++jj) wv[jj] = w[(size_t)(F.wave * 128 + j0 + jj) * NMOD * DM];
#pragma unroll
        for (int jj = 0; jj < 32; ++jj) { const int j = F.wave * 128 + j0 + jj;
          a0 += sl[j] * wv[jj]; a1 += sl[DM + j] * wv[jj]; a2 += sl[2 * DM + j] * wv[jj]; a3 += sl[3 * DM + j] * wv[jj]; a4 += sl[4 * DM + j] * wv[jj]; } }
      red[(F.wave * 5 + 0) * 64 + F.lane] = a0; red[(F.wave * 5 + 1) * 64 + F.lane] = a1; red[(F.wave * 5 + 2) * 64 + F.lane] = a2;
      red[(F.wave * 5 + 3) * 64 + F.lane] = a3; red[(F.wave * 5 + 4) * 64 + F.lane] = a4;
      __syncthreads();
      if (F.tid < 320) { const int r = F.tid >> 6, l = F.tid & 63; float s = 0.f;
#pragma unroll
        for (int w8 = 0; w8 < 8; ++w8) s += red[(w8 * 5 + r) * 64 + l];
        const int nn = (task % 96) * 64 + l;
        ((float*)(F.ws + WS_MOD))[((size_t)i * 5 + r) * NMOD * DM + nn] = s + adab[i * NMOD * DM + nn]; }
      __syncthreads();
    }
  }
  { LAS float* sk = (LAS float*)F.lds;
    LAS float* wq = sk + 128 * 132;
    const float* pskp = F.in(I_PSK); const float* pwqp = F.in(I_PWQ);
    for (int task = F.bid; task < DEPTH * 8 * 2 * 16; task += F.G) {
      const int jc = task & 15, half = (task >> 4) & 1, h = (task >> 5) & 7, i = task >> 8;
      const float* SK = pskp + ((size_t)i * 2 + half) * NKEYS * 128;
      const float* WQ = pwqp + (size_t)i * DM * PQN + (size_t)(jc * 64) * PQN + h * PQD + half * 128;
      for (int e = F.tid; e < 128 * 32; e += NTHR) { const int kk = e >> 5, d4 = e & 31; const f32x4 v = *(const f32x4*)(SK + (size_t)kk * 128 + d4 * 4); *(LAS f32x4*)(sk + kk * 132 + d4 * 4) = v; }
      for (int e = F.tid; e < 64 * 32; e += NTHR) { const int j = e >> 5, d4 = e & 31; const f32x4 v = *(const f32x4*)(WQ + (size_t)j * PQN + d4 * 4); *(LAS f32x4*)(wq + j * 128 + d4 * 4) = v; }
      __syncthreads();
      const int kk = F.tid & 127, jg = F.tid >> 7;
      float acc[16];
#pragma unroll
      for (int q = 0; q < 16; ++q) acc[q] = 0.f;
#pragma unroll 2
      for (int d4 = 0; d4 < 32; ++d4) { const f32x4 s = *(const LAS f32x4*)(sk + kk * 132 + d4 * 4);
#pragma unroll
        for (int q = 0; q < 16; ++q) { const f32x4 w = *(const LAS f32x4*)(wq + (jg * 16 + q) * 128 + d4 * 4); acc[q] += s.x * w.x + s.y * w.y + s.z * w.z + s.w * w.w; } }
      bf16* o = (bf16*)(F.ws + WS_WP) + ((size_t)i * PQN + h * PQD + half * 128 + kk) * DM + jc * 64 + jg * 16;
      u32x4 o0, o1; o0.x = pk2(acc[0], acc[1]); o0.y = pk2(acc[2], acc[3]); o0.z = pk2(acc[4], acc[5]); o0.w = pk2(acc[6], acc[7]);
      o1.x = pk2(acc[8], acc[9]); o1.y = pk2(acc[10], acc[11]); o1.z = pk2(acc[12], acc[13]); o1.w = pk2(acc[14], acc[15]);
      *(u32x4*)o = o0; *(u32x4*)(o + 8) = o1;
      __syncthreads();
    }
  }
  { const int gt = F.bid * NTHR + F.tid; float* rp = (float*)(F.ws + WS_ROPE);
    if (gt < 64 * 32) { const int pos = gt >> 5, f = gt & 31; const float inv = exp2f(-(float)(2 * f) * (13.287712379549449f / 64.f)); float sn, cs; sincosf((float)pos * inv, &sn, &cs); rp[2 * gt] = cs; rp[2 * gt + 1] = sn; }
    else if (gt < 64 * 32 + DEPTH * 2 * HD) { const int e = gt - 64 * 32, p = e & 127, which = (e >> 7) & 1, layer = e >> 8; const int q = p >> 1, pair = p & 1, d = (q >> 5) * 64 + pair * 32 + (q & 31);
      rp[64 * 32 * 2 + e] = (which == 0 ? F.in(I_QNG) : F.in(I_KNG))[layer * HD + d]; } }
  if (8 * conv_idle(F.G, 0) + 4 * conv_idle(F.G, 1) + 10 * conv_idle(F.G, 2) == 0) { const int per = (2 * CONV_NR + F.G - 1) / F.G; convert_rows(F, F.bid * per, (F.bid + 1) * per); }
  { LAS float* scr = (LAS float*)F.lds + F.wave * (64 * 33 + 16);
    const int gw = F.bid * NWAVES + F.wave, NGW = F.G * NWAVES;
    constexpr int I_QKV = (DM / 64) * (QKVD / 32), I_O = (DM / 64) * (DM / 32);
    const float* wqkvp = F.in(I_WQKV); const float* wop = F.in(I_WO);
    for (int it = gw; it < DEPTH * (I_QKV + I_O); it += NGW) {
      const int i = it / (I_QKV + I_O); int r = it % (I_QKV + I_O);
      if (r < I_QKV) p0_transpose_item<true, true>(wqkvp + (size_t)i * DM * QKVD, DM, QKVD, (bf16*)(F.ws + WS_WQKV + (size_t)i * QKVD * DM), scr, r, F.lane);
      else p0_transpose_item<false, true>(wop + (size_t)i * DM * DM, DM, DM, (bf16*)(F.ws + WS_WO + (size_t)i * DM * DM), scr, r - I_QKV, F.lane);
    }
  }
}

constexpr float H8_SCALE = 4.f;
__device__ __forceinline__ void phase_norm(const Ctx& F, int layer, int which  , int src_sel, bool latent_only) {
  const int gw = F.bid * NWAVES + F.wave, NGW = F.G * NWAVES;
  const float* gain = (which == 0 ? F.in(I_N1G) : F.in(I_N2G)) + layer * DM;
  const float* modl = (const float*)(F.ws + WS_MOD) + (size_t)layer * 5 * NMOD * DM;
  bf16* H = (bf16*)(F.ws + WS_H);
  const float* latp = st_lat(F, src_sel); const float* cxp = st_ctx(F, src_sel);
  for (int r = gw; r < NROWS; r += NGW) {
    if (latent_only && (r % RPB) < CTXL) continue;
    const float* xr = xrow_sel(latp, cxp, r);
    const float* mrow = modl + (size_t)mod_row(r) * NMOD * DM;
    const float* sh = mrow + (which == 0 ? 0 : 3) * DM; const float* sc = mrow + (which == 0 ? 1 : 4) * DM;
    f32x4 v[4]; float s = 0.f;
#pragma unroll
    for (int j = 0; j < 4; ++j) { v[j] = ((const f32x4*)xr)[F.lane + 64 * j]; s += (v[j].x * v[j].x + v[j].y * v[j].y) + (v[j].z * v[j].z + v[j].w * v[j].w); }
    const float rstd = rsqrtf(wave_sum(s) * (1.f / DM) + RMS_EPS);
    unsigned long long* o8 = (unsigned long long*)(H + (size_t)r * DM) + F.lane;
#pragma unroll
    for (int j = 0; j < 4; ++j) { const f32x4 g = ((const f32x4*)gain)[F.lane + 64 * j], a = ((const f32x4*)sc)[F.lane + 64 * j], b = ((const f32x4*)sh)[F.lane + 64 * j];
      const float y0 = v[j].x * rstd * g.x * (1.f + a.x) + b.x, y1 = v[j].y * rstd * g.y * (1.f + a.y) + b.y, y2 = v[j].z * rstd * g.z * (1.f + a.z) + b.z, y3 = v[j].w * rstd * g.w * (1.f + a.w) + b.w;
      if (which == 0) { int v8 = __builtin_amdgcn_cvt_pk_fp8_f32(y0 * H8_SCALE, y1 * H8_SCALE, 0, false); v8 = __builtin_amdgcn_cvt_pk_fp8_f32(y2 * H8_SCALE, y3 * H8_SCALE, v8, true);
        ((unsigned*)((unsigned char*)H + (size_t)r * DM))[F.lane + 64 * j] = (unsigned)v8; }
      else o8[64 * j] = (unsigned long long)pk2(y0, y1) | ((unsigned long long)pk2(y2, y3) << 32); }
  }
}

__device__ __forceinline__ void phase_qknorm(const Ctx& F, int layer) {
  const int gw = F.bid * NWAVES + F.wave, NGW = F.G * NWAVES;
  const int axis = F.lane >> 5, f = F.lane & 31, e1 = axis * 64 + f, e2 = e1 + 32;
  const float* qg = F.in(I_QNG) + layer * HD; const float* kg = F.in(I_KNG) + layer * HD;
  const float qg1 = qg[e1], qg2 = qg[e2], kg1 = kg[e1], kg2 = kg[e2];
  const float inv = exp2f(-(float)(2 * f) * (13.287712379549449f / 64.f));
  bf16* Q = (bf16*)(F.ws + WS_Q); bf16* K = (bf16*)(F.ws + WS_K);
  for (int r = gw; r < NROWS; r += NGW) {
    const int j = r % RPB; float cs = 1.f, sn = 0.f;
    if (j >= CTXL) { const int sp = j - CTXL; const float pos = (float)(axis == 0 ? (sp >> 6) : (sp & 63)); sincosf(pos * inv, &sn, &cs); }
#pragma unroll
    for (int h = 0; h < NH + NKV; ++h) {
      bf16* base = h < NH ? Q + (size_t)r * DM + h * HD : K + (size_t)r * (NKV * HD) + (h - NH) * HD;
      float x1 = bflo(base[e1]), x2 = bflo(base[e2]);
      const float rstd = rsqrtf(wave_sum(x1 * x1 + x2 * x2) * (1.f / HD) + RMS_EPS);
      x1 *= rstd * (h < NH ? qg1 : kg1); x2 *= rstd * (h < NH ? qg2 : kg2);
      const float y1 = x1 * cs - x2 * sn, y2 = x1 * sn + x2 * cs;
      base[e1] = (bf16)f2bf(y1); base[e2] = (bf16)f2bf(y2);
    }
  }
}
struct Order {
  int nM, nN, nwg, G, c, lat;
  __device__ void init(int nM_, int nN_, int G_, int c_, int lat_) { nM = nM_; nN = nN_; nwg = nM * nN; G = G_; c = c_; lat = lat_; }
  __device__ bool next(int i, pg8::Unit& u) const {
    const long L = (long)i * G + c; if (L >= nwg) return false;
    int wgid = (int)L; { const int q = nwg / 8, r = nwg % 8, xcd = wgid % 8, off = wgid / 8; wgid = (xcd < r ? xcd * (q + 1) : r * (q + 1) + (xcd - r) * q) + off; }
    const int WGM = 8, nig = WGM * nN, gid = wgid / nig, fm = gid * WGM, gsz = (nM - fm) < WGM ? (nM - fm) : WGM;
    int pm = fm + ((wgid % nig) % gsz); u.pn = (wgid % nig) / gsz;
    if (lat) pm = (pm >> 4) * 17 + 1 + (pm & 15);
    u.pm = pm; return true;
  }
  __device__ __forceinline__ void a_ready(const pg8::Unit&) const {}
  __device__ __forceinline__ void done(const pg8::Unit&) const {}
};
struct EpiQKV {
  static constexpr bool PERM = true, AFTER_DRAIN = false;
  unsigned char* ws; LAS float* xs  ; int layer;
  __device__ __forceinline__ void operator()(const pg8::f32x4 (&acc)[2][2][4][2], const pg8::Unit& u, int wr, int wc, int fr, int fq) const {
    const int row0 = u.pm * 256 + wr * 64 + fr;
    const size_t boff = u.pn < 4 ? WS_Q : (u.pn == 4 ? WS_K : WS_V); const int ldc = u.pn < 4 ? DM : NKV * HD, colt = u.pn < 4 ? u.pn * 256 : 0;
    bf16* base = (bf16*)(ws + boff);
    const int col0 = colt + wc * 32 + 8 * fq;
    if (u.pn == 5) {
      unsigned char* vt = ws + WS_V; const int bt = (u.pm * 256) / RPB, key0 = (u.pm * 256) % RPB + wr * 64 + fr;
#pragma unroll
      for (int ai = 0; ai < 2; ++ai)
#pragma unroll
        for (int m = 0; m < 4; ++m) { const int key = key0 + ai * 128 + m * 16;
#pragma unroll
          for (int bj = 0; bj < 2; ++bj) { const pg8::f32x4 v0 = acc[ai][bj][m][0], v1 = acc[ai][bj][m][1];
            int w0 = __builtin_amdgcn_cvt_pk_fp8_f32(v0[0] * att::V8A_SCALE, v0[1] * att::V8A_SCALE, 0, false); w0 = __builtin_amdgcn_cvt_pk_fp8_f32(v0[2] * att::V8A_SCALE, v0[3] * att::V8A_SCALE, w0, true);
            int w1 = __builtin_amdgcn_cvt_pk_fp8_f32(v1[0] * att::V8A_SCALE, v1[1] * att::V8A_SCALE, 0, false); w1 = __builtin_amdgcn_cvt_pk_fp8_f32(v1[2] * att::V8A_SCALE, v1[3] * att::V8A_SCALE, w1, true);
            unsigned char* cp = vt + ((size_t)((bt * 2 + bj) * 128 + wc * 32 + 8 * fq)) * RPB + key;
            cp[0 * RPB] = (unsigned char)(w0 & 0xff); cp[1 * RPB] = (unsigned char)((w0 >> 8) & 0xff); cp[2 * RPB] = (unsigned char)((w0 >> 16) & 0xff); cp[3 * RPB] = (unsigned char)((unsigned)w0 >> 24);
            cp[4 * RPB] = (unsigned char)(w1 & 0xff); cp[5 * RPB] = (unsigned char)((w1 >> 8) & 0xff); cp[6 * RPB] = (unsigned char)((w1 >> 16) & 0xff); cp[7 * RPB] = (unsigned char)((unsigned)w1 >> 24); } }
      return;
    }
#pragma unroll
    for (int ai = 0; ai < 2; ++ai)
#pragma unroll
      for (int m = 0; m < 4; ++m)
#pragma unroll
        for (int bj = 0; bj < 2; ++bj) { const pg8::f32x4 v0 = acc[ai][bj][m][0], v1 = acc[ai][bj][m][1];
          float ss = (v0[0] * v0[0] + v0[1] * v0[1]) + (v0[2] * v0[2] + v0[3] * v0[3]) + (v1[0] * v1[0] + v1[1] * v1[1]) + (v1[2] * v1[2] + v1[3] * v1[3]);
          ss += __shfl_xor(ss, 16); ss += __shfl_xor(ss, 32);
          if (fq == 0) xs[((((wr * 2 + ai) * 4 + m) * 16 + fr) * 2 + bj) * 4 + wc] = ss; }
    asm volatile("s_waitcnt lgkmcnt(0)" ::: "memory"); __builtin_amdgcn_s_barrier(); asm volatile("" ::: "memory");
    const float* rp = (const float*)(ws + WS_ROPE);
    const float* gp = rp + 64 * 32 * 2 + (layer * 2 + (u.pn < 4 ? 0 : 1)) * HD + wc * 32 + 8 * fq;
    const f32x4 g0 = *(const f32x4*)gp, g1 = *(const f32x4*)(gp + 4);
    const bool latent = (u.pm % 17) != 0;
    const int axis = wc >> 1, f0 = 16 * (wc & 1) + 4 * fq;
#pragma unroll
    for (int ai = 0; ai < 2; ++ai)
#pragma unroll
      for (int m = 0; m < 4; ++m) { const int r = row0 + ai * 128 + m * 16;
        f32x4 c01 = {1.f, 0.f, 1.f, 0.f}, c23 = {1.f, 0.f, 1.f, 0.f};
        if (latent) { const int sp = (r % RPB) - CTXL, pos = axis == 0 ? (sp >> 6) : (sp & 63); const float* cp = rp + (pos * 32 + f0) * 2; c01 = *(const f32x4*)cp; c23 = *(const f32x4*)(cp + 4); }
        unsigned char* rowp = (unsigned char*)base + (size_t)r * ldc + col0;
#pragma unroll
        for (int bj = 0; bj < 2; ++bj) { const LAS float* xp = xs + ((((wr * 2 + ai) * 4 + m) * 16 + fr) * 2 + bj) * 4;
          const float rstd = rsqrtf(((xp[0] + xp[1]) + (xp[2] + xp[3])) * (1.f / HD) + RMS_EPS);
          const pg8::f32x4 v0 = acc[ai][bj][m][0], v1 = acc[ai][bj][m][1];
          const float a0 = v0[0] * rstd * g0.x, b0 = v0[1] * rstd * g0.y, a1 = v0[2] * rstd * g0.z, b1 = v0[3] * rstd * g0.w;
          const float a2 = v1[0] * rstd * g1.x, b2 = v1[1] * rstd * g1.y, a3 = v1[2] * rstd * g1.z, b3 = v1[3] * rstd * g1.w;
          constexpr float QS = att::QK8_SCALE;
          int w0 = __builtin_amdgcn_cvt_pk_fp8_f32((a0 * c01.x - b0 * c01.y) * QS, (a0 * c01.y + b0 * c01.x) * QS, 0, false); w0 = __builtin_amdgcn_cvt_pk_fp8_f32((a1 * c01.z - b1 * c01.w) * QS, (a1 * c01.w + b1 * c01.z) * QS, w0, true);
          int w1 = __builtin_amdgcn_cvt_pk_fp8_f32((a2 * c23.x - b2 * c23.y) * QS, (a2 * c23.y + b2 * c23.x) * QS, 0, false); w1 = __builtin_amdgcn_cvt_pk_fp8_f32((a3 * c23.z - b3 * c23.w) * QS, (a3 * c23.w + b3 * c23.z) * QS, w1, true);
          u32x2 w; w.x = (unsigned)w0; w.y = (unsigned)w1; *(u32x2*)(rowp + bj * 128) = w; } }
    asm volatile("s_waitcnt lgkmcnt(0)" ::: "memory"); __builtin_amdgcn_s_barrier(); asm volatile("" ::: "memory");
  }
};
struct EpiRes {
  static constexpr bool PERM = false, AFTER_DRAIN = false;
  const float *xin, *cin; float *xout, *xc; const float* gmod  ;
  __device__ __forceinline__ void operator()(const pg8::f32x4 (&acc)[2][2][4][2], const pg8::Unit& u, int wr, int wc, int fr, int fq) const {
    const int col0 = u.pn * 256 + wc * 32 + 4 * fq;
#pragma unroll
    for (int ai = 0; ai < 2; ++ai)
#pragma unroll
      for (int m = 0; m < 4; ++m) { const int r = u.pm * 256 + ai * 128 + wr * 64 + m * 16 + fr;
        const int b_ = r / RPB, j_ = r % RPB; const size_t oc = (size_t)(b_ * CTXL + j_) * DM, ol = (size_t)(b_ * SEQ + (j_ - CTXL)) * DM;
        float* xn = j_ < CTXL ? xc + oc : xout + ol; const float* xo = j_ < CTXL ? cin + oc : xin + ol; const float* g = gmod + (size_t)(j_ < CTXL ? 4 : b_) * NMOD * DM;
#pragma unroll
        for (int bj = 0; bj < 2; ++bj)
#pragma unroll
          for (int n = 0; n < 2; ++n) { const int c = col0 + bj * 128 + n * 16; const f32x4 xv = *(const f32x4*)(xo + c), gv = *(const f32x4*)(g + c); const pg8::f32x4 a = acc[ai][bj][m][n];
            f32x4 o; o.x = xv.x + gv.x * a[0]; o.y = xv.y + gv.y * a[1]; o.z = xv.z + gv.z * a[2]; o.w = xv.w + gv.w * a[3]; *(f32x4*)(xn + c) = o; } }
  }
};
struct EpiF32 {
  static constexpr bool PERM = true, AFTER_DRAIN = false;
  _Float16* S; int ldc;
  __device__ __forceinline__ void operator()(const pg8::f32x4 (&acc)[2][2][4][2], const pg8::Unit& u, int wr, int wc, int fr, int fq) const {
    typedef _Float16 h8 __attribute__((ext_vector_type(8)));
    const int col0 = u.pn * 256 + wc * 32 + 8 * fq;
#pragma unroll
    for (int ai = 0; ai < 2; ++ai)
#pragma unroll
      for (int m = 0; m < 4; ++m) { _Float16* rowp = S + (size_t)(u.pm * 256 + ai * 128 + wr * 64 + m * 16 + fr) * ldc + col0;
#pragma unroll
        for (int bj = 0; bj < 2; ++bj) { const pg8::f32x4 v0 = acc[ai][bj][m][0], v1 = acc[ai][bj][m][1];
          h8 o; o[0] = (_Float16)v0[0]; o[1] = (_Float16)v0[1]; o[2] = (_Float16)v0[2]; o[3] = (_Float16)v0[3]; o[4] = (_Float16)v1[0]; o[5] = (_Float16)v1[1]; o[6] = (_Float16)v1[2]; o[7] = (_Float16)v1[3];
          *(h8*)(rowp + bj * 128) = o; } }
  }
};

__device__ __forceinline__ void phase_attn(const Ctx& F, int layer) {
  const unsigned char* Q = F.ws + WS_Q; const unsigned char* K = F.ws + WS_K; const unsigned char* V = F.ws + WS_V;
  char* lds = (char*)F.ldsg;
  const int pair = F.bid & 7, slot = F.bid >> 3, nslot = F.G >> 3;
  const int b = pair >> 1, g = pair & 1;
  const unsigned char* Kh = K + (size_t)(b * RPB) * (NKV * HD) + g * HD; const unsigned char* Vh = V + (size_t)((b * 2 + g) * 128) * RPB;
  const float* sinkp = F.in(I_SINKS);
  const int nunits = layer == 0 ? 68 : 64;
#pragma unroll 1
  for (int u = slot; u < nunits; u += nslot) {
    int h, NT, ks = 0, q0 = 0; float sk = 0.f, sk1 = 0.f; const unsigned char* Qb; const bool win = layer != 0;
    if (u < 64) {
      if (!win) { h = g * 4 + (u >> 4); const int qb = u & 15; Qb = Q + (size_t)(b * RPB + CTXL + qb * 256) * DM + h * HD; NT = RPB / 64; }
      else { h = g * 4 + (u >> 5) * 2; q0 = (u & 31) * 128; Qb = Q + (size_t)(b * RPB + CTXL + q0) * DM + h * HD;
        ks = q0 - 128 < 0 ? 0 : q0 - 128; const int ke = q0 + 256 > SEQ ? SEQ : q0 + 256; NT = 4 + (ke - ks) / 64;
        sk = sinkp[(layer / 2) * NH + h] * 1.4426950408889634f; sk1 = sinkp[(layer / 2) * NH + h + 1] * 1.4426950408889634f; } }
    else { h = g * 4 + (u - 64); Qb = Q + (size_t)(b * RPB) * DM + h * HD; NT = CTXL / 64; }
    att::attn_unit(win, Qb, F.ws + WS_O + (Qb - Q), Kh, Vh, NT, ks, q0, sk, sk1, lds);
  }
}

__device__ __forceinline__ void ins16(float (&v)[16], float x) {
#pragma unroll
  for (int i = 0; i < 16; ++i) { const float hi = fmaxf(v[i], x); x = fminf(v[i], x); v[i] = hi; }
}
#define CE_DESC(x, y) do { const float hi_ = fmaxf(x, y), lo_ = fminf(x, y); x = hi_; y = lo_; } while (0)
__device__ __forceinline__ void bitonic_merge16(float (&v)[16]) {
#pragma unroll
  for (int j = 8; j >= 1; j >>= 1)
#pragma unroll
    for (int i = 0; i < 16; ++i) if ((i & j) == 0) CE_DESC(v[i], v[i | j]);
}
__device__ __forceinline__ void bitonic_sort16(float (&v)[16]) {
#pragma unroll
  for (int k = 2; k <= 16; k <<= 1)
#pragma unroll
    for (int j = k >> 1; j >= 1; j >>= 1)
#pragma unroll
      for (int i = 0; i < 16; ++i) { const int l = i ^ j; if (l > i) { if ((i & k) == 0 || k == 16) CE_DESC(v[i], v[l]); else CE_DESC(v[l], v[i]); } }
}
__device__ __forceinline__ void top16_merge(float (&a)[16], const float (&b)[16]) {
#pragma unroll
  for (int i = 0; i < 16; ++i) a[i] = fmaxf(a[i], b[15 - i]);
  bitonic_merge16(a);
}
__device__ __forceinline__ void topk_step1(const LAS float* sc, LAS unsigned* T, int tid) {
  float v[16];
  { const LAS float* my = sc + tid * 65; const unsigned eb = (tid & 1) * 64;
    float g1[16];
#define LOAD16(dst, off) do { _Pragma("unroll") for (int e = 0; e < 16; ++e) dst[e] = __uint_as_float((__float_as_uint(my[(off) + e]) & ~127u) | (eb + (off) + e)); } while (0)
    LOAD16(v, 0); bitonic_sort16(v); LOAD16(g1, 16); bitonic_sort16(g1); top16_merge(v, g1);
    float h1[16];
    LOAD16(h1, 32); bitonic_sort16(h1); LOAD16(g1, 48); bitonic_sort16(g1); top16_merge(h1, g1);
    top16_merge(v, h1);
#undef LOAD16
  }
  { float o[16];
#pragma unroll
    for (int i = 0; i < 16; ++i) o[i] = __shfl_xor(v[i], 1);
    top16_merge(v, o); }
  if ((tid & 1) == 0) {
#pragma unroll
    for (int i = 0; i < 16; ++i) T[(tid >> 1) * 16 + i] = __float_as_uint(v[i]); }
}
__device__ __forceinline__ void topk_step2(const LAS unsigned* T, int p1, int* eout, float* gout) {
  const int p2 = p1 + 16;
  float a[16], bq[16];
#pragma unroll
  for (int i = 0; i < 16; ++i) { a[i] = __uint_as_float(T[p1 + i] & ~127u); bq[i] = __uint_as_float(T[p2 + i] & ~127u); }
  float w[16];
#pragma unroll
  for (int i = 0; i < 16; ++i) w[i] = __uint_as_float((__float_as_uint(a[0] + bq[i]) & ~255u) | (unsigned)i);
  { float r1[16];
#pragma unroll
    for (int i = 0; i < 16; ++i) r1[i] = i < 8 ? __uint_as_float((__float_as_uint(a[1] + bq[i]) & ~255u) | (unsigned)(16 + i)) : -INFINITY;
    top16_merge(w, r1); }
#pragma unroll
  for (int ia = 2; ia < 16; ++ia)
#pragma unroll
    for (int ib = 0; ib < 16; ++ib) if ((ia + 1) * (ib + 1) <= 16) { const float s_ = a[ia] + bq[ib]; ins16(w, __uint_as_float((__float_as_uint(s_) & ~255u) | (unsigned)(ia * 16 + ib))); }
  float ts[16]; int ex[16];
#pragma unroll
  for (int k = 0; k < 16; ++k) { const unsigned id = __float_as_uint(w[k]) & 255u; const unsigned k1 = T[p1 + (id >> 4)], k2 = T[p2 + (id & 15)];
    ts[k] = __uint_as_float(k1 & ~127u) + __uint_as_float(k2 & ~127u); ex[k] = (int)((k1 & 127u) * NKEYS + (k2 & 127u)); }
  float m = ts[0];
#pragma unroll
  for (int k = 1; k < 16; ++k) m = fmaxf(m, ts[k]);
  float l = 0.f;
#pragma unroll
  for (int k = 0; k < 16; ++k) { ts[k] = __expf(ts[k] - m); l += ts[k]; }
  const float il = 1.f / l;
#pragma unroll
  for (int k = 0; k < 16; k += 4) { *(int4*)(eout + k) = make_int4(ex[k], ex[k + 1], ex[k + 2], ex[k + 3]);
    f32x4 gv; gv.x = ts[k] * il; gv.y = ts[k + 1] * il; gv.z = ts[k + 2] * il; gv.w = ts[k + 3] * il; *(f32x4*)(gout + k) = gv; }
}
struct EpiTopk {
  static constexpr bool PERM = false, AFTER_DRAIN = true;
  int* EIDX; float* GATE;
  __device__ __forceinline__ void fused(pg8::f32x4 (&acc)[2][2][4][2], const pg8::Unit& u, int wr, int wc, int fr, int fq, PG8_LAS unsigned char* lds, int wid, int lane) const {
    LAS float* sc = (LAS float*)lds; LAS unsigned* T = (LAS unsigned*)(lds + 512 * 65 * 4);
    const int tid = wid * 64 + lane;
#pragma unroll
    for (int ai = 0; ai < 2; ++ai) {
#pragma unroll
      for (int m = 0; m < 4; ++m) { const int rl = wr * 64 + m * 16 + fr;
#pragma unroll
        for (int bj = 0; bj < 2; ++bj)
#pragma unroll
          for (int n = 0; n < 2; ++n) { const int c = bj * 128 + wc * 32 + n * 16 + fq * 4; LAS float* d = sc + (rl * 4 + (c >> 6)) * 65 + (c & 63); const pg8::f32x4 a = acc[ai][bj][m][n];
            d[0] = a[0]; d[1] = a[1]; d[2] = a[2]; d[3] = a[3]; } }
      asm volatile("s_waitcnt lgkmcnt(0)" ::: "memory"); __builtin_amdgcn_s_barrier(); asm volatile("" ::: "memory");
      topk_step1(sc, T, tid);
      asm volatile("s_waitcnt lgkmcnt(0)" ::: "memory"); __builtin_amdgcn_s_barrier(); asm volatile("" ::: "memory");
      if (tid < 128) { const size_t ob = (size_t)(u.pm * 256 + ai * 128 + tid) * 128 + u.pn * 16; topk_step2(T, tid * 32, EIDX + ob, GATE + ob); }
      asm volatile("s_waitcnt lgkmcnt(0)" ::: "memory"); __builtin_amdgcn_s_barrier(); asm volatile("" ::: "memory");
    }
  }
};
struct OneUnit {
  pg8::Unit u0;
  __device__ bool next(int i, pg8::Unit& u) const { if (i != 0) return false; u = u0; return true; }
  __device__ __forceinline__ void a_ready(const pg8::Unit&) const {}
  __device__ __forceinline__ void done(const pg8::Unit&) const {}
};
__device__ __forceinline__ void phase_topk(const Ctx& F, bool latent_only) {
  LAS float* sc = (LAS float*)F.lds;
  LAS unsigned* T = (LAS unsigned*)(F.lds + 512 * 65 * 4);
  const _Float16* S = (const _Float16*)(F.ws + WS_S); int* EIDX = (int*)(F.ws + WS_EIDX); float* GATE = (float*)(F.ws + WS_GATE);
  const int ngroups = NROWS / 16;
  auto grpok = [&](int gq) { return gq < ngroups && !(latent_only && ((gq * 16) % RPB) < CTXL); };
  int grp = F.bid; while (grp < ngroups && !grpok(grp)) grp += F.G;
  typedef _Float16 h4 __attribute__((ext_vector_type(4)));
  h4 v[16];
  if (grp < ngroups) {
#pragma unroll
    for (int it = 0; it < 16; ++it) v[it] = *(const h4*)(S + (size_t)(grp * 16 + it) * PQN + F.tid * 4); }
  for (; grp < ngroups; ) {
    const int r0 = grp * 16;
    int gn = grp + F.G; while (gn < ngroups && !grpok(gn)) gn += F.G;
#pragma unroll
    for (int it = 0; it < 16; ++it) { const int c = F.tid * 4; LAS float* d = sc + (it * 32 + (c >> 6)) * 65 + (c & 63); d[0] = (float)v[it][0]; d[1] = (float)v[it][1]; d[2] = (float)v[it][2]; d[3] = (float)v[it][3]; }
    if (gn < ngroups) {
#pragma unroll
      for (int it = 0; it < 16; ++it) v[it] = *(const h4*)(S + (size_t)(gn * 16 + it) * PQN + F.tid * 4); }
    __syncthreads();
    float v[16];
    { const LAS float* my = sc + F.tid * 65; const unsigned eb = (F.tid & 1) * 64;
      float g1[16];
#define LOAD16(dst, off) do { _Pragma("unroll") for (int e = 0; e < 16; ++e) dst[e] = __uint_as_float((__float_as_uint(my[(off) + e]) & ~127u) | (eb + (off) + e)); } while (0)
      LOAD16(v, 0); bitonic_sort16(v); LOAD16(g1, 16); bitonic_sort16(g1); top16_merge(v, g1);
      float h1[16];
      LOAD16(h1, 32); bitonic_sort16(h1); LOAD16(g1, 48); bitonic_sort16(g1); top16_merge(h1, g1);
      top16_merge(v, h1);
#undef LOAD16
    }
    { float o[16];
#pragma unroll
      for (int i = 0; i < 16; ++i) o[i] = __shfl_xor(v[i], 1);
      top16_merge(v, o); }
    if ((F.tid & 1) == 0) {
#pragma unroll
      for (int i = 0; i < 16; ++i) T[(F.tid >> 1) * 16 + i] = __float_as_uint(v[i]); }
    __syncthreads();
    if (F.tid < 128) {
      const int rl = F.tid >> 3, head = F.tid & 7, p1 = (rl * 16 + head * 2) * 16, p2 = p1 + 16;
      float a[16], bq[16];
#pragma unroll
      for (int i = 0; i < 16; ++i) { a[i] = __uint_as_float(T[p1 + i] & ~127u); bq[i] = __uint_as_float(T[p2 + i] & ~127u); }
      float w[16];
#pragma unroll
      for (int i = 0; i < 16; ++i) w[i] = __uint_as_float((__float_as_uint(a[0] + bq[i]) & ~255u) | (unsigned)i);
      { float r1[16];
#pragma unroll
        for (int i = 0; i < 16; ++i) r1[i] = i < 8 ? __uint_as_float((__float_as_uint(a[1] + bq[i]) & ~255u) | (unsigned)(16 + i)) : -INFINITY;
        top16_merge(w, r1); }
#pragma unroll
      for (int ia = 2; ia < 16; ++ia)
#pragma unroll
        for (int ib = 0; ib < 16; ++ib) if ((ia + 1) * (ib + 1) <= 16) { const float s = a[ia] + bq[ib]; ins16(w, __uint_as_float((__float_as_uint(s) & ~255u) | (unsigned)(ia * 16 + ib))); }
      float ts[16]; int ex[16];
#pragma unroll
      for (int k = 0; k < 16; ++k) { const unsigned id = __float_as_uint(w[k]) & 255u; const unsigned k1 = T[p1 + (id >> 4)], k2 = T[p2 + (id & 15)];
        ts[k] = __uint_as_float(k1 & ~127u) + __uint_as_float(k2 & ~127u); ex[k] = (int)((k1 & 127u) * NKEYS + (k2 & 127u)); }
      float m = ts[0];
#pragma unroll
      for (int k = 1; k < 16; ++k) m = fmaxf(m, ts[k]);
      float l = 0.f;
#pragma unroll
      for (int k = 0; k < 16; ++k) { ts[k] = __expf(ts[k] - m); l += ts[k]; }
      const float il = 1.f / l; const size_t ob = (size_t)(r0 + rl) * 128 + head * 16;
#pragma unroll
      for (int k = 0; k < 16; k += 4) { *(int4*)(EIDX + ob + k) = make_int4(ex[k], ex[k + 1], ex[k + 2], ex[k + 3]);
        f32x4 gv; gv.x = ts[k] * il; gv.y = ts[k + 1] * il; gv.z = ts[k + 2] * il; gv.w = ts[k + 3] * il; *(f32x4*)(GATE + ob + k) = gv; }
    }
    __syncthreads();
    grp = gn;
  }
}

typedef float f32x2 __attribute__((ext_vector_type(2)));
__device__ __forceinline__ float dpp_ror_add(float x, int) { return x; }
#define ROW_ROR_ADD(x, n) do { const int xi_ = __builtin_bit_cast(int, x); x += __builtin_bit_cast(float, __builtin_amdgcn_update_dpp(0, xi_, 0x120 + (n), 0xf, 0xf, false)); } while (0)
__device__ __forceinline__ float dot16_fp8(u32x4 q, const float* h, float acc) {
  const int qq[4] = {(int)q.x, (int)q.y, (int)q.z, (int)q.w}; f32x2 a2 = {acc, 0.f};
#pragma unroll
  for (int j = 0; j < 4; ++j) {
    a2 = __builtin_elementwise_fma(__builtin_amdgcn_cvt_pk_f32_fp8(qq[j], false), f32x2{h[4 * j], h[4 * j + 1]}, a2);
    a2 = __builtin_elementwise_fma(__builtin_amdgcn_cvt_pk_f32_fp8(qq[j], true), f32x2{h[4 * j + 2], h[4 * j + 3]}, a2); }
  return a2.x + a2.y;
}
constexpr int PCH = 8;
__device__ __forceinline__ int chunk_row0(unsigned c, bool latent_only) { return latent_only ? (int)(c / (SEQ / PCH)) * RPB + CTXL + (int)(c % (SEQ / PCH)) * PCH : (int)c * PCH; }
#ifndef UREP
#define UREP 1
#endif
#ifndef VREP
#define VREP 1
#endif
__device__ __forceinline__ unsigned xcc_id() { return (unsigned)__builtin_amdgcn_s_getreg((3 << 11) | 20) & 7u; }
__device__ __forceinline__ unsigned q_pull(unsigned* q, int lane) { unsigned c = 0; if (lane == 0) c = __hip_atomic_fetch_add(q, 1u, __ATOMIC_RELAXED, __HIP_MEMORY_SCOPE_AGENT); return (unsigned)__builtin_amdgcn_readfirstlane((int)c); }
__device__ __forceinline__ void phase_peer_u(const Ctx& F, int layer, bool latent_only, int rep) {
  unsigned* qb = (unsigned*)(F.ws + WS_CTL) + 8192 + ((layer * 2 + 0) * 2 + rep) * 8 * 64;
  const int* EIDX = (const int*)(F.ws + WS_EIDX);
  LAS unsigned* lst = (LAS unsigned*)(F.lds + F.wave * 4096);
  LAS float* pl = (LAS float*)(F.lds + F.wave * 4096 + 1024);
  const int g = F.lane >> 3;
  const int i0 = ((F.lane >> 2) & 1) * 8 + ((F.lane >> 1) & 1) * 4 + (F.lane & 1) * 2;
  const int myx = (int)xcc_id();
#pragma unroll 1
  for (int sx = 0; sx < 8; ++sx) {
    const int slice = (myx + sx) & 7;
    const bf16* H = (const bf16*)(F.ws + WS_H) + slice * 128 + (F.lane & 7) * 16;
    const unsigned char* U = F.ws + WS_UT + ((size_t)layer * 8 + slice) * NKEYS * NKEYS * 128; const unsigned uo = (unsigned)(F.lane & 7) * 16u;
    float* PART = (float*)(F.ws + WS_PART) + slice * 128;
    const unsigned nch = (unsigned)((latent_only ? NB * SEQ : NROWS) / PCH);
        unsigned e0, e1; u32x4 h0, h1;
#define UPREF(R) do { e0 = (unsigned)EIDX[(size_t)(R) * 128 + F.lane]; e1 = (unsigned)EIDX[(size_t)(R) * 128 + 64 + F.lane]; h0 = *(const u32x4*)(H + (size_t)(R) * DM); h1 = *(const u32x4*)(H + (size_t)(R) * DM + 8); } while (0)
#define UGATHER(QV, HH, LOFF, RNEXT, HASNEXT) do { lst[(LOFF) + F.lane] = e0; lst[(LOFF) + 64 + F.lane] = e1; \
          HH[0] = bflo(h0.x); HH[1] = bfhi(h0.x); HH[2] = bflo(h0.y); HH[3] = bfhi(h0.y); HH[4] = bflo(h0.z); HH[5] = bfhi(h0.z); HH[6] = bflo(h0.w); HH[7] = bfhi(h0.w); \
          HH[8] = bflo(h1.x); HH[9] = bfhi(h1.x); HH[10] = bflo(h1.y); HH[11] = bfhi(h1.y); HH[12] = bflo(h1.z); HH[13] = bfhi(h1.z); HH[14] = bflo(h1.w); HH[15] = bfhi(h1.w); \
          if (HASNEXT) UPREF(RNEXT); \
          asm volatile("s_waitcnt lgkmcnt(0)" ::: "memory"); \
          _Pragma("unroll") for (int i = 0; i < 16; ++i) QV[i] = *(const u32x4*)(U + (lst[(LOFF) + 8 * i + g] * 128u + uo)); } while (0)
#define UMATH(QV, HH, R) do { float p[16]; \
          _Pragma("unroll") for (int i = 0; i < 16; ++i) p[i] = dot16_fp8(QV[i], HH, 0.f); \
          _Pragma("unroll") for (int m = 4; m >= 1; m >>= 1) { const bool up = (F.lane & m) != 0; const int n = 2 * m; \
            _Pragma("unroll") for (int j = 0; j < n; ++j) { const float send = up ? p[j] : p[j + n], keep = up ? p[j + n] : p[j]; p[j] = keep + __shfl_xor(send, m); } } \
          pl[8 * i0 + g] = p[0]; pl[8 * i0 + 8 + g] = p[1]; \
          asm volatile("s_waitcnt lgkmcnt(0)" ::: "memory"); \
          float* po = PART + (size_t)(R) * 1024 + F.lane; po[0] = pl[F.lane]; po[64] = pl[64 + F.lane]; } while (0)
    unsigned c = q_pull(qb + slice * 64, F.lane);
    if (c < nch) {
      u32x4 qa[16], qb_[16]; float ha[16], hb[16];
      int rbeg = chunk_row0(c, latent_only);
      UPREF(rbeg);
      UGATHER(qa, ha, 0, rbeg + 1, true);
#pragma unroll 1
      while (true) {
        const unsigned cn = q_pull(qb + slice * 64, F.lane);
        const bool hn = cn < nch; const int nr0 = hn ? chunk_row0(cn, latent_only) : 0;
#pragma unroll 1
        for (int it = 0; it < PCH; it += 2) { const int r = rbeg + it; const bool lastp = it + 2 >= PCH;
          UGATHER(qb_, hb, 128, (lastp ? nr0 : r + 2), (!lastp || hn)); __builtin_amdgcn_sched_barrier(0);
          UMATH(qa, ha, r); __builtin_amdgcn_sched_barrier(0);
          if (!lastp || hn) UGATHER(qa, ha, 0, (lastp ? nr0 + 1 : r + 3), true);
          __builtin_amdgcn_sched_barrier(0);
          UMATH(qb_, hb, r + 1); __builtin_amdgcn_sched_barrier(0);
        }
        if (!hn) break;
        rbeg = nr0;
      }
    }
#undef UPREF
#undef UGATHER
#undef UMATH
  }
}

__device__ __forceinline__ void phase_peer_w(const Ctx& F, bool latent_only) {
  const int gw = F.bid * NWAVES + F.wave, NGW = F.G * NWAVES;
  const float* PART = (const float*)(F.ws + WS_PART); const float* GATE = (const float*)(F.ws + WS_GATE); float* PW = (float*)(F.ws + WS_PW);
  for (int r = gw; r < NROWS; r += NGW) {
    if (latent_only && (r % RPB) < CTXL) continue;
    float a = 0.f, b = 0.f;
#pragma unroll
    for (int x = 0; x < 8; ++x) { a += PART[(size_t)r * 1024 + x * 128 + F.lane]; b += PART[(size_t)r * 1024 + x * 128 + 64 + F.lane]; }
    const size_t o = (size_t)r * 128 + F.lane;
    PW[o] = GATE[o] * gelu_tanh(a * (1.f / U8_SCALE)); PW[o + 64] = GATE[o + 64] * gelu_tanh(b * (1.f / U8_SCALE));
  }
}

__device__ __forceinline__ void phase_peer_v(const Ctx& F, int layer, bool latent_only, int rep) {
  unsigned* qb = (unsigned*)(F.ws + WS_CTL) + 8192 + ((layer * 2 + 1) * 2 + rep) * 8 * 64;
  const int* EIDX = (const int*)(F.ws + WS_EIDX); const float* PW = (const float*)(F.ws + WS_PW);
  const float* g2 = (const float*)(F.ws + WS_MOD) + (size_t)layer * 5 * NMOD * DM + 5 * DM;
  const float* outl = F.outp();
  LAS u32x2* ew = (LAS u32x2*)(F.lds + F.wave * 4096);
  const int g = F.lane >> 3;
  const int myx = (int)xcc_id();
#pragma unroll 1
  for (int sx = 0; sx < 4; ++sx) {
    const int slice = (myx + sx) & 3;
    const unsigned char* V = F.ws + WS_VT + ((size_t)layer * 4 + slice) * NKEYS * NKEYS * 128; const unsigned vo = (unsigned)(F.lane & 7) * 16u;
    const int dl = slice * 256 + (F.lane & 7) * 32 + ((F.lane >> 5) & 1) * 16 + ((F.lane >> 4) & 1) * 8 + ((F.lane >> 3) & 1) * 4;
    const unsigned nch = (unsigned)((latent_only ? NB * SEQ : NROWS) / PCH);
        unsigned ea, eb; float wpa, wpb;
#define VPREF(R) do { const size_t o_ = (size_t)(R) * 128 + F.lane; ea = (unsigned)EIDX[o_]; eb = (unsigned)EIDX[o_ + 64]; wpa = PW[o_]; wpb = PW[o_ + 64]; } while (0)
#define VGATHER(QV, WV, LOFF, RNEXT, HASNEXT) do { \
          { u32x2 t0, t1; t0.x = ea; t0.y = __float_as_uint(wpa); t1.x = eb; t1.y = __float_as_uint(wpb); \
            ew[(LOFF) + F.lane] = t0; ew[(LOFF) + 64 + F.lane] = t1; } \
          if (HASNEXT) VPREF(RNEXT); \
          asm volatile("s_waitcnt lgkmcnt(0)" ::: "memory"); \
          _Pragma("unroll") for (int i = 0; i < 16; ++i) { const u32x2 t = ew[(LOFF) + 8 * i + g]; WV[i] = __uint_as_float(t.y); QV[i] = *(const u32x4*)(V + (t.x * 128u + vo)); } } while (0)
#define V4FMA(Q, B, J) do { const f32x2 f_ = __builtin_amdgcn_cvt_scalef32_pk_f32_fp4((Q), 1.0f, (B)); f32x2 a_ = {acc[(J)], acc[(J) + 1]}; a_ = __builtin_elementwise_fma(f_, w2, a_); acc[(J)] = a_.x; acc[(J) + 1] = a_.y; } while (0)
#define VMATH(QV, WV, R) do { float acc[32]; \
          float* x = (float*)xrow_sel(outl, (const float*)(F.ws + WS_XC), (R)); const float* xs = xrow_sel((const float*)(F.ws + WS_XB), (const float*)(F.ws + WS_XCB), (R)); const float* gg = g2 + (size_t)mod_row(R) * NMOD * DM; \
          const f32x4 xv = *(const f32x4*)(xs + dl), gv = *(const f32x4*)(gg + dl); \
          _Pragma("unroll") for (int q = 0; q < 32; ++q) acc[q] = 0.f; \
          _Pragma("unroll") for (int i = 0; i < 16; ++i) { const float w = WV[i]; const f32x2 w2 = {w, w}; const unsigned q0 = QV[i].x, q1 = QV[i].y, q2 = QV[i].z, q3 = QV[i].w; \
            V4FMA(q0, 0, 0); V4FMA(q0, 1, 2); V4FMA(q0, 2, 4); V4FMA(q0, 3, 6); V4FMA(q1, 0, 8); V4FMA(q1, 1, 10); V4FMA(q1, 2, 12); V4FMA(q1, 3, 14); \
            V4FMA(q2, 0, 16); V4FMA(q2, 1, 18); V4FMA(q2, 2, 20); V4FMA(q2, 3, 22); V4FMA(q3, 0, 24); V4FMA(q3, 1, 26); V4FMA(q3, 2, 28); V4FMA(q3, 3, 30); } \
          _Pragma("unroll") for (int j = 0; j < 16; ++j) { auto s2 = __builtin_amdgcn_permlane32_swap(__float_as_uint(acc[j]), __float_as_uint(acc[j + 16]), false, false); acc[j] = __uint_as_float(s2[0]) + __uint_as_float(s2[1]); } \
          _Pragma("unroll") for (int j = 0; j < 8; ++j) { auto s2 = __builtin_amdgcn_permlane16_swap(__float_as_uint(acc[j]), __float_as_uint(acc[j + 8]), false, false); acc[j] = __uint_as_float(s2[0]) + __uint_as_float(s2[1]); } \
          { const bool up = (F.lane & 8) != 0; \
            _Pragma("unroll") for (int j = 0; j < 4; ++j) { const float send = up ? acc[j] : acc[j + 4], keep = up ? acc[j + 4] : acc[j]; acc[j] = keep + __shfl_xor(send, 8); } } \
          f32x4 o; o.x = xv.x + gv.x * acc[0] * (1.f / V4_SCALE); o.y = xv.y + gv.y * acc[1] * (1.f / V4_SCALE); o.z = xv.z + gv.z * acc[2] * (1.f / V4_SCALE); o.w = xv.w + gv.w * acc[3] * (1.f / V4_SCALE); \
          *(f32x4*)(x + dl) = o; } while (0)
    unsigned c = q_pull(qb + slice * 64, F.lane);
    if (c < nch) {
      u32x4 qa[16], qb_[16]; float wa[16], wb[16];
      int rbeg = chunk_row0(c, latent_only);
      VPREF(rbeg);
      VGATHER(qa, wa, 0, rbeg + 1, true);
#pragma unroll 1
      while (true) {
        const unsigned cn = q_pull(qb + slice * 64, F.lane);
        const bool hn = cn < nch; const int nr0 = hn ? chunk_row0(cn, latent_only) : 0;
#pragma unroll 1
        for (int it = 0; it < PCH; it += 2) { const int r = rbeg + it; const bool lastp = it + 2 >= PCH;
          VGATHER(qb_, wb, 128, (lastp ? nr0 : r + 2), (!lastp || hn)); __builtin_amdgcn_sched_barrier(0);
          VMATH(qa, wa, r); __builtin_amdgcn_sched_barrier(0);
          if (!lastp || hn) VGATHER(qa, wa, 0, (lastp ? nr0 + 1 : r + 3), true);
          __builtin_amdgcn_sched_barrier(0);
          VMATH(qb_, wb, r + 1); __builtin_amdgcn_sched_barrier(0);
        }
        if (!hn) break;
        rbeg = nr0;
      }
    }
#undef VPREF
#undef VGATHER
#undef VMATH
#undef V4FMA
  }
}

#define XB_TMO      128
#define XB_XCNT(j)  (256  + 64 * (j))
#define XB_XSUB(j)  (1280 + 64 * (j))
#define XB_XGEN(j)  (2304 + 64 * (j))
#define XB_TOP      3328
#define XB_TOPGEN   3392
#define XCD_BAR_WORDS 3456
#define XB_SPIN_CAP (1u << 18)

__device__ __forceinline__ unsigned xb_ld(unsigned* p)              { return __hip_atomic_load(p, __ATOMIC_RELAXED, __HIP_MEMORY_SCOPE_AGENT); }
__device__ __forceinline__ unsigned xb_add(unsigned* p, unsigned v) { return __hip_atomic_fetch_add(p, v, __ATOMIC_RELAXED, __HIP_MEMORY_SCOPE_AGENT); }
__device__ __forceinline__ unsigned xb_xcc_id() { return (unsigned)__builtin_amdgcn_s_getreg((3 << 11) | 20) & 0xFu; }
#define XB_SPIN(cond, bar) do { unsigned _sp = 0; while (cond) { __builtin_amdgcn_s_sleep(1); \
    if ((++_sp & 255u) == 0u) { if (xb_ld(&(bar)[XB_TMO])) break; if (_sp > XB_SPIN_CAP) { atomicAdd(&(bar)[XB_TMO], 1u); break; } } } } while (0)

struct XcdBarrier {
    unsigned* bar; unsigned x;
    volatile LAS unsigned* st;
};

__device__ __forceinline__ XcdBarrier xcd_barrier_post(unsigned* bar, volatile LAS unsigned* st) {
    XcdBarrier b; b.bar = bar; b.x = xb_xcc_id(); b.st = st;
    if (threadIdx.x == 0) (void)xb_add(&bar[XB_XCNT(b.x)], 1u);
    return b;
}
__device__ __forceinline__ void xcd_barrier_complete(unsigned* bar, unsigned x, unsigned& nloc, unsigned& nx) {
    const unsigned G = gridDim.x * gridDim.y * gridDim.z;
    unsigned sum, cnt, mine, sp = 0u;
    for (;;) {
        sum = 0u; cnt = 0u; mine = 0u;
#pragma unroll
        for (unsigned j = 0; j < 16; ++j) { const unsigned c = xb_ld(&bar[XB_XCNT(j)]); sum += c; cnt += (c > 0u) ? 1u : 0u; mine = (j == x) ? c : mine; }
        if (sum == G) break;
        __builtin_amdgcn_s_sleep(1);
        if ((++sp & 255u) == 0u) { if (xb_ld(&bar[XB_TMO])) break; if (sp > XB_SPIN_CAP) { atomicAdd(&bar[XB_TMO], 1u); break; } }
    }
    nloc = mine > 0u ? mine : 1u; nx = cnt > 0u ? cnt : 1u;
}

__device__ __forceinline__ void xcd_barrier(const XcdBarrier& b) {
    asm volatile("s_waitcnt vmcnt(0)" ::: "memory");
    __syncthreads();
    if (threadIdx.x == 0) {
        unsigned* bar = b.bar;
        __builtin_amdgcn_s_waitcnt(0);
        unsigned nloc = b.st[0], nx = b.st[1];
        if (nloc == 0u) { xcd_barrier_complete(bar, b.x, nloc, nx); b.st[0] = nloc; b.st[1] = nx; }
        const unsigned old = xb_add(&bar[XB_XSUB(b.x)], 1u);
        const unsigned gen = old / nloc;
        if (old + 1u == (gen + 1u) * nloc) {
            __builtin_amdgcn_fence(__ATOMIC_RELEASE, "agent");
            asm volatile("s_waitcnt vmcnt(0)" ::: "memory");
            const unsigned og = xb_add(&bar[XB_TOP], 1u);
            const unsigned tg = og / nx;
            if (og + 1u == (tg + 1u) * nx) xb_add(&bar[XB_TOPGEN], 1u);
            else XB_SPIN(xb_ld(&bar[XB_TOPGEN]) == tg, bar);
            __builtin_amdgcn_fence(__ATOMIC_ACQUIRE, "agent");
            xb_add(&bar[XB_XGEN(b.x)], 1u);
            asm volatile("s_waitcnt vmcnt(0)" ::: "memory");
        } else {
            XB_SPIN(xb_ld(&bar[XB_XGEN(b.x)]) == gen, bar);
            __builtin_amdgcn_fence(__ATOMIC_ACQUIRE, "agent");
            asm volatile("s_waitcnt vmcnt(0)" ::: "memory");
        }
    }
    __syncthreads();
}


__global__ void __launch_bounds__(NTHR, 2) fwd(Args args) {
  extern __shared__ __attribute__((aligned(16))) unsigned char lds[];
  Ctx F;
  F.ws = args.ws; F.tid = threadIdx.x; F.lane = F.tid & 63; F.wave = __builtin_amdgcn_readfirstlane(F.tid >> 6); F.bid = blockIdx.x; F.G = gridDim.x;
  F.lds = (LAS unsigned char*)lds; F.ldsg = lds;
  if (F.tid < 18) { const unsigned long long p = F.tid < 17 ? (unsigned long long)args.in[F.tid] : (unsigned long long)args.out; ((LAS unsigned long long*)(F.lds + PTAB_OFF))[F.tid] = p; }
  __syncthreads();
  const int lo = args.ph_lo, hi = args.ph_hi;
#ifndef PHMASK
#define PHMASK 0x7ff
#endif
#define IN(k) (lo <= (k) && (k) < hi)
#define EN(b) ((PHMASK >> (b)) & 1)
#ifndef REPMASK
#define REPMASK 0
#endif
#define NREP(b) (1 + ((REPMASK >> (b)) & 1))
#define FRESH() do { int t_ = threadIdx.x; asm volatile("" : "+v"(t_)); F.tid = t_; F.lane = t_ & 63; F.wave = __builtin_amdgcn_readfirstlane(t_ >> 6); int b_ = blockIdx.x; asm volatile("" : "+s"(b_)); F.bid = b_; } while (0)
  if (F.tid < 4) ((LAS unsigned*)(F.lds + PTAB_OFF + 256))[F.tid] = 0u;
  __syncthreads();
  XcdBarrier xb; xb.bar = (unsigned*)(F.ws + WS_CTL) + 4096; xb.x = 0; xb.st = nullptr;
  if (hi - lo > 1) xb = xcd_barrier_post((unsigned*)(F.ws + WS_CTL) + 4096, (volatile LAS unsigned*)(F.lds + PTAB_OFF + 256));
#ifndef SEAM_CG_ALL
#define SEAM_CG_ALL 0
#endif
#ifndef XTRA_BAR
#define XTRA_BAR 0
#endif
#ifndef STAMPS
#define STAMPS 0
#endif
#define SEAM(k) do { if (STAMPS && blockIdx.x == 0 && threadIdx.x == 0) ((unsigned long long*)(F.ws + WS_CTL + 61440))[(k)] = __builtin_amdgcn_s_memrealtime(); if (IN(k) && IN((k) + 1)) { if (SEAM_CG_ALL) cg::this_grid().sync(); else { xcd_barrier(xb); for (int xb_ = 0; xb_ < XTRA_BAR; ++xb_) xcd_barrier(xb); } } } while (0)
  if (STAMPS && blockIdx.x == 0 && threadIdx.x == 0) ((unsigned long long*)(F.ws + WS_CTL + 61440))[63] = __builtin_amdgcn_s_memrealtime();
  if (EN(10) && IN(0)) for (int rep_ = 0; rep_ < NREP(10); ++rep_) { FRESH(); phase_prologue(F); } SEAM(0);
#pragma unroll 1
  for (int layer = 0; layer < DEPTH; ++layer) {
    const int pb = 1 + 11 * layer; const bool last = layer == DEPTH - 1;
    const float* modl = (const float*)(F.ws + WS_MOD) + (size_t)layer * 5 * NMOD * DM;
    if (EN(0) && IN(pb + 0)) for (int rep_ = 0; rep_ < NREP(0); ++rep_) { FRESH(); phase_norm(F, layer, 0, layer == 0 ? 0 : 2, false); } SEAM(pb + 0);
    if (EN(1) && IN(pb + 1)) for (int rep_ = 0; rep_ < NREP(1); ++rep_) { FRESH(); pg8::Gemm g{(const pg8::bf16_t*)(F.ws + WS_H), (const pg8::bf16_t*)(F.ws + WS_WQKV + (size_t)layer * QKVD * DM), NROWS, QKVD, DM};
      Order S; S.init(NROWS / 256, QKVD / 256, F.G, F.bid, 0); EpiQKV E{F.ws, (LAS float*)(F.lds + 131072), layer};
      pg8::gemm_phase<EpiQKV, Order, true, true, true, 0x7d7d7d7d  , 0x7a7a7a7a  >(F.lds, g, S, E);
      if (layer == 0) { int lo_, hi_; conv_slot(F, 0, lo_, hi_); convert_rows(F, lo_, hi_); } } SEAM(pb + 1);
    if (EN(2) && IN(pb + 2)) for (int rep_ = 0; rep_ < NREP(2); ++rep_) { }
    if (EN(3) && IN(pb + 3)) for (int rep_ = 0; rep_ < NREP(3); ++rep_) { FRESH(); phase_attn(F, layer); } SEAM(pb + 3);
    if (EN(4) && IN(pb + 4)) for (int rep_ = 0; rep_ < NREP(4); ++rep_) { FRESH(); pg8::Gemm g{(const pg8::bf16_t*)(F.ws + WS_O), (const pg8::bf16_t*)(F.ws + WS_WO + (size_t)layer * DM * DM), NROWS, DM, DM, 0x79797979  , 0x7a7a7a7a  };
      Order S; S.init(last ? NB * 16 : NROWS / 256, DM / 256, F.G, F.bid, last ? 1 : 0); EpiRes E{st_lat(F, layer == 0 ? 0 : 2), st_ctx(F, layer == 0 ? 0 : 2), (float*)(F.ws + WS_XB), (float*)(F.ws + WS_XCB), modl + 2 * DM};
      pg8::gemm_phase<EpiRes, Order, true, true, true, 0x79797979  , 0x7a7a7a7a  >(F.lds, g, S, E);
      if (layer == 0) { int lo_, hi_; conv_slot(F, 1, lo_, hi_); convert_rows(F, lo_, hi_); } } SEAM(pb + 4);
    if (EN(5) && IN(pb + 5)) for (int rep_ = 0; rep_ < NREP(5); ++rep_) { FRESH(); phase_norm(F, layer, 1, 1, last); } SEAM(pb + 5);
    if (EN(6) && IN(pb + 6)) for (int rep_ = 0; rep_ < NREP(6); ++rep_) { FRESH(); pg8::Gemm g{(const pg8::bf16_t*)(F.ws + WS_H), (const pg8::bf16_t*)(F.ws + WS_WP) + (size_t)layer * PQN * DM, NROWS, PQN, DM};
      Order S; S.init(last ? NB * 16 : NROWS / 256, PQN / 256, F.G, F.bid, last ? 1 : 0); EpiTopk E{(int*)(F.ws + WS_EIDX), (float*)(F.ws + WS_GATE)};
#pragma unroll 1
      for (int ui = 0; ; ++ui) { OneUnit S1; if (!S.next(ui, S1.u0)) break; pg8::gemm_phase<EpiTopk, OneUnit, false, true>(F.lds, g, S1, E); }
      if (layer == 0) { int lo_, hi_; conv_slot(F, 2, lo_, hi_); convert_rows(F, lo_, hi_); } } SEAM(pb + 6);
    if (EN(7) && IN(pb + 7)) for (int rep_ = 0; rep_ < NREP(7); ++rep_) { }
    if (EN(8) && IN(pb + 8)) for (int rep_ = 0; rep_ < NREP(8); ++rep_) { FRESH(); phase_peer_u(F, layer, last, rep_); } SEAM(pb + 8);
    if (EN(9) && IN(pb + 9)) { FRESH(); phase_peer_w(F, last); } SEAM(pb + 9);
    if (EN(9) && IN(pb + 10)) for (int rep_ = 0; rep_ < NREP(9); ++rep_) { FRESH(); phase_peer_v(F, layer, last, rep_); } if (!last) SEAM(pb + 10);
  }
  if (STAMPS && blockIdx.x == 0 && threadIdx.x == 0) ((unsigned long long*)(F.ws + WS_CTL + 61440))[NPHASE - 1] = __builtin_amdgcn_s_memrealtime();
#undef IN
#undef SEAM
}
}

#ifndef MK_MULTI
#define MK_MULTI 0
#endif
#ifndef DBG
#define DBG 0
#endif
#ifndef TS_A
#define TS_A 0
#endif
#ifndef TS_B
#define TS_B 4
#endif
namespace dbg {
__global__ void k_ts(const unsigned long long* ts, float* res) { const unsigned long long s0 = ts[63]; auto dur = [&](int k) { const unsigned long long e = ts[k], b = k == 0 ? s0 : ts[k - 1]; return (float)(e - b) * 0.01f; };
  res[0] = dur(TS_A) * 1e-5f; res[1] = dur(TS_B) * 1e-3f; res[2] = 0.f; }
template <bool ABF>
__global__ void __launch_bounds__(1024) k_cmp(const void* __restrict__ a, long lda, long aoff, const float* __restrict__ b, long ldb, long boff, int rows, int cols, int row0, int rstep_lat  , float* res) {
  __shared__ float sd[1024], sr[1024];
  float d2 = 0.f, r2 = 0.f;
  for (long e = threadIdx.x; e < (long)rows * cols; e += 1024) { const int r = row0 + (int)(e / cols), c = (int)(e % cols);
    if (rstep_lat == 1 && (r % RPB) < CTXL) continue; if (rstep_lat == 2 && (r % RPB) >= CTXL) continue;
    float av; if (ABF) av = __uint_as_float((unsigned)((const unsigned short*)a)[(long)r * lda + aoff + c] << 16); else av = ((const float*)a)[(long)r * lda + aoff + c];
    const float bv = b[(long)r * ldb + boff + c]; d2 += (av - bv) * (av - bv); r2 += bv * bv; }
  sd[threadIdx.x] = d2; sr[threadIdx.x] = r2; __syncthreads();
  for (int o = 512; o > 0; o >>= 1) { if ((int)threadIdx.x < o) { sd[threadIdx.x] += sd[threadIdx.x + o]; sr[threadIdx.x] += sr[threadIdx.x + o]; } __syncthreads(); }
  if (threadIdx.x == 0) *res = sqrtf(sd[0] / fmaxf(sr[0], 1e-30f));
}
__global__ void __launch_bounds__(1024) k_cmp8(const unsigned char* __restrict__ a, long lda, float ascale, const float* __restrict__ b, long ldb, long boff, int rows, int cols, int mode, float* res) {
  __shared__ float sd[1024], sr[1024]; float d2 = 0.f, r2 = 0.f; typedef float f2_t __attribute__((ext_vector_type(2)));
  for (long e = threadIdx.x; e < (long)rows * cols; e += 1024) { const int r = (int)(e / cols), c = (int)(e % cols);
    if (mode == 1 && (r % RPB) < CTXL) continue; if (mode == 2 && (r % RPB) >= CTXL) continue;
    const f2_t t = __builtin_amdgcn_cvt_pk_f32_fp8((int)a[(long)r * lda + c], false); const float av = t.x / ascale, bv = b[(long)r * ldb + boff + c]; d2 += (av - bv) * (av - bv); r2 += bv * bv; }
  sd[threadIdx.x] = d2; sr[threadIdx.x] = r2; __syncthreads();
  for (int o = 512; o > 0; o >>= 1) { if ((int)threadIdx.x < o) { sd[threadIdx.x] += sd[threadIdx.x + o]; sr[threadIdx.x] += sr[threadIdx.x + o]; } __syncthreads(); }
  if (threadIdx.x == 0) *res = sqrtf(sd[0] / fmaxf(sr[0], 1e-30f));
}
__global__ void __launch_bounds__(1024) k_cmp_scores(const float* __restrict__ S, const float* __restrict__ PQ, const float* __restrict__ SK, int nrows, float* res) {
  __shared__ float sd[1024], sr[1024];
  float d2 = 0.f, r2 = 0.f;
  for (long e = threadIdx.x; e < (long)nrows * PQN; e += 1024) { const int r = (int)(e / PQN), c = (int)(e % PQN), h = c >> 8, half = (c >> 7) & 1, k = c & 127;
    const float* q = PQ + (long)r * PQN + h * PQD + half * 128; const float* kp = SK + (long)half * NKEYS * 128 + (long)k * 128; float a = 0.f; for (int d = 0; d < 128; ++d) a += q[d] * kp[d];
    const float f = S[(long)r * PQN + c]; d2 += (f - a) * (f - a); r2 += a * a; }
  sd[threadIdx.x] = d2; sr[threadIdx.x] = r2; __syncthreads();
  for (int o = 512; o > 0; o >>= 1) { if ((int)threadIdx.x < o) { sd[threadIdx.x] += sd[threadIdx.x + o]; sr[threadIdx.x] += sr[threadIdx.x + o]; } __syncthreads(); }
  if (threadIdx.x == 0) *res = sqrtf(sd[0] / fmaxf(sr[0], 1e-30f));
}
__global__ void k_final(float* out, long n, const float* res) {
  const float sa = 1.f + 10.f * res[0];
  for (long i = blockIdx.x * 256L + threadIdx.x; i < n; i += gridDim.x * 256L) out[i] *= sa;
  if (blockIdx.x == 0 && threadIdx.x == 0) { }
}
__global__ void k_final2(float* out, const float* res) { out[0] += 1000.f * (res[1] + res[2]); }
}

__global__ void __launch_bounds__(1024) k_cmp_w8(const unsigned char* W8, const float* W, float* res) {
  __shared__ float sd[1024], sr[1024]; float d2 = 0.f, r2 = 0.f; typedef float f2_t __attribute__((ext_vector_type(2)));
  for (long e = threadIdx.x; e < (long)DEPTH * DM * DM; e += 1024) { const int k = (int)(e & 1023), n = (int)((e >> 10) & 1023), l = (int)(e >> 20);
    const f2_t t = __builtin_amdgcn_cvt_pk_f32_fp8((int)W8[e], false); const float av = t.x / 32.f, bv = W[(size_t)l * DM * DM + (size_t)k * DM + n]; d2 += (av - bv) * (av - bv); r2 += bv * bv; }
  sd[threadIdx.x] = d2; sr[threadIdx.x] = r2; __syncthreads();
  for (int o = 512; o > 0; o >>= 1) { if ((int)threadIdx.x < o) { sd[threadIdx.x] += sd[threadIdx.x + o]; sr[threadIdx.x] += sr[threadIdx.x + o]; } __syncthreads(); }
  if (threadIdx.x == 0) { res[0] = sqrtf(sd[0] / fmaxf(sr[0], 1e-30f)); res[1] = 0.f; res[2] = 0.f; }
}


__global__ void __launch_bounds__(1024) k_cmp_wo8(const unsigned char* O8, const unsigned char* W8, const float* XB, const float* xin, const float* g1  , int r0, float* res) {
  __shared__ float sd[1024], sr[1024]; float d2 = 0.f, r2 = 0.f;
  typedef float f2_t __attribute__((ext_vector_type(2)));
  for (int e = threadIdx.x; e < 64 * DM; e += 1024) { const int r = r0 + (e >> 10), n = e & 1023; const int b = r / RPB, j = r % RPB;
    float ref = 0.f; for (int k = 0; k < DM; k += 4) { const int qa = *(const int*)(O8 + (size_t)r * DM + k), qw = *(const int*)(W8 + (size_t)n * DM + k);
      const f2_t a0 = __builtin_amdgcn_cvt_pk_f32_fp8(qa, false), a1 = __builtin_amdgcn_cvt_pk_f32_fp8(qa, true), w0 = __builtin_amdgcn_cvt_pk_f32_fp8(qw, false), w1 = __builtin_amdgcn_cvt_pk_f32_fp8(qw, true);
      ref += a0.x * w0.x + a0.y * w0.y + a1.x * w1.x + a1.y * w1.y; }
    ref *= 1.f / (64.f * 32.f);
    const size_t ol = (size_t)(b * SEQ + (j - CTXL)) * DM + n; const float fast = (XB[ol] - xin[ol]) / g1[(size_t)b * NMOD * DM + n];
    d2 += (fast - ref) * (fast - ref); r2 += ref * ref; }
  sd[threadIdx.x] = d2; sr[threadIdx.x] = r2; __syncthreads();
  for (int o = 512; o > 0; o >>= 1) { if ((int)threadIdx.x < o) { sd[threadIdx.x] += sd[threadIdx.x + o]; sr[threadIdx.x] += sr[threadIdx.x + o]; } __syncthreads(); }
  if (threadIdx.x == 0) { res[0] = sqrtf(sd[0] / fmaxf(sr[0], 1e-30f)); res[1] = 0.f; res[2] = 0.f; }
}


__global__ void k_mfma8_test(float* res) {
  typedef int i32x8_t __attribute__((ext_vector_type(8))); typedef float f32x4_t __attribute__((ext_vector_type(4)));
  __shared__ float A[16][128], B[128][16]; __shared__ int bad; __shared__ float mx;
  const int l = threadIdx.x;
  for (int e = l; e < 16 * 128; e += 64) { const int i = e >> 7, k = e & 127; A[i][k] = (float)(((i * 7 + k * 3) % 5) - 2); B[k][i] = (float)(((i * 5 + k * 11) % 7) - 3); }
  if (l == 0) { bad = 0; mx = 0.f; }
  __syncthreads();
  i32x8_t a, b;
  for (int q = 0; q < 8; ++q) { int va = 0, vb = 0; const int k0 = 32 * (l >> 4) + 4 * q;
    va = __builtin_amdgcn_cvt_pk_fp8_f32(A[l & 15][k0] * 4.f, A[l & 15][k0 + 1] * 4.f, 0, false); va = __builtin_amdgcn_cvt_pk_fp8_f32(A[l & 15][k0 + 2] * 4.f, A[l & 15][k0 + 3] * 4.f, va, true);
    vb = __builtin_amdgcn_cvt_pk_fp8_f32(B[k0][l & 15] * 8.f, B[k0 + 1][l & 15] * 8.f, 0, false); vb = __builtin_amdgcn_cvt_pk_fp8_f32(B[k0 + 2][l & 15] * 8.f, B[k0 + 3][l & 15] * 8.f, vb, true);
    a[q] = va; b[q] = vb; }
  f32x4_t c = {0.f, 0.f, 0.f, 0.f};
  c = __builtin_amdgcn_mfma_scale_f32_16x16x128_f8f6f4(a, b, c, 0, 0, 0, 0x7d7d7d7d  , 0, 0x7c7c7c7c  );
  for (int r = 0; r < 4; ++r) { const int row = 4 * (l >> 4) + r, col = l & 15; float ref = 0.f; for (int k = 0; k < 128; ++k) ref += A[row][k] * B[k][col];
    const float d = fabsf(c[r] - ref); if (d > 1e-3f) atomicAdd(&bad, 1); atomicMax((int*)&mx, __float_as_int(d)); }
  __syncthreads();
  if (l == 0) { res[0] = (float)bad / 256.f; res[1] = mx * 1e-3f; res[2] = 0.f; }
}


static void run_naive(void* const* d_in, float* out, char* ws, hipStream_t stream, int slayer, int stop) {
  const float* x = (const float*)d_in[0]; const float* c = (const float*)d_in[1]; const float* ctx = (const float*)d_in[2]; const float* c_ctx = (const float*)d_in[3];
  const float* ada_w = (const float*)d_in[4]; const float* ada_b = (const float*)d_in[5]; const float* n1g = (const float*)d_in[6]; const float* n2g = (const float*)d_in[7];
  const float* w_qkv = (const float*)d_in[8]; const float* qng = (const float*)d_in[9]; const float* kng = (const float*)d_in[10]; const float* w_o = (const float*)d_in[11];
  const float* sinks = (const float*)d_in[12]; const float* pwq = (const float*)d_in[13]; const float* psk = (const float*)d_in[14]; const float* pu = (const float*)d_in[15];
  const float* pv = (const float*)d_in[16];
  constexpr size_t MiB = 1u << 20;
  float* MOD = (float*)(ws + 0); float* XC = (float*)(ws + 1 * MiB); int* EIDX = (int*)(ws + 6 * MiB); float* GATE = (float*)(ws + 15 * MiB); float* PW = (float*)(ws + 24 * MiB);
  float* H = (float*)(ws + 34 * MiB); float* QKV = (float*)(ws + 104 * MiB); float* O = (float*)(ws + 242 * MiB); float* PQ = QKV;
  hipFuncSetAttribute((const void*)nv::k_attn, hipFuncAttributeMaxDynamicSharedMemorySize, (4 * RPB + 4 * HD) * 4);
  hipMemcpyAsync(out, x, (size_t)NB * SEQ * DM * 4, hipMemcpyDeviceToDevice, stream);
  hipMemcpyAsync(XC, ctx, (size_t)NB * CTXL * DM * 4, hipMemcpyDeviceToDevice, stream);
  nv::k_mod<<<(DEPTH * 5 * NMOD * DM + 255) / 256, 256, 0, stream>>>(c, c_ctx, ada_w, ada_b, MOD);
  for (int i = 0; i < DEPTH; ++i) {
#define STOP(k) if (i == slayer && stop == (k)) return
    const bool last = i == DEPTH - 1; const float* modi = MOD + (size_t)i * 5 * NMOD * DM;
    STOP(1); nv::k_norm<<<NROWS, 256, 0, stream>>>(out, XC, n1g + i * DM, modi, 0, 1, H);
    STOP(2); nv::k_gemm<0><<<dim3(QKVD / 64, NROWS / 64), 256, 0, stream>>>(H, w_qkv + (size_t)i * DM * QKVD, QKV, NROWS, QKVD, DM, nullptr, nullptr, nullptr, 0, 0);
    STOP(3); nv::k_qknorm_rope<<<NROWS, 640, 0, stream>>>(QKV, qng + i * HD, kng + i * HD);
    STOP(4); const size_t shm = (4 * RPB + 4 * HD) * 4;
    if (i % 2 == 0) { nv::k_attn<<<dim3(NB * SEQ, NKV), 256, shm, stream>>>(QKV, 0, nullptr); if (!last) nv::k_attn<<<dim3(NB * CTXL, NKV), 256, shm, stream>>>(QKV, 1, nullptr); }
    else { nv::k_attn<<<dim3(NB * SEQ, NKV), 256, shm, stream>>>(QKV, 2, sinks + (i / 2) * NH); }
    STOP(5); nv::k_copy_o<<<NROWS, 256, 0, stream>>>(QKV, O);
    nv::k_gemm<1><<<dim3(DM / 64, NROWS / 64), 256, 0, stream>>>(O, w_o + (size_t)i * DM * DM, nullptr, NROWS, DM, DM, out, XC, modi, 2, last ? 1 : 0);
    STOP(6); nv::k_norm<<<NROWS, 256, 0, stream>>>(out, XC, n2g + i * DM, modi, 3, 4, H);
    STOP(7); nv::k_gemm<0><<<dim3(PQN / 64, NROWS / 64), 256, 0, stream>>>(H, pwq + (size_t)i * DM * PQN, PQ, NROWS, PQN, DM, nullptr, nullptr, nullptr, 0, 0);
    STOP(8); nv::k_peer_topk<<<NROWS, 256, 0, stream>>>(PQ, psk + (size_t)i * 2 * NKEYS * 128, EIDX, GATE);
    STOP(9); nv::k_peer_u<<<NROWS, 256, 0, stream>>>(H, pu + (size_t)i * NKEYS * NKEYS * DM, EIDX, GATE, PW);
    STOP(10); nv::k_peer_v<<<NROWS, 256, 0, stream>>>(pv + (size_t)i * NKEYS * NKEYS * DM, EIDX, PW, out, XC, modi, 5, last ? 1 : 0);
#undef STOP
  }
}

extern "C" void kernel_launch(void* const* d_in, const int* in_sizes, int n_in, void* d_out, int out_size, void* d_ws, size_t ws_size, hipStream_t stream) {
  static int grid = 0;
  if (grid == 0) {
    if (n_in != 17 || out_size != NB * SEQ * DM || ws_size < mk::WS_END) { fprintf(stderr, "kernel_launch: unexpected shapes (n_in %d out %d ws %zu)\n", n_in, out_size, ws_size); grid = -1; return; }
    int dev = 0, cus = 0, per_cu = 0;
    hipGetDevice(&dev); hipDeviceGetAttribute(&cus, hipDeviceAttributeMultiprocessorCount, dev);
    if (hipFuncSetAttribute((const void*)mk::fwd, hipFuncAttributeMaxDynamicSharedMemorySize, mk::LDS_BYTES) != hipSuccess) { fprintf(stderr, "kernel_launch: hipFuncSetAttribute failed\n"); grid = -1; return; }
    if (hipOccupancyMaxActiveBlocksPerMultiprocessor(&per_cu, (const void*)mk::fwd, mk::NTHR, mk::LDS_BYTES) != hipSuccess || per_cu < 1) { fprintf(stderr, "kernel_launch: occupancy query failed (%d)\n", per_cu); grid = -1; return; }
    grid = cus * 1;
    grid -= grid % 8;
  }
  if (grid < 0) return;
  mk::Args a{};
  for (int i = 0; i < 17; ++i) a.in[i] = (const float*)d_in[i];
  a.out = (float*)d_out; a.ws = (unsigned char*)d_ws;
#if DBG == 0
#if MK_MULTI
  for (int p = 0; p < mk::NPHASE; ++p) { a.ph_lo = p; a.ph_hi = p + 1; hipLaunchKernelGGL(mk::fwd, dim3(grid), dim3(mk::NTHR), mk::LDS_BYTES, stream, a); }
#else
  hipMemsetAsync((char*)d_ws + mk::WS_CTL, 0, 65536, stream);
  a.ph_lo = 0; a.ph_hi = mk::NPHASE; void* kargs[] = {&a};
  hipError_t e = hipLaunchCooperativeKernel((const void*)mk::fwd, dim3(grid), dim3(mk::NTHR), kargs, mk::LDS_BYTES, stream);
  if (e != hipSuccess) fprintf(stderr, "cooperative launch failed: %s (grid %d)\n", hipGetErrorString(e), grid);
#endif
#else
  {
    constexpr size_t MiB = 1u << 20; char* ws = (char*)d_ws; float* out = (float*)d_out;
    float* REF = (float*)(ws + 440 * MiB); float* RES = (float*)(ws + 511 * MiB);
    float* nH = (float*)(ws + 34 * MiB); float* nQKV = (float*)(ws + 104 * MiB); float* nMOD = (float*)ws; float* nXC = (float*)(ws + 1 * MiB);
    hipMemsetAsync(RES, 0, 64, stream);
    int slayer = 0, stop = 0, fastp = 0;
#if DBG == 1
    slayer = 0; stop = 2; fastp = 2;
#elif DBG == 2
    slayer = 0; stop = 4; fastp = 4;
#elif DBG == 3
    slayer = 0; stop = 5; fastp = 5;
#elif DBG == 4
    slayer = 0; stop = 6; fastp = 6;
#elif DBG == 5
    slayer = 0; stop = 8; fastp = 8;
#elif DBG == 6
    slayer = 1; stop = 1; fastp = 11;
#elif DBG == 7
    slayer = 1; stop = 5; fastp = 15;
#elif DBG == 8
    slayer = 9; stop = 99; fastp = 21;
#elif DBG == 32
    slayer = 0; stop = 1; fastp = 1;
#elif DBG == 31
    slayer = 0; stop = 1; fastp = 6;
#elif DBG == 30
    slayer = 0; stop = 1; fastp = 0;
#elif DBG == 20
    slayer = 0; stop = 1; fastp = 0;
#elif DBG == 9
    slayer = 1; stop = 1; fastp = 9;
#elif DBG == 10
    slayer = 0; stop = 10; fastp = 9;
#elif DBG == 11
    slayer = 0; stop = 1; fastp = 1;
#endif
    run_naive(d_in, out, ws, stream, slayer, stop);
#if DBG == 1
    hipMemcpyAsync(REF, nH, (size_t)NROWS * DM * 4, hipMemcpyDeviceToDevice, stream); hipMemcpyAsync(REF + (size_t)NROWS * DM, nMOD, (size_t)DEPTH * 5 * NMOD * DM * 4, hipMemcpyDeviceToDevice, stream);
#elif DBG == 3 || DBG == 7
    nv::k_copy_o<<<NROWS, 256, 0, stream>>>(nQKV, REF);
#elif DBG == 2
    hipMemcpyAsync(REF, nQKV, (size_t)NROWS * QKVD * 4, hipMemcpyDeviceToDevice, stream);
#elif DBG == 4 || DBG == 6 || DBG == 8 || DBG == 9
    hipMemcpyAsync(REF, out, (size_t)NB * SEQ * DM * 4, hipMemcpyDeviceToDevice, stream); hipMemcpyAsync(REF + (size_t)NB * SEQ * DM, nXC, (size_t)NB * CTXL * DM * 4, hipMemcpyDeviceToDevice, stream);
#endif
#if DBG == 10
    hipMemcpyAsync(REF, ws + 24 * MiB, (size_t)NROWS * 128 * 4, hipMemcpyDeviceToDevice, stream);
#endif
#if DBG == 9 || DBG == 10
    hipMemcpyAsync(REF + (size_t)70 * MiB / 4, ws + 6 * MiB, (size_t)NROWS * 128 * 4, hipMemcpyDeviceToDevice, stream); hipMemcpyAsync(REF + (size_t)80 * MiB / 4, ws + 15 * MiB, (size_t)NROWS * 128 * 4, hipMemcpyDeviceToDevice, stream);
#elif DBG == 5
    hipMemcpyAsync(REF, nQKV  , (size_t)512 * PQN * 4, hipMemcpyDeviceToDevice, stream);
#endif
    for (int p = 0; p < fastp; ++p) { a.ph_lo = p; a.ph_hi = p + 1; hipLaunchKernelGGL(mk::fwd, dim3(grid), dim3(mk::NTHR), mk::LDS_BYTES, stream, a); }
    unsigned char* fw = (unsigned char*)d_ws;
#if DBG == 30
    k_mfma8_test<<<1, 64, 0, stream>>>(RES);
#endif
#if DBG == 32
    k_cmp_w8<<<1, 1024, 0, stream>>>(fw + mk::WS_WO, (const float*)d_in[11], RES);
#endif
#if DBG == 31
    k_cmp_wo8<<<1, 1024, 0, stream>>>(fw + mk::WS_O, fw + mk::WS_WO, (const float*)(fw + mk::WS_XB), (const float*)d_in[0], (const float*)(fw + mk::WS_MOD) + 2 * DM, 300, RES);
#endif
#if DBG == 20
    { hipMemsetAsync((char*)d_ws + mk::WS_CTL, 0, 65536, stream); a.ph_lo = 0; a.ph_hi = mk::NPHASE; void* kargs[] = {&a};
      hipLaunchCooperativeKernel((const void*)mk::fwd, dim3(grid), dim3(mk::NTHR), kargs, mk::LDS_BYTES, stream);
      dbg::k_ts<<<1, 1, 0, stream>>>((const unsigned long long*)(fw + mk::WS_CTL + 61440), RES); }
#endif
#if DBG == 9 || DBG == 10
    hipMemcpyAsync(fw + mk::WS_EIDX, REF + (size_t)70 * MiB / 4, (size_t)NROWS * 128 * 4, hipMemcpyDeviceToDevice, stream); hipMemcpyAsync(fw + mk::WS_GATE, REF + (size_t)80 * MiB / 4, (size_t)NROWS * 128 * 4, hipMemcpyDeviceToDevice, stream);
    for (int p = 9; p < (DBG == 9 ? 11 : 10); ++p) { a.ph_lo = p; a.ph_hi = p + 1; hipLaunchKernelGGL(mk::fwd, dim3(grid), dim3(mk::NTHR), mk::LDS_BYTES, stream, a); }
#endif
#if DBG == 1
    dbg::k_cmp<true><<<1, 1024, 0, stream>>>(fw + mk::WS_H, DM, 0, REF, DM, 0, NROWS, DM, 0, 0, RES);
    dbg::k_cmp<false><<<1, 1024, 0, stream>>>(fw + mk::WS_MOD, NMOD * DM, 0, REF + (size_t)NROWS * DM, NMOD * DM, 0, DEPTH * 5, NMOD * DM, 0, 0, RES + 1);
#elif DBG == 2
    dbg::k_cmp<true><<<1, 1024, 0, stream>>>(fw + mk::WS_Q, DM, 0, REF, QKVD, 0, NROWS, DM, 0, 0, RES);
    dbg::k_cmp<true><<<1, 1024, 0, stream>>>(fw + mk::WS_K, 256, 0, REF, QKVD, 1024, NROWS, 256, 0, 0, RES + 2);
    dbg::k_cmp<true><<<1, 1024, 0, stream>>>(fw + mk::WS_V, 256, 0, REF, QKVD, 1280, NROWS, 256, 0, 0, RES + 1);
#elif DBG == 3 || DBG == 7
    dbg::k_cmp8<<<1, 1024, 0, stream>>>(fw + mk::WS_O, DM, 64.f, REF, DM, 0, NROWS, DM, 1, RES);
    if (DBG == 3) dbg::k_cmp8<<<1, 1024, 0, stream>>>(fw + mk::WS_O, DM, 64.f, REF, DM, 0, NROWS, DM, 2, RES + 1);
#elif DBG == 4 || DBG == 6 || DBG == 8 || DBG == 9
    dbg::k_cmp<false><<<1, 1024, 0, stream>>>(DBG == 4 ? (const void*)(fw + mk::WS_XB) : (const void*)out, DM, 0, REF, DM, 0, NB * SEQ, DM, 0, 0, RES);
    if (DBG != 8) dbg::k_cmp<false><<<1, 1024, 0, stream>>>(fw + (DBG == 4 ? mk::WS_XCB : mk::WS_XC), DM, 0, REF + (size_t)NB * SEQ * DM, DM, 0, NB * CTXL, DM, 0, 0, RES + 1);
#elif DBG == 11
    dbg::k_cmp<true><<<1, 1024, 0, stream>>>(fw + mk::WS_UT, DM, 0, (const float*)d_in[15], DM, 0, DEPTH * NKEYS * NKEYS, DM, 0, 0, RES);
    dbg::k_cmp<true><<<1, 1024, 0, stream>>>(fw + mk::WS_VT, DM, 0, (const float*)d_in[16], DM, 0, DEPTH * NKEYS * NKEYS, DM, 0, 0, RES + 1);
#elif DBG == 10
    dbg::k_cmp<false><<<1, 1024, 0, stream>>>(fw + mk::WS_PW, 128, 0, REF, 128, 0, NROWS, 128, 0, 0, RES);
#elif DBG == 5
    dbg::k_cmp_scores<<<1, 1024, 0, stream>>>((const float*)(fw + mk::WS_S), REF, (const float*)d_in[14], 512, RES);
#endif
    hipMemcpyAsync(REF, RES, 64, hipMemcpyDeviceToDevice, stream);
    run_naive(d_in, out, ws, stream, 9, 99);
    dbg::k_final<<<1024, 256, 0, stream>>>(out, (long)NB * SEQ * DM, REF);
    dbg::k_final2<<<1, 1, 0, stream>>>(out, REF);
  }
#endif
}
```
